# Optimizing an MI355X kernel written in HIP

```python
import math
import jax, jax.numpy as jnp
from jax import lax
import numpy as np

D_MODEL = 2048
BATCH = 8
SEQ = 2048
DEPTH = 4

N_MIXERS = 2
D_FF = 5632
ATT_HEADS = 32
ATT_KV_HEADS = 4
ATT_HEAD_DIM = D_MODEL // ATT_HEADS
ATT_GROUP = ATT_HEADS // ATT_KV_HEADS
WINDOW = 128
BLOCK = WINDOW
ATT_QKV_COLS = ATT_HEADS * ATT_HEAD_DIM + 2 * ATT_KV_HEADS * ATT_HEAD_DIM
M_HEADS = 4
M_V_DIM = D_MODEL // M_HEADS
M_QK_DIM = M_V_DIM // 2
CHUNK = 128
M_PROJ_COLS = 2 * M_HEADS * M_QK_DIM + 2 * M_HEADS * M_V_DIM + 2 * M_HEADS
N_ATT_LAYERS = (DEPTH + 1) // 2
N_MLSTM_LAYERS = DEPTH // 2
DEEPNORM_ALPHA = (2.0 * DEPTH) ** 0.25
DEEPNORM_BETA = (8.0 * DEPTH) ** -0.25
LN_EPS = 1e-5

kernel_name = "hybrid_swa_sink_alibi_mlstm_macaron_deepnorm"


def layer_norm(x, g, b):
    xf = x.astype(jnp.float32)
    mu = jnp.mean(xf, axis=-1, keepdims=True)
    var = jnp.mean(jnp.square(xf - mu), axis=-1, keepdims=True)
    return ((xf - mu) * lax.rsqrt(var + LN_EPS) * g.astype(jnp.float32) + b.astype(jnp.float32)).astype(x.dtype)


def swiglu(x, w1, w3, w2):
    return (jax.nn.silu(x @ w1) * (x @ w3)) @ w2


def alibi_slopes(n_heads):
    return 2.0 ** (-8.0 * jnp.arange(1, n_heads + 1, dtype=jnp.float32) / n_heads)


def sliding_window_attention(x, w_qkv, sinks, w_o):
    B, S, _ = x.shape
    H, KV, G, Dh = ATT_HEADS, ATT_KV_HEADS, ATT_GROUP, ATT_HEAD_DIM
    nb = S // BLOCK
    qkv = x @ w_qkv
    q, k, v = jnp.split(qkv, [H * Dh, H * Dh + KV * Dh], axis=-1)
    q = q.reshape(B, nb, BLOCK, KV, G, Dh)
    k = k.reshape(B, nb, BLOCK, KV, Dh)
    v = v.reshape(B, nb, BLOCK, KV, Dh)
    pad = jnp.zeros_like(k[:, :1])
    kb = jnp.concatenate([jnp.concatenate([pad, k[:, :-1]], axis=1), k], axis=2)
    vb = jnp.concatenate([jnp.concatenate([pad, v[:, :-1]], axis=1), v], axis=2)
    s = jnp.einsum('bnqkgd,bnskd->bnkgqs', q, kb).astype(jnp.float32) * (Dh ** -0.5)
    qi = jnp.arange(BLOCK)[:, None]
    kj = jnp.arange(2 * BLOCK)[None, :]
    dist = BLOCK + qi - kj
    in_window = (dist >= 0) & (dist < WINDOW)
    has_prev = (jnp.arange(nb)[:, None, None] > 0) | (kj >= BLOCK)[None]
    valid = in_window[None] & has_prev
    slopes = alibi_slopes(H).reshape(KV, G)
    s = s - slopes[:, :, None, None] * dist.astype(jnp.float32)
    s = jnp.where(valid[None, :, None, None], s, -jnp.inf)
    sink = sinks.astype(jnp.float32).reshape(KV, G)[:, :, None, None]
    m = jnp.maximum(jnp.max(s, axis=-1, keepdims=True), sink)
    p = jnp.exp(s - m)
    p = p / (jnp.sum(p, axis=-1, keepdims=True) + jnp.exp(sink - m))
    o = jnp.einsum('bnkgqs,bnskd->bnqkgd', p.astype(x.dtype), vb).reshape(B, S, H * Dh)
    return o @ w_o


def mlstm(x, w_in, b_gates, w_o):
    B, S, _ = x.shape
    H, Dk, Dv, L = M_HEADS, M_QK_DIM, M_V_DIM, CHUNK
    nc = S // L
    f32 = jnp.float32
    proj = x @ w_in
    q, k, v, og, gates = jnp.split(
        proj, [H * Dk, 2 * H * Dk, 2 * H * Dk + H * Dv, 2 * H * Dk + 2 * H * Dv], axis=-1)
    gates = gates.astype(f32) + b_gates.astype(f32)
    i_pre = gates[..., :H]
    log_f = jax.nn.log_sigmoid(gates[..., H:])

    def to_chunks(t, d):
        return t.astype(f32).reshape(B, nc, L, H, d).transpose(1, 0, 3, 2, 4)

    qc = to_chunks(q, Dk)
    kc = to_chunks(k, Dk) * (Dk ** -0.5)
    vc = to_chunks(v, Dv)
    ic = i_pre.reshape(B, nc, L, H).transpose(1, 0, 3, 2)
    fc = log_f.reshape(B, nc, L, H).transpose(1, 0, 3, 2)
    causal = jnp.tril(jnp.ones((L, L), dtype=bool))

    def step(carry, inp):
        C, n, m = carry
        qt, kt, vt, ig, lf = inp
        b = jnp.cumsum(lf, axis=-1)
        a = b + m[..., None]
        dmat = b[..., :, None] - b[..., None, :] + ig[..., None, :]
        dmat = jnp.where(causal, dmat, -jnp.inf)
        m_rows = jnp.maximum(a, jnp.max(dmat, axis=-1))
        inter = jnp.exp(a - m_rows)
        w = jnp.einsum('bhtd,bhsd->bhts', qt, kt) * jnp.exp(dmat - m_rows[..., None])
        num = inter[..., None] * jnp.einsum('bhtd,bhde->bhte', qt, C) + jnp.einsum('bhts,bhse->bhte', w, vt)
        den = inter * jnp.einsum('bhtd,bhd->bht', qt, n) + jnp.sum(w, axis=-1)
        h = num / jnp.maximum(jnp.abs(den), jnp.exp(-m_rows))[..., None]
        m_end = m_rows[..., -1]
        decay = jnp.exp(b[..., -1] + m - m_end)
        wk = jnp.exp(b[..., -1:] - b + ig - m_end[..., None])
        C = decay[..., None, None] * C + jnp.einsum('bhs,bhsd,bhse->bhde', wk, kt, vt)
        n = decay[..., None] * n + jnp.einsum('bhs,bhsd->bhd', wk, kt)
        return (C, n, m_end), h

    init = (jnp.zeros((B, H, Dk, Dv), f32), jnp.zeros((B, H, Dk), f32), jnp.zeros((B, H), f32))
    _, hs = lax.scan(step, init, (qc, kc, vc, ic, fc))
    h = hs.transpose(1, 0, 3, 2, 4).reshape(B, S, H * Dv).astype(x.dtype)
    return (h * jax.nn.sigmoid(og)) @ w_o


def setup_inputs(seed: int = 0) -> dict:
    key = jax.random.key(seed)
    ks = jax.random.split(key, 16)
    D, F = D_MODEL, D_FF
    beta = DEEPNORM_BETA
    x = jax.random.normal(ks[0], (BATCH, SEQ, D), jnp.float32)
    ffn_w1 = jax.random.normal(ks[1], (DEPTH, 2, D, F), jnp.float32) * (D ** -0.5) * beta
    ffn_w3 = jax.random.normal(ks[2], (DEPTH, 2, D, F), jnp.float32) * (D ** -0.5) * beta
    ffn_w2 = jax.random.normal(ks[3], (DEPTH, 2, F, D), jnp.float32) * (F ** -0.5) * beta
    ln_g = 1.0 + 0.02 * jax.random.normal(ks[4], (DEPTH, 3, D), jnp.float32)
    ln_b = 0.02 * jax.random.normal(ks[5], (DEPTH, 3, D), jnp.float32)
    att_scale = jnp.concatenate([
        jnp.ones((ATT_HEADS * ATT_HEAD_DIM + ATT_KV_HEADS * ATT_HEAD_DIM,), jnp.float32),
        jnp.full((ATT_KV_HEADS * ATT_HEAD_DIM,), beta, jnp.float32)])
    att_w_qkv = jax.random.normal(ks[6], (N_ATT_LAYERS, D, ATT_QKV_COLS), jnp.float32) * (D ** -0.5) * att_scale
    att_sinks = 0.5 * jax.random.normal(ks[7], (N_ATT_LAYERS, ATT_HEADS), jnp.float32)
    att_w_o = jax.random.normal(ks[8], (N_ATT_LAYERS, ATT_HEADS * ATT_HEAD_DIM, D), jnp.float32) * (D ** -0.5) * beta
    m_scale = jnp.concatenate([
        jnp.ones((2 * M_HEADS * M_QK_DIM,), jnp.float32),
        jnp.full((M_HEADS * M_V_DIM,), beta, jnp.float32),
        jnp.ones((M_HEADS * M_V_DIM,), jnp.float32),
        jnp.full((2 * M_HEADS,), 0.1, jnp.float32)])
    mlstm_w_in = jax.random.normal(ks[9], (N_MLSTM_LAYERS, D, M_PROJ_COLS), jnp.float32) * (D ** -0.5) * m_scale
    i_bias = 0.1 * jax.random.normal(ks[10], (N_MLSTM_LAYERS, M_HEADS), jnp.float32)
    f_bias = jnp.linspace(3.0, 6.0, M_HEADS, dtype=jnp.float32)[None] + 0.1 * jax.random.normal(ks[11], (N_MLSTM_LAYERS, M_HEADS), jnp.float32)
    mlstm_b_gates = jnp.concatenate([i_bias, f_bias], axis=-1)
    mlstm_w_o = jax.random.normal(ks[12], (N_MLSTM_LAYERS, M_HEADS * M_V_DIM, D), jnp.float32) * (D ** -0.5) * beta
    return {"x": x, "ffn_w1": ffn_w1, "ffn_w3": ffn_w3, "ffn_w2": ffn_w2,
            "ln_g": ln_g, "ln_b": ln_b,
            "att_w_qkv": att_w_qkv, "att_sinks": att_sinks, "att_w_o": att_w_o,
            "mlstm_w_in": mlstm_w_in, "mlstm_b_gates": mlstm_b_gates, "mlstm_w_o": mlstm_w_o}


def reference(x, ffn_w1, ffn_w3, ffn_w2, ln_g, ln_b, att_w_qkv, att_sinks, att_w_o,
              mlstm_w_in, mlstm_b_gates, mlstm_w_o):
    alpha = DEEPNORM_ALPHA
    for layer in range(DEPTH):
        ffn_a = swiglu(x, ffn_w1[layer, 0], ffn_w3[layer, 0], ffn_w2[layer, 0])
        x = layer_norm(alpha * x + 0.5 * ffn_a, ln_g[layer, 0], ln_b[layer, 0])
        j = layer // N_MIXERS
        if layer % N_MIXERS == 0:
            y = sliding_window_attention(x, att_w_qkv[j], att_sinks[j], att_w_o[j])
        else:
            y = mlstm(x, mlstm_w_in[j], mlstm_b_gates[j], mlstm_w_o[j])
        x = layer_norm(alpha * x + y, ln_g[layer, 1], ln_b[layer, 1])
        ffn_b = swiglu(x, ffn_w1[layer, 1], ffn_w3[layer, 1], ffn_w2[layer, 1])
        x = layer_norm(alpha * x + 0.5 * ffn_b, ln_g[layer, 2], ln_b[layer, 2])
    return x
```

```cpp
#include <hip/hip_runtime.h>
#include <hip/hip_bf16.h>
#include <cstdio>
#include <cstdint>
#include <cmath>

constexpr int BATCH = 8, SEQ = 2048, D = 2048, FF = 5632, DEPTH = 4;
constexpr int M = BATCH * SEQ;
constexpr int NUP = 2 * FF;
constexpr int NQKV = 2560;
constexpr int NMI = 6144, NMIW = 6152;
constexpr float LN_EPS = 1e-5f;
constexpr float ALPHA = 1.681792830507429f;
constexpr float LOG2E = 1.4426950408889634f;

namespace pg8 {
#define PG8_LAS __attribute__((address_space(3)))
typedef unsigned short bf16_t;
typedef short bf16x8 __attribute__((ext_vector_type(8)));
typedef float f32x4 __attribute__((ext_vector_type(4)));
typedef unsigned u32x4 __attribute__((ext_vector_type(4)));
constexpr int BM = 256, BK = 64, HALF = 128, HTB = HALF * BK * 2  , STAGE_BYTES = 8 * HTB, NXCD = 8, WGM = 8;

__host__ __device__ __forceinline__ int lds_byte(int r, int c) { const int st = (r >> 4) * 2 + (c >> 5), rr = r & 15, cc = c & 31, ob = rr * 64 + cc * 2; return st * 1024 + (ob ^ (((ob >> 9) & 1) << 5)); }
__host__ __device__ __forceinline__ void stage_rc(int b, int& R, int& C) { const int st = b / 1024, sb = b % 1024, swz = sb ^ (((sb >> 9) & 1) << 5); R = (st >> 1) * 16 + swz / 64; C = (st & 1) * 32 + (swz % 64) / 2; }
__host__ __device__ __forceinline__ int perm32(int rho) { const int n = rho >> 4, i = rho & 15; return 8 * (i >> 2) + 4 * n + (i & 3); }

__device__ __forceinline__ int pg8_lane() { int l; asm volatile("v_mbcnt_lo_u32_b32 %0, -1, 0\n\tv_mbcnt_hi_u32_b32 %0, -1, %0" : "=v"(l)); return l; }
struct Unit { int pm, pn; };
struct Gemm { const bf16_t* A; const bf16_t* Bt; int M, N, K; };

struct StaticOrder {
    int nM, nN, nwg, G, c;
    __host__ __device__ void init(int M_, int N_, int G_, int c_) { nM = M_ / BM; nN = N_ / BM; nwg = nM * nN; G = G_; c = c_; }
    __host__ __device__ bool next(int i, Unit& u) const {
        const long L = (long)i * G + c; if (L >= nwg) return false;
        int wgid = (int)L; { const int q = nwg / NXCD, r = nwg % NXCD, xcd = wgid % NXCD, off = wgid / NXCD; wgid = (xcd < r ? xcd * (q + 1) : r * (q + 1) + (xcd - r) * q) + off; }
        const int nig = WGM * nN, gid = wgid / nig, fm = gid * WGM, gsz = (nM - fm) < WGM ? (nM - fm) : WGM;
        u.pm = fm + ((wgid % nig) % gsz); u.pn = (wgid % nig) / gsz; return true;
    }
    __device__ __forceinline__ void a_ready(const Unit&) const {}
    __device__ __forceinline__ void done(const Unit&) const {}
};

__device__ __forceinline__ unsigned cvt_pk_bf16(float lo, float hi) { typedef float f2 __attribute__((ext_vector_type(2))); typedef __bf16 b2 __attribute__((ext_vector_type(2))); f2 v = {lo, hi}; b2 b = __builtin_convertvector(v, b2); return __builtin_bit_cast(unsigned, b); }
__device__ __forceinline__ float bf_lo(unsigned w) { return __uint_as_float(w << 16); }
__device__ __forceinline__ float bf_hi(unsigned w) { return __uint_as_float(w & 0xffff0000u); }
__device__ __forceinline__ float fsigmoid(float x) { return __builtin_amdgcn_rcpf(1.f + __builtin_amdgcn_exp2f(-LOG2E * x)); }

__device__ __forceinline__ void row_stats(const float* sp, int row0, int fq, float (&mu)[2][4], float (&rs)[2][4]) {
#pragma unroll
    for (int ai = 0; ai < 2; ++ai)
#pragma unroll
        for (int m = 0; m < 4; ++m) {
            const f32x4 v = *(const f32x4*)(sp + (size_t)(row0 + ai * HALF + m * 16) * 16 + fq * 4);
            float s = v[0] + v[2], q = v[1] + v[3];
            s += __shfl_xor(s, 16); q += __shfl_xor(q, 16); s += __shfl_xor(s, 32); q += __shfl_xor(q, 32);
            const float mean = s * (1.f / D), var = q * (1.f / D) - mean * mean;
            mu[ai][m] = mean; rs[ai][m] = __builtin_amdgcn_rsqf(var + LN_EPS);
        }
}

struct EpiUp {
    static constexpr bool PERM = true, AFTER_DRAIN = false;
    bf16_t* H; const float* c1; const float* c2; const float* sp;
    __device__ __forceinline__ void operator()(const f32x4 (&acc)[2][2][4][2], const Unit& u, int wr, int wc, int fr, int fq) const {
        const int row0 = u.pm * BM + wr * 64 + fr;
        float mu[2][4], rs[2][4]; row_stats(sp, row0, fq, mu, rs);
        const int cb = u.pn * BM + wc * 32 + 8 * fq;
        f32x4 k1[2][2], k2[2][2];
#pragma unroll
        for (int bj = 0; bj < 2; ++bj)
#pragma unroll
            for (int n = 0; n < 2; ++n) { k1[bj][n] = *(const f32x4*)(c1 + cb + bj * HALF + 4 * n); k2[bj][n] = *(const f32x4*)(c2 + cb + bj * HALF + 4 * n); }
        bf16_t* hp = H + (size_t)row0 * FF + u.pn * HALF + wc * 32 + 8 * fq;
#pragma unroll
        for (int ai = 0; ai < 2; ++ai)
#pragma unroll
            for (int m = 0; m < 4; ++m) {
                const float r_ = rs[ai][m], nm = -mu[ai][m] * r_;
                float hv[8];
#pragma unroll
                for (int n = 0; n < 2; ++n)
#pragma unroll
                    for (int j = 0; j < 4; ++j) {
                        const float ga = acc[ai][0][m][n][j] * r_ + (nm * k1[0][n][j] + k2[0][n][j]);
                        const float ub = acc[ai][1][m][n][j] * r_ + (nm * k1[1][n][j] + k2[1][n][j]);
                        hv[4 * n + j] = ga * fsigmoid(ga) * ub;
                    }
                u32x4 w; w.x = cvt_pk_bf16(hv[0], hv[1]); w.y = cvt_pk_bf16(hv[2], hv[3]); w.z = cvt_pk_bf16(hv[4], hv[5]); w.w = cvt_pk_bf16(hv[6], hv[7]);
                *(u32x4*)(hp + (size_t)(ai * HALF + m * 16) * FF) = w;
            }
    }
};

struct EpiLnOut {
    static constexpr bool PERM = true, AFTER_DRAIN = false;
    bf16_t* O; int ldo; const float* c1; const float* c2; const float* sp; int sig_from;
    __device__ __forceinline__ void operator()(const f32x4 (&acc)[2][2][4][2], const Unit& u, int wr, int wc, int fr, int fq) const {
        const int row0 = u.pm * BM + wr * 64 + fr;
        float mu[2][4], rs[2][4]; row_stats(sp, row0, fq, mu, rs);
        const int cb = u.pn * BM + wc * 32 + 8 * fq;
        const bool sg = u.pn >= sig_from;
        f32x4 k1[2][2], k2[2][2];
#pragma unroll
        for (int bj = 0; bj < 2; ++bj)
#pragma unroll
            for (int n = 0; n < 2; ++n) { k1[bj][n] = *(const f32x4*)(c1 + cb + bj * HALF + 4 * n); k2[bj][n] = *(const f32x4*)(c2 + cb + bj * HALF + 4 * n); }
        bf16_t* op = O + (size_t)row0 * ldo + cb;
#pragma unroll
        for (int ai = 0; ai < 2; ++ai)
#pragma unroll
            for (int m = 0; m < 4; ++m) {
                const float r_ = rs[ai][m], nm = -mu[ai][m] * r_;
#pragma unroll
                for (int bj = 0; bj < 2; ++bj) {
                    float v[8];
#pragma unroll
                    for (int n = 0; n < 2; ++n)
#pragma unroll
                        for (int j = 0; j < 4; ++j) { float t = acc[ai][bj][m][n][j] * r_ + (nm * k1[bj][n][j] + k2[bj][n][j]); if (sg) t = fsigmoid(t); v[4 * n + j] = t; }
                    u32x4 w; w.x = cvt_pk_bf16(v[0], v[1]); w.y = cvt_pk_bf16(v[2], v[3]); w.z = cvt_pk_bf16(v[4], v[5]); w.w = cvt_pk_bf16(v[6], v[7]);
                    *(u32x4*)(op + (size_t)(ai * HALF + m * 16) * ldo + bj * HALF) = w;
                }
            }
    }
};

struct EpiRes {
    static constexpr bool PERM = true, AFTER_DRAIN = false;
    bf16_t* R; const float* g; const float* b; const float* sp_in; float* sp_out; float coef; PG8_LAS float* tab; int wave;
    __device__ __forceinline__ void operator()(const f32x4 (&acc)[2][2][4][2], const Unit& u, int wr, int wc, int fr, int fq) const {
        typedef float f32x2v __attribute__((ext_vector_type(2)));
        const int row0 = u.pm * BM + wr * 64 + fr;
        float mu[2][4], rs[2][4]; row_stats(sp_in, row0, fq, mu, rs);
        const int cb = u.pn * BM + wc * 32 + 8 * fq;
        f32x4 gv[2][2], bv[2][2];
#pragma unroll
        for (int bj = 0; bj < 2; ++bj)
#pragma unroll
            for (int n = 0; n < 2; ++n) { gv[bj][n] = *(const f32x4*)(g + cb + bj * HALF + 4 * n); bv[bj][n] = *(const f32x4*)(b + cb + bj * HALF + 4 * n) * ALPHA; }
#pragma unroll
        for (int ai = 0; ai < 2; ++ai)
#pragma unroll
            for (int m = 0; m < 4; ++m) {
                const float A_ = ALPHA * rs[ai][m], B_ = -mu[ai][m] * A_;
                bf16_t* rp = R + (size_t)(row0 + ai * HALF + m * 16) * D + cb;
                float s = 0.f, q = 0.f;
#pragma unroll
                for (int bj = 0; bj < 2; ++bj) {
                    const u32x4 old = *(const u32x4*)(rp + bj * HALF);
                    float ro[8] = {bf_lo(old.x), bf_hi(old.x), bf_lo(old.y), bf_hi(old.y), bf_lo(old.z), bf_hi(old.z), bf_lo(old.w), bf_hi(old.w)};
                    float nv[8];
#pragma unroll
                    for (int n = 0; n < 2; ++n)
#pragma unroll
                        for (int j = 0; j < 4; ++j) nv[4 * n + j] = (ro[4 * n + j] * A_ + B_) * gv[bj][n][j] + bv[bj][n][j] + coef * acc[ai][bj][m][n][j];
                    u32x4 w; w.x = cvt_pk_bf16(nv[0], nv[1]); w.y = cvt_pk_bf16(nv[2], nv[3]); w.z = cvt_pk_bf16(nv[4], nv[5]); w.w = cvt_pk_bf16(nv[6], nv[7]);
                    *(u32x4*)(rp + bj * HALF) = w;
                    const float f0 = bf_lo(w.x), f1 = bf_hi(w.x), f2 = bf_lo(w.y), f3 = bf_hi(w.y), f4 = bf_lo(w.z), f5 = bf_hi(w.z), f6 = bf_lo(w.w), f7 = bf_hi(w.w);
                    s += ((f0 + f1) + (f2 + f3)) + ((f4 + f5) + (f6 + f7));
                    q += ((f0 * f0 + f1 * f1) + (f2 * f2 + f3 * f3)) + ((f4 * f4 + f5 * f5) + (f6 * f6 + f7 * f7));
                }
                s += __shfl_xor(s, 16); q += __shfl_xor(q, 16); s += __shfl_xor(s, 32); q += __shfl_xor(q, 32);
                if (fq == 0) *(PG8_LAS f32x2v*)(tab + ((ai * HALF + wr * 64 + m * 16 + fr) * 4 + wc) * 2) = (f32x2v){s, q};
            }
        asm volatile("s_waitcnt lgkmcnt(0)" ::: "memory"); __builtin_amdgcn_s_barrier(); asm volatile("" ::: "memory");
        const int tid = wave * 64 + pg8_lane();
        if (tid < BM) {
            const PG8_LAS f32x4* t4 = (const PG8_LAS f32x4*)(tab + tid * 8);
            const f32x4 a = t4[0], c = t4[1];
            *(f32x2v*)(sp_out + (size_t)(u.pm * BM + tid) * 16 + u.pn * 2) = (f32x2v){(a[0] + a[2]) + (c[0] + c[2]), (a[1] + a[3]) + (c[1] + c[3])};
        }
    }
};

template <class Epi, class Sched, bool ALIGN_EPI = false, bool SP2 = false>
__device__ __forceinline__ void gemm_phase(PG8_LAS unsigned char* lds, const Gemm g, const Sched& S, const Epi& E, int wave_in) {
    int wid = wave_in; asm volatile("" : "+s"(wid));
    const int lane = pg8_lane(), tid = wid * 64 + lane, wr = wid >> 2, wc = wid & 3, fr = lane & 15, fq = lane >> 4;
    const int K = g.K, nt = K / BK;
    unsigned voffA[2], voffB[2];
#pragma unroll
    for (int i = 0; i < 2; ++i) { int R, C; stage_rc(tid * 16 + i * 8192, R, C); const int Rb = Epi::PERM ? ((R & ~31) + perm32(R & 31)) : R;
        voffA[i] = (unsigned)(R * K + C) * 2u; voffB[i] = (unsigned)(Rb * K + C) * 2u; }
    const size_t kstep = (size_t)(BK * 2);
    const size_t hstep = (size_t)HALF * K * 2;
    const size_t tstep = 2 * hstep;
    const unsigned ldsw = (unsigned)wid * 1024u;
    const int aoff = lds_byte(wr * 64 + fr, fq * 8), boff = lds_byte(wc * 32 + fr, fq * 8);
#define PG8_SA(b, h) (((b) * 2 + (h)) * HTB)
#define PG8_SB(b, h) ((4 + (b) * 2 + (h)) * HTB)
#define PG8_STAGE(bufoff, gbase, voff) do { _Pragma("unroll") for (int _i = 0; _i < 2; ++_i) \
        __builtin_amdgcn_global_load_lds((const unsigned*)((const char*)(gbase) + (voff)[_i]), (PG8_LAS unsigned*)(lds + (bufoff) + ldsw + _i * 8192), 16, 0, 0); } while (0)
#define PG8_LDA(dst, b, h) do { _Pragma("unroll") for (int m = 0; m < 4; ++m) _Pragma("unroll") for (int k = 0; k < 2; ++k) dst[m][k] = *(const PG8_LAS bf16x8*)(lds + PG8_SA(b, h) + aoff + m * 2048 + k * 1024); } while (0)
#define PG8_LDB(dst, b, h) do { _Pragma("unroll") for (int n = 0; n < 2; ++n) _Pragma("unroll") for (int k = 0; k < 2; ++k) dst[n][k] = *(const PG8_LAS bf16x8*)(lds + PG8_SB(b, h) + boff + n * 2048 + k * 1024); } while (0)
#define PG8_MMA(ai, bj, At, Bt) do { __builtin_amdgcn_s_setprio(1); _Pragma("unroll") for (int m = 0; m < 4; ++m) _Pragma("unroll") for (int n = 0; n < 2; ++n) _Pragma("unroll") for (int k = 0; k < 2; ++k) \
        acc[ai][bj][m][n] = __builtin_amdgcn_mfma_f32_16x16x32_bf16(Bt[n][k], At[m][k], acc[ai][bj][m][n], 0, 0, 0); __builtin_amdgcn_s_setprio(0); } while (0)
#define PG8_WAIT_V(n) asm volatile("s_waitcnt vmcnt(" #n ")" ::: "memory")
#define PG8_WAIT_L(n) asm volatile("s_waitcnt lgkmcnt(" #n ")" ::: "memory")
#define PG8_BAR __builtin_amdgcn_s_barrier()
#define PG8_SCHED __builtin_amdgcn_sched_barrier(0)
    Unit cur, nxt; int ui = 0;
    if (!S.next(0, cur)) return;
    f32x4 acc[2][2][4][2];
#pragma unroll
    for (int a = 0; a < 2; ++a)
#pragma unroll
        for (int b = 0; b < 2; ++b)
#pragma unroll
            for (int m = 0; m < 4; ++m)
#pragma unroll
                for (int n = 0; n < 2; ++n) { float z0, z1, z2, z3; asm volatile("v_mov_b32 %0, 0\n\tv_mov_b32 %1, 0\n\tv_mov_b32 %2, 0\n\tv_mov_b32 %3, 0" : "=v"(z0), "=v"(z1), "=v"(z2), "=v"(z3)); acc[a][b][m][n] = (f32x4){z0, z1, z2, z3}; }
    bf16x8 At[4][2], B0[2][2], B1[2][2];
    const char* cA = (const char*)g.A + (size_t)cur.pm * tstep; const char* cB = (const char*)g.Bt + (size_t)cur.pn * tstep;
    S.a_ready(cur);
    if constexpr (SP2) {
        PG8_STAGE(PG8_SB(0, 0), cB, voffB); PG8_STAGE(PG8_SB(0, 1), cB + hstep, voffB); PG8_STAGE(PG8_SA(0, 0), cA, voffA); PG8_STAGE(PG8_SA(0, 1), cA + hstep, voffA);
        if (wr == 1) PG8_BAR;
        PG8_WAIT_V(2); PG8_BAR;
        PG8_STAGE(PG8_SB(1, 0), cB + kstep, voffB); PG8_STAGE(PG8_SA(1, 0), cA + kstep, voffA); PG8_STAGE(PG8_SB(1, 1), cB + hstep + kstep, voffB);
        PG8_WAIT_V(6); PG8_BAR;
    } else {
        PG8_STAGE(PG8_SB(0, 0), cB, voffB); PG8_STAGE(PG8_SA(0, 0), cA, voffA); PG8_STAGE(PG8_SB(0, 1), cB + hstep, voffB); PG8_STAGE(PG8_SA(0, 1), cA + hstep, voffA);
        if (wr == 1) PG8_BAR;
        PG8_WAIT_V(4); PG8_BAR;
        PG8_STAGE(PG8_SB(1, 0), cB + kstep, voffB); PG8_STAGE(PG8_SA(1, 0), cA + kstep, voffA); PG8_STAGE(PG8_SB(1, 1), cB + hstep + kstep, voffB);
        PG8_WAIT_V(6); PG8_BAR;
    }
    for (;;) {
        const bool has_next = S.next(ui + 1, nxt);
        const char* nA = has_next ? (const char*)g.A + (size_t)nxt.pm * tstep : cA; const char* nB = has_next ? (const char*)g.Bt + (size_t)nxt.pn * tstep : cB;
        for (int t = 0; t < nt; t += 2) {
            const bool last = (t == nt - 2);
            const char* a1 = cA + (size_t)(t + 1) * kstep;
            const char* a2 = last ? nA : cA + (size_t)(t + 2) * kstep; const char* b2 = last ? nB : cB + (size_t)(t + 2) * kstep;
            const char* a3 = a2 + kstep; const char* b3 = b2 + kstep;
            if (last && has_next) S.a_ready(nxt);
            if constexpr (SP2) {
            PG8_LDB(B0, 0, 0); PG8_LDB(B1, 0, 1); PG8_SCHED; PG8_LDA(At, 0, 0); PG8_STAGE(PG8_SA(1, 1), a1 + hstep, voffA);
            PG8_WAIT_V(8); PG8_WAIT_L(0); PG8_BAR; PG8_MMA(0, 0, At, B0); PG8_MMA(0, 1, At, B1); PG8_BAR; PG8_SCHED;
            PG8_LDA(At, 0, 1); PG8_STAGE(PG8_SB(0, 0), b2, voffB); PG8_STAGE(PG8_SB(0, 1), b2 + hstep, voffB); PG8_STAGE(PG8_SA(0, 0), a2, voffA);
            PG8_WAIT_V(8); PG8_WAIT_L(0); PG8_BAR; PG8_MMA(1, 0, At, B0); PG8_MMA(1, 1, At, B1); PG8_BAR; PG8_SCHED;
            PG8_LDB(B0, 1, 0); PG8_LDB(B1, 1, 1); PG8_SCHED; PG8_LDA(At, 1, 0); PG8_STAGE(PG8_SA(0, 1), a2 + hstep, voffA);
            PG8_WAIT_V(8); PG8_WAIT_L(0); PG8_BAR; PG8_MMA(0, 0, At, B0); PG8_MMA(0, 1, At, B1); PG8_BAR; PG8_SCHED;
            PG8_LDA(At, 1, 1); PG8_STAGE(PG8_SB(1, 0), b3, voffB); PG8_STAGE(PG8_SB(1, 1), b3 + hstep, voffB); PG8_STAGE(PG8_SA(1, 0), a3, voffA);
            PG8_WAIT_V(8); PG8_WAIT_L(0); PG8_BAR; PG8_MMA(1, 0, At, B0); PG8_MMA(1, 1, At, B1); PG8_BAR; PG8_SCHED;
            } else {
            PG8_LDB(B0, 0, 0); PG8_SCHED; PG8_LDA(At, 0, 0); PG8_STAGE(PG8_SA(1, 1), a1 + hstep, voffA);
            PG8_WAIT_L(8); PG8_BAR; PG8_WAIT_L(0); PG8_MMA(0, 0, At, B0); PG8_BAR; PG8_SCHED;
            PG8_LDB(B1, 0, 1); PG8_STAGE(PG8_SB(0, 0), b2, voffB);
            PG8_BAR; PG8_WAIT_L(0); PG8_MMA(0, 1, At, B1); PG8_BAR;
            PG8_LDA(At, 0, 1); PG8_STAGE(PG8_SA(0, 0), a2, voffA);
            PG8_BAR; PG8_WAIT_L(0); PG8_MMA(1, 0, At, B0); PG8_BAR; PG8_SCHED;
            PG8_STAGE(PG8_SB(0, 1), b2 + hstep, voffB);
            PG8_WAIT_V(6); PG8_BAR; PG8_MMA(1, 1, At, B1); PG8_BAR;
            PG8_LDB(B0, 1, 0); PG8_SCHED; PG8_LDA(At, 1, 0); PG8_STAGE(PG8_SA(0, 1), a2 + hstep, voffA);
            PG8_WAIT_L(8); PG8_BAR; PG8_WAIT_L(0); PG8_MMA(0, 0, At, B0); PG8_BAR; PG8_SCHED;
            PG8_LDB(B1, 1, 1); PG8_STAGE(PG8_SB(1, 0), b3, voffB);
            PG8_BAR; PG8_WAIT_L(0); PG8_MMA(0, 1, At, B1); PG8_BAR;
            PG8_LDA(At, 1, 1); PG8_STAGE(PG8_SA(1, 0), a3, voffA);
            PG8_BAR; PG8_WAIT_L(0); PG8_MMA(1, 0, At, B0); PG8_BAR; PG8_SCHED;
            PG8_STAGE(PG8_SB(1, 1), b3 + hstep, voffB);
            PG8_WAIT_V(6); PG8_BAR; PG8_MMA(1, 1, At, B1); PG8_BAR;
            }
        }
        if constexpr (ALIGN_EPI) { if (wr == 0) PG8_BAR; }
        if constexpr (!Epi::AFTER_DRAIN) { E(acc, cur, wr, wc, fr, fq); S.done(cur); }
        if (!has_next) break;
#pragma unroll
        for (int a = 0; a < 2; ++a)
#pragma unroll
            for (int b = 0; b < 2; ++b)
#pragma unroll
                for (int m = 0; m < 4; ++m)
#pragma unroll
                    for (int n = 0; n < 2; ++n) { float z0, z1, z2, z3; asm volatile("v_mov_b32 %0, 0\n\tv_mov_b32 %1, 0\n\tv_mov_b32 %2, 0\n\tv_mov_b32 %3, 0" : "=v"(z0), "=v"(z1), "=v"(z2), "=v"(z3)); acc[a][b][m][n] = (f32x4){z0, z1, z2, z3}; }
        cur = nxt; cA = nA; cB = nB; ++ui;
        if constexpr (ALIGN_EPI) { if (wr == 1) PG8_BAR; }
    }
    PG8_WAIT_V(0);
    if constexpr (!ALIGN_EPI) { if (wr == 0) PG8_BAR; }
    PG8_BAR;
    if constexpr (Epi::AFTER_DRAIN) { E.fused(acc, cur, wr, wc, fr, fq, lds, wid, lane); S.done(cur); }
#undef PG8_SA
#undef PG8_SB
#undef PG8_STAGE
#undef PG8_LDA
#undef PG8_LDB
#undef PG8_MMA
#undef PG8_WAIT_V
#undef PG8_WAIT_L
#undef PG8_BAR
#undef PG8_SCHED
}
}

#ifndef PG8_SP2
#define PG8_SP2 true
#endif

#define GAS __attribute__((address_space(1)))
#define LAS __attribute__((address_space(3)))
typedef unsigned short bf16;
typedef unsigned v4u __attribute__((ext_vector_type(4)));
typedef unsigned v2u __attribute__((ext_vector_type(2)));
typedef float f32x4 __attribute__((ext_vector_type(4)));
typedef float f32x2 __attribute__((ext_vector_type(2)));
typedef float f32x16 __attribute__((ext_vector_type(16)));
typedef short bf16x8 __attribute__((ext_vector_type(8)));
typedef short s16x4 __attribute__((ext_vector_type(4)));
typedef GAS unsigned gu32;
typedef GAS unsigned long long gu64;
typedef LAS const char* lcp;
typedef LAS char* lwp;
#define RLX_AGENT __ATOMIC_RELAXED, __HIP_MEMORY_SCOPE_AGENT
#define LDS_WAIT() asm volatile("s_waitcnt lgkmcnt(0)" ::: "memory")
#define VM_WAIT() asm volatile("s_waitcnt vmcnt(0)" ::: "memory")
#define WG_BAR() do { asm volatile("s_waitcnt vmcnt(0) lgkmcnt(0)" ::: "memory"); __builtin_amdgcn_s_barrier(); asm volatile("" ::: "memory"); } while (0)
#define DI __device__ __forceinline__
#define MFMA32(a, b, c) __builtin_amdgcn_mfma_f32_32x32x16_bf16((a), (b), (c), 0, 0, 0)
DI unsigned pk2(float lo, float hi) { return pg8::cvt_pk_bf16(lo, hi); }
DI float bflo(unsigned w) { return __uint_as_float(w << 16); }
DI float bfhi(unsigned w) { return __uint_as_float(w & 0xffff0000u); }
DI float ex2(float x) { return __builtin_amdgcn_exp2f(x); }
DI int crow(int r, int hi) { return (r & 3) + 8 * (r >> 2) + 4 * hi; }
DI float wave_sum(float v) {
#pragma unroll
    for (int o = 1; o < 64; o <<= 1) v += __shfl_xor(v, o);
    return v;
}
DI float half_swap_add(float v) { auto rr = __builtin_amdgcn_permlane32_swap(__float_as_uint(v), __float_as_uint(v), false, false); return __uint_as_float(rr[0]) + __uint_as_float(rr[1]); }
DI float half_swap_max(float v) { auto rr = __builtin_amdgcn_permlane32_swap(__float_as_uint(v), __float_as_uint(v), false, false); return fmaxf(__uint_as_float(rr[0]), __uint_as_float(rr[1])); }
typedef short v4i16_t __attribute__((ext_vector_type(4)));
DI s16x4 vtr(lcp p) { return __builtin_bit_cast(s16x4, __builtin_amdgcn_ds_read_tr16_b64_v4i16((LAS v4i16_t*)p)); }
DI bf16x8 cat8(s16x4 lo, s16x4 hi) { return (bf16x8){lo[0], lo[1], lo[2], lo[3], hi[0], hi[1], hi[2], hi[3]}; }
DI bf16x8 trfrag(lcp p) { return cat8(vtr(p), vtr(p + 512)); }
DI bf16x8 ldfrag(lcp p) { return *(const LAS bf16x8*)p; }
DI void glds16(const void* gsrc, LAS void* ldst) { __builtin_amdgcn_global_load_lds((const unsigned*)gsrc, (LAS unsigned*)ldst, 16, 0, 0); }
#define PACK8(x, s) ((bf16x8)__builtin_bit_cast(bf16x8, (v4u){pk2((x)[8 * (s) + 0], (x)[8 * (s) + 1]), pk2((x)[8 * (s) + 2], (x)[8 * (s) + 3]), pk2((x)[8 * (s) + 4], (x)[8 * (s) + 5]), pk2((x)[8 * (s) + 6], (x)[8 * (s) + 7])}))

constexpr size_t MiB = 1u << 20;
constexpr size_t WS_CTL = 0, CTL_ZERO_BYTES = 1 * MiB;
constexpr size_t WS_W13 = 2 * MiB;
constexpr size_t WS_W2 = 354 * MiB;
constexpr size_t WS_WQKV = 530 * MiB;
constexpr size_t WS_WO = 550 * MiB;
constexpr size_t WS_WIN = 566 * MiB;
constexpr size_t WS_WMO = 614 * MiB;
constexpr size_t WS_VEC = 630 * MiB;
constexpr size_t V_C1U = 0, V_C2U = 360448, V_C1Q = 720896, V_C2Q = 741376, V_C1I = 761856, V_C2I = 811008, V_CG = 860160, V_WG = 860416, V_ONES = 991488, V_ZEROS = 999680;
constexpr size_t WS_R = 632 * MiB;
constexpr size_t WS_SP = 696 * MiB;
constexpr size_t SP_BYTES = (size_t)M * 16 * 4;
constexpr size_t WS_H = 698 * MiB;
constexpr size_t WS_QKV = 874 * MiB;
constexpr size_t WS_AO = 954 * MiB;
constexpr size_t WS_MP = 1018 * MiB;
constexpr size_t WS_GATES = 1210 * MiB;
constexpr size_t WS_HG = 1211 * MiB;
constexpr size_t WS_END = 1275 * MiB;
constexpr int CW_TMO = 0, CW_BAR = 4096;

constexpr int RING_OFF = 0, RING_BYTES = 131072;
constexpr int TAB_OFF = 131072;
constexpr int MISC_OFF = 163840 - 256;
constexpr int LDS_BYTES = 163840;
constexpr int AT_K = 0, AT_V = 32768, AT_WS = 65536, AT_STG = 67584;
constexpr int ML_K = 0, ML_V = 65536, ML_VW = 81920, ML_C = 98304, ML_N = 131072, ML_G2 = 131584, ML_M2 = 132096, ML_FI = 132608, ML_EI = 133120, ML_WK = 133632, ML_WKB = 134144, ML_SC = 134400, ML_WS = 134464, ML_STG = 136512;
static_assert(ML_STG + 4 * 4096 <= MISC_OFF && AT_STG + 8 * 4096 <= MISC_OFF && TAB_OFF + 8192 <= MISC_OFF, "LDS map");

#define XB_TMO      128
#define XB_XCNT(j)  (256  + 64 * (j))
#define XB_XSUB(j)  (1280 + 64 * (j))
#define XB_XGEN(j)  (2304 + 64 * (j))
#define XB_TOP      3328
#define XB_TOPGEN   3392
#define XCD_BAR_WORDS 3456
#define XB_SPIN_CAP (1u << 18)

__device__ __forceinline__ unsigned xb_ld(unsigned* p)              { return __hip_atomic_load(p, __ATOMIC_RELAXED, __HIP_MEMORY_SCOPE_AGENT); }
__device__ __forceinline__ unsigned xb_add(unsigned* p, unsigned v) { return __hip_atomic_fetch_add(p, v, __ATOMIC_RELAXED, __HIP_MEMORY_SCOPE_AGENT); }
__device__ __forceinline__ unsigned xb_xcc_id() { return (unsigned)__builtin_amdgcn_s_getreg((3 << 11) | 20) & 0xFu; }
#define XB_SPIN(cond, bar) do { unsigned _sp = 0; while (cond) { __builtin_amdgcn_s_sleep(1); \
    if ((++_sp & 255u) == 0u) { if (xb_ld(&(bar)[XB_TMO])) break; if (_sp > XB_SPIN_CAP) { atomicAdd(&(bar)[XB_TMO], 1u); break; } } } } while (0)

struct XcdBarrier {
    unsigned* bar; unsigned x;
    volatile LAS unsigned* st;
};

__device__ __forceinline__ XcdBarrier xcd_barrier_post(unsigned* bar, volatile LAS unsigned* st) {
    XcdBarrier b; b.bar = bar; b.x = xb_xcc_id(); b.st = st;
    if (threadIdx.x == 0) (void)xb_add(&bar[XB_XCNT(b.x)], 1u);
    return b;
}
__device__ __forceinline__ void xcd_barrier_complete(unsigned* bar, unsigned x, unsigned& nloc, unsigned& nx) {
    const unsigned G = gridDim.x * gridDim.y * gridDim.z;
    unsigned sum, cnt, mine, sp = 0u;
    for (;;) {
        sum = 0u; cnt = 0u; mine = 0u;
#pragma unroll
        for (unsigned j = 0; j < 16; ++j) { const unsigned c = xb_ld(&bar[XB_XCNT(j)]); sum += c; cnt += (c > 0u) ? 1u : 0u; mine = (j == x) ? c : mine; }
        if (sum == G) break;
        __builtin_amdgcn_s_sleep(1);
        if ((++sp & 255u) == 0u) { if (xb_ld(&bar[XB_TMO])) break; if (sp > XB_SPIN_CAP) { atomicAdd(&bar[XB_TMO], 1u); break; } }
    }
    nloc = mine > 0u ? mine : 1u; nx = cnt > 0u ? cnt : 1u;
}

__device__ __forceinline__ void xcd_barrier(const XcdBarrier& b) {
    asm volatile("s_waitcnt vmcnt(0)" ::: "memory");
    __syncthreads();
    if (threadIdx.x == 0) {
        unsigned* bar = b.bar;
        __builtin_amdgcn_s_waitcnt(0);
        unsigned nloc = b.st[0], nx = b.st[1];
        if (nloc == 0u) { xcd_barrier_complete(bar, b.x, nloc, nx); b.st[0] = nloc; b.st[1] = nx; }
        const unsigned old = xb_add(&bar[XB_XSUB(b.x)], 1u);
        const unsigned gen = old / nloc;
        if (old + 1u == (gen + 1u) * nloc) {
            __builtin_amdgcn_fence(__ATOMIC_RELEASE, "agent");
            asm volatile("s_waitcnt vmcnt(0)" ::: "memory");
            const unsigned og = xb_add(&bar[XB_TOP], 1u);
            const unsigned tg = og / nx;
            if (og + 1u == (tg + 1u) * nx) xb_add(&bar[XB_TOPGEN], 1u);
            else XB_SPIN(xb_ld(&bar[XB_TOPGEN]) == tg, bar);
            __builtin_amdgcn_fence(__ATOMIC_ACQUIRE, "agent");
            xb_add(&bar[XB_XGEN(b.x)], 1u);
            asm volatile("s_waitcnt vmcnt(0)" ::: "memory");
        } else {
            XB_SPIN(xb_ld(&bar[XB_XGEN(b.x)]) == gen, bar);
            __builtin_amdgcn_fence(__ATOMIC_ACQUIRE, "agent");
            asm volatile("s_waitcnt vmcnt(0)" ::: "memory");
        }
    }
    __syncthreads();
}
DI void attn_phase(unsigned char* ldsg, const bf16* QKV, bf16* AO, const float* sinks, int G, int bid, int wave_in) {
    int wid = wave_in; asm volatile("" : "+s"(wid));
    const int lane = pg8::pg8_lane(), tid = wid * 64 + lane, r32 = lane & 31, hi = lane >> 5;
    LAS unsigned char* lds = (LAS unsigned char*)ldsg; const lcp L = (lcp)lds;
    LAS float* wsf = (LAS float*)(lds + AT_WS) + wid * 64;
    LAS bf16* stg = (LAS bf16*)(lds + AT_STG + wid * 4096);
    const lcp vlane = L + AT_V + ((lane >> 4) & 1) * 32 + (lane & 3) * 8 + (4 * hi + ((lane & 15) >> 2)) * 64;
    const lcp klane = L + AT_K + hi * 1024 + r32 * 16;
    for (int unit = bid; unit < BATCH * 16 * 4; unit += G) {
        const int kvh = unit & 3, nb = (unit >> 2) & 15, b = unit >> 6;
        const long rowq = (long)b * SEQ + nb * 128, rowk = rowq - 128;
        const int slot_lo = (nb == 0) ? 2 : 0;
        for (int sl = slot_lo; sl < 4; ++sl) {
            glds16(QKV + (rowk + 64 * sl + lane) * NQKV + 2048 + 64 * kvh + 8 * wid, lds + AT_K + sl * 8192 + wid * 1024);
            glds16(QKV + (rowk + 64 * sl + 16 * (wid & 3) + (lane >> 2)) * NQKV + 2304 + 64 * kvh + (wid >> 2) * 32 + (lane & 3) * 8, lds + AT_V + sl * 8192 + wid * 1024);
        }
        const int hq = 8 * kvh + wid;
        const bf16* qsrc = QKV + (rowq + r32) * NQKV + 64 * hq + 8 * hi;
        bf16x8 qn[4];
#pragma unroll
        for (int d0 = 0; d0 < 4; ++d0) qn[d0] = *(const bf16x8*)(qsrc + 16 * d0);
        const float slope2 = ex2(-0.25f * (float)(hq + 1)) * LOG2E, sink2 = sinks[hq] * LOG2E;
        const float base_l = -slope2 * (float)(r32 - 4 * hi);
        WG_BAR();
#pragma unroll 1
        for (int j = 0; j < 4; ++j) {
            const int ilo = (nb == 0) ? 4 - j : 0;
            bf16x8 qr[4];
#pragma unroll
            for (int d0 = 0; d0 < 4; ++d0) qr[d0] = qn[d0];
            if (j < 3) {
#pragma unroll
                for (int d0 = 0; d0 < 4; ++d0) qn[d0] = *(const bf16x8*)(qsrc + (size_t)(32 * (j + 1)) * NQKV + 16 * d0);
            }
            float sl2 = slope2, bl = base_l; asm volatile("" : "+v"(sl2), "+v"(bl));
            f32x16 p[5];
#pragma unroll
            for (int i = 0; i < 5; ++i) {
                if (i >= ilo) {
                    const int kt = j + i; const lcp kb = klane + (kt >> 1) * 8192 + (kt & 1) * 512;
                    f32x16 a = {};
#pragma unroll
                    for (int d0 = 0; d0 < 4; ++d0) a = MFMA32(ldfrag(kb + d0 * 2048), qr[d0], a);
#pragma unroll
                    for (int r = 0; r < 16; ++r) {
                        const int cr = (r & 3) + 8 * (r >> 2);
                        float s = fmaf(sl2, (float)(cr - 128 + 32 * i), fmaf(a[r], LOG2E, bl));
                        if (i == 0) { if (!(cr + 4 * hi > r32)) s = -INFINITY; }
                        if (i == 4) { if (!(cr + 4 * hi <= r32)) s = -INFINITY; }
                        a[r] = s;
                    }
                    p[i] = a;
                } else {
#pragma unroll
                    for (int r = 0; r < 16; ++r) p[i][r] = -INFINITY;
                }
            }
            float mx = sink2;
#pragma unroll
            for (int i = 0; i < 5; ++i)
#pragma unroll
                for (int r = 0; r < 16; ++r) mx = fmaxf(mx, p[i][r]);
            mx = half_swap_max(mx);
            float ls = 0.f;
#pragma unroll
            for (int i = 0; i < 5; ++i)
#pragma unroll
                for (int r = 0; r < 16; ++r) { const float e = ex2(p[i][r] - mx); p[i][r] = e; ls += e; }
            ls = half_swap_add(ls) + ex2(sink2 - mx);
            f32x16 o0 = {}, o1 = {};
#pragma unroll
            for (int i = 0; i < 5; ++i) {
                if (i >= ilo) {
                    const int kt = j + i; const lcp vb = vlane + (kt >> 1) * 8192 + (kt & 1) * 2048;
                    const bf16x8 pa = PACK8(p[i], 0), pb = PACK8(p[i], 1);
                    o0 = MFMA32(pa, trfrag(vb), o0);        o0 = MFMA32(pb, trfrag(vb + 1024), o0);
                    o1 = MFMA32(pa, trfrag(vb + 4096), o1); o1 = MFMA32(pb, trfrag(vb + 4096 + 1024), o1);
                }
            }
            if (hi == 0) wsf[r32] = __builtin_amdgcn_rcpf(ls);
#pragma unroll
            for (int r = 0; r < 16; ++r) {
                const int orow = crow(r, hi); const float rl = wsf[orow];
                stg[orow * 64 + r32] = (bf16)(pk2(o0[r] * rl, 0.f) & 0xffffu);
                stg[orow * 64 + 32 + r32] = (bf16)(pk2(o1[r] * rl, 0.f) & 0xffffu);
            }
#pragma unroll
            for (int i4 = 0; i4 < 4; ++i4) {
                const int row = i4 * 8 + (lane >> 3), ch = lane & 7;
                const v4u v = *(const LAS v4u*)(stg + row * 64 + ch * 8);
                *(v4u*)(AO + (rowq + 32 * j + row) * D + 64 * hq + ch * 8) = v;
            }
        }
        WG_BAR();
    }
}

DI void mlstm_phase(unsigned char* ldsg, const bf16* MP, const float* GT, bf16* HG, int G, int bid, int wave_in) {
    int wid = wave_in; asm volatile("" : "+s"(wid));
    const int lane0 = pg8::pg8_lane(), tid = wid * 64 + lane0;
    LAS unsigned char* lds = (LAS unsigned char*)ldsg; const lcp L = (lcp)lds;
    LAS float* G2 = (LAS float*)(lds + ML_G2); LAS float* M2 = (LAS float*)(lds + ML_M2); LAS float* FI = (LAS float*)(lds + ML_FI); LAS float* EI = (LAS float*)(lds + ML_EI);
    LAS float* WK = (LAS float*)(lds + ML_WK); LAS bf16* WKB = (LAS bf16*)(lds + ML_WKB); LAS float* SC = (LAS float*)(lds + ML_SC);
    LAS float* wsf = (LAS float*)(lds + ML_WS) + wid * 64;
    for (int unit = bid; unit < BATCH * 4 * 8; unit += G) {
        const int sl = unit & 7, h = (unit >> 3) & 3, b = unit >> 5;
        const bf16* Qp = MP + 256 * h; const bf16* Kp = MP + 1024 + 256 * h; const bf16* Vp = MP + 2048 + 512 * h + 64 * sl; const bf16* OGp = MP + 4096 + 512 * h + 64 * sl;
        { unsigned z = 0u; asm volatile("" : "+v"(z)); for (int i = tid; i < (32768 + 512) / 16; i += 512) *(LAS v4u*)(lds + ML_C + i * 16) = (v4u){z, z, z, z}; }
        f32x16 T[6];
#pragma unroll
        for (int x = 0; x < 6; ++x) T[x] = (f32x16){};
        float m_prev = 0.f;
        WG_BAR();
        for (int c = 0; c < 16; ++c) {
            const long row0 = (long)b * SEQ + 128 * c;
            const int lane = pg8::pg8_lane(), r32 = lane & 31, hi = lane >> 5;
            const int blk = (lane >> 4) & 1, q4 = (lane & 15) >> 2, p4 = lane & 3;
            const int vlo_ = blk * 32 + p4 * 8 + (4 * hi + q4) * 64;
            const int ktl_ = (2 * blk + (p4 >> 1)) * 2048 + (q4 + 4 * hi) * 16 + (p4 & 1) * 8;
            const int cbl_ = hi * 1024 + r32 * 16, kbl_ = hi * 2048 + r32 * 16;
            const unsigned m0 = (r32 == 0) ? 0xffffffffu : 0u; const v4u m0v = {m0, m0, m0, m0};
#pragma unroll
            for (int i = 0; i < 8; ++i) { const int chunk = 4 * wid + (i >> 1), half = i & 1;
                glds16(Kp + (row0 + 64 * half + lane) * NMI + chunk * 8, lds + ML_K + chunk * 2048 + half * 1024); }
            v4u vreg[2];
#pragma unroll
            for (int i = 0; i < 2; ++i) vreg[i] = *(const v4u*)(Vp + (row0 + 64 * i + 16 * (wid & 3) + (lane >> 2)) * NMI + (wid >> 2) * 32 + (lane & 3) * 8);
            bf16x8 qf[16];
            if (wid < 4) {
#pragma unroll
                for (int ks = 0; ks < 16; ++ks) qf[ks] = *(const bf16x8*)(Qp + (row0 + 32 * wid + r32) * NMI + 16 * ks + 8 * hi);
            }
            if (wid == 0) {
                const float* gp = GT + (size_t)(row0 + 2 * lane) * 8;
                const float i0 = gp[h], f0 = gp[4 + h], i1 = gp[8 + h], f1 = gp[12 + h];
                const float lf0 = -logf(1.f + expf(-f0)), lf1 = -logf(1.f + expf(-f1));
                float incl = lf0 + lf1;
#pragma unroll
                for (int o = 1; o < 64; o <<= 1) { const float t = __shfl_up(incl, o); if (lane >= o) incl += t; }
                const float b1 = incl, b0 = incl - lf1;
                const float g0 = i0 - b0, g1 = i1 - b1;
                float cm = fmaxf(g0, g1);
#pragma unroll
                for (int o = 1; o < 64; o <<= 1) { const float t = __shfl_up(cm, o); if (lane >= o) cm = fmaxf(cm, t); }
                float cprev = __shfl_up(cm, 1); if (lane == 0) cprev = -INFINITY;
                const float M0 = fmaxf(m_prev, fmaxf(cprev, g0)), M1 = fmaxf(m_prev, cm);
                const float Mend = __shfl(M1, 63), blast = __shfl(b1, 63);
                *(LAS f32x2*)(G2 + 2 * lane) = (f32x2){g0 * LOG2E, g1 * LOG2E};
                *(LAS f32x2*)(M2 + 2 * lane) = (f32x2){M0 * LOG2E, M1 * LOG2E};
                *(LAS f32x2*)(FI + 2 * lane) = (f32x2){ex2((m_prev - M0) * LOG2E), ex2((m_prev - M1) * LOG2E)};
                *(LAS f32x2*)(EI + 2 * lane) = (f32x2){ex2(-(b0 + M0) * LOG2E), ex2(-(b1 + M1) * LOG2E)};
                const float w0 = ex2((g0 - Mend) * LOG2E), w1 = ex2((g1 - Mend) * LOG2E);
                *(LAS f32x2*)(WK + 2 * lane) = (f32x2){w0, w1};
                *(LAS unsigned*)(WKB + 2 * lane) = pk2(w0, w1);
                if (lane == 0) SC[0] = ex2((m_prev - Mend) * LOG2E);
                m_prev = blast + Mend;
            }
            VM_WAIT();
#pragma unroll
            for (int i = 0; i < 2; ++i) *(LAS v4u*)(lds + ML_V + i * 8192 + wid * 1024 + lane * 16) = vreg[i];
            WG_BAR();
#pragma unroll
            for (int i = 0; i < 2; ++i) { const float w = WK[64 * i + 16 * (wid & 3) + (lane >> 2)]; const v4u v = vreg[i]; v4u o;
                o.x = pk2(bflo(v.x) * w, bfhi(v.x) * w); o.y = pk2(bflo(v.y) * w, bfhi(v.y) * w); o.z = pk2(bflo(v.z) * w, bfhi(v.z) * w); o.w = pk2(bflo(v.w) * w, bfhi(v.w) * w);
                *(LAS v4u*)(lds + ML_VW + i * 8192 + wid * 1024 + lane * 16) = o; }
            WG_BAR();
            if (wid < 4) {
                const int tt = wid;
                T[0] = (f32x16){}; T[1] = (f32x16){}; T[2] = (f32x16){};
                { const lcp cb = L + ML_C + cbl_; const lcp nbp = L + ML_N + 16 * hi;
#pragma unroll
                  for (int ks = 0; ks < 16; ++ks) {
                      const bf16x8 c0 = ldfrag(cb + ks * 2048), c1 = ldfrag(cb + ks * 2048 + 512);
                      const bf16x8 nf = __builtin_bit_cast(bf16x8, __builtin_bit_cast(v4u, ldfrag(nbp + ks * 32)) & m0v);
                      T[0] = MFMA32(qf[ks], c0, T[0]); T[1] = MFMA32(qf[ks], c1, T[1]); T[2] = MFMA32(qf[ks], nf, T[2]);
                      if ((ks & 3) == 3) __builtin_amdgcn_sched_barrier(0);
                  } }
                { float fi[16];
#pragma unroll
                  for (int r = 0; r < 16; ++r) fi[r] = FI[32 * tt + crow(r, hi)];
#pragma unroll
                  for (int r = 0; r < 16; ++r) { T[0][r] *= fi[r]; T[1][r] *= fi[r]; }
                  if (r32 == 0) {
#pragma unroll
                      for (int r = 0; r < 16; ++r) wsf[crow(r, hi)] = T[2][r] * fi[r];
                  } }
                const float Mt = M2[32 * tt + r32];
                float dsum = 0.f;
                for (int st = 0; st <= tt; ++st) {
                    f32x16 S = {};
                    const lcp kb = L + ML_K + kbl_ + st * 512;
#pragma unroll
                    for (int ks = 0; ks < 16; ++ks) S = MFMA32(ldfrag(kb + ks * 4096), qf[ks], S);
#pragma unroll
                    for (int r = 0; r < 16; ++r) {
                        const float w = ex2(G2[32 * st + crow(r, hi)] - Mt);
                        float v = S[r] * w;
                        if (st == tt && crow(r, hi) > r32) v = 0.f;
                        S[r] = v; dsum += v;
                    }
                    const bf16x8 pa = PACK8(S, 0), pb = PACK8(S, 1);
                    const lcp vb = L + ML_V + (st >> 1) * 8192 + (st & 1) * 2048 + vlo_;
                    T[0] = MFMA32(pa, trfrag(vb), T[0]);        T[0] = MFMA32(pb, trfrag(vb + 1024), T[0]);
                    T[1] = MFMA32(pa, trfrag(vb + 4096), T[1]); T[1] = MFMA32(pb, trfrag(vb + 4096 + 1024), T[1]);
                }
                dsum = half_swap_add(dsum);
                { const float den = wsf[r32] + dsum; const float dn = fmaxf(fabsf(den), EI[32 * tt + r32]);
                  if (hi == 0) wsf[32 + r32] = __builtin_amdgcn_rcpf(dn); }
                LAS bf16* stg = (LAS bf16*)(lds + ML_STG + tt * 4096);
#pragma unroll
                for (int r = 0; r < 16; ++r) {
                    const int orow = crow(r, hi); const float rd = wsf[32 + orow];
                    stg[orow * 64 + r32] = (bf16)(pk2(T[0][r] * rd, 0.f) & 0xffffu);
                    stg[orow * 64 + 32 + r32] = (bf16)(pk2(T[1][r] * rd, 0.f) & 0xffffu);
                }
#pragma unroll
                for (int i4 = 0; i4 < 4; ++i4) {
                    const int row = i4 * 8 + (lane >> 3), ch = lane & 7;
                    const v4u hv = *(const LAS v4u*)(stg + row * 64 + ch * 8);
                    const v4u og = *(const v4u*)(OGp + (row0 + 32 * tt + row) * NMI + ch * 8);
                    v4u o;
                    o.x = pk2(bflo(hv.x) * bflo(og.x), bfhi(hv.x) * bfhi(og.x)); o.y = pk2(bflo(hv.y) * bflo(og.y), bfhi(hv.y) * bfhi(og.y));
                    o.z = pk2(bflo(hv.z) * bflo(og.z), bfhi(hv.z) * bfhi(og.z)); o.w = pk2(bflo(hv.w) * bflo(og.w), bfhi(hv.w) * bfhi(og.w));
                    *(v4u*)(HG + (row0 + 32 * tt + row) * D + 512 * h + 64 * sl + ch * 8) = o;
                }
#pragma unroll
                for (int x = 3; x < 6; ++x) T[x] = (f32x16){};
            } else {
                const float decay = SC[0];
#pragma unroll
                for (int x = 0; x < 6; ++x)
#pragma unroll
                    for (int r = 0; r < 16; ++r) T[x][r] *= decay;
#pragma unroll
                for (int dti = 0; dti < 2; ++dti) {
                    const int dt = 2 * (wid - 4) + dti;
                    const lcp ka0 = L + ML_K + dt * 8192 + ktl_;
#pragma unroll
                    for (int s8 = 0; s8 < 8; ++s8) {
                        const lcp ka = ka0 + s8 * 256;
                        const bf16x8 af = cat8(vtr(ka), vtr(ka + 128));
                        const lcp vwb = L + ML_VW + (s8 >> 2) * 8192 + (s8 & 3) * 1024 + vlo_;
                        const bf16x8 b0 = trfrag(vwb), b1 = trfrag(vwb + 4096);
                        const LAS s16x4* wp = (const LAS s16x4*)(WKB + 16 * s8 + 4 * hi);
                        const bf16x8 nb = __builtin_bit_cast(bf16x8, __builtin_bit_cast(v4u, cat8(wp[0], wp[2])) & m0v);
                        T[2 * dti] = MFMA32(af, b0, T[2 * dti]); T[2 * dti + 1] = MFMA32(af, b1, T[2 * dti + 1]); T[4 + dti] = MFMA32(af, nb, T[4 + dti]);
                        if (s8 & 1) __builtin_amdgcn_sched_barrier(0);
                    }
                }
            }
            WG_BAR();
            if (wid >= 4) {
#pragma unroll
                for (int dti = 0; dti < 2; ++dti) {
                    const int dt = 2 * (wid - 4) + dti;
#pragma unroll
                    for (int et = 0; et < 2; ++et)
#pragma unroll
                        for (int g = 0; g < 4; ++g)
                            *(LAS v2u*)(lds + ML_C + (4 * dt + g) * 1024 + (32 * et + r32) * 16 + hi * 8) = (v2u){pk2(T[2 * dti + et][4 * g], T[2 * dti + et][4 * g + 1]), pk2(T[2 * dti + et][4 * g + 2], T[2 * dti + et][4 * g + 3])};
                    if (r32 == 0) {
#pragma unroll
                        for (int g = 0; g < 4; ++g)
                            *(LAS v2u*)(lds + ML_N + (32 * dt + 8 * g + 4 * hi) * 2) = (v2u){pk2(T[4 + dti][4 * g], T[4 + dti][4 * g + 1]), pk2(T[4 + dti][4 * g + 2], T[4 + dti][4 * g + 3])};
                    }
                }
            }
        }
        WG_BAR();
    }
}


constexpr int NWAVES = 8;
struct Args { const float* x; const float* w1; const float* w3; const float* w2; const float* ln_g; const float* ln_b; const float* wqkv; const float* sinks; const float* wo;
              const float* win; const float* bg; const float* wmo; float* out; unsigned char* ws; };
typedef const __attribute__((address_space(4))) Args* kargs_t;

DI void tr_strip(const float* W, int ldw, int n0, bf16* WT, size_t wt_row0, int Kdim, int kb0, int nkb, const float* g, const float* bb, float cs, float* c1o, float* c2o, LAS float* scr, int lane) {
    const int c = lane & 7;
    float a1[4] = {0.f, 0.f, 0.f, 0.f}, a2[4] = {0.f, 0.f, 0.f, 0.f};
    for (int kb = kb0; kb < kb0 + nkb; ++kb) {
        const int k0 = kb * 64;
#pragma unroll 8
        for (int i = 0; i < 32; ++i) { const int kk = 2 * i + (lane >> 5); scr[kk * 33 + (lane & 31)] = W[(size_t)(k0 + kk) * ldw + n0 + (lane & 31)]; }
        float gk[8], bk[8];
        if (g) { const f32x4 g0 = *(const f32x4*)(g + k0 + 8 * c), g1 = *(const f32x4*)(g + k0 + 8 * c + 4), b0 = *(const f32x4*)(bb + k0 + 8 * c), b1 = *(const f32x4*)(bb + k0 + 8 * c + 4);
#pragma unroll
            for (int i = 0; i < 4; ++i) { gk[i] = g0[i] * cs; gk[4 + i] = g1[i] * cs; bk[i] = b0[i] * cs; bk[4 + i] = b1[i] * cs; } }
        else {
#pragma unroll
            for (int i = 0; i < 8; ++i) { gk[i] = cs; bk[i] = 0.f; } }
        LDS_WAIT(); asm volatile("" ::: "memory");
#pragma unroll
        for (int j = 0; j < 4; ++j) { const int n = (lane >> 3) + 8 * j; const LAS float* s = scr + (8 * c) * 33 + n;
            float v[8];
#pragma unroll
            for (int i = 0; i < 8; ++i) v[i] = s[i * 33];
            v4u o; o.x = pk2(v[0] * gk[0], v[1] * gk[1]); o.y = pk2(v[2] * gk[2], v[3] * gk[3]); o.z = pk2(v[4] * gk[4], v[5] * gk[5]); o.w = pk2(v[6] * gk[6], v[7] * gk[7]);
            a1[j] += ((bflo(o.x) + bfhi(o.x)) + (bflo(o.y) + bfhi(o.y))) + ((bflo(o.z) + bfhi(o.z)) + (bflo(o.w) + bfhi(o.w)));
            a2[j] += ((v[0] * bk[0] + v[1] * bk[1]) + (v[2] * bk[2] + v[3] * bk[3])) + ((v[4] * bk[4] + v[5] * bk[5]) + (v[6] * bk[6] + v[7] * bk[7]));
            *(GAS v4u*)(WT + (wt_row0 + n) * Kdim + k0 + 8 * c) = o; }
        LDS_WAIT(); asm volatile("" ::: "memory");
    }
    if (g) {
#pragma unroll
        for (int j = 0; j < 4; ++j) { float s1 = a1[j], s2 = a2[j];
            s1 += __shfl_xor(s1, 1); s2 += __shfl_xor(s2, 1); s1 += __shfl_xor(s1, 2); s2 += __shfl_xor(s2, 2); s1 += __shfl_xor(s1, 4); s2 += __shfl_xor(s2, 4);
            if (c == 0) { c1o[(lane >> 3) + 8 * j] = s1; c2o[(lane >> 3) + 8 * j] = s2; } }
    }
}

DI void prologue(kargs_t a, LAS unsigned char* lds, int gw, int NGW, int wave, int lane) {
    unsigned char* ws = a->ws;
    float* vec = (float*)(ws + WS_VEC);
    const float* ones = (const float*)(ws + WS_VEC + V_ONES); const float* zeros = (const float*)(ws + WS_VEC + V_ZEROS);
    LAS float* scr = (LAS float*)(lds + wave * 16384);
    constexpr int T_UP = 8 * 2 * 176, T_QKV = 2 * 80, T_MI = 2 * 192, T_W2 = 8 * 64 * 4, T_WO = 2 * 64, T_WMO = 2 * 64, T_G = 16;
    constexpr int NT = T_UP + T_QKV + T_MI + T_W2 + T_WO + T_WMO + T_G;
    for (int it = gw; it < NT; it += NGW) {
        int r = it;
        if (r < T_UP) {
            const int f = r / 352, rr = r % 352, which = rr / 176, strip = rr % 176, n0 = 32 * strip;
            const int t = 3 * (f >> 1) + 2 * (f & 1);
            const float* gp = t ? a->ln_g + (size_t)(t - 1) * D : nullptr; const float* bp = t ? a->ln_b + (size_t)(t - 1) * D : nullptr;
            const size_t wrow = (size_t)256 * (n0 / 128) + 128 * which + (n0 % 128);
            const float* W = (which ? a->w3 : a->w1) + (size_t)f * D * FF;
            if (gp) tr_strip(W, FF, n0, (bf16*)(ws + WS_W13) + (size_t)f * NUP * D, wrow, D, 0, 32, gp, bp, 1.f, vec + V_C1U / 4 + (size_t)f * NUP + wrow, vec + V_C2U / 4 + (size_t)f * NUP + wrow, scr, lane);
            else { tr_strip(W, FF, n0, (bf16*)(ws + WS_W13) + (size_t)f * NUP * D, wrow, D, 0, 32, nullptr, nullptr, 1.f, nullptr, nullptr, scr, lane);
                   if (lane < 32) { vec[V_C1U / 4 + (size_t)f * NUP + wrow + lane] = 0.f; vec[V_C2U / 4 + (size_t)f * NUP + wrow + lane] = 0.f; } }
            continue; }
        r -= T_UP;
        if (r < T_QKV) { const int j = r / 80, n0 = 32 * (r % 80); const int t = 6 * j + 1;
            tr_strip(a->wqkv + (size_t)j * D * NQKV, NQKV, n0, (bf16*)(ws + WS_WQKV) + (size_t)j * NQKV * D, n0, D, 0, 32, a->ln_g + (size_t)(t - 1) * D, a->ln_b + (size_t)(t - 1) * D, n0 < 2048 ? 0.125f : 1.f,
                     vec + V_C1Q / 4 + j * NQKV + n0, vec + V_C2Q / 4 + j * NQKV + n0, scr, lane);
            continue; }
        r -= T_QKV;
        if (r < T_MI) { const int j = r / 192, n0 = 32 * (r % 192); const int t = 6 * j + 4;
            tr_strip(a->win + (size_t)j * D * NMIW, NMIW, n0, (bf16*)(ws + WS_WIN) + (size_t)j * NMI * D, n0, D, 0, 32, a->ln_g + (size_t)(t - 1) * D, a->ln_b + (size_t)(t - 1) * D, (n0 >= 1024 && n0 < 2048) ? 0.0625f : 1.f,
                     vec + V_C1I / 4 + j * NMI + n0, vec + V_C2I / 4 + j * NMI + n0, scr, lane);
            continue; }
        r -= T_MI;
        if (r < T_W2) { const int f = r / 256, rr = r % 256, strip = rr / 4, kq = rr % 4;
            tr_strip(a->w2 + (size_t)f * FF * D, D, 32 * strip, (bf16*)(ws + WS_W2) + (size_t)f * D * FF, 32 * strip, FF, 22 * kq, 22, nullptr, nullptr, 1.f, nullptr, nullptr, scr, lane);
            continue; }
        r -= T_W2;
        if (r < T_WO) { const int j = r / 64, strip = r % 64;
            tr_strip(a->wo + (size_t)j * D * D, D, 32 * strip, (bf16*)(ws + WS_WO) + (size_t)j * D * D, 32 * strip, D, 0, 32, nullptr, nullptr, 1.f, nullptr, nullptr, scr, lane);
            continue; }
        r -= T_WO;
        if (r < T_WMO) { const int j = r / 64, strip = r % 64;
            tr_strip(a->wmo + (size_t)j * D * D, D, 32 * strip, (bf16*)(ws + WS_WMO) + (size_t)j * D * D, 32 * strip, D, 0, 32, nullptr, nullptr, 1.f, nullptr, nullptr, scr, lane);
            continue; }
        r -= T_WMO;
        {
            const int j = r / 8, jj = r % 8; const int t = 6 * j + 4;
            const float* gp = a->ln_g + (size_t)(t - 1) * D; const float* bp = a->ln_b + (size_t)(t - 1) * D;
            const float* W = a->win + (size_t)j * D * NMIW + NMI + jj;
            float* wg = vec + V_WG / 4 + (size_t)(j * 8 + jj) * D;
            float s1 = 0.f, s2 = 0.f;
            for (int k = lane; k < D; k += 64) { const float w = W[(size_t)k * NMIW]; const float v = w * gp[k]; wg[k] = v; s1 += v; s2 += w * bp[k]; }
            s1 = wave_sum(s1); s2 = wave_sum(s2);
            if (lane == 0) { vec[V_CG / 4 + j * 16 + jj] = s1; vec[V_CG / 4 + j * 16 + 8 + jj] = s2 + a->bg[j * 8 + jj]; }
        }
    }
    bf16* R = (bf16*)(ws + WS_R); float* sp0 = (float*)(ws + WS_SP);
    for (int m = gw; m < M; m += NGW) {
        const GAS f32x4* xr = (const GAS f32x4*)(a->x + (size_t)m * D);
#pragma unroll
        for (int i = 0; i < 4; ++i) { const f32x4 v0 = xr[(i * 64 + lane) * 2], v1 = xr[(i * 64 + lane) * 2 + 1];
            *(GAS v4u*)(R + (size_t)m * D + (i * 64 + lane) * 8) = (v4u){pk2(v0[0], v0[1]), pk2(v0[2], v0[3]), pk2(v1[0], v1[1]), pk2(v1[2], v1[3])}; }
        if (lane < 8) *(f32x2*)(sp0 + (size_t)m * 16 + lane * 2) = (f32x2){0.f, 256.f * (1.f - LN_EPS)};
    }
    for (int i = gw * 64 + lane; i < D; i += NGW * 64) { vec[V_ONES / 4 + i] = 1.f; vec[V_ZEROS / 4 + i] = 0.f; }
    (void)ones; (void)zeros;
}

DI void gates_phase(LAS unsigned char* lds, const bf16* R, const float* sp, const float* wg, const float* cg, float* GT, int G, int bid, int wave_in) {
    int wave = wave_in; asm volatile("" : "+s"(wave));
    const int lane = pg8::pg8_lane(), tid = wave * 64 + lane;
    for (int i = tid; i < 8 * D / 4; i += 512) *(LAS f32x4*)(lds + i * 16) = *(const f32x4*)(wg + i * 4);
    WG_BAR();
    const LAS float* W = (const LAS float*)lds;
    for (int m = bid * NWAVES + wave; m < M; m += G * NWAVES) {
        float acc[8] = {0.f, 0.f, 0.f, 0.f, 0.f, 0.f, 0.f, 0.f};
#pragma unroll 1
        for (int i = 0; i < 4; ++i) {
            const int k = 8 * lane + 512 * i;
            const v4u rv = *(const v4u*)(R + (size_t)m * D + k);
            const float x[8] = {bflo(rv.x), bfhi(rv.x), bflo(rv.y), bfhi(rv.y), bflo(rv.z), bfhi(rv.z), bflo(rv.w), bfhi(rv.w)};
#pragma unroll
            for (int jj = 0; jj < 8; ++jj) { const f32x4 w0 = *(const LAS f32x4*)(W + jj * D + k), w1 = *(const LAS f32x4*)(W + jj * D + k + 4);
                acc[jj] += ((x[0] * w0[0] + x[1] * w0[1]) + (x[2] * w0[2] + x[3] * w0[3])) + ((x[4] * w1[0] + x[5] * w1[1]) + (x[6] * w1[2] + x[7] * w1[3])); }
        }
#pragma unroll
        for (int jj = 0; jj < 8; ++jj) acc[jj] = wave_sum(acc[jj]);
        float s = 0.f, q = 0.f;
        { const f32x4 v = *(const f32x4*)(sp + (size_t)m * 16 + (lane & 3) * 4); s = v[0] + v[2]; q = v[1] + v[3];
          s += __shfl_xor(s, 1); q += __shfl_xor(q, 1); s += __shfl_xor(s, 2); q += __shfl_xor(q, 2); }
        const float mean = s * (1.f / D), var = q * (1.f / D) - mean * mean, rstd = __builtin_amdgcn_rsqf(var + LN_EPS);
        float sel = acc[0];
#pragma unroll
        for (int jj = 1; jj < 8; ++jj) sel = (lane == jj) ? acc[jj] : sel;
        if (lane < 8) GT[(size_t)m * 8 + lane] = rstd * (sel - mean * cg[lane]) + cg[8 + lane];
    }
}

DI void final_ln(const bf16* R, const float* sp, const float* g, const float* b, float* out, int gw, int NGW, int lane) {
    for (int m = gw; m < M; m += NGW) {
        float s, q;
        { const f32x4 v = *(const f32x4*)(sp + (size_t)m * 16 + (lane & 3) * 4); s = v[0] + v[2]; q = v[1] + v[3];
          s += __shfl_xor(s, 1); q += __shfl_xor(q, 1); s += __shfl_xor(s, 2); q += __shfl_xor(q, 2); }
        const float mean = s * (1.f / D), var = q * (1.f / D) - mean * mean, rstd = __builtin_amdgcn_rsqf(var + LN_EPS);
#pragma unroll
        for (int i = 0; i < 4; ++i) {
            const int k = 8 * lane + 512 * i;
            const v4u rv = *(const v4u*)(R + (size_t)m * D + k);
            const f32x4 g0 = *(const f32x4*)(g + k), g1 = *(const f32x4*)(g + k + 4), b0 = *(const f32x4*)(b + k), b1 = *(const f32x4*)(b + k + 4);
            f32x4 o0, o1;
            o0[0] = (bflo(rv.x) - mean) * rstd * g0[0] + b0[0]; o0[1] = (bfhi(rv.x) - mean) * rstd * g0[1] + b0[1]; o0[2] = (bflo(rv.y) - mean) * rstd * g0[2] + b0[2]; o0[3] = (bfhi(rv.y) - mean) * rstd * g0[3] + b0[3];
            o1[0] = (bflo(rv.z) - mean) * rstd * g1[0] + b1[0]; o1[1] = (bfhi(rv.z) - mean) * rstd * g1[1] + b1[1]; o1[2] = (bflo(rv.w) - mean) * rstd * g1[2] + b1[2]; o1[3] = (bfhi(rv.w) - mean) * rstd * g1[3] + b1[3];
            *(GAS f32x4*)(out + (size_t)m * D + k) = o0; *(GAS f32x4*)(out + (size_t)m * D + k + 4) = o1;
        }
    }
}

#ifndef SKIP_ATT
#define SKIP_ATT 0
#endif
#ifndef SKIP_MLSTM
#define SKIP_MLSTM 0
#endif

DI kargs_t kargs() { kargs_t p = (kargs_t)__builtin_amdgcn_kernarg_segment_ptr(); asm volatile("" : "+s"(p)); return p; }
#define GRID_BAR() do { XcdBarrier b_; b_.bar = (unsigned*)(kargs()->ws + WS_CTL) + CW_BAR; b_.x = xb_xcc_id(); b_.st = (volatile LAS unsigned*)(lds + MISC_OFF) + 8; xcd_barrier(b_); } while (0)

__global__ void __launch_bounds__(NWAVES * 64, 2) fwd_kernel(Args args_by_value) {
    extern __shared__ __attribute__((aligned(16))) unsigned char lds_raw[];
    LAS unsigned char* lds = (LAS unsigned char*)lds_raw;
    const int w0 = __builtin_amdgcn_readfirstlane((int)threadIdx.x >> 6);
    const int G = gridDim.x, bid = blockIdx.x;
    { const int tid0 = threadIdx.x; if (tid0 < 64) ((volatile LAS unsigned*)(lds + MISC_OFF))[tid0] = 0u; }
    __syncthreads();
    (void)xcd_barrier_post((unsigned*)(kargs()->ws + WS_CTL) + CW_BAR, (volatile LAS unsigned*)(lds + MISC_OFF) + 8);
    {
        const int vcu = (G % 8 == 0) ? (bid % 8) * (G / 8) + bid / 8 : bid;
        prologue(kargs(), lds, vcu * NWAVES + w0, G * NWAVES, w0, pg8::pg8_lane());
    }
    GRID_BAR();

    for (int t = 0; t < 3 * DEPTH; ++t) {
        const int layer = t / 3, sub = t % 3;
        const int kind = (sub != 1) ? 0 : ((layer & 1) ? 2 : 1);
        const int j = layer >> 1;
        {
            unsigned char* ws = kargs()->ws;
            float* vec = (float*)(ws + WS_VEC);
            const bf16* R = (const bf16*)(ws + WS_R);
            const float* sp_in = (const float*)(ws + WS_SP) + (size_t)(t & 1) * (SP_BYTES / 4);
            if (kind == 0) {
                const int f = 2 * layer + (sub >> 1);
                pg8::Gemm g{R, (const bf16*)(ws + WS_W13) + (size_t)f * NUP * D, M, NUP, D}; pg8::StaticOrder S; S.init(M, NUP, G, bid);
                pg8::EpiUp E{(bf16*)(ws + WS_H), vec + V_C1U / 4 + (size_t)f * NUP, vec + V_C2U / 4 + (size_t)f * NUP, sp_in};
                pg8::gemm_phase<pg8::EpiUp, pg8::StaticOrder, true, PG8_SP2>(lds + RING_OFF, g, S, E, w0);
            } else {
                const bool att = kind == 1;
                pg8::Gemm g{R, att ? (const bf16*)(ws + WS_WQKV) + (size_t)j * NQKV * D : (const bf16*)(ws + WS_WIN) + (size_t)j * NMI * D, M, att ? NQKV : NMI, D};
                pg8::StaticOrder S; S.init(M, att ? NQKV : NMI, G, bid);
                pg8::EpiLnOut E{att ? (bf16*)(ws + WS_QKV) : (bf16*)(ws + WS_MP), att ? NQKV : NMI, att ? vec + V_C1Q / 4 + j * NQKV : vec + V_C1I / 4 + j * NMI, att ? vec + V_C2Q / 4 + j * NQKV : vec + V_C2I / 4 + j * NMI, sp_in, att ? 1000 : 16};
                pg8::gemm_phase<pg8::EpiLnOut, pg8::StaticOrder, true, PG8_SP2>(lds + RING_OFF, g, S, E, w0);
                if (!att) gates_phase(lds, R, sp_in, vec + V_WG / 4 + (size_t)j * 8 * D, vec + V_CG / 4 + j * 16, (float*)(ws + WS_GATES), G, bid, w0);
            }
        }
        GRID_BAR();
        if (kind == 1) {
            if (!SKIP_ATT) { kargs_t ka = kargs(); unsigned char* ws = ka->ws; attn_phase(lds_raw, (const bf16*)(ws + WS_QKV), (bf16*)(ws + WS_AO), ka->sinks + j * 32, G, bid, w0); }
            GRID_BAR();
        } else if (kind == 2) {
            if (!SKIP_MLSTM) { unsigned char* ws = kargs()->ws; mlstm_phase(lds_raw, (const bf16*)(ws + WS_MP), (const float*)(ws + WS_GATES), (bf16*)(ws + WS_HG), G, bid, w0); }
            GRID_BAR();
        }
        {
            kargs_t ka = kargs(); unsigned char* ws = ka->ws;
            const float* g_prev = t ? ka->ln_g + (size_t)(t - 1) * D : (const float*)(ws + WS_VEC) + V_ONES / 4;
            const float* b_prev = t ? ka->ln_b + (size_t)(t - 1) * D : (const float*)(ws + WS_VEC) + V_ZEROS / 4;
            const float* sp_in = (const float*)(ws + WS_SP) + (size_t)(t & 1) * (SP_BYTES / 4); float* sp_out = (float*)(ws + WS_SP) + (size_t)((t + 1) & 1) * (SP_BYTES / 4);
            const bf16* A = (const bf16*)(ws + (kind == 0 ? WS_H : (kind == 1 ? WS_AO : WS_HG)));
            const int f = 2 * layer + (sub >> 1);
            const bf16* Bt = kind == 0 ? (const bf16*)(ws + WS_W2) + (size_t)f * D * FF : (kind == 1 ? (const bf16*)(ws + WS_WO) + (size_t)j * D * D : (const bf16*)(ws + WS_WMO) + (size_t)j * D * D);
            float coef = kind == 0 ? 0.5f : 1.f;
            if ((kind == 1 && SKIP_ATT) || (kind == 2 && SKIP_MLSTM)) coef = 0.f;
            pg8::Gemm g{A, Bt, M, D, kind == 0 ? FF : D}; pg8::StaticOrder S; S.init(M, D, G, bid);
            pg8::EpiRes E{(bf16*)(ws + WS_R), g_prev, b_prev, sp_in, sp_out, coef, (LAS float*)(lds + TAB_OFF), w0};
            pg8::gemm_phase<pg8::EpiRes, pg8::StaticOrder, true, PG8_SP2>(lds + RING_OFF, g, S, E, w0);
        }
        GRID_BAR();
    }
    {
        kargs_t ka = kargs(); unsigned char* ws = ka->ws;
        const int vcu = (G % 8 == 0) ? (bid % 8) * (G / 8) + bid / 8 : bid;
        final_ln((const bf16*)(ws + WS_R), (const float*)(ws + WS_SP), ka->ln_g + (size_t)(3 * DEPTH - 1) * D, ka->ln_b + (size_t)(3 * DEPTH - 1) * D, ka->out, vcu * NWAVES + w0, G * NWAVES, pg8::pg8_lane());
    }
}

extern "C" void kernel_launch(void* const* d_in, const int* in_sizes, int n_in, void* d_out, int out_size, void* d_ws, size_t ws_size, hipStream_t stream) {
    static int grid = 0;
    if (grid == 0) {
        if (n_in != 12 || in_sizes[0] != M * D || out_size != M * D || ws_size < WS_END) { fprintf(stderr, "kernel_launch: unexpected shapes / workspace (n_in %d, ws %zu < %zu); nothing launched\n", n_in, ws_size, (size_t)WS_END); grid = -1; return; }
        int dev = 0, cus = 0;
        if (hipGetDevice(&dev) != hipSuccess || hipDeviceGetAttribute(&cus, hipDeviceAttributeMultiprocessorCount, dev) != hipSuccess) { grid = -1; return; }
        if (hipFuncSetAttribute((const void*)fwd_kernel, hipFuncAttributeMaxDynamicSharedMemorySize, LDS_BYTES) != hipSuccess) { fprintf(stderr, "kernel_launch: hipFuncSetAttribute failed\n"); grid = -1; return; }
        int per_cu = 0;
        if (hipOccupancyMaxActiveBlocksPerMultiprocessor(&per_cu, (const void*)fwd_kernel, NWAVES * 64, LDS_BYTES) != hipSuccess || per_cu < 1) { fprintf(stderr, "kernel_launch: occupancy query says %d\n", per_cu); }
        (void)hipGetLastError();
        grid = cus;
    }
    if (grid < 0) return;
    (void)hipMemsetAsync((char*)d_ws + WS_CTL, 0, CTL_ZERO_BYTES, stream);
    Args a{};
    a.x = (const float*)d_in[0]; a.w1 = (const float*)d_in[1]; a.w3 = (const float*)d_in[2]; a.w2 = (const float*)d_in[3]; a.ln_g = (const float*)d_in[4]; a.ln_b = (const float*)d_in[5];
    a.wqkv = (const float*)d_in[6]; a.sinks = (const float*)d_in[7]; a.wo = (const float*)d_in[8]; a.win = (const float*)d_in[9]; a.bg = (const float*)d_in[10]; a.wmo = (const float*)d_in[11];
    a.out = (float*)d_out; a.ws = (unsigned char*)d_ws;
    hipLaunchKernelGGL(fwd_kernel, dim3(grid), dim3(NWAVES * 64), LDS_BYTES, stream, a);
}
```

```cpp
#include <hip/hip_runtime.h>
#include <hip/hip_bf16.h>
#include <cstdio>
#include <cstdint>
#include <cmath>

constexpr int BATCH = 8, SEQ = 2048, D = 2048, FF = 5632, DEPTH = 4;
constexpr int M = BATCH * SEQ;
constexpr int NUP = 2 * FF;
constexpr int NQKV = 2560;
constexpr int NMI = 6144, NMIW = 6152;
constexpr float LN_EPS = 1e-5f;
constexpr float ALPHA = 1.681792830507429f;
constexpr float LOG2E = 1.4426950408889634f;

constexpr size_t MiB = 1u << 20;
constexpr size_t WS_CTL = 0, CTL_ZERO_BYTES = 1 * MiB;
constexpr size_t WS_W13 = 2 * MiB;
constexpr size_t WS_W2 = 178 * MiB;
constexpr size_t WS_WQKV = 266 * MiB;
constexpr size_t WS_WO = 286 * MiB;
constexpr size_t WS_WIN = 302 * MiB;
constexpr size_t WS_WMO = 350 * MiB;
constexpr size_t WS_VEC = 366 * MiB;
constexpr size_t V_C1U = 0, V_C2U = 360448, V_C1Q = 720896, V_C2Q = 741376, V_C1I = 761856, V_C2I = 811008, V_CG = 860160, V_WG = 860416, V_ONES = 991488, V_ZEROS = 999680;
constexpr size_t WS_R = 368 * MiB;
constexpr size_t WS_R8 = 432 * MiB;
constexpr size_t WS_SP = 464 * MiB;
constexpr size_t SP_BYTES = (size_t)M * 16 * 4;
constexpr size_t WS_H = 466 * MiB;
constexpr size_t WS_QKV = 554 * MiB;
constexpr size_t WS_AO = 634 * MiB;
constexpr size_t WS_MP = 698 * MiB;
constexpr size_t WS_GATES = 890 * MiB;
constexpr size_t WS_HG = 891 * MiB;
constexpr size_t WS_END = 955 * MiB;
constexpr int CW_TMO = 0, CW_BAR = 4096;

struct Args { const float* x; const float* w1; const float* w3; const float* w2; const float* ln_g; const float* ln_b; const float* wqkv; const float* sinks; const float* wo;
              const float* win; const float* bg; const float* wmo; float* out; unsigned char* ws; };
typedef const __attribute__((address_space(4))) Args* kargs_t;
__device__ __forceinline__ kargs_t kargs() { kargs_t p = (kargs_t)__builtin_amdgcn_kernarg_segment_ptr(); asm volatile("" : "+s"(p)); return p; }

namespace pg8 {
#define PG8_LAS __attribute__((address_space(3)))
typedef unsigned short bf16_t;
typedef short bf16x8 __attribute__((ext_vector_type(8)));
typedef _Float16 f16x8 __attribute__((ext_vector_type(8)));
typedef float f32x4 __attribute__((ext_vector_type(4)));
typedef unsigned u32x4 __attribute__((ext_vector_type(4)));
constexpr int BM = 256, BK = 64, HALF = 128, HTB = HALF * BK * 2  , STAGE_BYTES = 8 * HTB, NXCD = 8, WGM = 8;

__host__ __device__ __forceinline__ int lds_byte(int r, int c) { const int st = (r >> 4) * 2 + (c >> 5), rr = r & 15, cc = c & 31, ob = rr * 64 + cc * 2; return st * 1024 + (ob ^ (((ob >> 9) & 1) << 5)); }
__host__ __device__ __forceinline__ void stage_rc(int b, int& R, int& C) { const int st = b / 1024, sb = b % 1024, swz = sb ^ (((sb >> 9) & 1) << 5); R = (st >> 1) * 16 + swz / 64; C = (st & 1) * 32 + (swz % 64) / 2; }
__host__ __device__ __forceinline__ int perm32(int rho) { const int n = rho >> 4, i = rho & 15; return 8 * (i >> 2) + 4 * n + (i & 3); }

typedef int i32x4 __attribute__((ext_vector_type(4)));
typedef int i32x8 __attribute__((ext_vector_type(8)));
constexpr int F8_FMT = 1;
__device__ __forceinline__ i32x8 cat_i8(bf16x8 lo, bf16x8 hi) { const i32x4 a = __builtin_bit_cast(i32x4, lo), b = __builtin_bit_cast(i32x4, hi); return __builtin_shufflevector(a, b, 0, 1, 2, 3, 4, 5, 6, 7); }
__device__ __forceinline__ void mfma_f8_inplace(f32x4& c, const i32x8 a, const i32x8 b) { asm volatile("v_mfma_f32_16x16x128_f8f6f4 %0, %1, %2, %0 cbsz:1 blgp:1" : "+v"(c) : "v"(a), "v"(b)); }
typedef unsigned u32x2 __attribute__((ext_vector_type(2)));
__device__ __forceinline__ u32x2 cvt8_f8(const float (&v)[8]) {
    int a, b; asm volatile("" : "=v"(a), "=v"(b));
    a = __builtin_amdgcn_cvt_pk_bf8_f32(v[0], v[1], a, false); a = __builtin_amdgcn_cvt_pk_bf8_f32(v[2], v[3], a, true);
    b = __builtin_amdgcn_cvt_pk_bf8_f32(v[4], v[5], b, false); b = __builtin_amdgcn_cvt_pk_bf8_f32(v[6], v[7], b, true);
    return (u32x2){(unsigned)a, (unsigned)b};
}
__device__ __forceinline__ int pg8_lane() { int l; asm volatile("v_mbcnt_lo_u32_b32 %0, -1, 0\n\tv_mbcnt_hi_u32_b32 %0, -1, %0" : "=v"(l)); return l; }
struct Unit { int pm, pn; };
struct Gemm { const bf16_t* A; const bf16_t* Bt; int M, N, K; };

struct StaticOrder {
    int nM, nN, nwg, G, c;
    __host__ __device__ void init(int M_, int N_, int G_, int c_) { nM = M_ / BM; nN = N_ / BM; nwg = nM * nN; G = G_; c = c_; }
    __host__ __device__ bool next(int i, Unit& u) const {
        const long L = (long)i * G + c; if (L >= nwg) return false;
        int wgid = (int)L; { const int q = nwg / NXCD, r = nwg % NXCD, xcd = wgid % NXCD, off = wgid / NXCD; wgid = (xcd < r ? xcd * (q + 1) : r * (q + 1) + (xcd - r) * q) + off; }
        const int nig = WGM * nN, gid = wgid / nig, fm = gid * WGM, gsz = (nM - fm) < WGM ? (nM - fm) : WGM;
        u.pm = fm + ((wgid % nig) % gsz); u.pn = (wgid % nig) / gsz; return true;
    }
    __device__ __forceinline__ void a_ready(const Unit&) const {}
    __device__ __forceinline__ void done(const Unit&) const {}
};

__device__ __forceinline__ unsigned cvt_pk_bf16(float lo, float hi) { typedef float f2 __attribute__((ext_vector_type(2))); typedef _Float16 b2 __attribute__((ext_vector_type(2))); f2 v = {lo, hi}; b2 b = __builtin_convertvector(v, b2); return __builtin_bit_cast(unsigned, b); }
__device__ __forceinline__ float bf_lo(unsigned w) { typedef _Float16 b2 __attribute__((ext_vector_type(2))); return (float)__builtin_bit_cast(b2, w)[0]; }
__device__ __forceinline__ float bf_hi(unsigned w) { typedef _Float16 b2 __attribute__((ext_vector_type(2))); return (float)__builtin_bit_cast(b2, w)[1]; }
__device__ __forceinline__ float fsigmoid(float x) { return __builtin_amdgcn_rcpf(1.f + __builtin_amdgcn_exp2f(-LOG2E * x)); }

__device__ __forceinline__ float sum_fq(float v) {
    auto a = __builtin_amdgcn_permlane16_swap(__float_as_uint(v), __float_as_uint(v), false, false); v = __uint_as_float(a[0]) + __uint_as_float(a[1]);
    auto b = __builtin_amdgcn_permlane32_swap(__float_as_uint(v), __float_as_uint(v), false, false); return __uint_as_float(b[0]) + __uint_as_float(b[1]);
}
__device__ __forceinline__ void row_stats(const float* sp, int row0, int fq, float (&mu)[2][4], float (&rs)[2][4]) {
#pragma unroll
    for (int ai = 0; ai < 2; ++ai)
#pragma unroll
        for (int m = 0; m < 4; ++m) {
            const f32x4 v = *(const f32x4*)(sp + (size_t)(row0 + ai * HALF + m * 16) * 16 + fq * 4);
            float s = v[0] + v[2], q = v[1] + v[3];
            s = sum_fq(s); q = sum_fq(q);
            const float mean = s * (1.f / D), var = q * (1.f / D) - mean * mean;
            mu[ai][m] = mean; rs[ai][m] = __builtin_amdgcn_rsqf(var + LN_EPS);
        }
}

struct EpiUp {
    static constexpr bool PERM = true, AFTER_DRAIN = false;
    int f, tpar;
    __device__ __forceinline__ void operator()(const f32x4 (&acc)[2][2][4][2], const Unit& u, int wr, int wc, int, int) const {
        const int lane_ = pg8_lane(), fr = lane_ & 15, fq = lane_ >> 4;
        const int row0 = u.pm * BM + wr * 64 + fr;
        unsigned char* ws = kargs()->ws; unsigned char* H = ws + WS_H;
        const float* c1 = (const float*)(ws + WS_VEC + V_C1U) + (size_t)f * NUP; const float* c2 = (const float*)(ws + WS_VEC + V_C2U) + (size_t)f * NUP; const float* sp = (const float*)(ws + WS_SP) + (size_t)tpar * (SP_BYTES / 4);
        float mu[2][4], rs[2][4]; row_stats(sp, row0, fq, mu, rs);
        const int cb = u.pn * BM + wc * 32 + 8 * fq;
        f32x4 k1[2][2], k2[2][2];
#pragma unroll
        for (int bj = 0; bj < 2; ++bj)
#pragma unroll
            for (int n = 0; n < 2; ++n) { k1[bj][n] = *(const f32x4*)(c1 + cb + bj * HALF + 4 * n); k2[bj][n] = *(const f32x4*)(c2 + cb + bj * HALF + 4 * n); }
        unsigned char* hp = H + (size_t)row0 * FF + u.pn * HALF + wc * 32 + 8 * fq;
#pragma unroll
        for (int ai = 0; ai < 2; ++ai)
#pragma unroll
            for (int m = 0; m < 4; ++m) {
                const float r_ = rs[ai][m], nm = -mu[ai][m] * r_;
                float hv[8];
#pragma unroll
                for (int n = 0; n < 2; ++n)
#pragma unroll
                    for (int j = 0; j < 4; ++j) {
                        const float ga = acc[ai][0][m][n][j] * r_ + (nm * k1[0][n][j] + k2[0][n][j]);
                        const float ub = acc[ai][1][m][n][j] * r_ + (nm * k1[1][n][j] + k2[1][n][j]);
                        hv[4 * n + j] = ga * fsigmoid(ga) * ub;
                    }
                *(u32x2*)(hp + (size_t)(ai * HALF + m * 16) * FF) = cvt8_f8(hv);
            }
    }
};

struct EpiLnOut {
    static constexpr bool PERM = true, AFTER_DRAIN = false;
    int att, j, tpar;
    __device__ __forceinline__ void operator()(const f32x4 (&acc)[2][2][4][2], const Unit& u, int wr, int wc, int, int) const {
        const int lane_ = pg8_lane(), fr = lane_ & 15, fq = lane_ >> 4;
        const int row0 = u.pm * BM + wr * 64 + fr;
        unsigned char* ws = kargs()->ws; bf16_t* O = (bf16_t*)(ws + (att ? WS_QKV : WS_MP)); const int ldo = att ? NQKV : NMI, sig_from = att ? 1000 : 16;
        const float* c1 = (const float*)(ws + WS_VEC + (att ? V_C1Q : V_C1I)) + j * ldo; const float* c2 = (const float*)(ws + WS_VEC + (att ? V_C2Q : V_C2I)) + j * ldo; const float* sp = (const float*)(ws + WS_SP) + (size_t)tpar * (SP_BYTES / 4);
        float mu[2][4], rs[2][4]; row_stats(sp, row0, fq, mu, rs);
        const int cb = u.pn * BM + wc * 32 + 8 * fq;
        const bool sg = u.pn >= sig_from;
        f32x4 k1[2][2], k2[2][2];
#pragma unroll
        for (int bj = 0; bj < 2; ++bj)
#pragma unroll
            for (int n = 0; n < 2; ++n) { k1[bj][n] = *(const f32x4*)(c1 + cb + bj * HALF + 4 * n); k2[bj][n] = *(const f32x4*)(c2 + cb + bj * HALF + 4 * n); }
        bf16_t* op = O + (size_t)row0 * ldo + cb;
#pragma unroll
        for (int ai = 0; ai < 2; ++ai)
#pragma unroll
            for (int m = 0; m < 4; ++m) {
                const float r_ = rs[ai][m], nm = -mu[ai][m] * r_;
#pragma unroll
                for (int bj = 0; bj < 2; ++bj) {
                    float v[8];
#pragma unroll
                    for (int n = 0; n < 2; ++n)
#pragma unroll
                        for (int j = 0; j < 4; ++j) { float t = acc[ai][bj][m][n][j] * r_ + (nm * k1[bj][n][j] + k2[bj][n][j]); if (sg) t = fsigmoid(t); v[4 * n + j] = t; }
                    u32x4 w; w.x = cvt_pk_bf16(v[0], v[1]); w.y = cvt_pk_bf16(v[2], v[3]); w.z = cvt_pk_bf16(v[4], v[5]); w.w = cvt_pk_bf16(v[6], v[7]);
                    *(u32x4*)(op + (size_t)(ai * HALF + m * 16) * ldo + bj * HALF) = w;
                }
            }
    }
};

struct EpiRes {
    static constexpr bool PERM = true, AFTER_DRAIN = false;
    int t; float coef; PG8_LAS float* tab; int wave;
    __device__ __forceinline__ void operator()(const f32x4 (&acc)[2][2][4][2], const Unit& u, int wr, int wc, int, int) const {
        const int lane_ = pg8_lane(), fr = lane_ & 15, fq = lane_ >> 4;
        typedef float f32x2v __attribute__((ext_vector_type(2)));
        const int row0 = u.pm * BM + wr * 64 + fr;
        kargs_t ka = kargs(); unsigned char* ws = ka->ws; bf16_t* R = (bf16_t*)(ws + WS_R); unsigned char* R8 = ws + WS_R8;
        const float* g = t ? ka->ln_g + (size_t)(t - 1) * D : (const float*)(ws + WS_VEC + V_ONES); const float* b = t ? ka->ln_b + (size_t)(t - 1) * D : (const float*)(ws + WS_VEC + V_ZEROS);
        const float* sp_in = (const float*)(ws + WS_SP) + (size_t)(t & 1) * (SP_BYTES / 4); float* sp_out = (float*)(ws + WS_SP) + (size_t)((t + 1) & 1) * (SP_BYTES / 4);
        float mu[2][4], rs[2][4]; row_stats(sp_in, row0, fq, mu, rs);
#pragma unroll
        for (int bj = 0; bj < 2; ++bj) {
            const int cb = u.pn * BM + bj * HALF + wc * 32 + 8 * fq;
            f32x4 gv[2], bv[2];
#pragma unroll
            for (int n = 0; n < 2; ++n) { gv[n] = *(const f32x4*)(g + cb + 4 * n); bv[n] = *(const f32x4*)(b + cb + 4 * n) * ALPHA; }
#pragma unroll
            for (int ai = 0; ai < 2; ++ai)
#pragma unroll
                for (int m = 0; m < 4; ++m) {
                    const float A_ = ALPHA * rs[ai][m], B_ = -mu[ai][m] * A_;
                    const size_t off = (size_t)(row0 + ai * HALF + m * 16) * D + cb;
                    const u32x4 old = *(const u32x4*)(R + off);
                    const float ro[8] = {bf_lo(old.x), bf_hi(old.x), bf_lo(old.y), bf_hi(old.y), bf_lo(old.z), bf_hi(old.z), bf_lo(old.w), bf_hi(old.w)};
                    float nv[8];
#pragma unroll
                    for (int n = 0; n < 2; ++n)
#pragma unroll
                        for (int j = 0; j < 4; ++j) nv[4 * n + j] = (ro[4 * n + j] * A_ + B_) * gv[n][j] + bv[n][j] + coef * acc[ai][bj][m][n][j];
                    u32x4 w; w.x = cvt_pk_bf16(nv[0], nv[1]); w.y = cvt_pk_bf16(nv[2], nv[3]); w.z = cvt_pk_bf16(nv[4], nv[5]); w.w = cvt_pk_bf16(nv[6], nv[7]);
                    *(u32x4*)(R + off) = w;
                    *(u32x2*)(R8 + off) = cvt8_f8(nv);
                    const float f0 = bf_lo(w.x), f1 = bf_hi(w.x), f2 = bf_lo(w.y), f3 = bf_hi(w.y), f4 = bf_lo(w.z), f5 = bf_hi(w.z), f6 = bf_lo(w.w), f7 = bf_hi(w.w);
                    float s = ((f0 + f1) + (f2 + f3)) + ((f4 + f5) + (f6 + f7));
                    float q = ((f0 * f0 + f1 * f1) + (f2 * f2 + f3 * f3)) + ((f4 * f4 + f5 * f5) + (f6 * f6 + f7 * f7));
                    s = sum_fq(s); q = sum_fq(q);
                    if (fq == 0) *(PG8_LAS f32x2v*)(tab + (((ai * HALF + wr * 64 + m * 16 + fr) * 4 + wc) * 2 + bj) * 2) = (f32x2v){s, q};
                    if (m & 1) asm volatile("" ::: "memory");
                }
        }
        asm volatile("s_waitcnt lgkmcnt(0)" ::: "memory"); __builtin_amdgcn_s_barrier(); asm volatile("" ::: "memory");
        const int tid = wave * 64 + pg8_lane();
        if (tid < BM) {
            const PG8_LAS f32x4* t4 = (const PG8_LAS f32x4*)(tab + tid * 16);
            const f32x4 a = t4[0], c = t4[1], d = t4[2], e = t4[3];
            *(f32x2v*)(sp_out + (size_t)(u.pm * BM + tid) * 16 + u.pn * 2) = (f32x2v){((a[0] + a[2]) + (c[0] + c[2])) + ((d[0] + d[2]) + (e[0] + e[2])), ((a[1] + a[3]) + (c[1] + c[3])) + ((d[1] + d[3]) + (e[1] + e[3]))};
        }
    }
};

template <class Epi, class Sched, bool ALIGN_EPI = false, bool SP2 = false, bool F8 = false>
__device__ __forceinline__ void gemm_phase(PG8_LAS unsigned char* lds, const Gemm g, const Sched& S, const Epi& E, int wave_in) {
    int wid = wave_in; asm volatile("" : "+s"(wid));
    const int lane = pg8_lane(), tid = wid * 64 + lane, wr = wid >> 2, wc = wid & 3, fr = lane & 15, fq = lane >> 4;
    const int K = g.K, nt = K / BK;
    unsigned voffA[2], voffB[2];
#pragma unroll
    for (int i = 0; i < 2; ++i) { int R, C; stage_rc(tid * 16 + i * 8192, R, C); const int Rb = Epi::PERM ? ((R & ~31) + perm32(R & 31)) : R;
        voffA[i] = (unsigned)(R * K + C) * 2u; voffB[i] = (unsigned)(Rb * K + C) * 2u; }
    const size_t kstep = (size_t)(BK * 2);
    const size_t hstep = (size_t)HALF * K * 2;
    const size_t tstep = 2 * hstep;
    const unsigned ldsw = (unsigned)wid * 1024u;
    const int aoff = lds_byte(wr * 64 + fr, fq * 8), boff = lds_byte(wc * 32 + fr, fq * 8);
#define PG8_SA(b, h) (((b) * 2 + (h)) * HTB)
#define PG8_SB(b, h) ((4 + (b) * 2 + (h)) * HTB)
#define PG8_STAGE(bufoff, gbase, voff) do { _Pragma("unroll") for (int _i = 0; _i < 2; ++_i) \
        __builtin_amdgcn_global_load_lds((const unsigned*)((const char*)(gbase) + (voff)[_i]), (PG8_LAS unsigned*)(lds + (bufoff) + ldsw + _i * 8192), 16, 0, 0); } while (0)
#define PG8_LDA(dst, b, h) do { _Pragma("unroll") for (int m = 0; m < 4; ++m) _Pragma("unroll") for (int k = 0; k < 2; ++k) dst[m][k] = *(const PG8_LAS bf16x8*)(lds + PG8_SA(b, h) + aoff + m * 2048 + k * 1024); } while (0)
#define PG8_LDB(dst, b, h) do { _Pragma("unroll") for (int n = 0; n < 2; ++n) _Pragma("unroll") for (int k = 0; k < 2; ++k) dst[n][k] = *(const PG8_LAS bf16x8*)(lds + PG8_SB(b, h) + boff + n * 2048 + k * 1024); } while (0)
#define PG8_MMA(ai, bj, At, Bt) do { __builtin_amdgcn_s_setprio(1); _Pragma("unroll") for (int m = 0; m < 4; ++m) _Pragma("unroll") for (int n = 0; n < 2; ++n) { \
        if constexpr (F8) mfma_f8_inplace(acc[ai][bj][m][n], cat_i8(Bt[n][0], Bt[n][1]), cat_i8(At[m][0], At[m][1])); \
        else { _Pragma("unroll") for (int k = 0; k < 2; ++k) acc[ai][bj][m][n] = __builtin_amdgcn_mfma_f32_16x16x32_f16(__builtin_bit_cast(f16x8, Bt[n][k]), __builtin_bit_cast(f16x8, At[m][k]), acc[ai][bj][m][n], 0, 0, 0); } } \
        __builtin_amdgcn_s_setprio(0); } while (0)
#define PG8_WAIT_V(n) asm volatile("s_waitcnt vmcnt(" #n ")" ::: "memory")
#define PG8_WAIT_L(n) asm volatile("s_waitcnt lgkmcnt(" #n ")" ::: "memory")
#define PG8_BAR __builtin_amdgcn_s_barrier()
#define PG8_SCHED __builtin_amdgcn_sched_barrier(0)
    Unit cur, nxt; int ui = 0;
    if (!S.next(0, cur)) return;
    f32x4 acc[2][2][4][2];
#pragma unroll
    for (int a = 0; a < 2; ++a)
#pragma unroll
        for (int b = 0; b < 2; ++b)
#pragma unroll
            for (int m = 0; m < 4; ++m)
#pragma unroll
                for (int n = 0; n < 2; ++n) { float z0, z1, z2, z3; asm volatile("v_mov_b32 %0, 0\n\tv_mov_b32 %1, 0\n\tv_mov_b32 %2, 0\n\tv_mov_b32 %3, 0" : "=v"(z0), "=v"(z1), "=v"(z2), "=v"(z3)); acc[a][b][m][n] = (f32x4){z0, z1, z2, z3}; }
    bf16x8 At[4][2], B0[2][2], B1[2][2];
    const char* cA = (const char*)g.A + (size_t)cur.pm * tstep; const char* cB = (const char*)g.Bt + (size_t)cur.pn * tstep;
    S.a_ready(cur);
    if constexpr (SP2) {
        PG8_STAGE(PG8_SB(0, 0), cB, voffB); PG8_STAGE(PG8_SB(0, 1), cB + hstep, voffB); PG8_STAGE(PG8_SA(0, 0), cA, voffA); PG8_STAGE(PG8_SA(0, 1), cA + hstep, voffA);
        if (wr == 1) PG8_BAR;
        PG8_WAIT_V(2); PG8_BAR;
        PG8_STAGE(PG8_SB(1, 0), cB + kstep, voffB); PG8_STAGE(PG8_SA(1, 0), cA + kstep, voffA); PG8_STAGE(PG8_SB(1, 1), cB + hstep + kstep, voffB);
        PG8_WAIT_V(6); PG8_BAR;
    } else {
        PG8_STAGE(PG8_SB(0, 0), cB, voffB); PG8_STAGE(PG8_SA(0, 0), cA, voffA); PG8_STAGE(PG8_SB(0, 1), cB + hstep, voffB); PG8_STAGE(PG8_SA(0, 1), cA + hstep, voffA);
        if (wr == 1) PG8_BAR;
        PG8_WAIT_V(4); PG8_BAR;
        PG8_STAGE(PG8_SB(1, 0), cB + kstep, voffB); PG8_STAGE(PG8_SA(1, 0), cA + kstep, voffA); PG8_STAGE(PG8_SB(1, 1), cB + hstep + kstep, voffB);
        PG8_WAIT_V(6); PG8_BAR;
    }
    for (;;) {
        const bool has_next = S.next(ui + 1, nxt);
        const char* nA = has_next ? (const char*)g.A + (size_t)nxt.pm * tstep : cA; const char* nB = has_next ? (const char*)g.Bt + (size_t)nxt.pn * tstep : cB;
        for (int t = 0; t < nt; t += 2) {
            const bool last = (t == nt - 2);
            const char* a1 = cA + (size_t)(t + 1) * kstep;
            const char* a2 = last ? nA : cA + (size_t)(t + 2) * kstep; const char* b2 = last ? nB : cB + (size_t)(t + 2) * kstep;
            const char* a3 = a2 + kstep; const char* b3 = b2 + kstep;
            if (last && has_next) S.a_ready(nxt);
            if constexpr (SP2) {
            PG8_LDB(B0, 0, 0); PG8_LDB(B1, 0, 1); PG8_SCHED; PG8_LDA(At, 0, 0); PG8_STAGE(PG8_SA(1, 1), a1 + hstep, voffA);
            PG8_WAIT_V(8); PG8_WAIT_L(0); PG8_BAR; PG8_MMA(0, 0, At, B0); PG8_MMA(0, 1, At, B1); PG8_BAR; PG8_SCHED;
            PG8_LDA(At, 0, 1); PG8_STAGE(PG8_SB(0, 0), b2, voffB); PG8_STAGE(PG8_SB(0, 1), b2 + hstep, voffB); PG8_STAGE(PG8_SA(0, 0), a2, voffA);
            PG8_WAIT_V(8); PG8_WAIT_L(0); PG8_BAR; PG8_MMA(1, 0, At, B0); PG8_MMA(1, 1, At, B1); PG8_BAR; PG8_SCHED;
            PG8_LDB(B0, 1, 0); PG8_LDB(B1, 1, 1); PG8_SCHED; PG8_LDA(At, 1, 0); PG8_STAGE(PG8_SA(0, 1), a2 + hstep, voffA);
            PG8_WAIT_V(8); PG8_WAIT_L(0); PG8_BAR; PG8_MMA(0, 0, At, B0); PG8_MMA(0, 1, At, B1); PG8_BAR; PG8_SCHED;
            PG8_LDA(At, 1, 1); PG8_STAGE(PG8_SB(1, 0), b3, voffB); PG8_STAGE(PG8_SB(1, 1), b3 + hstep, voffB); PG8_STAGE(PG8_SA(1, 0), a3, voffA);
            PG8_WAIT_V(8); PG8_WAIT_L(0); PG8_BAR; PG8_MMA(1, 0, At, B0); PG8_MMA(1, 1, At, B1); PG8_BAR; PG8_SCHED;
            } else {
            PG8_LDB(B0, 0, 0); PG8_SCHED; PG8_LDA(At, 0, 0); PG8_STAGE(PG8_SA(1, 1), a1 + hstep, voffA);
            PG8_WAIT_L(8); PG8_BAR; PG8_WAIT_L(0); PG8_MMA(0, 0, At, B0); PG8_BAR; PG8_SCHED;
            PG8_LDB(B1, 0, 1); PG8_STAGE(PG8_SB(0, 0), b2, voffB);
            PG8_BAR; PG8_WAIT_L(0); PG8_MMA(0, 1, At, B1); PG8_BAR;
            PG8_LDA(At, 0, 1); PG8_STAGE(PG8_SA(0, 0), a2, voffA);
            PG8_BAR; PG8_WAIT_L(0); PG8_MMA(1, 0, At, B0); PG8_BAR; PG8_SCHED;
            PG8_STAGE(PG8_SB(0, 1), b2 + hstep, voffB);
            PG8_WAIT_V(6); PG8_BAR; PG8_MMA(1, 1, At, B1); PG8_BAR;
            PG8_LDB(B0, 1, 0); PG8_SCHED; PG8_LDA(At, 1, 0); PG8_STAGE(PG8_SA(0, 1), a2 + hstep, voffA);
            PG8_WAIT_L(8); PG8_BAR; PG8_WAIT_L(0); PG8_MMA(0, 0, At, B0); PG8_BAR; PG8_SCHED;
            PG8_LDB(B1, 1, 1); PG8_STAGE(PG8_SB(1, 0), b3, voffB);
            PG8_BAR; PG8_WAIT_L(0); PG8_MMA(0, 1, At, B1); PG8_BAR;
            PG8_LDA(At, 1, 1); PG8_STAGE(PG8_SA(1, 0), a3, voffA);
            PG8_BAR; PG8_WAIT_L(0); PG8_MMA(1, 0, At, B0); PG8_BAR; PG8_SCHED;
            PG8_STAGE(PG8_SB(1, 1), b3 + hstep, voffB);
            PG8_WAIT_V(6); PG8_BAR; PG8_MMA(1, 1, At, B1); PG8_BAR;
            }
        }
        if constexpr (F8) asm volatile("s_nop 15\n\ts_nop 7" ::: "memory");
        if constexpr (ALIGN_EPI) { if (wr == 0) PG8_BAR; }
        if constexpr (!Epi::AFTER_DRAIN) { E(acc, cur, wr, wc, fr, fq); S.done(cur); }
        if (!has_next) break;
#pragma unroll
        for (int a = 0; a < 2; ++a)
#pragma unroll
            for (int b = 0; b < 2; ++b)
#pragma unroll
                for (int m = 0; m < 4; ++m)
#pragma unroll
                    for (int n = 0; n < 2; ++n) { float z0, z1, z2, z3; asm volatile("v_mov_b32 %0, 0\n\tv_mov_b32 %1, 0\n\tv_mov_b32 %2, 0\n\tv_mov_b32 %3, 0" : "=v"(z0), "=v"(z1), "=v"(z2), "=v"(z3)); acc[a][b][m][n] = (f32x4){z0, z1, z2, z3}; }
        cur = nxt; cA = nA; cB = nB; ++ui;
        if constexpr (ALIGN_EPI) { if (wr == 1) PG8_BAR; }
    }
    PG8_WAIT_V(0);
    if constexpr (!ALIGN_EPI) { if (wr == 0) PG8_BAR; }
    PG8_BAR;
    if constexpr (Epi::AFTER_DRAIN) { E.fused(acc, cur, wr, wc, fr, fq, lds, wid, lane); S.done(cur); }
#undef PG8_SA
#undef PG8_SB
#undef PG8_STAGE
#undef PG8_LDA
#undef PG8_LDB
#undef PG8_MMA
#undef PG8_WAIT_V
#undef PG8_WAIT_L
#undef PG8_BAR
#undef PG8_SCHED
}
}

#ifndef PG8_SP2
#define PG8_SP2 true
#endif

#define GAS __attribute__((address_space(1)))
#define LAS __attribute__((address_space(3)))
typedef unsigned short bf16;
typedef unsigned v4u __attribute__((ext_vector_type(4)));
typedef unsigned v2u __attribute__((ext_vector_type(2)));
typedef float f32x4 __attribute__((ext_vector_type(4)));
typedef float f32x2 __attribute__((ext_vector_type(2)));
typedef float f32x16 __attribute__((ext_vector_type(16)));
typedef short bf16x8 __attribute__((ext_vector_type(8)));
typedef short s16x4 __attribute__((ext_vector_type(4)));
typedef GAS unsigned gu32;
typedef GAS unsigned long long gu64;
typedef LAS const char* lcp;
typedef LAS char* lwp;
#define RLX_AGENT __ATOMIC_RELAXED, __HIP_MEMORY_SCOPE_AGENT
#define LDS_WAIT() asm volatile("s_waitcnt lgkmcnt(0)" ::: "memory")
#define VM_WAIT() asm volatile("s_waitcnt vmcnt(0)" ::: "memory")
#define WG_BAR() do { asm volatile("s_waitcnt vmcnt(0) lgkmcnt(0)" ::: "memory"); __builtin_amdgcn_s_barrier(); asm volatile("" ::: "memory"); } while (0)
#define DI __device__ __forceinline__
#define MFMA32(a, b, c) __builtin_amdgcn_mfma_f32_32x32x16_f16(__builtin_bit_cast(pg8::f16x8, (a)), __builtin_bit_cast(pg8::f16x8, (b)), (c), 0, 0, 0)
DI unsigned pk2(float lo, float hi) { return pg8::cvt_pk_bf16(lo, hi); }
DI float bflo(unsigned w) { return pg8::bf_lo(w); }
DI float bfhi(unsigned w) { return pg8::bf_hi(w); }
DI float ex2(float x) { return __builtin_amdgcn_exp2f(x); }
DI f32x16 zero16() { float z = 0.f; asm volatile("" : "+v"(z)); return (f32x16){z, z, z, z, z, z, z, z, z, z, z, z, z, z, z, z}; }
DI int crow(int r, int hi) { return (r & 3) + 8 * (r >> 2) + 4 * hi; }
#define SWZ_XOR(v, m) __uint_as_float((unsigned)__builtin_amdgcn_ds_swizzle((int)__float_as_uint(v), ((m) << 10) | 0x1f))
DI float half_swap_add(float v);
DI float wave_sum(float v) { v += SWZ_XOR(v, 1); v += SWZ_XOR(v, 2); v += SWZ_XOR(v, 4); v += SWZ_XOR(v, 8); v += SWZ_XOR(v, 16); return half_swap_add(v); }
DI float shfl_lane(float v, int src_lane) { return __uint_as_float((unsigned)__builtin_amdgcn_ds_bpermute(src_lane << 2, (int)__float_as_uint(v))); }
DI float half_swap_add(float v) { auto rr = __builtin_amdgcn_permlane32_swap(__float_as_uint(v), __float_as_uint(v), false, false); return __uint_as_float(rr[0]) + __uint_as_float(rr[1]); }
DI float half_swap_max(float v) { auto rr = __builtin_amdgcn_permlane32_swap(__float_as_uint(v), __float_as_uint(v), false, false); return fmaxf(__uint_as_float(rr[0]), __uint_as_float(rr[1])); }
typedef short v4i16_t __attribute__((ext_vector_type(4)));
DI s16x4 vtr(lcp p) { return __builtin_bit_cast(s16x4, __builtin_amdgcn_ds_read_tr16_b64_v4i16((LAS v4i16_t*)p)); }
DI bf16x8 cat8(s16x4 lo, s16x4 hi) { return (bf16x8){lo[0], lo[1], lo[2], lo[3], hi[0], hi[1], hi[2], hi[3]}; }
DI bf16x8 trfrag(lcp p) { return cat8(vtr(p), vtr(p + 512)); }
DI bf16x8 ldfrag(lcp p) { return *(const LAS bf16x8*)p; }
DI void glds16(const void* gsrc, LAS void* ldst) { __builtin_amdgcn_global_load_lds((const unsigned*)gsrc, (LAS unsigned*)ldst, 16, 0, 0); }
#define PACK8(x, s) ((bf16x8)__builtin_bit_cast(bf16x8, (v4u){pk2((x)[8 * (s) + 0], (x)[8 * (s) + 1]), pk2((x)[8 * (s) + 2], (x)[8 * (s) + 3]), pk2((x)[8 * (s) + 4], (x)[8 * (s) + 5]), pk2((x)[8 * (s) + 6], (x)[8 * (s) + 7])}))

constexpr int RING_OFF = 0, RING_BYTES = 131072;
constexpr int TAB_OFF = 131072;
constexpr int MISC_OFF = 163840 - 256;
constexpr int LDS_BYTES = 163840;
constexpr int AT_K = 0, AT_V = 32768, AT_WS = 65536, AT_STG = 67584;
constexpr int ML_K = 0, ML_V = 65536, ML_VW = 81920, ML_C = 98304, ML_N = 131072, ML_G2 = 131584, ML_M2 = 132096, ML_FI = 132608, ML_EI = 133120, ML_WK = 133632, ML_WKB = 134144, ML_SC = 134400, ML_WS = 134464, ML_STG = 136512;
static_assert(ML_STG + 4 * 4096 <= MISC_OFF && AT_STG + 8 * 4096 <= MISC_OFF && TAB_OFF + 16384 <= MISC_OFF, "LDS map");

#define XB_TMO      128
#define XB_XCNT(j)  (256  + 64 * (j))
#define XB_XSUB(j)  (1280 + 64 * (j))
#define XB_XGEN(j)  (2304 + 64 * (j))
#define XB_TOP      3328
#define XB_TOPGEN   3392
#define XCD_BAR_WORDS 3456
#define XB_SPIN_CAP (1u << 18)

__device__ __forceinline__ unsigned xb_ld(unsigned* p)              { return __hip_atomic_load(p, __ATOMIC_RELAXED, __HIP_MEMORY_SCOPE_AGENT); }
__device__ __forceinline__ unsigned xb_add(unsigned* p, unsigned v) { return __hip_atomic_fetch_add(p, v, __ATOMIC_RELAXED, __HIP_MEMORY_SCOPE_AGENT); }
__device__ __forceinline__ unsigned xb_xcc_id() { return (unsigned)__builtin_amdgcn_s_getreg((3 << 11) | 20) & 0xFu; }
#define XB_SPIN(cond, bar) do { unsigned _sp = 0; while (cond) { __builtin_amdgcn_s_sleep(1); \
    if ((++_sp & 255u) == 0u) { if (xb_ld(&(bar)[XB_TMO])) break; if (_sp > XB_SPIN_CAP) { atomicAdd(&(bar)[XB_TMO], 1u); break; } } } } while (0)

struct XcdBarrier {
    unsigned* bar; unsigned x;
    volatile LAS unsigned* st;
};

__device__ __forceinline__ XcdBarrier xcd_barrier_post(unsigned* bar, volatile LAS unsigned* st) {
    XcdBarrier b; b.bar = bar; b.x = xb_xcc_id(); b.st = st;
    if (threadIdx.x == 0) (void)xb_add(&bar[XB_XCNT(b.x)], 1u);
    return b;
}
__device__ __forceinline__ void xcd_barrier_complete(unsigned* bar, unsigned x, unsigned& nloc, unsigned& nx) {
    const unsigned G = gridDim.x * gridDim.y * gridDim.z;
    unsigned sum, cnt, mine, sp = 0u;
    for (;;) {
        sum = 0u; cnt = 0u; mine = 0u;
#pragma unroll
        for (unsigned j = 0; j < 16; ++j) { const unsigned c = xb_ld(&bar[XB_XCNT(j)]); sum += c; cnt += (c > 0u) ? 1u : 0u; mine = (j == x) ? c : mine; }
        if (sum == G) break;
        __builtin_amdgcn_s_sleep(1);
        if ((++sp & 255u) == 0u) { if (xb_ld(&bar[XB_TMO])) break; if (sp > XB_SPIN_CAP) { atomicAdd(&bar[XB_TMO], 1u); break; } }
    }
    nloc = mine > 0u ? mine : 1u; nx = cnt > 0u ? cnt : 1u;
}

__device__ __forceinline__ void xcd_barrier(const XcdBarrier& b) {
    asm volatile("s_waitcnt vmcnt(0)" ::: "memory");
    __syncthreads();
    if (threadIdx.x == 0) {
        unsigned* bar = b.bar;
        __builtin_amdgcn_s_waitcnt(0);
        unsigned nloc = b.st[0], nx = b.st[1];
        if (nloc == 0u) { xcd_barrier_complete(bar, b.x, nloc, nx); b.st[0] = nloc; b.st[1] = nx; }
        const unsigned old = xb_add(&bar[XB_XSUB(b.x)], 1u);
        const unsigned gen = old / nloc;
        if (old + 1u == (gen + 1u) * nloc) {
            __builtin_amdgcn_fence(__ATOMIC_RELEASE, "agent");
            asm volatile("s_waitcnt vmcnt(0)" ::: "memory");
            const unsigned og = xb_add(&bar[XB_TOP], 1u);
            const unsigned tg = og / nx;
            if (og + 1u == (tg + 1u) * nx) xb_add(&bar[XB_TOPGEN], 1u);
            else XB_SPIN(xb_ld(&bar[XB_TOPGEN]) == tg, bar);
            __builtin_amdgcn_fence(__ATOMIC_ACQUIRE, "agent");
            xb_add(&bar[XB_XGEN(b.x)], 1u);
            asm volatile("s_waitcnt vmcnt(0)" ::: "memory");
        } else {
            XB_SPIN(xb_ld(&bar[XB_XGEN(b.x)]) == gen, bar);
            __builtin_amdgcn_fence(__ATOMIC_ACQUIRE, "agent");
            asm volatile("s_waitcnt vmcnt(0)" ::: "memory");
        }
    }
    __syncthreads();
}
DI void attn_phase(unsigned char* ldsg, const bf16* QKV, bf16* AO, const float* sinks, int G, int bid, int wave_in) {
    int wid = wave_in; asm volatile("" : "+s"(wid));
    const int lane = pg8::pg8_lane(), tid = wid * 64 + lane, r32 = lane & 31, hi = lane >> 5;
    LAS unsigned char* lds = (LAS unsigned char*)ldsg; const lcp L = (lcp)lds;
    LAS float* wsf = (LAS float*)(lds + AT_WS) + wid * 64;
    LAS bf16* stg = (LAS bf16*)(lds + AT_STG + wid * 4096);
    const lcp vlane = L + AT_V + ((lane >> 4) & 1) * 32 + (lane & 3) * 8 + (4 * hi + ((lane & 15) >> 2)) * 64;
    const lcp klane = L + AT_K + hi * 1024 + r32 * 16;
    for (int unit = bid; unit < BATCH * 16 * 4; unit += G) {
        const int kvh = unit & 3, nb = (unit >> 2) & 15, b = unit >> 6;
        const long rowq = (long)b * SEQ + nb * 128, rowk = rowq - 128;
        const int slot_lo = (nb == 0) ? 2 : 0;
        for (int sl = slot_lo; sl < 4; ++sl) {
            glds16(QKV + (rowk + 64 * sl + lane) * NQKV + 2048 + 64 * kvh + 8 * wid, lds + AT_K + sl * 8192 + wid * 1024);
            glds16(QKV + (rowk + 64 * sl + 16 * (wid & 3) + (lane >> 2)) * NQKV + 2304 + 64 * kvh + (wid >> 2) * 32 + (lane & 3) * 8, lds + AT_V + sl * 8192 + wid * 1024);
        }
        const int hq = 8 * kvh + wid;
        const bf16* qsrc = QKV + (rowq + r32) * NQKV + 64 * hq + 8 * hi;
        bf16x8 qn[4];
#pragma unroll
        for (int d0 = 0; d0 < 4; ++d0) qn[d0] = *(const bf16x8*)(qsrc + 16 * d0);
        const float slope2 = ex2(-0.25f * (float)(hq + 1)) * LOG2E, sink2 = sinks[hq] * LOG2E;
        const float base_l = -slope2 * (float)(r32 - 4 * hi);
        WG_BAR();
#pragma unroll 1
        for (int j = 0; j < 4; ++j) {
            const int ilo = (nb == 0) ? 4 - j : 0;
            bf16x8 qr[4];
#pragma unroll
            for (int d0 = 0; d0 < 4; ++d0) qr[d0] = qn[d0];
            if (j < 3) {
#pragma unroll
                for (int d0 = 0; d0 < 4; ++d0) qn[d0] = *(const bf16x8*)(qsrc + (size_t)(32 * (j + 1)) * NQKV + 16 * d0);
            }
            float sl2 = slope2, bl = base_l; asm volatile("" : "+v"(sl2), "+v"(bl));
            f32x16 p[5];
#pragma unroll
            for (int i = 0; i < 5; ++i) {
                if (i >= ilo) {
                    const int kt = j + i; const lcp kb = klane + (kt >> 1) * 8192 + (kt & 1) * 512;
                    f32x16 a = zero16();
#pragma unroll
                    for (int d0 = 0; d0 < 4; ++d0) a = MFMA32(ldfrag(kb + d0 * 2048), qr[d0], a);
#pragma unroll
                    for (int r = 0; r < 16; ++r) {
                        const int cr = (r & 3) + 8 * (r >> 2);
                        float s = fmaf(sl2, (float)(cr - 128 + 32 * i), fmaf(a[r], LOG2E, bl));
                        if (i == 0) { if (!(cr + 4 * hi > r32)) s = -INFINITY; }
                        if (i == 4) { if (!(cr + 4 * hi <= r32)) s = -INFINITY; }
                        a[r] = s;
                    }
                    p[i] = a;
                } else {
#pragma unroll
                    for (int r = 0; r < 16; ++r) p[i][r] = -INFINITY;
                }
            }
            float mx = sink2;
#pragma unroll
            for (int i = 0; i < 5; ++i)
#pragma unroll
                for (int r = 0; r < 16; ++r) mx = fmaxf(mx, p[i][r]);
            mx = half_swap_max(mx);
            float ls = 0.f;
#pragma unroll
            for (int i = 0; i < 5; ++i)
#pragma unroll
                for (int r = 0; r < 16; ++r) { const float e = ex2(p[i][r] - mx); p[i][r] = e; ls += e; }
            ls = half_swap_add(ls) + ex2(sink2 - mx);
            f32x16 o0 = zero16(), o1 = zero16();
#pragma unroll
            for (int i = 0; i < 5; ++i) {
                if (i >= ilo) {
                    const int kt = j + i; const lcp vb = vlane + (kt >> 1) * 8192 + (kt & 1) * 2048;
                    const bf16x8 pa = PACK8(p[i], 0), pb = PACK8(p[i], 1);
                    o0 = MFMA32(pa, trfrag(vb), o0);        o0 = MFMA32(pb, trfrag(vb + 1024), o0);
                    o1 = MFMA32(pa, trfrag(vb + 4096), o1); o1 = MFMA32(pb, trfrag(vb + 4096 + 1024), o1);
                }
            }
            if (hi == 0) wsf[r32] = __builtin_amdgcn_rcpf(ls);
#pragma unroll
            for (int r = 0; r < 16; ++r) {
                const int orow = crow(r, hi); const float rl = wsf[orow];
                stg[orow * 64 + r32] = (bf16)(pk2(o0[r] * rl, 0.f) & 0xffffu);
                stg[orow * 64 + 32 + r32] = (bf16)(pk2(o1[r] * rl, 0.f) & 0xffffu);
            }
#pragma unroll
            for (int i4 = 0; i4 < 4; ++i4) {
                const int row = i4 * 8 + (lane >> 3), ch = lane & 7;
                const v4u v = *(const LAS v4u*)(stg + row * 64 + ch * 8);
                *(v4u*)(AO + (rowq + 32 * j + row) * D + 64 * hq + ch * 8) = v;
            }
        }
        WG_BAR();
    }
}

DI void mlstm_phase(unsigned char* ldsg, const bf16* MP, const float* GT, bf16* HG, int G, int bid, int wave_in) {
    int wid = wave_in; asm volatile("" : "+s"(wid));
    const int lane0 = pg8::pg8_lane(), tid = wid * 64 + lane0;
    LAS unsigned char* lds = (LAS unsigned char*)ldsg; const lcp L = (lcp)lds;
    LAS float* G2 = (LAS float*)(lds + ML_G2); LAS float* M2 = (LAS float*)(lds + ML_M2); LAS float* FI = (LAS float*)(lds + ML_FI); LAS float* EI = (LAS float*)(lds + ML_EI);
    LAS float* WK = (LAS float*)(lds + ML_WK); LAS bf16* WKB = (LAS bf16*)(lds + ML_WKB); LAS float* SC = (LAS float*)(lds + ML_SC);
    LAS float* wsf = (LAS float*)(lds + ML_WS) + wid * 64;
    for (int unit = bid; unit < BATCH * 4 * 8; unit += G) {
        const int sl = unit & 7, h = (unit >> 3) & 3, b = unit >> 5;
        const bf16* Qp = MP + 256 * h; const bf16* Kp = MP + 1024 + 256 * h; const bf16* Vp = MP + 2048 + 512 * h + 64 * sl; const bf16* OGp = MP + 4096 + 512 * h + 64 * sl;
        { unsigned z = 0u; asm volatile("" : "+v"(z)); for (int i = tid; i < (32768 + 512) / 16; i += 512) *(LAS v4u*)(lds + ML_C + i * 16) = (v4u){z, z, z, z}; }
        f32x16 T[6];
#pragma unroll
        for (int x = 0; x < 6; ++x) T[x] = zero16();
        float m_prev = 0.f;
        WG_BAR();
        for (int c = 0; c < 16; ++c) {
            const long row0 = (long)b * SEQ + 128 * c;
            const int lane = pg8::pg8_lane(), r32 = lane & 31, hi = lane >> 5;
            const int blk = (lane >> 4) & 1, q4 = (lane & 15) >> 2, p4 = lane & 3;
            const int vlo_ = blk * 32 + p4 * 8 + (4 * hi + q4) * 64;
            const int ktl_ = (2 * blk + (p4 >> 1)) * 2048 + (q4 + 4 * hi) * 16 + (p4 & 1) * 8;
            const int cbl_ = hi * 1024 + r32 * 16, kbl_ = hi * 2048 + r32 * 16;
            const unsigned m0 = (r32 == 0) ? 0xffffffffu : 0u; const v4u m0v = {m0, m0, m0, m0};
#pragma unroll
            for (int i = 0; i < 8; ++i) { const int chunk = 4 * wid + (i >> 1), half = i & 1;
                glds16(Kp + (row0 + 64 * half + lane) * NMI + chunk * 8, lds + ML_K + chunk * 2048 + half * 1024); }
            v4u vreg[2];
#pragma unroll
            for (int i = 0; i < 2; ++i) vreg[i] = *(const v4u*)(Vp + (row0 + 64 * i + 16 * (wid & 3) + (lane >> 2)) * NMI + (wid >> 2) * 32 + (lane & 3) * 8);
            bf16x8 qf[16];
            if (wid < 4) {
#pragma unroll
                for (int ks = 0; ks < 16; ++ks) qf[ks] = *(const bf16x8*)(Qp + (row0 + 32 * wid + r32) * NMI + 16 * ks + 8 * hi);
            }
            if (wid == 0) {
                const float* gp = GT + (size_t)(row0 + 2 * lane) * 8;
                const float i0 = gp[h], f0 = gp[4 + h], i1 = gp[8 + h], f1 = gp[12 + h];
                const float lf0 = -logf(1.f + expf(-f0)), lf1 = -logf(1.f + expf(-f1));
                float incl = lf0 + lf1;
#pragma unroll
                for (int o = 1; o < 64; o <<= 1) { const float t = shfl_lane(incl, lane - o); if (lane >= o) incl += t; }
                const float b1 = incl, b0 = incl - lf1;
                const float g0 = i0 - b0, g1 = i1 - b1;
                float cm = fmaxf(g0, g1);
#pragma unroll
                for (int o = 1; o < 64; o <<= 1) { const float t = shfl_lane(cm, lane - o); if (lane >= o) cm = fmaxf(cm, t); }
                float cprev = shfl_lane(cm, lane - 1); if (lane == 0) cprev = -INFINITY;
                const float M0 = fmaxf(m_prev, fmaxf(cprev, g0)), M1 = fmaxf(m_prev, cm);
                const float Mend = shfl_lane(M1, 63), blast = shfl_lane(b1, 63);
                *(LAS f32x2*)(G2 + 2 * lane) = (f32x2){g0 * LOG2E, g1 * LOG2E};
                *(LAS f32x2*)(M2 + 2 * lane) = (f32x2){M0 * LOG2E, M1 * LOG2E};
                *(LAS f32x2*)(FI + 2 * lane) = (f32x2){ex2((m_prev - M0) * LOG2E), ex2((m_prev - M1) * LOG2E)};
                *(LAS f32x2*)(EI + 2 * lane) = (f32x2){ex2(-(b0 + M0) * LOG2E), ex2(-(b1 + M1) * LOG2E)};
                const float w0 = ex2((g0 - Mend) * LOG2E), w1 = ex2((g1 - Mend) * LOG2E);
                *(LAS f32x2*)(WK + 2 * lane) = (f32x2){w0, w1};
                *(LAS unsigned*)(WKB + 2 * lane) = pk2(w0, w1);
                if (lane == 0) SC[0] = ex2((m_prev - Mend) * LOG2E);
                m_prev = blast + Mend;
            }
            VM_WAIT();
#pragma unroll
            for (int i = 0; i < 2; ++i) *(LAS v4u*)(lds + ML_V + i * 8192 + wid * 1024 + lane * 16) = vreg[i];
            WG_BAR();
#pragma unroll
            for (int i = 0; i < 2; ++i) { const float w = WK[64 * i + 16 * (wid & 3) + (lane >> 2)]; const v4u v = vreg[i]; v4u o;
                o.x = pk2(bflo(v.x) * w, bfhi(v.x) * w); o.y = pk2(bflo(v.y) * w, bfhi(v.y) * w); o.z = pk2(bflo(v.z) * w, bfhi(v.z) * w); o.w = pk2(bflo(v.w) * w, bfhi(v.w) * w);
                *(LAS v4u*)(lds + ML_VW + i * 8192 + wid * 1024 + lane * 16) = o; }
            WG_BAR();
            if (wid < 4) {
                const int tt = wid;
                T[0] = zero16(); T[1] = zero16(); T[2] = zero16();
                { const lcp cb = L + ML_C + cbl_; const lcp nbp = L + ML_N + 16 * hi;
#pragma unroll
                  for (int ks = 0; ks < 16; ++ks) {
                      const bf16x8 c0 = ldfrag(cb + ks * 2048), c1 = ldfrag(cb + ks * 2048 + 512);
                      const bf16x8 nf = __builtin_bit_cast(bf16x8, __builtin_bit_cast(v4u, ldfrag(nbp + ks * 32)) & m0v);
                      T[0] = MFMA32(qf[ks], c0, T[0]); T[1] = MFMA32(qf[ks], c1, T[1]); T[2] = MFMA32(qf[ks], nf, T[2]);
                      if ((ks & 3) == 3) __builtin_amdgcn_sched_barrier(0);
                  } }
                { float fi[16];
#pragma unroll
                  for (int r = 0; r < 16; ++r) fi[r] = FI[32 * tt + crow(r, hi)];
#pragma unroll
                  for (int r = 0; r < 16; ++r) { T[0][r] *= fi[r]; T[1][r] *= fi[r]; }
                  if (r32 == 0) {
#pragma unroll
                      for (int r = 0; r < 16; ++r) wsf[crow(r, hi)] = T[2][r] * fi[r];
                  } }
                const float Mt = M2[32 * tt + r32];
                float dsum = 0.f;
                for (int st = 0; st <= tt; ++st) {
                    f32x16 S = zero16();
                    const lcp kb = L + ML_K + kbl_ + st * 512;
#pragma unroll
                    for (int ks = 0; ks < 16; ++ks) S = MFMA32(ldfrag(kb + ks * 4096), qf[ks], S);
#pragma unroll
                    for (int r = 0; r < 16; ++r) {
                        const float w = ex2(G2[32 * st + crow(r, hi)] - Mt);
                        float v = S[r] * w;
                        if (st == tt && crow(r, hi) > r32) v = 0.f;
                        S[r] = v; dsum += v;
                    }
                    const bf16x8 pa = PACK8(S, 0), pb = PACK8(S, 1);
                    const lcp vb = L + ML_V + (st >> 1) * 8192 + (st & 1) * 2048 + vlo_;
                    T[0] = MFMA32(pa, trfrag(vb), T[0]);        T[0] = MFMA32(pb, trfrag(vb + 1024), T[0]);
                    T[1] = MFMA32(pa, trfrag(vb + 4096), T[1]); T[1] = MFMA32(pb, trfrag(vb + 4096 + 1024), T[1]);
                }
                dsum = half_swap_add(dsum);
                { const float den = wsf[r32] + dsum; const float dn = fmaxf(fabsf(den), EI[32 * tt + r32]);
                  if (hi == 0) wsf[32 + r32] = __builtin_amdgcn_rcpf(dn); }
                LAS bf16* stg = (LAS bf16*)(lds + ML_STG + tt * 4096);
#pragma unroll
                for (int r = 0; r < 16; ++r) {
                    const int orow = crow(r, hi); const float rd = wsf[32 + orow];
                    stg[orow * 64 + r32] = (bf16)(pk2(T[0][r] * rd, 0.f) & 0xffffu);
                    stg[orow * 64 + 32 + r32] = (bf16)(pk2(T[1][r] * rd, 0.f) & 0xffffu);
                }
#pragma unroll
                for (int i4 = 0; i4 < 4; ++i4) {
                    const int row = i4 * 8 + (lane >> 3), ch = lane & 7;
                    const v4u hv = *(const LAS v4u*)(stg + row * 64 + ch * 8);
                    const v4u og = *(const v4u*)(OGp + (row0 + 32 * tt + row) * NMI + ch * 8);
                    v4u o;
                    o.x = pk2(bflo(hv.x) * bflo(og.x), bfhi(hv.x) * bfhi(og.x)); o.y = pk2(bflo(hv.y) * bflo(og.y), bfhi(hv.y) * bfhi(og.y));
                    o.z = pk2(bflo(hv.z) * bflo(og.z), bfhi(hv.z) * bfhi(og.z)); o.w = pk2(bflo(hv.w) * bflo(og.w), bfhi(hv.w) * bfhi(og.w));
                    *(v4u*)(HG + (row0 + 32 * tt + row) * D + 512 * h + 64 * sl + ch * 8) = o;
                }
#pragma unroll
                for (int x = 3; x < 6; ++x) T[x] = zero16();
            } else {
                const float decay = SC[0];
#pragma unroll
                for (int x = 0; x < 6; ++x)
#pragma unroll
                    for (int r = 0; r < 16; ++r) T[x][r] *= decay;
#pragma unroll
                for (int dti = 0; dti < 2; ++dti) {
                    const int dt = 2 * (wid - 4) + dti;
                    const lcp ka0 = L + ML_K + dt * 8192 + ktl_;
#pragma unroll
                    for (int s8 = 0; s8 < 8; ++s8) {
                        const lcp ka = ka0 + s8 * 256;
                        const bf16x8 af = cat8(vtr(ka), vtr(ka + 128));
                        const lcp vwb = L + ML_VW + (s8 >> 2) * 8192 + (s8 & 3) * 1024 + vlo_;
                        const bf16x8 b0 = trfrag(vwb), b1 = trfrag(vwb + 4096);
                        const LAS s16x4* wp = (const LAS s16x4*)(WKB + 16 * s8 + 4 * hi);
                        const bf16x8 nb = __builtin_bit_cast(bf16x8, __builtin_bit_cast(v4u, cat8(wp[0], wp[2])) & m0v);
                        T[2 * dti] = MFMA32(af, b0, T[2 * dti]); T[2 * dti + 1] = MFMA32(af, b1, T[2 * dti + 1]); T[4 + dti] = MFMA32(af, nb, T[4 + dti]);
                        if (s8 & 1) __builtin_amdgcn_sched_barrier(0);
                    }
                }
            }
            WG_BAR();
            if (wid >= 4) {
#pragma unroll
                for (int dti = 0; dti < 2; ++dti) {
                    const int dt = 2 * (wid - 4) + dti;
#pragma unroll
                    for (int et = 0; et < 2; ++et)
#pragma unroll
                        for (int g = 0; g < 4; ++g)
                            *(LAS v2u*)(lds + ML_C + (4 * dt + g) * 1024 + (32 * et + r32) * 16 + hi * 8) = (v2u){pk2(T[2 * dti + et][4 * g], T[2 * dti + et][4 * g + 1]), pk2(T[2 * dti + et][4 * g + 2], T[2 * dti + et][4 * g + 3])};
                    if (r32 == 0) {
#pragma unroll
                        for (int g = 0; g < 4; ++g)
                            *(LAS v2u*)(lds + ML_N + (32 * dt + 8 * g + 4 * hi) * 2) = (v2u){pk2(T[4 + dti][4 * g], T[4 + dti][4 * g + 1]), pk2(T[4 + dti][4 * g + 2], T[4 + dti][4 * g + 3])};
                    }
                }
            }
        }
        WG_BAR();
    }
}


constexpr int NWAVES = 8;

template <bool F8> DI void tr_strip(const float* W, int ldw, int n0, void* WTv, size_t wt_row0, int Kdim, int kb0, int nkb, const float* g, const float* bb, float cs, float* c1o, float* c2o, LAS float* scr, int lane) {
    bf16* WT = (bf16*)WTv; unsigned char* WT8 = (unsigned char*)WTv;
    const int c = lane & 7;
    float a1[4] = {0.f, 0.f, 0.f, 0.f}, a2[4] = {0.f, 0.f, 0.f, 0.f};
    for (int kb = kb0; kb < kb0 + nkb; ++kb) {
        const int k0 = kb * 64;
#pragma unroll 8
        for (int i = 0; i < 32; ++i) { const int kk = 2 * i + (lane >> 5); scr[kk * 33 + (lane & 31)] = W[(size_t)(k0 + kk) * ldw + n0 + (lane & 31)]; }
        float gk[8], bk[8];
        if (g) { const f32x4 g0 = *(const f32x4*)(g + k0 + 8 * c), g1 = *(const f32x4*)(g + k0 + 8 * c + 4), b0 = *(const f32x4*)(bb + k0 + 8 * c), b1 = *(const f32x4*)(bb + k0 + 8 * c + 4);
#pragma unroll
            for (int i = 0; i < 4; ++i) { gk[i] = g0[i] * cs; gk[4 + i] = g1[i] * cs; bk[i] = b0[i] * cs; bk[4 + i] = b1[i] * cs; } }
        else {
#pragma unroll
            for (int i = 0; i < 8; ++i) { gk[i] = cs; bk[i] = 0.f; } }
        LDS_WAIT(); asm volatile("" ::: "memory");
#pragma unroll
        for (int j = 0; j < 4; ++j) { const int n = (lane >> 3) + 8 * j; const LAS float* s = scr + (8 * c) * 33 + n;
            float v[8];
#pragma unroll
            for (int i = 0; i < 8; ++i) v[i] = s[i * 33];
            a2[j] += ((v[0] * bk[0] + v[1] * bk[1]) + (v[2] * bk[2] + v[3] * bk[3])) + ((v[4] * bk[4] + v[5] * bk[5]) + (v[6] * bk[6] + v[7] * bk[7]));
            if constexpr (F8) {
                float wv[8];
#pragma unroll
                for (int i = 0; i < 8; ++i) wv[i] = v[i] * gk[i];
                const v2u o = pg8::cvt8_f8(wv);
                a1[j] += ((__builtin_amdgcn_cvt_f32_bf8((int)o.x, 0) + __builtin_amdgcn_cvt_f32_bf8((int)o.x, 1)) + (__builtin_amdgcn_cvt_f32_bf8((int)o.x, 2) + __builtin_amdgcn_cvt_f32_bf8((int)o.x, 3)))
                       + ((__builtin_amdgcn_cvt_f32_bf8((int)o.y, 0) + __builtin_amdgcn_cvt_f32_bf8((int)o.y, 1)) + (__builtin_amdgcn_cvt_f32_bf8((int)o.y, 2) + __builtin_amdgcn_cvt_f32_bf8((int)o.y, 3)));
                *(GAS v2u*)(WT8 + (wt_row0 + n) * Kdim + k0 + 8 * c) = o;
            } else {
                v4u o; o.x = pk2(v[0] * gk[0], v[1] * gk[1]); o.y = pk2(v[2] * gk[2], v[3] * gk[3]); o.z = pk2(v[4] * gk[4], v[5] * gk[5]); o.w = pk2(v[6] * gk[6], v[7] * gk[7]);
                a1[j] += ((bflo(o.x) + bfhi(o.x)) + (bflo(o.y) + bfhi(o.y))) + ((bflo(o.z) + bfhi(o.z)) + (bflo(o.w) + bfhi(o.w)));
                *(GAS v4u*)(WT + (wt_row0 + n) * Kdim + k0 + 8 * c) = o;
            } }
        LDS_WAIT(); asm volatile("" ::: "memory");
    }
    if (g) {
#pragma unroll
        for (int j = 0; j < 4; ++j) { float s1 = a1[j], s2 = a2[j];
            s1 += SWZ_XOR(s1, 1); s2 += SWZ_XOR(s2, 1); s1 += SWZ_XOR(s1, 2); s2 += SWZ_XOR(s2, 2); s1 += SWZ_XOR(s1, 4); s2 += SWZ_XOR(s2, 4);
            if (c == 0) { c1o[(lane >> 3) + 8 * j] = s1; c2o[(lane >> 3) + 8 * j] = s2; } }
    }
}

DI void prologue(kargs_t a, LAS unsigned char* lds, int gw, int NGW, int wave, int lane) {
    unsigned char* ws = a->ws;
    float* vec = (float*)(ws + WS_VEC);
    const float* ones = (const float*)(ws + WS_VEC + V_ONES); const float* zeros = (const float*)(ws + WS_VEC + V_ZEROS);
    LAS float* scr = (LAS float*)(lds + wave * 16384);
    constexpr int T_UP = 8 * 2 * 176, T_QKV = 2 * 80, T_MI = 2 * 192, T_W2 = 8 * 64 * 4, T_WO = 2 * 64, T_WMO = 2 * 64, T_G = 16;
    constexpr int NT = T_UP + T_QKV + T_MI + T_W2 + T_WO + T_WMO + T_G;
    for (int it = gw; it < NT; it += NGW) {
        int r = it;
        if (r < T_UP) {
            const int f = r / 352, rr = r % 352, which = rr / 176, strip = rr % 176, n0 = 32 * strip;
            const int t = 3 * (f >> 1) + 2 * (f & 1);
            const float* gp = t ? a->ln_g + (size_t)(t - 1) * D : nullptr; const float* bp = t ? a->ln_b + (size_t)(t - 1) * D : nullptr;
            const size_t wrow = (size_t)256 * (n0 / 128) + 128 * which + (n0 % 128);
            const float* W = (which ? a->w3 : a->w1) + (size_t)f * D * FF;
            if (gp) tr_strip<true>(W, FF, n0, ws + WS_W13 + (size_t)f * NUP * D, wrow, D, 0, 32, gp, bp, 1.f, vec + V_C1U / 4 + (size_t)f * NUP + wrow, vec + V_C2U / 4 + (size_t)f * NUP + wrow, scr, lane);
            else { tr_strip<true>(W, FF, n0, ws + WS_W13 + (size_t)f * NUP * D, wrow, D, 0, 32, nullptr, nullptr, 1.f, nullptr, nullptr, scr, lane);
                   if (lane < 32) { vec[V_C1U / 4 + (size_t)f * NUP + wrow + lane] = 0.f; vec[V_C2U / 4 + (size_t)f * NUP + wrow + lane] = 0.f; } }
            continue; }
        r -= T_UP;
        if (r < T_QKV) { const int j = r / 80, n0 = 32 * (r % 80); const int t = 6 * j + 1;
            tr_strip<false>(a->wqkv + (size_t)j * D * NQKV, NQKV, n0, (bf16*)(ws + WS_WQKV) + (size_t)j * NQKV * D, n0, D, 0, 32, a->ln_g + (size_t)(t - 1) * D, a->ln_b + (size_t)(t - 1) * D, n0 < 2048 ? 0.125f : 1.f,
                     vec + V_C1Q / 4 + j * NQKV + n0, vec + V_C2Q / 4 + j * NQKV + n0, scr, lane);
            continue; }
        r -= T_QKV;
        if (r < T_MI) { const int j = r / 192, n0 = 32 * (r % 192); const int t = 6 * j + 4;
            tr_strip<false>(a->win + (size_t)j * D * NMIW, NMIW, n0, (bf16*)(ws + WS_WIN) + (size_t)j * NMI * D, n0, D, 0, 32, a->ln_g + (size_t)(t - 1) * D, a->ln_b + (size_t)(t - 1) * D, (n0 >= 1024 && n0 < 2048) ? 0.0625f : 1.f,
                     vec + V_C1I / 4 + j * NMI + n0, vec + V_C2I / 4 + j * NMI + n0, scr, lane);
            continue; }
        r -= T_MI;
        if (r < T_W2) { const int f = r / 256, rr = r % 256, strip = rr / 4, kq = rr % 4;
            tr_strip<true>(a->w2 + (size_t)f * FF * D, D, 32 * strip, ws + WS_W2 + (size_t)f * D * FF, 32 * strip, FF, 22 * kq, 22, nullptr, nullptr, 1.f, nullptr, nullptr, scr, lane);
            continue; }
        r -= T_W2;
        if (r < T_WO) { const int j = r / 64, strip = r % 64;
            tr_strip<false>(a->wo + (size_t)j * D * D, D, 32 * strip, (bf16*)(ws + WS_WO) + (size_t)j * D * D, 32 * strip, D, 0, 32, nullptr, nullptr, 1.f, nullptr, nullptr, scr, lane);
            continue; }
        r -= T_WO;
        if (r < T_WMO) { const int j = r / 64, strip = r % 64;
            tr_strip<false>(a->wmo + (size_t)j * D * D, D, 32 * strip, (bf16*)(ws + WS_WMO) + (size_t)j * D * D, 32 * strip, D, 0, 32, nullptr, nullptr, 1.f, nullptr, nullptr, scr, lane);
            continue; }
        r -= T_WMO;
        {
            const int j = r / 8, jj = r % 8; const int t = 6 * j + 4;
            const float* gp = a->ln_g + (size_t)(t - 1) * D; const float* bp = a->ln_b + (size_t)(t - 1) * D;
            const float* W = a->win + (size_t)j * D * NMIW + NMI + jj;
            float* wg = vec + V_WG / 4 + (size_t)(j * 8 + jj) * D;
            float s1 = 0.f, s2 = 0.f;
            for (int k = lane; k < D; k += 64) { const float w = W[(size_t)k * NMIW]; const float v = w * gp[k]; wg[k] = v; s1 += v; s2 += w * bp[k]; }
            s1 = wave_sum(s1); s2 = wave_sum(s2);
            if (lane == 0) { vec[V_CG / 4 + j * 16 + jj] = s1; vec[V_CG / 4 + j * 16 + 8 + jj] = s2 + a->bg[j * 8 + jj]; }
        }
    }
    bf16* R = (bf16*)(ws + WS_R); float* sp0 = (float*)(ws + WS_SP);
    for (int m = gw; m < M; m += NGW) {
        const GAS f32x4* xr = (const GAS f32x4*)(a->x + (size_t)m * D);
#pragma unroll
        for (int i = 0; i < 4; ++i) { const f32x4 v0 = xr[(i * 64 + lane) * 2], v1 = xr[(i * 64 + lane) * 2 + 1];
            *(GAS v4u*)(R + (size_t)m * D + (i * 64 + lane) * 8) = (v4u){pk2(v0[0], v0[1]), pk2(v0[2], v0[3]), pk2(v1[0], v1[1]), pk2(v1[2], v1[3])};
            { const float xv[8] = {v0[0], v0[1], v0[2], v0[3], v1[0], v1[1], v1[2], v1[3]}; *(GAS v2u*)(ws + WS_R8 + (size_t)m * D + (i * 64 + lane) * 8) = pg8::cvt8_f8(xv); } }
        if (lane < 8) *(f32x2*)(sp0 + (size_t)m * 16 + lane * 2) = (f32x2){0.f, 256.f * (1.f - LN_EPS)};
    }
    for (int i = gw * 64 + lane; i < D; i += NGW * 64) { vec[V_ONES / 4 + i] = 1.f; vec[V_ZEROS / 4 + i] = 0.f; }
    (void)ones; (void)zeros;
}

DI void gates_phase(LAS unsigned char* lds, const bf16* R, const float* sp, const float* wg, const float* cg, float* GT, int G, int bid, int wave_in) {
    int wave = wave_in; asm volatile("" : "+s"(wave));
    const int lane = pg8::pg8_lane(), tid = wave * 64 + lane;
    for (int i = tid; i < 8 * D / 4; i += 512) *(LAS f32x4*)(lds + i * 16) = *(const f32x4*)(wg + i * 4);
    WG_BAR();
    const LAS float* W = (const LAS float*)lds;
    for (int m = bid * NWAVES + wave; m < M; m += G * NWAVES) {
        float acc[8] = {0.f, 0.f, 0.f, 0.f, 0.f, 0.f, 0.f, 0.f};
#pragma unroll 1
        for (int i = 0; i < 4; ++i) {
            const int k = 8 * lane + 512 * i;
            const v4u rv = *(const v4u*)(R + (size_t)m * D + k);
            const float x[8] = {bflo(rv.x), bfhi(rv.x), bflo(rv.y), bfhi(rv.y), bflo(rv.z), bfhi(rv.z), bflo(rv.w), bfhi(rv.w)};
#pragma unroll
            for (int jj = 0; jj < 8; ++jj) { const f32x4 w0 = *(const LAS f32x4*)(W + jj * D + k), w1 = *(const LAS f32x4*)(W + jj * D + k + 4);
                acc[jj] += ((x[0] * w0[0] + x[1] * w0[1]) + (x[2] * w0[2] + x[3] * w0[3])) + ((x[4] * w1[0] + x[5] * w1[1]) + (x[6] * w1[2] + x[7] * w1[3])); }
        }
#pragma unroll
        for (int jj = 0; jj < 8; ++jj) acc[jj] = wave_sum(acc[jj]);
        float s = 0.f, q = 0.f;
        { const f32x4 v = *(const f32x4*)(sp + (size_t)m * 16 + (lane & 3) * 4); s = v[0] + v[2]; q = v[1] + v[3];
          s += SWZ_XOR(s, 1); q += SWZ_XOR(q, 1); s += SWZ_XOR(s, 2); q += SWZ_XOR(q, 2); }
        const float mean = s * (1.f / D), var = q * (1.f / D) - mean * mean, rstd = __builtin_amdgcn_rsqf(var + LN_EPS);
        float sel = acc[0];
#pragma unroll
        for (int jj = 1; jj < 8; ++jj) sel = (lane == jj) ? acc[jj] : sel;
        if (lane < 8) GT[(size_t)m * 8 + lane] = rstd * (sel - mean * cg[lane]) + cg[8 + lane];
    }
}

DI void final_ln(const bf16* R, const float* sp, const float* g, const float* b, float* out, int gw, int NGW, int lane) {
    for (int m = gw; m < M; m += NGW) {
        float s, q;
        { const f32x4 v = *(const f32x4*)(sp + (size_t)m * 16 + (lane & 3) * 4); s = v[0] + v[2]; q = v[1] + v[3];
          s += SWZ_XOR(s, 1); q += SWZ_XOR(q, 1); s += SWZ_XOR(s, 2); q += SWZ_XOR(q, 2); }
        const float mean = s * (1.f / D), var = q * (1.f / D) - mean * mean, rstd = __builtin_amdgcn_rsqf(var + LN_EPS);
#pragma unroll
        for (int i = 0; i < 4; ++i) {
            const int k = 8 * lane + 512 * i;
            const v4u rv = *(const v4u*)(R + (size_t)m * D + k);
            const f32x4 g0 = *(const f32x4*)(g + k), g1 = *(const f32x4*)(g + k + 4), b0 = *(const f32x4*)(b + k), b1 = *(const f32x4*)(b + k + 4);
            f32x4 o0, o1;
            o0[0] = (bflo(rv.x) - mean) * rstd * g0[0] + b0[0]; o0[1] = (bfhi(rv.x) - mean) * rstd * g0[1] + b0[1]; o0[2] = (bflo(rv.y) - mean) * rstd * g0[2] + b0[2]; o0[3] = (bfhi(rv.y) - mean) * rstd * g0[3] + b0[3];
            o1[0] = (bflo(rv.z) - mean) * rstd * g1[0] + b1[0]; o1[1] = (bfhi(rv.z) - mean) * rstd * g1[1] + b1[1]; o1[2] = (bflo(rv.w) - mean) * rstd * g1[2] + b1[2]; o1[3] = (bfhi(rv.w) - mean) * rstd * g1[3] + b1[3];
            *(GAS f32x4*)(out + (size_t)m * D + k) = o0; *(GAS f32x4*)(out + (size_t)m * D + k + 4) = o1;
        }
    }
}

#ifndef SKIP_ATT
#define SKIP_ATT 0
#endif
#ifndef SKIP_MLSTM
#define SKIP_MLSTM 0
#endif

#define GRID_BAR() do { XcdBarrier b_; b_.bar = (unsigned*)(kargs()->ws + WS_CTL) + CW_BAR; b_.x = xb_xcc_id(); b_.st = (volatile LAS unsigned*)(lds + MISC_OFF) + 8; xcd_barrier(b_); } while (0)

__global__ void __launch_bounds__(NWAVES * 64, 2) fwd_kernel(Args args_by_value) {
    extern __shared__ __attribute__((aligned(16))) unsigned char lds_raw[];
    LAS unsigned char* lds = (LAS unsigned char*)lds_raw;
    const int w0 = __builtin_amdgcn_readfirstlane((int)threadIdx.x >> 6);
    const int G = gridDim.x, bid = blockIdx.x;
    { const int tid0 = threadIdx.x; if (tid0 < 64) ((volatile LAS unsigned*)(lds + MISC_OFF))[tid0] = 0u; }
    __syncthreads();
    (void)xcd_barrier_post((unsigned*)(kargs()->ws + WS_CTL) + CW_BAR, (volatile LAS unsigned*)(lds + MISC_OFF) + 8);
    {
        const int vcu = (G % 8 == 0) ? (bid % 8) * (G / 8) + bid / 8 : bid;
        prologue(kargs(), lds, vcu * NWAVES + w0, G * NWAVES, w0, pg8::pg8_lane());
    }
    GRID_BAR();

    for (int t = 0; t < 3 * DEPTH; ++t) {
        const int layer = t / 3, sub = t % 3;
        const int kind = (sub != 1) ? 0 : ((layer & 1) ? 2 : 1);
        const int j = layer >> 1;
        {
            unsigned char* ws = kargs()->ws;
            float* vec = (float*)(ws + WS_VEC);
            const bf16* R = (const bf16*)(ws + WS_R);
            const float* sp_in = (const float*)(ws + WS_SP) + (size_t)(t & 1) * (SP_BYTES / 4);
            if (kind == 0) {
                const int f = 2 * layer + (sub >> 1);
                pg8::Gemm g{(const bf16*)(ws + WS_R8), (const bf16*)(ws + WS_W13 + (size_t)f * NUP * D), M, NUP, D / 2}; pg8::StaticOrder S; S.init(M, NUP, G, bid);
                pg8::EpiUp E{f, t & 1};
                pg8::gemm_phase<pg8::EpiUp, pg8::StaticOrder, true, PG8_SP2, true>(lds + RING_OFF, g, S, E, w0);
            } else {
                const bool att = kind == 1;
                pg8::Gemm g{R, att ? (const bf16*)(ws + WS_WQKV) + (size_t)j * NQKV * D : (const bf16*)(ws + WS_WIN) + (size_t)j * NMI * D, M, att ? NQKV : NMI, D};
                pg8::StaticOrder S; S.init(M, att ? NQKV : NMI, G, bid);
                pg8::EpiLnOut E{att ? 1 : 0, j, t & 1};
                pg8::gemm_phase<pg8::EpiLnOut, pg8::StaticOrder, true, PG8_SP2>(lds + RING_OFF, g, S, E, w0);
                if (!att) gates_phase(lds, R, sp_in, vec + V_WG / 4 + (size_t)j * 8 * D, vec + V_CG / 4 + j * 16, (float*)(ws + WS_GATES), G, bid, w0);
            }
        }
        GRID_BAR();
        if (kind == 1) {
            if (!SKIP_ATT) { kargs_t ka = kargs(); unsigned char* ws = ka->ws; attn_phase(lds_raw, (const bf16*)(ws + WS_QKV), (bf16*)(ws + WS_AO), ka->sinks + j * 32, G, bid, w0); }
            GRID_BAR();
        } else if (kind == 2) {
            if (!SKIP_MLSTM) { unsigned char* ws = kargs()->ws; mlstm_phase(lds_raw, (const bf16*)(ws + WS_MP), (const float*)(ws + WS_GATES), (bf16*)(ws + WS_HG), G, bid, w0); }
            GRID_BAR();
        }
        {
            kargs_t ka = kargs(); unsigned char* ws = ka->ws;
            float coef = kind == 0 ? 0.5f : 1.f;
            if ((kind == 1 && SKIP_ATT) || (kind == 2 && SKIP_MLSTM)) coef = 0.f;
            pg8::StaticOrder S; S.init(M, D, G, bid);
            pg8::EpiRes E{t, coef, (LAS float*)(lds + TAB_OFF), w0};
            if (kind == 0) {
                const int f = 2 * layer + (sub >> 1);
                pg8::Gemm g{(const bf16*)(ws + WS_H), (const bf16*)(ws + WS_W2 + (size_t)f * D * FF), M, D, FF / 2};
                pg8::gemm_phase<pg8::EpiRes, pg8::StaticOrder, true, PG8_SP2, true>(lds + RING_OFF, g, S, E, w0);
            } else {
                const bf16* A = (const bf16*)(ws + (kind == 1 ? WS_AO : WS_HG));
                const bf16* Bt = kind == 1 ? (const bf16*)(ws + WS_WO) + (size_t)j * D * D : (const bf16*)(ws + WS_WMO) + (size_t)j * D * D;
                pg8::Gemm g{A, Bt, M, D, D};
                pg8::gemm_phase<pg8::EpiRes, pg8::StaticOrder, true, PG8_SP2, false>(lds + RING_OFF, g, S, E, w0);
            }
        }
        GRID_BAR();
    }
    {
        kargs_t ka = kargs(); unsigned char* ws = ka->ws;
        const int vcu = (G % 8 == 0) ? (bid % 8) * (G / 8) + bid / 8 : bid;
        final_ln((const bf16*)(ws + WS_R), (const float*)(ws + WS_SP), ka->ln_g + (size_t)(3 * DEPTH - 1) * D, ka->ln_b + (size_t)(3 * DEPTH - 1) * D, ka->out, vcu * NWAVES + w0, G * NWAVES, pg8::pg8_lane());
    }
}

extern "C" void kernel_launch(void* const* d_in, const int* in_sizes, int n_in, void* d_out, int out_size, void* d_ws, size_t ws_size, hipStream_t stream) {
    static int grid = 0;
    if (grid == 0) {
        if (n_in != 12 || in_sizes[0] != M * D || out_size != M * D || ws_size < WS_END) { fprintf(stderr, "kernel_launch: unexpected shapes / workspace (n_in %d, ws %zu < %zu); nothing launched\n", n_in, ws_size, (size_t)WS_END); grid = -1; return; }
        int dev = 0, cus = 0;
        if (hipGetDevice(&dev) != hipSuccess || hipDeviceGetAttribute(&cus, hipDeviceAttributeMultiprocessorCount, dev) != hipSuccess) { grid = -1; return; }
        if (hipFuncSetAttribute((const void*)fwd_kernel, hipFuncAttributeMaxDynamicSharedMemorySize, LDS_BYTES) != hipSuccess) { fprintf(stderr, "kernel_launch: hipFuncSetAttribute failed\n"); grid = -1; return; }
        int per_cu = 0;
        if (hipOccupancyMaxActiveBlocksPerMultiprocessor(&per_cu, (const void*)fwd_kernel, NWAVES * 64, LDS_BYTES) != hipSuccess || per_cu < 1) { fprintf(stderr, "kernel_launch: occupancy query says %d\n", per_cu); }
        (void)hipGetLastError();
        grid = cus;
    }
    if (grid < 0) return;
    (void)hipMemsetAsync((char*)d_ws + WS_CTL, 0, CTL_ZERO_BYTES, stream);
    Args a{};
    a.x = (const float*)d_in[0]; a.w1 = (const float*)d_in[1]; a.w3 = (const float*)d_in[2]; a.w2 = (const float*)d_in[3]; a.ln_g = (const float*)d_in[4]; a.ln_b = (const float*)d_in[5];
    a.wqkv = (const float*)d_in[6]; a.sinks = (const float*)d_in[7]; a.wo = (const float*)d_in[8]; a.win = (const float*)d_in[9]; a.bg = (const float*)d_in[10]; a.wmo = (const float*)d_in[11];
    a.out = (float*)d_out; a.ws = (unsigned char*)d_ws;
    hipLaunchKernelGGL(fwd_kernel, dim3(grid), dim3(NWAVES * 64), LDS_BYTES, stream, a);
}
```

```cpp
#include <hip/hip_runtime.h>
#include <hip/hip_bf16.h>
#include <cstdio>
#include <cstdint>
#include <cmath>

constexpr int BATCH = 8, SEQ = 2048, D = 2048, FF = 5632, DEPTH = 4;
constexpr int M = BATCH * SEQ;
constexpr int NUP = 2 * FF;
constexpr int NQKV = 2560;
constexpr int NMI = 6144, NMIW = 6152;
constexpr float LN_EPS = 1e-5f;
constexpr float ALPHA = 1.681792830507429f;
constexpr float LOG2E = 1.4426950408889634f;

constexpr size_t MiB = 1u << 20;
constexpr size_t WS_CTL = 0, CTL_ZERO_BYTES = 1 * MiB;
constexpr size_t WS_W13 = 2 * MiB;
constexpr size_t WS_W2 = 178 * MiB;
constexpr size_t WS_WQKV = 266 * MiB;
constexpr size_t WS_WO = 286 * MiB;
constexpr size_t WS_WIN = 302 * MiB;
constexpr size_t WS_WMO = 350 * MiB;
constexpr size_t WS_VEC = 366 * MiB;
constexpr size_t V_C1U = 0, V_C2U = 360448, V_C1Q = 720896, V_C2Q = 741376, V_C1I = 761856, V_C2I = 811008, V_CG = 860160, V_WG = 860416, V_ONES = 991488, V_ZEROS = 999680;
constexpr size_t WS_R = 368 * MiB;
constexpr size_t WS_R8 = 432 * MiB;
constexpr size_t WS_SP = 464 * MiB;
constexpr size_t SP_BYTES = (size_t)M * 16 * 4;
constexpr size_t WS_H = 466 * MiB;
constexpr size_t WS_QKV = 554 * MiB;
constexpr size_t WS_AO = 634 * MiB;
constexpr size_t WS_MP = 698 * MiB;
constexpr size_t WS_GATES = 890 * MiB;
constexpr size_t WS_HG = 891 * MiB;
constexpr size_t WS_END = 955 * MiB;
constexpr int CW_TMO = 0, CW_BAR = 4096;

struct Args { const float* x; const float* w1; const float* w3; const float* w2; const float* ln_g; const float* ln_b; const float* wqkv; const float* sinks; const float* wo;
              const float* win; const float* bg; const float* wmo; float* out; unsigned char* ws; };
typedef const __attribute__((address_space(4))) Args* kargs_t;
__device__ __forceinline__ kargs_t kargs() { kargs_t p = (kargs_t)__builtin_amdgcn_kernarg_segment_ptr(); asm volatile("" : "+s"(p)); return p; }

namespace pg8 {
#define PG8_LAS __attribute__((address_space(3)))
typedef unsigned short bf16_t;
typedef short bf16x8 __attribute__((ext_vector_type(8)));
typedef _Float16 f16x8 __attribute__((ext_vector_type(8)));
typedef float f32x4 __attribute__((ext_vector_type(4)));
typedef unsigned u32x4 __attribute__((ext_vector_type(4)));
constexpr int BM = 256, BK = 64, HALF = 128, HTB = HALF * BK * 2  , STAGE_BYTES = 8 * HTB, NXCD = 8, WGM = 8;

__host__ __device__ __forceinline__ int lds_byte(int r, int c) { const int st = (r >> 4) * 2 + (c >> 5), rr = r & 15, cc = c & 31, ob = rr * 64 + cc * 2; return st * 1024 + (ob ^ (((ob >> 9) & 1) << 5)); }
__host__ __device__ __forceinline__ void stage_rc(int b, int& R, int& C) { const int st = b / 1024, sb = b % 1024, swz = sb ^ (((sb >> 9) & 1) << 5); R = (st >> 1) * 16 + swz / 64; C = (st & 1) * 32 + (swz % 64) / 2; }
__host__ __device__ __forceinline__ int perm32(int rho) { const int n = rho >> 4, i = rho & 15; return 8 * (i >> 2) + 4 * n + (i & 3); }

typedef int i32x4 __attribute__((ext_vector_type(4)));
typedef int i32x8 __attribute__((ext_vector_type(8)));
constexpr float F8_SR = 8.f, F8_SW = 1024.f, F8_SH = 16.f, F8_SO = 64.f;
__device__ __forceinline__ i32x8 cat_i8(bf16x8 lo, bf16x8 hi) { const i32x4 a = __builtin_bit_cast(i32x4, lo), b = __builtin_bit_cast(i32x4, hi); return __builtin_shufflevector(a, b, 0, 1, 2, 3, 4, 5, 6, 7); }
__device__ __forceinline__ void mfma_f8_inplace(f32x4& c, const i32x8 a, const i32x8 b) { asm volatile("v_mfma_f32_16x16x128_f8f6f4 %0, %1, %2, %0 cbsz:0 blgp:0" : "+v"(c) : "v"(a), "v"(b)); }
typedef unsigned u32x2 __attribute__((ext_vector_type(2)));
__device__ __forceinline__ u32x2 cvt8_f8(const float (&v)[8], float s) {
    int a, b; asm volatile("" : "=v"(a), "=v"(b));
    a = __builtin_amdgcn_cvt_pk_fp8_f32(v[0] * s, v[1] * s, a, false); a = __builtin_amdgcn_cvt_pk_fp8_f32(v[2] * s, v[3] * s, a, true);
    b = __builtin_amdgcn_cvt_pk_fp8_f32(v[4] * s, v[5] * s, b, false); b = __builtin_amdgcn_cvt_pk_fp8_f32(v[6] * s, v[7] * s, b, true);
    return (u32x2){(unsigned)a, (unsigned)b};
}
__device__ __forceinline__ int pg8_lane() { int l; asm volatile("v_mbcnt_lo_u32_b32 %0, -1, 0\n\tv_mbcnt_hi_u32_b32 %0, -1, %0" : "=v"(l)); return l; }
struct Unit { int pm, pn; };
struct Gemm { const bf16_t* A; const bf16_t* Bt; int M, N, K; };

struct StaticOrder {
    int nM, nN, nwg, G, c;
    __host__ __device__ void init(int M_, int N_, int G_, int c_) { nM = M_ / BM; nN = N_ / BM; nwg = nM * nN; G = G_; c = c_; }
    __host__ __device__ bool next(int i, Unit& u) const {
        const long L = (long)i * G + c; if (L >= nwg) return false;
        int wgid = (int)L; { const int q = nwg / NXCD, r = nwg % NXCD, xcd = wgid % NXCD, off = wgid / NXCD; wgid = (xcd < r ? xcd * (q + 1) : r * (q + 1) + (xcd - r) * q) + off; }
        const int nig = WGM * nN, gid = wgid / nig, fm = gid * WGM, gsz = (nM - fm) < WGM ? (nM - fm) : WGM;
        u.pm = fm + ((wgid % nig) % gsz); u.pn = (wgid % nig) / gsz; return true;
    }
    __device__ __forceinline__ void a_ready(const Unit&) const {}
    __device__ __forceinline__ void done(const Unit&) const {}
};

__device__ __forceinline__ unsigned cvt_pk_bf16(float lo, float hi) { typedef float f2 __attribute__((ext_vector_type(2))); typedef _Float16 b2 __attribute__((ext_vector_type(2))); f2 v = {lo, hi}; b2 b = __builtin_convertvector(v, b2); return __builtin_bit_cast(unsigned, b); }
__device__ __forceinline__ float bf_lo(unsigned w) { typedef _Float16 b2 __attribute__((ext_vector_type(2))); return (float)__builtin_bit_cast(b2, w)[0]; }
__device__ __forceinline__ float bf_hi(unsigned w) { typedef _Float16 b2 __attribute__((ext_vector_type(2))); return (float)__builtin_bit_cast(b2, w)[1]; }
__device__ __forceinline__ float fsigmoid(float x) { return __builtin_amdgcn_rcpf(1.f + __builtin_amdgcn_exp2f(-LOG2E * x)); }

__device__ __forceinline__ float sum_fq(float v) {
    auto a = __builtin_amdgcn_permlane16_swap(__float_as_uint(v), __float_as_uint(v), false, false); v = __uint_as_float(a[0]) + __uint_as_float(a[1]);
    auto b = __builtin_amdgcn_permlane32_swap(__float_as_uint(v), __float_as_uint(v), false, false); return __uint_as_float(b[0]) + __uint_as_float(b[1]);
}
__device__ __forceinline__ void row_stats(const float* sp, int row0, int fq, float (&mu)[2][4], float (&rs)[2][4]) {
#pragma unroll
    for (int ai = 0; ai < 2; ++ai)
#pragma unroll
        for (int m = 0; m < 4; ++m) {
            const f32x4 v = *(const f32x4*)(sp + (size_t)(row0 + ai * HALF + m * 16) * 16 + fq * 4);
            float s = v[0] + v[2], q = v[1] + v[3];
            s = sum_fq(s); q = sum_fq(q);
            const float mean = s * (1.f / D), var = q * (1.f / D) - mean * mean;
            mu[ai][m] = mean; rs[ai][m] = __builtin_amdgcn_rsqf(var + LN_EPS);
        }
}

struct EpiNull {
    static constexpr bool PERM = true, AFTER_DRAIN = false;
    float* sink;
    __device__ __forceinline__ void operator()(const f32x4 (&acc)[2][2][4][2], const Unit& u, int wr, int wc, int, int) const {
        float s = 0.f;
#pragma unroll
        for (int ai = 0; ai < 2; ++ai)
#pragma unroll
            for (int bj = 0; bj < 2; ++bj)
#pragma unroll
                for (int m = 0; m < 4; ++m)
#pragma unroll
                    for (int n = 0; n < 2; ++n) s += acc[ai][bj][m][n][0] + acc[ai][bj][m][n][1] + acc[ai][bj][m][n][2] + acc[ai][bj][m][n][3];
        if (s == 123.456f) sink[u.pm + wr + wc] = s;
    }
};

struct EpiUp {
    static constexpr bool PERM = true, AFTER_DRAIN = false;
    int f, tpar;
    __device__ __forceinline__ void operator()(const f32x4 (&acc)[2][2][4][2], const Unit& u, int wr, int wc, int, int) const {
        const int lane_ = pg8_lane(), fr = lane_ & 15, fq = lane_ >> 4;
        const int row0 = u.pm * BM + wr * 64 + fr;
        unsigned char* ws = kargs()->ws; unsigned char* H = ws + WS_H;
        const float* c1 = (const float*)(ws + WS_VEC + V_C1U) + (size_t)f * NUP; const float* c2 = (const float*)(ws + WS_VEC + V_C2U) + (size_t)f * NUP; const float* sp = (const float*)(ws + WS_SP) + (size_t)tpar * (SP_BYTES / 4);
        float mu[2][4], rs[2][4]; row_stats(sp, row0, fq, mu, rs);
        const int cb = u.pn * BM + wc * 32 + 8 * fq;
        f32x4 k1[2][2], k2[2][2];
#pragma unroll
        for (int bj = 0; bj < 2; ++bj)
#pragma unroll
            for (int n = 0; n < 2; ++n) { k1[bj][n] = *(const f32x4*)(c1 + cb + bj * HALF + 4 * n); k2[bj][n] = *(const f32x4*)(c2 + cb + bj * HALF + 4 * n); }
        unsigned char* hp = H + (size_t)row0 * FF + u.pn * HALF + wc * 32 + 8 * fq;
#pragma unroll
        for (int ai = 0; ai < 2; ++ai)
#pragma unroll
            for (int m = 0; m < 4; ++m) {
                const float r_ = rs[ai][m], nm = -mu[ai][m] * r_, ra = r_ * (1.f / (F8_SR * F8_SW));
                float hv[8];
#pragma unroll
                for (int n = 0; n < 2; ++n)
#pragma unroll
                    for (int j = 0; j < 4; ++j) {
                        const float ga = acc[ai][0][m][n][j] * ra + (nm * k1[0][n][j] + k2[0][n][j]);
                        const float ub = acc[ai][1][m][n][j] * ra + (nm * k1[1][n][j] + k2[1][n][j]);
                        hv[4 * n + j] = ga * fsigmoid(ga) * ub;
                    }
                *(u32x2*)(hp + (size_t)(ai * HALF + m * 16) * FF) = cvt8_f8(hv, F8_SH);
            }
    }
};

struct EpiLnOut {
    static constexpr bool PERM = true, AFTER_DRAIN = false;
    int att, j, tpar; float ascale;
    __device__ __forceinline__ void operator()(const f32x4 (&acc)[2][2][4][2], const Unit& u, int wr, int wc, int, int) const {
        const int lane_ = pg8_lane(), fr = lane_ & 15, fq = lane_ >> 4;
        const int row0 = u.pm * BM + wr * 64 + fr;
        unsigned char* ws = kargs()->ws; bf16_t* O = (bf16_t*)(ws + (att ? WS_QKV : WS_MP)); const int ldo = att ? NQKV : NMI, sig_from = att ? 1000 : 16;
        const float* c1 = (const float*)(ws + WS_VEC + (att ? V_C1Q : V_C1I)) + j * ldo; const float* c2 = (const float*)(ws + WS_VEC + (att ? V_C2Q : V_C2I)) + j * ldo; const float* sp = (const float*)(ws + WS_SP) + (size_t)tpar * (SP_BYTES / 4);
        float mu[2][4], rs[2][4]; row_stats(sp, row0, fq, mu, rs);
        const int cb = u.pn * BM + wc * 32 + 8 * fq;
        const bool sg = u.pn >= sig_from;
        f32x4 k1[2][2], k2[2][2];
#pragma unroll
        for (int bj = 0; bj < 2; ++bj)
#pragma unroll
            for (int n = 0; n < 2; ++n) { k1[bj][n] = *(const f32x4*)(c1 + cb + bj * HALF + 4 * n); k2[bj][n] = *(const f32x4*)(c2 + cb + bj * HALF + 4 * n); }
        bf16_t* op = O + (size_t)row0 * ldo + cb;
#pragma unroll
        for (int ai = 0; ai < 2; ++ai)
#pragma unroll
            for (int m = 0; m < 4; ++m) {
                const float r_ = rs[ai][m], nm = -mu[ai][m] * r_, ra = r_ * ascale;
#pragma unroll
                for (int bj = 0; bj < 2; ++bj) {
                    float v[8];
#pragma unroll
                    for (int n = 0; n < 2; ++n)
#pragma unroll
                        for (int j = 0; j < 4; ++j) { float t = acc[ai][bj][m][n][j] * ra + (nm * k1[bj][n][j] + k2[bj][n][j]); if (sg) t = fsigmoid(t); v[4 * n + j] = t; }
                    u32x4 w; w.x = cvt_pk_bf16(v[0], v[1]); w.y = cvt_pk_bf16(v[2], v[3]); w.z = cvt_pk_bf16(v[4], v[5]); w.w = cvt_pk_bf16(v[6], v[7]);
                    *(u32x4*)(op + (size_t)(ai * HALF + m * 16) * ldo + bj * HALF) = w;
                }
            }
    }
};

struct EpiRes {
    static constexpr bool PERM = true, AFTER_DRAIN = false;
    int t; float coef; PG8_LAS float* tab; int wave; int dry;
    __device__ __forceinline__ void operator()(const f32x4 (&acc)[2][2][4][2], const Unit& u, int wr, int wc, int, int) const {
        const int lane_ = pg8_lane(), fr = lane_ & 15, fq = lane_ >> 4;
        typedef float f32x2v __attribute__((ext_vector_type(2)));
        const int row0 = u.pm * BM + wr * 64 + fr;
        kargs_t ka = kargs(); unsigned char* ws = ka->ws; bf16_t* R = (bf16_t*)(ws + WS_R); unsigned char* R8 = ws + (dry ? WS_MP + 64 * MiB : WS_R8); bf16_t* Ro = dry ? (bf16_t*)(ws + WS_MP) : R;
        const float* g = t ? ka->ln_g + (size_t)(t - 1) * D : (const float*)(ws + WS_VEC + V_ONES); const float* b = t ? ka->ln_b + (size_t)(t - 1) * D : (const float*)(ws + WS_VEC + V_ZEROS);
        const float* sp_in = (const float*)(ws + WS_SP) + (size_t)(t & 1) * (SP_BYTES / 4); float* sp_out = dry ? (float*)(ws + WS_MP + 96 * MiB) : (float*)(ws + WS_SP) + (size_t)((t + 1) & 1) * (SP_BYTES / 4);
        float mu[2][4], rs[2][4]; row_stats(sp_in, row0, fq, mu, rs);
        asm volatile("" ::: "memory");
#pragma unroll
        for (int bj = 0; bj < 2; ++bj) {
            const int cb = u.pn * BM + bj * HALF + wc * 32 + 8 * fq;
            f32x4 gv[2], bv[2];
#pragma unroll
            for (int n = 0; n < 2; ++n) { gv[n] = *(const f32x4*)(g + cb + 4 * n); bv[n] = *(const f32x4*)(b + cb + 4 * n) * ALPHA; }
#pragma unroll
            for (int ai = 0; ai < 2; ++ai) {
                u32x4 old[4];
#pragma unroll
                for (int m = 0; m < 4; ++m) old[m] = *(const u32x4*)(R + (size_t)(row0 + ai * HALF + m * 16) * D + cb);
#pragma unroll
                for (int m = 0; m < 4; ++m) {
                    const float A_ = ALPHA * rs[ai][m], B_ = -mu[ai][m] * A_;
                    const size_t off = (size_t)(row0 + ai * HALF + m * 16) * D + cb;
                    const u32x4 o = old[m];
                    const float ro[8] = {bf_lo(o.x), bf_hi(o.x), bf_lo(o.y), bf_hi(o.y), bf_lo(o.z), bf_hi(o.z), bf_lo(o.w), bf_hi(o.w)};
                    float nv[8];
#pragma unroll
                    for (int n = 0; n < 2; ++n)
#pragma unroll
                        for (int j = 0; j < 4; ++j) nv[4 * n + j] = (ro[4 * n + j] * A_ + B_) * gv[n][j] + bv[n][j] + coef * acc[ai][bj][m][n][j];
                    u32x4 w; w.x = cvt_pk_bf16(nv[0], nv[1]); w.y = cvt_pk_bf16(nv[2], nv[3]); w.z = cvt_pk_bf16(nv[4], nv[5]); w.w = cvt_pk_bf16(nv[6], nv[7]);
                    *(u32x4*)(Ro + off) = w;
                    *(u32x2*)(R8 + off) = cvt8_f8(nv, F8_SR);
                    const float f0 = bf_lo(w.x), f1 = bf_hi(w.x), f2 = bf_lo(w.y), f3 = bf_hi(w.y), f4 = bf_lo(w.z), f5 = bf_hi(w.z), f6 = bf_lo(w.w), f7 = bf_hi(w.w);
                    float s = ((f0 + f1) + (f2 + f3)) + ((f4 + f5) + (f6 + f7));
                    float q = ((f0 * f0 + f1 * f1) + (f2 * f2 + f3 * f3)) + ((f4 * f4 + f5 * f5) + (f6 * f6 + f7 * f7));
                    s = sum_fq(s); q = sum_fq(q);
                    if (fq == 0) *(PG8_LAS f32x2v*)(tab + (((ai * HALF + wr * 64 + m * 16 + fr) * 4 + wc) * 2 + bj) * 2) = (f32x2v){s, q};
                }
                asm volatile("" ::: "memory");
            }
        }
        asm volatile("s_waitcnt lgkmcnt(0)" ::: "memory"); __builtin_amdgcn_s_barrier(); asm volatile("" ::: "memory");
        const int tid = wave * 64 + pg8_lane();
        if (tid < BM) {
            const PG8_LAS f32x4* t4 = (const PG8_LAS f32x4*)(tab + tid * 16);
            const f32x4 a = t4[0], c = t4[1], d = t4[2], e = t4[3];
            *(f32x2v*)(sp_out + (size_t)(u.pm * BM + tid) * 16 + u.pn * 2) = (f32x2v){((a[0] + a[2]) + (c[0] + c[2])) + ((d[0] + d[2]) + (e[0] + e[2])), ((a[1] + a[3]) + (c[1] + c[3])) + ((d[1] + d[3]) + (e[1] + e[3]))};
        }
    }
};

template <class Epi, class Sched, bool ALIGN_EPI = false, bool SP2 = false, bool F8 = false>
__device__ __forceinline__ void gemm_phase(PG8_LAS unsigned char* lds, const Gemm g, const Sched& S, const Epi& E, int wave_in) {
    int wid = wave_in; asm volatile("" : "+s"(wid));
    const int lane = pg8_lane(), tid = wid * 64 + lane, wr = wid >> 2, wc = wid & 3, fr = lane & 15, fq = lane >> 4;
    const int K = g.K, nt = K / BK;
    unsigned voffA[2], voffB[2];
#pragma unroll
    for (int i = 0; i < 2; ++i) { int R, C; stage_rc(tid * 16 + i * 8192, R, C); const int Rb = Epi::PERM ? ((R & ~31) + perm32(R & 31)) : R;
        voffA[i] = (unsigned)(R * K + C) * 2u; voffB[i] = (unsigned)(Rb * K + C) * 2u; }
    const size_t kstep = (size_t)(BK * 2);
    const size_t hstep = (size_t)HALF * K * 2;
    const size_t tstep = 2 * hstep;
    const unsigned ldsw = (unsigned)wid * 1024u;
    const int aoff = lds_byte(wr * 64 + fr, fq * 8), boff = lds_byte(wc * 32 + fr, fq * 8);
#define PG8_SA(b, h) (((b) * 2 + (h)) * HTB)
#define PG8_SB(b, h) ((4 + (b) * 2 + (h)) * HTB)
#define PG8_STAGE(bufoff, gbase, voff) do { _Pragma("unroll") for (int _i = 0; _i < 2; ++_i) \
        __builtin_amdgcn_global_load_lds((const unsigned*)((const char*)(gbase) + (voff)[_i]), (PG8_LAS unsigned*)(lds + (bufoff) + ldsw + _i * 8192), 16, 0, 0); } while (0)
#define PG8_LDA(dst, b, h) do { _Pragma("unroll") for (int m = 0; m < 4; ++m) _Pragma("unroll") for (int k = 0; k < 2; ++k) dst[m][k] = *(const PG8_LAS bf16x8*)(lds + PG8_SA(b, h) + aoff + m * 2048 + k * 1024); } while (0)
#define PG8_LDB(dst, b, h) do { _Pragma("unroll") for (int n = 0; n < 2; ++n) _Pragma("unroll") for (int k = 0; k < 2; ++k) dst[n][k] = *(const PG8_LAS bf16x8*)(lds + PG8_SB(b, h) + boff + n * 2048 + k * 1024); } while (0)
#define PG8_MMA(ai, bj, At, Bt) do { __builtin_amdgcn_s_setprio(1); _Pragma("unroll") for (int m = 0; m < 4; ++m) _Pragma("unroll") for (int n = 0; n < 2; ++n) { \
        if constexpr (F8) mfma_f8_inplace(acc[ai][bj][m][n], cat_i8(Bt[n][0], Bt[n][1]), cat_i8(At[m][0], At[m][1])); \
        else { _Pragma("unroll") for (int k = 0; k < 2; ++k) acc[ai][bj][m][n] = __builtin_amdgcn_mfma_f32_16x16x32_f16(__builtin_bit_cast(f16x8, Bt[n][k]), __builtin_bit_cast(f16x8, At[m][k]), acc[ai][bj][m][n], 0, 0, 0); } } \
        __builtin_amdgcn_s_setprio(0); } while (0)
#define PG8_WAIT_V(n) asm volatile("s_waitcnt vmcnt(" #n ")" ::: "memory")
#define PG8_WAIT_L(n) asm volatile("s_waitcnt lgkmcnt(" #n ")" ::: "memory")
#define PG8_BAR __builtin_amdgcn_s_barrier()
#define PG8_SCHED __builtin_amdgcn_sched_barrier(0)
    Unit cur, nxt; int ui = 0;
    if (!S.next(0, cur)) return;
    f32x4 acc[2][2][4][2];
#pragma unroll
    for (int a = 0; a < 2; ++a)
#pragma unroll
        for (int b = 0; b < 2; ++b)
#pragma unroll
            for (int m = 0; m < 4; ++m)
#pragma unroll
                for (int n = 0; n < 2; ++n) { float z0, z1, z2, z3; asm volatile("v_mov_b32 %0, 0\n\tv_mov_b32 %1, 0\n\tv_mov_b32 %2, 0\n\tv_mov_b32 %3, 0" : "=v"(z0), "=v"(z1), "=v"(z2), "=v"(z3)); acc[a][b][m][n] = (f32x4){z0, z1, z2, z3}; }
    bf16x8 At[4][2], B0[2][2], B1[2][2];
    const char* cA = (const char*)g.A + (size_t)cur.pm * tstep; const char* cB = (const char*)g.Bt + (size_t)cur.pn * tstep;
    S.a_ready(cur);
    if constexpr (SP2) {
        PG8_STAGE(PG8_SB(0, 0), cB, voffB); PG8_STAGE(PG8_SB(0, 1), cB + hstep, voffB); PG8_STAGE(PG8_SA(0, 0), cA, voffA); PG8_STAGE(PG8_SA(0, 1), cA + hstep, voffA);
        if (wr == 1) PG8_BAR;
        PG8_WAIT_V(2); PG8_BAR;
        PG8_STAGE(PG8_SB(1, 0), cB + kstep, voffB); PG8_STAGE(PG8_SA(1, 0), cA + kstep, voffA); PG8_STAGE(PG8_SB(1, 1), cB + hstep + kstep, voffB);
        PG8_WAIT_V(6); PG8_BAR;
    } else {
        PG8_STAGE(PG8_SB(0, 0), cB, voffB); PG8_STAGE(PG8_SA(0, 0), cA, voffA); PG8_STAGE(PG8_SB(0, 1), cB + hstep, voffB); PG8_STAGE(PG8_SA(0, 1), cA + hstep, voffA);
        if (wr == 1) PG8_BAR;
        PG8_WAIT_V(4); PG8_BAR;
        PG8_STAGE(PG8_SB(1, 0), cB + kstep, voffB); PG8_STAGE(PG8_SA(1, 0), cA + kstep, voffA); PG8_STAGE(PG8_SB(1, 1), cB + hstep + kstep, voffB);
        PG8_WAIT_V(6); PG8_BAR;
    }
    for (;;) {
        const bool has_next = S.next(ui + 1, nxt);
        const char* nA = has_next ? (const char*)g.A + (size_t)nxt.pm * tstep : cA; const char* nB = has_next ? (const char*)g.Bt + (size_t)nxt.pn * tstep : cB;
        for (int t = 0; t < nt; t += 2) {
            const bool last = (t == nt - 2);
            const char* a1 = cA + (size_t)(t + 1) * kstep;
            const char* a2 = last ? nA : cA + (size_t)(t + 2) * kstep; const char* b2 = last ? nB : cB + (size_t)(t + 2) * kstep;
            const char* a3 = a2 + kstep; const char* b3 = b2 + kstep;
            if (last && has_next) S.a_ready(nxt);
            if constexpr (SP2) {
            PG8_LDB(B0, 0, 0); PG8_LDB(B1, 0, 1); PG8_SCHED; PG8_LDA(At, 0, 0); PG8_STAGE(PG8_SA(1, 1), a1 + hstep, voffA);
            PG8_WAIT_V(8); PG8_WAIT_L(0); PG8_BAR; PG8_MMA(0, 0, At, B0); PG8_MMA(0, 1, At, B1); PG8_BAR; PG8_SCHED;
            PG8_LDA(At, 0, 1); PG8_STAGE(PG8_SB(0, 0), b2, voffB); PG8_STAGE(PG8_SB(0, 1), b2 + hstep, voffB); PG8_STAGE(PG8_SA(0, 0), a2, voffA);
            PG8_WAIT_V(8); PG8_WAIT_L(0); PG8_BAR; PG8_MMA(1, 0, At, B0); PG8_MMA(1, 1, At, B1); PG8_BAR; PG8_SCHED;
            PG8_LDB(B0, 1, 0); PG8_LDB(B1, 1, 1); PG8_SCHED; PG8_LDA(At, 1, 0); PG8_STAGE(PG8_SA(0, 1), a2 + hstep, voffA);
            PG8_WAIT_V(8); PG8_WAIT_L(0); PG8_BAR; PG8_MMA(0, 0, At, B0); PG8_MMA(0, 1, At, B1); PG8_BAR; PG8_SCHED;
            PG8_LDA(At, 1, 1); PG8_STAGE(PG8_SB(1, 0), b3, voffB); PG8_STAGE(PG8_SB(1, 1), b3 + hstep, voffB); PG8_STAGE(PG8_SA(1, 0), a3, voffA);
            PG8_WAIT_V(8); PG8_WAIT_L(0); PG8_BAR; PG8_MMA(1, 0, At, B0); PG8_MMA(1, 1, At, B1); PG8_BAR; PG8_SCHED;
            } else {
            PG8_LDB(B0, 0, 0); PG8_SCHED; PG8_LDA(At, 0, 0); PG8_STAGE(PG8_SA(1, 1), a1 + hstep, voffA);
            PG8_WAIT_L(8); PG8_BAR; PG8_WAIT_L(0); PG8_MMA(0, 0, At, B0); PG8_BAR; PG8_SCHED;
            PG8_LDB(B1, 0, 1); PG8_STAGE(PG8_SB(0, 0), b2, voffB);
            PG8_BAR; PG8_WAIT_L(0); PG8_MMA(0, 1, At, B1); PG8_BAR;
            PG8_LDA(At, 0, 1); PG8_STAGE(PG8_SA(0, 0), a2, voffA);
            PG8_BAR; PG8_WAIT_L(0); PG8_MMA(1, 0, At, B0); PG8_BAR; PG8_SCHED;
            PG8_STAGE(PG8_SB(0, 1), b2 + hstep, voffB);
            PG8_WAIT_V(6); PG8_BAR; PG8_MMA(1, 1, At, B1); PG8_BAR;
            PG8_LDB(B0, 1, 0); PG8_SCHED; PG8_LDA(At, 1, 0); PG8_STAGE(PG8_SA(0, 1), a2 + hstep, voffA);
            PG8_WAIT_L(8); PG8_BAR; PG8_WAIT_L(0); PG8_MMA(0, 0, At, B0); PG8_BAR; PG8_SCHED;
            PG8_LDB(B1, 1, 1); PG8_STAGE(PG8_SB(1, 0), b3, voffB);
            PG8_BAR; PG8_WAIT_L(0); PG8_MMA(0, 1, At, B1); PG8_BAR;
            PG8_LDA(At, 1, 1); PG8_STAGE(PG8_SA(1, 0), a3, voffA);
            PG8_BAR; PG8_WAIT_L(0); PG8_MMA(1, 0, At, B0); PG8_BAR; PG8_SCHED;
            PG8_STAGE(PG8_SB(1, 1), b3 + hstep, voffB);
            PG8_WAIT_V(6); PG8_BAR; PG8_MMA(1, 1, At, B1); PG8_BAR;
            }
        }
        if constexpr (F8) asm volatile("s_nop 15\n\ts_nop 7" ::: "memory");
        if constexpr (ALIGN_EPI) { if (wr == 0) PG8_BAR; }
        if constexpr (!Epi::AFTER_DRAIN) { E(acc, cur, wr, wc, fr, fq); S.done(cur); }
        if (!has_next) break;
#pragma unroll
        for (int a = 0; a < 2; ++a)
#pragma unroll
            for (int b = 0; b < 2; ++b)
#pragma unroll
                for (int m = 0; m < 4; ++m)
#pragma unroll
                    for (int n = 0; n < 2; ++n) { float z0, z1, z2, z3; asm volatile("v_mov_b32 %0, 0\n\tv_mov_b32 %1, 0\n\tv_mov_b32 %2, 0\n\tv_mov_b32 %3, 0" : "=v"(z0), "=v"(z1), "=v"(z2), "=v"(z3)); acc[a][b][m][n] = (f32x4){z0, z1, z2, z3}; }
        cur = nxt; cA = nA; cB = nB; ++ui;
        if constexpr (ALIGN_EPI) { if (wr == 1) PG8_BAR; }
    }
    PG8_WAIT_V(0);
    if constexpr (!ALIGN_EPI) { if (wr == 0) PG8_BAR; }
    PG8_BAR;
    if constexpr (Epi::AFTER_DRAIN) { E.fused(acc, cur, wr, wc, fr, fq, lds, wid, lane); S.done(cur); }
#undef PG8_SA
#undef PG8_SB
#undef PG8_STAGE
#undef PG8_LDA
#undef PG8_LDB
#undef PG8_MMA
#undef PG8_WAIT_V
#undef PG8_WAIT_L
#undef PG8_BAR
#undef PG8_SCHED
}
}

#ifndef PG8_SP2
#define PG8_SP2 true
#endif

#define GAS __attribute__((address_space(1)))
#define LAS __attribute__((address_space(3)))
typedef unsigned short bf16;
typedef unsigned v4u __attribute__((ext_vector_type(4)));
typedef unsigned v2u __attribute__((ext_vector_type(2)));
typedef float f32x4 __attribute__((ext_vector_type(4)));
typedef float f32x2 __attribute__((ext_vector_type(2)));
typedef float f32x16 __attribute__((ext_vector_type(16)));
typedef short bf16x8 __attribute__((ext_vector_type(8)));
typedef short s16x4 __attribute__((ext_vector_type(4)));
typedef GAS unsigned gu32;
typedef GAS unsigned long long gu64;
typedef LAS const char* lcp;
typedef LAS char* lwp;
#define RLX_AGENT __ATOMIC_RELAXED, __HIP_MEMORY_SCOPE_AGENT
#define LDS_WAIT() asm volatile("s_waitcnt lgkmcnt(0)" ::: "memory")
#define VM_WAIT() asm volatile("s_waitcnt vmcnt(0)" ::: "memory")
#define WG_BAR() do { asm volatile("s_waitcnt vmcnt(0) lgkmcnt(0)" ::: "memory"); __builtin_amdgcn_s_barrier(); asm volatile("" ::: "memory"); } while (0)
#define DI __device__ __forceinline__
#define MFMA32(a, b, c) __builtin_amdgcn_mfma_f32_32x32x16_f16(__builtin_bit_cast(pg8::f16x8, (a)), __builtin_bit_cast(pg8::f16x8, (b)), (c), 0, 0, 0)
DI unsigned pk2(float lo, float hi) { return pg8::cvt_pk_bf16(lo, hi); }
DI float bflo(unsigned w) { return pg8::bf_lo(w); }
DI float bfhi(unsigned w) { return pg8::bf_hi(w); }
DI float ex2(float x) { return __builtin_amdgcn_exp2f(x); }
DI f32x16 zero16() { float z = 0.f; asm volatile("" : "+v"(z)); return (f32x16){z, z, z, z, z, z, z, z, z, z, z, z, z, z, z, z}; }
DI int crow(int r, int hi) { return (r & 3) + 8 * (r >> 2) + 4 * hi; }
#define SWZ_XOR(v, m) __uint_as_float((unsigned)__builtin_amdgcn_ds_swizzle((int)__float_as_uint(v), ((m) << 10) | 0x1f))
DI float half_swap_add(float v);
DI float wave_sum(float v) { v += SWZ_XOR(v, 1); v += SWZ_XOR(v, 2); v += SWZ_XOR(v, 4); v += SWZ_XOR(v, 8); v += SWZ_XOR(v, 16); return half_swap_add(v); }
DI float shfl_lane(float v, int src_lane) { return __uint_as_float((unsigned)__builtin_amdgcn_ds_bpermute(src_lane << 2, (int)__float_as_uint(v))); }
DI float half_swap_add(float v) { auto rr = __builtin_amdgcn_permlane32_swap(__float_as_uint(v), __float_as_uint(v), false, false); return __uint_as_float(rr[0]) + __uint_as_float(rr[1]); }
DI float half_swap_max(float v) { auto rr = __builtin_amdgcn_permlane32_swap(__float_as_uint(v), __float_as_uint(v), false, false); return fmaxf(__uint_as_float(rr[0]), __uint_as_float(rr[1])); }
typedef short v4i16_t __attribute__((ext_vector_type(4)));
DI s16x4 vtr(lcp p) { return __builtin_bit_cast(s16x4, __builtin_amdgcn_ds_read_tr16_b64_v4i16((LAS v4i16_t*)p)); }
DI bf16x8 cat8(s16x4 lo, s16x4 hi) { return (bf16x8){lo[0], lo[1], lo[2], lo[3], hi[0], hi[1], hi[2], hi[3]}; }
DI bf16x8 trfrag(lcp p) { return cat8(vtr(p), vtr(p + 512)); }
DI bf16x8 ldfrag(lcp p) { return *(const LAS bf16x8*)p; }
DI void glds16(const void* gsrc, LAS void* ldst) { __builtin_amdgcn_global_load_lds((const unsigned*)gsrc, (LAS unsigned*)ldst, 16, 0, 0); }
#define PACK8(x, s) ((bf16x8)__builtin_bit_cast(bf16x8, (v4u){pk2((x)[8 * (s) + 0], (x)[8 * (s) + 1]), pk2((x)[8 * (s) + 2], (x)[8 * (s) + 3]), pk2((x)[8 * (s) + 4], (x)[8 * (s) + 5]), pk2((x)[8 * (s) + 6], (x)[8 * (s) + 7])}))

constexpr int RING_OFF = 0, RING_BYTES = 131072;
constexpr int TAB_OFF = 131072;
constexpr int MISC_OFF = 163840 - 256;
constexpr int LDS_BYTES = 163840;
constexpr int AT_K = 0, AT_V = 32768, AT_WS = 65536, AT_STG = 67584;
constexpr int ML_K = 0, ML_V = 65536, ML_VW = 81920, ML_C = 98304, ML_N = 131072, ML_G2 = 131584, ML_M2 = 132096, ML_FI = 132608, ML_EI = 133120, ML_WK = 133632, ML_WKB = 134144, ML_SC = 134400, ML_WS = 134464, ML_STG = 136512;
static_assert(ML_STG + 4 * 4096 <= MISC_OFF && AT_STG + 8 * 4096 <= MISC_OFF && TAB_OFF + 16384 <= MISC_OFF, "LDS map");

#define XB_TMO      128
#define XB_XCNT(j)  (256  + 64 * (j))
#define XB_XSUB(j)  (1280 + 64 * (j))
#define XB_XGEN(j)  (2304 + 64 * (j))
#define XB_TOP      3328
#define XB_TOPGEN   3392
#define XCD_BAR_WORDS 3456
#define XB_SPIN_CAP (1u << 18)

__device__ __forceinline__ unsigned xb_ld(unsigned* p)              { return __hip_atomic_load(p, __ATOMIC_RELAXED, __HIP_MEMORY_SCOPE_AGENT); }
__device__ __forceinline__ unsigned xb_add(unsigned* p, unsigned v) { return __hip_atomic_fetch_add(p, v, __ATOMIC_RELAXED, __HIP_MEMORY_SCOPE_AGENT); }
__device__ __forceinline__ unsigned xb_xcc_id() { return (unsigned)__builtin_amdgcn_s_getreg((3 << 11) | 20) & 0xFu; }
#define XB_SPIN(cond, bar) do { unsigned _sp = 0; while (cond) { __builtin_amdgcn_s_sleep(1); \
    if ((++_sp & 255u) == 0u) { if (xb_ld(&(bar)[XB_TMO])) break; if (_sp > XB_SPIN_CAP) { atomicAdd(&(bar)[XB_TMO], 1u); break; } } } } while (0)

struct XcdBarrier {
    unsigned* bar; unsigned x;
    volatile LAS unsigned* st;
};

__device__ __forceinline__ XcdBarrier xcd_barrier_post(unsigned* bar, volatile LAS unsigned* st) {
    XcdBarrier b; b.bar = bar; b.x = xb_xcc_id(); b.st = st;
    if (threadIdx.x == 0) (void)xb_add(&bar[XB_XCNT(b.x)], 1u);
    return b;
}
__device__ __forceinline__ void xcd_barrier_complete(unsigned* bar, unsigned x, unsigned& nloc, unsigned& nx) {
    const unsigned G = gridDim.x * gridDim.y * gridDim.z;
    unsigned sum, cnt, mine, sp = 0u;
    for (;;) {
        sum = 0u; cnt = 0u; mine = 0u;
#pragma unroll
        for (unsigned j = 0; j < 16; ++j) { const unsigned c = xb_ld(&bar[XB_XCNT(j)]); sum += c; cnt += (c > 0u) ? 1u : 0u; mine = (j == x) ? c : mine; }
        if (sum == G) break;
        __builtin_amdgcn_s_sleep(1);
        if ((++sp & 255u) == 0u) { if (xb_ld(&bar[XB_TMO])) break; if (sp > XB_SPIN_CAP) { atomicAdd(&bar[XB_TMO], 1u); break; } }
    }
    nloc = mine > 0u ? mine : 1u; nx = cnt > 0u ? cnt : 1u;
}

__device__ __forceinline__ void xcd_barrier(const XcdBarrier& b) {
    asm volatile("s_waitcnt vmcnt(0)" ::: "memory");
    __syncthreads();
    if (threadIdx.x == 0) {
        unsigned* bar = b.bar;
        __builtin_amdgcn_s_waitcnt(0);
        unsigned nloc = b.st[0], nx = b.st[1];
        if (nloc == 0u) { xcd_barrier_complete(bar, b.x, nloc, nx); b.st[0] = nloc; b.st[1] = nx; }
        const unsigned old = xb_add(&bar[XB_XSUB(b.x)], 1u);
        const unsigned gen = old / nloc;
        if (old + 1u == (gen + 1u) * nloc) {
            __builtin_amdgcn_fence(__ATOMIC_RELEASE, "agent");
            asm volatile("s_waitcnt vmcnt(0)" ::: "memory");
            const unsigned og = xb_add(&bar[XB_TOP], 1u);
            const unsigned tg = og / nx;
            if (og + 1u == (tg + 1u) * nx) xb_add(&bar[XB_TOPGEN], 1u);
            else XB_SPIN(xb_ld(&bar[XB_TOPGEN]) == tg, bar);
            __builtin_amdgcn_fence(__ATOMIC_ACQUIRE, "agent");
            xb_add(&bar[XB_XGEN(b.x)], 1u);
            asm volatile("s_waitcnt vmcnt(0)" ::: "memory");
        } else {
            XB_SPIN(xb_ld(&bar[XB_XGEN(b.x)]) == gen, bar);
            __builtin_amdgcn_fence(__ATOMIC_ACQUIRE, "agent");
            asm volatile("s_waitcnt vmcnt(0)" ::: "memory");
        }
    }
    __syncthreads();
}
DI void attn_phase(unsigned char* ldsg, const bf16* QKV, unsigned char* AO8, const float* sinks, int G, int bid, int wave_in) {
    int wid = wave_in; asm volatile("" : "+s"(wid));
    const int lane = pg8::pg8_lane(), tid = wid * 64 + lane, r32 = lane & 31, hi = lane >> 5;
    LAS unsigned char* lds = (LAS unsigned char*)ldsg; const lcp L = (lcp)lds;
    LAS float* wsf = (LAS float*)(lds + AT_WS) + wid * 64;
    LAS unsigned char* stg = lds + AT_STG + wid * 4096;
    const lcp vlane = L + AT_V + ((lane >> 4) & 1) * 32 + (lane & 3) * 8 + (4 * hi + ((lane & 15) >> 2)) * 64;
    const lcp klane = L + AT_K + hi * 1024 + r32 * 16;
    for (int unit = bid; unit < BATCH * 16 * 4; unit += G) {
        const int kvh = unit & 3, nb = (unit >> 2) & 15, b = unit >> 6;
        const long rowq = (long)b * SEQ + nb * 128, rowk = rowq - 128;
        const int slot_lo = (nb == 0) ? 2 : 0;
        for (int sl = slot_lo; sl < 4; ++sl) {
            glds16(QKV + (rowk + 64 * sl + lane) * NQKV + 2048 + 64 * kvh + 8 * wid, lds + AT_K + sl * 8192 + wid * 1024);
            glds16(QKV + (rowk + 64 * sl + 16 * (wid & 3) + (lane >> 2)) * NQKV + 2304 + 64 * kvh + (wid >> 2) * 32 + (lane & 3) * 8, lds + AT_V + sl * 8192 + wid * 1024);
        }
        const int hq = 8 * kvh + wid;
        const bf16* qsrc = QKV + (rowq + r32) * NQKV + 64 * hq + 8 * hi;
        bf16x8 qn[4];
#pragma unroll
        for (int d0 = 0; d0 < 4; ++d0) qn[d0] = *(const bf16x8*)(qsrc + 16 * d0);
        const float slope2 = ex2(-0.25f * (float)(hq + 1)) * LOG2E, sink2 = sinks[hq] * LOG2E;
        const float base_l = -slope2 * (float)(r32 - 4 * hi);
        WG_BAR();
#pragma unroll 1
        for (int j = 0; j < 4; ++j) {
            const int ilo = (nb == 0) ? 4 - j : 0;
            bf16x8 qr[4];
#pragma unroll
            for (int d0 = 0; d0 < 4; ++d0) qr[d0] = qn[d0];
            if (j < 3) {
#pragma unroll
                for (int d0 = 0; d0 < 4; ++d0) qn[d0] = *(const bf16x8*)(qsrc + (size_t)(32 * (j + 1)) * NQKV + 16 * d0);
            }
            float sl2 = slope2, bl = base_l; asm volatile("" : "+v"(sl2), "+v"(bl));
            f32x16 p[5];
#pragma unroll
            for (int i = 0; i < 5; ++i) {
                if (i >= ilo) {
                    const int kt = j + i; const lcp kb = klane + (kt >> 1) * 8192 + (kt & 1) * 512;
                    f32x16 a = zero16();
#pragma unroll
                    for (int d0 = 0; d0 < 4; ++d0) a = MFMA32(ldfrag(kb + d0 * 2048), qr[d0], a);
#pragma unroll
                    for (int r = 0; r < 16; ++r) {
                        const int cr = (r & 3) + 8 * (r >> 2);
                        float s = fmaf(sl2, (float)(cr - 128 + 32 * i), fmaf(a[r], LOG2E, bl));
                        if (i == 0) { if (!(cr + 4 * hi > r32)) s = -INFINITY; }
                        if (i == 4) { if (!(cr + 4 * hi <= r32)) s = -INFINITY; }
                        a[r] = s;
                    }
                    p[i] = a;
                } else {
#pragma unroll
                    for (int r = 0; r < 16; ++r) p[i][r] = -INFINITY;
                }
            }
            float mx = sink2;
#pragma unroll
            for (int i = 0; i < 5; ++i)
#pragma unroll
                for (int r = 0; r < 16; ++r) mx = fmaxf(mx, p[i][r]);
            mx = half_swap_max(mx);
            float ls = 0.f;
#pragma unroll
            for (int i = 0; i < 5; ++i)
#pragma unroll
                for (int r = 0; r < 16; ++r) { const float e = ex2(p[i][r] - mx); p[i][r] = e; ls += e; }
            ls = half_swap_add(ls) + ex2(sink2 - mx);
            f32x16 o0 = zero16(), o1 = zero16();
#pragma unroll
            for (int i = 0; i < 5; ++i) {
                if (i >= ilo) {
                    const int kt = j + i; const lcp vb = vlane + (kt >> 1) * 8192 + (kt & 1) * 2048;
                    const bf16x8 pa = PACK8(p[i], 0), pb = PACK8(p[i], 1);
                    o0 = MFMA32(pa, trfrag(vb), o0);        o0 = MFMA32(pb, trfrag(vb + 1024), o0);
                    o1 = MFMA32(pa, trfrag(vb + 4096), o1); o1 = MFMA32(pb, trfrag(vb + 4096 + 1024), o1);
                }
            }
            if (hi == 0) wsf[r32] = __builtin_amdgcn_rcpf(ls);
#pragma unroll
            for (int r = 0; r < 16; ++r) {
                const int orow = crow(r, hi); const float rl = wsf[orow] * pg8::F8_SO;
                int pk; asm volatile("" : "=v"(pk)); pk = __builtin_amdgcn_cvt_pk_fp8_f32(o0[r] * rl, o1[r] * rl, pk, false);
                stg[orow * 64 + r32] = (unsigned char)(pk & 0xff);
                stg[orow * 64 + 32 + r32] = (unsigned char)((pk >> 8) & 0xff);
            }
#pragma unroll
            for (int i4 = 0; i4 < 2; ++i4) {
                const int row = i4 * 16 + (lane >> 2), ch = lane & 3;
                const v4u v = *(const LAS v4u*)(stg + row * 64 + ch * 16);
                *(v4u*)(AO8 + (rowq + 32 * j + row) * D + 64 * hq + ch * 16) = v;
            }
        }
        WG_BAR();
    }
}

DI void mlstm_phase(unsigned char* ldsg, const bf16* MP, const float* GT, bf16* HG, int G, int bid, int wave_in) {
    int wid = wave_in; asm volatile("" : "+s"(wid));
    const int lane0 = pg8::pg8_lane(), tid = wid * 64 + lane0;
    LAS unsigned char* lds = (LAS unsigned char*)ldsg; const lcp L = (lcp)lds;
    LAS float* G2 = (LAS float*)(lds + ML_G2); LAS float* M2 = (LAS float*)(lds + ML_M2); LAS float* FI = (LAS float*)(lds + ML_FI); LAS float* EI = (LAS float*)(lds + ML_EI);
    LAS float* WK = (LAS float*)(lds + ML_WK); LAS bf16* WKB = (LAS bf16*)(lds + ML_WKB); LAS float* SC = (LAS float*)(lds + ML_SC);
    LAS float* wsf = (LAS float*)(lds + ML_WS) + wid * 64;
    for (int unit = bid; unit < BATCH * 4 * 8; unit += G) {
        const int sl = unit & 7, h = (unit >> 3) & 3, b = unit >> 5;
        const bf16* Qp = MP + 256 * h; const bf16* Kp = MP + 1024 + 256 * h; const bf16* Vp = MP + 2048 + 512 * h + 64 * sl; const bf16* OGp = MP + 4096 + 512 * h + 64 * sl;
        { unsigned z = 0u; asm volatile("" : "+v"(z)); for (int i = tid; i < (32768 + 512) / 16; i += 512) *(LAS v4u*)(lds + ML_C + i * 16) = (v4u){z, z, z, z}; }
        f32x16 T[6];
#pragma unroll
        for (int x = 0; x < 6; ++x) T[x] = zero16();
        float m_prev = 0.f;
        WG_BAR();
        for (int c = 0; c < 16; ++c) {
            const long row0 = (long)b * SEQ + 128 * c;
            const int lane = pg8::pg8_lane(), r32 = lane & 31, hi = lane >> 5;
            const int blk = (lane >> 4) & 1, q4 = (lane & 15) >> 2, p4 = lane & 3;
            const int vlo_ = blk * 32 + p4 * 8 + (4 * hi + q4) * 64;
            const int ktl_ = (2 * blk + (p4 >> 1)) * 2048 + (q4 + 4 * hi) * 16 + (p4 & 1) * 8;
            const int cbl_ = hi * 1024 + r32 * 16, kbl_ = hi * 2048 + r32 * 16;
            const unsigned m0 = (r32 == 0) ? 0xffffffffu : 0u; const v4u m0v = {m0, m0, m0, m0};
#pragma unroll
            for (int i = 0; i < 8; ++i) { const int chunk = 4 * wid + (i >> 1), half = i & 1;
                glds16(Kp + (row0 + 64 * half + lane) * NMI + chunk * 8, lds + ML_K + chunk * 2048 + half * 1024); }
            v4u vreg[2];
#pragma unroll
            for (int i = 0; i < 2; ++i) vreg[i] = *(const v4u*)(Vp + (row0 + 64 * i + 16 * (wid & 3) + (lane >> 2)) * NMI + (wid >> 2) * 32 + (lane & 3) * 8);
            bf16x8 qf[16];
            if (wid < 4) {
#pragma unroll
                for (int ks = 0; ks < 16; ++ks) qf[ks] = *(const bf16x8*)(Qp + (row0 + 32 * wid + r32) * NMI + 16 * ks + 8 * hi);
            }
            if (wid == 0) {
                const float* gp = GT + (size_t)(row0 + 2 * lane) * 8;
                const float i0 = gp[h], f0 = gp[4 + h], i1 = gp[8 + h], f1 = gp[12 + h];
                const float lf0 = -logf(1.f + expf(-f0)), lf1 = -logf(1.f + expf(-f1));
                float incl = lf0 + lf1;
#pragma unroll
                for (int o = 1; o < 64; o <<= 1) { const float t = shfl_lane(incl, lane - o); if (lane >= o) incl += t; }
                const float b1 = incl, b0 = incl - lf1;
                const float g0 = i0 - b0, g1 = i1 - b1;
                float cm = fmaxf(g0, g1);
#pragma unroll
                for (int o = 1; o < 64; o <<= 1) { const float t = shfl_lane(cm, lane - o); if (lane >= o) cm = fmaxf(cm, t); }
                float cprev = shfl_lane(cm, lane - 1); if (lane == 0) cprev = -INFINITY;
                const float M0 = fmaxf(m_prev, fmaxf(cprev, g0)), M1 = fmaxf(m_prev, cm);
                const float Mend = shfl_lane(M1, 63), blast = shfl_lane(b1, 63);
                *(LAS f32x2*)(G2 + 2 * lane) = (f32x2){g0 * LOG2E, g1 * LOG2E};
                *(LAS f32x2*)(M2 + 2 * lane) = (f32x2){M0 * LOG2E, M1 * LOG2E};
                *(LAS f32x2*)(FI + 2 * lane) = (f32x2){ex2((m_prev - M0) * LOG2E), ex2((m_prev - M1) * LOG2E)};
                *(LAS f32x2*)(EI + 2 * lane) = (f32x2){ex2(-(b0 + M0) * LOG2E), ex2(-(b1 + M1) * LOG2E)};
                const float w0 = ex2((g0 - Mend) * LOG2E), w1 = ex2((g1 - Mend) * LOG2E);
                *(LAS f32x2*)(WK + 2 * lane) = (f32x2){w0, w1};
                *(LAS unsigned*)(WKB + 2 * lane) = pk2(w0, w1);
                if (lane == 0) SC[0] = ex2((m_prev - Mend) * LOG2E);
                m_prev = blast + Mend;
            }
            VM_WAIT();
#pragma unroll
            for (int i = 0; i < 2; ++i) *(LAS v4u*)(lds + ML_V + i * 8192 + wid * 1024 + lane * 16) = vreg[i];
            WG_BAR();
#pragma unroll
            for (int i = 0; i < 2; ++i) { const float w = WK[64 * i + 16 * (wid & 3) + (lane >> 2)]; const v4u v = vreg[i]; v4u o;
                o.x = pk2(bflo(v.x) * w, bfhi(v.x) * w); o.y = pk2(bflo(v.y) * w, bfhi(v.y) * w); o.z = pk2(bflo(v.z) * w, bfhi(v.z) * w); o.w = pk2(bflo(v.w) * w, bfhi(v.w) * w);
                *(LAS v4u*)(lds + ML_VW + i * 8192 + wid * 1024 + lane * 16) = o; }
            WG_BAR();
            if (wid < 4) {
                const int tt = wid;
                T[0] = zero16(); T[1] = zero16(); T[2] = zero16();
                { const lcp cb = L + ML_C + cbl_; const lcp nbp = L + ML_N + 16 * hi;
#pragma unroll
                  for (int ks = 0; ks < 16; ++ks) {
                      const bf16x8 c0 = ldfrag(cb + ks * 2048), c1 = ldfrag(cb + ks * 2048 + 512);
                      const bf16x8 nf = __builtin_bit_cast(bf16x8, __builtin_bit_cast(v4u, ldfrag(nbp + ks * 32)) & m0v);
                      T[0] = MFMA32(qf[ks], c0, T[0]); T[1] = MFMA32(qf[ks], c1, T[1]); T[2] = MFMA32(qf[ks], nf, T[2]);
                      if ((ks & 3) == 3) __builtin_amdgcn_sched_barrier(0);
                  } }
                { float fi[16];
#pragma unroll
                  for (int r = 0; r < 16; ++r) fi[r] = FI[32 * tt + crow(r, hi)];
#pragma unroll
                  for (int r = 0; r < 16; ++r) { T[0][r] *= fi[r]; T[1][r] *= fi[r]; }
                  if (r32 == 0) {
#pragma unroll
                      for (int r = 0; r < 16; ++r) wsf[crow(r, hi)] = T[2][r] * fi[r];
                  } }
                const float Mt = M2[32 * tt + r32];
                float dsum = 0.f;
                for (int st = 0; st <= tt; ++st) {
                    f32x16 S = zero16();
                    const lcp kb = L + ML_K + kbl_ + st * 512;
#pragma unroll
                    for (int ks = 0; ks < 16; ++ks) S = MFMA32(ldfrag(kb + ks * 4096), qf[ks], S);
#pragma unroll
                    for (int r = 0; r < 16; ++r) {
                        const float w = ex2(G2[32 * st + crow(r, hi)] - Mt);
                        float v = S[r] * w;
                        if (st == tt && crow(r, hi) > r32) v = 0.f;
                        S[r] = v; dsum += v;
                    }
                    const bf16x8 pa = PACK8(S, 0), pb = PACK8(S, 1);
                    const lcp vb = L + ML_V + (st >> 1) * 8192 + (st & 1) * 2048 + vlo_;
                    T[0] = MFMA32(pa, trfrag(vb), T[0]);        T[0] = MFMA32(pb, trfrag(vb + 1024), T[0]);
                    T[1] = MFMA32(pa, trfrag(vb + 4096), T[1]); T[1] = MFMA32(pb, trfrag(vb + 4096 + 1024), T[1]);
                }
                dsum = half_swap_add(dsum);
                { const float den = wsf[r32] + dsum; const float dn = fmaxf(fabsf(den), EI[32 * tt + r32]);
                  if (hi == 0) wsf[32 + r32] = __builtin_amdgcn_rcpf(dn); }
                LAS bf16* stg = (LAS bf16*)(lds + ML_STG + tt * 4096);
#pragma unroll
                for (int r = 0; r < 16; ++r) {
                    const int orow = crow(r, hi); const float rd = wsf[32 + orow];
                    stg[orow * 64 + r32] = (bf16)(pk2(T[0][r] * rd, 0.f) & 0xffffu);
                    stg[orow * 64 + 32 + r32] = (bf16)(pk2(T[1][r] * rd, 0.f) & 0xffffu);
                }
#pragma unroll
                for (int i4 = 0; i4 < 4; ++i4) {
                    const int row = i4 * 8 + (lane >> 3), ch = lane & 7;
                    const v4u hv = *(const LAS v4u*)(stg + row * 64 + ch * 8);
                    const v4u og = *(const v4u*)(OGp + (row0 + 32 * tt + row) * NMI + ch * 8);
                    v4u o;
                    o.x = pk2(bflo(hv.x) * bflo(og.x), bfhi(hv.x) * bfhi(og.x)); o.y = pk2(bflo(hv.y) * bflo(og.y), bfhi(hv.y) * bfhi(og.y));
                    o.z = pk2(bflo(hv.z) * bflo(og.z), bfhi(hv.z) * bfhi(og.z)); o.w = pk2(bflo(hv.w) * bflo(og.w), bfhi(hv.w) * bfhi(og.w));
                    *(v4u*)(HG + (row0 + 32 * tt + row) * D + 512 * h + 64 * sl + ch * 8) = o;
                }
#pragma unroll
                for (int x = 3; x < 6; ++x) T[x] = zero16();
            } else {
                const float decay = SC[0];
#pragma unroll
                for (int x = 0; x < 6; ++x)
#pragma unroll
                    for (int r = 0; r < 16; ++r) T[x][r] *= decay;
#pragma unroll
                for (int dti = 0; dti < 2; ++dti) {
                    const int dt = 2 * (wid - 4) + dti;
                    const lcp ka0 = L + ML_K + dt * 8192 + ktl_;
#pragma unroll
                    for (int s8 = 0; s8 < 8; ++s8) {
                        const lcp ka = ka0 + s8 * 256;
                        const bf16x8 af = cat8(vtr(ka), vtr(ka + 128));
                        const lcp vwb = L + ML_VW + (s8 >> 2) * 8192 + (s8 & 3) * 1024 + vlo_;
                        const bf16x8 b0 = trfrag(vwb), b1 = trfrag(vwb + 4096);
                        const LAS s16x4* wp = (const LAS s16x4*)(WKB + 16 * s8 + 4 * hi);
                        const bf16x8 nb = __builtin_bit_cast(bf16x8, __builtin_bit_cast(v4u, cat8(wp[0], wp[2])) & m0v);
                        T[2 * dti] = MFMA32(af, b0, T[2 * dti]); T[2 * dti + 1] = MFMA32(af, b1, T[2 * dti + 1]); T[4 + dti] = MFMA32(af, nb, T[4 + dti]);
                        if (s8 & 1) __builtin_amdgcn_sched_barrier(0);
                    }
                }
            }
            WG_BAR();
            if (wid >= 4) {
#pragma unroll
                for (int dti = 0; dti < 2; ++dti) {
                    const int dt = 2 * (wid - 4) + dti;
#pragma unroll
                    for (int et = 0; et < 2; ++et)
#pragma unroll
                        for (int g = 0; g < 4; ++g)
                            *(LAS v2u*)(lds + ML_C + (4 * dt + g) * 1024 + (32 * et + r32) * 16 + hi * 8) = (v2u){pk2(T[2 * dti + et][4 * g], T[2 * dti + et][4 * g + 1]), pk2(T[2 * dti + et][4 * g + 2], T[2 * dti + et][4 * g + 3])};
                    if (r32 == 0) {
#pragma unroll
                        for (int g = 0; g < 4; ++g)
                            *(LAS v2u*)(lds + ML_N + (32 * dt + 8 * g + 4 * hi) * 2) = (v2u){pk2(T[4 + dti][4 * g], T[4 + dti][4 * g + 1]), pk2(T[4 + dti][4 * g + 2], T[4 + dti][4 * g + 3])};
                    }
                }
            }
        }
        WG_BAR();
    }
}


constexpr int NWAVES = 8;

template <bool F8> DI void tr_strip(const float* W, int ldw, int n0, void* WTv, size_t wt_row0, int Kdim, int kb0, int nkb, const float* g, const float* bb, float cs, float* c1o, float* c2o, LAS float* scr, int lane) {
    bf16* WT = (bf16*)WTv; unsigned char* WT8 = (unsigned char*)WTv;
    const int c = lane & 7;
    float a1[4] = {0.f, 0.f, 0.f, 0.f}, a2[4] = {0.f, 0.f, 0.f, 0.f};
    for (int kb = kb0; kb < kb0 + nkb; ++kb) {
        const int k0 = kb * 64;
#pragma unroll 8
        for (int i = 0; i < 32; ++i) { const int kk = 2 * i + (lane >> 5); scr[kk * 33 + (lane & 31)] = W[(size_t)(k0 + kk) * ldw + n0 + (lane & 31)]; }
        float gk[8], bk[8];
        if (g) { const f32x4 g0 = *(const f32x4*)(g + k0 + 8 * c), g1 = *(const f32x4*)(g + k0 + 8 * c + 4), b0 = *(const f32x4*)(bb + k0 + 8 * c), b1 = *(const f32x4*)(bb + k0 + 8 * c + 4);
#pragma unroll
            for (int i = 0; i < 4; ++i) { gk[i] = g0[i] * cs; gk[4 + i] = g1[i] * cs; bk[i] = b0[i] * cs; bk[4 + i] = b1[i] * cs; } }
        else {
#pragma unroll
            for (int i = 0; i < 8; ++i) { gk[i] = cs; bk[i] = 0.f; } }
        LDS_WAIT(); asm volatile("" ::: "memory");
#pragma unroll
        for (int j = 0; j < 4; ++j) { const int n = (lane >> 3) + 8 * j; const LAS float* s = scr + (8 * c) * 33 + n;
            float v[8];
#pragma unroll
            for (int i = 0; i < 8; ++i) v[i] = s[i * 33];
            a2[j] += ((v[0] * bk[0] + v[1] * bk[1]) + (v[2] * bk[2] + v[3] * bk[3])) + ((v[4] * bk[4] + v[5] * bk[5]) + (v[6] * bk[6] + v[7] * bk[7]));
            if constexpr (F8) {
                float wv[8];
#pragma unroll
                for (int i = 0; i < 8; ++i) wv[i] = v[i] * gk[i];
                const v2u o = pg8::cvt8_f8(wv, pg8::F8_SW);
                a1[j] += ((__builtin_amdgcn_cvt_f32_fp8((int)o.x, 0) + __builtin_amdgcn_cvt_f32_fp8((int)o.x, 1)) + (__builtin_amdgcn_cvt_f32_fp8((int)o.x, 2) + __builtin_amdgcn_cvt_f32_fp8((int)o.x, 3)))
                       + ((__builtin_amdgcn_cvt_f32_fp8((int)o.y, 0) + __builtin_amdgcn_cvt_f32_fp8((int)o.y, 1)) + (__builtin_amdgcn_cvt_f32_fp8((int)o.y, 2) + __builtin_amdgcn_cvt_f32_fp8((int)o.y, 3)));
                *(GAS v2u*)(WT8 + (wt_row0 + n) * Kdim + k0 + 8 * c) = o;
            } else {
                v4u o; o.x = pk2(v[0] * gk[0], v[1] * gk[1]); o.y = pk2(v[2] * gk[2], v[3] * gk[3]); o.z = pk2(v[4] * gk[4], v[5] * gk[5]); o.w = pk2(v[6] * gk[6], v[7] * gk[7]);
                a1[j] += ((bflo(o.x) + bfhi(o.x)) + (bflo(o.y) + bfhi(o.y))) + ((bflo(o.z) + bfhi(o.z)) + (bflo(o.w) + bfhi(o.w)));
                *(GAS v4u*)(WT + (wt_row0 + n) * Kdim + k0 + 8 * c) = o;
            } }
        LDS_WAIT(); asm volatile("" ::: "memory");
    }
    if (g) {
#pragma unroll
        for (int j = 0; j < 4; ++j) { float s1 = a1[j], s2 = a2[j];
            s1 += SWZ_XOR(s1, 1); s2 += SWZ_XOR(s2, 1); s1 += SWZ_XOR(s1, 2); s2 += SWZ_XOR(s2, 2); s1 += SWZ_XOR(s1, 4); s2 += SWZ_XOR(s2, 4);
            if (c == 0) { c1o[(lane >> 3) + 8 * j] = F8 ? s1 * (1.f / pg8::F8_SW) : s1; c2o[(lane >> 3) + 8 * j] = s2; } }
    }
}

DI void prologue(kargs_t a, LAS unsigned char* lds, int gw, int NGW, int wave, int lane) {
    unsigned char* ws = a->ws;
    float* vec = (float*)(ws + WS_VEC);
    const float* ones = (const float*)(ws + WS_VEC + V_ONES); const float* zeros = (const float*)(ws + WS_VEC + V_ZEROS);
    LAS float* scr = (LAS float*)(lds + wave * 16384);
    constexpr int T_UP = 8 * 2 * 176, T_QKV = 2 * 80, T_MI = 2 * 192, T_W2 = 8 * 64 * 4, T_WO = 2 * 64, T_WMO = 2 * 64, T_G = 16;
    constexpr int NT = T_UP + T_QKV + T_MI + T_W2 + T_WO + T_WMO + T_G;
    for (int it = gw; it < NT; it += NGW) {
        int r = it;
        if (r < T_UP) {
            const int f = r / 352, rr = r % 352, which = rr / 176, strip = rr % 176, n0 = 32 * strip;
            const int t = 3 * (f >> 1) + 2 * (f & 1);
            const float* gp = t ? a->ln_g + (size_t)(t - 1) * D : nullptr; const float* bp = t ? a->ln_b + (size_t)(t - 1) * D : nullptr;
            const size_t wrow = (size_t)256 * (n0 / 128) + 128 * which + (n0 % 128);
            const float* W = (which ? a->w3 : a->w1) + (size_t)f * D * FF;
            if (gp) tr_strip<true>(W, FF, n0, ws + WS_W13 + (size_t)f * NUP * D, wrow, D, 0, 32, gp, bp, 1.f, vec + V_C1U / 4 + (size_t)f * NUP + wrow, vec + V_C2U / 4 + (size_t)f * NUP + wrow, scr, lane);
            else { tr_strip<true>(W, FF, n0, ws + WS_W13 + (size_t)f * NUP * D, wrow, D, 0, 32, nullptr, nullptr, 1.f, nullptr, nullptr, scr, lane);
                   if (lane < 32) { vec[V_C1U / 4 + (size_t)f * NUP + wrow + lane] = 0.f; vec[V_C2U / 4 + (size_t)f * NUP + wrow + lane] = 0.f; } }
            continue; }
        r -= T_UP;
        if (r < T_QKV) { const int j = r / 80, n0 = 32 * (r % 80); const int t = 6 * j + 1;
            tr_strip<true>(a->wqkv + (size_t)j * D * NQKV, NQKV, n0, ws + WS_WQKV + (size_t)j * NQKV * D, n0, D, 0, 32, a->ln_g + (size_t)(t - 1) * D, a->ln_b + (size_t)(t - 1) * D, n0 < 2048 ? 0.125f : 1.f,
                     vec + V_C1Q / 4 + j * NQKV + n0, vec + V_C2Q / 4 + j * NQKV + n0, scr, lane);
            continue; }
        r -= T_QKV;
        if (r < T_MI) { const int j = r / 192, n0 = 32 * (r % 192); const int t = 6 * j + 4;
            tr_strip<false>(a->win + (size_t)j * D * NMIW, NMIW, n0, (bf16*)(ws + WS_WIN) + (size_t)j * NMI * D, n0, D, 0, 32, a->ln_g + (size_t)(t - 1) * D, a->ln_b + (size_t)(t - 1) * D, (n0 >= 1024 && n0 < 2048) ? 0.0625f : 1.f,
                     vec + V_C1I / 4 + j * NMI + n0, vec + V_C2I / 4 + j * NMI + n0, scr, lane);
            continue; }
        r -= T_MI;
        if (r < T_W2) { const int f = r / 256, rr = r % 256, strip = rr / 4, kq = rr % 4;
            tr_strip<true>(a->w2 + (size_t)f * FF * D, D, 32 * strip, ws + WS_W2 + (size_t)f * D * FF, 32 * strip, FF, 22 * kq, 22, nullptr, nullptr, 1.f, nullptr, nullptr, scr, lane);
            continue; }
        r -= T_W2;
        if (r < T_WO) { const int j = r / 64, strip = r % 64;
            tr_strip<true>(a->wo + (size_t)j * D * D, D, 32 * strip, ws + WS_WO + (size_t)j * D * D, 32 * strip, D, 0, 32, nullptr, nullptr, 1.f, nullptr, nullptr, scr, lane);
            continue; }
        r -= T_WO;
        if (r < T_WMO) { const int j = r / 64, strip = r % 64;
            tr_strip<false>(a->wmo + (size_t)j * D * D, D, 32 * strip, (bf16*)(ws + WS_WMO) + (size_t)j * D * D, 32 * strip, D, 0, 32, nullptr, nullptr, 1.f, nullptr, nullptr, scr, lane);
            continue; }
        r -= T_WMO;
        {
            const int j = r / 8, jj = r % 8; const int t = 6 * j + 4;
            const float* gp = a->ln_g + (size_t)(t - 1) * D; const float* bp = a->ln_b + (size_t)(t - 1) * D;
            const float* W = a->win + (size_t)j * D * NMIW + NMI + jj;
            float* wg = vec + V_WG / 4 + (size_t)(j * 8 + jj) * D;
            float s1 = 0.f, s2 = 0.f;
            for (int k = lane; k < D; k += 64) { const float w = W[(size_t)k * NMIW]; const float v = w * gp[k]; wg[k] = v; s1 += v; s2 += w * bp[k]; }
            s1 = wave_sum(s1); s2 = wave_sum(s2);
            if (lane == 0) { vec[V_CG / 4 + j * 16 + jj] = s1; vec[V_CG / 4 + j * 16 + 8 + jj] = s2 + a->bg[j * 8 + jj]; }
        }
    }
    bf16* R = (bf16*)(ws + WS_R); float* sp0 = (float*)(ws + WS_SP);
    for (int m = gw; m < M; m += NGW) {
        const GAS f32x4* xr = (const GAS f32x4*)(a->x + (size_t)m * D);
#pragma unroll
        for (int i = 0; i < 4; ++i) { const f32x4 v0 = xr[(i * 64 + lane) * 2], v1 = xr[(i * 64 + lane) * 2 + 1];
            *(GAS v4u*)(R + (size_t)m * D + (i * 64 + lane) * 8) = (v4u){pk2(v0[0], v0[1]), pk2(v0[2], v0[3]), pk2(v1[0], v1[1]), pk2(v1[2], v1[3])};
            { const float xv[8] = {v0[0], v0[1], v0[2], v0[3], v1[0], v1[1], v1[2], v1[3]}; *(GAS v2u*)(ws + WS_R8 + (size_t)m * D + (i * 64 + lane) * 8) = pg8::cvt8_f8(xv, pg8::F8_SR); } }
        if (lane < 8) *(f32x2*)(sp0 + (size_t)m * 16 + lane * 2) = (f32x2){0.f, 256.f * (1.f - LN_EPS)};
    }
    for (int i = gw * 64 + lane; i < D; i += NGW * 64) { vec[V_ONES / 4 + i] = 1.f; vec[V_ZEROS / 4 + i] = 0.f; }
    (void)ones; (void)zeros;
}

DI void gates_phase(LAS unsigned char* lds, const bf16* R, const float* sp, const float* wg, const float* cg, float* GT, int G, int bid, int wave_in) {
    int wave = wave_in; asm volatile("" : "+s"(wave));
    const int lane = pg8::pg8_lane(), tid = wave * 64 + lane;
    for (int i = tid; i < 8 * D / 4; i += 512) *(LAS f32x4*)(lds + i * 16) = *(const f32x4*)(wg + i * 4);
    WG_BAR();
    const LAS float* W = (const LAS float*)lds;
    for (int m = bid * NWAVES + wave; m < M; m += G * NWAVES) {
        float acc[8] = {0.f, 0.f, 0.f, 0.f, 0.f, 0.f, 0.f, 0.f};
#pragma unroll 1
        for (int i = 0; i < 4; ++i) {
            const int k = 8 * lane + 512 * i;
            const v4u rv = *(const v4u*)(R + (size_t)m * D + k);
            const float x[8] = {bflo(rv.x), bfhi(rv.x), bflo(rv.y), bfhi(rv.y), bflo(rv.z), bfhi(rv.z), bflo(rv.w), bfhi(rv.w)};
#pragma unroll
            for (int jj = 0; jj < 8; ++jj) { const f32x4 w0 = *(const LAS f32x4*)(W + jj * D + k), w1 = *(const LAS f32x4*)(W + jj * D + k + 4);
                acc[jj] += ((x[0] * w0[0] + x[1] * w0[1]) + (x[2] * w0[2] + x[3] * w0[3])) + ((x[4] * w1[0] + x[5] * w1[1]) + (x[6] * w1[2] + x[7] * w1[3])); }
        }
#pragma unroll
        for (int jj = 0; jj < 8; ++jj) acc[jj] = wave_sum(acc[jj]);
        float s = 0.f, q = 0.f;
        { const f32x4 v = *(const f32x4*)(sp + (size_t)m * 16 + (lane & 3) * 4); s = v[0] + v[2]; q = v[1] + v[3];
          s += SWZ_XOR(s, 1); q += SWZ_XOR(q, 1); s += SWZ_XOR(s, 2); q += SWZ_XOR(q, 2); }
        const float mean = s * (1.f / D), var = q * (1.f / D) - mean * mean, rstd = __builtin_amdgcn_rsqf(var + LN_EPS);
        float sel = acc[0];
#pragma unroll
        for (int jj = 1; jj < 8; ++jj) sel = (lane == jj) ? acc[jj] : sel;
        if (lane < 8) GT[(size_t)m * 8 + lane] = rstd * (sel - mean * cg[lane]) + cg[8 + lane];
    }
}

DI void final_ln(const bf16* R, const float* sp, const float* g, const float* b, float* out, int gw, int NGW, int lane) {
    for (int m = gw; m < M; m += NGW) {
        float s, q;
        { const f32x4 v = *(const f32x4*)(sp + (size_t)m * 16 + (lane & 3) * 4); s = v[0] + v[2]; q = v[1] + v[3];
          s += SWZ_XOR(s, 1); q += SWZ_XOR(q, 1); s += SWZ_XOR(s, 2); q += SWZ_XOR(q, 2); }
        const float mean = s * (1.f / D), var = q * (1.f / D) - mean * mean, rstd = __builtin_amdgcn_rsqf(var + LN_EPS);
#pragma unroll
        for (int i = 0; i < 4; ++i) {
            const int k = 8 * lane + 512 * i;
            const v4u rv = *(const v4u*)(R + (size_t)m * D + k);
            const f32x4 g0 = *(const f32x4*)(g + k), g1 = *(const f32x4*)(g + k + 4), b0 = *(const f32x4*)(b + k), b1 = *(const f32x4*)(b + k + 4);
            f32x4 o0, o1;
            o0[0] = (bflo(rv.x) - mean) * rstd * g0[0] + b0[0]; o0[1] = (bfhi(rv.x) - mean) * rstd * g0[1] + b0[1]; o0[2] = (bflo(rv.y) - mean) * rstd * g0[2] + b0[2]; o0[3] = (bfhi(rv.y) - mean) * rstd * g0[3] + b0[3];
            o1[0] = (bflo(rv.z) - mean) * rstd * g1[0] + b1[0]; o1[1] = (bfhi(rv.z) - mean) * rstd * g1[1] + b1[1]; o1[2] = (bflo(rv.w) - mean) * rstd * g1[2] + b1[2]; o1[3] = (bfhi(rv.w) - mean) * rstd * g1[3] + b1[3];
            *(GAS f32x4*)(out + (size_t)m * D + k) = o0; *(GAS f32x4*)(out + (size_t)m * D + k + 4) = o1;
        }
    }
}

#ifndef PROBE_DUP
#define PROBE_DUP 0
#endif
#ifndef SKIP_ATT
#define SKIP_ATT 0
#endif
#ifndef SKIP_MLSTM
#define SKIP_MLSTM 0
#endif

#define GRID_BAR1() do { XcdBarrier b_; b_.bar = (unsigned*)(kargs()->ws + WS_CTL) + CW_BAR; b_.x = xb_xcc_id(); b_.st = (volatile LAS unsigned*)(lds + MISC_OFF) + 8; xcd_barrier(b_); } while (0)
#define GRID_BAR() do { GRID_BAR1(); if (PROBE_DUP & 1024) GRID_BAR1(); } while (0)

__global__ void __launch_bounds__(NWAVES * 64, 2) fwd_kernel(Args args_by_value) {
    extern __shared__ __attribute__((aligned(16))) unsigned char lds_raw[];
    LAS unsigned char* lds = (LAS unsigned char*)lds_raw;
    const int w0 = __builtin_amdgcn_readfirstlane((int)threadIdx.x >> 6);
    const int G = gridDim.x, bid = blockIdx.x;
    { const int tid0 = threadIdx.x; if (tid0 < 64) ((volatile LAS unsigned*)(lds + MISC_OFF))[tid0] = 0u; }
    __syncthreads();
    (void)xcd_barrier_post((unsigned*)(kargs()->ws + WS_CTL) + CW_BAR, (volatile LAS unsigned*)(lds + MISC_OFF) + 8);
    {
        const int vcu = (G % 8 == 0) ? (bid % 8) * (G / 8) + bid / 8 : bid;
        prologue(kargs(), lds, vcu * NWAVES + w0, G * NWAVES, w0, pg8::pg8_lane());
        if (PROBE_DUP & 1) { WG_BAR(); prologue(kargs(), lds, vcu * NWAVES + w0, G * NWAVES, w0, pg8::pg8_lane()); }
    }
    GRID_BAR();

    for (int t = 0; t < 3 * DEPTH; ++t) {
        const int layer = t / 3, sub = t % 3;
        const int kind = (sub != 1) ? 0 : ((layer & 1) ? 2 : 1);
        const int j = layer >> 1;
        {
            unsigned char* ws = kargs()->ws;
            float* vec = (float*)(ws + WS_VEC);
            const bf16* R = (const bf16*)(ws + WS_R);
            const float* sp_in = (const float*)(ws + WS_SP) + (size_t)(t & 1) * (SP_BYTES / 4);
            if (kind == 0) {
                const int f = 2 * layer + (sub >> 1);
                pg8::Gemm g{(const bf16*)(ws + WS_R8), (const bf16*)(ws + WS_W13 + (size_t)f * NUP * D), M, NUP, D / 2}; pg8::StaticOrder S; S.init(M, NUP, G, bid);
                pg8::EpiUp E{f, t & 1};
                pg8::gemm_phase<pg8::EpiUp, pg8::StaticOrder, true, PG8_SP2, true>(lds + RING_OFF, g, S, E, w0);
                if (PROBE_DUP & 16) pg8::gemm_phase<pg8::EpiUp, pg8::StaticOrder, true, PG8_SP2, true>(lds + RING_OFF, g, S, E, w0);
                if (PROBE_DUP & 128) { pg8::EpiNull EN{(float*)(ws + WS_GATES)}; pg8::gemm_phase<pg8::EpiNull, pg8::StaticOrder, true, PG8_SP2, true>(lds + RING_OFF, g, S, EN, w0); }
            } else if (kind == 1) {
                pg8::Gemm g{(const bf16*)(ws + WS_R8), (const bf16*)(ws + WS_WQKV + (size_t)j * NQKV * D), M, NQKV, D / 2}; pg8::StaticOrder S; S.init(M, NQKV, G, bid);
                pg8::EpiLnOut E{1, j, t & 1, 1.f / (pg8::F8_SR * pg8::F8_SW)};
                pg8::gemm_phase<pg8::EpiLnOut, pg8::StaticOrder, true, PG8_SP2, true>(lds + RING_OFF, g, S, E, w0);
                if (PROBE_DUP & 32) pg8::gemm_phase<pg8::EpiLnOut, pg8::StaticOrder, true, PG8_SP2, true>(lds + RING_OFF, g, S, E, w0);
            } else {
                pg8::Gemm g{R, (const bf16*)(ws + WS_WIN) + (size_t)j * NMI * D, M, NMI, D}; pg8::StaticOrder S; S.init(M, NMI, G, bid);
                pg8::EpiLnOut E{0, j, t & 1, 1.f};
                pg8::gemm_phase<pg8::EpiLnOut, pg8::StaticOrder, true, PG8_SP2>(lds + RING_OFF, g, S, E, w0);
                if (PROBE_DUP & 32) pg8::gemm_phase<pg8::EpiLnOut, pg8::StaticOrder, true, PG8_SP2>(lds + RING_OFF, g, S, E, w0);
                gates_phase(lds, R, sp_in, vec + V_WG / 4 + (size_t)j * 8 * D, vec + V_CG / 4 + j * 16, (float*)(ws + WS_GATES), G, bid, w0);
                if (PROBE_DUP & 8) { WG_BAR(); gates_phase(lds, R, sp_in, vec + V_WG / 4 + (size_t)j * 8 * D, vec + V_CG / 4 + j * 16, (float*)(ws + WS_GATES), G, bid, w0); }
            }
        }
        GRID_BAR();
        if (kind == 1) {
            if (!SKIP_ATT) { kargs_t ka = kargs(); unsigned char* ws = ka->ws; attn_phase(lds_raw, (const bf16*)(ws + WS_QKV), ws + WS_AO, ka->sinks + j * 32, G, bid, w0);
                if (PROBE_DUP & 2) attn_phase(lds_raw, (const bf16*)(ws + WS_QKV), ws + WS_AO, ka->sinks + j * 32, G, bid, w0); }
            GRID_BAR();
        } else if (kind == 2) {
            if (!SKIP_MLSTM) { unsigned char* ws = kargs()->ws; mlstm_phase(lds_raw, (const bf16*)(ws + WS_MP), (const float*)(ws + WS_GATES), (bf16*)(ws + WS_HG), G, bid, w0);
                if (PROBE_DUP & 4) mlstm_phase(lds_raw, (const bf16*)(ws + WS_MP), (const float*)(ws + WS_GATES), (bf16*)(ws + WS_HG), G, bid, w0); }
            GRID_BAR();
        }
        {
            kargs_t ka = kargs(); unsigned char* ws = ka->ws;
            float coef = kind == 0 ? 0.5f / (pg8::F8_SH * pg8::F8_SW) : (kind == 1 ? 1.f / (pg8::F8_SO * pg8::F8_SW) : 1.f);
            if ((kind == 1 && SKIP_ATT) || (kind == 2 && SKIP_MLSTM)) coef = 0.f;
            pg8::StaticOrder S; S.init(M, D, G, bid);
            pg8::EpiRes E{t, coef, (LAS float*)(lds + TAB_OFF), w0, 0};
            if (kind != 2) {
                const int f = 2 * layer + (sub >> 1);
                pg8::Gemm g{(const bf16*)(ws + (kind == 0 ? WS_H : WS_AO)), (const bf16*)(kind == 0 ? ws + WS_W2 + (size_t)f * D * FF : ws + WS_WO + (size_t)j * D * D), M, D, kind == 0 ? FF / 2 : D / 2};
                if (PROBE_DUP & 64) { pg8::EpiNull EN{(float*)(ws + WS_GATES)}; pg8::gemm_phase<pg8::EpiNull, pg8::StaticOrder, true, PG8_SP2, true>(lds + RING_OFF, g, S, EN, w0); }
                if (PROBE_DUP & 512) { pg8::EpiRes ED{t, coef, (LAS float*)(lds + TAB_OFF), w0, 1}; pg8::gemm_phase<pg8::EpiRes, pg8::StaticOrder, true, PG8_SP2, true>(lds + RING_OFF, g, S, ED, w0); }
                pg8::gemm_phase<pg8::EpiRes, pg8::StaticOrder, true, PG8_SP2, true>(lds + RING_OFF, g, S, E, w0);
            } else {
                pg8::Gemm g{(const bf16*)(ws + WS_HG), (const bf16*)(ws + WS_WMO) + (size_t)j * D * D, M, D, D};
                if (PROBE_DUP & 256) { pg8::EpiNull EN{(float*)(ws + WS_GATES)}; pg8::gemm_phase<pg8::EpiNull, pg8::StaticOrder, true, PG8_SP2, false>(lds + RING_OFF, g, S, EN, w0); }
                pg8::gemm_phase<pg8::EpiRes, pg8::StaticOrder, true, PG8_SP2, false>(lds + RING_OFF, g, S, E, w0);
            }
        }
        GRID_BAR();
    }
    {
        kargs_t ka = kargs(); unsigned char* ws = ka->ws;
        const int vcu = (G % 8 == 0) ? (bid % 8) * (G / 8) + bid / 8 : bid;
        final_ln((const bf16*)(ws + WS_R), (const float*)(ws + WS_SP), ka->ln_g + (size_t)(3 * DEPTH - 1) * D, ka->ln_b + (size_t)(3 * DEPTH - 1) * D, ka->out, vcu * NWAVES + w0, G * NWAVES, pg8::pg8_lane());
    }
}

extern "C" void kernel_launch(void* const* d_in, const int* in_sizes, int n_in, void* d_out, int out_size, void* d_ws, size_t ws_size, hipStream_t stream) {
    static int grid = 0;
    if (grid == 0) {
        if (n_in != 12 || in_sizes[0] != M * D || out_size != M * D || ws_size < WS_END) { fprintf(stderr, "kernel_launch: unexpected shapes / workspace (n_in %d, ws %zu < %zu); nothing launched\n", n_in, ws_size, (size_t)WS_END); grid = -1; return; }
        int dev = 0, cus = 0;
        if (hipGetDevice(&dev) != hipSuccess || hipDeviceGetAttribute(&cus, hipDeviceAttributeMultiprocessorCount, dev) != hipSuccess) { grid = -1; return; }
        if (hipFuncSetAttribute((const void*)fwd_kernel, hipFuncAttributeMaxDynamicSharedMemorySize, LDS_BYTES) != hipSuccess) { fprintf(stderr, "kernel_launch: hipFuncSetAttribute failed\n"); grid = -1; return; }
        int per_cu = 0;
        if (hipOccupancyMaxActiveBlocksPerMultiprocessor(&per_cu, (const void*)fwd_kernel, NWAVES * 64, LDS_BYTES) != hipSuccess || per_cu < 1) { fprintf(stderr, "kernel_launch: occupancy query says %d\n", per_cu); }
        (void)hipGetLastError();
        grid = cus;
    }
    if (grid < 0) return;
    (void)hipMemsetAsync((char*)d_ws + WS_CTL, 0, CTL_ZERO_BYTES, stream);
    Args a{};
    a.x = (const float*)d_in[0]; a.w1 = (const float*)d_in[1]; a.w3 = (const float*)d_in[2]; a.w2 = (const float*)d_in[3]; a.ln_g = (const float*)d_in[4]; a.ln_b = (const float*)d_in[5];
    a.wqkv = (const float*)d_in[6]; a.sinks = (const float*)d_in[7]; a.wo = (const float*)d_in[8]; a.win = (const float*)d_in[9]; a.bg = (const float*)d_in[10]; a.wmo = (const float*)d_in[11];
    a.out = (float*)d_out; a.ws = (unsigned char*)d_ws;
    hipLaunchKernelGGL(fwd_kernel, dim3(grid), dim3(NWAVES * 64), LDS_BYTES, stream, a);
}
```

```cpp
#include <hip/hip_runtime.h>
#include <hip/hip_bf16.h>
#include <cstdio>
#include <cstdint>
#include <cmath>

constexpr int BATCH = 8, SEQ = 2048, D = 2048, FF = 5632, DEPTH = 4;
constexpr int M = BATCH * SEQ;
constexpr int NUP = 2 * FF;
constexpr int NQKV = 2560;
constexpr int NMI = 6144, NMIW = 6152;
constexpr float LN_EPS = 1e-5f;
constexpr float ALPHA = 1.681792830507429f;
constexpr float LOG2E = 1.4426950408889634f;

constexpr size_t MiB = 1u << 20;
constexpr size_t WS_CTL = 0, CTL_ZERO_BYTES = 1 * MiB;
constexpr size_t WS_W13 = 2 * MiB;
constexpr size_t WS_W2 = 178 * MiB;
constexpr size_t WS_WQKV = 266 * MiB;
constexpr size_t WS_WO = 286 * MiB;
constexpr size_t WS_WIN = 302 * MiB;
constexpr size_t WS_WMO = 350 * MiB;
constexpr size_t WS_VEC = 366 * MiB;
constexpr size_t V_C1U = 0, V_C2U = 360448, V_C1Q = 720896, V_C2Q = 741376, V_C1I = 761856, V_C2I = 811008, V_CG = 860160, V_WG = 860416, V_ONES = 991488, V_ZEROS = 999680;
constexpr size_t WS_R = 368 * MiB;
constexpr size_t WS_R8 = 432 * MiB;
constexpr size_t WS_SP = 464 * MiB;
constexpr size_t SP_BYTES = (size_t)M * 16 * 4;
constexpr size_t WS_H = 466 * MiB;
constexpr size_t WS_QKV = 554 * MiB;
constexpr size_t WS_AO = 634 * MiB;
constexpr size_t WS_MP = 698 * MiB;
constexpr size_t WS_GATES = 890 * MiB;
constexpr size_t WS_HG = 891 * MiB;
constexpr size_t WS_END = 955 * MiB;
constexpr int CW_TMO = 0, CW_BAR = 4096;

struct Args { const float* x; const float* w1; const float* w3; const float* w2; const float* ln_g; const float* ln_b; const float* wqkv; const float* sinks; const float* wo;
              const float* win; const float* bg; const float* wmo; float* out; unsigned char* ws; };
typedef const __attribute__((address_space(4))) Args* kargs_t;
__device__ __forceinline__ kargs_t kargs() { kargs_t p = (kargs_t)__builtin_amdgcn_kernarg_segment_ptr(); asm volatile("" : "+s"(p)); return p; }

namespace pg8 {
#define PG8_LAS __attribute__((address_space(3)))
typedef unsigned short bf16_t;
typedef short bf16x8 __attribute__((ext_vector_type(8)));
typedef _Float16 f16x8 __attribute__((ext_vector_type(8)));
typedef float f32x4 __attribute__((ext_vector_type(4)));
typedef unsigned u32x4 __attribute__((ext_vector_type(4)));
constexpr int BM = 256, BK = 64, HALF = 128, HTB = HALF * BK * 2  , STAGE_BYTES = 8 * HTB, NXCD = 8, WGM = 8;

__host__ __device__ __forceinline__ int lds_byte(int r, int c) { const int st = (r >> 4) * 2 + (c >> 5), rr = r & 15, cc = c & 31, ob = rr * 64 + cc * 2; return st * 1024 + (ob ^ (((ob >> 9) & 1) << 5)); }
__host__ __device__ __forceinline__ void stage_rc(int b, int& R, int& C) { const int st = b / 1024, sb = b % 1024, swz = sb ^ (((sb >> 9) & 1) << 5); R = (st >> 1) * 16 + swz / 64; C = (st & 1) * 32 + (swz % 64) / 2; }
__host__ __device__ __forceinline__ int perm32(int rho) { const int n = rho >> 4, i = rho & 15; return 8 * (i >> 2) + 4 * n + (i & 3); }

typedef int i32x4 __attribute__((ext_vector_type(4)));
typedef int i32x8 __attribute__((ext_vector_type(8)));
constexpr float F8_SR = 8.f, F8_SW = 1024.f, F8_SH = 16.f, F8_SO = 64.f;
__device__ __forceinline__ i32x8 cat_i8(bf16x8 lo, bf16x8 hi) { const i32x4 a = __builtin_bit_cast(i32x4, lo), b = __builtin_bit_cast(i32x4, hi); return __builtin_shufflevector(a, b, 0, 1, 2, 3, 4, 5, 6, 7); }
__device__ __forceinline__ void mfma_f8_inplace(f32x4& c, const i32x8 a, const i32x8 b) { asm volatile("v_mfma_f32_16x16x128_f8f6f4 %0, %1, %2, %0 cbsz:0 blgp:0" : "+v"(c) : "v"(a), "v"(b)); }
typedef unsigned u32x2 __attribute__((ext_vector_type(2)));
__device__ __forceinline__ u32x2 cvt8_f8(const float (&v)[8], float s) {
    int a, b; asm volatile("" : "=v"(a), "=v"(b));
    a = __builtin_amdgcn_cvt_pk_fp8_f32(v[0] * s, v[1] * s, a, false); a = __builtin_amdgcn_cvt_pk_fp8_f32(v[2] * s, v[3] * s, a, true);
    b = __builtin_amdgcn_cvt_pk_fp8_f32(v[4] * s, v[5] * s, b, false); b = __builtin_amdgcn_cvt_pk_fp8_f32(v[6] * s, v[7] * s, b, true);
    return (u32x2){(unsigned)a, (unsigned)b};
}
__device__ __forceinline__ int pg8_lane() { int l; asm volatile("v_mbcnt_lo_u32_b32 %0, -1, 0\n\tv_mbcnt_hi_u32_b32 %0, -1, %0" : "=v"(l)); return l; }
struct Unit { int pm, pn; };
struct Gemm { const bf16_t* A; const bf16_t* Bt; int M, N, K; };

struct StaticOrder {
    int nM, nN, nwg, G, c;
    __host__ __device__ void init(int M_, int N_, int G_, int c_) { nM = M_ / BM; nN = N_ / BM; nwg = nM * nN; G = G_; c = c_; }
    __host__ __device__ bool next(int i, Unit& u) const {
        const long L = (long)i * G + c; if (L >= nwg) return false;
        int wgid = (int)L; { const int q = nwg / NXCD, r = nwg % NXCD, xcd = wgid % NXCD, off = wgid / NXCD; wgid = (xcd < r ? xcd * (q + 1) : r * (q + 1) + (xcd - r) * q) + off; }
        const int nig = WGM * nN, gid = wgid / nig, fm = gid * WGM, gsz = (nM - fm) < WGM ? (nM - fm) : WGM;
        u.pm = fm + ((wgid % nig) % gsz); u.pn = (wgid % nig) / gsz; return true;
    }
    __device__ __forceinline__ void a_ready(const Unit&) const {}
    __device__ __forceinline__ void done(const Unit&) const {}
};

__device__ __forceinline__ unsigned cvt_pk_bf16(float lo, float hi) { typedef float f2 __attribute__((ext_vector_type(2))); typedef _Float16 b2 __attribute__((ext_vector_type(2))); f2 v = {lo, hi}; b2 b = __builtin_convertvector(v, b2); return __builtin_bit_cast(unsigned, b); }
__device__ __forceinline__ float bf_lo(unsigned w) { typedef _Float16 b2 __attribute__((ext_vector_type(2))); return (float)__builtin_bit_cast(b2, w)[0]; }
__device__ __forceinline__ float bf_hi(unsigned w) { typedef _Float16 b2 __attribute__((ext_vector_type(2))); return (float)__builtin_bit_cast(b2, w)[1]; }
__device__ __forceinline__ float fsigmoid(float x) { return __builtin_amdgcn_rcpf(1.f + __builtin_amdgcn_exp2f(-LOG2E * x)); }

__device__ __forceinline__ float sum_fq(float v) {
    auto a = __builtin_amdgcn_permlane16_swap(__float_as_uint(v), __float_as_uint(v), false, false); v = __uint_as_float(a[0]) + __uint_as_float(a[1]);
    auto b = __builtin_amdgcn_permlane32_swap(__float_as_uint(v), __float_as_uint(v), false, false); return __uint_as_float(b[0]) + __uint_as_float(b[1]);
}
__device__ __forceinline__ void row_stats(const float* sp, int row0, int fq, float (&mu)[2][4], float (&rs)[2][4]) {
#pragma unroll
    for (int ai = 0; ai < 2; ++ai)
#pragma unroll
        for (int m = 0; m < 4; ++m) {
            const f32x4 v = *(const f32x4*)(sp + (size_t)(row0 + ai * HALF + m * 16) * 16 + fq * 4);
            float s = v[0] + v[2], q = v[1] + v[3];
            s = sum_fq(s); q = sum_fq(q);
            const float mean = s * (1.f / D), var = q * (1.f / D) - mean * mean;
            mu[ai][m] = mean; rs[ai][m] = __builtin_amdgcn_rsqf(var + LN_EPS);
        }
}

struct EpiNull {
    static constexpr bool PERM = true, AFTER_DRAIN = false;
    float* sink;
    __device__ __forceinline__ void operator()(const f32x4 (&acc)[2][2][4][2], const Unit& u, int wr, int wc, int, int) const {
        float s = 0.f;
#pragma unroll
        for (int ai = 0; ai < 2; ++ai)
#pragma unroll
            for (int bj = 0; bj < 2; ++bj)
#pragma unroll
                for (int m = 0; m < 4; ++m)
#pragma unroll
                    for (int n = 0; n < 2; ++n) s += acc[ai][bj][m][n][0] + acc[ai][bj][m][n][1] + acc[ai][bj][m][n][2] + acc[ai][bj][m][n][3];
        if (s == 123.456f) sink[u.pm + wr + wc] = s;
    }
};

struct EpiUp {
    static constexpr bool PERM = true, AFTER_DRAIN = false;
    int f, tpar;
    __device__ __forceinline__ void operator()(const f32x4 (&acc)[2][2][4][2], const Unit& u, int wr, int wc, int, int) const {
        const int lane_ = pg8_lane(), fr = lane_ & 15, fq = lane_ >> 4;
        const int row0 = u.pm * BM + wr * 64 + fr;
        int f = this->f, tpar = this->tpar; asm volatile("" : "+s"(f), "+s"(tpar));
        unsigned char* ws = kargs()->ws; unsigned char* H = ws + WS_H;
        const float* c1 = (const float*)(ws + WS_VEC + V_C1U) + (size_t)f * NUP; const float* c2 = (const float*)(ws + WS_VEC + V_C2U) + (size_t)f * NUP; const float* sp = (const float*)(ws + WS_SP) + (size_t)tpar * (SP_BYTES / 4);
        float mu[2][4], rs[2][4]; row_stats(sp, row0, fq, mu, rs);
        const int cb = u.pn * BM + wc * 32 + 8 * fq;
        f32x4 k1[2][2], k2[2][2];
#pragma unroll
        for (int bj = 0; bj < 2; ++bj)
#pragma unroll
            for (int n = 0; n < 2; ++n) { k1[bj][n] = *(const f32x4*)(c1 + cb + bj * HALF + 4 * n); k2[bj][n] = *(const f32x4*)(c2 + cb + bj * HALF + 4 * n); }
        unsigned char* hp = H + (size_t)row0 * FF + u.pn * HALF + wc * 32 + 8 * fq;
#pragma unroll
        for (int ai = 0; ai < 2; ++ai)
#pragma unroll
            for (int m = 0; m < 4; ++m) {
                const float r_ = rs[ai][m], nm = -mu[ai][m] * r_, ra = r_ * (1.f / (F8_SR * F8_SW));
                float hv[8];
#pragma unroll
                for (int n = 0; n < 2; ++n)
#pragma unroll
                    for (int j = 0; j < 4; ++j) {
                        const float ga = acc[ai][0][m][n][j] * ra + (nm * k1[0][n][j] + k2[0][n][j]);
                        const float ub = acc[ai][1][m][n][j] * ra + (nm * k1[1][n][j] + k2[1][n][j]);
                        hv[4 * n + j] = ga * fsigmoid(ga) * ub;
                    }
                *(u32x2*)(hp + (size_t)(ai * HALF + m * 16) * FF) = cvt8_f8(hv, F8_SH);
            }
    }
};

struct EpiLnOut {
    static constexpr bool PERM = true, AFTER_DRAIN = false;
    int att, j, tpar; float ascale;
    __device__ __forceinline__ void operator()(const f32x4 (&acc)[2][2][4][2], const Unit& u, int wr, int wc, int, int) const {
        const int lane_ = pg8_lane(), fr = lane_ & 15, fq = lane_ >> 4;
        const int row0 = u.pm * BM + wr * 64 + fr;
        int att = this->att, j = this->j, tpar = this->tpar; asm volatile("" : "+s"(att), "+s"(j), "+s"(tpar));
        unsigned char* ws = kargs()->ws; bf16_t* O = (bf16_t*)(ws + (att ? WS_QKV : WS_MP)); const int ldo = att ? NQKV : NMI, sig_from = att ? 1000 : 16;
        const float* c1 = (const float*)(ws + WS_VEC + (att ? V_C1Q : V_C1I)) + j * ldo; const float* c2 = (const float*)(ws + WS_VEC + (att ? V_C2Q : V_C2I)) + j * ldo; const float* sp = (const float*)(ws + WS_SP) + (size_t)tpar * (SP_BYTES / 4);
        float mu[2][4], rs[2][4]; row_stats(sp, row0, fq, mu, rs);
        const int cb = u.pn * BM + wc * 32 + 8 * fq;
        const bool sg = u.pn >= sig_from;
        f32x4 k1[2][2], k2[2][2];
#pragma unroll
        for (int bj = 0; bj < 2; ++bj)
#pragma unroll
            for (int n = 0; n < 2; ++n) { k1[bj][n] = *(const f32x4*)(c1 + cb + bj * HALF + 4 * n); k2[bj][n] = *(const f32x4*)(c2 + cb + bj * HALF + 4 * n); }
        bf16_t* op = O + (size_t)row0 * ldo + cb;
#pragma unroll
        for (int ai = 0; ai < 2; ++ai)
#pragma unroll
            for (int m = 0; m < 4; ++m) {
                const float r_ = rs[ai][m], nm = -mu[ai][m] * r_, ra = r_ * ascale;
#pragma unroll
                for (int bj = 0; bj < 2; ++bj) {
                    float v[8];
#pragma unroll
                    for (int n = 0; n < 2; ++n)
#pragma unroll
                        for (int j = 0; j < 4; ++j) { float t = acc[ai][bj][m][n][j] * ra + (nm * k1[bj][n][j] + k2[bj][n][j]); if (sg) t = fsigmoid(t); v[4 * n + j] = t; }
                    u32x4 w; w.x = cvt_pk_bf16(v[0], v[1]); w.y = cvt_pk_bf16(v[2], v[3]); w.z = cvt_pk_bf16(v[4], v[5]); w.w = cvt_pk_bf16(v[6], v[7]);
                    *(u32x4*)(op + (size_t)(ai * HALF + m * 16) * ldo + bj * HALF) = w;
                }
            }
    }
};

struct EpiRes {
    static constexpr bool PERM = true, AFTER_DRAIN = false;
    int t; float coef; PG8_LAS float* tab; int wave; int dry;
    __device__ __forceinline__ void operator()(const f32x4 (&acc)[2][2][4][2], const Unit& u, int wr, int wc, int, int) const {
        const int lane_ = pg8_lane(), fr = lane_ & 15, fq = lane_ >> 4;
        typedef float f32x2v __attribute__((ext_vector_type(2)));
        const int row0 = u.pm * BM + wr * 64 + fr;
        int t = this->t; asm volatile("" : "+s"(t));
        kargs_t ka = kargs(); unsigned char* ws = ka->ws; bf16_t* R = (bf16_t*)(ws + WS_R); unsigned char* R8 = ws + (dry ? WS_MP + 64 * MiB : WS_R8); bf16_t* Ro = dry ? (bf16_t*)(ws + WS_MP) : R;
        const float* g = t ? ka->ln_g + (size_t)(t - 1) * D : (const float*)(ws + WS_VEC + V_ONES); const float* b = t ? ka->ln_b + (size_t)(t - 1) * D : (const float*)(ws + WS_VEC + V_ZEROS);
        const float* sp_in = (const float*)(ws + WS_SP) + (size_t)(t & 1) * (SP_BYTES / 4); float* sp_out = dry ? (float*)(ws + WS_MP + 96 * MiB) : (float*)(ws + WS_SP) + (size_t)((t + 1) & 1) * (SP_BYTES / 4);
        float mu[2][4], rs[2][4]; row_stats(sp_in, row0, fq, mu, rs);
        asm volatile("" ::: "memory");
#pragma unroll
        for (int bj = 0; bj < 2; ++bj) {
            const int cb = u.pn * BM + bj * HALF + wc * 32 + 8 * fq;
            f32x4 gv[2], bv[2];
#pragma unroll
            for (int n = 0; n < 2; ++n) { gv[n] = *(const f32x4*)(g + cb + 4 * n); bv[n] = *(const f32x4*)(b + cb + 4 * n) * ALPHA; }
#pragma unroll
            for (int ai = 0; ai < 2; ++ai) {
                u32x4 old[4];
#pragma unroll
                for (int m = 0; m < 4; ++m) old[m] = *(const u32x4*)(R + (size_t)(row0 + ai * HALF + m * 16) * D + cb);
#pragma unroll
                for (int m = 0; m < 4; ++m) {
                    const float A_ = ALPHA * rs[ai][m], B_ = -mu[ai][m] * A_;
                    const size_t off = (size_t)(row0 + ai * HALF + m * 16) * D + cb;
                    const u32x4 o = old[m];
                    const float ro[8] = {bf_lo(o.x), bf_hi(o.x), bf_lo(o.y), bf_hi(o.y), bf_lo(o.z), bf_hi(o.z), bf_lo(o.w), bf_hi(o.w)};
                    float nv[8];
#pragma unroll
                    for (int n = 0; n < 2; ++n)
#pragma unroll
                        for (int j = 0; j < 4; ++j) nv[4 * n + j] = (ro[4 * n + j] * A_ + B_) * gv[n][j] + bv[n][j] + coef * acc[ai][bj][m][n][j];
                    u32x4 w; w.x = cvt_pk_bf16(nv[0], nv[1]); w.y = cvt_pk_bf16(nv[2], nv[3]); w.z = cvt_pk_bf16(nv[4], nv[5]); w.w = cvt_pk_bf16(nv[6], nv[7]);
                    *(u32x4*)(Ro + off) = w;
                    *(u32x2*)(R8 + off) = cvt8_f8(nv, F8_SR);
                    const float f0 = bf_lo(w.x), f1 = bf_hi(w.x), f2 = bf_lo(w.y), f3 = bf_hi(w.y), f4 = bf_lo(w.z), f5 = bf_hi(w.z), f6 = bf_lo(w.w), f7 = bf_hi(w.w);
                    float s = ((f0 + f1) + (f2 + f3)) + ((f4 + f5) + (f6 + f7));
                    float q = ((f0 * f0 + f1 * f1) + (f2 * f2 + f3 * f3)) + ((f4 * f4 + f5 * f5) + (f6 * f6 + f7 * f7));
                    s = sum_fq(s); q = sum_fq(q);
                    if (fq == 0) *(PG8_LAS f32x2v*)(tab + (((ai * HALF + wr * 64 + m * 16 + fr) * 4 + wc) * 2 + bj) * 2) = (f32x2v){s, q};
                }
                asm volatile("" ::: "memory");
            }
        }
        asm volatile("s_waitcnt lgkmcnt(0)" ::: "memory"); __builtin_amdgcn_s_barrier(); asm volatile("" ::: "memory");
        const int tid = wave * 64 + pg8_lane();
        if (tid < BM) {
            const PG8_LAS f32x4* t4 = (const PG8_LAS f32x4*)(tab + tid * 16);
            const f32x4 a = t4[0], c = t4[1], d = t4[2], e = t4[3];
            *(f32x2v*)(sp_out + (size_t)(u.pm * BM + tid) * 16 + u.pn * 2) = (f32x2v){((a[0] + a[2]) + (c[0] + c[2])) + ((d[0] + d[2]) + (e[0] + e[2])), ((a[1] + a[3]) + (c[1] + c[3])) + ((d[1] + d[3]) + (e[1] + e[3]))};
        }
    }
};

template <class Epi, class Sched, bool ALIGN_EPI = false, bool SP2 = false, bool F8 = false>
__device__ __forceinline__ void gemm_phase(PG8_LAS unsigned char* lds, const Gemm g, const Sched& S, const Epi& E, int wave_in) {
    int wid = wave_in; asm volatile("" : "+s"(wid));
    const int lane = pg8_lane(), tid = wid * 64 + lane, wr = wid >> 2, wc = wid & 3, fr = lane & 15, fq = lane >> 4;
    const int K = g.K, nt = K / BK;
    unsigned voffA[2], voffB[2];
#pragma unroll
    for (int i = 0; i < 2; ++i) { int R, C; stage_rc(tid * 16 + i * 8192, R, C); const int Rb = Epi::PERM ? ((R & ~31) + perm32(R & 31)) : R;
        voffA[i] = (unsigned)(R * K + C) * 2u; voffB[i] = (unsigned)(Rb * K + C) * 2u; }
    const size_t kstep = (size_t)(BK * 2);
    const size_t hstep = (size_t)HALF * K * 2;
    const size_t tstep = 2 * hstep;
    const unsigned ldsw = (unsigned)wid * 1024u;
    const int aoff = lds_byte(wr * 64 + fr, fq * 8), boff = lds_byte(wc * 32 + fr, fq * 8);
#define PG8_SA(b, h) (((b) * 2 + (h)) * HTB)
#define PG8_SB(b, h) ((4 + (b) * 2 + (h)) * HTB)
#define PG8_STAGE(bufoff, gbase, voff) do { _Pragma("unroll") for (int _i = 0; _i < 2; ++_i) \
        __builtin_amdgcn_global_load_lds((const unsigned*)((const char*)(gbase) + (voff)[_i]), (PG8_LAS unsigned*)(lds + (bufoff) + ldsw + _i * 8192), 16, 0, 0); } while (0)
#define PG8_LDA(dst, b, h) do { _Pragma("unroll") for (int m = 0; m < 4; ++m) _Pragma("unroll") for (int k = 0; k < 2; ++k) dst[m][k] = *(const PG8_LAS bf16x8*)(lds + PG8_SA(b, h) + aoff + m * 2048 + k * 1024); } while (0)
#define PG8_LDB(dst, b, h) do { _Pragma("unroll") for (int n = 0; n < 2; ++n) _Pragma("unroll") for (int k = 0; k < 2; ++k) dst[n][k] = *(const PG8_LAS bf16x8*)(lds + PG8_SB(b, h) + boff + n * 2048 + k * 1024); } while (0)
#define PG8_MMA(ai, bj, At, Bt) do { __builtin_amdgcn_s_setprio(1); _Pragma("unroll") for (int m = 0; m < 4; ++m) _Pragma("unroll") for (int n = 0; n < 2; ++n) { \
        if constexpr (F8) mfma_f8_inplace(acc[ai][bj][m][n], cat_i8(Bt[n][0], Bt[n][1]), cat_i8(At[m][0], At[m][1])); \
        else { _Pragma("unroll") for (int k = 0; k < 2; ++k) acc[ai][bj][m][n] = __builtin_amdgcn_mfma_f32_16x16x32_f16(__builtin_bit_cast(f16x8, Bt[n][k]), __builtin_bit_cast(f16x8, At[m][k]), acc[ai][bj][m][n], 0, 0, 0); } } \
        __builtin_amdgcn_s_setprio(0); } while (0)
#define PG8_WAIT_V(n) asm volatile("s_waitcnt vmcnt(" #n ")" ::: "memory")
#define PG8_WAIT_L(n) asm volatile("s_waitcnt lgkmcnt(" #n ")" ::: "memory")
#define PG8_BAR __builtin_amdgcn_s_barrier()
#define PG8_SCHED __builtin_amdgcn_sched_barrier(0)
    Unit cur, nxt; int ui = 0;
    if (!S.next(0, cur)) return;
    f32x4 acc[2][2][4][2];
#pragma unroll
    for (int a = 0; a < 2; ++a)
#pragma unroll
        for (int b = 0; b < 2; ++b)
#pragma unroll
            for (int m = 0; m < 4; ++m)
#pragma unroll
                for (int n = 0; n < 2; ++n) { float z0, z1, z2, z3; asm volatile("v_mov_b32 %0, 0\n\tv_mov_b32 %1, 0\n\tv_mov_b32 %2, 0\n\tv_mov_b32 %3, 0" : "=v"(z0), "=v"(z1), "=v"(z2), "=v"(z3)); acc[a][b][m][n] = (f32x4){z0, z1, z2, z3}; }
    bf16x8 At[4][2], B0[2][2], B1[2][2];
    const char* cA = (const char*)g.A + (size_t)cur.pm * tstep; const char* cB = (const char*)g.Bt + (size_t)cur.pn * tstep;
    S.a_ready(cur);
    if constexpr (SP2) {
        PG8_STAGE(PG8_SB(0, 0), cB, voffB); PG8_STAGE(PG8_SB(0, 1), cB + hstep, voffB); PG8_STAGE(PG8_SA(0, 0), cA, voffA); PG8_STAGE(PG8_SA(0, 1), cA + hstep, voffA);
        if (wr == 1) PG8_BAR;
        PG8_WAIT_V(2); PG8_BAR;
        PG8_STAGE(PG8_SB(1, 0), cB + kstep, voffB); PG8_STAGE(PG8_SA(1, 0), cA + kstep, voffA); PG8_STAGE(PG8_SB(1, 1), cB + hstep + kstep, voffB);
        PG8_WAIT_V(6); PG8_BAR;
    } else {
        PG8_STAGE(PG8_SB(0, 0), cB, voffB); PG8_STAGE(PG8_SA(0, 0), cA, voffA); PG8_STAGE(PG8_SB(0, 1), cB + hstep, voffB); PG8_STAGE(PG8_SA(0, 1), cA + hstep, voffA);
        if (wr == 1) PG8_BAR;
        PG8_WAIT_V(4); PG8_BAR;
        PG8_STAGE(PG8_SB(1, 0), cB + kstep, voffB); PG8_STAGE(PG8_SA(1, 0), cA + kstep, voffA); PG8_STAGE(PG8_SB(1, 1), cB + hstep + kstep, voffB);
        PG8_WAIT_V(6); PG8_BAR;
    }
    for (;;) {
        const bool has_next = S.next(ui + 1, nxt);
        const char* nA = has_next ? (const char*)g.A + (size_t)nxt.pm * tstep : cA; const char* nB = has_next ? (const char*)g.Bt + (size_t)nxt.pn * tstep : cB;
        for (int t = 0; t < nt; t += 2) {
            const bool last = (t == nt - 2);
            const char* a1 = cA + (size_t)(t + 1) * kstep;
            const char* a2 = last ? nA : cA + (size_t)(t + 2) * kstep; const char* b2 = last ? nB : cB + (size_t)(t + 2) * kstep;
            const char* a3 = a2 + kstep; const char* b3 = b2 + kstep;
            if (last && has_next) S.a_ready(nxt);
            if constexpr (SP2) {
            PG8_LDB(B0, 0, 0); PG8_LDB(B1, 0, 1); PG8_SCHED; PG8_LDA(At, 0, 0); PG8_STAGE(PG8_SA(1, 1), a1 + hstep, voffA);
            PG8_WAIT_V(8); PG8_WAIT_L(0); PG8_BAR; PG8_MMA(0, 0, At, B0); PG8_MMA(0, 1, At, B1); PG8_BAR; PG8_SCHED;
            PG8_LDA(At, 0, 1); PG8_STAGE(PG8_SB(0, 0), b2, voffB); PG8_STAGE(PG8_SB(0, 1), b2 + hstep, voffB); PG8_STAGE(PG8_SA(0, 0), a2, voffA);
            PG8_WAIT_V(8); PG8_WAIT_L(0); PG8_BAR; PG8_MMA(1, 0, At, B0); PG8_MMA(1, 1, At, B1); PG8_BAR; PG8_SCHED;
            PG8_LDB(B0, 1, 0); PG8_LDB(B1, 1, 1); PG8_SCHED; PG8_LDA(At, 1, 0); PG8_STAGE(PG8_SA(0, 1), a2 + hstep, voffA);
            PG8_WAIT_V(8); PG8_WAIT_L(0); PG8_BAR; PG8_MMA(0, 0, At, B0); PG8_MMA(0, 1, At, B1); PG8_BAR; PG8_SCHED;
            PG8_LDA(At, 1, 1); PG8_STAGE(PG8_SB(1, 0), b3, voffB); PG8_STAGE(PG8_SB(1, 1), b3 + hstep, voffB); PG8_STAGE(PG8_SA(1, 0), a3, voffA);
            PG8_WAIT_V(8); PG8_WAIT_L(0); PG8_BAR; PG8_MMA(1, 0, At, B0); PG8_MMA(1, 1, At, B1); PG8_BAR; PG8_SCHED;
            } else {
            PG8_LDB(B0, 0, 0); PG8_SCHED; PG8_LDA(At, 0, 0); PG8_STAGE(PG8_SA(1, 1), a1 + hstep, voffA);
            PG8_WAIT_L(8); PG8_BAR; PG8_WAIT_L(0); PG8_MMA(0, 0, At, B0); PG8_BAR; PG8_SCHED;
            PG8_LDB(B1, 0, 1); PG8_STAGE(PG8_SB(0, 0), b2, voffB);
            PG8_BAR; PG8_WAIT_L(0); PG8_MMA(0, 1, At, B1); PG8_BAR;
            PG8_LDA(At, 0, 1); PG8_STAGE(PG8_SA(0, 0), a2, voffA);
            PG8_BAR; PG8_WAIT_L(0); PG8_MMA(1, 0, At, B0); PG8_BAR; PG8_SCHED;
            PG8_STAGE(PG8_SB(0, 1), b2 + hstep, voffB);
            PG8_WAIT_V(6); PG8_BAR; PG8_MMA(1, 1, At, B1); PG8_BAR;
            PG8_LDB(B0, 1, 0); PG8_SCHED; PG8_LDA(At, 1, 0); PG8_STAGE(PG8_SA(0, 1), a2 + hstep, voffA);
            PG8_WAIT_L(8); PG8_BAR; PG8_WAIT_L(0); PG8_MMA(0, 0, At, B0); PG8_BAR; PG8_SCHED;
            PG8_LDB(B1, 1, 1); PG8_STAGE(PG8_SB(1, 0), b3, voffB);
            PG8_BAR; PG8_WAIT_L(0); PG8_MMA(0, 1, At, B1); PG8_BAR;
            PG8_LDA(At, 1, 1); PG8_STAGE(PG8_SA(1, 0), a3, voffA);
            PG8_BAR; PG8_WAIT_L(0); PG8_MMA(1, 0, At, B0); PG8_BAR; PG8_SCHED;
            PG8_STAGE(PG8_SB(1, 1), b3 + hstep, voffB);
            PG8_WAIT_V(6); PG8_BAR; PG8_MMA(1, 1, At, B1); PG8_BAR;
            }
        }
        if constexpr (F8) asm volatile("s_nop 15\n\ts_nop 7" ::: "memory");
        if constexpr (ALIGN_EPI) { if (wr == 0) PG8_BAR; }
        if constexpr (!Epi::AFTER_DRAIN) { E(acc, cur, wr, wc, fr, fq); S.done(cur); }
        if (!has_next) break;
#pragma unroll
        for (int a = 0; a < 2; ++a)
#pragma unroll
            for (int b = 0; b < 2; ++b)
#pragma unroll
                for (int m = 0; m < 4; ++m)
#pragma unroll
                    for (int n = 0; n < 2; ++n) { float z0, z1, z2, z3; asm volatile("v_mov_b32 %0, 0\n\tv_mov_b32 %1, 0\n\tv_mov_b32 %2, 0\n\tv_mov_b32 %3, 0" : "=v"(z0), "=v"(z1), "=v"(z2), "=v"(z3)); acc[a][b][m][n] = (f32x4){z0, z1, z2, z3}; }
        cur = nxt; cA = nA; cB = nB; ++ui;
        if constexpr (ALIGN_EPI) { if (wr == 1) PG8_BAR; }
    }
    PG8_WAIT_V(0);
    if constexpr (!ALIGN_EPI) { if (wr == 0) PG8_BAR; }
    PG8_BAR;
    if constexpr (Epi::AFTER_DRAIN) { E.fused(acc, cur, wr, wc, fr, fq, lds, wid, lane); S.done(cur); }
#undef PG8_SA
#undef PG8_SB
#undef PG8_STAGE
#undef PG8_LDA
#undef PG8_LDB
#undef PG8_MMA
#undef PG8_WAIT_V
#undef PG8_WAIT_L
#undef PG8_BAR
#undef PG8_SCHED
}
}

#ifndef PG8_SP2
#define PG8_SP2 true
#endif

#define GAS __attribute__((address_space(1)))
#define LAS __attribute__((address_space(3)))
typedef unsigned short bf16;
typedef unsigned v4u __attribute__((ext_vector_type(4)));
typedef unsigned v2u __attribute__((ext_vector_type(2)));
typedef float f32x4 __attribute__((ext_vector_type(4)));
typedef float f32x2 __attribute__((ext_vector_type(2)));
typedef float f32x16 __attribute__((ext_vector_type(16)));
typedef short bf16x8 __attribute__((ext_vector_type(8)));
typedef short s16x4 __attribute__((ext_vector_type(4)));
typedef GAS unsigned gu32;
typedef GAS unsigned long long gu64;
typedef LAS const char* lcp;
typedef LAS char* lwp;
#define RLX_AGENT __ATOMIC_RELAXED, __HIP_MEMORY_SCOPE_AGENT
#define LDS_WAIT() asm volatile("s_waitcnt lgkmcnt(0)" ::: "memory")
#define VM_WAIT() asm volatile("s_waitcnt vmcnt(0)" ::: "memory")
#define WG_BAR() do { asm volatile("s_waitcnt vmcnt(0) lgkmcnt(0)" ::: "memory"); __builtin_amdgcn_s_barrier(); asm volatile("" ::: "memory"); } while (0)
#define DI __device__ __forceinline__
#define MFMA32(a, b, c) __builtin_amdgcn_mfma_f32_32x32x16_f16(__builtin_bit_cast(pg8::f16x8, (a)), __builtin_bit_cast(pg8::f16x8, (b)), (c), 0, 0, 0)
DI unsigned pk2(float lo, float hi) { return pg8::cvt_pk_bf16(lo, hi); }
DI float bflo(unsigned w) { return pg8::bf_lo(w); }
DI float bfhi(unsigned w) { return pg8::bf_hi(w); }
DI float ex2(float x) { return __builtin_amdgcn_exp2f(x); }
DI f32x16 zero16() { float z = 0.f; asm volatile("" : "+v"(z)); return (f32x16){z, z, z, z, z, z, z, z, z, z, z, z, z, z, z, z}; }
DI int crow(int r, int hi) { return (r & 3) + 8 * (r >> 2) + 4 * hi; }
#define SWZ_XOR(v, m) __uint_as_float((unsigned)__builtin_amdgcn_ds_swizzle((int)__float_as_uint(v), ((m) << 10) | 0x1f))
DI float half_swap_add(float v);
DI float wave_sum(float v) { v += SWZ_XOR(v, 1); v += SWZ_XOR(v, 2); v += SWZ_XOR(v, 4); v += SWZ_XOR(v, 8); v += SWZ_XOR(v, 16); return half_swap_add(v); }
DI float shfl_lane(float v, int src_lane) { return __uint_as_float((unsigned)__builtin_amdgcn_ds_bpermute(src_lane << 2, (int)__float_as_uint(v))); }
DI float half_swap_add(float v) { auto rr = __builtin_amdgcn_permlane32_swap(__float_as_uint(v), __float_as_uint(v), false, false); return __uint_as_float(rr[0]) + __uint_as_float(rr[1]); }
DI float half_swap_max(float v) { auto rr = __builtin_amdgcn_permlane32_swap(__float_as_uint(v), __float_as_uint(v), false, false); return fmaxf(__uint_as_float(rr[0]), __uint_as_float(rr[1])); }
typedef short v4i16_t __attribute__((ext_vector_type(4)));
DI s16x4 vtr(lcp p) { return __builtin_bit_cast(s16x4, __builtin_amdgcn_ds_read_tr16_b64_v4i16((LAS v4i16_t*)p)); }
DI bf16x8 cat8(s16x4 lo, s16x4 hi) { return (bf16x8){lo[0], lo[1], lo[2], lo[3], hi[0], hi[1], hi[2], hi[3]}; }
DI bf16x8 trfrag(lcp p) { return cat8(vtr(p), vtr(p + 512)); }
DI bf16x8 ldfrag(lcp p) { return *(const LAS bf16x8*)p; }
DI void glds16(const void* gsrc, LAS void* ldst) { __builtin_amdgcn_global_load_lds((const unsigned*)gsrc, (LAS unsigned*)ldst, 16, 0, 0); }
#define PACK8(x, s) ((bf16x8)__builtin_bit_cast(bf16x8, (v4u){pk2((x)[8 * (s) + 0], (x)[8 * (s) + 1]), pk2((x)[8 * (s) + 2], (x)[8 * (s) + 3]), pk2((x)[8 * (s) + 4], (x)[8 * (s) + 5]), pk2((x)[8 * (s) + 6], (x)[8 * (s) + 7])}))

constexpr int RING_OFF = 0, RING_BYTES = 131072;
constexpr int TAB_OFF = 131072;
constexpr int MISC_OFF = 163840 - 256;
constexpr int LDS_BYTES = 163840;
constexpr int AT_K = 0, AT_V = 32768, AT_WS = 65536, AT_STG = 67584;
constexpr int ML_K = 0, ML_V = 65536, ML_VW = 81920, ML_C = 98304, ML_N = 131072, ML_G2 = 131584, ML_M2 = 132096, ML_FI = 132608, ML_EI = 133120, ML_WK = 133632, ML_WKB = 134144, ML_SC = 134400, ML_WS = 134464, ML_STG = 136512;
static_assert(ML_STG + 4 * 4096 <= MISC_OFF && AT_STG + 8 * 4096 <= MISC_OFF && TAB_OFF + 16384 <= MISC_OFF, "LDS map");

#define XB_TMO      128
#define XB_XCNT(j)  (256  + 64 * (j))
#define XB_XSUB(j)  (1280 + 64 * (j))
#define XB_XGEN(j)  (2304 + 64 * (j))
#define XB_TOP      3328
#define XB_TOPGEN   3392
#define XCD_BAR_WORDS 3456
#define XB_SPIN_CAP (1u << 18)

__device__ __forceinline__ unsigned xb_ld(unsigned* p)              { return __hip_atomic_load(p, __ATOMIC_RELAXED, __HIP_MEMORY_SCOPE_AGENT); }
__device__ __forceinline__ unsigned xb_add(unsigned* p, unsigned v) { return __hip_atomic_fetch_add(p, v, __ATOMIC_RELAXED, __HIP_MEMORY_SCOPE_AGENT); }
__device__ __forceinline__ unsigned xb_xcc_id() { return (unsigned)__builtin_amdgcn_s_getreg((3 << 11) | 20) & 0xFu; }
#define XB_SPIN(cond, bar) do { unsigned _sp = 0; while (cond) { __builtin_amdgcn_s_sleep(1); \
    if ((++_sp & 255u) == 0u) { if (xb_ld(&(bar)[XB_TMO])) break; if (_sp > XB_SPIN_CAP) { atomicAdd(&(bar)[XB_TMO], 1u); break; } } } } while (0)

struct XcdBarrier {
    unsigned* bar; unsigned x;
    volatile LAS unsigned* st;
};

__device__ __forceinline__ XcdBarrier xcd_barrier_post(unsigned* bar, volatile LAS unsigned* st) {
    XcdBarrier b; b.bar = bar; b.x = xb_xcc_id(); b.st = st;
    if (threadIdx.x == 0) (void)xb_add(&bar[XB_XCNT(b.x)], 1u);
    return b;
}
__device__ __forceinline__ void xcd_barrier_complete(unsigned* bar, unsigned x, unsigned& nloc, unsigned& nx) {
    const unsigned G = gridDim.x * gridDim.y * gridDim.z;
    unsigned sum, cnt, mine, sp = 0u;
    for (;;) {
        sum = 0u; cnt = 0u; mine = 0u;
#pragma unroll
        for (unsigned j = 0; j < 16; ++j) { const unsigned c = xb_ld(&bar[XB_XCNT(j)]); sum += c; cnt += (c > 0u) ? 1u : 0u; mine = (j == x) ? c : mine; }
        if (sum == G) break;
        __builtin_amdgcn_s_sleep(1);
        if ((++sp & 255u) == 0u) { if (xb_ld(&bar[XB_TMO])) break; if (sp > XB_SPIN_CAP) { atomicAdd(&bar[XB_TMO], 1u); break; } }
    }
    nloc = mine > 0u ? mine : 1u; nx = cnt > 0u ? cnt : 1u;
}

__device__ __forceinline__ void xcd_barrier(const XcdBarrier& b) {
    asm volatile("s_waitcnt vmcnt(0)" ::: "memory");
    __syncthreads();
    if (threadIdx.x == 0) {
        unsigned* bar = b.bar;
        __builtin_amdgcn_s_waitcnt(0);
        unsigned nloc = b.st[0], nx = b.st[1];
        if (nloc == 0u) { xcd_barrier_complete(bar, b.x, nloc, nx); b.st[0] = nloc; b.st[1] = nx; }
        const unsigned old = xb_add(&bar[XB_XSUB(b.x)], 1u);
        const unsigned gen = old / nloc;
        if (old + 1u == (gen + 1u) * nloc) {
            __builtin_amdgcn_fence(__ATOMIC_RELEASE, "agent");
            asm volatile("s_waitcnt vmcnt(0)" ::: "memory");
            const unsigned og = xb_add(&bar[XB_TOP], 1u);
            const unsigned tg = og / nx;
            if (og + 1u == (tg + 1u) * nx) xb_add(&bar[XB_TOPGEN], 1u);
            else XB_SPIN(xb_ld(&bar[XB_TOPGEN]) == tg, bar);
            __builtin_amdgcn_fence(__ATOMIC_ACQUIRE, "agent");
            xb_add(&bar[XB_XGEN(b.x)], 1u);
            asm volatile("s_waitcnt vmcnt(0)" ::: "memory");
        } else {
            XB_SPIN(xb_ld(&bar[XB_XGEN(b.x)]) == gen, bar);
            __builtin_amdgcn_fence(__ATOMIC_ACQUIRE, "agent");
            asm volatile("s_waitcnt vmcnt(0)" ::: "memory");
        }
    }
    __syncthreads();
}
DI void attn_phase(unsigned char* ldsg, const bf16* QKV, unsigned char* AO8, const float* sinks, int G, int bid, int wave_in) {
    int wid = wave_in; asm volatile("" : "+s"(wid));
    const int lane = pg8::pg8_lane(), tid = wid * 64 + lane, r32 = lane & 31, hi = lane >> 5;
    LAS unsigned char* lds = (LAS unsigned char*)ldsg; const lcp L = (lcp)lds;
    LAS float* wsf = (LAS float*)(lds + AT_WS) + wid * 64;
    LAS unsigned char* stg = lds + AT_STG + wid * 4096;
    const lcp vlane = L + AT_V + ((lane >> 4) & 1) * 32 + (lane & 3) * 8 + (4 * hi + ((lane & 15) >> 2)) * 64;
    const lcp klane = L + AT_K + hi * 1024 + r32 * 16;
    for (int unit = bid; unit < BATCH * 16 * 4; unit += G) {
        const int kvh = unit & 3, nb = (unit >> 2) & 15, b = unit >> 6;
        const long rowq = (long)b * SEQ + nb * 128, rowk = rowq - 128;
        const int slot_lo = (nb == 0) ? 2 : 0;
        for (int sl = slot_lo; sl < 4; ++sl) {
            glds16(QKV + (rowk + 64 * sl + lane) * NQKV + 2048 + 64 * kvh + 8 * wid, lds + AT_K + sl * 8192 + wid * 1024);
            glds16(QKV + (rowk + 64 * sl + 16 * (wid & 3) + (lane >> 2)) * NQKV + 2304 + 64 * kvh + (wid >> 2) * 32 + (lane & 3) * 8, lds + AT_V + sl * 8192 + wid * 1024);
        }
        const int hq = 8 * kvh + wid;
        const bf16* qsrc = QKV + (rowq + r32) * NQKV + 64 * hq + 8 * hi;
        bf16x8 qn[4];
#pragma unroll
        for (int d0 = 0; d0 < 4; ++d0) qn[d0] = *(const bf16x8*)(qsrc + 16 * d0);
        const float slope2 = ex2(-0.25f * (float)(hq + 1)) * LOG2E, sink2 = sinks[hq] * LOG2E;
        const float base_l = -slope2 * (float)(r32 - 4 * hi);
        WG_BAR();
#pragma unroll 1
        for (int j = 0; j < 4; ++j) {
            const int ilo = (nb == 0) ? 4 - j : 0;
            bf16x8 qr[4];
#pragma unroll
            for (int d0 = 0; d0 < 4; ++d0) qr[d0] = qn[d0];
            if (j < 3) {
#pragma unroll
                for (int d0 = 0; d0 < 4; ++d0) qn[d0] = *(const bf16x8*)(qsrc + (size_t)(32 * (j + 1)) * NQKV + 16 * d0);
            }
            float sl2 = slope2, bl = base_l; asm volatile("" : "+v"(sl2), "+v"(bl));
            f32x16 p[5];
#pragma unroll
            for (int i = 0; i < 5; ++i) {
                if (i >= ilo) {
                    const int kt = j + i; const lcp kb = klane + (kt >> 1) * 8192 + (kt & 1) * 512;
                    f32x16 a = zero16();
#pragma unroll
                    for (int d0 = 0; d0 < 4; ++d0) a = MFMA32(ldfrag(kb + d0 * 2048), qr[d0], a);
#pragma unroll
                    for (int r = 0; r < 16; ++r) {
                        const int cr = (r & 3) + 8 * (r >> 2);
                        float s = fmaf(sl2, (float)(cr - 128 + 32 * i), fmaf(a[r], LOG2E, bl));
                        if (i == 0) { if (!(cr + 4 * hi > r32)) s = -INFINITY; }
                        if (i == 4) { if (!(cr + 4 * hi <= r32)) s = -INFINITY; }
                        a[r] = s;
                    }
                    p[i] = a;
                } else {
#pragma unroll
                    for (int r = 0; r < 16; ++r) p[i][r] = -INFINITY;
                }
            }
            float mx = sink2;
#pragma unroll
            for (int i = 0; i < 5; ++i)
#pragma unroll
                for (int r = 0; r < 16; ++r) mx = fmaxf(mx, p[i][r]);
            mx = half_swap_max(mx);
            float ls = 0.f;
#pragma unroll
            for (int i = 0; i < 5; ++i)
#pragma unroll
                for (int r = 0; r < 16; ++r) { const float e = ex2(p[i][r] - mx); p[i][r] = e; ls += e; }
            ls = half_swap_add(ls) + ex2(sink2 - mx);
            f32x16 o0 = zero16(), o1 = zero16();
#pragma unroll
            for (int i = 0; i < 5; ++i) {
                if (i >= ilo) {
                    const int kt = j + i; const lcp vb = vlane + (kt >> 1) * 8192 + (kt & 1) * 2048;
                    const bf16x8 pa = PACK8(p[i], 0), pb = PACK8(p[i], 1);
                    o0 = MFMA32(pa, trfrag(vb), o0);        o0 = MFMA32(pb, trfrag(vb + 1024), o0);
                    o1 = MFMA32(pa, trfrag(vb + 4096), o1); o1 = MFMA32(pb, trfrag(vb + 4096 + 1024), o1);
                }
            }
            if (hi == 0) wsf[r32] = __builtin_amdgcn_rcpf(ls);
#pragma unroll
            for (int r = 0; r < 16; ++r) {
                const int orow = crow(r, hi); const float rl = wsf[orow] * pg8::F8_SO;
                int pk; asm volatile("" : "=v"(pk)); pk = __builtin_amdgcn_cvt_pk_fp8_f32(o0[r] * rl, o1[r] * rl, pk, false);
                stg[orow * 64 + r32] = (unsigned char)(pk & 0xff);
                stg[orow * 64 + 32 + r32] = (unsigned char)((pk >> 8) & 0xff);
            }
#pragma unroll
            for (int i4 = 0; i4 < 2; ++i4) {
                const int row = i4 * 16 + (lane >> 2), ch = lane & 3;
                const v4u v = *(const LAS v4u*)(stg + row * 64 + ch * 16);
                *(v4u*)(AO8 + (rowq + 32 * j + row) * D + 64 * hq + ch * 16) = v;
            }
        }
        WG_BAR();
    }
}

constexpr int ML_GSET = ML_STG + 4 * 4096 - ML_G2;
static_assert(ML_G2 + ML_GSET + (ML_WS - ML_G2) <= MISC_OFF, "LDS map: second gate-array set");
#define DPPF(old, src, ctrl, rmask, bc) __uint_as_float((unsigned)__builtin_amdgcn_update_dpp((int)__float_as_uint(old), (int)__float_as_uint(src), (ctrl), (rmask), 0xf, (bc)))
DI float scan_add64(float v) {
    v += DPPF(0.f, v, 0x111, 0xf, true); v += DPPF(0.f, v, 0x112, 0xf, true); v += DPPF(0.f, v, 0x114, 0xf, true); v += DPPF(0.f, v, 0x118, 0xf, true);
    v += DPPF(0.f, v, 0x142, 0xa, false); v += DPPF(0.f, v, 0x143, 0xc, false); return v;
}
DI float scan_max64(float v) {
    const float ninf = -INFINITY;
    v = fmaxf(v, DPPF(ninf, v, 0x111, 0xf, false)); v = fmaxf(v, DPPF(ninf, v, 0x112, 0xf, false)); v = fmaxf(v, DPPF(ninf, v, 0x114, 0xf, false)); v = fmaxf(v, DPPF(ninf, v, 0x118, 0xf, false));
    v = fmaxf(v, DPPF(ninf, v, 0x142, 0xa, false)); v = fmaxf(v, DPPF(ninf, v, 0x143, 0xc, false)); return v;
}
DI float ml_gate_scan(LAS unsigned char* lds, int gofs, const float* GT, long row0, int h, int lane, float m_prev) {
    LAS float* G2 = (LAS float*)(lds + ML_G2 + gofs); LAS float* M2 = (LAS float*)(lds + ML_M2 + gofs); LAS float* FI = (LAS float*)(lds + ML_FI + gofs); LAS float* EI = (LAS float*)(lds + ML_EI + gofs);
    LAS float* WK = (LAS float*)(lds + ML_WK + gofs); LAS bf16* WKB = (LAS bf16*)(lds + ML_WKB + gofs); LAS float* SC = (LAS float*)(lds + ML_SC + gofs);
    const float* gp = GT + (size_t)(row0 + 2 * lane) * 8;
    const float i0 = gp[h], f0 = gp[4 + h], i1 = gp[8 + h], f1 = gp[12 + h];
    const float lf0 = -0.6931471805599453f * __builtin_amdgcn_logf(1.f + ex2(-LOG2E * f0)), lf1 = -0.6931471805599453f * __builtin_amdgcn_logf(1.f + ex2(-LOG2E * f1));
    const float incl = scan_add64(lf0 + lf1);
    const float b1 = incl, b0 = incl - lf1;
    const float g0 = i0 - b0, g1 = i1 - b1;
    const float cm = scan_max64(fmaxf(g0, g1));
    const float cprev = DPPF(-INFINITY, cm, 0x138, 0xf, false);
    const float M0 = fmaxf(m_prev, fmaxf(cprev, g0)), M1 = fmaxf(m_prev, cm);
    const float Mend = __uint_as_float((unsigned)__builtin_amdgcn_readlane((int)__float_as_uint(M1), 63)), blast = __uint_as_float((unsigned)__builtin_amdgcn_readlane((int)__float_as_uint(b1), 63));
    *(LAS f32x2*)(G2 + 2 * lane) = (f32x2){g0 * LOG2E, g1 * LOG2E};
    *(LAS f32x2*)(M2 + 2 * lane) = (f32x2){M0 * LOG2E, M1 * LOG2E};
    *(LAS f32x2*)(FI + 2 * lane) = (f32x2){ex2((m_prev - M0) * LOG2E), ex2((m_prev - M1) * LOG2E)};
    *(LAS f32x2*)(EI + 2 * lane) = (f32x2){ex2(-(b0 + M0) * LOG2E), ex2(-(b1 + M1) * LOG2E)};
    const float w0 = ex2((g0 - Mend) * LOG2E), w1 = ex2((g1 - Mend) * LOG2E);
    *(LAS f32x2*)(WK + 2 * lane) = (f32x2){w0, w1};
    *(LAS unsigned*)(WKB + 2 * lane) = pk2(w0, w1);
    if (lane == 0) SC[0] = ex2((m_prev - Mend) * LOG2E);
    return blast + Mend;
}
template <int VAR = 0>
DI void mlstm_phase(unsigned char* ldsg, const bf16* MP, const float* GT, bf16* HG, int G, int bid, int wave_in) {
    int wid = wave_in; asm volatile("" : "+s"(wid));
    const int lane0 = pg8::pg8_lane(), tid = wid * 64 + lane0;
    LAS unsigned char* lds = (LAS unsigned char*)ldsg; const lcp L = (lcp)lds;
    LAS float* wsf = (LAS float*)(lds + ML_WS) + wid * 64;
    for (int unit = bid; unit < BATCH * 4 * 8; unit += G) {
        const int ux = unit & 7, uy = unit >> 3, bh = ux + 8 * (uy >> 3), sl = uy & 7, h = bh & 3, b = bh >> 2;
        const bf16* Qp = MP + 256 * h; const bf16* Kp = MP + 1024 + 256 * h; const bf16* Vp = MP + 2048 + 512 * h + 64 * sl; const bf16* OGp = MP + 4096 + 512 * h + 64 * sl;
        { unsigned z = 0u; asm volatile("" : "+v"(z)); for (int i = tid; i < (32768 + 512) / 16; i += 512) *(LAS v4u*)(lds + ML_C + i * 16) = (v4u){z, z, z, z}; }
        f32x16 T[6];
#pragma unroll
        for (int x = 0; x < 6; ++x) T[x] = zero16();
        float m_prev = 0.f;
        v4u X[16], vreg[2];
        { const long row0 = (long)b * SEQ; const int lane = lane0, r32 = lane & 31, hi = lane >> 5;
          if (wid >= 4) {
#pragma unroll
              for (int i = 0; i < 16; ++i) X[i] = *(const v4u*)(Kp + (row0 + 8 * i + (lane & 7)) * NMI + (8 * (wid - 4) + (lane >> 3)) * 8);
          } else {
#pragma unroll
              for (int ks = 0; ks < 16; ++ks) X[ks] = *(const v4u*)(Qp + (row0 + 32 * wid + r32) * NMI + 16 * ks + 8 * hi);
          }
#pragma unroll
          for (int i = 0; i < 2; ++i) vreg[i] = *(const v4u*)(Vp + (row0 + 64 * i + 16 * (wid & 3) + (lane >> 2)) * NMI + (wid >> 2) * 32 + (lane & 3) * 8);
          if (wid == 4 && !(VAR & 16)) m_prev = ml_gate_scan(lds, 0, GT, row0, h, lane, m_prev);
        }
        WG_BAR();
        for (int c = 0; c < 16; ++c) {
            const long row0 = (long)b * SEQ + 128 * c;
            const int gofs = (c & 1) * ML_GSET;
            const int lane = pg8::pg8_lane(), r32 = lane & 31, hi = lane >> 5;
            const int blk = (lane >> 4) & 1, q4 = (lane & 15) >> 2, p4 = lane & 3;
            const int vlo_ = blk * 32 + p4 * 8 + (4 * hi + q4) * 64;
            const int ktl_ = (2 * blk + (p4 >> 1)) * 2048 + (q4 + 4 * hi) * 16 + (p4 & 1) * 8;
            const int cbl_ = hi * 1024 + r32 * 16, kbl_ = hi * 2048 + r32 * 16;
            const unsigned m0 = (r32 == 0) ? 0xffffffffu : 0u; const v4u m0v = {m0, m0, m0, m0};
            LAS float* G2 = (LAS float*)(lds + ML_G2 + gofs); LAS float* M2 = (LAS float*)(lds + ML_M2 + gofs); LAS float* FI = (LAS float*)(lds + ML_FI + gofs); LAS float* EI = (LAS float*)(lds + ML_EI + gofs);
            LAS float* WK = (LAS float*)(lds + ML_WK + gofs); LAS bf16* WKB = (LAS bf16*)(lds + ML_WKB + gofs); LAS float* SC = (LAS float*)(lds + ML_SC + gofs);
            VM_WAIT();
            if (wid >= 4) {
#pragma unroll
                for (int i = 0; i < 16; ++i) *(LAS v4u*)(lds + ML_K + (8 * (wid - 4) + (lane >> 3)) * 2048 + (8 * i + (lane & 7)) * 16) = X[i];
            }
#pragma unroll
            for (int i = 0; i < 2; ++i) { const float w = WK[64 * i + 16 * (wid & 3) + (lane >> 2)]; const v4u v = vreg[i]; v4u o;
                o.x = pk2(bflo(v.x) * w, bfhi(v.x) * w); o.y = pk2(bflo(v.y) * w, bfhi(v.y) * w); o.z = pk2(bflo(v.z) * w, bfhi(v.z) * w); o.w = pk2(bflo(v.w) * w, bfhi(v.w) * w);
                *(LAS v4u*)(lds + ML_V + i * 8192 + wid * 1024 + lane * 16) = v;
                *(LAS v4u*)(lds + ML_VW + i * 8192 + wid * 1024 + lane * 16) = o; }
            WG_BAR();
            const bool more = c + 1 < 16;
            if (more && !(VAR & 32)) {
                const long row1 = row0 + 128;
                if (wid >= 4) {
#pragma unroll
                    for (int i = 0; i < 16; ++i) X[i] = *(const v4u*)(Kp + (row1 + 8 * i + (lane & 7)) * NMI + (8 * (wid - 4) + (lane >> 3)) * 8);
                }
#pragma unroll
                for (int i = 0; i < 2; ++i) vreg[i] = *(const v4u*)(Vp + (row1 + 64 * i + 16 * (wid & 3) + (lane >> 2)) * NMI + (wid >> 2) * 32 + (lane & 3) * 8);
            }
            if (wid < 4) {
                const int tt = wid;
                v4u ogv[4];
#pragma unroll
                for (int i4 = 0; i4 < 4; ++i4) ogv[i4] = *(const v4u*)(OGp + (row0 + 32 * tt + i4 * 8 + (lane >> 3)) * NMI + (lane & 7) * 8);
                T[0] = zero16(); T[1] = zero16(); T[2] = zero16();
                if (!(VAR & 4)) { const lcp cb = L + ML_C + cbl_; const lcp nbp = L + ML_N + 16 * hi;
#pragma unroll
                  for (int ks = 0; ks < 16; ++ks) {
                      const bf16x8 c0 = ldfrag(cb + ks * 2048), c1 = ldfrag(cb + ks * 2048 + 512);
                      const bf16x8 nf = __builtin_bit_cast(bf16x8, __builtin_bit_cast(v4u, ldfrag(nbp + ks * 32)) & m0v);
                      T[0] = MFMA32(__builtin_bit_cast(bf16x8, X[ks]), c0, T[0]); T[1] = MFMA32(__builtin_bit_cast(bf16x8, X[ks]), c1, T[1]); T[2] = MFMA32(__builtin_bit_cast(bf16x8, X[ks]), nf, T[2]);
                      if ((ks & 3) == 3) __builtin_amdgcn_sched_barrier(0);
                  } }
                { float fi[16];
#pragma unroll
                  for (int r = 0; r < 16; ++r) fi[r] = FI[32 * tt + crow(r, hi)];
#pragma unroll
                  for (int r = 0; r < 16; ++r) { T[0][r] *= fi[r]; T[1][r] *= fi[r]; }
                  if (r32 == 0) {
#pragma unroll
                      for (int r = 0; r < 16; ++r) wsf[crow(r, hi)] = T[2][r] * fi[r];
                  } }
                const float Mt = M2[32 * tt + r32];
                float dsum = 0.f;
                for (int st = 0; st <= ((VAR & 2) ? -1 : tt); ++st) {
                    f32x16 S = zero16();
                    const lcp kb = L + ML_K + kbl_ + st * 512;
#pragma unroll
                    for (int ks = 0; ks < 16; ++ks) S = MFMA32(ldfrag(kb + ks * 4096), __builtin_bit_cast(bf16x8, X[ks]), S);
#pragma unroll
                    for (int r = 0; r < 16; ++r) {
                        const float w = ex2(G2[32 * st + crow(r, hi)] - Mt);
                        float v = S[r] * w;
                        if (st == tt && crow(r, hi) > r32) v = 0.f;
                        S[r] = v; dsum += v;
                    }
                    const bf16x8 pa = PACK8(S, 0), pb = PACK8(S, 1);
                    const lcp vb = L + ML_V + (st >> 1) * 8192 + (st & 1) * 2048 + vlo_;
                    T[0] = MFMA32(pa, trfrag(vb), T[0]);        T[0] = MFMA32(pb, trfrag(vb + 1024), T[0]);
                    T[1] = MFMA32(pa, trfrag(vb + 4096), T[1]); T[1] = MFMA32(pb, trfrag(vb + 4096 + 1024), T[1]);
                }
                if (more && !(VAR & 64)) {
#pragma unroll
                    for (int ks = 0; ks < 16; ++ks) X[ks] = *(const v4u*)(Qp + (row0 + 128 + 32 * wid + r32) * NMI + 16 * ks + 8 * hi);
                }
                dsum = half_swap_add(dsum);
                { const float den = wsf[r32] + dsum; const float dn = fmaxf(fabsf(den), EI[32 * tt + r32]);
                  if (hi == 0) wsf[32 + r32] = __builtin_amdgcn_rcpf(dn); }
                LAS bf16* stg = (LAS bf16*)(lds + ML_STG + tt * 4096);
                if (!(VAR & 8)) {
#pragma unroll
                for (int r = 0; r < 16; ++r) {
                    const int orow = crow(r, hi); const float rd = wsf[32 + orow];
                    stg[orow * 64 + r32] = (bf16)(pk2(T[0][r] * rd, 0.f) & 0xffffu);
                    stg[orow * 64 + 32 + r32] = (bf16)(pk2(T[1][r] * rd, 0.f) & 0xffffu);
                }
#pragma unroll
                for (int i4 = 0; i4 < 4; ++i4) {
                    const int row = i4 * 8 + (lane >> 3), ch = lane & 7;
                    const v4u hv = *(const LAS v4u*)(stg + row * 64 + ch * 8);
                    const v4u og = ogv[i4];
                    v4u o;
                    o.x = pk2(bflo(hv.x) * bflo(og.x), bfhi(hv.x) * bfhi(og.x)); o.y = pk2(bflo(hv.y) * bflo(og.y), bfhi(hv.y) * bfhi(og.y));
                    o.z = pk2(bflo(hv.z) * bflo(og.z), bfhi(hv.z) * bfhi(og.z)); o.w = pk2(bflo(hv.w) * bflo(og.w), bfhi(hv.w) * bfhi(og.w));
                    *(v4u*)(HG + (row0 + 32 * tt + row) * D + 512 * h + 64 * sl + ch * 8) = o;
                }
                }
#pragma unroll
                for (int x = 3; x < 6; ++x) T[x] = zero16();
            } else {
                const float decay = SC[0];
#pragma unroll
                for (int x = 0; x < 6; ++x)
#pragma unroll
                    for (int r = 0; r < 16; ++r) T[x][r] *= decay;
#pragma unroll
                for (int dti = 0; dti < ((VAR & 1) ? 0 : 2); ++dti) {
                    const int dt = 2 * (wid - 4) + dti;
                    const lcp ka0 = L + ML_K + dt * 8192 + ktl_;
#pragma unroll
                    for (int s8 = 0; s8 < 8; ++s8) {
                        const lcp ka = ka0 + s8 * 256;
                        const bf16x8 af = cat8(vtr(ka), vtr(ka + 128));
                        const lcp vwb = L + ML_VW + (s8 >> 2) * 8192 + (s8 & 3) * 1024 + vlo_;
                        const bf16x8 b0 = trfrag(vwb), b1 = trfrag(vwb + 4096);
                        const LAS s16x4* wp = (const LAS s16x4*)(WKB + 16 * s8 + 4 * hi);
                        const bf16x8 nb = __builtin_bit_cast(bf16x8, __builtin_bit_cast(v4u, cat8(wp[0], wp[2])) & m0v);
                        T[2 * dti] = MFMA32(af, b0, T[2 * dti]); T[2 * dti + 1] = MFMA32(af, b1, T[2 * dti + 1]); T[4 + dti] = MFMA32(af, nb, T[4 + dti]);
                        if (s8 & 1) __builtin_amdgcn_sched_barrier(0);
                    }
                }
                if (more && wid == 4 && !(VAR & 16)) m_prev = ml_gate_scan(lds, ML_GSET - gofs, GT, row0 + 128, h, lane, m_prev);
            }
            asm volatile("s_waitcnt lgkmcnt(0)" ::: "memory"); __builtin_amdgcn_s_barrier(); asm volatile("" ::: "memory");
            if (wid >= 4) {
#pragma unroll
                for (int dti = 0; dti < 2; ++dti) {
                    const int dt = 2 * (wid - 4) + dti;
#pragma unroll
                    for (int et = 0; et < 2; ++et)
#pragma unroll
                        for (int g = 0; g < 4; ++g)
                            *(LAS v2u*)(lds + ML_C + (4 * dt + g) * 1024 + (32 * et + r32) * 16 + hi * 8) = (v2u){pk2(T[2 * dti + et][4 * g], T[2 * dti + et][4 * g + 1]), pk2(T[2 * dti + et][4 * g + 2], T[2 * dti + et][4 * g + 3])};
                    if (r32 == 0) {
#pragma unroll
                        for (int g = 0; g < 4; ++g)
                            *(LAS v2u*)(lds + ML_N + (32 * dt + 8 * g + 4 * hi) * 2) = (v2u){pk2(T[4 + dti][4 * g], T[4 + dti][4 * g + 1]), pk2(T[4 + dti][4 * g + 2], T[4 + dti][4 * g + 3])};
                    }
                }
            }
        }
        WG_BAR();
    }
}


constexpr int NWAVES = 8;

template <bool F8> DI void tr_strip(const float* W, int ldw, int n0, void* WTv, size_t wt_row0, int Kdim, int kb0, int nkb, const float* g, const float* bb, float cs, float* c1o, float* c2o, LAS float* scr, int lane) {
    bf16* WT = (bf16*)WTv; unsigned char* WT8 = (unsigned char*)WTv;
    const int c = lane & 7;
    float a1[4] = {0.f, 0.f, 0.f, 0.f}, a2[4] = {0.f, 0.f, 0.f, 0.f};
    for (int kb = kb0; kb < kb0 + nkb; ++kb) {
        const int k0 = kb * 64;
#pragma unroll 8
        for (int i = 0; i < 32; ++i) { const int kk = 2 * i + (lane >> 5); scr[kk * 33 + (lane & 31)] = W[(size_t)(k0 + kk) * ldw + n0 + (lane & 31)]; }
        float gk[8], bk[8];
        if (g) { const f32x4 g0 = *(const f32x4*)(g + k0 + 8 * c), g1 = *(const f32x4*)(g + k0 + 8 * c + 4), b0 = *(const f32x4*)(bb + k0 + 8 * c), b1 = *(const f32x4*)(bb + k0 + 8 * c + 4);
#pragma unroll
            for (int i = 0; i < 4; ++i) { gk[i] = g0[i] * cs; gk[4 + i] = g1[i] * cs; bk[i] = b0[i] * cs; bk[4 + i] = b1[i] * cs; } }
        else {
#pragma unroll
            for (int i = 0; i < 8; ++i) { gk[i] = cs; bk[i] = 0.f; } }
        LDS_WAIT(); asm volatile("" ::: "memory");
#pragma unroll
        for (int j = 0; j < 4; ++j) { const int n = (lane >> 3) + 8 * j; const LAS float* s = scr + (8 * c) * 33 + n;
            float v[8];
#pragma unroll
            for (int i = 0; i < 8; ++i) v[i] = s[i * 33];
            a2[j] += ((v[0] * bk[0] + v[1] * bk[1]) + (v[2] * bk[2] + v[3] * bk[3])) + ((v[4] * bk[4] + v[5] * bk[5]) + (v[6] * bk[6] + v[7] * bk[7]));
            if constexpr (F8) {
                float wv[8];
#pragma unroll
                for (int i = 0; i < 8; ++i) wv[i] = v[i] * gk[i];
                const v2u o = pg8::cvt8_f8(wv, pg8::F8_SW);
                a1[j] += ((__builtin_amdgcn_cvt_f32_fp8((int)o.x, 0) + __builtin_amdgcn_cvt_f32_fp8((int)o.x, 1)) + (__builtin_amdgcn_cvt_f32_fp8((int)o.x, 2) + __builtin_amdgcn_cvt_f32_fp8((int)o.x, 3)))
                       + ((__builtin_amdgcn_cvt_f32_fp8((int)o.y, 0) + __builtin_amdgcn_cvt_f32_fp8((int)o.y, 1)) + (__builtin_amdgcn_cvt_f32_fp8((int)o.y, 2) + __builtin_amdgcn_cvt_f32_fp8((int)o.y, 3)));
                *(GAS v2u*)(WT8 + (wt_row0 + n) * Kdim + k0 + 8 * c) = o;
            } else {
                v4u o; o.x = pk2(v[0] * gk[0], v[1] * gk[1]); o.y = pk2(v[2] * gk[2], v[3] * gk[3]); o.z = pk2(v[4] * gk[4], v[5] * gk[5]); o.w = pk2(v[6] * gk[6], v[7] * gk[7]);
                a1[j] += ((bflo(o.x) + bfhi(o.x)) + (bflo(o.y) + bfhi(o.y))) + ((bflo(o.z) + bfhi(o.z)) + (bflo(o.w) + bfhi(o.w)));
                *(GAS v4u*)(WT + (wt_row0 + n) * Kdim + k0 + 8 * c) = o;
            } }
        LDS_WAIT(); asm volatile("" ::: "memory");
    }
    if (g) {
#pragma unroll
        for (int j = 0; j < 4; ++j) { float s1 = a1[j], s2 = a2[j];
            s1 += SWZ_XOR(s1, 1); s2 += SWZ_XOR(s2, 1); s1 += SWZ_XOR(s1, 2); s2 += SWZ_XOR(s2, 2); s1 += SWZ_XOR(s1, 4); s2 += SWZ_XOR(s2, 4);
            if (c == 0) { c1o[(lane >> 3) + 8 * j] = F8 ? s1 * (1.f / pg8::F8_SW) : s1; c2o[(lane >> 3) + 8 * j] = s2; } }
    }
}

DI void prologue(kargs_t a, LAS unsigned char* lds, int gw, int NGW, int wave, int lane) {
    unsigned char* ws = a->ws;
    float* vec = (float*)(ws + WS_VEC);
    const float* ones = (const float*)(ws + WS_VEC + V_ONES); const float* zeros = (const float*)(ws + WS_VEC + V_ZEROS);
    LAS float* scr = (LAS float*)(lds + wave * 16384);
    constexpr int T_UP = 8 * 2 * 176, T_QKV = 2 * 80, T_MI = 2 * 192, T_W2 = 8 * 64 * 4, T_WO = 2 * 64, T_WMO = 2 * 64, T_G = 16;
    constexpr int NT = T_UP + T_QKV + T_MI + T_W2 + T_WO + T_WMO + T_G;
    for (int it = gw; it < NT; it += NGW) {
        int r = it;
        if (r < T_UP) {
            const int f = r / 352, rr = r % 352, which = rr / 176, strip = rr % 176, n0 = 32 * strip;
            const int t = 3 * (f >> 1) + 2 * (f & 1);
            const float* gp = t ? a->ln_g + (size_t)(t - 1) * D : nullptr; const float* bp = t ? a->ln_b + (size_t)(t - 1) * D : nullptr;
            const size_t wrow = (size_t)256 * (n0 / 128) + 128 * which + (n0 % 128);
            const float* W = (which ? a->w3 : a->w1) + (size_t)f * D * FF;
            if (gp) tr_strip<true>(W, FF, n0, ws + WS_W13 + (size_t)f * NUP * D, wrow, D, 0, 32, gp, bp, 1.f, vec + V_C1U / 4 + (size_t)f * NUP + wrow, vec + V_C2U / 4 + (size_t)f * NUP + wrow, scr, lane);
            else { tr_strip<true>(W, FF, n0, ws + WS_W13 + (size_t)f * NUP * D, wrow, D, 0, 32, nullptr, nullptr, 1.f, nullptr, nullptr, scr, lane);
                   if (lane < 32) { vec[V_C1U / 4 + (size_t)f * NUP + wrow + lane] = 0.f; vec[V_C2U / 4 + (size_t)f * NUP + wrow + lane] = 0.f; } }
            continue; }
        r -= T_UP;
        if (r < T_QKV) { const int j = r / 80, n0 = 32 * (r % 80); const int t = 6 * j + 1;
            tr_strip<true>(a->wqkv + (size_t)j * D * NQKV, NQKV, n0, ws + WS_WQKV + (size_t)j * NQKV * D, n0, D, 0, 32, a->ln_g + (size_t)(t - 1) * D, a->ln_b + (size_t)(t - 1) * D, n0 < 2048 ? 0.125f : 1.f,
                     vec + V_C1Q / 4 + j * NQKV + n0, vec + V_C2Q / 4 + j * NQKV + n0, scr, lane);
            continue; }
        r -= T_QKV;
        if (r < T_MI) { const int j = r / 192, n0 = 32 * (r % 192); const int t = 6 * j + 4;
            tr_strip<false>(a->win + (size_t)j * D * NMIW, NMIW, n0, (bf16*)(ws + WS_WIN) + (size_t)j * NMI * D, n0, D, 0, 32, a->ln_g + (size_t)(t - 1) * D, a->ln_b + (size_t)(t - 1) * D, (n0 >= 1024 && n0 < 2048) ? 0.0625f : 1.f,
                     vec + V_C1I / 4 + j * NMI + n0, vec + V_C2I / 4 + j * NMI + n0, scr, lane);
            continue; }
        r -= T_MI;
        if (r < T_W2) { const int f = r / 256, rr = r % 256, strip = rr / 4, kq = rr % 4;
            tr_strip<true>(a->w2 + (size_t)f * FF * D, D, 32 * strip, ws + WS_W2 + (size_t)f * D * FF, 32 * strip, FF, 22 * kq, 22, nullptr, nullptr, 1.f, nullptr, nullptr, scr, lane);
            continue; }
        r -= T_W2;
        if (r < T_WO) { const int j = r / 64, strip = r % 64;
            tr_strip<true>(a->wo + (size_t)j * D * D, D, 32 * strip, ws + WS_WO + (size_t)j * D * D, 32 * strip, D, 0, 32, nullptr, nullptr, 1.f, nullptr, nullptr, scr, lane);
            continue; }
        r -= T_WO;
        if (r < T_WMO) { const int j = r / 64, strip = r % 64;
            tr_strip<false>(a->wmo + (size_t)j * D * D, D, 32 * strip, (bf16*)(ws + WS_WMO) + (size_t)j * D * D, 32 * strip, D, 0, 32, nullptr, nullptr, 1.f, nullptr, nullptr, scr, lane);
            continue; }
        r -= T_WMO;
        {
            const int j = r / 8, jj = r % 8; const int t = 6 * j + 4;
            const float* gp = a->ln_g + (size_t)(t - 1) * D; const float* bp = a->ln_b + (size_t)(t - 1) * D;
            const float* W = a->win + (size_t)j * D * NMIW + NMI + jj;
            bf16* wg16 = (bf16*)(vec + V_WG / 4) + (size_t)(j * 8 + jj) * D;
            float s1 = 0.f, s2 = 0.f;
            for (int k = lane; k < D; k += 64) { const float w = W[(size_t)k * NMIW]; const unsigned hv = pk2(w * gp[k], 0.f) & 0xffffu; wg16[k] = (bf16)hv; s1 += bflo(hv); s2 += w * bp[k]; }
            s1 = wave_sum(s1); s2 = wave_sum(s2);
            if (lane == 0) { vec[V_CG / 4 + j * 16 + jj] = s1; vec[V_CG / 4 + j * 16 + 8 + jj] = s2 + a->bg[j * 8 + jj]; }
        }
    }
    bf16* R = (bf16*)(ws + WS_R); float* sp0 = (float*)(ws + WS_SP);
    for (int m = gw; m < M; m += NGW) {
        const GAS f32x4* xr = (const GAS f32x4*)(a->x + (size_t)m * D);
#pragma unroll
        for (int i = 0; i < 4; ++i) { const f32x4 v0 = xr[(i * 64 + lane) * 2], v1 = xr[(i * 64 + lane) * 2 + 1];
            *(GAS v4u*)(R + (size_t)m * D + (i * 64 + lane) * 8) = (v4u){pk2(v0[0], v0[1]), pk2(v0[2], v0[3]), pk2(v1[0], v1[1]), pk2(v1[2], v1[3])};
            { const float xv[8] = {v0[0], v0[1], v0[2], v0[3], v1[0], v1[1], v1[2], v1[3]}; *(GAS v2u*)(ws + WS_R8 + (size_t)m * D + (i * 64 + lane) * 8) = pg8::cvt8_f8(xv, pg8::F8_SR); } }
        if (lane < 8) *(f32x2*)(sp0 + (size_t)m * 16 + lane * 2) = (f32x2){0.f, 256.f * (1.f - LN_EPS)};
    }
    for (int i = gw * 64 + lane; i < D; i += NGW * 64) { vec[V_ONES / 4 + i] = 1.f; vec[V_ZEROS / 4 + i] = 0.f; }
    (void)ones; (void)zeros;
}

DI void gates_phase(LAS unsigned char* lds, const bf16* R, const float* sp, const bf16* wg16, const float* cg, float* GT, int G, int bid, int wave_in) {
    int wave = wave_in; asm volatile("" : "+s"(wave));
    const int lane = pg8::pg8_lane(), tid = wave * 64 + lane, r32 = lane & 31, hi = lane >> 5;
    LAS float* part = (LAS float*)lds;
    const unsigned mk = (r32 < 8) ? 0xffffffffu : 0u; const v4u mkv = {mk, mk, mk, mk};
    for (int panel = bid; panel < M / 64; panel += G) {
        const long r0 = (long)panel * 64;
        const bf16* bsrc = wg16 + (size_t)(r32 & 7) * D + 256 * wave + 8 * hi;
        bf16x8 bfr[16];
#pragma unroll
        for (int ks = 0; ks < 16; ++ks) bfr[ks] = __builtin_bit_cast(bf16x8, *(const v4u*)(bsrc + 16 * ks) & mkv);
#pragma unroll
        for (int rt = 0; rt < 2; ++rt) {
            const bf16* asrc = R + (r0 + 32 * rt + r32) * D + 256 * wave + 8 * hi;
            bf16x8 afr[16];
#pragma unroll
            for (int ks = 0; ks < 16; ++ks) afr[ks] = *(const bf16x8*)(asrc + 16 * ks);
            f32x16 acc = zero16();
#pragma unroll
            for (int ks = 0; ks < 16; ++ks) acc = MFMA32(afr[ks], bfr[ks], acc);
            if (r32 < 8) {
#pragma unroll
                for (int r = 0; r < 16; ++r) part[(wave * 64 + 32 * rt + crow(r, hi)) * 8 + r32] = acc[r];
            }
        }
        WG_BAR();
        {
            const int row = tid >> 3, col = tid & 7;
            float s = 0.f;
#pragma unroll
            for (int w = 0; w < 8; ++w) s += part[(w * 64 + row) * 8 + col];
            const f32x4* spr = (const f32x4*)(sp + (size_t)(r0 + row) * 16);
            const f32x4 v0 = spr[0], v1 = spr[1], v2 = spr[2], v3 = spr[3];
            const float ss = ((v0[0] + v0[2]) + (v1[0] + v1[2])) + ((v2[0] + v2[2]) + (v3[0] + v3[2])), qq = ((v0[1] + v0[3]) + (v1[1] + v1[3])) + ((v2[1] + v2[3]) + (v3[1] + v3[3]));
            const float mean = ss * (1.f / D), var = qq * (1.f / D) - mean * mean, rstd = __builtin_amdgcn_rsqf(var + LN_EPS);
            GT[(size_t)(r0 + row) * 8 + col] = rstd * (s - mean * cg[col]) + cg[8 + col];
        }
        WG_BAR();
    }
}

DI void final_ln(const bf16* R, const float* sp, const float* g, const float* b, float* out, int gw, int NGW, int lane) {
    for (int m = gw; m < M; m += NGW) {
        float s, q;
        { const f32x4 v = *(const f32x4*)(sp + (size_t)m * 16 + (lane & 3) * 4); s = v[0] + v[2]; q = v[1] + v[3];
          s += SWZ_XOR(s, 1); q += SWZ_XOR(q, 1); s += SWZ_XOR(s, 2); q += SWZ_XOR(q, 2); }
        const float mean = s * (1.f / D), var = q * (1.f / D) - mean * mean, rstd = __builtin_amdgcn_rsqf(var + LN_EPS);
#pragma unroll
        for (int i = 0; i < 4; ++i) {
            const int k = 8 * lane + 512 * i;
            const v4u rv = *(const v4u*)(R + (size_t)m * D + k);
            const f32x4 g0 = *(const f32x4*)(g + k), g1 = *(const f32x4*)(g + k + 4), b0 = *(const f32x4*)(b + k), b1 = *(const f32x4*)(b + k + 4);
            f32x4 o0, o1;
            o0[0] = (bflo(rv.x) - mean) * rstd * g0[0] + b0[0]; o0[1] = (bfhi(rv.x) - mean) * rstd * g0[1] + b0[1]; o0[2] = (bflo(rv.y) - mean) * rstd * g0[2] + b0[2]; o0[3] = (bfhi(rv.y) - mean) * rstd * g0[3] + b0[3];
            o1[0] = (bflo(rv.z) - mean) * rstd * g1[0] + b1[0]; o1[1] = (bfhi(rv.z) - mean) * rstd * g1[1] + b1[1]; o1[2] = (bflo(rv.w) - mean) * rstd * g1[2] + b1[2]; o1[3] = (bfhi(rv.w) - mean) * rstd * g1[3] + b1[3];
            *(GAS f32x4*)(out + (size_t)m * D + k) = o0; *(GAS f32x4*)(out + (size_t)m * D + k + 4) = o1;
        }
    }
}

#ifndef PROBE_DUP
#define PROBE_DUP 0
#endif
#ifndef PROBE_MLV
#define PROBE_MLV 0
#endif
#ifndef SKIP_ATT
#define SKIP_ATT 0
#endif
#ifndef SKIP_MLSTM
#define SKIP_MLSTM 0
#endif

#define GRID_BAR1() do { XcdBarrier b_; b_.bar = (unsigned*)(kargs()->ws + WS_CTL) + CW_BAR; b_.x = xb_xcc_id(); b_.st = (volatile LAS unsigned*)(lds + MISC_OFF) + 8; xcd_barrier(b_); } while (0)
#define GRID_BAR() do { GRID_BAR1(); if (PROBE_DUP & 1024) GRID_BAR1(); } while (0)

__global__ void __launch_bounds__(NWAVES * 64, 2) fwd_kernel(Args args_by_value) {
    extern __shared__ __attribute__((aligned(16))) unsigned char lds_raw[];
    LAS unsigned char* lds = (LAS unsigned char*)lds_raw;
    const int w0 = __builtin_amdgcn_readfirstlane((int)threadIdx.x >> 6);
    const int G0 = gridDim.x, bid0 = blockIdx.x; const int G = G0, bid = bid0;
    { const int tid0 = threadIdx.x; if (tid0 < 64) ((volatile LAS unsigned*)(lds + MISC_OFF))[tid0] = 0u; }
    __syncthreads();
    (void)xcd_barrier_post((unsigned*)(kargs()->ws + WS_CTL) + CW_BAR, (volatile LAS unsigned*)(lds + MISC_OFF) + 8);
    {
        const int vcu = (G % 8 == 0) ? (bid % 8) * (G / 8) + bid / 8 : bid;
        prologue(kargs(), lds, vcu * NWAVES + w0, G * NWAVES, w0, pg8::pg8_lane());
        if (PROBE_DUP & 1) { WG_BAR(); prologue(kargs(), lds, vcu * NWAVES + w0, G * NWAVES, w0, pg8::pg8_lane()); }
    }
    GRID_BAR();

    for (int t = 0; t < 3 * DEPTH; ++t) {
        int G = G0, bid = bid0; asm volatile("" : "+s"(G), "+s"(bid));
        const int layer = t / 3, sub = t % 3;
        const int kind = (sub != 1) ? 0 : ((layer & 1) ? 2 : 1);
        const int j = layer >> 1;
        {
            unsigned char* ws = kargs()->ws;
            float* vec = (float*)(ws + WS_VEC);
            const bf16* R = (const bf16*)(ws + WS_R);
            const float* sp_in = (const float*)(ws + WS_SP) + (size_t)(t & 1) * (SP_BYTES / 4);
            if (kind == 0) {
                const int f = 2 * layer + (sub >> 1);
                pg8::Gemm g{(const bf16*)(ws + WS_R8), (const bf16*)(ws + WS_W13 + (size_t)f * NUP * D), M, NUP, D / 2}; pg8::StaticOrder S; S.init(M, NUP, G, bid);
                pg8::EpiUp E{f, t & 1};
                pg8::gemm_phase<pg8::EpiUp, pg8::StaticOrder, true, PG8_SP2, true>(lds + RING_OFF, g, S, E, w0);
                if (PROBE_DUP & 16) pg8::gemm_phase<pg8::EpiUp, pg8::StaticOrder, true, PG8_SP2, true>(lds + RING_OFF, g, S, E, w0);
                if (PROBE_DUP & 128) { pg8::EpiNull EN{(float*)(ws + WS_GATES)}; pg8::gemm_phase<pg8::EpiNull, pg8::StaticOrder, true, PG8_SP2, true>(lds + RING_OFF, g, S, EN, w0); }
            } else if (kind == 1) {
                pg8::Gemm g{(const bf16*)(ws + WS_R8), (const bf16*)(ws + WS_WQKV + (size_t)j * NQKV * D), M, NQKV, D / 2}; pg8::StaticOrder S; S.init(M, NQKV, G, bid);
                pg8::EpiLnOut E{1, j, t & 1, 1.f / (pg8::F8_SR * pg8::F8_SW)};
                pg8::gemm_phase<pg8::EpiLnOut, pg8::StaticOrder, true, PG8_SP2, true>(lds + RING_OFF, g, S, E, w0);
                if (PROBE_DUP & 32) pg8::gemm_phase<pg8::EpiLnOut, pg8::StaticOrder, true, PG8_SP2, true>(lds + RING_OFF, g, S, E, w0);
            } else {
                pg8::Gemm g{R, (const bf16*)(ws + WS_WIN) + (size_t)j * NMI * D, M, NMI, D}; pg8::StaticOrder S; S.init(M, NMI, G, bid);
                pg8::EpiLnOut E{0, j, t & 1, 1.f};
                pg8::gemm_phase<pg8::EpiLnOut, pg8::StaticOrder, true, PG8_SP2>(lds + RING_OFF, g, S, E, w0);
                if (PROBE_DUP & 32) pg8::gemm_phase<pg8::EpiLnOut, pg8::StaticOrder, true, PG8_SP2>(lds + RING_OFF, g, S, E, w0);
                gates_phase(lds, R, sp_in, (const bf16*)(vec + V_WG / 4) + (size_t)j * 8 * D, vec + V_CG / 4 + j * 16, (float*)(ws + WS_GATES), G, bid, w0);
                if (PROBE_DUP & 8) { WG_BAR(); gates_phase(lds, R, sp_in, (const bf16*)(vec + V_WG / 4) + (size_t)j * 8 * D, vec + V_CG / 4 + j * 16, (float*)(ws + WS_GATES), G, bid, w0); }
            }
        }
        GRID_BAR();
        if (kind == 1) {
            if (!SKIP_ATT) { kargs_t ka = kargs(); unsigned char* ws = ka->ws; attn_phase(lds_raw, (const bf16*)(ws + WS_QKV), ws + WS_AO, ka->sinks + j * 32, G, bid, w0);
                if (PROBE_DUP & 2) attn_phase(lds_raw, (const bf16*)(ws + WS_QKV), ws + WS_AO, ka->sinks + j * 32, G, bid, w0); }
            GRID_BAR();
        } else if (kind == 2) {
            if (!SKIP_MLSTM) { unsigned char* ws = kargs()->ws; mlstm_phase(lds_raw, (const bf16*)(ws + WS_MP), (const float*)(ws + WS_GATES), (bf16*)(ws + WS_HG), G, bid, w0);
                if (PROBE_DUP & 4) mlstm_phase<PROBE_MLV>(lds_raw, (const bf16*)(ws + WS_MP), (const float*)(ws + WS_GATES), (bf16*)(ws + WS_H), G, bid, w0); }
            GRID_BAR();
        }
        {
            kargs_t ka = kargs(); unsigned char* ws = ka->ws;
            float coef = kind == 0 ? 0.5f / (pg8::F8_SH * pg8::F8_SW) : (kind == 1 ? 1.f / (pg8::F8_SO * pg8::F8_SW) : 1.f);
            if ((kind == 1 && SKIP_ATT) || (kind == 2 && SKIP_MLSTM)) coef = 0.f;
            pg8::StaticOrder S; S.init(M, D, G, bid);
            pg8::EpiRes E{t, coef, (LAS float*)(lds + TAB_OFF), w0, 0};
            if (kind != 2) {
                const int f = 2 * layer + (sub >> 1);
                pg8::Gemm g{(const bf16*)(ws + (kind == 0 ? WS_H : WS_AO)), (const bf16*)(kind == 0 ? ws + WS_W2 + (size_t)f * D * FF : ws + WS_WO + (size_t)j * D * D), M, D, kind == 0 ? FF / 2 : D / 2};
                if (PROBE_DUP & 64) { pg8::EpiNull EN{(float*)(ws + WS_GATES)}; pg8::gemm_phase<pg8::EpiNull, pg8::StaticOrder, true, PG8_SP2, true>(lds + RING_OFF, g, S, EN, w0); }
                if (PROBE_DUP & 512) { pg8::EpiRes ED{t, coef, (LAS float*)(lds + TAB_OFF), w0, 1}; pg8::gemm_phase<pg8::EpiRes, pg8::StaticOrder, true, PG8_SP2, true>(lds + RING_OFF, g, S, ED, w0); }
                pg8::gemm_phase<pg8::EpiRes, pg8::StaticOrder, true, PG8_SP2, true>(lds + RING_OFF, g, S, E, w0);
            } else {
                pg8::Gemm g{(const bf16*)(ws + WS_HG), (const bf16*)(ws + WS_WMO) + (size_t)j * D * D, M, D, D};
                if (PROBE_DUP & 256) { pg8::EpiNull EN{(float*)(ws + WS_GATES)}; pg8::gemm_phase<pg8::EpiNull, pg8::StaticOrder, true, PG8_SP2, false>(lds + RING_OFF, g, S, EN, w0); }
                pg8::gemm_phase<pg8::EpiRes, pg8::StaticOrder, true, PG8_SP2, false>(lds + RING_OFF, g, S, E, w0);
            }
        }
        GRID_BAR();
    }
    {
        kargs_t ka = kargs(); unsigned char* ws = ka->ws;
        const int vcu = (G % 8 == 0) ? (bid % 8) * (G / 8) + bid / 8 : bid;
        final_ln((const bf16*)(ws + WS_R), (const float*)(ws + WS_SP), ka->ln_g + (size_t)(3 * DEPTH - 1) * D, ka->ln_b + (size_t)(3 * DEPTH - 1) * D, ka->out, vcu * NWAVES + w0, G * NWAVES, pg8::pg8_lane());
    }
}

extern "C" void kernel_launch(void* const* d_in, const int* in_sizes, int n_in, void* d_out, int out_size, void* d_ws, size_t ws_size, hipStream_t stream) {
    static int grid = 0;
    if (grid == 0) {
        if (n_in != 12 || in_sizes[0] != M * D || out_size != M * D || ws_size < WS_END) { fprintf(stderr, "kernel_launch: unexpected shapes / workspace (n_in %d, ws %zu < %zu); nothing launched\n", n_in, ws_size, (size_t)WS_END); grid = -1; return; }
        int dev = 0, cus = 0;
        if (hipGetDevice(&dev) != hipSuccess || hipDeviceGetAttribute(&cus, hipDeviceAttributeMultiprocessorCount, dev) != hipSuccess) { grid = -1; return; }
        if (hipFuncSetAttribute((const void*)fwd_kernel, hipFuncAttributeMaxDynamicSharedMemorySize, LDS_BYTES) != hipSuccess) { fprintf(stderr, "kernel_launch: hipFuncSetAttribute failed\n"); grid = -1; return; }
        int per_cu = 0;
        if (hipOccupancyMaxActiveBlocksPerMultiprocessor(&per_cu, (const void*)fwd_kernel, NWAVES * 64, LDS_BYTES) != hipSuccess || per_cu < 1) { fprintf(stderr, "kernel_launch: occupancy query says %d\n", per_cu); }
        (void)hipGetLastError();
        grid = cus;
    }
    if (grid < 0) return;
    (void)hipMemsetAsync((char*)d_ws + WS_CTL, 0, CTL_ZERO_BYTES, stream);
    Args a{};
    a.x = (const float*)d_in[0]; a.w1 = (const float*)d_in[1]; a.w3 = (const float*)d_in[2]; a.w2 = (const float*)d_in[3]; a.ln_g = (const float*)d_in[4]; a.ln_b = (const float*)d_in[5];
    a.wqkv = (const float*)d_in[6]; a.sinks = (const float*)d_in[7]; a.wo = (const float*)d_in[8]; a.win = (const float*)d_in[9]; a.bg = (const float*)d_in[10]; a.wmo = (const float*)d_in[11];
    a.out = (float*)d_out; a.ws = (unsigned char*)d_ws;
    hipLaunchKernelGGL(fwd_kernel, dim3(grid), dim3(NWAVES * 64), LDS_BYTES, stream, a);
}
```

```cpp
#include <hip/hip_runtime.h>
#include <hip/hip_bf16.h>
#include <cstdio>
#include <cstdint>
#include <cmath>

constexpr int BATCH = 8, SEQ = 2048, D = 2048, FF = 5632, DEPTH = 4;
constexpr int M = BATCH * SEQ;
constexpr int NUP = 2 * FF;
constexpr int NQKV = 2560;
constexpr int NMI = 6144, NMIW = 6152;
constexpr float LN_EPS = 1e-5f;
constexpr float ALPHA = 1.681792830507429f;
constexpr float LOG2E = 1.4426950408889634f;

constexpr size_t MiB = 1u << 20;
constexpr size_t WS_CTL = 0, CTL_ZERO_BYTES = 64 * 1024;
constexpr size_t WS_W13 = 2 * MiB;
constexpr size_t WS_W2 = 178 * MiB;
constexpr size_t WS_WQKV = 266 * MiB;
constexpr size_t WS_WO = 286 * MiB;
constexpr size_t WS_WIN = 302 * MiB;
constexpr size_t WS_WMO = 350 * MiB;
constexpr size_t WS_VEC = 366 * MiB;
constexpr size_t V_C1U = 0, V_C2U = 360448, V_C1Q = 720896, V_C2Q = 741376, V_C1I = 761856, V_C2I = 811008, V_CG = 860160, V_WG = 860416, V_ONES = 991488, V_ZEROS = 999680;
constexpr size_t WS_R = 368 * MiB;
constexpr size_t WS_R8 = 432 * MiB;
constexpr size_t WS_SP = 464 * MiB;
constexpr size_t SP_BYTES = (size_t)M * 16 * 4;
constexpr size_t WS_H = 466 * MiB;
constexpr size_t WS_QKV = 554 * MiB;
constexpr size_t WS_AO = 634 * MiB;
constexpr size_t WS_MP = 698 * MiB;
constexpr size_t WS_GATES = 890 * MiB;
constexpr size_t WS_HG = 891 * MiB;
constexpr size_t WS_END = 955 * MiB;
constexpr int CW_TMO = 0, CW_BAR = 4096;

struct Args { const float* x; const float* w1; const float* w3; const float* w2; const float* ln_g; const float* ln_b; const float* wqkv; const float* sinks; const float* wo;
              const float* win; const float* bg; const float* wmo; float* out; unsigned char* ws; };
typedef const __attribute__((address_space(4))) Args* kargs_t;
__device__ __forceinline__ kargs_t kargs() { kargs_t p = (kargs_t)__builtin_amdgcn_kernarg_segment_ptr(); asm volatile("" : "+s"(p)); return p; }

namespace pg8 {
#define PG8_LAS __attribute__((address_space(3)))
typedef unsigned short bf16_t;
typedef short bf16x8 __attribute__((ext_vector_type(8)));
typedef _Float16 f16x8 __attribute__((ext_vector_type(8)));
typedef float f32x4 __attribute__((ext_vector_type(4)));
typedef unsigned u32x4 __attribute__((ext_vector_type(4)));
constexpr int BM = 256, BK = 64, HALF = 128, HTB = HALF * BK * 2  , STAGE_BYTES = 8 * HTB, NXCD = 8, WGM = 8;

__host__ __device__ __forceinline__ int lds_byte(int r, int c) { const int st = (r >> 4) * 2 + (c >> 5), rr = r & 15, cc = c & 31, ob = rr * 64 + cc * 2; return st * 1024 + (ob ^ (((ob >> 9) & 1) << 5)); }
__host__ __device__ __forceinline__ void stage_rc(int b, int& R, int& C) { const int st = b / 1024, sb = b % 1024, swz = sb ^ (((sb >> 9) & 1) << 5); R = (st >> 1) * 16 + swz / 64; C = (st & 1) * 32 + (swz % 64) / 2; }
__host__ __device__ __forceinline__ int perm32(int rho) { const int n = rho >> 4, i = rho & 15; return 8 * (i >> 2) + 4 * n + (i & 3); }

typedef int i32x4 __attribute__((ext_vector_type(4)));
typedef int i32x8 __attribute__((ext_vector_type(8)));
constexpr float F8_SR = 8.f, F8_SW = 1024.f, F8_SH = 16.f, F8_SO = 64.f;
__device__ __forceinline__ i32x8 cat_i8(bf16x8 lo, bf16x8 hi) { const i32x4 a = __builtin_bit_cast(i32x4, lo), b = __builtin_bit_cast(i32x4, hi); return __builtin_shufflevector(a, b, 0, 1, 2, 3, 4, 5, 6, 7); }
__device__ __forceinline__ void mfma_f8_inplace(f32x4& c, const i32x8 a, const i32x8 b) { asm volatile("v_mfma_f32_16x16x128_f8f6f4 %0, %1, %2, %0 cbsz:0 blgp:0" : "+v"(c) : "v"(a), "v"(b)); }
typedef unsigned u32x2 __attribute__((ext_vector_type(2)));
__device__ __forceinline__ u32x2 cvt8_f8(const float (&v)[8], float s) {
    int a, b; asm volatile("" : "=v"(a), "=v"(b));
    a = __builtin_amdgcn_cvt_pk_fp8_f32(v[0] * s, v[1] * s, a, false); a = __builtin_amdgcn_cvt_pk_fp8_f32(v[2] * s, v[3] * s, a, true);
    b = __builtin_amdgcn_cvt_pk_fp8_f32(v[4] * s, v[5] * s, b, false); b = __builtin_amdgcn_cvt_pk_fp8_f32(v[6] * s, v[7] * s, b, true);
    return (u32x2){(unsigned)a, (unsigned)b};
}
__device__ __forceinline__ int pg8_lane() { int l; asm volatile("v_mbcnt_lo_u32_b32 %0, -1, 0\n\tv_mbcnt_hi_u32_b32 %0, -1, %0" : "=v"(l)); return l; }
struct Unit { int pm, pn; };
struct Gemm { const bf16_t* A; const bf16_t* Bt; int M, N, K; };

struct StaticOrder {
    int nM, nN, nwg, G, c, r0 = 0, r1 = 1 << 20;
    __host__ __device__ void init(int M_, int N_, int G_, int c_) { nM = M_ / BM; nN = N_ / BM; nwg = nM * nN; G = G_; c = c_; }
    __host__ __device__ bool next(int i, Unit& u) const {
        i += r0; if (i >= r1) return false;
        const long L = (long)i * G + c; if (L >= nwg) return false;
        int wgid = (int)L; { const int q = nwg / NXCD, r = nwg % NXCD, xcd = wgid % NXCD, off = wgid / NXCD; wgid = (xcd < r ? xcd * (q + 1) : r * (q + 1) + (xcd - r) * q) + off; }
        const int nig = WGM * nN, gid = wgid / nig, fm = gid * WGM, gsz = (nM - fm) < WGM ? (nM - fm) : WGM;
        u.pm = fm + ((wgid % nig) % gsz); u.pn = (wgid % nig) / gsz; return true;
    }
    __device__ __forceinline__ void a_ready(const Unit&) const {}
    __device__ __forceinline__ void done(const Unit&) const {}
};

__device__ __forceinline__ unsigned cvt_pk_bf16(float lo, float hi) { typedef float f2 __attribute__((ext_vector_type(2))); typedef _Float16 b2 __attribute__((ext_vector_type(2))); f2 v = {lo, hi}; b2 b = __builtin_convertvector(v, b2); return __builtin_bit_cast(unsigned, b); }
__device__ __forceinline__ float bf_lo(unsigned w) { typedef _Float16 b2 __attribute__((ext_vector_type(2))); return (float)__builtin_bit_cast(b2, w)[0]; }
__device__ __forceinline__ float bf_hi(unsigned w) { typedef _Float16 b2 __attribute__((ext_vector_type(2))); return (float)__builtin_bit_cast(b2, w)[1]; }
__device__ __forceinline__ float fsigmoid(float x) { return __builtin_amdgcn_rcpf(1.f + __builtin_amdgcn_exp2f(-LOG2E * x)); }

__device__ __forceinline__ float sum_fq(float v) {
    auto a = __builtin_amdgcn_permlane16_swap(__float_as_uint(v), __float_as_uint(v), false, false); v = __uint_as_float(a[0]) + __uint_as_float(a[1]);
    auto b = __builtin_amdgcn_permlane32_swap(__float_as_uint(v), __float_as_uint(v), false, false); return __uint_as_float(b[0]) + __uint_as_float(b[1]);
}
__device__ __forceinline__ void row_stats(const float* sp, int row0, int fq, float (&mu)[2][4], float (&rs)[2][4]) {
#pragma unroll
    for (int ai = 0; ai < 2; ++ai)
#pragma unroll
        for (int m = 0; m < 4; ++m) {
            const f32x4 v = *(const f32x4*)(sp + (size_t)(row0 + ai * HALF + m * 16) * 16 + fq * 4);
            float s = v[0] + v[2], q = v[1] + v[3];
            s = sum_fq(s); q = sum_fq(q);
            const float mean = s * (1.f / D), var = q * (1.f / D) - mean * mean;
            mu[ai][m] = mean; rs[ai][m] = __builtin_amdgcn_rsqf(var + LN_EPS);
        }
}

struct EpiNull {
    static constexpr bool PERM = true, AFTER_DRAIN = false;
    float* sink;
    __device__ __forceinline__ void operator()(const f32x4 (&acc)[2][2][4][2], const Unit& u, int wr, int wc, int, int) const {
        float s = 0.f;
#pragma unroll
        for (int ai = 0; ai < 2; ++ai)
#pragma unroll
            for (int bj = 0; bj < 2; ++bj)
#pragma unroll
                for (int m = 0; m < 4; ++m)
#pragma unroll
                    for (int n = 0; n < 2; ++n) s += acc[ai][bj][m][n][0] + acc[ai][bj][m][n][1] + acc[ai][bj][m][n][2] + acc[ai][bj][m][n][3];
        if (s == 123.456f) sink[u.pm + wr + wc] = s;
    }
};

struct EpiUp {
    static constexpr bool PERM = true, AFTER_DRAIN = false;
    int f, tpar;
    __device__ __forceinline__ void operator()(const f32x4 (&acc)[2][2][4][2], const Unit& u, int wr, int wc, int, int) const {
        const int lane_ = pg8_lane(), fr = lane_ & 15, fq = lane_ >> 4;
        const int row0 = u.pm * BM + wr * 64 + fr;
        int f = this->f, tpar = this->tpar; asm volatile("" : "+s"(f), "+s"(tpar));
        unsigned char* ws = kargs()->ws; unsigned char* H = ws + WS_H;
        const float* c1 = (const float*)(ws + WS_VEC + V_C1U) + (size_t)f * NUP; const float* c2 = (const float*)(ws + WS_VEC + V_C2U) + (size_t)f * NUP; const float* sp = (const float*)(ws + WS_SP) + (size_t)tpar * (SP_BYTES / 4);
        float mu[2][4], rs[2][4]; row_stats(sp, row0, fq, mu, rs);
        const int cb = u.pn * BM + wc * 32 + 8 * fq;
        f32x4 k1[2][2], k2[2][2];
#pragma unroll
        for (int bj = 0; bj < 2; ++bj)
#pragma unroll
            for (int n = 0; n < 2; ++n) { k1[bj][n] = *(const f32x4*)(c1 + cb + bj * HALF + 4 * n); k2[bj][n] = *(const f32x4*)(c2 + cb + bj * HALF + 4 * n); }
        unsigned char* hp = H + (size_t)row0 * FF + u.pn * HALF + wc * 32 + 8 * fq;
#pragma unroll
        for (int ai = 0; ai < 2; ++ai)
#pragma unroll
            for (int m = 0; m < 4; ++m) {
                const float r_ = rs[ai][m], nm = -mu[ai][m] * r_, ra = r_ * (1.f / (F8_SR * F8_SW));
                float hv[8];
#pragma unroll
                for (int n = 0; n < 2; ++n)
#pragma unroll
                    for (int j = 0; j < 4; ++j) {
                        const float ga = acc[ai][0][m][n][j] * ra + (nm * k1[0][n][j] + k2[0][n][j]);
                        const float ub = acc[ai][1][m][n][j] * ra + (nm * k1[1][n][j] + k2[1][n][j]);
                        hv[4 * n + j] = ga * fsigmoid(ga) * ub;
                    }
                *(u32x2*)(hp + (size_t)(ai * HALF + m * 16) * FF) = cvt8_f8(hv, F8_SH);
            }
    }
};

struct EpiLnOut {
    static constexpr bool PERM = true, AFTER_DRAIN = false;
    int mode, j, tpar;
    __device__ __forceinline__ void operator()(const f32x4 (&acc)[2][2][4][2], const Unit& u, int wr, int wc, int, int) const {
        const int lane_ = pg8_lane(), fr = lane_ & 15, fq = lane_ >> 4;
        const int row0 = u.pm * BM + wr * 64 + fr;
        int mode = this->mode, j = this->j, tpar = this->tpar; asm volatile("" : "+s"(mode), "+s"(j), "+s"(tpar));
        const bool att = mode == 0; const int coff = mode == 2 ? 4096 : 0;
        unsigned char* ws = kargs()->ws; bf16_t* O = (bf16_t*)(ws + (att ? WS_QKV : WS_MP)) + coff; const int ldo = att ? NQKV : NMI, sig_from = mode == 2 ? 0 : (mode == 1 ? 16 : 1000);
        const float ascale = mode == 1 ? 1.f : 1.f / (F8_SR * F8_SW);
        const float* c1 = (const float*)(ws + WS_VEC + (att ? V_C1Q : V_C1I)) + j * ldo + coff; const float* c2 = (const float*)(ws + WS_VEC + (att ? V_C2Q : V_C2I)) + j * ldo + coff; const float* sp = (const float*)(ws + WS_SP) + (size_t)tpar * (SP_BYTES / 4);
        float mu[2][4], rs[2][4]; row_stats(sp, row0, fq, mu, rs);
        const int cb = u.pn * BM + wc * 32 + 8 * fq;
        const bool sg = u.pn >= sig_from;
        f32x4 k1[2][2], k2[2][2];
#pragma unroll
        for (int bj = 0; bj < 2; ++bj)
#pragma unroll
            for (int n = 0; n < 2; ++n) { k1[bj][n] = *(const f32x4*)(c1 + cb + bj * HALF + 4 * n); k2[bj][n] = *(const f32x4*)(c2 + cb + bj * HALF + 4 * n); }
        bf16_t* op = O + (size_t)row0 * ldo + cb;
#pragma unroll
        for (int ai = 0; ai < 2; ++ai)
#pragma unroll
            for (int m = 0; m < 4; ++m) {
                const float r_ = rs[ai][m], nm = -mu[ai][m] * r_, ra = r_ * ascale;
#pragma unroll
                for (int bj = 0; bj < 2; ++bj) {
                    float v[8];
#pragma unroll
                    for (int n = 0; n < 2; ++n)
#pragma unroll
                        for (int j = 0; j < 4; ++j) { float t = acc[ai][bj][m][n][j] * ra + (nm * k1[bj][n][j] + k2[bj][n][j]); if (sg) t = fsigmoid(t); v[4 * n + j] = t; }
                    u32x4 w; w.x = cvt_pk_bf16(v[0], v[1]); w.y = cvt_pk_bf16(v[2], v[3]); w.z = cvt_pk_bf16(v[4], v[5]); w.w = cvt_pk_bf16(v[6], v[7]);
                    *(u32x4*)(op + (size_t)(ai * HALF + m * 16) * ldo + bj * HALF) = w;
                }
            }
    }
};

struct EpiRes {
    static constexpr bool PERM = true, AFTER_DRAIN = false;
    int t; float coef; PG8_LAS float* tab; int wave; int dry;
    __device__ __forceinline__ void operator()(const f32x4 (&acc)[2][2][4][2], const Unit& u, int wr, int wc, int, int) const {
        const int lane_ = pg8_lane(), fr = lane_ & 15, fq = lane_ >> 4;
        typedef float f32x2v __attribute__((ext_vector_type(2)));
        const int row0 = u.pm * BM + wr * 64 + fr;
        int t = this->t; asm volatile("" : "+s"(t));
        const bool need8 = (t != 3 && t != 9 && t != 11) || dry;
        kargs_t ka = kargs(); unsigned char* ws = ka->ws; bf16_t* R = (bf16_t*)(ws + WS_R); unsigned char* R8 = ws + (dry ? WS_MP + 64 * MiB : WS_R8); bf16_t* Ro = dry ? (bf16_t*)(ws + WS_MP) : R;
        const float* g = t ? ka->ln_g + (size_t)(t - 1) * D : (const float*)(ws + WS_VEC + V_ONES); const float* b = t ? ka->ln_b + (size_t)(t - 1) * D : (const float*)(ws + WS_VEC + V_ZEROS);
        const float* sp_in = (const float*)(ws + WS_SP) + (size_t)(t & 1) * (SP_BYTES / 4); float* sp_out = dry ? (float*)(ws + WS_MP + 96 * MiB) : (float*)(ws + WS_SP) + (size_t)((t + 1) & 1) * (SP_BYTES / 4);
        float mu[2][4], rs[2][4]; row_stats(sp_in, row0, fq, mu, rs);
        asm volatile("" ::: "memory");
#pragma unroll
        for (int bj = 0; bj < 2; ++bj) {
            const int cb = u.pn * BM + bj * HALF + wc * 32 + 8 * fq;
            f32x4 gv[2], bv[2];
#pragma unroll
            for (int n = 0; n < 2; ++n) { gv[n] = *(const f32x4*)(g + cb + 4 * n); bv[n] = *(const f32x4*)(b + cb + 4 * n) * ALPHA; }
#pragma unroll
            for (int ai = 0; ai < 2; ++ai) {
                u32x4 old[4];
#pragma unroll
                for (int m = 0; m < 4; ++m) old[m] = *(const u32x4*)(R + (size_t)(row0 + ai * HALF + m * 16) * D + cb);
#pragma unroll
                for (int m = 0; m < 4; ++m) {
                    const float A_ = ALPHA * rs[ai][m], B_ = -mu[ai][m] * A_;
                    const size_t off = (size_t)(row0 + ai * HALF + m * 16) * D + cb;
                    const u32x4 o = old[m];
                    const float ro[8] = {bf_lo(o.x), bf_hi(o.x), bf_lo(o.y), bf_hi(o.y), bf_lo(o.z), bf_hi(o.z), bf_lo(o.w), bf_hi(o.w)};
                    float nv[8];
#pragma unroll
                    for (int n = 0; n < 2; ++n)
#pragma unroll
                        for (int j = 0; j < 4; ++j) nv[4 * n + j] = (ro[4 * n + j] * A_ + B_) * gv[n][j] + bv[n][j] + coef * acc[ai][bj][m][n][j];
                    u32x4 w; w.x = cvt_pk_bf16(nv[0], nv[1]); w.y = cvt_pk_bf16(nv[2], nv[3]); w.z = cvt_pk_bf16(nv[4], nv[5]); w.w = cvt_pk_bf16(nv[6], nv[7]);
                    *(u32x4*)(Ro + off) = w;
                    if (need8) *(u32x2*)(R8 + off) = cvt8_f8(nv, F8_SR);
                    const float f0 = bf_lo(w.x), f1 = bf_hi(w.x), f2 = bf_lo(w.y), f3 = bf_hi(w.y), f4 = bf_lo(w.z), f5 = bf_hi(w.z), f6 = bf_lo(w.w), f7 = bf_hi(w.w);
                    float s = ((f0 + f1) + (f2 + f3)) + ((f4 + f5) + (f6 + f7));
                    float q = ((f0 * f0 + f1 * f1) + (f2 * f2 + f3 * f3)) + ((f4 * f4 + f5 * f5) + (f6 * f6 + f7 * f7));
                    s = sum_fq(s); q = sum_fq(q);
                    if (fq == 0) *(PG8_LAS f32x2v*)(tab + (((ai * HALF + wr * 64 + m * 16 + fr) * 4 + wc) * 2 + bj) * 2) = (f32x2v){s, q};
                }
                asm volatile("" ::: "memory");
            }
        }
        asm volatile("s_waitcnt lgkmcnt(0)" ::: "memory"); __builtin_amdgcn_s_barrier(); asm volatile("" ::: "memory");
        const int tid = wave * 64 + pg8_lane();
        if (tid < BM) {
            const PG8_LAS f32x4* t4 = (const PG8_LAS f32x4*)(tab + tid * 16);
            const f32x4 a = t4[0], c = t4[1], d = t4[2], e = t4[3];
            *(f32x2v*)(sp_out + (size_t)(u.pm * BM + tid) * 16 + u.pn * 2) = (f32x2v){((a[0] + a[2]) + (c[0] + c[2])) + ((d[0] + d[2]) + (e[0] + e[2])), ((a[1] + a[3]) + (c[1] + c[3])) + ((d[1] + d[3]) + (e[1] + e[3]))};
        }
    }
};

template <class Epi, class Sched, bool ALIGN_EPI = false, bool SP2 = false, bool F8 = false>
__device__ __forceinline__ void gemm_phase(PG8_LAS unsigned char* lds, const Gemm g, const Sched& S, const Epi& E, int wave_in) {
    int wid = wave_in; asm volatile("" : "+s"(wid));
    const int lane = pg8_lane(), tid = wid * 64 + lane, wr = wid >> 2, wc = wid & 3, fr = lane & 15, fq = lane >> 4;
    const int K = g.K, nt = K / BK;
    unsigned voffA[2], voffB[2];
#pragma unroll
    for (int i = 0; i < 2; ++i) { int R, C; stage_rc(tid * 16 + i * 8192, R, C); const int Rb = Epi::PERM ? ((R & ~31) + perm32(R & 31)) : R;
        voffA[i] = (unsigned)(R * K + C) * 2u; voffB[i] = (unsigned)(Rb * K + C) * 2u; }
    const size_t kstep = (size_t)(BK * 2);
    const size_t hstep = (size_t)HALF * K * 2;
    const size_t tstep = 2 * hstep;
    const unsigned ldsw = (unsigned)wid * 1024u;
    const int aoff = lds_byte(wr * 64 + fr, fq * 8), boff = lds_byte(wc * 32 + fr, fq * 8);
#define PG8_SA(b, h) (((b) * 2 + (h)) * HTB)
#define PG8_SB(b, h) ((4 + (b) * 2 + (h)) * HTB)
#define PG8_STAGE(bufoff, gbase, voff) do { _Pragma("unroll") for (int _i = 0; _i < 2; ++_i) \
        __builtin_amdgcn_global_load_lds((const unsigned*)((const char*)(gbase) + (voff)[_i]), (PG8_LAS unsigned*)(lds + (bufoff) + ldsw + _i * 8192), 16, 0, 0); } while (0)
#define PG8_LDA(dst, b, h) do { _Pragma("unroll") for (int m = 0; m < 4; ++m) _Pragma("unroll") for (int k = 0; k < 2; ++k) dst[m][k] = *(const PG8_LAS bf16x8*)(lds + PG8_SA(b, h) + aoff + m * 2048 + k * 1024); } while (0)
#define PG8_LDB(dst, b, h) do { _Pragma("unroll") for (int n = 0; n < 2; ++n) _Pragma("unroll") for (int k = 0; k < 2; ++k) dst[n][k] = *(const PG8_LAS bf16x8*)(lds + PG8_SB(b, h) + boff + n * 2048 + k * 1024); } while (0)
#define PG8_MMA(ai, bj, At, Bt) do { __builtin_amdgcn_s_setprio(1); _Pragma("unroll") for (int m = 0; m < 4; ++m) _Pragma("unroll") for (int n = 0; n < 2; ++n) { \
        if constexpr (F8) mfma_f8_inplace(acc[ai][bj][m][n], cat_i8(Bt[n][0], Bt[n][1]), cat_i8(At[m][0], At[m][1])); \
        else { _Pragma("unroll") for (int k = 0; k < 2; ++k) acc[ai][bj][m][n] = __builtin_amdgcn_mfma_f32_16x16x32_f16(__builtin_bit_cast(f16x8, Bt[n][k]), __builtin_bit_cast(f16x8, At[m][k]), acc[ai][bj][m][n], 0, 0, 0); } } \
        __builtin_amdgcn_s_setprio(0); } while (0)
#define PG8_WAIT_V(n) asm volatile("s_waitcnt vmcnt(" #n ")" ::: "memory")
#define PG8_WAIT_L(n) asm volatile("s_waitcnt lgkmcnt(" #n ")" ::: "memory")
#define PG8_BAR __builtin_amdgcn_s_barrier()
#define PG8_SCHED __builtin_amdgcn_sched_barrier(0)
    Unit cur, nxt; int ui = 0;
    if (!S.next(0, cur)) return;
    f32x4 acc[2][2][4][2];
#pragma unroll
    for (int a = 0; a < 2; ++a)
#pragma unroll
        for (int b = 0; b < 2; ++b)
#pragma unroll
            for (int m = 0; m < 4; ++m)
#pragma unroll
                for (int n = 0; n < 2; ++n) { float z0, z1, z2, z3; asm volatile("v_mov_b32 %0, 0\n\tv_mov_b32 %1, 0\n\tv_mov_b32 %2, 0\n\tv_mov_b32 %3, 0" : "=v"(z0), "=v"(z1), "=v"(z2), "=v"(z3)); acc[a][b][m][n] = (f32x4){z0, z1, z2, z3}; }
    bf16x8 At[4][2], B0[2][2], B1[2][2];
    const char* cA = (const char*)g.A + (size_t)cur.pm * tstep; const char* cB = (const char*)g.Bt + (size_t)cur.pn * tstep;
    S.a_ready(cur);
    if constexpr (SP2) {
        PG8_STAGE(PG8_SB(0, 0), cB, voffB); PG8_STAGE(PG8_SB(0, 1), cB + hstep, voffB); PG8_STAGE(PG8_SA(0, 0), cA, voffA); PG8_STAGE(PG8_SA(0, 1), cA + hstep, voffA);
        if (wr == 1) PG8_BAR;
        PG8_WAIT_V(2); PG8_BAR;
        PG8_STAGE(PG8_SB(1, 0), cB + kstep, voffB); PG8_STAGE(PG8_SA(1, 0), cA + kstep, voffA); PG8_STAGE(PG8_SB(1, 1), cB + hstep + kstep, voffB);
        PG8_WAIT_V(6); PG8_BAR;
    } else {
        PG8_STAGE(PG8_SB(0, 0), cB, voffB); PG8_STAGE(PG8_SA(0, 0), cA, voffA); PG8_STAGE(PG8_SB(0, 1), cB + hstep, voffB); PG8_STAGE(PG8_SA(0, 1), cA + hstep, voffA);
        if (wr == 1) PG8_BAR;
        PG8_WAIT_V(4); PG8_BAR;
        PG8_STAGE(PG8_SB(1, 0), cB + kstep, voffB); PG8_STAGE(PG8_SA(1, 0), cA + kstep, voffA); PG8_STAGE(PG8_SB(1, 1), cB + hstep + kstep, voffB);
        PG8_WAIT_V(6); PG8_BAR;
    }
    for (;;) {
        const bool has_next = S.next(ui + 1, nxt);
        const char* nA = has_next ? (const char*)g.A + (size_t)nxt.pm * tstep : cA; const char* nB = has_next ? (const char*)g.Bt + (size_t)nxt.pn * tstep : cB;
        for (int t = 0; t < nt; t += 2) {
            const bool last = (t == nt - 2);
            const char* a1 = cA + (size_t)(t + 1) * kstep;
            const char* a2 = last ? nA : cA + (size_t)(t + 2) * kstep; const char* b2 = last ? nB : cB + (size_t)(t + 2) * kstep;
            const char* a3 = a2 + kstep; const char* b3 = b2 + kstep;
            if (last && has_next) S.a_ready(nxt);
            if constexpr (SP2) {
            PG8_LDB(B0, 0, 0); PG8_LDB(B1, 0, 1); PG8_SCHED; PG8_LDA(At, 0, 0); PG8_STAGE(PG8_SA(1, 1), a1 + hstep, voffA);
            PG8_WAIT_V(8); PG8_WAIT_L(0); PG8_BAR; PG8_MMA(0, 0, At, B0); PG8_MMA(0, 1, At, B1); PG8_BAR; PG8_SCHED;
            PG8_LDA(At, 0, 1); PG8_STAGE(PG8_SB(0, 0), b2, voffB); PG8_STAGE(PG8_SB(0, 1), b2 + hstep, voffB); PG8_STAGE(PG8_SA(0, 0), a2, voffA);
            PG8_WAIT_V(8); PG8_WAIT_L(0); PG8_BAR; PG8_MMA(1, 0, At, B0); PG8_MMA(1, 1, At, B1); PG8_BAR; PG8_SCHED;
            PG8_LDB(B0, 1, 0); PG8_LDB(B1, 1, 1); PG8_SCHED; PG8_LDA(At, 1, 0); PG8_STAGE(PG8_SA(0, 1), a2 + hstep, voffA);
            PG8_WAIT_V(8); PG8_WAIT_L(0); PG8_BAR; PG8_MMA(0, 0, At, B0); PG8_MMA(0, 1, At, B1); PG8_BAR; PG8_SCHED;
            PG8_LDA(At, 1, 1); PG8_STAGE(PG8_SB(1, 0), b3, voffB); PG8_STAGE(PG8_SB(1, 1), b3 + hstep, voffB); PG8_STAGE(PG8_SA(1, 0), a3, voffA);
            PG8_WAIT_V(8); PG8_WAIT_L(0); PG8_BAR; PG8_MMA(1, 0, At, B0); PG8_MMA(1, 1, At, B1); PG8_BAR; PG8_SCHED;
            } else {
            PG8_LDB(B0, 0, 0); PG8_SCHED; PG8_LDA(At, 0, 0); PG8_STAGE(PG8_SA(1, 1), a1 + hstep, voffA);
            PG8_WAIT_L(8); PG8_BAR; PG8_WAIT_L(0); PG8_MMA(0, 0, At, B0); PG8_BAR; PG8_SCHED;
            PG8_LDB(B1, 0, 1); PG8_STAGE(PG8_SB(0, 0), b2, voffB);
            PG8_BAR; PG8_WAIT_L(0); PG8_MMA(0, 1, At, B1); PG8_BAR;
            PG8_LDA(At, 0, 1); PG8_STAGE(PG8_SA(0, 0), a2, voffA);
            PG8_BAR; PG8_WAIT_L(0); PG8_MMA(1, 0, At, B0); PG8_BAR; PG8_SCHED;
            PG8_STAGE(PG8_SB(0, 1), b2 + hstep, voffB);
            PG8_WAIT_V(6); PG8_BAR; PG8_MMA(1, 1, At, B1); PG8_BAR;
            PG8_LDB(B0, 1, 0); PG8_SCHED; PG8_LDA(At, 1, 0); PG8_STAGE(PG8_SA(0, 1), a2 + hstep, voffA);
            PG8_WAIT_L(8); PG8_BAR; PG8_WAIT_L(0); PG8_MMA(0, 0, At, B0); PG8_BAR; PG8_SCHED;
            PG8_LDB(B1, 1, 1); PG8_STAGE(PG8_SB(1, 0), b3, voffB);
            PG8_BAR; PG8_WAIT_L(0); PG8_MMA(0, 1, At, B1); PG8_BAR;
            PG8_LDA(At, 1, 1); PG8_STAGE(PG8_SA(1, 0), a3, voffA);
            PG8_BAR; PG8_WAIT_L(0); PG8_MMA(1, 0, At, B0); PG8_BAR; PG8_SCHED;
            PG8_STAGE(PG8_SB(1, 1), b3 + hstep, voffB);
            PG8_WAIT_V(6); PG8_BAR; PG8_MMA(1, 1, At, B1); PG8_BAR;
            }
        }
        if constexpr (F8) asm volatile("s_nop 15\n\ts_nop 7" ::: "memory");
        if constexpr (ALIGN_EPI) { if (wr == 0) PG8_BAR; }
        if constexpr (!Epi::AFTER_DRAIN) { E(acc, cur, wr, wc, fr, fq); S.done(cur); }
        if (!has_next) break;
#pragma unroll
        for (int a = 0; a < 2; ++a)
#pragma unroll
            for (int b = 0; b < 2; ++b)
#pragma unroll
                for (int m = 0; m < 4; ++m)
#pragma unroll
                    for (int n = 0; n < 2; ++n) { float z0, z1, z2, z3; asm volatile("v_mov_b32 %0, 0\n\tv_mov_b32 %1, 0\n\tv_mov_b32 %2, 0\n\tv_mov_b32 %3, 0" : "=v"(z0), "=v"(z1), "=v"(z2), "=v"(z3)); acc[a][b][m][n] = (f32x4){z0, z1, z2, z3}; }
        cur = nxt; cA = nA; cB = nB; ++ui;
        if constexpr (ALIGN_EPI) { if (wr == 1) PG8_BAR; }
    }
    PG8_WAIT_V(0);
    if constexpr (!ALIGN_EPI) { if (wr == 0) PG8_BAR; }
    PG8_BAR;
    if constexpr (Epi::AFTER_DRAIN) { E.fused(acc, cur, wr, wc, fr, fq, lds, wid, lane); S.done(cur); }
#undef PG8_SA
#undef PG8_SB
#undef PG8_STAGE
#undef PG8_LDA
#undef PG8_LDB
#undef PG8_MMA
#undef PG8_WAIT_V
#undef PG8_WAIT_L
#undef PG8_BAR
#undef PG8_SCHED
}
}

#ifndef PG8_SP2
#define PG8_SP2 true
#endif

#define GAS __attribute__((address_space(1)))
#define LAS __attribute__((address_space(3)))
typedef unsigned short bf16;
typedef unsigned v4u __attribute__((ext_vector_type(4)));
typedef unsigned v2u __attribute__((ext_vector_type(2)));
typedef float f32x4 __attribute__((ext_vector_type(4)));
typedef float f32x2 __attribute__((ext_vector_type(2)));
typedef float f32x16 __attribute__((ext_vector_type(16)));
typedef short bf16x8 __attribute__((ext_vector_type(8)));
typedef short s16x4 __attribute__((ext_vector_type(4)));
typedef GAS unsigned gu32;
typedef GAS unsigned long long gu64;
typedef LAS const char* lcp;
typedef LAS char* lwp;
#define RLX_AGENT __ATOMIC_RELAXED, __HIP_MEMORY_SCOPE_AGENT
#define LDS_WAIT() asm volatile("s_waitcnt lgkmcnt(0)" ::: "memory")
#define VM_WAIT() asm volatile("s_waitcnt vmcnt(0)" ::: "memory")
#define WG_BAR() do { asm volatile("s_waitcnt vmcnt(0) lgkmcnt(0)" ::: "memory"); __builtin_amdgcn_s_barrier(); asm volatile("" ::: "memory"); } while (0)
#define DI __device__ __forceinline__
#define MFMA32(a, b, c) __builtin_amdgcn_mfma_f32_32x32x16_f16(__builtin_bit_cast(pg8::f16x8, (a)), __builtin_bit_cast(pg8::f16x8, (b)), (c), 0, 0, 0)
DI unsigned pk2(float lo, float hi) { return pg8::cvt_pk_bf16(lo, hi); }
DI float bflo(unsigned w) { return pg8::bf_lo(w); }
DI float bfhi(unsigned w) { return pg8::bf_hi(w); }
DI float ex2(float x) { return __builtin_amdgcn_exp2f(x); }
DI f32x16 zero16() { float z = 0.f; asm volatile("" : "+v"(z)); return (f32x16){z, z, z, z, z, z, z, z, z, z, z, z, z, z, z, z}; }
DI int crow(int r, int hi) { return (r & 3) + 8 * (r >> 2) + 4 * hi; }
#define SWZ_XOR(v, m) __uint_as_float((unsigned)__builtin_amdgcn_ds_swizzle((int)__float_as_uint(v), ((m) << 10) | 0x1f))
DI float half_swap_add(float v);
DI float wave_sum(float v) { v += SWZ_XOR(v, 1); v += SWZ_XOR(v, 2); v += SWZ_XOR(v, 4); v += SWZ_XOR(v, 8); v += SWZ_XOR(v, 16); return half_swap_add(v); }
DI float shfl_lane(float v, int src_lane) { return __uint_as_float((unsigned)__builtin_amdgcn_ds_bpermute(src_lane << 2, (int)__float_as_uint(v))); }
DI float half_swap_add(float v) { auto rr = __builtin_amdgcn_permlane32_swap(__float_as_uint(v), __float_as_uint(v), false, false); return __uint_as_float(rr[0]) + __uint_as_float(rr[1]); }
DI float half_swap_max(float v) { auto rr = __builtin_amdgcn_permlane32_swap(__float_as_uint(v), __float_as_uint(v), false, false); return fmaxf(__uint_as_float(rr[0]), __uint_as_float(rr[1])); }
typedef short v4i16_t __attribute__((ext_vector_type(4)));
DI s16x4 vtr(lcp p) { return __builtin_bit_cast(s16x4, __builtin_amdgcn_ds_read_tr16_b64_v4i16((LAS v4i16_t*)p)); }
DI bf16x8 cat8(s16x4 lo, s16x4 hi) { return (bf16x8){lo[0], lo[1], lo[2], lo[3], hi[0], hi[1], hi[2], hi[3]}; }
DI bf16x8 trfrag(lcp p) { return cat8(vtr(p), vtr(p + 512)); }
DI bf16x8 ldfrag(lcp p) { return *(const LAS bf16x8*)p; }
DI void glds16(const void* gsrc, LAS void* ldst) { __builtin_amdgcn_global_load_lds((const unsigned*)gsrc, (LAS unsigned*)ldst, 16, 0, 0); }
#define PACK8(x, s) ((bf16x8)__builtin_bit_cast(bf16x8, (v4u){pk2((x)[8 * (s) + 0], (x)[8 * (s) + 1]), pk2((x)[8 * (s) + 2], (x)[8 * (s) + 3]), pk2((x)[8 * (s) + 4], (x)[8 * (s) + 5]), pk2((x)[8 * (s) + 6], (x)[8 * (s) + 7])}))

constexpr int RING_OFF = 0, RING_BYTES = 131072;
constexpr int TAB_OFF = 131072;
constexpr int MISC_OFF = 163840 - 256;
constexpr int LDS_BYTES = 163840;
constexpr int AT_K = 0, AT_V = 32768, AT_WS = 65536, AT_STG = 67584;
constexpr int ML_K = 0, ML_V = 65536, ML_VW = 81920, ML_C = 98304, ML_N = 131072, ML_G2 = 131584, ML_M2 = 132096, ML_FI = 132608, ML_EI = 133120, ML_WK = 133632, ML_WKB = 134144, ML_SC = 134400, ML_WS = 134464, ML_STG = 136512;
static_assert(ML_STG + 4 * 4096 <= MISC_OFF && AT_STG + 8 * 4096 <= MISC_OFF && TAB_OFF + 16384 <= MISC_OFF, "LDS map");

#define XB_TMO      128
#define XB_XCNT(j)  (256  + 64 * (j))
#define XB_XSUB(j)  (1280 + 64 * (j))
#define XB_XGEN(j)  (2304 + 64 * (j))
#define XB_TOP      3328
#define XB_TOPGEN   3392
#define XCD_BAR_WORDS 3456
#define XB_SPIN_CAP (1u << 18)

__device__ __forceinline__ unsigned xb_ld(unsigned* p)              { return __hip_atomic_load(p, __ATOMIC_RELAXED, __HIP_MEMORY_SCOPE_AGENT); }
__device__ __forceinline__ unsigned xb_add(unsigned* p, unsigned v) { return __hip_atomic_fetch_add(p, v, __ATOMIC_RELAXED, __HIP_MEMORY_SCOPE_AGENT); }
__device__ __forceinline__ unsigned xb_xcc_id() { return (unsigned)__builtin_amdgcn_s_getreg((3 << 11) | 20) & 0xFu; }
#define XB_SPIN(cond, bar) do { unsigned _sp = 0; while (cond) { __builtin_amdgcn_s_sleep(1); \
    if ((++_sp & 255u) == 0u) { if (xb_ld(&(bar)[XB_TMO])) break; if (_sp > XB_SPIN_CAP) { atomicAdd(&(bar)[XB_TMO], 1u); break; } } } } while (0)

struct XcdBarrier {
    unsigned* bar; unsigned x;
    volatile LAS unsigned* st;
};

__device__ __forceinline__ XcdBarrier xcd_barrier_post(unsigned* bar, volatile LAS unsigned* st) {
    XcdBarrier b; b.bar = bar; b.x = xb_xcc_id(); b.st = st;
    if (threadIdx.x == 0) (void)xb_add(&bar[XB_XCNT(b.x)], 1u);
    return b;
}
__device__ __forceinline__ void xcd_barrier_complete(unsigned* bar, unsigned x, unsigned& nloc, unsigned& nx) {
    const unsigned G = gridDim.x * gridDim.y * gridDim.z;
    unsigned sum, cnt, mine, sp = 0u;
    for (;;) {
        sum = 0u; cnt = 0u; mine = 0u;
#pragma unroll
        for (unsigned j = 0; j < 16; ++j) { const unsigned c = xb_ld(&bar[XB_XCNT(j)]); sum += c; cnt += (c > 0u) ? 1u : 0u; mine = (j == x) ? c : mine; }
        if (sum == G) break;
        __builtin_amdgcn_s_sleep(1);
        if ((++sp & 255u) == 0u) { if (xb_ld(&bar[XB_TMO])) break; if (sp > XB_SPIN_CAP) { atomicAdd(&bar[XB_TMO], 1u); break; } }
    }
    nloc = mine > 0u ? mine : 1u; nx = cnt > 0u ? cnt : 1u;
}

__device__ __forceinline__ void xcd_barrier(const XcdBarrier& b) {
    asm volatile("s_waitcnt vmcnt(0)" ::: "memory");
    __syncthreads();
    if (threadIdx.x == 0) {
        unsigned* bar = b.bar;
        __builtin_amdgcn_s_waitcnt(0);
        unsigned nloc = b.st[0], nx = b.st[1];
        if (nloc == 0u) { xcd_barrier_complete(bar, b.x, nloc, nx); b.st[0] = nloc; b.st[1] = nx; }
        const unsigned old = xb_add(&bar[XB_XSUB(b.x)], 1u);
        const unsigned gen = old / nloc;
        if (old + 1u == (gen + 1u) * nloc) {
            __builtin_amdgcn_fence(__ATOMIC_RELEASE, "agent");
            asm volatile("s_waitcnt vmcnt(0)" ::: "memory");
            const unsigned og = xb_add(&bar[XB_TOP], 1u);
            const unsigned tg = og / nx;
            if (og + 1u == (tg + 1u) * nx) xb_add(&bar[XB_TOPGEN], 1u);
            else XB_SPIN(xb_ld(&bar[XB_TOPGEN]) == tg, bar);
            __builtin_amdgcn_fence(__ATOMIC_ACQUIRE, "agent");
            xb_add(&bar[XB_XGEN(b.x)], 1u);
            asm volatile("s_waitcnt vmcnt(0)" ::: "memory");
        } else {
            XB_SPIN(xb_ld(&bar[XB_XGEN(b.x)]) == gen, bar);
            __builtin_amdgcn_fence(__ATOMIC_ACQUIRE, "agent");
            asm volatile("s_waitcnt vmcnt(0)" ::: "memory");
        }
    }
    __syncthreads();
}
DI void attn_phase(unsigned char* ldsg, const bf16* QKV, unsigned char* AO8, const float* sinks, int G, int bid, int wave_in) {
    int wid = wave_in; asm volatile("" : "+s"(wid));
    const int lane = pg8::pg8_lane(), tid = wid * 64 + lane, r32 = lane & 31, hi = lane >> 5;
    LAS unsigned char* lds = (LAS unsigned char*)ldsg; const lcp L = (lcp)lds;
    LAS float* wsf = (LAS float*)(lds + AT_WS) + wid * 64;
    LAS unsigned char* stg = lds + AT_STG + wid * 4096;
    const lcp vlane = L + AT_V + ((lane >> 4) & 1) * 32 + (lane & 3) * 8 + (4 * hi + ((lane & 15) >> 2)) * 64;
    const lcp klane = L + AT_K + hi * 1024 + r32 * 16;
    for (int unit = bid; unit < BATCH * 16 * 4; unit += G) {
        const int kvh = unit & 3, nb = (unit >> 2) & 15, b = unit >> 6;
        const long rowq = (long)b * SEQ + nb * 128, rowk = rowq - 128;
        const int slot_lo = (nb == 0) ? 2 : 0;
        for (int sl = slot_lo; sl < 4; ++sl) {
            glds16(QKV + (rowk + 64 * sl + lane) * NQKV + 2048 + 64 * kvh + 8 * wid, lds + AT_K + sl * 8192 + wid * 1024);
            glds16(QKV + (rowk + 64 * sl + 16 * (wid & 3) + (lane >> 2)) * NQKV + 2304 + 64 * kvh + (wid >> 2) * 32 + (lane & 3) * 8, lds + AT_V + sl * 8192 + wid * 1024);
        }
        const int hq = 8 * kvh + wid;
        const bf16* qsrc = QKV + (rowq + r32) * NQKV + 64 * hq + 8 * hi;
        bf16x8 qn[4];
#pragma unroll
        for (int d0 = 0; d0 < 4; ++d0) qn[d0] = *(const bf16x8*)(qsrc + 16 * d0);
        const float slope2 = ex2(-0.25f * (float)(hq + 1)) * LOG2E, sink2 = sinks[hq] * LOG2E;
        const float base_l = -slope2 * (float)(r32 - 4 * hi);
        WG_BAR();
#pragma unroll 1
        for (int j = 0; j < 4; ++j) {
            const int ilo = (nb == 0) ? 4 - j : 0;
            bf16x8 qr[4];
#pragma unroll
            for (int d0 = 0; d0 < 4; ++d0) qr[d0] = qn[d0];
            if (j < 3) {
#pragma unroll
                for (int d0 = 0; d0 < 4; ++d0) qn[d0] = *(const bf16x8*)(qsrc + (size_t)(32 * (j + 1)) * NQKV + 16 * d0);
            }
            float sl2 = slope2, bl = base_l; asm volatile("" : "+v"(sl2), "+v"(bl));
            f32x16 p[5];
#pragma unroll
            for (int i = 0; i < 5; ++i) {
                if (i >= ilo) {
                    const int kt = j + i; const lcp kb = klane + (kt >> 1) * 8192 + (kt & 1) * 512;
                    f32x16 a = zero16();
#pragma unroll
                    for (int d0 = 0; d0 < 4; ++d0) a = MFMA32(ldfrag(kb + d0 * 2048), qr[d0], a);
#pragma unroll
                    for (int r = 0; r < 16; ++r) {
                        const int cr = (r & 3) + 8 * (r >> 2);
                        float s = fmaf(sl2, (float)(cr - 128 + 32 * i), fmaf(a[r], LOG2E, bl));
                        if (i == 0) { if (!(cr + 4 * hi > r32)) s = -INFINITY; }
                        if (i == 4) { if (!(cr + 4 * hi <= r32)) s = -INFINITY; }
                        a[r] = s;
                    }
                    p[i] = a;
                } else {
#pragma unroll
                    for (int r = 0; r < 16; ++r) p[i][r] = -INFINITY;
                }
            }
            float mx = sink2;
#pragma unroll
            for (int i = 0; i < 5; ++i)
#pragma unroll
                for (int r = 0; r < 16; ++r) mx = fmaxf(mx, p[i][r]);
            mx = half_swap_max(mx);
            float ls = 0.f;
#pragma unroll
            for (int i = 0; i < 5; ++i)
#pragma unroll
                for (int r = 0; r < 16; ++r) { const float e = ex2(p[i][r] - mx); p[i][r] = e; ls += e; }
            ls = half_swap_add(ls) + ex2(sink2 - mx);
            f32x16 o0 = zero16(), o1 = zero16();
#pragma unroll
            for (int i = 0; i < 5; ++i) {
                if (i >= ilo) {
                    const int kt = j + i; const lcp vb = vlane + (kt >> 1) * 8192 + (kt & 1) * 2048;
                    const bf16x8 pa = PACK8(p[i], 0), pb = PACK8(p[i], 1);
                    o0 = MFMA32(pa, trfrag(vb), o0);        o0 = MFMA32(pb, trfrag(vb + 1024), o0);
                    o1 = MFMA32(pa, trfrag(vb + 4096), o1); o1 = MFMA32(pb, trfrag(vb + 4096 + 1024), o1);
                }
            }
            if (hi == 0) wsf[r32] = __builtin_amdgcn_rcpf(ls);
#pragma unroll
            for (int r = 0; r < 16; ++r) {
                const int orow = crow(r, hi); const float rl = wsf[orow] * pg8::F8_SO;
                int pk; asm volatile("" : "=v"(pk)); pk = __builtin_amdgcn_cvt_pk_fp8_f32(o0[r] * rl, o1[r] * rl, pk, false);
                stg[orow * 64 + r32] = (unsigned char)(pk & 0xff);
                stg[orow * 64 + 32 + r32] = (unsigned char)((pk >> 8) & 0xff);
            }
#pragma unroll
            for (int i4 = 0; i4 < 2; ++i4) {
                const int row = i4 * 16 + (lane >> 2), ch = lane & 3;
                const v4u v = *(const LAS v4u*)(stg + row * 64 + ch * 16);
                *(v4u*)(AO8 + (rowq + 32 * j + row) * D + 64 * hq + ch * 16) = v;
            }
        }
        WG_BAR();
    }
}

constexpr int ML_GSET = ML_STG + 4 * 4096 - ML_G2;
static_assert(ML_G2 + ML_GSET + (ML_WS - ML_G2) <= MISC_OFF, "LDS map: second gate-array set");
#define DPPF(old, src, ctrl, rmask, bc) __uint_as_float((unsigned)__builtin_amdgcn_update_dpp((int)__float_as_uint(old), (int)__float_as_uint(src), (ctrl), (rmask), 0xf, (bc)))
DI float scan_add64(float v) {
    v += DPPF(0.f, v, 0x111, 0xf, true); v += DPPF(0.f, v, 0x112, 0xf, true); v += DPPF(0.f, v, 0x114, 0xf, true); v += DPPF(0.f, v, 0x118, 0xf, true);
    v += DPPF(0.f, v, 0x142, 0xa, false); v += DPPF(0.f, v, 0x143, 0xc, false); return v;
}
DI float scan_max64(float v) {
    const float ninf = -INFINITY;
    v = fmaxf(v, DPPF(ninf, v, 0x111, 0xf, false)); v = fmaxf(v, DPPF(ninf, v, 0x112, 0xf, false)); v = fmaxf(v, DPPF(ninf, v, 0x114, 0xf, false)); v = fmaxf(v, DPPF(ninf, v, 0x118, 0xf, false));
    v = fmaxf(v, DPPF(ninf, v, 0x142, 0xa, false)); v = fmaxf(v, DPPF(ninf, v, 0x143, 0xc, false)); return v;
}
DI float ml_gate_scan(LAS unsigned char* lds, int gofs, const float* GT, long row0, int h, int lane, float m_prev) {
    LAS float* G2 = (LAS float*)(lds + ML_G2 + gofs); LAS float* M2 = (LAS float*)(lds + ML_M2 + gofs); LAS float* FI = (LAS float*)(lds + ML_FI + gofs); LAS float* EI = (LAS float*)(lds + ML_EI + gofs);
    LAS float* WK = (LAS float*)(lds + ML_WK + gofs); LAS bf16* WKB = (LAS bf16*)(lds + ML_WKB + gofs); LAS float* SC = (LAS float*)(lds + ML_SC + gofs);
    const float* gp = GT + (size_t)(row0 + 2 * lane) * 8;
    const float i0 = gp[h], f0 = gp[4 + h], i1 = gp[8 + h], f1 = gp[12 + h];
    const float lf0 = -0.6931471805599453f * __builtin_amdgcn_logf(1.f + ex2(-LOG2E * f0)), lf1 = -0.6931471805599453f * __builtin_amdgcn_logf(1.f + ex2(-LOG2E * f1));
    const float incl = scan_add64(lf0 + lf1);
    const float b1 = incl, b0 = incl - lf1;
    const float g0 = i0 - b0, g1 = i1 - b1;
    const float cm = scan_max64(fmaxf(g0, g1));
    const float cprev = DPPF(-INFINITY, cm, 0x138, 0xf, false);
    const float M0 = fmaxf(m_prev, fmaxf(cprev, g0)), M1 = fmaxf(m_prev, cm);
    const float Mend = __uint_as_float((unsigned)__builtin_amdgcn_readlane((int)__float_as_uint(M1), 63)), blast = __uint_as_float((unsigned)__builtin_amdgcn_readlane((int)__float_as_uint(b1), 63));
    *(LAS f32x2*)(G2 + 2 * lane) = (f32x2){g0 * LOG2E, g1 * LOG2E};
    *(LAS f32x2*)(M2 + 2 * lane) = (f32x2){M0 * LOG2E, M1 * LOG2E};
    *(LAS f32x2*)(FI + 2 * lane) = (f32x2){ex2((m_prev - M0) * LOG2E), ex2((m_prev - M1) * LOG2E)};
    *(LAS f32x2*)(EI + 2 * lane) = (f32x2){ex2(-(b0 + M0) * LOG2E), ex2(-(b1 + M1) * LOG2E)};
    const float w0 = ex2((g0 - Mend) * LOG2E), w1 = ex2((g1 - Mend) * LOG2E);
    *(LAS f32x2*)(WK + 2 * lane) = (f32x2){w0, w1};
    *(LAS unsigned*)(WKB + 2 * lane) = pk2(w0, w1);
    if (lane == 0) SC[0] = ex2((m_prev - Mend) * LOG2E);
    return blast + Mend;
}
template <int VAR = 0>
DI void mlstm_phase(unsigned char* ldsg, const bf16* MP, const float* GT, bf16* HG, int G, int bid, int wave_in) {
    int wid = wave_in; asm volatile("" : "+s"(wid));
    const int lane0 = pg8::pg8_lane(), tid = wid * 64 + lane0;
    LAS unsigned char* lds = (LAS unsigned char*)ldsg; const lcp L = (lcp)lds;
    LAS float* wsf = (LAS float*)(lds + ML_WS) + wid * 64;
    for (int unit = bid; unit < BATCH * 4 * 8; unit += G) {
        const int ux = unit & 7, uy = unit >> 3, bh = ux + 8 * (uy >> 3), sl = uy & 7, h = bh & 3, b = bh >> 2;
        const bf16* Qp = MP + 256 * h; const bf16* Kp = MP + 1024 + 256 * h; const bf16* Vp = MP + 2048 + 512 * h + 64 * sl; const bf16* OGp = MP + 4096 + 512 * h + 64 * sl;
        { unsigned z = 0u; asm volatile("" : "+v"(z)); for (int i = tid; i < (32768 + 512) / 16; i += 512) *(LAS v4u*)(lds + ML_C + i * 16) = (v4u){z, z, z, z}; }
        f32x16 T[6];
#pragma unroll
        for (int x = 0; x < 6; ++x) T[x] = zero16();
        float m_prev = 0.f;
        v4u X[16], vreg[2];
        { const long row0 = (long)b * SEQ; const int lane = lane0, r32 = lane & 31, hi = lane >> 5;
          if (wid >= 4) {
#pragma unroll
              for (int i = 0; i < 16; ++i) X[i] = *(const v4u*)(Kp + (row0 + 8 * i + (lane & 7)) * NMI + (8 * (wid - 4) + (lane >> 3)) * 8);
          } else {
#pragma unroll
              for (int ks = 0; ks < 16; ++ks) X[ks] = *(const v4u*)(Qp + (row0 + 32 * wid + r32) * NMI + 16 * ks + 8 * hi);
          }
#pragma unroll
          for (int i = 0; i < 2; ++i) vreg[i] = *(const v4u*)(Vp + (row0 + 64 * i + 16 * (wid & 3) + (lane >> 2)) * NMI + (wid >> 2) * 32 + (lane & 3) * 8);
          if (wid == 4 && !(VAR & 16)) m_prev = ml_gate_scan(lds, 0, GT, row0, h, lane, m_prev);
        }
        WG_BAR();
        for (int c = 0; c < 16; ++c) {
            const long row0 = (long)b * SEQ + 128 * c;
            const int gofs = (c & 1) * ML_GSET;
            const int lane = pg8::pg8_lane(), r32 = lane & 31, hi = lane >> 5;
            const int blk = (lane >> 4) & 1, q4 = (lane & 15) >> 2, p4 = lane & 3;
            const int vlo_ = blk * 32 + p4 * 8 + (4 * hi + q4) * 64;
            const int ktl_ = (2 * blk + (p4 >> 1)) * 2048 + (q4 + 4 * hi) * 16 + (p4 & 1) * 8;
            const int cbl_ = hi * 1024 + r32 * 16, kbl_ = hi * 2048 + r32 * 16;
            const unsigned m0 = (r32 == 0) ? 0xffffffffu : 0u; const v4u m0v = {m0, m0, m0, m0};
            LAS float* G2 = (LAS float*)(lds + ML_G2 + gofs); LAS float* M2 = (LAS float*)(lds + ML_M2 + gofs); LAS float* FI = (LAS float*)(lds + ML_FI + gofs); LAS float* EI = (LAS float*)(lds + ML_EI + gofs);
            LAS float* WK = (LAS float*)(lds + ML_WK + gofs); LAS bf16* WKB = (LAS bf16*)(lds + ML_WKB + gofs); LAS float* SC = (LAS float*)(lds + ML_SC + gofs);
            VM_WAIT();
            if (wid >= 4) {
#pragma unroll
                for (int i = 0; i < 16; ++i) *(LAS v4u*)(lds + ML_K + (8 * (wid - 4) + (lane >> 3)) * 2048 + (8 * i + (lane & 7)) * 16) = X[i];
            }
#pragma unroll
            for (int i = 0; i < 2; ++i) { const float w = WK[64 * i + 16 * (wid & 3) + (lane >> 2)]; const v4u v = vreg[i]; v4u o;
                o.x = pk2(bflo(v.x) * w, bfhi(v.x) * w); o.y = pk2(bflo(v.y) * w, bfhi(v.y) * w); o.z = pk2(bflo(v.z) * w, bfhi(v.z) * w); o.w = pk2(bflo(v.w) * w, bfhi(v.w) * w);
                *(LAS v4u*)(lds + ML_V + i * 8192 + wid * 1024 + lane * 16) = v;
                *(LAS v4u*)(lds + ML_VW + i * 8192 + wid * 1024 + lane * 16) = o; }
            WG_BAR();
            const bool more = c + 1 < 16;
            if (more && !(VAR & 32)) {
                const long row1 = row0 + 128;
                if (wid >= 4) {
#pragma unroll
                    for (int i = 0; i < 16; ++i) X[i] = *(const v4u*)(Kp + (row1 + 8 * i + (lane & 7)) * NMI + (8 * (wid - 4) + (lane >> 3)) * 8);
                }
#pragma unroll
                for (int i = 0; i < 2; ++i) vreg[i] = *(const v4u*)(Vp + (row1 + 64 * i + 16 * (wid & 3) + (lane >> 2)) * NMI + (wid >> 2) * 32 + (lane & 3) * 8);
            }
            if (wid < 4) {
                const int tt = wid;
                v4u ogv[4];
#pragma unroll
                for (int i4 = 0; i4 < 4; ++i4) ogv[i4] = *(const v4u*)(OGp + (row0 + 32 * tt + i4 * 8 + (lane >> 3)) * NMI + (lane & 7) * 8);
                T[0] = zero16(); T[1] = zero16(); T[2] = zero16();
                if (!(VAR & 4)) { const lcp cb = L + ML_C + cbl_; const lcp nbp = L + ML_N + 16 * hi;
#pragma unroll
                  for (int ks = 0; ks < 16; ++ks) {
                      const bf16x8 c0 = ldfrag(cb + ks * 2048), c1 = ldfrag(cb + ks * 2048 + 512);
                      const bf16x8 nf = __builtin_bit_cast(bf16x8, __builtin_bit_cast(v4u, ldfrag(nbp + ks * 32)) & m0v);
                      T[0] = MFMA32(__builtin_bit_cast(bf16x8, X[ks]), c0, T[0]); T[1] = MFMA32(__builtin_bit_cast(bf16x8, X[ks]), c1, T[1]); T[2] = MFMA32(__builtin_bit_cast(bf16x8, X[ks]), nf, T[2]);
                      if ((ks & 3) == 3) __builtin_amdgcn_sched_barrier(0);
                  } }
                { float fi[16];
#pragma unroll
                  for (int r = 0; r < 16; ++r) fi[r] = FI[32 * tt + crow(r, hi)];
#pragma unroll
                  for (int r = 0; r < 16; ++r) { T[0][r] *= fi[r]; T[1][r] *= fi[r]; }
                  if (r32 == 0) {
#pragma unroll
                      for (int r = 0; r < 16; ++r) wsf[crow(r, hi)] = T[2][r] * fi[r];
                  } }
                const float Mt = M2[32 * tt + r32];
                float dsum = 0.f;
                for (int st = 0; st <= ((VAR & 2) ? -1 : tt); ++st) {
                    f32x16 S = zero16();
                    const lcp kb = L + ML_K + kbl_ + st * 512;
#pragma unroll
                    for (int ks = 0; ks < 16; ++ks) S = MFMA32(ldfrag(kb + ks * 4096), __builtin_bit_cast(bf16x8, X[ks]), S);
#pragma unroll
                    for (int r = 0; r < 16; ++r) {
                        const float w = ex2(G2[32 * st + crow(r, hi)] - Mt);
                        float v = S[r] * w;
                        if (st == tt && crow(r, hi) > r32) v = 0.f;
                        S[r] = v; dsum += v;
                    }
                    const bf16x8 pa = PACK8(S, 0), pb = PACK8(S, 1);
                    const lcp vb = L + ML_V + (st >> 1) * 8192 + (st & 1) * 2048 + vlo_;
                    T[0] = MFMA32(pa, trfrag(vb), T[0]);        T[0] = MFMA32(pb, trfrag(vb + 1024), T[0]);
                    T[1] = MFMA32(pa, trfrag(vb + 4096), T[1]); T[1] = MFMA32(pb, trfrag(vb + 4096 + 1024), T[1]);
                }
                if (more && !(VAR & 64)) {
#pragma unroll
                    for (int ks = 0; ks < 16; ++ks) X[ks] = *(const v4u*)(Qp + (row0 + 128 + 32 * wid + r32) * NMI + 16 * ks + 8 * hi);
                }
                dsum = half_swap_add(dsum);
                { const float den = wsf[r32] + dsum; const float dn = fmaxf(fabsf(den), EI[32 * tt + r32]);
                  if (hi == 0) wsf[32 + r32] = __builtin_amdgcn_rcpf(dn); }
                LAS bf16* stg = (LAS bf16*)(lds + ML_STG + tt * 4096);
                if (!(VAR & 8)) {
#pragma unroll
                for (int r = 0; r < 16; ++r) {
                    const int orow = crow(r, hi); const float rd = wsf[32 + orow];
                    stg[orow * 64 + r32] = (bf16)(pk2(T[0][r] * rd, 0.f) & 0xffffu);
                    stg[orow * 64 + 32 + r32] = (bf16)(pk2(T[1][r] * rd, 0.f) & 0xffffu);
                }
#pragma unroll
                for (int i4 = 0; i4 < 4; ++i4) {
                    const int row = i4 * 8 + (lane >> 3), ch = lane & 7;
                    const v4u hv = *(const LAS v4u*)(stg + row * 64 + ch * 8);
                    const v4u og = ogv[i4];
                    v4u o;
                    o.x = pk2(bflo(hv.x) * bflo(og.x), bfhi(hv.x) * bfhi(og.x)); o.y = pk2(bflo(hv.y) * bflo(og.y), bfhi(hv.y) * bfhi(og.y));
                    o.z = pk2(bflo(hv.z) * bflo(og.z), bfhi(hv.z) * bfhi(og.z)); o.w = pk2(bflo(hv.w) * bflo(og.w), bfhi(hv.w) * bfhi(og.w));
                    *(v4u*)(HG + (row0 + 32 * tt + row) * D + 512 * h + 64 * sl + ch * 8) = o;
                }
                }
#pragma unroll
                for (int x = 3; x < 6; ++x) T[x] = zero16();
            } else {
                const float decay = SC[0];
#pragma unroll
                for (int x = 0; x < 6; ++x)
#pragma unroll
                    for (int r = 0; r < 16; ++r) T[x][r] *= decay;
#pragma unroll
                for (int dti = 0; dti < ((VAR & 1) ? 0 : 2); ++dti) {
                    const int dt = 2 * (wid - 4) + dti;
                    const lcp ka0 = L + ML_K + dt * 8192 + ktl_;
#pragma unroll
                    for (int s8 = 0; s8 < 8; ++s8) {
                        const lcp ka = ka0 + s8 * 256;
                        const bf16x8 af = cat8(vtr(ka), vtr(ka + 128));
                        const lcp vwb = L + ML_VW + (s8 >> 2) * 8192 + (s8 & 3) * 1024 + vlo_;
                        const bf16x8 b0 = trfrag(vwb), b1 = trfrag(vwb + 4096);
                        const LAS s16x4* wp = (const LAS s16x4*)(WKB + 16 * s8 + 4 * hi);
                        const bf16x8 nb = __builtin_bit_cast(bf16x8, __builtin_bit_cast(v4u, cat8(wp[0], wp[2])) & m0v);
                        T[2 * dti] = MFMA32(af, b0, T[2 * dti]); T[2 * dti + 1] = MFMA32(af, b1, T[2 * dti + 1]); T[4 + dti] = MFMA32(af, nb, T[4 + dti]);
                        if (s8 & 1) __builtin_amdgcn_sched_barrier(0);
                    }
                }
                if (more && wid == 4 && !(VAR & 16)) m_prev = ml_gate_scan(lds, ML_GSET - gofs, GT, row0 + 128, h, lane, m_prev);
            }
            asm volatile("s_waitcnt lgkmcnt(0)" ::: "memory"); __builtin_amdgcn_s_barrier(); asm volatile("" ::: "memory");
            if (wid >= 4) {
#pragma unroll
                for (int dti = 0; dti < 2; ++dti) {
                    const int dt = 2 * (wid - 4) + dti;
#pragma unroll
                    for (int et = 0; et < 2; ++et)
#pragma unroll
                        for (int g = 0; g < 4; ++g)
                            *(LAS v2u*)(lds + ML_C + (4 * dt + g) * 1024 + (32 * et + r32) * 16 + hi * 8) = (v2u){pk2(T[2 * dti + et][4 * g], T[2 * dti + et][4 * g + 1]), pk2(T[2 * dti + et][4 * g + 2], T[2 * dti + et][4 * g + 3])};
                    if (r32 == 0) {
#pragma unroll
                        for (int g = 0; g < 4; ++g)
                            *(LAS v2u*)(lds + ML_N + (32 * dt + 8 * g + 4 * hi) * 2) = (v2u){pk2(T[4 + dti][4 * g], T[4 + dti][4 * g + 1]), pk2(T[4 + dti][4 * g + 2], T[4 + dti][4 * g + 3])};
                    }
                }
            }
        }
        WG_BAR();
    }
}


constexpr int NWAVES = 8;

template <bool F8> DI void tr_strip(const float* W, int ldw, int n0, void* WTv, size_t wt_row0, int Kdim, int kb0, int nkb, const float* g, const float* bb, float cs, float* c1o, float* c2o, LAS float* scr, int lane) {
    bf16* WT = (bf16*)WTv; unsigned char* WT8 = (unsigned char*)WTv;
    const int c = lane & 7;
    float a1[4] = {0.f, 0.f, 0.f, 0.f}, a2[4] = {0.f, 0.f, 0.f, 0.f};
    for (int kb = kb0; kb < kb0 + nkb; ++kb) {
        const int k0 = kb * 64;
#pragma unroll 8
        for (int i = 0; i < 32; ++i) { const int kk = 2 * i + (lane >> 5); scr[kk * 33 + (lane & 31)] = W[(size_t)(k0 + kk) * ldw + n0 + (lane & 31)]; }
        float gk[8], bk[8];
        if (g) { const f32x4 g0 = *(const f32x4*)(g + k0 + 8 * c), g1 = *(const f32x4*)(g + k0 + 8 * c + 4), b0 = *(const f32x4*)(bb + k0 + 8 * c), b1 = *(const f32x4*)(bb + k0 + 8 * c + 4);
#pragma unroll
            for (int i = 0; i < 4; ++i) { gk[i] = g0[i] * cs; gk[4 + i] = g1[i] * cs; bk[i] = b0[i] * cs; bk[4 + i] = b1[i] * cs; } }
        else {
#pragma unroll
            for (int i = 0; i < 8; ++i) { gk[i] = cs; bk[i] = 0.f; } }
        LDS_WAIT(); asm volatile("" ::: "memory");
#pragma unroll
        for (int j = 0; j < 4; ++j) { const int n = (lane >> 3) + 8 * j; const LAS float* s = scr + (8 * c) * 33 + n;
            float v[8];
#pragma unroll
            for (int i = 0; i < 8; ++i) v[i] = s[i * 33];
            a2[j] += ((v[0] * bk[0] + v[1] * bk[1]) + (v[2] * bk[2] + v[3] * bk[3])) + ((v[4] * bk[4] + v[5] * bk[5]) + (v[6] * bk[6] + v[7] * bk[7]));
            if constexpr (F8) {
                float wv[8];
#pragma unroll
                for (int i = 0; i < 8; ++i) wv[i] = v[i] * gk[i];
                const v2u o = pg8::cvt8_f8(wv, pg8::F8_SW);
                a1[j] += ((__builtin_amdgcn_cvt_f32_fp8((int)o.x, 0) + __builtin_amdgcn_cvt_f32_fp8((int)o.x, 1)) + (__builtin_amdgcn_cvt_f32_fp8((int)o.x, 2) + __builtin_amdgcn_cvt_f32_fp8((int)o.x, 3)))
                       + ((__builtin_amdgcn_cvt_f32_fp8((int)o.y, 0) + __builtin_amdgcn_cvt_f32_fp8((int)o.y, 1)) + (__builtin_amdgcn_cvt_f32_fp8((int)o.y, 2) + __builtin_amdgcn_cvt_f32_fp8((int)o.y, 3)));
                *(GAS v2u*)(WT8 + (wt_row0 + n) * Kdim + k0 + 8 * c) = o;
            } else {
                v4u o; o.x = pk2(v[0] * gk[0], v[1] * gk[1]); o.y = pk2(v[2] * gk[2], v[3] * gk[3]); o.z = pk2(v[4] * gk[4], v[5] * gk[5]); o.w = pk2(v[6] * gk[6], v[7] * gk[7]);
                a1[j] += ((bflo(o.x) + bfhi(o.x)) + (bflo(o.y) + bfhi(o.y))) + ((bflo(o.z) + bfhi(o.z)) + (bflo(o.w) + bfhi(o.w)));
                *(GAS v4u*)(WT + (wt_row0 + n) * Kdim + k0 + 8 * c) = o;
            } }
        LDS_WAIT(); asm volatile("" ::: "memory");
    }
    if (g) {
#pragma unroll
        for (int j = 0; j < 4; ++j) { float s1 = a1[j], s2 = a2[j];
            s1 += SWZ_XOR(s1, 1); s2 += SWZ_XOR(s2, 1); s1 += SWZ_XOR(s1, 2); s2 += SWZ_XOR(s2, 2); s1 += SWZ_XOR(s1, 4); s2 += SWZ_XOR(s2, 4);
            if (c == 0) { c1o[(lane >> 3) + 8 * j] = F8 ? s1 * (1.f / pg8::F8_SW) : s1; c2o[(lane >> 3) + 8 * j] = s2; } }
    }
}

DI void prologue(kargs_t a, LAS unsigned char* lds, int gw, int NGW, int wave, int lane) {
    unsigned char* ws = a->ws;
    float* vec = (float*)(ws + WS_VEC);
    const float* ones = (const float*)(ws + WS_VEC + V_ONES); const float* zeros = (const float*)(ws + WS_VEC + V_ZEROS);
    LAS float* scr = (LAS float*)(lds + wave * 16384);
    constexpr int T_UP = 8 * 2 * 176, T_QKV = 2 * 80, T_MI = 2 * 192, T_W2 = 8 * 64 * 4, T_WO = 2 * 64, T_WMO = 2 * 64, T_G = 16;
    constexpr int NT = T_UP + T_QKV + T_MI + T_W2 + T_WO + T_WMO + T_G;
    for (int it = gw; it < NT; it += NGW) {
        int r = it;
        if (r < T_UP) {
            const int f = r / 352, rr = r % 352, which = rr / 176, strip = rr % 176, n0 = 32 * strip;
            const int t = 3 * (f >> 1) + 2 * (f & 1);
            const float* gp = t ? a->ln_g + (size_t)(t - 1) * D : nullptr; const float* bp = t ? a->ln_b + (size_t)(t - 1) * D : nullptr;
            const size_t wrow = (size_t)256 * (n0 / 128) + 128 * which + (n0 % 128);
            const float* W = (which ? a->w3 : a->w1) + (size_t)f * D * FF;
            if (gp) tr_strip<true>(W, FF, n0, ws + WS_W13 + (size_t)f * NUP * D, wrow, D, 0, 32, gp, bp, 1.f, vec + V_C1U / 4 + (size_t)f * NUP + wrow, vec + V_C2U / 4 + (size_t)f * NUP + wrow, scr, lane);
            else { tr_strip<true>(W, FF, n0, ws + WS_W13 + (size_t)f * NUP * D, wrow, D, 0, 32, nullptr, nullptr, 1.f, nullptr, nullptr, scr, lane);
                   if (lane < 32) { vec[V_C1U / 4 + (size_t)f * NUP + wrow + lane] = 0.f; vec[V_C2U / 4 + (size_t)f * NUP + wrow + lane] = 0.f; } }
            continue; }
        r -= T_UP;
        if (r < T_QKV) { const int j = r / 80, n0 = 32 * (r % 80); const int t = 6 * j + 1;
            tr_strip<true>(a->wqkv + (size_t)j * D * NQKV, NQKV, n0, ws + WS_WQKV + (size_t)j * NQKV * D, n0, D, 0, 32, a->ln_g + (size_t)(t - 1) * D, a->ln_b + (size_t)(t - 1) * D, n0 < 2048 ? 0.125f : 1.f,
                     vec + V_C1Q / 4 + j * NQKV + n0, vec + V_C2Q / 4 + j * NQKV + n0, scr, lane);
            continue; }
        r -= T_QKV;
        if (r < T_MI) { const int j = r / 192, n0 = 32 * (r % 192); const int t = 6 * j + 4;
            if (true) tr_strip<false>(a->win + (size_t)j * D * NMIW, NMIW, n0, (bf16*)(ws + WS_WIN) + (size_t)j * NMI * D, n0, D, 0, 32, a->ln_g + (size_t)(t - 1) * D, a->ln_b + (size_t)(t - 1) * D, (n0 >= 1024 && n0 < 2048) ? 0.0625f : 1.f,
                     vec + V_C1I / 4 + j * NMI + n0, vec + V_C2I / 4 + j * NMI + n0, scr, lane);
            else tr_strip<true>(a->win + (size_t)j * D * NMIW, NMIW, n0, ws + WS_WIN + 32 * MiB + (size_t)j * 2048 * D, n0 - 4096, D, 0, 32, a->ln_g + (size_t)(t - 1) * D, a->ln_b + (size_t)(t - 1) * D, 1.f,
                     vec + V_C1I / 4 + j * NMI + n0, vec + V_C2I / 4 + j * NMI + n0, scr, lane);
            continue; }
        r -= T_MI;
        if (r < T_W2) { const int f = r / 256, rr = r % 256, strip = rr / 4, kq = rr % 4;
            tr_strip<true>(a->w2 + (size_t)f * FF * D, D, 32 * strip, ws + WS_W2 + (size_t)f * D * FF, 32 * strip, FF, 22 * kq, 22, nullptr, nullptr, 1.f, nullptr, nullptr, scr, lane);
            continue; }
        r -= T_W2;
        if (r < T_WO) { const int j = r / 64, strip = r % 64;
            tr_strip<true>(a->wo + (size_t)j * D * D, D, 32 * strip, ws + WS_WO + (size_t)j * D * D, 32 * strip, D, 0, 32, nullptr, nullptr, 1.f, nullptr, nullptr, scr, lane);
            continue; }
        r -= T_WO;
        if (r < T_WMO) { const int j = r / 64, strip = r % 64;
            tr_strip<false>(a->wmo + (size_t)j * D * D, D, 32 * strip, (bf16*)(ws + WS_WMO) + (size_t)j * D * D, 32 * strip, D, 0, 32, nullptr, nullptr, 1.f, nullptr, nullptr, scr, lane);
            continue; }
        r -= T_WMO;
        {
            const int j = r / 8, jj = r % 8; const int t = 6 * j + 4;
            const float* gp = a->ln_g + (size_t)(t - 1) * D; const float* bp = a->ln_b + (size_t)(t - 1) * D;
            const float* W = a->win + (size_t)j * D * NMIW + NMI + jj;
            bf16* wg16 = (bf16*)(vec + V_WG / 4) + (size_t)(j * 8 + jj) * D;
            float s1 = 0.f, s2 = 0.f;
            for (int k = lane; k < D; k += 64) { const float w = W[(size_t)k * NMIW]; const unsigned hv = pk2(w * gp[k], 0.f) & 0xffffu; wg16[k] = (bf16)hv; s1 += bflo(hv); s2 += w * bp[k]; }
            s1 = wave_sum(s1); s2 = wave_sum(s2);
            if (lane == 0) { vec[V_CG / 4 + j * 16 + jj] = s1; vec[V_CG / 4 + j * 16 + 8 + jj] = s2 + a->bg[j * 8 + jj]; }
        }
    }
    bf16* R = (bf16*)(ws + WS_R); float* sp0 = (float*)(ws + WS_SP);
    for (int m = gw; m < M; m += NGW) {
        const GAS f32x4* xr = (const GAS f32x4*)(a->x + (size_t)m * D);
#pragma unroll
        for (int i = 0; i < 4; ++i) { const f32x4 v0 = xr[(i * 64 + lane) * 2], v1 = xr[(i * 64 + lane) * 2 + 1];
            *(GAS v4u*)(R + (size_t)m * D + (i * 64 + lane) * 8) = (v4u){pk2(v0[0], v0[1]), pk2(v0[2], v0[3]), pk2(v1[0], v1[1]), pk2(v1[2], v1[3])};
            { const float xv[8] = {v0[0], v0[1], v0[2], v0[3], v1[0], v1[1], v1[2], v1[3]}; *(GAS v2u*)(ws + WS_R8 + (size_t)m * D + (i * 64 + lane) * 8) = pg8::cvt8_f8(xv, pg8::F8_SR); } }
        if (lane < 8) *(f32x2*)(sp0 + (size_t)m * 16 + lane * 2) = (f32x2){0.f, 256.f * (1.f - LN_EPS)};
    }
    for (int i = gw * 64 + lane; i < D; i += NGW * 64) { vec[V_ONES / 4 + i] = 1.f; vec[V_ZEROS / 4 + i] = 0.f; }
    (void)ones; (void)zeros;
}

DI void gates_phase(LAS unsigned char* lds, const bf16* R, const float* sp, const bf16* wg16, const float* cg, float* GT, int G, int bid, int wave_in) {
    int wave = wave_in; asm volatile("" : "+s"(wave));
    const int lane = pg8::pg8_lane(), tid = wave * 64 + lane, r32 = lane & 31, hi = lane >> 5;
    LAS float* part = (LAS float*)lds;
    const unsigned mk = (r32 < 8) ? 0xffffffffu : 0u; const v4u mkv = {mk, mk, mk, mk};
    for (int panel = bid; panel < M / 64; panel += G) {
        const long r0 = (long)panel * 64;
        const bf16* bsrc = wg16 + (size_t)(r32 & 7) * D + 256 * wave + 8 * hi;
        bf16x8 bfr[16];
#pragma unroll
        for (int ks = 0; ks < 16; ++ks) bfr[ks] = __builtin_bit_cast(bf16x8, *(const v4u*)(bsrc + 16 * ks) & mkv);
#pragma unroll
        for (int rt = 0; rt < 2; ++rt) {
            const bf16* asrc = R + (r0 + 32 * rt + r32) * D + 256 * wave + 8 * hi;
            bf16x8 afr[16];
#pragma unroll
            for (int ks = 0; ks < 16; ++ks) afr[ks] = *(const bf16x8*)(asrc + 16 * ks);
            f32x16 acc = zero16();
#pragma unroll
            for (int ks = 0; ks < 16; ++ks) acc = MFMA32(afr[ks], bfr[ks], acc);
            if (r32 < 8) {
#pragma unroll
                for (int r = 0; r < 16; ++r) part[(wave * 64 + 32 * rt + crow(r, hi)) * 8 + r32] = acc[r];
            }
        }
        WG_BAR();
        {
            const int row = tid >> 3, col = tid & 7;
            float s = 0.f;
#pragma unroll
            for (int w = 0; w < 8; ++w) s += part[(w * 64 + row) * 8 + col];
            const f32x4* spr = (const f32x4*)(sp + (size_t)(r0 + row) * 16);
            const f32x4 v0 = spr[0], v1 = spr[1], v2 = spr[2], v3 = spr[3];
            const float ss = ((v0[0] + v0[2]) + (v1[0] + v1[2])) + ((v2[0] + v2[2]) + (v3[0] + v3[2])), qq = ((v0[1] + v0[3]) + (v1[1] + v1[3])) + ((v2[1] + v2[3]) + (v3[1] + v3[3]));
            const float mean = ss * (1.f / D), var = qq * (1.f / D) - mean * mean, rstd = __builtin_amdgcn_rsqf(var + LN_EPS);
            GT[(size_t)(r0 + row) * 8 + col] = rstd * (s - mean * cg[col]) + cg[8 + col];
        }
        WG_BAR();
    }
}

DI void final_ln(const bf16* R, const float* sp, const float* g, const float* b, float* out, int gw, int NGW, int lane) {
    for (int m = gw; m < M; m += NGW) {
        float s, q;
        { const f32x4 v = *(const f32x4*)(sp + (size_t)m * 16 + (lane & 3) * 4); s = v[0] + v[2]; q = v[1] + v[3];
          s += SWZ_XOR(s, 1); q += SWZ_XOR(q, 1); s += SWZ_XOR(s, 2); q += SWZ_XOR(q, 2); }
        const float mean = s * (1.f / D), var = q * (1.f / D) - mean * mean, rstd = __builtin_amdgcn_rsqf(var + LN_EPS);
#pragma unroll
        for (int i = 0; i < 4; ++i) {
            const int k = 8 * lane + 512 * i;
            const v4u rv = *(const v4u*)(R + (size_t)m * D + k);
            const f32x4 g0 = *(const f32x4*)(g + k), g1 = *(const f32x4*)(g + k + 4), b0 = *(const f32x4*)(b + k), b1 = *(const f32x4*)(b + k + 4);
            f32x4 o0, o1;
            o0[0] = (bflo(rv.x) - mean) * rstd * g0[0] + b0[0]; o0[1] = (bfhi(rv.x) - mean) * rstd * g0[1] + b0[1]; o0[2] = (bflo(rv.y) - mean) * rstd * g0[2] + b0[2]; o0[3] = (bfhi(rv.y) - mean) * rstd * g0[3] + b0[3];
            o1[0] = (bflo(rv.z) - mean) * rstd * g1[0] + b1[0]; o1[1] = (bfhi(rv.z) - mean) * rstd * g1[1] + b1[1]; o1[2] = (bflo(rv.w) - mean) * rstd * g1[2] + b1[2]; o1[3] = (bfhi(rv.w) - mean) * rstd * g1[3] + b1[3];
            *(GAS f32x4*)(out + (size_t)m * D + k) = o0; *(GAS f32x4*)(out + (size_t)m * D + k + 4) = o1;
        }
    }
}

#ifndef PROBE_DUP
#define PROBE_DUP 0
#endif
#ifndef PROBE_MLV
#define PROBE_MLV 0
#endif
#ifndef SKIP_ATT
#define SKIP_ATT 0
#endif
#ifndef SKIP_MLSTM
#define SKIP_MLSTM 0
#endif

#define GRID_BAR1() do { XcdBarrier b_; b_.bar = (unsigned*)(kargs()->ws + WS_CTL) + CW_BAR; b_.x = xb_xcc_id(); b_.st = (volatile LAS unsigned*)(lds + MISC_OFF) + 8; xcd_barrier(b_); } while (0)
#define GRID_BAR() do { GRID_BAR1(); if (PROBE_DUP & 1024) GRID_BAR1(); } while (0)

__global__ void __launch_bounds__(NWAVES * 64, 2) fwd_kernel(Args args_by_value) {
    extern __shared__ __attribute__((aligned(16))) unsigned char lds_raw[];
    LAS unsigned char* lds = (LAS unsigned char*)lds_raw;
    const int w0 = __builtin_amdgcn_readfirstlane((int)threadIdx.x >> 6);
    const int G0 = gridDim.x, bid0 = blockIdx.x; const int G = G0, bid = bid0;
    { const int tid0 = threadIdx.x; if (tid0 < 64) ((volatile LAS unsigned*)(lds + MISC_OFF))[tid0] = 0u; }
    __syncthreads();
    (void)xcd_barrier_post((unsigned*)(kargs()->ws + WS_CTL) + CW_BAR, (volatile LAS unsigned*)(lds + MISC_OFF) + 8);
    {
        const int vcu = (G % 8 == 0) ? (bid % 8) * (G / 8) + bid / 8 : bid;
        prologue(kargs(), lds, vcu * NWAVES + w0, G * NWAVES, w0, pg8::pg8_lane());
        if (PROBE_DUP & 1) { WG_BAR(); prologue(kargs(), lds, vcu * NWAVES + w0, G * NWAVES, w0, pg8::pg8_lane()); }
    }
    GRID_BAR();

    for (int t = 0; t < 3 * DEPTH; ++t) {
        int G = G0, bid = bid0; asm volatile("" : "+s"(G), "+s"(bid));
        const int layer = t / 3, sub = t % 3;
        const int kind = (sub != 1) ? 0 : ((layer & 1) ? 2 : 1);
        const int j = layer >> 1;
        {
            unsigned char* ws = kargs()->ws;
            float* vec = (float*)(ws + WS_VEC);
            const bf16* R = (const bf16*)(ws + WS_R);
            const float* sp_in = (const float*)(ws + WS_SP) + (size_t)(t & 1) * (SP_BYTES / 4);
            if (kind == 0) {
                const int f = 2 * layer + (sub >> 1);
                pg8::Gemm g{(const bf16*)(ws + WS_R8), (const bf16*)(ws + WS_W13 + (size_t)f * NUP * D), M, NUP, D / 2}; pg8::StaticOrder S; S.init(M, NUP, G, bid);
                pg8::EpiUp E{f, t & 1};
                if (PROBE_DUP & 2048) { S.r1 = 5; pg8::gemm_phase<pg8::EpiUp, pg8::StaticOrder, true, PG8_SP2, true>(lds + RING_OFF, g, S, E, w0); GRID_BAR(); S.r0 = 5; S.r1 = 1 << 20; }
                pg8::gemm_phase<pg8::EpiUp, pg8::StaticOrder, true, PG8_SP2, true>(lds + RING_OFF, g, S, E, w0);
                if (PROBE_DUP & 16) pg8::gemm_phase<pg8::EpiUp, pg8::StaticOrder, true, PG8_SP2, true>(lds + RING_OFF, g, S, E, w0);
                if (PROBE_DUP & 128) { pg8::EpiNull EN{(float*)(ws + WS_GATES)}; pg8::gemm_phase<pg8::EpiNull, pg8::StaticOrder, true, PG8_SP2, true>(lds + RING_OFF, g, S, EN, w0); }
            } else {
                if (kind == 2) {
                    pg8::Gemm g{R, (const bf16*)(ws + WS_WIN) + (size_t)j * NMI * D, M, NMI, D}; pg8::StaticOrder S; S.init(M, NMI, G, bid);
                    pg8::EpiLnOut E{1, j, t & 1};
                    pg8::gemm_phase<pg8::EpiLnOut, pg8::StaticOrder, true, PG8_SP2>(lds + RING_OFF, g, S, E, w0);
                    if (PROBE_DUP & 32) pg8::gemm_phase<pg8::EpiLnOut, pg8::StaticOrder, true, PG8_SP2>(lds + RING_OFF, g, S, E, w0);
                }
                if (kind == 1) {
                    const int N = kind == 1 ? NQKV : 2048;
                    pg8::Gemm g{(const bf16*)(ws + WS_R8), (const bf16*)(kind == 1 ? ws + WS_WQKV + (size_t)j * NQKV * D : ws + WS_WIN + 32 * MiB + (size_t)j * 2048 * D), M, N, D / 2}; pg8::StaticOrder S; S.init(M, N, G, bid);
                    pg8::EpiLnOut E{kind == 1 ? 0 : 2, j, t & 1};
                    pg8::gemm_phase<pg8::EpiLnOut, pg8::StaticOrder, true, PG8_SP2, true>(lds + RING_OFF, g, S, E, w0);
                    if (PROBE_DUP & 32) pg8::gemm_phase<pg8::EpiLnOut, pg8::StaticOrder, true, PG8_SP2, true>(lds + RING_OFF, g, S, E, w0);
                }
                if (kind == 2) {
                    gates_phase(lds, R, sp_in, (const bf16*)(vec + V_WG / 4) + (size_t)j * 8 * D, vec + V_CG / 4 + j * 16, (float*)(ws + WS_GATES), G, bid, w0);
                    if (PROBE_DUP & 8) { WG_BAR(); gates_phase(lds, R, sp_in, (const bf16*)(vec + V_WG / 4) + (size_t)j * 8 * D, vec + V_CG / 4 + j * 16, (float*)(ws + WS_GATES), G, bid, w0); }
                }
            }
        }
        GRID_BAR();
        if (kind == 1) {
            if (!SKIP_ATT) { kargs_t ka = kargs(); unsigned char* ws = ka->ws; attn_phase(lds_raw, (const bf16*)(ws + WS_QKV), ws + WS_AO, ka->sinks + j * 32, G, bid, w0);
                if (PROBE_DUP & 2) attn_phase(lds_raw, (const bf16*)(ws + WS_QKV), ws + WS_AO, ka->sinks + j * 32, G, bid, w0); }
            GRID_BAR();
        } else if (kind == 2) {
            if (!SKIP_MLSTM) { unsigned char* ws = kargs()->ws; mlstm_phase(lds_raw, (const bf16*)(ws + WS_MP), (const float*)(ws + WS_GATES), (bf16*)(ws + WS_HG), G, bid, w0);
                if (PROBE_DUP & 4) mlstm_phase<PROBE_MLV>(lds_raw, (const bf16*)(ws + WS_MP), (const float*)(ws + WS_GATES), (bf16*)(ws + WS_H), G, bid, w0); }
            GRID_BAR();
        }
        {
            kargs_t ka = kargs(); unsigned char* ws = ka->ws;
            float coef = kind == 0 ? 0.5f / (pg8::F8_SH * pg8::F8_SW) : (kind == 1 ? 1.f / (pg8::F8_SO * pg8::F8_SW) : 1.f);
            if ((kind == 1 && SKIP_ATT) || (kind == 2 && SKIP_MLSTM)) coef = 0.f;
            pg8::StaticOrder S; S.init(M, D, G, bid);
            pg8::EpiRes E{t, coef, (LAS float*)(lds + TAB_OFF), w0, 0};
            if (kind != 2) {
                const int f = 2 * layer + (sub >> 1);
                pg8::Gemm g{(const bf16*)(ws + (kind == 0 ? WS_H : WS_AO)), (const bf16*)(kind == 0 ? ws + WS_W2 + (size_t)f * D * FF : ws + WS_WO + (size_t)j * D * D), M, D, kind == 0 ? FF / 2 : D / 2};
                if (PROBE_DUP & 64) { pg8::EpiNull EN{(float*)(ws + WS_GATES)}; pg8::gemm_phase<pg8::EpiNull, pg8::StaticOrder, true, PG8_SP2, true>(lds + RING_OFF, g, S, EN, w0); }
                if (PROBE_DUP & 512) { pg8::EpiRes ED{t, coef, (LAS float*)(lds + TAB_OFF), w0, 1}; pg8::gemm_phase<pg8::EpiRes, pg8::StaticOrder, true, PG8_SP2, true>(lds + RING_OFF, g, S, ED, w0); }
                pg8::gemm_phase<pg8::EpiRes, pg8::StaticOrder, true, PG8_SP2, true>(lds + RING_OFF, g, S, E, w0);
            } else {
                pg8::Gemm g{(const bf16*)(ws + WS_HG), (const bf16*)(ws + WS_WMO) + (size_t)j * D * D, M, D, D};
                if (PROBE_DUP & 256) { pg8::EpiNull EN{(float*)(ws + WS_GATES)}; pg8::gemm_phase<pg8::EpiNull, pg8::StaticOrder, true, PG8_SP2, false>(lds + RING_OFF, g, S, EN, w0); }
                pg8::gemm_phase<pg8::EpiRes, pg8::StaticOrder, true, PG8_SP2, false>(lds + RING_OFF, g, S, E, w0);
            }
        }
        GRID_BAR();
    }
    {
        kargs_t ka = kargs(); unsigned char* ws = ka->ws;
        const int vcu = (G % 8 == 0) ? (bid % 8) * (G / 8) + bid / 8 : bid;
        final_ln((const bf16*)(ws + WS_R), (const float*)(ws + WS_SP), ka->ln_g + (size_t)(3 * DEPTH - 1) * D, ka->ln_b + (size_t)(3 * DEPTH - 1) * D, ka->out, vcu * NWAVES + w0, G * NWAVES, pg8::pg8_lane());
    }
}

extern "C" void kernel_launch(void* const* d_in, const int* in_sizes, int n_in, void* d_out, int out_size, void* d_ws, size_t ws_size, hipStream_t stream) {
    static int grid = 0;
    if (grid == 0) {
        if (n_in != 12 || in_sizes[0] != M * D || out_size != M * D || ws_size < WS_END) { fprintf(stderr, "kernel_launch: unexpected shapes / workspace (n_in %d, ws %zu < %zu); nothing launched\n", n_in, ws_size, (size_t)WS_END); grid = -1; return; }
        int dev = 0, cus = 0;
        if (hipGetDevice(&dev) != hipSuccess || hipDeviceGetAttribute(&cus, hipDeviceAttributeMultiprocessorCount, dev) != hipSuccess) { grid = -1; return; }
        if (hipFuncSetAttribute((const void*)fwd_kernel, hipFuncAttributeMaxDynamicSharedMemorySize, LDS_BYTES) != hipSuccess) { fprintf(stderr, "kernel_launch: hipFuncSetAttribute failed\n"); grid = -1; return; }
        int per_cu = 0;
        if (hipOccupancyMaxActiveBlocksPerMultiprocessor(&per_cu, (const void*)fwd_kernel, NWAVES * 64, LDS_BYTES) != hipSuccess || per_cu < 1) { fprintf(stderr, "kernel_launch: occupancy query says %d\n", per_cu); }
        (void)hipGetLastError();
        grid = cus;
    }
    if (grid < 0) return;
    (void)hipMemsetAsync((char*)d_ws + WS_CTL, 0, CTL_ZERO_BYTES, stream);
    Args a{};
    a.x = (const float*)d_in[0]; a.w1 = (const float*)d_in[1]; a.w3 = (const float*)d_in[2]; a.w2 = (const float*)d_in[3]; a.ln_g = (const float*)d_in[4]; a.ln_b = (const float*)d_in[5];
    a.wqkv = (const float*)d_in[6]; a.sinks = (const float*)d_in[7]; a.wo = (const float*)d_in[8]; a.win = (const float*)d_in[9]; a.bg = (const float*)d_in[10]; a.wmo = (const float*)d_in[11];
    a.out = (float*)d_out; a.ws = (unsigned char*)d_ws;
    hipLaunchKernelGGL(fwd_kernel, dim3(grid), dim3(NWAVES * 64), LDS_BYTES, stream, a);
}
```

```cpp
#include <hip/hip_runtime.h>
#include <hip/hip_bf16.h>
#include <cstdio>
#include <cstdint>
#include <cmath>

constexpr int BATCH = 8, SEQ = 2048, D = 2048, FF = 5632, DEPTH = 4;
constexpr int M = BATCH * SEQ;
constexpr int NUP = 2 * FF;
constexpr int NQKV = 2560;
constexpr int NMI = 6144, NMIW = 6152;
constexpr float LN_EPS = 1e-5f;
constexpr float ALPHA = 1.681792830507429f;
constexpr float LOG2E = 1.4426950408889634f;

constexpr size_t MiB = 1u << 20;
constexpr size_t WS_CTL = 0, CTL_ZERO_BYTES = 192 * 1024;
constexpr size_t WS_W13 = 2 * MiB;
constexpr size_t WS_W2 = 178 * MiB;
constexpr size_t WS_WQKV = 266 * MiB;
constexpr size_t WS_WO = 286 * MiB;
constexpr size_t WS_WIN = 302 * MiB;
constexpr size_t WS_WMO = 350 * MiB;
constexpr size_t WS_VEC = 366 * MiB;
constexpr size_t V_C1U = 0, V_C2U = 360448, V_C1Q = 720896, V_C2Q = 741376, V_C1I = 761856, V_C2I = 811008, V_CG = 860160, V_WG = 860416, V_ONES = 991488, V_ZEROS = 999680;
constexpr size_t WS_R = 368 * MiB;
constexpr size_t WS_R8 = 432 * MiB;
constexpr size_t WS_SP = 464 * MiB;
constexpr size_t SP_BYTES = (size_t)M * 16 * 4;
constexpr size_t WS_H = 466 * MiB;
constexpr size_t WS_QKV = 554 * MiB;
constexpr size_t WS_AO = 634 * MiB;
constexpr size_t WS_MP = 698 * MiB;
constexpr size_t WS_GATES = 890 * MiB;
constexpr size_t WS_HG = 891 * MiB;
constexpr size_t WS_END = 955 * MiB;
constexpr int CW_TMO = 0, CW_BAR = 4096;

struct Args { const float* x; const float* w1; const float* w3; const float* w2; const float* ln_g; const float* ln_b; const float* wqkv; const float* sinks; const float* wo;
              const float* win; const float* bg; const float* wmo; float* out; unsigned char* ws; };
typedef const __attribute__((address_space(4))) Args* kargs_t;
__device__ __forceinline__ kargs_t kargs() { kargs_t p = (kargs_t)__builtin_amdgcn_kernarg_segment_ptr(); asm volatile("" : "+s"(p)); return p; }

namespace pg8 {
#define PG8_LAS __attribute__((address_space(3)))
typedef unsigned short bf16_t;
typedef short bf16x8 __attribute__((ext_vector_type(8)));
typedef _Float16 f16x8 __attribute__((ext_vector_type(8)));
typedef float f32x4 __attribute__((ext_vector_type(4)));
typedef unsigned u32x4 __attribute__((ext_vector_type(4)));
constexpr int BM = 256, BK = 64, HALF = 128, HTB = HALF * BK * 2  , STAGE_BYTES = 8 * HTB, NXCD = 8, WGM = 8;

__host__ __device__ __forceinline__ int lds_byte(int r, int c) { const int st = (r >> 4) * 2 + (c >> 5), rr = r & 15, cc = c & 31, ob = rr * 64 + cc * 2; return st * 1024 + (ob ^ (((ob >> 9) & 1) << 5)); }
__host__ __device__ __forceinline__ void stage_rc(int b, int& R, int& C) { const int st = b / 1024, sb = b % 1024, swz = sb ^ (((sb >> 9) & 1) << 5); R = (st >> 1) * 16 + swz / 64; C = (st & 1) * 32 + (swz % 64) / 2; }
__host__ __device__ __forceinline__ int perm32(int rho) { const int n = rho >> 4, i = rho & 15; return 8 * (i >> 2) + 4 * n + (i & 3); }

typedef int i32x4 __attribute__((ext_vector_type(4)));
typedef int i32x8 __attribute__((ext_vector_type(8)));
constexpr float F8_SR = 8.f, F8_SW = 1024.f, F8_SH = 16.f, F8_SO = 64.f;
__device__ __forceinline__ i32x8 cat_i8(bf16x8 lo, bf16x8 hi) { const i32x4 a = __builtin_bit_cast(i32x4, lo), b = __builtin_bit_cast(i32x4, hi); return __builtin_shufflevector(a, b, 0, 1, 2, 3, 4, 5, 6, 7); }
__device__ __forceinline__ void mfma_f8_inplace(f32x4& c, const i32x8 a, const i32x8 b) { asm volatile("v_mfma_f32_16x16x128_f8f6f4 %0, %1, %2, %0 cbsz:0 blgp:0" : "+v"(c) : "v"(a), "v"(b)); }
typedef unsigned u32x2 __attribute__((ext_vector_type(2)));
__device__ __forceinline__ u32x2 cvt8_f8(const float (&v)[8], float s) {
    int a, b; asm volatile("" : "=v"(a), "=v"(b));
    a = __builtin_amdgcn_cvt_pk_fp8_f32(v[0] * s, v[1] * s, a, false); a = __builtin_amdgcn_cvt_pk_fp8_f32(v[2] * s, v[3] * s, a, true);
    b = __builtin_amdgcn_cvt_pk_fp8_f32(v[4] * s, v[5] * s, b, false); b = __builtin_amdgcn_cvt_pk_fp8_f32(v[6] * s, v[7] * s, b, true);
    return (u32x2){(unsigned)a, (unsigned)b};
}
__device__ __forceinline__ int pg8_lane() { int l; asm volatile("v_mbcnt_lo_u32_b32 %0, -1, 0\n\tv_mbcnt_hi_u32_b32 %0, -1, %0" : "=v"(l)); return l; }
struct Unit { int pm, pn; };
struct Gemm { const bf16_t* A; const bf16_t* Bt; int M, N, K; };

struct StaticOrder {
    int nM, nN, nwg, G, c, r0 = 0, r1 = 1 << 20;
    __host__ __device__ void init(int M_, int N_, int G_, int c_) { nM = M_ / BM; nN = N_ / BM; nwg = nM * nN; G = G_; c = c_; }
    __host__ __device__ bool next(int i, Unit& u) const {
        i += r0; if (i >= r1) return false;
        const long L = (long)i * G + c; if (L >= nwg) return false;
        int wgid = (int)L; { const int q = nwg / NXCD, r = nwg % NXCD, xcd = wgid % NXCD, off = wgid / NXCD; wgid = (xcd < r ? xcd * (q + 1) : r * (q + 1) + (xcd - r) * q) + off; }
        const int nig = WGM * nN, gid = wgid / nig, fm = gid * WGM, gsz = (nM - fm) < WGM ? (nM - fm) : WGM;
        u.pm = fm + ((wgid % nig) % gsz); u.pn = (wgid % nig) / gsz; return true;
    }
    __device__ __forceinline__ void a_ready(const Unit&) const {}
    __device__ __forceinline__ void done(const Unit&) const {}
};

__device__ __forceinline__ unsigned cvt_pk_bf16(float lo, float hi) { typedef float f2 __attribute__((ext_vector_type(2))); typedef _Float16 b2 __attribute__((ext_vector_type(2))); f2 v = {lo, hi}; b2 b = __builtin_convertvector(v, b2); return __builtin_bit_cast(unsigned, b); }
__device__ __forceinline__ float bf_lo(unsigned w) { typedef _Float16 b2 __attribute__((ext_vector_type(2))); return (float)__builtin_bit_cast(b2, w)[0]; }
__device__ __forceinline__ float bf_hi(unsigned w) { typedef _Float16 b2 __attribute__((ext_vector_type(2))); return (float)__builtin_bit_cast(b2, w)[1]; }
__device__ __forceinline__ float fsigmoid(float x) { return __builtin_amdgcn_rcpf(1.f + __builtin_amdgcn_exp2f(-LOG2E * x)); }

__device__ __forceinline__ float sum_fq(float v) {
    auto a = __builtin_amdgcn_permlane16_swap(__float_as_uint(v), __float_as_uint(v), false, false); v = __uint_as_float(a[0]) + __uint_as_float(a[1]);
    auto b = __builtin_amdgcn_permlane32_swap(__float_as_uint(v), __float_as_uint(v), false, false); return __uint_as_float(b[0]) + __uint_as_float(b[1]);
}
__device__ __forceinline__ void row_stats(const float* sp, int row0, int fq, float (&mu)[2][4], float (&rs)[2][4]) {
#pragma unroll
    for (int ai = 0; ai < 2; ++ai)
#pragma unroll
        for (int m = 0; m < 4; ++m) {
            const f32x4 v = *(const f32x4*)(sp + (size_t)(row0 + ai * HALF + m * 16) * 16 + fq * 4);
            float s = v[0] + v[2], q = v[1] + v[3];
            s = sum_fq(s); q = sum_fq(q);
            const float mean = s * (1.f / D), var = q * (1.f / D) - mean * mean;
            mu[ai][m] = mean; rs[ai][m] = __builtin_amdgcn_rsqf(var + LN_EPS);
        }
}

struct EpiNull {
    static constexpr bool PERM = true, AFTER_DRAIN = false;
    float* sink;
    __device__ __forceinline__ void operator()(const f32x4 (&acc)[2][2][4][2], const Unit& u, int wr, int wc, int, int) const {
        float s = 0.f;
#pragma unroll
        for (int ai = 0; ai < 2; ++ai)
#pragma unroll
            for (int bj = 0; bj < 2; ++bj)
#pragma unroll
                for (int m = 0; m < 4; ++m)
#pragma unroll
                    for (int n = 0; n < 2; ++n) s += acc[ai][bj][m][n][0] + acc[ai][bj][m][n][1] + acc[ai][bj][m][n][2] + acc[ai][bj][m][n][3];
        if (s == 123.456f) sink[u.pm + wr + wc] = s;
    }
};

struct EpiUp {
    static constexpr bool PERM = true, AFTER_DRAIN = false;
    int f, tpar;
    __device__ __forceinline__ void operator()(const f32x4 (&acc)[2][2][4][2], const Unit& u, int wr, int wc, int, int) const {
        const int lane_ = pg8_lane(), fr = lane_ & 15, fq = lane_ >> 4;
        const int row0 = u.pm * BM + wr * 64 + fr;
        int f = this->f, tpar = this->tpar; asm volatile("" : "+s"(f), "+s"(tpar));
        unsigned char* ws = kargs()->ws; unsigned char* H = ws + WS_H;
        const float* c1 = (const float*)(ws + WS_VEC + V_C1U) + (size_t)f * NUP; const float* c2 = (const float*)(ws + WS_VEC + V_C2U) + (size_t)f * NUP; const float* sp = (const float*)(ws + WS_SP) + (size_t)tpar * (SP_BYTES / 4);
        float mu[2][4], rs[2][4]; row_stats(sp, row0, fq, mu, rs);
        const int cb = u.pn * BM + wc * 32 + 8 * fq;
        f32x4 k1[2][2], k2[2][2];
#pragma unroll
        for (int bj = 0; bj < 2; ++bj)
#pragma unroll
            for (int n = 0; n < 2; ++n) { k1[bj][n] = *(const f32x4*)(c1 + cb + bj * HALF + 4 * n); k2[bj][n] = *(const f32x4*)(c2 + cb + bj * HALF + 4 * n); }
        unsigned char* hp = H + (size_t)row0 * FF + u.pn * HALF + wc * 32 + 8 * fq;
#pragma unroll
        for (int ai = 0; ai < 2; ++ai)
#pragma unroll
            for (int m = 0; m < 4; ++m) {
                const float r_ = rs[ai][m], nm = -mu[ai][m] * r_, ra = r_ * (1.f / (F8_SR * F8_SW));
                float hv[8];
#pragma unroll
                for (int n = 0; n < 2; ++n)
#pragma unroll
                    for (int j = 0; j < 4; ++j) {
                        const float ga = acc[ai][0][m][n][j] * ra + (nm * k1[0][n][j] + k2[0][n][j]);
                        const float ub = acc[ai][1][m][n][j] * ra + (nm * k1[1][n][j] + k2[1][n][j]);
                        hv[4 * n + j] = ga * fsigmoid(ga) * ub;
                    }
                *(u32x2*)(hp + (size_t)(ai * HALF + m * 16) * FF) = cvt8_f8(hv, F8_SH);
            }
    }
};

struct EpiLnOut {
    static constexpr bool PERM = true, AFTER_DRAIN = false;
    int mode, j, tpar;
    __device__ __forceinline__ void operator()(const f32x4 (&acc)[2][2][4][2], const Unit& u, int wr, int wc, int, int) const {
        const int lane_ = pg8_lane(), fr = lane_ & 15, fq = lane_ >> 4;
        const int row0 = u.pm * BM + wr * 64 + fr;
        int mode = this->mode, j = this->j, tpar = this->tpar; asm volatile("" : "+s"(mode), "+s"(j), "+s"(tpar));
        const bool att = mode == 0; const int coff = mode == 2 ? 4096 : 0;
        unsigned char* ws = kargs()->ws; bf16_t* O = (bf16_t*)(ws + (att ? WS_QKV : WS_MP)) + coff; const int ldo = att ? NQKV : NMI, sig_from = mode == 2 ? 0 : (mode == 1 ? 16 : 1000);
        const float ascale = mode == 1 ? 1.f : 1.f / (F8_SR * F8_SW);
        const float* c1 = (const float*)(ws + WS_VEC + (att ? V_C1Q : V_C1I)) + j * ldo + coff; const float* c2 = (const float*)(ws + WS_VEC + (att ? V_C2Q : V_C2I)) + j * ldo + coff; const float* sp = (const float*)(ws + WS_SP) + (size_t)tpar * (SP_BYTES / 4);
        float mu[2][4], rs[2][4]; row_stats(sp, row0, fq, mu, rs);
        const int cb = u.pn * BM + wc * 32 + 8 * fq;
        const bool sg = u.pn >= sig_from;
        f32x4 k1[2][2], k2[2][2];
#pragma unroll
        for (int bj = 0; bj < 2; ++bj)
#pragma unroll
            for (int n = 0; n < 2; ++n) { k1[bj][n] = *(const f32x4*)(c1 + cb + bj * HALF + 4 * n); k2[bj][n] = *(const f32x4*)(c2 + cb + bj * HALF + 4 * n); }
        bf16_t* op = O + (size_t)row0 * ldo + cb;
#pragma unroll
        for (int ai = 0; ai < 2; ++ai)
#pragma unroll
            for (int m = 0; m < 4; ++m) {
                const float r_ = rs[ai][m], nm = -mu[ai][m] * r_, ra = r_ * ascale;
#pragma unroll
                for (int bj = 0; bj < 2; ++bj) {
                    float v[8];
#pragma unroll
                    for (int n = 0; n < 2; ++n)
#pragma unroll
                        for (int j = 0; j < 4; ++j) { float t = acc[ai][bj][m][n][j] * ra + (nm * k1[bj][n][j] + k2[bj][n][j]); if (sg) t = fsigmoid(t); v[4 * n + j] = t; }
                    u32x4 w; w.x = cvt_pk_bf16(v[0], v[1]); w.y = cvt_pk_bf16(v[2], v[3]); w.z = cvt_pk_bf16(v[4], v[5]); w.w = cvt_pk_bf16(v[6], v[7]);
                    *(u32x4*)(op + (size_t)(ai * HALF + m * 16) * ldo + bj * HALF) = w;
                }
            }
    }
};

struct EpiRes {
    static constexpr bool PERM = true, AFTER_DRAIN = false;
    int t; float coef; PG8_LAS float* tab; int wave; int dry;
    __device__ __forceinline__ void operator()(const f32x4 (&acc)[2][2][4][2], const Unit& u, int wr, int wc, int, int) const {
        const int lane_ = pg8_lane(), fr = lane_ & 15, fq = lane_ >> 4;
        typedef float f32x2v __attribute__((ext_vector_type(2)));
        const int row0 = u.pm * BM + wr * 64 + fr;
        int t = this->t; asm volatile("" : "+s"(t));
        const bool need8 = (t != 3 && t != 9 && t != 11) || dry;
        kargs_t ka = kargs(); unsigned char* ws = ka->ws; bf16_t* R = (bf16_t*)(ws + WS_R); unsigned char* R8 = ws + (dry ? WS_MP + 64 * MiB : WS_R8); bf16_t* Ro = dry ? (bf16_t*)(ws + WS_MP) : R;
        const float* g = t ? ka->ln_g + (size_t)(t - 1) * D : (const float*)(ws + WS_VEC + V_ONES); const float* b = t ? ka->ln_b + (size_t)(t - 1) * D : (const float*)(ws + WS_VEC + V_ZEROS);
        const float* sp_in = (const float*)(ws + WS_SP) + (size_t)(t & 1) * (SP_BYTES / 4); float* sp_out = dry ? (float*)(ws + WS_MP + 96 * MiB) : (float*)(ws + WS_SP) + (size_t)((t + 1) & 1) * (SP_BYTES / 4);
        const int cb0 = u.pn * BM + wc * 32 + 8 * fq;
        u32x4 cur[4];
#pragma unroll
        for (int m = 0; m < 4; ++m) cur[m] = *(const u32x4*)(R + (size_t)(row0 + m * 16) * D + cb0);
        float mu[2][4], rs[2][4]; row_stats(sp_in, row0, fq, mu, rs);
        f32x4 gv[2], bv[2];
#pragma unroll
        for (int k = 0; k < 4; ++k) {
            const int bj = k >> 1, ai = k & 1, cb = cb0 + bj * HALF;
            if (ai == 0) {
#pragma unroll
                for (int n = 0; n < 2; ++n) { gv[n] = *(const f32x4*)(g + cb + 4 * n); bv[n] = *(const f32x4*)(b + cb + 4 * n) * ALPHA; }
            }
#pragma unroll
            for (int m = 0; m < 4; ++m) {
                const float A_ = ALPHA * rs[ai][m], B_ = -mu[ai][m] * A_;
                const size_t off = (size_t)(row0 + ai * HALF + m * 16) * D + cb;
                const u32x4 o = cur[m];
                if (k < 3 && dry != 3) cur[m] = *(const u32x4*)(R + (size_t)(row0 + ((k + 1) & 1) * HALF + m * 16) * D + cb0 + ((k + 1) >> 1) * HALF);
                const float ro[8] = {bf_lo(o.x), bf_hi(o.x), bf_lo(o.y), bf_hi(o.y), bf_lo(o.z), bf_hi(o.z), bf_lo(o.w), bf_hi(o.w)};
                float nv[8];
#pragma unroll
                for (int n = 0; n < 2; ++n)
#pragma unroll
                    for (int j = 0; j < 4; ++j) nv[4 * n + j] = (ro[4 * n + j] * A_ + B_) * gv[n][j] + bv[n][j] + coef * acc[ai][bj][m][n][j];
                u32x4 w; w.x = cvt_pk_bf16(nv[0], nv[1]); w.y = cvt_pk_bf16(nv[2], nv[3]); w.z = cvt_pk_bf16(nv[4], nv[5]); w.w = cvt_pk_bf16(nv[6], nv[7]);
                if (dry != 2) { *(u32x4*)(Ro + off) = w;
                if (need8) *(u32x2*)(R8 + off) = cvt8_f8(nv, F8_SR); }
                const float f0 = bf_lo(w.x), f1 = bf_hi(w.x), f2 = bf_lo(w.y), f3 = bf_hi(w.y), f4 = bf_lo(w.z), f5 = bf_hi(w.z), f6 = bf_lo(w.w), f7 = bf_hi(w.w);
                float s = ((f0 + f1) + (f2 + f3)) + ((f4 + f5) + (f6 + f7));
                float q = ((f0 * f0 + f1 * f1) + (f2 * f2 + f3 * f3)) + ((f4 * f4 + f5 * f5) + (f6 * f6 + f7 * f7));
                s = sum_fq(s); q = sum_fq(q);
                if (fq == 0) *(PG8_LAS f32x2v*)(tab + (((ai * HALF + wr * 64 + m * 16 + fr) * 4 + wc) * 2 + bj) * 2) = (f32x2v){s, q};
                asm volatile("" ::: "memory");
            }
        }
        asm volatile("s_waitcnt lgkmcnt(0)" ::: "memory"); __builtin_amdgcn_s_barrier(); asm volatile("" ::: "memory");
        const int tid = wave * 64 + pg8_lane();
        if (tid < BM) {
            const PG8_LAS f32x4* t4 = (const PG8_LAS f32x4*)(tab + tid * 16);
            const f32x4 a = t4[0], c = t4[1], d = t4[2], e = t4[3];
            *(f32x2v*)(sp_out + (size_t)(u.pm * BM + tid) * 16 + u.pn * 2) = (f32x2v){((a[0] + a[2]) + (c[0] + c[2])) + ((d[0] + d[2]) + (e[0] + e[2])), ((a[1] + a[3]) + (c[1] + c[3])) + ((d[1] + d[3]) + (e[1] + e[3]))};
        }
    }
};

template <class Epi, class Sched, bool ALIGN_EPI = false, bool SP2 = false, bool F8 = false>
__device__ __forceinline__ void gemm_phase(PG8_LAS unsigned char* lds, const Gemm g, const Sched& S, const Epi& E, int wave_in) {
    int wid = wave_in; asm volatile("" : "+s"(wid));
    const int lane = pg8_lane(), tid = wid * 64 + lane, wr = wid >> 2, wc = wid & 3, fr = lane & 15, fq = lane >> 4;
    const int K = g.K, nt = K / BK;
    unsigned voffA[2], voffB[2];
#pragma unroll
    for (int i = 0; i < 2; ++i) { int R, C; stage_rc(tid * 16 + i * 8192, R, C); const int Rb = Epi::PERM ? ((R & ~31) + perm32(R & 31)) : R;
        voffA[i] = (unsigned)(R * K + C) * 2u; voffB[i] = (unsigned)(Rb * K + C) * 2u; }
    const size_t kstep = (size_t)(BK * 2);
    const size_t hstep = (size_t)HALF * K * 2;
    const size_t tstep = 2 * hstep;
    const unsigned ldsw = (unsigned)wid * 1024u;
    const int aoff = lds_byte(wr * 64 + fr, fq * 8), boff = lds_byte(wc * 32 + fr, fq * 8);
#define PG8_SA(b, h) (((b) * 2 + (h)) * HTB)
#define PG8_SB(b, h) ((4 + (b) * 2 + (h)) * HTB)
#define PG8_STAGE(bufoff, gbase, voff) do { _Pragma("unroll") for (int _i = 0; _i < 2; ++_i) \
        __builtin_amdgcn_global_load_lds((const unsigned*)((const char*)(gbase) + (voff)[_i]), (PG8_LAS unsigned*)(lds + (bufoff) + ldsw + _i * 8192), 16, 0, 0); } while (0)
#define PG8_LDA(dst, b, h) do { _Pragma("unroll") for (int m = 0; m < 4; ++m) _Pragma("unroll") for (int k = 0; k < 2; ++k) dst[m][k] = *(const PG8_LAS bf16x8*)(lds + PG8_SA(b, h) + aoff + m * 2048 + k * 1024); } while (0)
#define PG8_LDB(dst, b, h) do { _Pragma("unroll") for (int n = 0; n < 2; ++n) _Pragma("unroll") for (int k = 0; k < 2; ++k) dst[n][k] = *(const PG8_LAS bf16x8*)(lds + PG8_SB(b, h) + boff + n * 2048 + k * 1024); } while (0)
#define PG8_MMA(ai, bj, At, Bt) do { __builtin_amdgcn_s_setprio(1); _Pragma("unroll") for (int m = 0; m < 4; ++m) _Pragma("unroll") for (int n = 0; n < 2; ++n) { \
        if constexpr (F8) mfma_f8_inplace(acc[ai][bj][m][n], cat_i8(Bt[n][0], Bt[n][1]), cat_i8(At[m][0], At[m][1])); \
        else { _Pragma("unroll") for (int k = 0; k < 2; ++k) acc[ai][bj][m][n] = __builtin_amdgcn_mfma_f32_16x16x32_f16(__builtin_bit_cast(f16x8, Bt[n][k]), __builtin_bit_cast(f16x8, At[m][k]), acc[ai][bj][m][n], 0, 0, 0); } } \
        __builtin_amdgcn_s_setprio(0); } while (0)
#define PG8_WAIT_V(n) asm volatile("s_waitcnt vmcnt(" #n ")" ::: "memory")
#define PG8_WAIT_L(n) asm volatile("s_waitcnt lgkmcnt(" #n ")" ::: "memory")
#define PG8_BAR __builtin_amdgcn_s_barrier()
#define PG8_SCHED __builtin_amdgcn_sched_barrier(0)
    Unit cur, nxt; int ui = 0;
    if (!S.next(0, cur)) return;
    f32x4 acc[2][2][4][2];
#pragma unroll
    for (int a = 0; a < 2; ++a)
#pragma unroll
        for (int b = 0; b < 2; ++b)
#pragma unroll
            for (int m = 0; m < 4; ++m)
#pragma unroll
                for (int n = 0; n < 2; ++n) { float z0, z1, z2, z3; asm volatile("v_mov_b32 %0, 0\n\tv_mov_b32 %1, 0\n\tv_mov_b32 %2, 0\n\tv_mov_b32 %3, 0" : "=v"(z0), "=v"(z1), "=v"(z2), "=v"(z3)); acc[a][b][m][n] = (f32x4){z0, z1, z2, z3}; }
    bf16x8 At[4][2], B0[2][2], B1[2][2];
    const char* cA = (const char*)g.A + (size_t)cur.pm * tstep; const char* cB = (const char*)g.Bt + (size_t)cur.pn * tstep;
    S.a_ready(cur);
    if constexpr (SP2) {
        PG8_STAGE(PG8_SB(0, 0), cB, voffB); PG8_STAGE(PG8_SB(0, 1), cB + hstep, voffB); PG8_STAGE(PG8_SA(0, 0), cA, voffA); PG8_STAGE(PG8_SA(0, 1), cA + hstep, voffA);
        if (wr == 1) PG8_BAR;
        PG8_WAIT_V(2); PG8_BAR;
        PG8_STAGE(PG8_SB(1, 0), cB + kstep, voffB); PG8_STAGE(PG8_SA(1, 0), cA + kstep, voffA); PG8_STAGE(PG8_SB(1, 1), cB + hstep + kstep, voffB);
        PG8_WAIT_V(6); PG8_BAR;
    } else {
        PG8_STAGE(PG8_SB(0, 0), cB, voffB); PG8_STAGE(PG8_SA(0, 0), cA, voffA); PG8_STAGE(PG8_SB(0, 1), cB + hstep, voffB); PG8_STAGE(PG8_SA(0, 1), cA + hstep, voffA);
        if (wr == 1) PG8_BAR;
        PG8_WAIT_V(4); PG8_BAR;
        PG8_STAGE(PG8_SB(1, 0), cB + kstep, voffB); PG8_STAGE(PG8_SA(1, 0), cA + kstep, voffA); PG8_STAGE(PG8_SB(1, 1), cB + hstep + kstep, voffB);
        PG8_WAIT_V(6); PG8_BAR;
    }
    for (;;) {
        const bool has_next = S.next(ui + 1, nxt);
        const char* nA = has_next ? (const char*)g.A + (size_t)nxt.pm * tstep : cA; const char* nB = has_next ? (const char*)g.Bt + (size_t)nxt.pn * tstep : cB;
        for (int t = 0; t < nt; t += 2) {
            const bool last = (t == nt - 2);
            const char* a1 = cA + (size_t)(t + 1) * kstep;
            const char* a2 = last ? nA : cA + (size_t)(t + 2) * kstep; const char* b2 = last ? nB : cB + (size_t)(t + 2) * kstep;
            const char* a3 = a2 + kstep; const char* b3 = b2 + kstep;
            if (last && has_next) S.a_ready(nxt);
            if constexpr (SP2) {
            PG8_LDB(B0, 0, 0); PG8_LDB(B1, 0, 1); PG8_SCHED; PG8_LDA(At, 0, 0); PG8_STAGE(PG8_SA(1, 1), a1 + hstep, voffA);
            PG8_WAIT_V(8); PG8_WAIT_L(0); PG8_BAR; PG8_MMA(0, 0, At, B0); PG8_MMA(0, 1, At, B1); PG8_BAR; PG8_SCHED;
            PG8_LDA(At, 0, 1); PG8_STAGE(PG8_SB(0, 0), b2, voffB); PG8_STAGE(PG8_SB(0, 1), b2 + hstep, voffB); PG8_STAGE(PG8_SA(0, 0), a2, voffA);
            PG8_WAIT_V(8); PG8_WAIT_L(0); PG8_BAR; PG8_MMA(1, 0, At, B0); PG8_MMA(1, 1, At, B1); PG8_BAR; PG8_SCHED;
            PG8_LDB(B0, 1, 0); PG8_LDB(B1, 1, 1); PG8_SCHED; PG8_LDA(At, 1, 0); PG8_STAGE(PG8_SA(0, 1), a2 + hstep, voffA);
            PG8_WAIT_V(8); PG8_WAIT_L(0); PG8_BAR; PG8_MMA(0, 0, At, B0); PG8_MMA(0, 1, At, B1); PG8_BAR; PG8_SCHED;
            PG8_LDA(At, 1, 1); PG8_STAGE(PG8_SB(1, 0), b3, voffB); PG8_STAGE(PG8_SB(1, 1), b3 + hstep, voffB); PG8_STAGE(PG8_SA(1, 0), a3, voffA);
            PG8_WAIT_V(8); PG8_WAIT_L(0); PG8_BAR; PG8_MMA(1, 0, At, B0); PG8_MMA(1, 1, At, B1); PG8_BAR; PG8_SCHED;
            } else {
            PG8_LDB(B0, 0, 0); PG8_SCHED; PG8_LDA(At, 0, 0); PG8_STAGE(PG8_SA(1, 1), a1 + hstep, voffA);
            PG8_WAIT_L(8); PG8_BAR; PG8_WAIT_L(0); PG8_MMA(0, 0, At, B0); PG8_BAR; PG8_SCHED;
            PG8_LDB(B1, 0, 1); PG8_STAGE(PG8_SB(0, 0), b2, voffB);
            PG8_BAR; PG8_WAIT_L(0); PG8_MMA(0, 1, At, B1); PG8_BAR;
            PG8_LDA(At, 0, 1); PG8_STAGE(PG8_SA(0, 0), a2, voffA);
            PG8_BAR; PG8_WAIT_L(0); PG8_MMA(1, 0, At, B0); PG8_BAR; PG8_SCHED;
            PG8_STAGE(PG8_SB(0, 1), b2 + hstep, voffB);
            PG8_WAIT_V(6); PG8_BAR; PG8_MMA(1, 1, At, B1); PG8_BAR;
            PG8_LDB(B0, 1, 0); PG8_SCHED; PG8_LDA(At, 1, 0); PG8_STAGE(PG8_SA(0, 1), a2 + hstep, voffA);
            PG8_WAIT_L(8); PG8_BAR; PG8_WAIT_L(0); PG8_MMA(0, 0, At, B0); PG8_BAR; PG8_SCHED;
            PG8_LDB(B1, 1, 1); PG8_STAGE(PG8_SB(1, 0), b3, voffB);
            PG8_BAR; PG8_WAIT_L(0); PG8_MMA(0, 1, At, B1); PG8_BAR;
            PG8_LDA(At, 1, 1); PG8_STAGE(PG8_SA(1, 0), a3, voffA);
            PG8_BAR; PG8_WAIT_L(0); PG8_MMA(1, 0, At, B0); PG8_BAR; PG8_SCHED;
            PG8_STAGE(PG8_SB(1, 1), b3 + hstep, voffB);
            PG8_WAIT_V(6); PG8_BAR; PG8_MMA(1, 1, At, B1); PG8_BAR;
            }
        }
        if constexpr (F8) asm volatile("s_nop 15\n\ts_nop 7" ::: "memory");
        if constexpr (ALIGN_EPI) { if (wr == 0) PG8_BAR; }
        if constexpr (!Epi::AFTER_DRAIN) { E(acc, cur, wr, wc, fr, fq); S.done(cur); }
        if (!has_next) break;
#pragma unroll
        for (int a = 0; a < 2; ++a)
#pragma unroll
            for (int b = 0; b < 2; ++b)
#pragma unroll
                for (int m = 0; m < 4; ++m)
#pragma unroll
                    for (int n = 0; n < 2; ++n) { float z0, z1, z2, z3; asm volatile("v_mov_b32 %0, 0\n\tv_mov_b32 %1, 0\n\tv_mov_b32 %2, 0\n\tv_mov_b32 %3, 0" : "=v"(z0), "=v"(z1), "=v"(z2), "=v"(z3)); acc[a][b][m][n] = (f32x4){z0, z1, z2, z3}; }
        cur = nxt; cA = nA; cB = nB; ++ui;
        if constexpr (ALIGN_EPI) { if (wr == 1) PG8_BAR; }
    }
    PG8_WAIT_V(0);
    if constexpr (!ALIGN_EPI) { if (wr == 0) PG8_BAR; }
    PG8_BAR;
    if constexpr (Epi::AFTER_DRAIN) { E.fused(acc, cur, wr, wc, fr, fq, lds, wid, lane); S.done(cur); }
#undef PG8_SA
#undef PG8_SB
#undef PG8_STAGE
#undef PG8_LDA
#undef PG8_LDB
#undef PG8_MMA
#undef PG8_WAIT_V
#undef PG8_WAIT_L
#undef PG8_BAR
#undef PG8_SCHED
}
}

#ifndef PG8_SP2
#define PG8_SP2 true
#endif

#define GAS __attribute__((address_space(1)))
#define LAS __attribute__((address_space(3)))
typedef unsigned short bf16;
typedef unsigned v4u __attribute__((ext_vector_type(4)));
typedef unsigned v2u __attribute__((ext_vector_type(2)));
typedef float f32x4 __attribute__((ext_vector_type(4)));
typedef float f32x2 __attribute__((ext_vector_type(2)));
typedef float f32x16 __attribute__((ext_vector_type(16)));
typedef short bf16x8 __attribute__((ext_vector_type(8)));
typedef short s16x4 __attribute__((ext_vector_type(4)));
typedef GAS unsigned gu32;
typedef GAS unsigned long long gu64;
typedef LAS const char* lcp;
typedef LAS char* lwp;
#define RLX_AGENT __ATOMIC_RELAXED, __HIP_MEMORY_SCOPE_AGENT
#define LDS_WAIT() asm volatile("s_waitcnt lgkmcnt(0)" ::: "memory")
#define VM_WAIT() asm volatile("s_waitcnt vmcnt(0)" ::: "memory")
#define WG_BAR() do { asm volatile("s_waitcnt vmcnt(0) lgkmcnt(0)" ::: "memory"); __builtin_amdgcn_s_barrier(); asm volatile("" ::: "memory"); } while (0)
#define DI __device__ __forceinline__
#define MFMA32(a, b, c) __builtin_amdgcn_mfma_f32_32x32x16_f16(__builtin_bit_cast(pg8::f16x8, (a)), __builtin_bit_cast(pg8::f16x8, (b)), (c), 0, 0, 0)
DI unsigned pk2(float lo, float hi) { return pg8::cvt_pk_bf16(lo, hi); }
DI float bflo(unsigned w) { return pg8::bf_lo(w); }
DI float bfhi(unsigned w) { return pg8::bf_hi(w); }
DI float ex2(float x) { return __builtin_amdgcn_exp2f(x); }
DI f32x16 zero16() { float z = 0.f; asm volatile("" : "+v"(z)); return (f32x16){z, z, z, z, z, z, z, z, z, z, z, z, z, z, z, z}; }
DI int crow(int r, int hi) { return (r & 3) + 8 * (r >> 2) + 4 * hi; }
#define SWZ_XOR(v, m) __uint_as_float((unsigned)__builtin_amdgcn_ds_swizzle((int)__float_as_uint(v), ((m) << 10) | 0x1f))
DI float half_swap_add(float v);
DI float wave_sum(float v) { v += SWZ_XOR(v, 1); v += SWZ_XOR(v, 2); v += SWZ_XOR(v, 4); v += SWZ_XOR(v, 8); v += SWZ_XOR(v, 16); return half_swap_add(v); }
DI float shfl_lane(float v, int src_lane) { return __uint_as_float((unsigned)__builtin_amdgcn_ds_bpermute(src_lane << 2, (int)__float_as_uint(v))); }
DI float half_swap_add(float v) { auto rr = __builtin_amdgcn_permlane32_swap(__float_as_uint(v), __float_as_uint(v), false, false); return __uint_as_float(rr[0]) + __uint_as_float(rr[1]); }
DI float half_swap_max(float v) { auto rr = __builtin_amdgcn_permlane32_swap(__float_as_uint(v), __float_as_uint(v), false, false); return fmaxf(__uint_as_float(rr[0]), __uint_as_float(rr[1])); }
typedef short v4i16_t __attribute__((ext_vector_type(4)));
DI s16x4 vtr(lcp p) { return __builtin_bit_cast(s16x4, __builtin_amdgcn_ds_read_tr16_b64_v4i16((LAS v4i16_t*)p)); }
DI bf16x8 cat8(s16x4 lo, s16x4 hi) { return (bf16x8){lo[0], lo[1], lo[2], lo[3], hi[0], hi[1], hi[2], hi[3]}; }
DI bf16x8 trfrag(lcp p) { return cat8(vtr(p), vtr(p + 512)); }
DI bf16x8 ldfrag(lcp p) { return *(const LAS bf16x8*)p; }
DI void glds16(const void* gsrc, LAS void* ldst) { __builtin_amdgcn_global_load_lds((const unsigned*)gsrc, (LAS unsigned*)ldst, 16, 0, 0); }
#define PACK8(x, s) ((bf16x8)__builtin_bit_cast(bf16x8, (v4u){pk2((x)[8 * (s) + 0], (x)[8 * (s) + 1]), pk2((x)[8 * (s) + 2], (x)[8 * (s) + 3]), pk2((x)[8 * (s) + 4], (x)[8 * (s) + 5]), pk2((x)[8 * (s) + 6], (x)[8 * (s) + 7])}))

constexpr int RING_OFF = 0, RING_BYTES = 131072;
constexpr int TAB_OFF = 131072;
constexpr int MISC_OFF = 163840 - 256;
constexpr int LDS_BYTES = 163840;
constexpr int AT_K = 0, AT_V = 32768, AT_WS = 65536, AT_STG = 67584;
constexpr int ML_K = 0, ML_V = 65536, ML_VW = 81920, ML_C = 98304, ML_N = 131072, ML_G2 = 131584, ML_M2 = 132096, ML_FI = 132608, ML_EI = 133120, ML_WK = 133632, ML_WKB = 134144, ML_SC = 134400, ML_WS = 134464, ML_STG = 136512;
static_assert(ML_STG + 4 * 4096 <= MISC_OFF && AT_STG + 8 * 4096 <= MISC_OFF && TAB_OFF + 16384 <= MISC_OFF, "LDS map");

#define XB_TMO      128
#define XB_XCNT(j)  (256  + 64 * (j))
#define XB_XSUB(j)  (1280 + 64 * (j))
#define XB_XGEN(j)  (2304 + 64 * (j))
#define XB_TOP      3328
#define XB_TOPGEN   3392
#define XCD_BAR_WORDS 3456
#define XB_SPIN_CAP (1u << 18)

__device__ __forceinline__ unsigned xb_ld(unsigned* p)              { return __hip_atomic_load(p, __ATOMIC_RELAXED, __HIP_MEMORY_SCOPE_AGENT); }
__device__ __forceinline__ unsigned xb_add(unsigned* p, unsigned v) { return __hip_atomic_fetch_add(p, v, __ATOMIC_RELAXED, __HIP_MEMORY_SCOPE_AGENT); }
__device__ __forceinline__ unsigned xb_xcc_id() { return (unsigned)__builtin_amdgcn_s_getreg((3 << 11) | 20) & 0xFu; }
#define XB_SPIN(cond, bar) do { unsigned _sp = 0; while (cond) { __builtin_amdgcn_s_sleep(1); \
    if ((++_sp & 255u) == 0u) { if (xb_ld(&(bar)[XB_TMO])) break; if (_sp > XB_SPIN_CAP) { atomicAdd(&(bar)[XB_TMO], 1u); break; } } } } while (0)

struct XcdBarrier {
    unsigned* bar; unsigned x;
    volatile LAS unsigned* st;
    unsigned total;
};

__device__ __forceinline__ XcdBarrier xcd_barrier_post(unsigned* bar, volatile LAS unsigned* st) {
    XcdBarrier b; b.bar = bar; b.x = xb_xcc_id(); b.st = st; b.total = gridDim.x * gridDim.y * gridDim.z;
    if (threadIdx.x == 0) (void)xb_add(&bar[XB_XCNT(b.x)], 1u);
    return b;
}
__device__ __forceinline__ void xcd_barrier_complete(unsigned* bar, unsigned x, unsigned G, unsigned& nloc, unsigned& nx) {
    unsigned sum, cnt, mine, sp = 0u;
    for (;;) {
        sum = 0u; cnt = 0u; mine = 0u;
#pragma unroll
        for (unsigned j = 0; j < 16; ++j) { const unsigned c = xb_ld(&bar[XB_XCNT(j)]); sum += c; cnt += (c > 0u) ? 1u : 0u; mine = (j == x) ? c : mine; }
        if (sum == G) break;
        __builtin_amdgcn_s_sleep(1);
        if ((++sp & 255u) == 0u) { if (xb_ld(&bar[XB_TMO])) break; if (sp > XB_SPIN_CAP) { atomicAdd(&bar[XB_TMO], 1u); break; } }
    }
    nloc = mine > 0u ? mine : 1u; nx = cnt > 0u ? cnt : 1u;
}

__device__ __forceinline__ void xcd_barrier(const XcdBarrier& b) {
    asm volatile("s_waitcnt vmcnt(0)" ::: "memory");
    __syncthreads();
    if (threadIdx.x == 0) {
        unsigned* bar = b.bar;
        __builtin_amdgcn_s_waitcnt(0);
        unsigned nloc = b.st[0], nx = b.st[1];
        if (nloc == 0u) { xcd_barrier_complete(bar, b.x, b.total, nloc, nx); b.st[0] = nloc; b.st[1] = nx; }
        const unsigned old = xb_add(&bar[XB_XSUB(b.x)], 1u);
        const unsigned gen = old / nloc;
        if (old + 1u == (gen + 1u) * nloc) {
            __builtin_amdgcn_fence(__ATOMIC_RELEASE, "agent");
            asm volatile("s_waitcnt vmcnt(0)" ::: "memory");
            const unsigned og = xb_add(&bar[XB_TOP], 1u);
            const unsigned tg = og / nx;
            if (og + 1u == (tg + 1u) * nx) xb_add(&bar[XB_TOPGEN], 1u);
            else XB_SPIN(xb_ld(&bar[XB_TOPGEN]) == tg, bar);
            __builtin_amdgcn_fence(__ATOMIC_ACQUIRE, "agent");
            xb_add(&bar[XB_XGEN(b.x)], 1u);
            asm volatile("s_waitcnt vmcnt(0)" ::: "memory");
        } else {
            XB_SPIN(xb_ld(&bar[XB_XGEN(b.x)]) == gen, bar);
            __builtin_amdgcn_fence(__ATOMIC_ACQUIRE, "agent");
            asm volatile("s_waitcnt vmcnt(0)" ::: "memory");
        }
    }
    __syncthreads();
}
DI void attn_phase(unsigned char* ldsg, const bf16* QKV, unsigned char* AO8, const float* sinks, int ng, int gx, int gy, int Gy, int wave_in) {
    int wid = wave_in; asm volatile("" : "+s"(wid));
    const int lane = pg8::pg8_lane(), tid = wid * 64 + lane, r32 = lane & 31, hi = lane >> 5;
    LAS unsigned char* lds = (LAS unsigned char*)ldsg; const lcp L = (lcp)lds;
    LAS float* wsf = (LAS float*)(lds + AT_WS) + wid * 64;
    LAS unsigned char* stg = lds + AT_STG + wid * 4096;
    const lcp vlane = L + AT_V + ((lane >> 4) & 1) * 32 + (lane & 3) * 8 + (4 * hi + ((lane & 15) >> 2)) * 64;
    const lcp klane = L + AT_K + hi * 1024 + r32 * 16;
    for (int uu = gy; uu < 64 * (BATCH / ng); uu += Gy) { const int b = gx + ng * (uu >> 6), ul = uu & 63;
        const int kvh = ul & 3, nb = ul >> 2;
        const long rowq = (long)b * SEQ + nb * 128, rowk = rowq - 128;
        const int slot_lo = (nb == 0) ? 2 : 0;
        for (int sl = slot_lo; sl < 4; ++sl) {
            glds16(QKV + (rowk + 64 * sl + lane) * NQKV + 2048 + 64 * kvh + 8 * wid, lds + AT_K + sl * 8192 + wid * 1024);
            glds16(QKV + (rowk + 64 * sl + 16 * (wid & 3) + (lane >> 2)) * NQKV + 2304 + 64 * kvh + (wid >> 2) * 32 + (lane & 3) * 8, lds + AT_V + sl * 8192 + wid * 1024);
        }
        const int hq = 8 * kvh + wid;
        const bf16* qsrc = QKV + (rowq + r32) * NQKV + 64 * hq + 8 * hi;
        bf16x8 qn[4];
#pragma unroll
        for (int d0 = 0; d0 < 4; ++d0) qn[d0] = *(const bf16x8*)(qsrc + 16 * d0);
        const float slope2 = ex2(-0.25f * (float)(hq + 1)) * LOG2E, sink2 = sinks[hq] * LOG2E;
        const float base_l = -slope2 * (float)(r32 - 4 * hi);
        WG_BAR();
#pragma unroll 1
        for (int j = 0; j < 4; ++j) {
            const int ilo = (nb == 0) ? 4 - j : 0;
            bf16x8 qr[4];
#pragma unroll
            for (int d0 = 0; d0 < 4; ++d0) qr[d0] = qn[d0];
            if (j < 3) {
#pragma unroll
                for (int d0 = 0; d0 < 4; ++d0) qn[d0] = *(const bf16x8*)(qsrc + (size_t)(32 * (j + 1)) * NQKV + 16 * d0);
            }
            float sl2 = slope2, bl = base_l; asm volatile("" : "+v"(sl2), "+v"(bl));
            f32x16 p[5];
#pragma unroll
            for (int i = 0; i < 5; ++i) {
                if (i >= ilo) {
                    const int kt = j + i; const lcp kb = klane + (kt >> 1) * 8192 + (kt & 1) * 512;
                    f32x16 a = zero16();
#pragma unroll
                    for (int d0 = 0; d0 < 4; ++d0) a = MFMA32(ldfrag(kb + d0 * 2048), qr[d0], a);
#pragma unroll
                    for (int r = 0; r < 16; ++r) {
                        const int cr = (r & 3) + 8 * (r >> 2);
                        float s = fmaf(sl2, (float)(cr - 128 + 32 * i), fmaf(a[r], LOG2E, bl));
                        if (i == 0) { if (!(cr + 4 * hi > r32)) s = -INFINITY; }
                        if (i == 4) { if (!(cr + 4 * hi <= r32)) s = -INFINITY; }
                        a[r] = s;
                    }
                    p[i] = a;
                } else {
#pragma unroll
                    for (int r = 0; r < 16; ++r) p[i][r] = -INFINITY;
                }
            }
            float mx = sink2;
#pragma unroll
            for (int i = 0; i < 5; ++i)
#pragma unroll
                for (int r = 0; r < 16; ++r) mx = fmaxf(mx, p[i][r]);
            mx = half_swap_max(mx);
            float ls = 0.f;
#pragma unroll
            for (int i = 0; i < 5; ++i)
#pragma unroll
                for (int r = 0; r < 16; ++r) { const float e = ex2(p[i][r] - mx); p[i][r] = e; ls += e; }
            ls = half_swap_add(ls) + ex2(sink2 - mx);
            f32x16 o0 = zero16(), o1 = zero16();
#pragma unroll
            for (int i = 0; i < 5; ++i) {
                if (i >= ilo) {
                    const int kt = j + i; const lcp vb = vlane + (kt >> 1) * 8192 + (kt & 1) * 2048;
                    const bf16x8 pa = PACK8(p[i], 0), pb = PACK8(p[i], 1);
                    o0 = MFMA32(pa, trfrag(vb), o0);        o0 = MFMA32(pb, trfrag(vb + 1024), o0);
                    o1 = MFMA32(pa, trfrag(vb + 4096), o1); o1 = MFMA32(pb, trfrag(vb + 4096 + 1024), o1);
                }
            }
            if (hi == 0) wsf[r32] = __builtin_amdgcn_rcpf(ls);
#pragma unroll
            for (int r = 0; r < 16; ++r) {
                const int orow = crow(r, hi); const float rl = wsf[orow] * pg8::F8_SO;
                int pk; asm volatile("" : "=v"(pk)); pk = __builtin_amdgcn_cvt_pk_fp8_f32(o0[r] * rl, o1[r] * rl, pk, false);
                stg[orow * 64 + r32] = (unsigned char)(pk & 0xff);
                stg[orow * 64 + 32 + r32] = (unsigned char)((pk >> 8) & 0xff);
            }
#pragma unroll
            for (int i4 = 0; i4 < 2; ++i4) {
                const int row = i4 * 16 + (lane >> 2), ch = lane & 3;
                const v4u v = *(const LAS v4u*)(stg + row * 64 + ch * 16);
                *(v4u*)(AO8 + (rowq + 32 * j + row) * D + 64 * hq + ch * 16) = v;
            }
        }
        WG_BAR();
    }
}

constexpr int ML_GSET = ML_STG + 4 * 4096 - ML_G2;
static_assert(ML_G2 + ML_GSET + (ML_WS - ML_G2) <= MISC_OFF, "LDS map: second gate-array set");
#define DPPF(old, src, ctrl, rmask, bc) __uint_as_float((unsigned)__builtin_amdgcn_update_dpp((int)__float_as_uint(old), (int)__float_as_uint(src), (ctrl), (rmask), 0xf, (bc)))
DI float scan_add64(float v) {
    v += DPPF(0.f, v, 0x111, 0xf, true); v += DPPF(0.f, v, 0x112, 0xf, true); v += DPPF(0.f, v, 0x114, 0xf, true); v += DPPF(0.f, v, 0x118, 0xf, true);
    v += DPPF(0.f, v, 0x142, 0xa, false); v += DPPF(0.f, v, 0x143, 0xc, false); return v;
}
DI float scan_max64(float v) {
    const float ninf = -INFINITY;
    v = fmaxf(v, DPPF(ninf, v, 0x111, 0xf, false)); v = fmaxf(v, DPPF(ninf, v, 0x112, 0xf, false)); v = fmaxf(v, DPPF(ninf, v, 0x114, 0xf, false)); v = fmaxf(v, DPPF(ninf, v, 0x118, 0xf, false));
    v = fmaxf(v, DPPF(ninf, v, 0x142, 0xa, false)); v = fmaxf(v, DPPF(ninf, v, 0x143, 0xc, false)); return v;
}
DI float ml_gate_scan(LAS unsigned char* lds, int gofs, const float* GT, long row0, int h, int lane, float m_prev) {
    LAS float* G2 = (LAS float*)(lds + ML_G2 + gofs); LAS float* M2 = (LAS float*)(lds + ML_M2 + gofs); LAS float* FI = (LAS float*)(lds + ML_FI + gofs); LAS float* EI = (LAS float*)(lds + ML_EI + gofs);
    LAS float* WK = (LAS float*)(lds + ML_WK + gofs); LAS bf16* WKB = (LAS bf16*)(lds + ML_WKB + gofs); LAS float* SC = (LAS float*)(lds + ML_SC + gofs);
    const float* gp = GT + (size_t)(row0 + 2 * lane) * 8;
    const float i0 = gp[h], f0 = gp[4 + h], i1 = gp[8 + h], f1 = gp[12 + h];
    const float lf0 = -0.6931471805599453f * __builtin_amdgcn_logf(1.f + ex2(-LOG2E * f0)), lf1 = -0.6931471805599453f * __builtin_amdgcn_logf(1.f + ex2(-LOG2E * f1));
    const float incl = scan_add64(lf0 + lf1);
    const float b1 = incl, b0 = incl - lf1;
    const float g0 = i0 - b0, g1 = i1 - b1;
    const float cm = scan_max64(fmaxf(g0, g1));
    const float cprev = DPPF(-INFINITY, cm, 0x138, 0xf, false);
    const float M0 = fmaxf(m_prev, fmaxf(cprev, g0)), M1 = fmaxf(m_prev, cm);
    const float Mend = __uint_as_float((unsigned)__builtin_amdgcn_readlane((int)__float_as_uint(M1), 63)), blast = __uint_as_float((unsigned)__builtin_amdgcn_readlane((int)__float_as_uint(b1), 63));
    *(LAS f32x2*)(G2 + 2 * lane) = (f32x2){g0 * LOG2E, g1 * LOG2E};
    *(LAS f32x2*)(M2 + 2 * lane) = (f32x2){M0 * LOG2E, M1 * LOG2E};
    *(LAS f32x2*)(FI + 2 * lane) = (f32x2){ex2((m_prev - M0) * LOG2E), ex2((m_prev - M1) * LOG2E)};
    *(LAS f32x2*)(EI + 2 * lane) = (f32x2){ex2(-(b0 + M0) * LOG2E), ex2(-(b1 + M1) * LOG2E)};
    const float w0 = ex2((g0 - Mend) * LOG2E), w1 = ex2((g1 - Mend) * LOG2E);
    *(LAS f32x2*)(WK + 2 * lane) = (f32x2){w0, w1};
    *(LAS unsigned*)(WKB + 2 * lane) = pk2(w0, w1);
    if (lane == 0) SC[0] = ex2((m_prev - Mend) * LOG2E);
    return blast + Mend;
}
template <int VAR = 0>
DI void mlstm_phase(unsigned char* ldsg, const bf16* MP, const float* GT, bf16* HG, int ng, int gx, int gy, int Gy, int wave_in) {
    int wid = wave_in; asm volatile("" : "+s"(wid));
    const int lane0 = pg8::pg8_lane(), tid = wid * 64 + lane0;
    LAS unsigned char* lds = (LAS unsigned char*)ldsg; const lcp L = (lcp)lds;
    LAS float* wsf = (LAS float*)(lds + ML_WS) + wid * 64;
    for (int uu = gy; uu < 32 * (BATCH / ng); uu += Gy) { const int b = gx + ng * (uu >> 5), ul = uu & 31;
        const int h = ul >> 3, sl = ul & 7;
        const bf16* Qp = MP + 256 * h; const bf16* Kp = MP + 1024 + 256 * h; const bf16* Vp = MP + 2048 + 512 * h + 64 * sl; const bf16* OGp = MP + 4096 + 512 * h + 64 * sl;
        { unsigned z = 0u; asm volatile("" : "+v"(z)); for (int i = tid; i < (32768 + 512) / 16; i += 512) *(LAS v4u*)(lds + ML_C + i * 16) = (v4u){z, z, z, z}; }
        f32x16 T[6];
#pragma unroll
        for (int x = 0; x < 6; ++x) T[x] = zero16();
        float m_prev = 0.f;
        v4u X[16], vreg[2];
        { const long row0 = (long)b * SEQ; const int lane = lane0, r32 = lane & 31, hi = lane >> 5;
          if (wid >= 4) {
#pragma unroll
              for (int i = 0; i < 16; ++i) X[i] = *(const v4u*)(Kp + (row0 + 8 * i + (lane & 7)) * NMI + (8 * (wid - 4) + (lane >> 3)) * 8);
          } else {
#pragma unroll
              for (int ks = 0; ks < 16; ++ks) X[ks] = *(const v4u*)(Qp + (row0 + 32 * wid + r32) * NMI + 16 * ks + 8 * hi);
          }
#pragma unroll
          for (int i = 0; i < 2; ++i) vreg[i] = *(const v4u*)(Vp + (row0 + 64 * i + 16 * (wid & 3) + (lane >> 2)) * NMI + (wid >> 2) * 32 + (lane & 3) * 8);
          if (wid == 4 && !(VAR & 16)) m_prev = ml_gate_scan(lds, 0, GT, row0, h, lane, m_prev);
        }
        WG_BAR();
        for (int c = 0; c < 16; ++c) {
            const long row0 = (long)b * SEQ + 128 * c;
            const int gofs = (c & 1) * ML_GSET;
            const int lane = pg8::pg8_lane(), r32 = lane & 31, hi = lane >> 5;
            const int blk = (lane >> 4) & 1, q4 = (lane & 15) >> 2, p4 = lane & 3;
            const int vlo_ = blk * 32 + p4 * 8 + (4 * hi + q4) * 64;
            const int ktl_ = (2 * blk + (p4 >> 1)) * 2048 + (q4 + 4 * hi) * 16 + (p4 & 1) * 8;
            const int cbl_ = hi * 1024 + r32 * 16, kbl_ = hi * 2048 + r32 * 16;
            const unsigned m0 = (r32 == 0) ? 0xffffffffu : 0u; const v4u m0v = {m0, m0, m0, m0};
            LAS float* G2 = (LAS float*)(lds + ML_G2 + gofs); LAS float* M2 = (LAS float*)(lds + ML_M2 + gofs); LAS float* FI = (LAS float*)(lds + ML_FI + gofs); LAS float* EI = (LAS float*)(lds + ML_EI + gofs);
            LAS float* WK = (LAS float*)(lds + ML_WK + gofs); LAS bf16* WKB = (LAS bf16*)(lds + ML_WKB + gofs); LAS float* SC = (LAS float*)(lds + ML_SC + gofs);
            VM_WAIT();
            if (wid >= 4) {
#pragma unroll
                for (int i = 0; i < 16; ++i) *(LAS v4u*)(lds + ML_K + (8 * (wid - 4) + (lane >> 3)) * 2048 + (8 * i + (lane & 7)) * 16) = X[i];
            }
#pragma unroll
            for (int i = 0; i < 2; ++i) { const float w = WK[64 * i + 16 * (wid & 3) + (lane >> 2)]; const v4u v = vreg[i]; v4u o;
                o.x = pk2(bflo(v.x) * w, bfhi(v.x) * w); o.y = pk2(bflo(v.y) * w, bfhi(v.y) * w); o.z = pk2(bflo(v.z) * w, bfhi(v.z) * w); o.w = pk2(bflo(v.w) * w, bfhi(v.w) * w);
                *(LAS v4u*)(lds + ML_V + i * 8192 + wid * 1024 + lane * 16) = v;
                *(LAS v4u*)(lds + ML_VW + i * 8192 + wid * 1024 + lane * 16) = o; }
            WG_BAR();
            const bool more = c + 1 < 16;
            if (more && !(VAR & 32)) {
                const long row1 = row0 + 128;
                if (wid >= 4) {
#pragma unroll
                    for (int i = 0; i < 16; ++i) X[i] = *(const v4u*)(Kp + (row1 + 8 * i + (lane & 7)) * NMI + (8 * (wid - 4) + (lane >> 3)) * 8);
                }
#pragma unroll
                for (int i = 0; i < 2; ++i) vreg[i] = *(const v4u*)(Vp + (row1 + 64 * i + 16 * (wid & 3) + (lane >> 2)) * NMI + (wid >> 2) * 32 + (lane & 3) * 8);
            }
            if (wid < 4) {
                const int tt = wid;
                v4u ogv[4];
#pragma unroll
                for (int i4 = 0; i4 < 4; ++i4) ogv[i4] = *(const v4u*)(OGp + (row0 + 32 * tt + i4 * 8 + (lane >> 3)) * NMI + (lane & 7) * 8);
                T[0] = zero16(); T[1] = zero16(); T[2] = zero16();
                if (!(VAR & 4)) { const lcp cb = L + ML_C + cbl_; const lcp nbp = L + ML_N + 16 * hi;
#pragma unroll
                  for (int ks = 0; ks < 16; ++ks) {
                      const bf16x8 c0 = ldfrag(cb + ks * 2048), c1 = ldfrag(cb + ks * 2048 + 512);
                      const bf16x8 nf = __builtin_bit_cast(bf16x8, __builtin_bit_cast(v4u, ldfrag(nbp + ks * 32)) & m0v);
                      T[0] = MFMA32(__builtin_bit_cast(bf16x8, X[ks]), c0, T[0]); T[1] = MFMA32(__builtin_bit_cast(bf16x8, X[ks]), c1, T[1]); T[2] = MFMA32(__builtin_bit_cast(bf16x8, X[ks]), nf, T[2]);
                      if ((ks & 3) == 3) __builtin_amdgcn_sched_barrier(0);
                  } }
                { float fi[16];
#pragma unroll
                  for (int r = 0; r < 16; ++r) fi[r] = FI[32 * tt + crow(r, hi)];
#pragma unroll
                  for (int r = 0; r < 16; ++r) { T[0][r] *= fi[r]; T[1][r] *= fi[r]; }
                  if (r32 == 0) {
#pragma unroll
                      for (int r = 0; r < 16; ++r) wsf[crow(r, hi)] = T[2][r] * fi[r];
                  } }
                const float Mt = M2[32 * tt + r32];
                float dsum = 0.f;
                for (int st = 0; st <= ((VAR & 2) ? -1 : tt); ++st) {
                    f32x16 S = zero16();
                    const lcp kb = L + ML_K + kbl_ + st * 512;
#pragma unroll
                    for (int ks = 0; ks < 16; ++ks) S = MFMA32(ldfrag(kb + ks * 4096), __builtin_bit_cast(bf16x8, X[ks]), S);
#pragma unroll
                    for (int r = 0; r < 16; ++r) {
                        const float w = ex2(G2[32 * st + crow(r, hi)] - Mt);
                        float v = S[r] * w;
                        if (st == tt && crow(r, hi) > r32) v = 0.f;
                        S[r] = v; dsum += v;
                    }
                    const bf16x8 pa = PACK8(S, 0), pb = PACK8(S, 1);
                    const lcp vb = L + ML_V + (st >> 1) * 8192 + (st & 1) * 2048 + vlo_;
                    T[0] = MFMA32(pa, trfrag(vb), T[0]);        T[0] = MFMA32(pb, trfrag(vb + 1024), T[0]);
                    T[1] = MFMA32(pa, trfrag(vb + 4096), T[1]); T[1] = MFMA32(pb, trfrag(vb + 4096 + 1024), T[1]);
                }
                if (more && !(VAR & 64)) {
#pragma unroll
                    for (int ks = 0; ks < 16; ++ks) X[ks] = *(const v4u*)(Qp + (row0 + 128 + 32 * wid + r32) * NMI + 16 * ks + 8 * hi);
                }
                dsum = half_swap_add(dsum);
                { const float den = wsf[r32] + dsum; const float dn = fmaxf(fabsf(den), EI[32 * tt + r32]);
                  if (hi == 0) wsf[32 + r32] = __builtin_amdgcn_rcpf(dn); }
                LAS bf16* stg = (LAS bf16*)(lds + ML_STG + tt * 4096);
                if (!(VAR & 8)) {
#pragma unroll
                for (int r = 0; r < 16; ++r) {
                    const int orow = crow(r, hi); const float rd = wsf[32 + orow];
                    stg[orow * 64 + r32] = (bf16)(pk2(T[0][r] * rd, 0.f) & 0xffffu);
                    stg[orow * 64 + 32 + r32] = (bf16)(pk2(T[1][r] * rd, 0.f) & 0xffffu);
                }
#pragma unroll
                for (int i4 = 0; i4 < 4; ++i4) {
                    const int row = i4 * 8 + (lane >> 3), ch = lane & 7;
                    const v4u hv = *(const LAS v4u*)(stg + row * 64 + ch * 8);
                    const v4u og = ogv[i4];
                    v4u o;
                    o.x = pk2(bflo(hv.x) * bflo(og.x), bfhi(hv.x) * bfhi(og.x)); o.y = pk2(bflo(hv.y) * bflo(og.y), bfhi(hv.y) * bfhi(og.y));
                    o.z = pk2(bflo(hv.z) * bflo(og.z), bfhi(hv.z) * bfhi(og.z)); o.w = pk2(bflo(hv.w) * bflo(og.w), bfhi(hv.w) * bfhi(og.w));
                    *(v4u*)(HG + (row0 + 32 * tt + row) * D + 512 * h + 64 * sl + ch * 8) = o;
                }
                }
#pragma unroll
                for (int x = 3; x < 6; ++x) T[x] = zero16();
            } else {
                const float decay = SC[0];
#pragma unroll
                for (int x = 0; x < 6; ++x)
#pragma unroll
                    for (int r = 0; r < 16; ++r) T[x][r] *= decay;
#pragma unroll
                for (int dti = 0; dti < ((VAR & 1) ? 0 : 2); ++dti) {
                    const int dt = 2 * (wid - 4) + dti;
                    const lcp ka0 = L + ML_K + dt * 8192 + ktl_;
#pragma unroll
                    for (int s8 = 0; s8 < 8; ++s8) {
                        const lcp ka = ka0 + s8 * 256;
                        const bf16x8 af = cat8(vtr(ka), vtr(ka + 128));
                        const lcp vwb = L + ML_VW + (s8 >> 2) * 8192 + (s8 & 3) * 1024 + vlo_;
                        const bf16x8 b0 = trfrag(vwb), b1 = trfrag(vwb + 4096);
                        const LAS s16x4* wp = (const LAS s16x4*)(WKB + 16 * s8 + 4 * hi);
                        const bf16x8 nb = __builtin_bit_cast(bf16x8, __builtin_bit_cast(v4u, cat8(wp[0], wp[2])) & m0v);
                        T[2 * dti] = MFMA32(af, b0, T[2 * dti]); T[2 * dti + 1] = MFMA32(af, b1, T[2 * dti + 1]); T[4 + dti] = MFMA32(af, nb, T[4 + dti]);
                        if (s8 & 1) __builtin_amdgcn_sched_barrier(0);
                    }
                }
                if (more && wid == 4 && !(VAR & 16)) m_prev = ml_gate_scan(lds, ML_GSET - gofs, GT, row0 + 128, h, lane, m_prev);
            }
            asm volatile("s_waitcnt lgkmcnt(0)" ::: "memory"); __builtin_amdgcn_s_barrier(); asm volatile("" ::: "memory");
            if (wid >= 4) {
#pragma unroll
                for (int dti = 0; dti < 2; ++dti) {
                    const int dt = 2 * (wid - 4) + dti;
#pragma unroll
                    for (int et = 0; et < 2; ++et)
#pragma unroll
                        for (int g = 0; g < 4; ++g)
                            *(LAS v2u*)(lds + ML_C + (4 * dt + g) * 1024 + (32 * et + r32) * 16 + hi * 8) = (v2u){pk2(T[2 * dti + et][4 * g], T[2 * dti + et][4 * g + 1]), pk2(T[2 * dti + et][4 * g + 2], T[2 * dti + et][4 * g + 3])};
                    if (r32 == 0) {
#pragma unroll
                        for (int g = 0; g < 4; ++g)
                            *(LAS v2u*)(lds + ML_N + (32 * dt + 8 * g + 4 * hi) * 2) = (v2u){pk2(T[4 + dti][4 * g], T[4 + dti][4 * g + 1]), pk2(T[4 + dti][4 * g + 2], T[4 + dti][4 * g + 3])};
                    }
                }
            }
        }
        WG_BAR();
    }
}


constexpr int NWAVES = 8;

template <bool F8> DI void tr_strip(const float* W, int ldw, int n0, void* WTv, size_t wt_row0, int Kdim, int kb0, int nkb, const float* g, const float* bb, float cs, float* c1o, float* c2o, LAS float* scr, int lane) {
    bf16* WT = (bf16*)WTv; unsigned char* WT8 = (unsigned char*)WTv;
    const int c = lane & 7;
    float a1[4] = {0.f, 0.f, 0.f, 0.f}, a2[4] = {0.f, 0.f, 0.f, 0.f};
    for (int kb = kb0; kb < kb0 + nkb; ++kb) {
        const int k0 = kb * 64;
#pragma unroll 8
        for (int i = 0; i < 32; ++i) { const int kk = 2 * i + (lane >> 5); scr[kk * 33 + (lane & 31)] = W[(size_t)(k0 + kk) * ldw + n0 + (lane & 31)]; }
        float gk[8], bk[8];
        if (g) { const f32x4 g0 = *(const f32x4*)(g + k0 + 8 * c), g1 = *(const f32x4*)(g + k0 + 8 * c + 4), b0 = *(const f32x4*)(bb + k0 + 8 * c), b1 = *(const f32x4*)(bb + k0 + 8 * c + 4);
#pragma unroll
            for (int i = 0; i < 4; ++i) { gk[i] = g0[i] * cs; gk[4 + i] = g1[i] * cs; bk[i] = b0[i] * cs; bk[4 + i] = b1[i] * cs; } }
        else {
#pragma unroll
            for (int i = 0; i < 8; ++i) { gk[i] = cs; bk[i] = 0.f; } }
        LDS_WAIT(); asm volatile("" ::: "memory");
#pragma unroll
        for (int j = 0; j < 4; ++j) { const int n = (lane >> 3) + 8 * j; const LAS float* s = scr + (8 * c) * 33 + n;
            float v[8];
#pragma unroll
            for (int i = 0; i < 8; ++i) v[i] = s[i * 33];
            a2[j] += ((v[0] * bk[0] + v[1] * bk[1]) + (v[2] * bk[2] + v[3] * bk[3])) + ((v[4] * bk[4] + v[5] * bk[5]) + (v[6] * bk[6] + v[7] * bk[7]));
            if constexpr (F8) {
                float wv[8];
#pragma unroll
                for (int i = 0; i < 8; ++i) wv[i] = v[i] * gk[i];
                const v2u o = pg8::cvt8_f8(wv, pg8::F8_SW);
                a1[j] += ((__builtin_amdgcn_cvt_f32_fp8((int)o.x, 0) + __builtin_amdgcn_cvt_f32_fp8((int)o.x, 1)) + (__builtin_amdgcn_cvt_f32_fp8((int)o.x, 2) + __builtin_amdgcn_cvt_f32_fp8((int)o.x, 3)))
                       + ((__builtin_amdgcn_cvt_f32_fp8((int)o.y, 0) + __builtin_amdgcn_cvt_f32_fp8((int)o.y, 1)) + (__builtin_amdgcn_cvt_f32_fp8((int)o.y, 2) + __builtin_amdgcn_cvt_f32_fp8((int)o.y, 3)));
                *(GAS v2u*)(WT8 + (wt_row0 + n) * Kdim + k0 + 8 * c) = o;
            } else {
                v4u o; o.x = pk2(v[0] * gk[0], v[1] * gk[1]); o.y = pk2(v[2] * gk[2], v[3] * gk[3]); o.z = pk2(v[4] * gk[4], v[5] * gk[5]); o.w = pk2(v[6] * gk[6], v[7] * gk[7]);
                a1[j] += ((bflo(o.x) + bfhi(o.x)) + (bflo(o.y) + bfhi(o.y))) + ((bflo(o.z) + bfhi(o.z)) + (bflo(o.w) + bfhi(o.w)));
                *(GAS v4u*)(WT + (wt_row0 + n) * Kdim + k0 + 8 * c) = o;
            } }
        LDS_WAIT(); asm volatile("" ::: "memory");
    }
    if (g) {
#pragma unroll
        for (int j = 0; j < 4; ++j) { float s1 = a1[j], s2 = a2[j];
            s1 += SWZ_XOR(s1, 1); s2 += SWZ_XOR(s2, 1); s1 += SWZ_XOR(s1, 2); s2 += SWZ_XOR(s2, 2); s1 += SWZ_XOR(s1, 4); s2 += SWZ_XOR(s2, 4);
            if (c == 0) { c1o[(lane >> 3) + 8 * j] = F8 ? s1 * (1.f / pg8::F8_SW) : s1; c2o[(lane >> 3) + 8 * j] = s2; } }
    }
}

DI void prologue(kargs_t a, LAS unsigned char* lds, int gw, int NGW, int wave, int lane) {
    unsigned char* ws = a->ws;
    float* vec = (float*)(ws + WS_VEC);
    const float* ones = (const float*)(ws + WS_VEC + V_ONES); const float* zeros = (const float*)(ws + WS_VEC + V_ZEROS);
    LAS float* scr = (LAS float*)(lds + wave * 16384);
    constexpr int T_UP = 8 * 2 * 176, T_QKV = 2 * 80, T_MI = 2 * 192, T_W2 = 8 * 64 * 4, T_WO = 2 * 64, T_WMO = 2 * 64, T_G = 16;
    constexpr int NT = T_UP + T_QKV + T_MI + T_W2 + T_WO + T_WMO + T_G;
    for (int it = gw; it < NT; it += NGW) {
        int r = it;
        if (r < T_UP) {
            const int f = r / 352, rr = r % 352, which = rr / 176, strip = rr % 176, n0 = 32 * strip;
            const int t = 3 * (f >> 1) + 2 * (f & 1);
            const float* gp = t ? a->ln_g + (size_t)(t - 1) * D : nullptr; const float* bp = t ? a->ln_b + (size_t)(t - 1) * D : nullptr;
            const size_t wrow = (size_t)256 * (n0 / 128) + 128 * which + (n0 % 128);
            const float* W = (which ? a->w3 : a->w1) + (size_t)f * D * FF;
            if (gp) tr_strip<true>(W, FF, n0, ws + WS_W13 + (size_t)f * NUP * D, wrow, D, 0, 32, gp, bp, 1.f, vec + V_C1U / 4 + (size_t)f * NUP + wrow, vec + V_C2U / 4 + (size_t)f * NUP + wrow, scr, lane);
            else { tr_strip<true>(W, FF, n0, ws + WS_W13 + (size_t)f * NUP * D, wrow, D, 0, 32, nullptr, nullptr, 1.f, nullptr, nullptr, scr, lane);
                   if (lane < 32) { vec[V_C1U / 4 + (size_t)f * NUP + wrow + lane] = 0.f; vec[V_C2U / 4 + (size_t)f * NUP + wrow + lane] = 0.f; } }
            continue; }
        r -= T_UP;
        if (r < T_QKV) { const int j = r / 80, n0 = 32 * (r % 80); const int t = 6 * j + 1;
            tr_strip<true>(a->wqkv + (size_t)j * D * NQKV, NQKV, n0, ws + WS_WQKV + (size_t)j * NQKV * D, n0, D, 0, 32, a->ln_g + (size_t)(t - 1) * D, a->ln_b + (size_t)(t - 1) * D, n0 < 2048 ? 0.125f : 1.f,
                     vec + V_C1Q / 4 + j * NQKV + n0, vec + V_C2Q / 4 + j * NQKV + n0, scr, lane);
            continue; }
        r -= T_QKV;
        if (r < T_MI) { const int j = r / 192, n0 = 32 * (r % 192); const int t = 6 * j + 4;
            if (true) tr_strip<false>(a->win + (size_t)j * D * NMIW, NMIW, n0, (bf16*)(ws + WS_WIN) + (size_t)j * NMI * D, n0, D, 0, 32, a->ln_g + (size_t)(t - 1) * D, a->ln_b + (size_t)(t - 1) * D, (n0 >= 1024 && n0 < 2048) ? 0.0625f : 1.f,
                     vec + V_C1I / 4 + j * NMI + n0, vec + V_C2I / 4 + j * NMI + n0, scr, lane);
            else tr_strip<true>(a->win + (size_t)j * D * NMIW, NMIW, n0, ws + WS_WIN + 32 * MiB + (size_t)j * 2048 * D, n0 - 4096, D, 0, 32, a->ln_g + (size_t)(t - 1) * D, a->ln_b + (size_t)(t - 1) * D, 1.f,
                     vec + V_C1I / 4 + j * NMI + n0, vec + V_C2I / 4 + j * NMI + n0, scr, lane);
            continue; }
        r -= T_MI;
        if (r < T_W2) { const int f = r / 256, rr = r % 256, strip = rr / 4, kq = rr % 4;
            tr_strip<true>(a->w2 + (size_t)f * FF * D, D, 32 * strip, ws + WS_W2 + (size_t)f * D * FF, 32 * strip, FF, 22 * kq, 22, nullptr, nullptr, 1.f, nullptr, nullptr, scr, lane);
            continue; }
        r -= T_W2;
        if (r < T_WO) { const int j = r / 64, strip = r % 64;
            tr_strip<true>(a->wo + (size_t)j * D * D, D, 32 * strip, ws + WS_WO + (size_t)j * D * D, 32 * strip, D, 0, 32, nullptr, nullptr, 1.f, nullptr, nullptr, scr, lane);
            continue; }
        r -= T_WO;
        if (r < T_WMO) { const int j = r / 64, strip = r % 64;
            tr_strip<false>(a->wmo + (size_t)j * D * D, D, 32 * strip, (bf16*)(ws + WS_WMO) + (size_t)j * D * D, 32 * strip, D, 0, 32, nullptr, nullptr, 1.f, nullptr, nullptr, scr, lane);
            continue; }
        r -= T_WMO;
        {
            const int j = r / 8, jj = r % 8; const int t = 6 * j + 4;
            const float* gp = a->ln_g + (size_t)(t - 1) * D; const float* bp = a->ln_b + (size_t)(t - 1) * D;
            const float* W = a->win + (size_t)j * D * NMIW + NMI + jj;
            bf16* wg16 = (bf16*)(vec + V_WG / 4) + (size_t)(j * 8 + jj) * D;
            float s1 = 0.f, s2 = 0.f;
            for (int k = lane; k < D; k += 64) { const float w = W[(size_t)k * NMIW]; const unsigned hv = pk2(w * gp[k], 0.f) & 0xffffu; wg16[k] = (bf16)hv; s1 += bflo(hv); s2 += w * bp[k]; }
            s1 = wave_sum(s1); s2 = wave_sum(s2);
            if (lane == 0) { vec[V_CG / 4 + j * 16 + jj] = s1; vec[V_CG / 4 + j * 16 + 8 + jj] = s2 + a->bg[j * 8 + jj]; }
        }
    }
    bf16* R = (bf16*)(ws + WS_R); float* sp0 = (float*)(ws + WS_SP);
    for (int m = gw; m < M; m += NGW) {
        const GAS f32x4* xr = (const GAS f32x4*)(a->x + (size_t)m * D);
#pragma unroll
        for (int i = 0; i < 4; ++i) { const f32x4 v0 = xr[(i * 64 + lane) * 2], v1 = xr[(i * 64 + lane) * 2 + 1];
            *(GAS v4u*)(R + (size_t)m * D + (i * 64 + lane) * 8) = (v4u){pk2(v0[0], v0[1]), pk2(v0[2], v0[3]), pk2(v1[0], v1[1]), pk2(v1[2], v1[3])};
            { const float xv[8] = {v0[0], v0[1], v0[2], v0[3], v1[0], v1[1], v1[2], v1[3]}; *(GAS v2u*)(ws + WS_R8 + (size_t)m * D + (i * 64 + lane) * 8) = pg8::cvt8_f8(xv, pg8::F8_SR); } }
        if (lane < 8) *(f32x2*)(sp0 + (size_t)m * 16 + lane * 2) = (f32x2){0.f, 256.f * (1.f - LN_EPS)};
    }
    for (int i = gw * 64 + lane; i < D; i += NGW * 64) { vec[V_ONES / 4 + i] = 1.f; vec[V_ZEROS / 4 + i] = 0.f; }
    (void)ones; (void)zeros;
}

DI void gates_phase(LAS unsigned char* lds, const bf16* R, const float* sp, const bf16* wg16, const float* cg, float* GT, int ng, int gx, int gy, int Gy, int wave_in) {
    int wave = wave_in; asm volatile("" : "+s"(wave));
    const int lane = pg8::pg8_lane(), tid = wave * 64 + lane, r32 = lane & 31, hi = lane >> 5;
    LAS float* part = (LAS float*)lds;
    const unsigned mk = (r32 < 8) ? 0xffffffffu : 0u; const v4u mkv = {mk, mk, mk, mk};
    for (int uu = gy; uu < (SEQ / 64) * (BATCH / ng); uu += Gy) { const int b = gx + ng * (uu >> 5), pl = uu & 31;
        const long r0 = (long)b * SEQ + (long)pl * 64;
        const bf16* bsrc = wg16 + (size_t)(r32 & 7) * D + 256 * wave + 8 * hi;
        bf16x8 bfr[16];
#pragma unroll
        for (int ks = 0; ks < 16; ++ks) bfr[ks] = __builtin_bit_cast(bf16x8, *(const v4u*)(bsrc + 16 * ks) & mkv);
#pragma unroll
        for (int rt = 0; rt < 2; ++rt) {
            const bf16* asrc = R + (r0 + 32 * rt + r32) * D + 256 * wave + 8 * hi;
            bf16x8 afr[16];
#pragma unroll
            for (int ks = 0; ks < 16; ++ks) afr[ks] = *(const bf16x8*)(asrc + 16 * ks);
            f32x16 acc = zero16();
#pragma unroll
            for (int ks = 0; ks < 16; ++ks) acc = MFMA32(afr[ks], bfr[ks], acc);
            if (r32 < 8) {
#pragma unroll
                for (int r = 0; r < 16; ++r) part[(wave * 64 + 32 * rt + crow(r, hi)) * 8 + r32] = acc[r];
            }
        }
        WG_BAR();
        {
            const int row = tid >> 3, col = tid & 7;
            float s = 0.f;
#pragma unroll
            for (int w = 0; w < 8; ++w) s += part[(w * 64 + row) * 8 + col];
            const f32x4* spr = (const f32x4*)(sp + (size_t)(r0 + row) * 16);
            const f32x4 v0 = spr[0], v1 = spr[1], v2 = spr[2], v3 = spr[3];
            const float ss = ((v0[0] + v0[2]) + (v1[0] + v1[2])) + ((v2[0] + v2[2]) + (v3[0] + v3[2])), qq = ((v0[1] + v0[3]) + (v1[1] + v1[3])) + ((v2[1] + v2[3]) + (v3[1] + v3[3]));
            const float mean = ss * (1.f / D), var = qq * (1.f / D) - mean * mean, rstd = __builtin_amdgcn_rsqf(var + LN_EPS);
            GT[(size_t)(r0 + row) * 8 + col] = rstd * (s - mean * cg[col]) + cg[8 + col];
        }
        WG_BAR();
    }
}

DI void final_ln(const bf16* R, const float* sp, const float* g, const float* b, float* out, int ng, int gx, int gw, int NGW, int lane) {
    for (int bb = gx; bb < BATCH; bb += ng) for (int m = bb * SEQ + gw; m < (bb + 1) * SEQ; m += NGW) {
        float s, q;
        { const f32x4 v = *(const f32x4*)(sp + (size_t)m * 16 + (lane & 3) * 4); s = v[0] + v[2]; q = v[1] + v[3];
          s += SWZ_XOR(s, 1); q += SWZ_XOR(q, 1); s += SWZ_XOR(s, 2); q += SWZ_XOR(q, 2); }
        const float mean = s * (1.f / D), var = q * (1.f / D) - mean * mean, rstd = __builtin_amdgcn_rsqf(var + LN_EPS);
#pragma unroll
        for (int i = 0; i < 4; ++i) {
            const int k = 8 * lane + 512 * i;
            const v4u rv = *(const v4u*)(R + (size_t)m * D + k);
            const f32x4 g0 = *(const f32x4*)(g + k), g1 = *(const f32x4*)(g + k + 4), b0 = *(const f32x4*)(b + k), b1 = *(const f32x4*)(b + k + 4);
            f32x4 o0, o1;
            o0[0] = (bflo(rv.x) - mean) * rstd * g0[0] + b0[0]; o0[1] = (bfhi(rv.x) - mean) * rstd * g0[1] + b0[1]; o0[2] = (bflo(rv.y) - mean) * rstd * g0[2] + b0[2]; o0[3] = (bfhi(rv.y) - mean) * rstd * g0[3] + b0[3];
            o1[0] = (bflo(rv.z) - mean) * rstd * g1[0] + b1[0]; o1[1] = (bfhi(rv.z) - mean) * rstd * g1[1] + b1[1]; o1[2] = (bflo(rv.w) - mean) * rstd * g1[2] + b1[2]; o1[3] = (bfhi(rv.w) - mean) * rstd * g1[3] + b1[3];
            *(GAS f32x4*)(out + (size_t)m * D + k) = o0; *(GAS f32x4*)(out + (size_t)m * D + k + 4) = o1;
        }
    }
}

#ifndef PROBE_DUP
#define PROBE_DUP 0
#endif
#ifndef PROBE_DRY
#define PROBE_DRY 1
#endif
#ifndef PROBE_MLV
#define PROBE_MLV 0
#endif
#ifndef SKIP_ATT
#define SKIP_ATT 0
#endif
#ifndef SKIP_MLSTM
#define SKIP_MLSTM 0
#endif

#define GRID_BAR1() do { XcdBarrier b_; b_.bar = (unsigned*)(kargs()->ws + WS_CTL) + CW_BAR; b_.x = xb_xcc_id(); b_.st = (volatile LAS unsigned*)(lds + MISC_OFF) + 8; b_.total = gridDim.x; xcd_barrier(b_); } while (0)
#define GRID_BAR() do { GRID_BAR1(); if (PROBE_DUP & 1024) GRID_BAR1(); } while (0)
#define GROUP_BAR1() do { XcdBarrier b_; b_.bar = (unsigned*)(kargs()->ws + WS_CTL) + CW_BAR + (1 + (bid & 7)) * XCD_BAR_WORDS; b_.x = xb_xcc_id(); b_.st = (volatile LAS unsigned*)(lds + MISC_OFF) + 10; b_.total = gridDim.x / 8; xcd_barrier(b_); } while (0)
#define LAYER_BAR() do { if (grouped) { GROUP_BAR1(); if (PROBE_DUP & 1024) GROUP_BAR1(); } else GRID_BAR(); } while (0)

__global__ void __launch_bounds__(NWAVES * 64, 2) fwd_kernel(Args args_by_value) {
    extern __shared__ __attribute__((aligned(16))) unsigned char lds_raw[];
    LAS unsigned char* lds = (LAS unsigned char*)lds_raw;
    const int w0 = __builtin_amdgcn_readfirstlane((int)threadIdx.x >> 6);
    const int G0 = gridDim.x, bid0 = blockIdx.x; const int G = G0, bid = bid0;
    { const int tid0 = threadIdx.x; if (tid0 < 64) ((volatile LAS unsigned*)(lds + MISC_OFF))[tid0] = 0u; }
    __syncthreads();
    (void)xcd_barrier_post((unsigned*)(kargs()->ws + WS_CTL) + CW_BAR, (volatile LAS unsigned*)(lds + MISC_OFF) + 8);
    const bool grouped = (G0 == 256);
    if (grouped) (void)xcd_barrier_post((unsigned*)(kargs()->ws + WS_CTL) + CW_BAR + (1 + (bid0 & 7)) * XCD_BAR_WORDS, (volatile LAS unsigned*)(lds + MISC_OFF) + 10);
    {
        const int vcu = (G % 8 == 0) ? (bid % 8) * (G / 8) + bid / 8 : bid;
        prologue(kargs(), lds, vcu * NWAVES + w0, G * NWAVES, w0, pg8::pg8_lane());
        if (PROBE_DUP & 1) { WG_BAR(); prologue(kargs(), lds, vcu * NWAVES + w0, G * NWAVES, w0, pg8::pg8_lane()); }
    }
    GRID_BAR();

    for (int t = 0; t < 3 * DEPTH; ++t) {
        int G = G0, bid = bid0; asm volatile("" : "+s"(G), "+s"(bid));
        const int ng = grouped ? 8 : 1, gx = bid % ng, gy = bid / ng, Gy = G / ng;
        const int layer = t / 3, sub = t % 3;
        const int kind = (sub != 1) ? 0 : ((layer & 1) ? 2 : 1);
        const int j = layer >> 1;
        {
            unsigned char* ws = kargs()->ws;
            float* vec = (float*)(ws + WS_VEC);
            const bf16* R = (const bf16*)(ws + WS_R);
            const float* sp_in = (const float*)(ws + WS_SP) + (size_t)(t & 1) * (SP_BYTES / 4);
            if (kind == 0) {
                const int f = 2 * layer + (sub >> 1);
                pg8::Gemm g{(const bf16*)(ws + WS_R8), (const bf16*)(ws + WS_W13 + (size_t)f * NUP * D), M, NUP, D / 2}; pg8::StaticOrder S; S.init(M, NUP, G, bid);
                pg8::EpiUp E{f, t & 1};
                if (PROBE_DUP & 2048) { S.r1 = 5; pg8::gemm_phase<pg8::EpiUp, pg8::StaticOrder, true, PG8_SP2, true>(lds + RING_OFF, g, S, E, w0); LAYER_BAR(); S.r0 = 5; S.r1 = 1 << 20; }
                pg8::gemm_phase<pg8::EpiUp, pg8::StaticOrder, true, PG8_SP2, true>(lds + RING_OFF, g, S, E, w0);
                if (PROBE_DUP & 16) pg8::gemm_phase<pg8::EpiUp, pg8::StaticOrder, true, PG8_SP2, true>(lds + RING_OFF, g, S, E, w0);
                if (PROBE_DUP & 128) { pg8::EpiNull EN{(float*)(ws + WS_GATES)}; pg8::gemm_phase<pg8::EpiNull, pg8::StaticOrder, true, PG8_SP2, true>(lds + RING_OFF, g, S, EN, w0); }
            } else {
                if (kind == 2) {
                    pg8::Gemm g{R, (const bf16*)(ws + WS_WIN) + (size_t)j * NMI * D, M, NMI, D}; pg8::StaticOrder S; S.init(M, NMI, G, bid);
                    pg8::EpiLnOut E{1, j, t & 1};
                    pg8::gemm_phase<pg8::EpiLnOut, pg8::StaticOrder, true, PG8_SP2>(lds + RING_OFF, g, S, E, w0);
                    if (PROBE_DUP & 32) pg8::gemm_phase<pg8::EpiLnOut, pg8::StaticOrder, true, PG8_SP2>(lds + RING_OFF, g, S, E, w0);
                }
                if (kind == 1) {
                    const int N = kind == 1 ? NQKV : 2048;
                    pg8::Gemm g{(const bf16*)(ws + WS_R8), (const bf16*)(kind == 1 ? ws + WS_WQKV + (size_t)j * NQKV * D : ws + WS_WIN + 32 * MiB + (size_t)j * 2048 * D), M, N, D / 2}; pg8::StaticOrder S; S.init(M, N, G, bid);
                    pg8::EpiLnOut E{kind == 1 ? 0 : 2, j, t & 1};
                    pg8::gemm_phase<pg8::EpiLnOut, pg8::StaticOrder, true, PG8_SP2, true>(lds + RING_OFF, g, S, E, w0);
                    if (PROBE_DUP & 32) pg8::gemm_phase<pg8::EpiLnOut, pg8::StaticOrder, true, PG8_SP2, true>(lds + RING_OFF, g, S, E, w0);
                }
                if (kind == 2) {
                    gates_phase(lds, R, sp_in, (const bf16*)(vec + V_WG / 4) + (size_t)j * 8 * D, vec + V_CG / 4 + j * 16, (float*)(ws + WS_GATES), ng, gx, gy, Gy, w0);
                    if (PROBE_DUP & 8) { WG_BAR(); gates_phase(lds, R, sp_in, (const bf16*)(vec + V_WG / 4) + (size_t)j * 8 * D, vec + V_CG / 4 + j * 16, (float*)(ws + WS_GATES), ng, gx, gy, Gy, w0); }
                }
            }
        }
        LAYER_BAR();
        if (kind == 1) {
            if (!SKIP_ATT) { kargs_t ka = kargs(); unsigned char* ws = ka->ws; attn_phase(lds_raw, (const bf16*)(ws + WS_QKV), ws + WS_AO, ka->sinks + j * 32, ng, gx, gy, Gy, w0);
                if (PROBE_DUP & 2) attn_phase(lds_raw, (const bf16*)(ws + WS_QKV), ws + WS_AO, ka->sinks + j * 32, ng, gx, gy, Gy, w0); }
            LAYER_BAR();
        } else if (kind == 2) {
            if (!SKIP_MLSTM) { unsigned char* ws = kargs()->ws; mlstm_phase(lds_raw, (const bf16*)(ws + WS_MP), (const float*)(ws + WS_GATES), (bf16*)(ws + WS_HG), ng, gx, gy, Gy, w0);
                if (PROBE_DUP & 4) mlstm_phase<PROBE_MLV>(lds_raw, (const bf16*)(ws + WS_MP), (const float*)(ws + WS_GATES), (bf16*)(ws + WS_H), ng, gx, gy, Gy, w0); }
            LAYER_BAR();
        }
        {
            kargs_t ka = kargs(); unsigned char* ws = ka->ws;
            float coef = kind == 0 ? 0.5f / (pg8::F8_SH * pg8::F8_SW) : (kind == 1 ? 1.f / (pg8::F8_SO * pg8::F8_SW) : 1.f);
            if ((kind == 1 && SKIP_ATT) || (kind == 2 && SKIP_MLSTM)) coef = 0.f;
            pg8::StaticOrder S; S.init(M, D, G, bid);
            pg8::EpiRes E{t, coef, (LAS float*)(lds + TAB_OFF), w0, 0};
            if (kind != 2) {
                const int f = 2 * layer + (sub >> 1);
                pg8::Gemm g{(const bf16*)(ws + (kind == 0 ? WS_H : WS_AO)), (const bf16*)(kind == 0 ? ws + WS_W2 + (size_t)f * D * FF : ws + WS_WO + (size_t)j * D * D), M, D, kind == 0 ? FF / 2 : D / 2};
                if (PROBE_DUP & 64) { pg8::EpiNull EN{(float*)(ws + WS_GATES)}; pg8::gemm_phase<pg8::EpiNull, pg8::StaticOrder, true, PG8_SP2, true>(lds + RING_OFF, g, S, EN, w0); }
                if (PROBE_DUP & 512) { pg8::EpiRes ED{t, coef, (LAS float*)(lds + TAB_OFF), w0, PROBE_DRY}; pg8::gemm_phase<pg8::EpiRes, pg8::StaticOrder, true, PG8_SP2, true>(lds + RING_OFF, g, S, ED, w0); }
                pg8::gemm_phase<pg8::EpiRes, pg8::StaticOrder, true, PG8_SP2, true>(lds + RING_OFF, g, S, E, w0);
            } else {
                pg8::Gemm g{(const bf16*)(ws + WS_HG), (const bf16*)(ws + WS_WMO) + (size_t)j * D * D, M, D, D};
                if (PROBE_DUP & 256) { pg8::EpiNull EN{(float*)(ws + WS_GATES)}; pg8::gemm_phase<pg8::EpiNull, pg8::StaticOrder, true, PG8_SP2, false>(lds + RING_OFF, g, S, EN, w0); }
                pg8::gemm_phase<pg8::EpiRes, pg8::StaticOrder, true, PG8_SP2, false>(lds + RING_OFF, g, S, E, w0);
            }
        }
        LAYER_BAR();
    }
    {
        kargs_t ka = kargs(); unsigned char* ws = ka->ws;
        const int ng = grouped ? 8 : 1, gx = bid % ng, gy = bid / ng, Gy = G / ng;
        final_ln((const bf16*)(ws + WS_R), (const float*)(ws + WS_SP), ka->ln_g + (size_t)(3 * DEPTH - 1) * D, ka->ln_b + (size_t)(3 * DEPTH - 1) * D, ka->out, ng, gx, gy * NWAVES + w0, Gy * NWAVES, pg8::pg8_lane());
    }
}

extern "C" void kernel_launch(void* const* d_in, const int* in_sizes, int n_in, void* d_out, int out_size, void* d_ws, size_t ws_size, hipStream_t stream) {
    static int grid = 0;
    if (grid == 0) {
        if (n_in != 12 || in_sizes[0] != M * D || out_size != M * D || ws_size < WS_END) { fprintf(stderr, "kernel_launch: unexpected shapes / workspace (n_in %d, ws %zu < %zu); nothing launched\n", n_in, ws_size, (size_t)WS_END); grid = -1; return; }
        int dev = 0, cus = 0;
        if (hipGetDevice(&dev) != hipSuccess || hipDeviceGetAttribute(&cus, hipDeviceAttributeMultiprocessorCount, dev) != hipSuccess) { grid = -1; return; }
        if (hipFuncSetAttribute((const void*)fwd_kernel, hipFuncAttributeMaxDynamicSharedMemorySize, LDS_BYTES) != hipSuccess) { fprintf(stderr, "kernel_launch: hipFuncSetAttribute failed\n"); grid = -1; return; }
        int per_cu = 0;
        if (hipOccupancyMaxActiveBlocksPerMultiprocessor(&per_cu, (const void*)fwd_kernel, NWAVES * 64, LDS_BYTES) != hipSuccess || per_cu < 1) { fprintf(stderr, "kernel_launch: occupancy query says %d\n", per_cu); }
        (void)hipGetLastError();
        grid = cus;
    }
    if (grid < 0) return;
    (void)hipMemsetAsync((char*)d_ws + WS_CTL, 0, CTL_ZERO_BYTES, stream);
    Args a{};
    a.x = (const float*)d_in[0]; a.w1 = (const float*)d_in[1]; a.w3 = (const float*)d_in[2]; a.w2 = (const float*)d_in[3]; a.ln_g = (const float*)d_in[4]; a.ln_b = (const float*)d_in[5];
    a.wqkv = (const float*)d_in[6]; a.sinks = (const float*)d_in[7]; a.wo = (const float*)d_in[8]; a.win = (const float*)d_in[9]; a.bg = (const float*)d_in[10]; a.wmo = (const float*)d_in[11];
    a.out = (float*)d_out; a.ws = (unsigned char*)d_ws;
    hipLaunchKernelGGL(fwd_kernel, dim3(grid), dim3(NWAVES * 64), LDS_BYTES, stream, a);
}
```

```cpp
#include <hip/hip_runtime.h>
#include <hip/hip_bf16.h>
#include <cstdio>
#include <cstdint>
#include <cmath>

constexpr int BATCH = 8, SEQ = 2048, D = 2048, FF = 5632, DEPTH = 4;
constexpr int M = BATCH * SEQ;
constexpr int NUP = 2 * FF;
constexpr int NQKV = 2560;
constexpr int NMI = 6144, NMIW = 6152;
constexpr float LN_EPS = 1e-5f;
constexpr float ALPHA = 1.681792830507429f;
constexpr float LOG2E = 1.4426950408889634f;

constexpr size_t MiB = 1u << 20;
constexpr size_t WS_CTL = 0, CTL_ZERO_BYTES = 192 * 1024;
constexpr size_t WS_W13 = 2 * MiB;
constexpr size_t WS_W2 = 178 * MiB;
constexpr size_t WS_WQKV = 266 * MiB;
constexpr size_t WS_WO = 286 * MiB;
constexpr size_t WS_WIN = 302 * MiB;
constexpr size_t WS_WMO = 350 * MiB;
constexpr size_t WS_VEC = 366 * MiB;
constexpr size_t V_C1U = 0, V_C2U = 360448, V_C1Q = 720896, V_C2Q = 741376, V_C1I = 761856, V_C2I = 811008, V_CG = 860160, V_WG = 860416, V_ONES = 991488, V_ZEROS = 999680;
constexpr size_t WS_R = 368 * MiB;
constexpr size_t WS_R8 = 432 * MiB;
constexpr size_t WS_SP = 464 * MiB;
constexpr size_t SP_BYTES = (size_t)M * 16 * 4;
constexpr size_t WS_H = 466 * MiB;
constexpr size_t WS_QKV = 554 * MiB;
constexpr size_t WS_AO = 634 * MiB;
constexpr size_t WS_MP = 698 * MiB;
constexpr size_t WS_GATES = 890 * MiB;
constexpr size_t WS_HG = 891 * MiB;
constexpr size_t WS_END = 955 * MiB;
constexpr int CW_TMO = 0, CW_BAR = 4096;

struct Args { const float* x; const float* w1; const float* w3; const float* w2; const float* ln_g; const float* ln_b; const float* wqkv; const float* sinks; const float* wo;
              const float* win; const float* bg; const float* wmo; float* out; unsigned char* ws; };
typedef const __attribute__((address_space(4))) Args* kargs_t;
__device__ __forceinline__ kargs_t kargs() { kargs_t p = (kargs_t)__builtin_amdgcn_kernarg_segment_ptr(); asm volatile("" : "+s"(p)); return p; }

namespace pg8 {
#define PG8_LAS __attribute__((address_space(3)))
typedef unsigned short bf16_t;
typedef short bf16x8 __attribute__((ext_vector_type(8)));
typedef _Float16 f16x8 __attribute__((ext_vector_type(8)));
typedef float f32x4 __attribute__((ext_vector_type(4)));
typedef unsigned u32x4 __attribute__((ext_vector_type(4)));
constexpr int BM = 256, BK = 64, HALF = 128, HTB = HALF * BK * 2  , STAGE_BYTES = 8 * HTB, NXCD = 8, WGM = 8;

__host__ __device__ __forceinline__ int lds_byte(int r, int c) { const int st = (r >> 4) * 2 + (c >> 5), rr = r & 15, cc = c & 31, ob = rr * 64 + cc * 2; return st * 1024 + (ob ^ (((ob >> 9) & 1) << 5)); }
__host__ __device__ __forceinline__ void stage_rc(int b, int& R, int& C) { const int st = b / 1024, sb = b % 1024, swz = sb ^ (((sb >> 9) & 1) << 5); R = (st >> 1) * 16 + swz / 64; C = (st & 1) * 32 + (swz % 64) / 2; }
__host__ __device__ __forceinline__ int perm32(int rho) { const int n = rho >> 4, i = rho & 15; return 8 * (i >> 2) + 4 * n + (i & 3); }

typedef int i32x4 __attribute__((ext_vector_type(4)));
typedef int i32x8 __attribute__((ext_vector_type(8)));
constexpr float F8_SR = 8.f, F8_SW = 1024.f, F8_SH = 16.f, F8_SO = 64.f;
__device__ __forceinline__ i32x8 cat_i8(bf16x8 lo, bf16x8 hi) { const i32x4 a = __builtin_bit_cast(i32x4, lo), b = __builtin_bit_cast(i32x4, hi); return __builtin_shufflevector(a, b, 0, 1, 2, 3, 4, 5, 6, 7); }
__device__ __forceinline__ void mfma_f8_inplace(f32x4& c, const i32x8 a, const i32x8 b) { asm volatile("v_mfma_f32_16x16x128_f8f6f4 %0, %1, %2, %0 cbsz:0 blgp:0" : "+v"(c) : "v"(a), "v"(b)); }
typedef unsigned u32x2 __attribute__((ext_vector_type(2)));
__device__ __forceinline__ u32x2 cvt8_f8(const float (&v)[8], float s) {
    int a, b; asm volatile("" : "=v"(a), "=v"(b));
    a = __builtin_amdgcn_cvt_pk_fp8_f32(v[0] * s, v[1] * s, a, false); a = __builtin_amdgcn_cvt_pk_fp8_f32(v[2] * s, v[3] * s, a, true);
    b = __builtin_amdgcn_cvt_pk_fp8_f32(v[4] * s, v[5] * s, b, false); b = __builtin_amdgcn_cvt_pk_fp8_f32(v[6] * s, v[7] * s, b, true);
    return (u32x2){(unsigned)a, (unsigned)b};
}
__device__ __forceinline__ int pg8_lane() { int l; asm volatile("v_mbcnt_lo_u32_b32 %0, -1, 0\n\tv_mbcnt_hi_u32_b32 %0, -1, %0" : "=v"(l)); return l; }
struct Unit { int pm, pn; };
struct Gemm { const bf16_t* A; const bf16_t* Bt; int M, N, K; };

struct StaticOrder {
    int nM, nN, nwg, G, c, r0 = 0, r1 = 1 << 20;
    __host__ __device__ void init(int M_, int N_, int G_, int c_) { nM = M_ / BM; nN = N_ / BM; nwg = nM * nN; G = G_; c = c_; }
    __host__ __device__ bool next(int i, Unit& u) const {
        i += r0; if (i >= r1) return false;
        const long L = (long)i * G + c; if (L >= nwg) return false;
        int wgid = (int)L; { const int q = nwg / NXCD, r = nwg % NXCD, xcd = wgid % NXCD, off = wgid / NXCD; wgid = (xcd < r ? xcd * (q + 1) : r * (q + 1) + (xcd - r) * q) + off; }
        const int nig = WGM * nN, gid = wgid / nig, fm = gid * WGM, gsz = (nM - fm) < WGM ? (nM - fm) : WGM;
        u.pm = fm + ((wgid % nig) % gsz); u.pn = (wgid % nig) / gsz; return true;
    }
    __device__ __forceinline__ void a_ready(const Unit&) const {}
    __device__ __forceinline__ void done(const Unit&) const {}
};

__device__ __forceinline__ unsigned cvt_pk_bf16(float lo, float hi) { typedef float f2 __attribute__((ext_vector_type(2))); typedef _Float16 b2 __attribute__((ext_vector_type(2))); f2 v = {lo, hi}; b2 b = __builtin_convertvector(v, b2); return __builtin_bit_cast(unsigned, b); }
__device__ __forceinline__ float bf_lo(unsigned w) { typedef _Float16 b2 __attribute__((ext_vector_type(2))); return (float)__builtin_bit_cast(b2, w)[0]; }
__device__ __forceinline__ float bf_hi(unsigned w) { typedef _Float16 b2 __attribute__((ext_vector_type(2))); return (float)__builtin_bit_cast(b2, w)[1]; }
__device__ __forceinline__ float fsigmoid(float x) { return __builtin_amdgcn_rcpf(1.f + __builtin_amdgcn_exp2f(-LOG2E * x)); }

__device__ __forceinline__ float sum_fq(float v) {
    auto a = __builtin_amdgcn_permlane16_swap(__float_as_uint(v), __float_as_uint(v), false, false); v = __uint_as_float(a[0]) + __uint_as_float(a[1]);
    auto b = __builtin_amdgcn_permlane32_swap(__float_as_uint(v), __float_as_uint(v), false, false); return __uint_as_float(b[0]) + __uint_as_float(b[1]);
}
constexpr int STAB_OFF = 131072 + 16384;
__device__ __forceinline__ void stats_prep(const float* sp, int pm, int wave) {
    PG8_LAS float* stab = (PG8_LAS float*)(STAB_OFF);
    const int tid = wave * 64 + pg8_lane();
    if (tid < BM) {
        const f32x4* p = (const f32x4*)(sp + (size_t)(pm * BM + tid) * 16);
        const f32x4 v0 = p[0], v1 = p[1], v2 = p[2], v3 = p[3];
        const float s = ((v0[0] + v0[2]) + (v1[0] + v1[2])) + ((v2[0] + v2[2]) + (v3[0] + v3[2])), q = ((v0[1] + v0[3]) + (v1[1] + v1[3])) + ((v2[1] + v2[3]) + (v3[1] + v3[3]));
        const float mean = s * (1.f / D), var = q * (1.f / D) - mean * mean;
        typedef float f32x2v __attribute__((ext_vector_type(2)));
        *(PG8_LAS f32x2v*)(stab + 2 * tid) = (f32x2v){mean, __builtin_amdgcn_rsqf(var + LN_EPS)};
    }
    if (tid == 0) *(PG8_LAS int*)(stab + 2 * BM) = pm;
}
__device__ __forceinline__ void row_stats(const float* sp, int row0, int fq, float (&mu)[2][4], float (&rs)[2][4]) {
    { PG8_LAS const float* stab = (PG8_LAS const float*)(STAB_OFF); const int pm = row0 / BM;
      if (*(PG8_LAS const int*)(stab + 2 * BM) == pm) {
          typedef float f32x2v __attribute__((ext_vector_type(2)));
#pragma unroll
          for (int ai = 0; ai < 2; ++ai)
#pragma unroll
              for (int m = 0; m < 4; ++m) { const f32x2v v = *(PG8_LAS const f32x2v*)(stab + 2 * ((row0 % BM) + ai * HALF + m * 16)); mu[ai][m] = v[0]; rs[ai][m] = v[1]; }
          return; } }
#pragma unroll
    for (int ai = 0; ai < 2; ++ai)
#pragma unroll
        for (int m = 0; m < 4; ++m) {
            const f32x4 v = *(const f32x4*)(sp + (size_t)(row0 + ai * HALF + m * 16) * 16 + fq * 4);
            float s = v[0] + v[2], q = v[1] + v[3];
            s = sum_fq(s); q = sum_fq(q);
            const float mean = s * (1.f / D), var = q * (1.f / D) - mean * mean;
            mu[ai][m] = mean; rs[ai][m] = __builtin_amdgcn_rsqf(var + LN_EPS);
        }
}

struct EpiNull {
    static constexpr bool PERM = true, AFTER_DRAIN = false;
    __device__ __forceinline__ void prep(const Unit&, int) const {}
    float* sink;
    __device__ __forceinline__ void operator()(const f32x4 (&acc)[2][2][4][2], const Unit& u, int wr, int wc, int, int) const {
        float s = 0.f;
#pragma unroll
        for (int ai = 0; ai < 2; ++ai)
#pragma unroll
            for (int bj = 0; bj < 2; ++bj)
#pragma unroll
                for (int m = 0; m < 4; ++m)
#pragma unroll
                    for (int n = 0; n < 2; ++n) s += acc[ai][bj][m][n][0] + acc[ai][bj][m][n][1] + acc[ai][bj][m][n][2] + acc[ai][bj][m][n][3];
        if (s == 123.456f) sink[u.pm + wr + wc] = s;
    }
};

struct EpiUp {
    static constexpr bool PERM = true, AFTER_DRAIN = false;
    __device__ __forceinline__ void prep(const Unit& u, int wave) const { stats_prep((const float*)(kargs()->ws + WS_SP) + (size_t)tpar * (SP_BYTES / 4), u.pm, wave); }
    int f, tpar;
    __device__ __forceinline__ void operator()(const f32x4 (&acc)[2][2][4][2], const Unit& u, int wr, int wc, int, int) const {
        const int lane_ = pg8_lane(), fr = lane_ & 15, fq = lane_ >> 4;
        const int row0 = u.pm * BM + wr * 64 + fr;
        int f = this->f, tpar = this->tpar; asm volatile("" : "+s"(f), "+s"(tpar));
        unsigned char* ws = kargs()->ws; unsigned char* H = ws + WS_H;
        const float* c1 = (const float*)(ws + WS_VEC + V_C1U) + (size_t)f * NUP; const float* c2 = (const float*)(ws + WS_VEC + V_C2U) + (size_t)f * NUP; const float* sp = (const float*)(ws + WS_SP) + (size_t)tpar * (SP_BYTES / 4);
        float mu[2][4], rs[2][4]; row_stats(sp, row0, fq, mu, rs);
        const int cb = u.pn * BM + wc * 32 + 8 * fq;
        f32x4 k1[2][2], k2[2][2];
#pragma unroll
        for (int bj = 0; bj < 2; ++bj)
#pragma unroll
            for (int n = 0; n < 2; ++n) { k1[bj][n] = *(const f32x4*)(c1 + cb + bj * HALF + 4 * n); k2[bj][n] = *(const f32x4*)(c2 + cb + bj * HALF + 4 * n); }
        unsigned char* hp = H + (size_t)row0 * FF + u.pn * HALF + wc * 32 + 8 * fq;
#pragma unroll
        for (int ai = 0; ai < 2; ++ai)
#pragma unroll
            for (int m = 0; m < 4; ++m) {
                const float r_ = rs[ai][m], nm = -mu[ai][m] * r_, ra = r_ * (1.f / (F8_SR * F8_SW));
                float hv[8];
#pragma unroll
                for (int n = 0; n < 2; ++n)
#pragma unroll
                    for (int j = 0; j < 4; ++j) {
                        const float ga = acc[ai][0][m][n][j] * ra + (nm * k1[0][n][j] + k2[0][n][j]);
                        const float ub = acc[ai][1][m][n][j] * ra + (nm * k1[1][n][j] + k2[1][n][j]);
                        hv[4 * n + j] = ga * fsigmoid(ga) * ub;
                    }
                *(u32x2*)(hp + (size_t)(ai * HALF + m * 16) * FF) = cvt8_f8(hv, F8_SH);
            }
    }
};

struct EpiLnOut {
    static constexpr bool PERM = true, AFTER_DRAIN = false;
    __device__ __forceinline__ void prep(const Unit& u, int wave) const { stats_prep((const float*)(kargs()->ws + WS_SP) + (size_t)tpar * (SP_BYTES / 4), u.pm, wave); }
    int mode, j, tpar;
    __device__ __forceinline__ void operator()(const f32x4 (&acc)[2][2][4][2], const Unit& u, int wr, int wc, int, int) const {
        const int lane_ = pg8_lane(), fr = lane_ & 15, fq = lane_ >> 4;
        const int row0 = u.pm * BM + wr * 64 + fr;
        int mode = this->mode, j = this->j, tpar = this->tpar; asm volatile("" : "+s"(mode), "+s"(j), "+s"(tpar));
        const bool att = mode == 0; const int coff = mode == 2 ? 4096 : 0;
        unsigned char* ws = kargs()->ws; bf16_t* O = (bf16_t*)(ws + (att ? WS_QKV : WS_MP)) + coff; const int ldo = att ? NQKV : NMI, sig_from = mode == 2 ? 0 : (mode == 1 ? 16 : 1000);
        const float ascale = mode == 1 ? 1.f : 1.f / (F8_SR * F8_SW);
        const float* c1 = (const float*)(ws + WS_VEC + (att ? V_C1Q : V_C1I)) + j * ldo + coff; const float* c2 = (const float*)(ws + WS_VEC + (att ? V_C2Q : V_C2I)) + j * ldo + coff; const float* sp = (const float*)(ws + WS_SP) + (size_t)tpar * (SP_BYTES / 4);
        float mu[2][4], rs[2][4]; row_stats(sp, row0, fq, mu, rs);
        const int cb = u.pn * BM + wc * 32 + 8 * fq;
        const bool sg = u.pn >= sig_from;
        f32x4 k1[2][2], k2[2][2];
#pragma unroll
        for (int bj = 0; bj < 2; ++bj)
#pragma unroll
            for (int n = 0; n < 2; ++n) { k1[bj][n] = *(const f32x4*)(c1 + cb + bj * HALF + 4 * n); k2[bj][n] = *(const f32x4*)(c2 + cb + bj * HALF + 4 * n); }
        bf16_t* op = O + (size_t)row0 * ldo + cb;
#pragma unroll
        for (int ai = 0; ai < 2; ++ai)
#pragma unroll
            for (int m = 0; m < 4; ++m) {
                const float r_ = rs[ai][m], nm = -mu[ai][m] * r_, ra = r_ * ascale;
#pragma unroll
                for (int bj = 0; bj < 2; ++bj) {
                    float v[8];
#pragma unroll
                    for (int n = 0; n < 2; ++n)
#pragma unroll
                        for (int j = 0; j < 4; ++j) { float t = acc[ai][bj][m][n][j] * ra + (nm * k1[bj][n][j] + k2[bj][n][j]); if (sg) t = fsigmoid(t); v[4 * n + j] = t; }
                    u32x4 w; w.x = cvt_pk_bf16(v[0], v[1]); w.y = cvt_pk_bf16(v[2], v[3]); w.z = cvt_pk_bf16(v[4], v[5]); w.w = cvt_pk_bf16(v[6], v[7]);
                    *(u32x4*)(op + (size_t)(ai * HALF + m * 16) * ldo + bj * HALF) = w;
                }
            }
    }
};

struct EpiRes {
    static constexpr bool PERM = true, AFTER_DRAIN = false;
    __device__ __forceinline__ void prep(const Unit& u, int wave) const { stats_prep((const float*)(kargs()->ws + WS_SP) + (size_t)(t & 1) * (SP_BYTES / 4), u.pm, wave); }
    int t; float coef; PG8_LAS float* tab; int wave; int dry;
    __device__ __forceinline__ void operator()(const f32x4 (&acc)[2][2][4][2], const Unit& u, int wr, int wc, int, int) const {
        const int lane_ = pg8_lane(), fr = lane_ & 15, fq = lane_ >> 4;
        typedef float f32x2v __attribute__((ext_vector_type(2)));
        const int row0 = u.pm * BM + wr * 64 + fr;
        int t = this->t; asm volatile("" : "+s"(t));
        const bool need8 = (t != 3 && t != 9 && t != 11) || dry;
        kargs_t ka = kargs(); unsigned char* ws = ka->ws; bf16_t* R = (bf16_t*)(ws + WS_R); unsigned char* R8 = ws + (dry ? WS_MP + 64 * MiB : WS_R8); bf16_t* Ro = dry ? (bf16_t*)(ws + WS_MP) : R;
        const float* g = t ? ka->ln_g + (size_t)(t - 1) * D : (const float*)(ws + WS_VEC + V_ONES); const float* b = t ? ka->ln_b + (size_t)(t - 1) * D : (const float*)(ws + WS_VEC + V_ZEROS);
        const float* sp_in = (const float*)(ws + WS_SP) + (size_t)(t & 1) * (SP_BYTES / 4); float* sp_out = dry ? (float*)(ws + WS_MP + 96 * MiB) : (float*)(ws + WS_SP) + (size_t)((t + 1) & 1) * (SP_BYTES / 4);
        const int cb0 = u.pn * BM + wc * 32 + 8 * fq;
        u32x4 cur[4];
#pragma unroll
        for (int m = 0; m < 4; ++m) cur[m] = *(const u32x4*)(R + (size_t)(row0 + m * 16) * D + cb0);
        float mu[2][4], rs[2][4]; row_stats(sp_in, row0, fq, mu, rs);
        f32x4 gv[2], bv[2];
#pragma unroll
        for (int k = 0; k < 4; ++k) {
            const int bj = k >> 1, ai = k & 1, cb = cb0 + bj * HALF;
            if (ai == 0) {
#pragma unroll
                for (int n = 0; n < 2; ++n) { gv[n] = *(const f32x4*)(g + cb + 4 * n); bv[n] = *(const f32x4*)(b + cb + 4 * n) * ALPHA; }
            }
#pragma unroll
            for (int m = 0; m < 4; ++m) {
                const float A_ = ALPHA * rs[ai][m], B_ = -mu[ai][m] * A_;
                const size_t off = (size_t)(row0 + ai * HALF + m * 16) * D + cb;
                const u32x4 o = cur[m];
                if (k < 3 && dry != 3) cur[m] = *(const u32x4*)(R + (size_t)(row0 + ((k + 1) & 1) * HALF + m * 16) * D + cb0 + ((k + 1) >> 1) * HALF);
                const float ro[8] = {bf_lo(o.x), bf_hi(o.x), bf_lo(o.y), bf_hi(o.y), bf_lo(o.z), bf_hi(o.z), bf_lo(o.w), bf_hi(o.w)};
                float nv[8];
#pragma unroll
                for (int n = 0; n < 2; ++n)
#pragma unroll
                    for (int j = 0; j < 4; ++j) nv[4 * n + j] = (ro[4 * n + j] * A_ + B_) * gv[n][j] + bv[n][j] + coef * acc[ai][bj][m][n][j];
                u32x4 w; w.x = cvt_pk_bf16(nv[0], nv[1]); w.y = cvt_pk_bf16(nv[2], nv[3]); w.z = cvt_pk_bf16(nv[4], nv[5]); w.w = cvt_pk_bf16(nv[6], nv[7]);
                if (dry != 2) { *(u32x4*)(Ro + off) = w;
                if (need8) *(u32x2*)(R8 + off) = cvt8_f8(nv, F8_SR); }
                const float f0 = bf_lo(w.x), f1 = bf_hi(w.x), f2 = bf_lo(w.y), f3 = bf_hi(w.y), f4 = bf_lo(w.z), f5 = bf_hi(w.z), f6 = bf_lo(w.w), f7 = bf_hi(w.w);
                float s = ((f0 + f1) + (f2 + f3)) + ((f4 + f5) + (f6 + f7));
                float q = ((f0 * f0 + f1 * f1) + (f2 * f2 + f3 * f3)) + ((f4 * f4 + f5 * f5) + (f6 * f6 + f7 * f7));
                s = sum_fq(s); q = sum_fq(q);
                if (fq == 0) *(PG8_LAS f32x2v*)(tab + (((ai * HALF + wr * 64 + m * 16 + fr) * 4 + wc) * 2 + bj) * 2) = (f32x2v){s, q};
                asm volatile("" ::: "memory");
            }
        }
        asm volatile("s_waitcnt lgkmcnt(0)" ::: "memory"); __builtin_amdgcn_s_barrier(); asm volatile("" ::: "memory");
        const int tid = wave * 64 + pg8_lane();
        if (tid < BM) {
            const PG8_LAS f32x4* t4 = (const PG8_LAS f32x4*)(tab + tid * 16);
            const f32x4 a = t4[0], c = t4[1], d = t4[2], e = t4[3];
            *(f32x2v*)(sp_out + (size_t)(u.pm * BM + tid) * 16 + u.pn * 2) = (f32x2v){((a[0] + a[2]) + (c[0] + c[2])) + ((d[0] + d[2]) + (e[0] + e[2])), ((a[1] + a[3]) + (c[1] + c[3])) + ((d[1] + d[3]) + (e[1] + e[3]))};
        }
    }
};

template <class Epi, class Sched, bool ALIGN_EPI = false, bool SP2 = false, bool F8 = false>
__device__ __forceinline__ void gemm_phase(PG8_LAS unsigned char* lds, const Gemm g, const Sched& S, const Epi& E, int wave_in) {
    int wid = wave_in; asm volatile("" : "+s"(wid));
    const int lane = pg8_lane(), tid = wid * 64 + lane, wr = wid >> 2, wc = wid & 3, fr = lane & 15, fq = lane >> 4;
    const int K = g.K, nt = K / BK;
    unsigned voffA[2], voffB[2];
#pragma unroll
    for (int i = 0; i < 2; ++i) { int R, C; stage_rc(tid * 16 + i * 8192, R, C); const int Rb = Epi::PERM ? ((R & ~31) + perm32(R & 31)) : R;
        voffA[i] = (unsigned)(R * K + C) * 2u; voffB[i] = (unsigned)(Rb * K + C) * 2u; }
    const size_t kstep = (size_t)(BK * 2);
    const size_t hstep = (size_t)HALF * K * 2;
    const size_t tstep = 2 * hstep;
    const unsigned ldsw = (unsigned)wid * 1024u;
    const int aoff = lds_byte(wr * 64 + fr, fq * 8), boff = lds_byte(wc * 32 + fr, fq * 8);
#define PG8_SA(b, h) (((b) * 2 + (h)) * HTB)
#define PG8_SB(b, h) ((4 + (b) * 2 + (h)) * HTB)
#define PG8_STAGE(bufoff, gbase, voff) do { _Pragma("unroll") for (int _i = 0; _i < 2; ++_i) \
        __builtin_amdgcn_global_load_lds((const unsigned*)((const char*)(gbase) + (voff)[_i]), (PG8_LAS unsigned*)(lds + (bufoff) + ldsw + _i * 8192), 16, 0, 0); } while (0)
#define PG8_LDA(dst, b, h) do { _Pragma("unroll") for (int m = 0; m < 4; ++m) _Pragma("unroll") for (int k = 0; k < 2; ++k) dst[m][k] = *(const PG8_LAS bf16x8*)(lds + PG8_SA(b, h) + aoff + m * 2048 + k * 1024); } while (0)
#define PG8_LDB(dst, b, h) do { _Pragma("unroll") for (int n = 0; n < 2; ++n) _Pragma("unroll") for (int k = 0; k < 2; ++k) dst[n][k] = *(const PG8_LAS bf16x8*)(lds + PG8_SB(b, h) + boff + n * 2048 + k * 1024); } while (0)
#define PG8_MMA(ai, bj, At, Bt) do { __builtin_amdgcn_s_setprio(1); _Pragma("unroll") for (int m = 0; m < 4; ++m) _Pragma("unroll") for (int n = 0; n < 2; ++n) { \
        if constexpr (F8) mfma_f8_inplace(acc[ai][bj][m][n], cat_i8(Bt[n][0], Bt[n][1]), cat_i8(At[m][0], At[m][1])); \
        else { _Pragma("unroll") for (int k = 0; k < 2; ++k) acc[ai][bj][m][n] = __builtin_amdgcn_mfma_f32_16x16x32_f16(__builtin_bit_cast(f16x8, Bt[n][k]), __builtin_bit_cast(f16x8, At[m][k]), acc[ai][bj][m][n], 0, 0, 0); } } \
        __builtin_amdgcn_s_setprio(0); } while (0)
#define PG8_WAIT_V(n) asm volatile("s_waitcnt vmcnt(" #n ")" ::: "memory")
#define PG8_WAIT_L(n) asm volatile("s_waitcnt lgkmcnt(" #n ")" ::: "memory")
#define PG8_BAR __builtin_amdgcn_s_barrier()
#define PG8_SCHED __builtin_amdgcn_sched_barrier(0)
    Unit cur, nxt; int ui = 0;
    if (!S.next(0, cur)) return;
    E.prep(cur, wave_in);
    f32x4 acc[2][2][4][2];
#pragma unroll
    for (int a = 0; a < 2; ++a)
#pragma unroll
        for (int b = 0; b < 2; ++b)
#pragma unroll
            for (int m = 0; m < 4; ++m)
#pragma unroll
                for (int n = 0; n < 2; ++n) { float z0, z1, z2, z3; asm volatile("v_mov_b32 %0, 0\n\tv_mov_b32 %1, 0\n\tv_mov_b32 %2, 0\n\tv_mov_b32 %3, 0" : "=v"(z0), "=v"(z1), "=v"(z2), "=v"(z3)); acc[a][b][m][n] = (f32x4){z0, z1, z2, z3}; }
    bf16x8 At[4][2], B0[2][2], B1[2][2];
    const char* cA = (const char*)g.A + (size_t)cur.pm * tstep; const char* cB = (const char*)g.Bt + (size_t)cur.pn * tstep;
    S.a_ready(cur);
    if constexpr (SP2) {
        PG8_STAGE(PG8_SB(0, 0), cB, voffB); PG8_STAGE(PG8_SB(0, 1), cB + hstep, voffB); PG8_STAGE(PG8_SA(0, 0), cA, voffA); PG8_STAGE(PG8_SA(0, 1), cA + hstep, voffA);
        if (wr == 1) PG8_BAR;
        PG8_WAIT_V(2); PG8_BAR;
        PG8_STAGE(PG8_SB(1, 0), cB + kstep, voffB); PG8_STAGE(PG8_SA(1, 0), cA + kstep, voffA); PG8_STAGE(PG8_SB(1, 1), cB + hstep + kstep, voffB);
        PG8_WAIT_V(6); PG8_BAR;
    } else {
        PG8_STAGE(PG8_SB(0, 0), cB, voffB); PG8_STAGE(PG8_SA(0, 0), cA, voffA); PG8_STAGE(PG8_SB(0, 1), cB + hstep, voffB); PG8_STAGE(PG8_SA(0, 1), cA + hstep, voffA);
        if (wr == 1) PG8_BAR;
        PG8_WAIT_V(4); PG8_BAR;
        PG8_STAGE(PG8_SB(1, 0), cB + kstep, voffB); PG8_STAGE(PG8_SA(1, 0), cA + kstep, voffA); PG8_STAGE(PG8_SB(1, 1), cB + hstep + kstep, voffB);
        PG8_WAIT_V(6); PG8_BAR;
    }
    for (;;) {
        const bool has_next = S.next(ui + 1, nxt);
        const char* nA = has_next ? (const char*)g.A + (size_t)nxt.pm * tstep : cA; const char* nB = has_next ? (const char*)g.Bt + (size_t)nxt.pn * tstep : cB;
        for (int t = 0; t < nt; t += 2) {
            const bool last = (t == nt - 2);
            const char* a1 = cA + (size_t)(t + 1) * kstep;
            const char* a2 = last ? nA : cA + (size_t)(t + 2) * kstep; const char* b2 = last ? nB : cB + (size_t)(t + 2) * kstep;
            const char* a3 = a2 + kstep; const char* b3 = b2 + kstep;
            if (last && has_next) S.a_ready(nxt);
            if constexpr (SP2) {
            PG8_LDB(B0, 0, 0); PG8_LDB(B1, 0, 1); PG8_SCHED; PG8_LDA(At, 0, 0); PG8_STAGE(PG8_SA(1, 1), a1 + hstep, voffA);
            PG8_WAIT_V(8); PG8_WAIT_L(0); PG8_BAR; PG8_MMA(0, 0, At, B0); PG8_MMA(0, 1, At, B1); PG8_BAR; PG8_SCHED;
            PG8_LDA(At, 0, 1); PG8_STAGE(PG8_SB(0, 0), b2, voffB); PG8_STAGE(PG8_SB(0, 1), b2 + hstep, voffB); PG8_STAGE(PG8_SA(0, 0), a2, voffA);
            PG8_WAIT_V(8); PG8_WAIT_L(0); PG8_BAR; PG8_MMA(1, 0, At, B0); PG8_MMA(1, 1, At, B1); PG8_BAR; PG8_SCHED;
            PG8_LDB(B0, 1, 0); PG8_LDB(B1, 1, 1); PG8_SCHED; PG8_LDA(At, 1, 0); PG8_STAGE(PG8_SA(0, 1), a2 + hstep, voffA);
            PG8_WAIT_V(8); PG8_WAIT_L(0); PG8_BAR; PG8_MMA(0, 0, At, B0); PG8_MMA(0, 1, At, B1); PG8_BAR; PG8_SCHED;
            PG8_LDA(At, 1, 1); PG8_STAGE(PG8_SB(1, 0), b3, voffB); PG8_STAGE(PG8_SB(1, 1), b3 + hstep, voffB); PG8_STAGE(PG8_SA(1, 0), a3, voffA);
            PG8_WAIT_V(8); PG8_WAIT_L(0); PG8_BAR; PG8_MMA(1, 0, At, B0); PG8_MMA(1, 1, At, B1); PG8_BAR; PG8_SCHED;
            } else {
            PG8_LDB(B0, 0, 0); PG8_SCHED; PG8_LDA(At, 0, 0); PG8_STAGE(PG8_SA(1, 1), a1 + hstep, voffA);
            PG8_WAIT_L(8); PG8_BAR; PG8_WAIT_L(0); PG8_MMA(0, 0, At, B0); PG8_BAR; PG8_SCHED;
            PG8_LDB(B1, 0, 1); PG8_STAGE(PG8_SB(0, 0), b2, voffB);
            PG8_BAR; PG8_WAIT_L(0); PG8_MMA(0, 1, At, B1); PG8_BAR;
            PG8_LDA(At, 0, 1); PG8_STAGE(PG8_SA(0, 0), a2, voffA);
            PG8_BAR; PG8_WAIT_L(0); PG8_MMA(1, 0, At, B0); PG8_BAR; PG8_SCHED;
            PG8_STAGE(PG8_SB(0, 1), b2 + hstep, voffB);
            PG8_WAIT_V(6); PG8_BAR; PG8_MMA(1, 1, At, B1); PG8_BAR;
            PG8_LDB(B0, 1, 0); PG8_SCHED; PG8_LDA(At, 1, 0); PG8_STAGE(PG8_SA(0, 1), a2 + hstep, voffA);
            PG8_WAIT_L(8); PG8_BAR; PG8_WAIT_L(0); PG8_MMA(0, 0, At, B0); PG8_BAR; PG8_SCHED;
            PG8_LDB(B1, 1, 1); PG8_STAGE(PG8_SB(1, 0), b3, voffB);
            PG8_BAR; PG8_WAIT_L(0); PG8_MMA(0, 1, At, B1); PG8_BAR;
            PG8_LDA(At, 1, 1); PG8_STAGE(PG8_SA(1, 0), a3, voffA);
            PG8_BAR; PG8_WAIT_L(0); PG8_MMA(1, 0, At, B0); PG8_BAR; PG8_SCHED;
            PG8_STAGE(PG8_SB(1, 1), b3 + hstep, voffB);
            PG8_WAIT_V(6); PG8_BAR; PG8_MMA(1, 1, At, B1); PG8_BAR;
            }
        }
        if constexpr (F8) asm volatile("s_nop 15\n\ts_nop 7" ::: "memory");
        if constexpr (ALIGN_EPI) { if (wr == 0) PG8_BAR; }
        if constexpr (!Epi::AFTER_DRAIN) { E(acc, cur, wr, wc, fr, fq); S.done(cur); }
        if (!has_next) break;
#pragma unroll
        for (int a = 0; a < 2; ++a)
#pragma unroll
            for (int b = 0; b < 2; ++b)
#pragma unroll
                for (int m = 0; m < 4; ++m)
#pragma unroll
                    for (int n = 0; n < 2; ++n) { float z0, z1, z2, z3; asm volatile("v_mov_b32 %0, 0\n\tv_mov_b32 %1, 0\n\tv_mov_b32 %2, 0\n\tv_mov_b32 %3, 0" : "=v"(z0), "=v"(z1), "=v"(z2), "=v"(z3)); acc[a][b][m][n] = (f32x4){z0, z1, z2, z3}; }
        cur = nxt; cA = nA; cB = nB; ++ui;
        if constexpr (ALIGN_EPI) { if (wr == 1) PG8_BAR; }
    }
    PG8_WAIT_V(0);
    if constexpr (!ALIGN_EPI) { if (wr == 0) PG8_BAR; }
    PG8_BAR;
    if constexpr (Epi::AFTER_DRAIN) { E.fused(acc, cur, wr, wc, fr, fq, lds, wid, lane); S.done(cur); }
#undef PG8_SA
#undef PG8_SB
#undef PG8_STAGE
#undef PG8_LDA
#undef PG8_LDB
#undef PG8_MMA
#undef PG8_WAIT_V
#undef PG8_WAIT_L
#undef PG8_BAR
#undef PG8_SCHED
}
}

#ifndef PG8_SP2
#define PG8_SP2 true
#endif

#define GAS __attribute__((address_space(1)))
#define LAS __attribute__((address_space(3)))
typedef unsigned short bf16;
typedef unsigned v4u __attribute__((ext_vector_type(4)));
typedef unsigned v2u __attribute__((ext_vector_type(2)));
typedef float f32x4 __attribute__((ext_vector_type(4)));
typedef float f32x2 __attribute__((ext_vector_type(2)));
typedef float f32x16 __attribute__((ext_vector_type(16)));
typedef short bf16x8 __attribute__((ext_vector_type(8)));
typedef short s16x4 __attribute__((ext_vector_type(4)));
typedef GAS unsigned gu32;
typedef GAS unsigned long long gu64;
typedef LAS const char* lcp;
typedef LAS char* lwp;
#define RLX_AGENT __ATOMIC_RELAXED, __HIP_MEMORY_SCOPE_AGENT
#define LDS_WAIT() asm volatile("s_waitcnt lgkmcnt(0)" ::: "memory")
#define VM_WAIT() asm volatile("s_waitcnt vmcnt(0)" ::: "memory")
#define WG_BAR() do { asm volatile("s_waitcnt vmcnt(0) lgkmcnt(0)" ::: "memory"); __builtin_amdgcn_s_barrier(); asm volatile("" ::: "memory"); } while (0)
#define DI __device__ __forceinline__
#define MFMA32(a, b, c) __builtin_amdgcn_mfma_f32_32x32x16_f16(__builtin_bit_cast(pg8::f16x8, (a)), __builtin_bit_cast(pg8::f16x8, (b)), (c), 0, 0, 0)
DI unsigned pk2(float lo, float hi) { return pg8::cvt_pk_bf16(lo, hi); }
DI float bflo(unsigned w) { return pg8::bf_lo(w); }
DI float bfhi(unsigned w) { return pg8::bf_hi(w); }
DI float ex2(float x) { return __builtin_amdgcn_exp2f(x); }
DI f32x16 zero16() { float z = 0.f; asm volatile("" : "+v"(z)); return (f32x16){z, z, z, z, z, z, z, z, z, z, z, z, z, z, z, z}; }
DI int crow(int r, int hi) { return (r & 3) + 8 * (r >> 2) + 4 * hi; }
#define SWZ_XOR(v, m) __uint_as_float((unsigned)__builtin_amdgcn_ds_swizzle((int)__float_as_uint(v), ((m) << 10) | 0x1f))
DI float half_swap_add(float v);
DI float wave_sum(float v) { v += SWZ_XOR(v, 1); v += SWZ_XOR(v, 2); v += SWZ_XOR(v, 4); v += SWZ_XOR(v, 8); v += SWZ_XOR(v, 16); return half_swap_add(v); }
DI float shfl_lane(float v, int src_lane) { return __uint_as_float((unsigned)__builtin_amdgcn_ds_bpermute(src_lane << 2, (int)__float_as_uint(v))); }
DI float half_swap_add(float v) { auto rr = __builtin_amdgcn_permlane32_swap(__float_as_uint(v), __float_as_uint(v), false, false); return __uint_as_float(rr[0]) + __uint_as_float(rr[1]); }
DI float half_swap_max(float v) { auto rr = __builtin_amdgcn_permlane32_swap(__float_as_uint(v), __float_as_uint(v), false, false); return fmaxf(__uint_as_float(rr[0]), __uint_as_float(rr[1])); }
typedef short v4i16_t __attribute__((ext_vector_type(4)));
DI s16x4 vtr(lcp p) { return __builtin_bit_cast(s16x4, __builtin_amdgcn_ds_read_tr16_b64_v4i16((LAS v4i16_t*)p)); }
DI bf16x8 cat8(s16x4 lo, s16x4 hi) { return (bf16x8){lo[0], lo[1], lo[2], lo[3], hi[0], hi[1], hi[2], hi[3]}; }
DI bf16x8 trfrag(lcp p) { return cat8(vtr(p), vtr(p + 512)); }
DI bf16x8 ldfrag(lcp p) { return *(const LAS bf16x8*)p; }
DI void glds16(const void* gsrc, LAS void* ldst) { __builtin_amdgcn_global_load_lds((const unsigned*)gsrc, (LAS unsigned*)ldst, 16, 0, 0); }
#define PACK8(x, s) ((bf16x8)__builtin_bit_cast(bf16x8, (v4u){pk2((x)[8 * (s) + 0], (x)[8 * (s) + 1]), pk2((x)[8 * (s) + 2], (x)[8 * (s) + 3]), pk2((x)[8 * (s) + 4], (x)[8 * (s) + 5]), pk2((x)[8 * (s) + 6], (x)[8 * (s) + 7])}))

constexpr int RING_OFF = 0, RING_BYTES = 131072;
constexpr int TAB_OFF = 131072;
constexpr int MISC_OFF = 163840 - 256;
constexpr int LDS_BYTES = 163840;
constexpr int AT_K = 0, AT_V = 32768, AT_WS = 65536, AT_STG = 67584;
constexpr int ML_K = 0, ML_V = 65536, ML_VW = 81920, ML_C = 98304, ML_N = 131072, ML_G2 = 131584, ML_M2 = 132096, ML_FI = 132608, ML_EI = 133120, ML_WK = 133632, ML_WKB = 134144, ML_SC = 134400, ML_WS = 134464, ML_STG = 136512;
static_assert(ML_STG + 4 * 4096 <= MISC_OFF && AT_STG + 8 * 4096 <= MISC_OFF && TAB_OFF + 16384 + 2048 + 64 <= MISC_OFF && pg8::STAB_OFF == TAB_OFF + 16384, "LDS map");

#define XB_TMO      128
#define XB_XCNT(j)  (256  + 64 * (j))
#define XB_XSUB(j)  (1280 + 64 * (j))
#define XB_XGEN(j)  (2304 + 64 * (j))
#define XB_TOP      3328
#define XB_TOPGEN   3392
#define XCD_BAR_WORDS 3456
#define XB_SPIN_CAP (1u << 18)

__device__ __forceinline__ unsigned xb_ld(unsigned* p)              { return __hip_atomic_load(p, __ATOMIC_RELAXED, __HIP_MEMORY_SCOPE_AGENT); }
__device__ __forceinline__ unsigned xb_add(unsigned* p, unsigned v) { return __hip_atomic_fetch_add(p, v, __ATOMIC_RELAXED, __HIP_MEMORY_SCOPE_AGENT); }
__device__ __forceinline__ unsigned xb_xcc_id() { return (unsigned)__builtin_amdgcn_s_getreg((3 << 11) | 20) & 0xFu; }
#define XB_SPIN(cond, bar) do { unsigned _sp = 0; while (cond) { __builtin_amdgcn_s_sleep(1); \
    if ((++_sp & 255u) == 0u) { if (xb_ld(&(bar)[XB_TMO])) break; if (_sp > XB_SPIN_CAP) { atomicAdd(&(bar)[XB_TMO], 1u); break; } } } } while (0)

struct XcdBarrier {
    unsigned* bar; unsigned x;
    volatile LAS unsigned* st;
    unsigned total;
};

__device__ __forceinline__ XcdBarrier xcd_barrier_post(unsigned* bar, volatile LAS unsigned* st) {
    XcdBarrier b; b.bar = bar; b.x = xb_xcc_id(); b.st = st; b.total = gridDim.x * gridDim.y * gridDim.z;
    if (threadIdx.x == 0) (void)xb_add(&bar[XB_XCNT(b.x)], 1u);
    return b;
}
__device__ __forceinline__ void xcd_barrier_complete(unsigned* bar, unsigned x, unsigned G, unsigned& nloc, unsigned& nx) {
    unsigned sum, cnt, mine, sp = 0u;
    for (;;) {
        sum = 0u; cnt = 0u; mine = 0u;
#pragma unroll
        for (unsigned j = 0; j < 16; ++j) { const unsigned c = xb_ld(&bar[XB_XCNT(j)]); sum += c; cnt += (c > 0u) ? 1u : 0u; mine = (j == x) ? c : mine; }
        if (sum == G) break;
        __builtin_amdgcn_s_sleep(1);
        if ((++sp & 255u) == 0u) { if (xb_ld(&bar[XB_TMO])) break; if (sp > XB_SPIN_CAP) { atomicAdd(&bar[XB_TMO], 1u); break; } }
    }
    nloc = mine > 0u ? mine : 1u; nx = cnt > 0u ? cnt : 1u;
}

__device__ __forceinline__ void xcd_barrier(const XcdBarrier& b) {
    asm volatile("s_waitcnt vmcnt(0)" ::: "memory");
    __syncthreads();
    if (threadIdx.x == 0) {
        unsigned* bar = b.bar;
        __builtin_amdgcn_s_waitcnt(0);
        unsigned nloc = b.st[0], nx = b.st[1];
        if (nloc == 0u) { xcd_barrier_complete(bar, b.x, b.total, nloc, nx); b.st[0] = nloc; b.st[1] = nx; }
        const unsigned old = xb_add(&bar[XB_XSUB(b.x)], 1u);
        const unsigned gen = old / nloc;
        if (old + 1u == (gen + 1u) * nloc) {
            __builtin_amdgcn_fence(__ATOMIC_RELEASE, "agent");
            asm volatile("s_waitcnt vmcnt(0)" ::: "memory");
            const unsigned og = xb_add(&bar[XB_TOP], 1u);
            const unsigned tg = og / nx;
            if (og + 1u == (tg + 1u) * nx) xb_add(&bar[XB_TOPGEN], 1u);
            else XB_SPIN(xb_ld(&bar[XB_TOPGEN]) == tg, bar);
            __builtin_amdgcn_fence(__ATOMIC_ACQUIRE, "agent");
            xb_add(&bar[XB_XGEN(b.x)], 1u);
            asm volatile("s_waitcnt vmcnt(0)" ::: "memory");
        } else {
            XB_SPIN(xb_ld(&bar[XB_XGEN(b.x)]) == gen, bar);
            __builtin_amdgcn_fence(__ATOMIC_ACQUIRE, "agent");
            asm volatile("s_waitcnt vmcnt(0)" ::: "memory");
        }
    }
    __syncthreads();
}
DI void attn_phase(unsigned char* ldsg, const bf16* QKV, unsigned char* AO8, const float* sinks, int ng, int gx, int gy, int Gy, int wave_in) {
    int wid = wave_in; asm volatile("" : "+s"(wid));
    const int lane = pg8::pg8_lane(), tid = wid * 64 + lane, r32 = lane & 31, hi = lane >> 5;
    LAS unsigned char* lds = (LAS unsigned char*)ldsg; const lcp L = (lcp)lds;
    LAS float* wsf = (LAS float*)(lds + AT_WS) + wid * 64;
    LAS unsigned char* stg = lds + AT_STG + wid * 4096;
    const lcp vlane = L + AT_V + ((lane >> 4) & 1) * 32 + (lane & 3) * 8 + (4 * hi + ((lane & 15) >> 2)) * 64;
    const lcp klane = L + AT_K + hi * 1024 + r32 * 16;
    for (int uu = gy; uu < 64 * (BATCH / ng); uu += Gy) { const int b = gx + ng * (uu >> 6), ul = uu & 63;
        const int kvh = ul & 3, nb = ul >> 2;
        const long rowq = (long)b * SEQ + nb * 128, rowk = rowq - 128;
        const int slot_lo = (nb == 0) ? 2 : 0;
        for (int sl = slot_lo; sl < 4; ++sl) {
            glds16(QKV + (rowk + 64 * sl + lane) * NQKV + 2048 + 64 * kvh + 8 * wid, lds + AT_K + sl * 8192 + wid * 1024);
            glds16(QKV + (rowk + 64 * sl + 16 * (wid & 3) + (lane >> 2)) * NQKV + 2304 + 64 * kvh + (wid >> 2) * 32 + (lane & 3) * 8, lds + AT_V + sl * 8192 + wid * 1024);
        }
        const int hq = 8 * kvh + wid;
        const bf16* qsrc = QKV + (rowq + r32) * NQKV + 64 * hq + 8 * hi;
        bf16x8 qn[4];
#pragma unroll
        for (int d0 = 0; d0 < 4; ++d0) qn[d0] = *(const bf16x8*)(qsrc + 16 * d0);
        const float slope2 = ex2(-0.25f * (float)(hq + 1)) * LOG2E, sink2 = sinks[hq] * LOG2E;
        const float base_l = -slope2 * (float)(r32 - 4 * hi);
        WG_BAR();
#pragma unroll 1
        for (int j = 0; j < 4; ++j) {
            const int ilo = (nb == 0) ? 4 - j : 0;
            bf16x8 qr[4];
#pragma unroll
            for (int d0 = 0; d0 < 4; ++d0) qr[d0] = qn[d0];
            if (j < 3) {
#pragma unroll
                for (int d0 = 0; d0 < 4; ++d0) qn[d0] = *(const bf16x8*)(qsrc + (size_t)(32 * (j + 1)) * NQKV + 16 * d0);
            }
            float sl2 = slope2, bl = base_l; asm volatile("" : "+v"(sl2), "+v"(bl));
            f32x16 p[5];
#pragma unroll
            for (int i = 0; i < 5; ++i) {
                if (i >= ilo) {
                    const int kt = j + i; const lcp kb = klane + (kt >> 1) * 8192 + (kt & 1) * 512;
                    f32x16 a = zero16();
#pragma unroll
                    for (int d0 = 0; d0 < 4; ++d0) a = MFMA32(ldfrag(kb + d0 * 2048), qr[d0], a);
#pragma unroll
                    for (int r = 0; r < 16; ++r) {
                        const int cr = (r & 3) + 8 * (r >> 2);
                        float s = fmaf(sl2, (float)(cr - 128 + 32 * i), fmaf(a[r], LOG2E, bl));
                        if (i == 0) { if (!(cr + 4 * hi > r32)) s = -INFINITY; }
                        if (i == 4) { if (!(cr + 4 * hi <= r32)) s = -INFINITY; }
                        a[r] = s;
                    }
                    p[i] = a;
                } else {
#pragma unroll
                    for (int r = 0; r < 16; ++r) p[i][r] = -INFINITY;
                }
            }
            float mx = sink2;
#pragma unroll
            for (int i = 0; i < 5; ++i)
#pragma unroll
                for (int r = 0; r < 16; ++r) mx = fmaxf(mx, p[i][r]);
            mx = half_swap_max(mx);
            float ls = 0.f;
#pragma unroll
            for (int i = 0; i < 5; ++i)
#pragma unroll
                for (int r = 0; r < 16; ++r) { const float e = ex2(p[i][r] - mx); p[i][r] = e; ls += e; }
            ls = half_swap_add(ls) + ex2(sink2 - mx);
            f32x16 o0 = zero16(), o1 = zero16();
#pragma unroll
            for (int i = 0; i < 5; ++i) {
                if (i >= ilo) {
                    const int kt = j + i; const lcp vb = vlane + (kt >> 1) * 8192 + (kt & 1) * 2048;
                    const bf16x8 pa = PACK8(p[i], 0), pb = PACK8(p[i], 1);
                    o0 = MFMA32(pa, trfrag(vb), o0);        o0 = MFMA32(pb, trfrag(vb + 1024), o0);
                    o1 = MFMA32(pa, trfrag(vb + 4096), o1); o1 = MFMA32(pb, trfrag(vb + 4096 + 1024), o1);
                }
            }
            if (hi == 0) wsf[r32] = __builtin_amdgcn_rcpf(ls);
#pragma unroll
            for (int r = 0; r < 16; ++r) {
                const int orow = crow(r, hi); const float rl = wsf[orow] * pg8::F8_SO;
                int pk; asm volatile("" : "=v"(pk)); pk = __builtin_amdgcn_cvt_pk_fp8_f32(o0[r] * rl, o1[r] * rl, pk, false);
                stg[orow * 64 + r32] = (unsigned char)(pk & 0xff);
                stg[orow * 64 + 32 + r32] = (unsigned char)((pk >> 8) & 0xff);
            }
#pragma unroll
            for (int i4 = 0; i4 < 2; ++i4) {
                const int row = i4 * 16 + (lane >> 2), ch = lane & 3;
                const v4u v = *(const LAS v4u*)(stg + row * 64 + ch * 16);
                *(v4u*)(AO8 + (rowq + 32 * j + row) * D + 64 * hq + ch * 16) = v;
            }
        }
        WG_BAR();
    }
}

constexpr int ML_GSET = ML_STG + 4 * 4096 - ML_G2;
static_assert(ML_G2 + ML_GSET + (ML_WS - ML_G2) <= MISC_OFF, "LDS map: second gate-array set");
#define DPPF(old, src, ctrl, rmask, bc) __uint_as_float((unsigned)__builtin_amdgcn_update_dpp((int)__float_as_uint(old), (int)__float_as_uint(src), (ctrl), (rmask), 0xf, (bc)))
DI float scan_add64(float v) {
    v += DPPF(0.f, v, 0x111, 0xf, true); v += DPPF(0.f, v, 0x112, 0xf, true); v += DPPF(0.f, v, 0x114, 0xf, true); v += DPPF(0.f, v, 0x118, 0xf, true);
    v += DPPF(0.f, v, 0x142, 0xa, false); v += DPPF(0.f, v, 0x143, 0xc, false); return v;
}
DI float scan_max64(float v) {
    const float ninf = -INFINITY;
    v = fmaxf(v, DPPF(ninf, v, 0x111, 0xf, false)); v = fmaxf(v, DPPF(ninf, v, 0x112, 0xf, false)); v = fmaxf(v, DPPF(ninf, v, 0x114, 0xf, false)); v = fmaxf(v, DPPF(ninf, v, 0x118, 0xf, false));
    v = fmaxf(v, DPPF(ninf, v, 0x142, 0xa, false)); v = fmaxf(v, DPPF(ninf, v, 0x143, 0xc, false)); return v;
}
DI float ml_gate_scan(LAS unsigned char* lds, int gofs, const float* GT, long row0, int h, int lane, float m_prev) {
    LAS float* G2 = (LAS float*)(lds + ML_G2 + gofs); LAS float* M2 = (LAS float*)(lds + ML_M2 + gofs); LAS float* FI = (LAS float*)(lds + ML_FI + gofs); LAS float* EI = (LAS float*)(lds + ML_EI + gofs);
    LAS float* WK = (LAS float*)(lds + ML_WK + gofs); LAS bf16* WKB = (LAS bf16*)(lds + ML_WKB + gofs); LAS float* SC = (LAS float*)(lds + ML_SC + gofs);
    const float* gp = GT + (size_t)(row0 + 2 * lane) * 8;
    const float i0 = gp[h], f0 = gp[4 + h], i1 = gp[8 + h], f1 = gp[12 + h];
    const float lf0 = -0.6931471805599453f * __builtin_amdgcn_logf(1.f + ex2(-LOG2E * f0)), lf1 = -0.6931471805599453f * __builtin_amdgcn_logf(1.f + ex2(-LOG2E * f1));
    const float incl = scan_add64(lf0 + lf1);
    const float b1 = incl, b0 = incl - lf1;
    const float g0 = i0 - b0, g1 = i1 - b1;
    const float cm = scan_max64(fmaxf(g0, g1));
    const float cprev = DPPF(-INFINITY, cm, 0x138, 0xf, false);
    const float M0 = fmaxf(m_prev, fmaxf(cprev, g0)), M1 = fmaxf(m_prev, cm);
    const float Mend = __uint_as_float((unsigned)__builtin_amdgcn_readlane((int)__float_as_uint(M1), 63)), blast = __uint_as_float((unsigned)__builtin_amdgcn_readlane((int)__float_as_uint(b1), 63));
    *(LAS f32x2*)(G2 + 2 * lane) = (f32x2){g0 * LOG2E, g1 * LOG2E};
    *(LAS f32x2*)(M2 + 2 * lane) = (f32x2){M0 * LOG2E, M1 * LOG2E};
    *(LAS f32x2*)(FI + 2 * lane) = (f32x2){ex2((m_prev - M0) * LOG2E), ex2((m_prev - M1) * LOG2E)};
    *(LAS f32x2*)(EI + 2 * lane) = (f32x2){ex2(-(b0 + M0) * LOG2E), ex2(-(b1 + M1) * LOG2E)};
    const float w0 = ex2((g0 - Mend) * LOG2E), w1 = ex2((g1 - Mend) * LOG2E);
    *(LAS f32x2*)(WK + 2 * lane) = (f32x2){w0, w1};
    *(LAS unsigned*)(WKB + 2 * lane) = pk2(w0, w1);
    if (lane == 0) SC[0] = ex2((m_prev - Mend) * LOG2E);
    return blast + Mend;
}
template <int VAR = 0>
DI void mlstm_phase(unsigned char* ldsg, const bf16* MP, const float* GT, bf16* HG, int ng, int gx, int gy, int Gy, int wave_in) {
    int wid = wave_in; asm volatile("" : "+s"(wid));
    const int lane0 = pg8::pg8_lane(), tid = wid * 64 + lane0;
    LAS unsigned char* lds = (LAS unsigned char*)ldsg; const lcp L = (lcp)lds;
    LAS float* wsf = (LAS float*)(lds + ML_WS) + wid * 64;
    for (int uu = gy; uu < 32 * (BATCH / ng); uu += Gy) { const int b = gx + ng * (uu >> 5), ul = uu & 31;
        const int h = ul >> 3, sl = ul & 7;
        const bf16* Qp = MP + 256 * h; const bf16* Kp = MP + 1024 + 256 * h; const bf16* Vp = MP + 2048 + 512 * h + 64 * sl; const bf16* OGp = MP + 4096 + 512 * h + 64 * sl;
        { unsigned z = 0u; asm volatile("" : "+v"(z)); for (int i = tid; i < (32768 + 512) / 16; i += 512) *(LAS v4u*)(lds + ML_C + i * 16) = (v4u){z, z, z, z}; }
        f32x16 T[6];
#pragma unroll
        for (int x = 0; x < 6; ++x) T[x] = zero16();
        float m_prev = 0.f;
        v4u X[16], vreg[2];
        { const long row0 = (long)b * SEQ; const int lane = lane0, r32 = lane & 31, hi = lane >> 5;
          if (wid >= 4) {
#pragma unroll
              for (int i = 0; i < 16; ++i) X[i] = *(const v4u*)(Kp + (row0 + 8 * i + (lane & 7)) * NMI + (8 * (wid - 4) + (lane >> 3)) * 8);
          } else {
#pragma unroll
              for (int ks = 0; ks < 16; ++ks) X[ks] = *(const v4u*)(Qp + (row0 + 32 * wid + r32) * NMI + 16 * ks + 8 * hi);
          }
#pragma unroll
          for (int i = 0; i < 2; ++i) vreg[i] = *(const v4u*)(Vp + (row0 + 64 * i + 16 * (wid & 3) + (lane >> 2)) * NMI + (wid >> 2) * 32 + (lane & 3) * 8);
          if (wid == 4 && !(VAR & 16)) m_prev = ml_gate_scan(lds, 0, GT, row0, h, lane, m_prev);
        }
        WG_BAR();
        for (int c = 0; c < 16; ++c) {
            const long row0 = (long)b * SEQ + 128 * c;
            const int gofs = (c & 1) * ML_GSET;
            const int lane = pg8::pg8_lane(), r32 = lane & 31, hi = lane >> 5;
            const int blk = (lane >> 4) & 1, q4 = (lane & 15) >> 2, p4 = lane & 3;
            const int vlo_ = blk * 32 + p4 * 8 + (4 * hi + q4) * 64;
            const int ktl_ = (2 * blk + (p4 >> 1)) * 2048 + (q4 + 4 * hi) * 16 + (p4 & 1) * 8;
            const int cbl_ = hi * 1024 + r32 * 16, kbl_ = hi * 2048 + r32 * 16;
            const unsigned m0 = (r32 == 0) ? 0xffffffffu : 0u; const v4u m0v = {m0, m0, m0, m0};
            LAS float* G2 = (LAS float*)(lds + ML_G2 + gofs); LAS float* M2 = (LAS float*)(lds + ML_M2 + gofs); LAS float* FI = (LAS float*)(lds + ML_FI + gofs); LAS float* EI = (LAS float*)(lds + ML_EI + gofs);
            LAS float* WK = (LAS float*)(lds + ML_WK + gofs); LAS bf16* WKB = (LAS bf16*)(lds + ML_WKB + gofs); LAS float* SC = (LAS float*)(lds + ML_SC + gofs);
            VM_WAIT();
            if (wid >= 4) {
#pragma unroll
                for (int i = 0; i < 16; ++i) *(LAS v4u*)(lds + ML_K + (8 * (wid - 4) + (lane >> 3)) * 2048 + (8 * i + (lane & 7)) * 16) = X[i];
            }
#pragma unroll
            for (int i = 0; i < 2; ++i) { const float w = WK[64 * i + 16 * (wid & 3) + (lane >> 2)]; const v4u v = vreg[i]; v4u o;
                o.x = pk2(bflo(v.x) * w, bfhi(v.x) * w); o.y = pk2(bflo(v.y) * w, bfhi(v.y) * w); o.z = pk2(bflo(v.z) * w, bfhi(v.z) * w); o.w = pk2(bflo(v.w) * w, bfhi(v.w) * w);
                *(LAS v4u*)(lds + ML_V + i * 8192 + wid * 1024 + lane * 16) = v;
                *(LAS v4u*)(lds + ML_VW + i * 8192 + wid * 1024 + lane * 16) = o; }
            WG_BAR();
            const bool more = c + 1 < 16;
            if (more && !(VAR & 32)) {
                const long row1 = row0 + 128;
                if (wid >= 4) {
#pragma unroll
                    for (int i = 0; i < 16; ++i) X[i] = *(const v4u*)(Kp + (row1 + 8 * i + (lane & 7)) * NMI + (8 * (wid - 4) + (lane >> 3)) * 8);
                }
#pragma unroll
                for (int i = 0; i < 2; ++i) vreg[i] = *(const v4u*)(Vp + (row1 + 64 * i + 16 * (wid & 3) + (lane >> 2)) * NMI + (wid >> 2) * 32 + (lane & 3) * 8);
            }
            if (wid < 4) {
                const int tt = wid;
                v4u ogv[4];
#pragma unroll
                for (int i4 = 0; i4 < 4; ++i4) ogv[i4] = *(const v4u*)(OGp + (row0 + 32 * tt + i4 * 8 + (lane >> 3)) * NMI + (lane & 7) * 8);
                T[0] = zero16(); T[1] = zero16(); T[2] = zero16();
                if (!(VAR & 4)) { const lcp cb = L + ML_C + cbl_; const lcp nbp = L + ML_N + 16 * hi;
#pragma unroll
                  for (int ks = 0; ks < 16; ++ks) {
                      const bf16x8 c0 = ldfrag(cb + ks * 2048), c1 = ldfrag(cb + ks * 2048 + 512);
                      const bf16x8 nf = __builtin_bit_cast(bf16x8, __builtin_bit_cast(v4u, ldfrag(nbp + ks * 32)) & m0v);
                      T[0] = MFMA32(__builtin_bit_cast(bf16x8, X[ks]), c0, T[0]); T[1] = MFMA32(__builtin_bit_cast(bf16x8, X[ks]), c1, T[1]); T[2] = MFMA32(__builtin_bit_cast(bf16x8, X[ks]), nf, T[2]);
                      if ((ks & 3) == 3) __builtin_amdgcn_sched_barrier(0);
                  } }
                { float fi[16];
#pragma unroll
                  for (int r = 0; r < 16; ++r) fi[r] = FI[32 * tt + crow(r, hi)];
#pragma unroll
                  for (int r = 0; r < 16; ++r) { T[0][r] *= fi[r]; T[1][r] *= fi[r]; }
                  if (r32 == 0) {
#pragma unroll
                      for (int r = 0; r < 16; ++r) wsf[crow(r, hi)] = T[2][r] * fi[r];
                  } }
                const float Mt = M2[32 * tt + r32];
                float dsum = 0.f;
                for (int st = 0; st <= ((VAR & 2) ? -1 : tt); ++st) {
                    f32x16 S = zero16();
                    const lcp kb = L + ML_K + kbl_ + st * 512;
#pragma unroll
                    for (int ks = 0; ks < 16; ++ks) S = MFMA32(ldfrag(kb + ks * 4096), __builtin_bit_cast(bf16x8, X[ks]), S);
#pragma unroll
                    for (int r = 0; r < 16; ++r) {
                        const float w = ex2(G2[32 * st + crow(r, hi)] - Mt);
                        float v = S[r] * w;
                        if (st == tt && crow(r, hi) > r32) v = 0.f;
                        S[r] = v; dsum += v;
                    }
                    const bf16x8 pa = PACK8(S, 0), pb = PACK8(S, 1);
                    const lcp vb = L + ML_V + (st >> 1) * 8192 + (st & 1) * 2048 + vlo_;
                    T[0] = MFMA32(pa, trfrag(vb), T[0]);        T[0] = MFMA32(pb, trfrag(vb + 1024), T[0]);
                    T[1] = MFMA32(pa, trfrag(vb + 4096), T[1]); T[1] = MFMA32(pb, trfrag(vb + 4096 + 1024), T[1]);
                }
                if (more && !(VAR & 64)) {
#pragma unroll
                    for (int ks = 0; ks < 16; ++ks) X[ks] = *(const v4u*)(Qp + (row0 + 128 + 32 * wid + r32) * NMI + 16 * ks + 8 * hi);
                }
                dsum = half_swap_add(dsum);
                { const float den = wsf[r32] + dsum; const float dn = fmaxf(fabsf(den), EI[32 * tt + r32]);
                  if (hi == 0) wsf[32 + r32] = __builtin_amdgcn_rcpf(dn); }
                LAS bf16* stg = (LAS bf16*)(lds + ML_STG + tt * 4096);
                if (!(VAR & 8)) {
#pragma unroll
                for (int r = 0; r < 16; ++r) {
                    const int orow = crow(r, hi); const float rd = wsf[32 + orow];
                    stg[orow * 64 + r32] = (bf16)(pk2(T[0][r] * rd, 0.f) & 0xffffu);
                    stg[orow * 64 + 32 + r32] = (bf16)(pk2(T[1][r] * rd, 0.f) & 0xffffu);
                }
#pragma unroll
                for (int i4 = 0; i4 < 4; ++i4) {
                    const int row = i4 * 8 + (lane >> 3), ch = lane & 7;
                    const v4u hv = *(const LAS v4u*)(stg + row * 64 + ch * 8);
                    const v4u og = ogv[i4];
                    v4u o;
                    o.x = pk2(bflo(hv.x) * bflo(og.x), bfhi(hv.x) * bfhi(og.x)); o.y = pk2(bflo(hv.y) * bflo(og.y), bfhi(hv.y) * bfhi(og.y));
                    o.z = pk2(bflo(hv.z) * bflo(og.z), bfhi(hv.z) * bfhi(og.z)); o.w = pk2(bflo(hv.w) * bflo(og.w), bfhi(hv.w) * bfhi(og.w));
                    *(v4u*)(HG + (row0 + 32 * tt + row) * D + 512 * h + 64 * sl + ch * 8) = o;
                }
                }
#pragma unroll
                for (int x = 3; x < 6; ++x) T[x] = zero16();
            } else {
                const float decay = SC[0];
#pragma unroll
                for (int x = 0; x < 6; ++x)
#pragma unroll
                    for (int r = 0; r < 16; ++r) T[x][r] *= decay;
#pragma unroll
                for (int dti = 0; dti < ((VAR & 1) ? 0 : 2); ++dti) {
                    const int dt = 2 * (wid - 4) + dti;
                    const lcp ka0 = L + ML_K + dt * 8192 + ktl_;
#pragma unroll
                    for (int s8 = 0; s8 < 8; ++s8) {
                        const lcp ka = ka0 + s8 * 256;
                        const bf16x8 af = cat8(vtr(ka), vtr(ka + 128));
                        const lcp vwb = L + ML_VW + (s8 >> 2) * 8192 + (s8 & 3) * 1024 + vlo_;
                        const bf16x8 b0 = trfrag(vwb), b1 = trfrag(vwb + 4096);
                        const LAS s16x4* wp = (const LAS s16x4*)(WKB + 16 * s8 + 4 * hi);
                        const bf16x8 nb = __builtin_bit_cast(bf16x8, __builtin_bit_cast(v4u, cat8(wp[0], wp[2])) & m0v);
                        T[2 * dti] = MFMA32(af, b0, T[2 * dti]); T[2 * dti + 1] = MFMA32(af, b1, T[2 * dti + 1]); T[4 + dti] = MFMA32(af, nb, T[4 + dti]);
                        if (s8 & 1) __builtin_amdgcn_sched_barrier(0);
                    }
                }
                if (more && wid == 4 && !(VAR & 16)) m_prev = ml_gate_scan(lds, ML_GSET - gofs, GT, row0 + 128, h, lane, m_prev);
            }
            asm volatile("s_waitcnt lgkmcnt(0)" ::: "memory"); __builtin_amdgcn_s_barrier(); asm volatile("" ::: "memory");
            if (wid >= 4) {
#pragma unroll
                for (int dti = 0; dti < 2; ++dti) {
                    const int dt = 2 * (wid - 4) + dti;
#pragma unroll
                    for (int et = 0; et < 2; ++et)
#pragma unroll
                        for (int g = 0; g < 4; ++g)
                            *(LAS v2u*)(lds + ML_C + (4 * dt + g) * 1024 + (32 * et + r32) * 16 + hi * 8) = (v2u){pk2(T[2 * dti + et][4 * g], T[2 * dti + et][4 * g + 1]), pk2(T[2 * dti + et][4 * g + 2], T[2 * dti + et][4 * g + 3])};
                    if (r32 == 0) {
#pragma unroll
                        for (int g = 0; g < 4; ++g)
                            *(LAS v2u*)(lds + ML_N + (32 * dt + 8 * g + 4 * hi) * 2) = (v2u){pk2(T[4 + dti][4 * g], T[4 + dti][4 * g + 1]), pk2(T[4 + dti][4 * g + 2], T[4 + dti][4 * g + 3])};
                    }
                }
            }
        }
        WG_BAR();
    }
}


constexpr int NWAVES = 8;

template <bool F8> DI void tr_strip(const float* W, int ldw, int n0, void* WTv, size_t wt_row0, int Kdim, int kb0, int nkb, const float* g, const float* bb, float cs, float* c1o, float* c2o, LAS float* scr, int lane) {
    bf16* WT = (bf16*)WTv; unsigned char* WT8 = (unsigned char*)WTv;
    const int c = lane & 7;
    float a1[4] = {0.f, 0.f, 0.f, 0.f}, a2[4] = {0.f, 0.f, 0.f, 0.f};
    for (int kb = kb0; kb < kb0 + nkb; ++kb) {
        const int k0 = kb * 64;
#pragma unroll 8
        for (int i = 0; i < 32; ++i) { const int kk = 2 * i + (lane >> 5); scr[kk * 33 + (lane & 31)] = W[(size_t)(k0 + kk) * ldw + n0 + (lane & 31)]; }
        float gk[8], bk[8];
        if (g) { const f32x4 g0 = *(const f32x4*)(g + k0 + 8 * c), g1 = *(const f32x4*)(g + k0 + 8 * c + 4), b0 = *(const f32x4*)(bb + k0 + 8 * c), b1 = *(const f32x4*)(bb + k0 + 8 * c + 4);
#pragma unroll
            for (int i = 0; i < 4; ++i) { gk[i] = g0[i] * cs; gk[4 + i] = g1[i] * cs; bk[i] = b0[i] * cs; bk[4 + i] = b1[i] * cs; } }
        else {
#pragma unroll
            for (int i = 0; i < 8; ++i) { gk[i] = cs; bk[i] = 0.f; } }
        LDS_WAIT(); asm volatile("" ::: "memory");
#pragma unroll
        for (int j = 0; j < 4; ++j) { const int n = (lane >> 3) + 8 * j; const LAS float* s = scr + (8 * c) * 33 + n;
            float v[8];
#pragma unroll
            for (int i = 0; i < 8; ++i) v[i] = s[i * 33];
            a2[j] += ((v[0] * bk[0] + v[1] * bk[1]) + (v[2] * bk[2] + v[3] * bk[3])) + ((v[4] * bk[4] + v[5] * bk[5]) + (v[6] * bk[6] + v[7] * bk[7]));
            if constexpr (F8) {
                float wv[8];
#pragma unroll
                for (int i = 0; i < 8; ++i) wv[i] = v[i] * gk[i];
                const v2u o = pg8::cvt8_f8(wv, pg8::F8_SW);
                a1[j] += ((__builtin_amdgcn_cvt_f32_fp8((int)o.x, 0) + __builtin_amdgcn_cvt_f32_fp8((int)o.x, 1)) + (__builtin_amdgcn_cvt_f32_fp8((int)o.x, 2) + __builtin_amdgcn_cvt_f32_fp8((int)o.x, 3)))
                       + ((__builtin_amdgcn_cvt_f32_fp8((int)o.y, 0) + __builtin_amdgcn_cvt_f32_fp8((int)o.y, 1)) + (__builtin_amdgcn_cvt_f32_fp8((int)o.y, 2) + __builtin_amdgcn_cvt_f32_fp8((int)o.y, 3)));
                *(GAS v2u*)(WT8 + (wt_row0 + n) * Kdim + k0 + 8 * c) = o;
            } else {
                v4u o; o.x = pk2(v[0] * gk[0], v[1] * gk[1]); o.y = pk2(v[2] * gk[2], v[3] * gk[3]); o.z = pk2(v[4] * gk[4], v[5] * gk[5]); o.w = pk2(v[6] * gk[6], v[7] * gk[7]);
                a1[j] += ((bflo(o.x) + bfhi(o.x)) + (bflo(o.y) + bfhi(o.y))) + ((bflo(o.z) + bfhi(o.z)) + (bflo(o.w) + bfhi(o.w)));
                *(GAS v4u*)(WT + (wt_row0 + n) * Kdim + k0 + 8 * c) = o;
            } }
        LDS_WAIT(); asm volatile("" ::: "memory");
    }
    if (g) {
#pragma unroll
        for (int j = 0; j < 4; ++j) { float s1 = a1[j], s2 = a2[j];
            s1 += SWZ_XOR(s1, 1); s2 += SWZ_XOR(s2, 1); s1 += SWZ_XOR(s1, 2); s2 += SWZ_XOR(s2, 2); s1 += SWZ_XOR(s1, 4); s2 += SWZ_XOR(s2, 4);
            if (c == 0) { c1o[(lane >> 3) + 8 * j] = F8 ? s1 * (1.f / pg8::F8_SW) : s1; c2o[(lane >> 3) + 8 * j] = s2; } }
    }
}

DI void prologue(kargs_t a, LAS unsigned char* lds, int gw, int NGW, int wave, int lane) {
    unsigned char* ws = a->ws;
    float* vec = (float*)(ws + WS_VEC);
    const float* ones = (const float*)(ws + WS_VEC + V_ONES); const float* zeros = (const float*)(ws + WS_VEC + V_ZEROS);
    LAS float* scr = (LAS float*)(lds + wave * 16384);
    constexpr int T_UP = 8 * 2 * 176, T_QKV = 2 * 80, T_MI = 2 * 192, T_W2 = 8 * 64 * 4, T_WO = 2 * 64, T_WMO = 2 * 64, T_G = 16;
    constexpr int NT = T_UP + T_QKV + T_MI + T_W2 + T_WO + T_WMO + T_G;
    for (int it = gw; it < NT; it += NGW) {
        int r = it;
        if (r < T_UP) {
            const int f = r / 352, rr = r % 352, which = rr / 176, strip = rr % 176, n0 = 32 * strip;
            const int t = 3 * (f >> 1) + 2 * (f & 1);
            const float* gp = t ? a->ln_g + (size_t)(t - 1) * D : nullptr; const float* bp = t ? a->ln_b + (size_t)(t - 1) * D : nullptr;
            const size_t wrow = (size_t)256 * (n0 / 128) + 128 * which + (n0 % 128);
            const float* W = (which ? a->w3 : a->w1) + (size_t)f * D * FF;
            if (gp) tr_strip<true>(W, FF, n0, ws + WS_W13 + (size_t)f * NUP * D, wrow, D, 0, 32, gp, bp, 1.f, vec + V_C1U / 4 + (size_t)f * NUP + wrow, vec + V_C2U / 4 + (size_t)f * NUP + wrow, scr, lane);
            else { tr_strip<true>(W, FF, n0, ws + WS_W13 + (size_t)f * NUP * D, wrow, D, 0, 32, nullptr, nullptr, 1.f, nullptr, nullptr, scr, lane);
                   if (lane < 32) { vec[V_C1U / 4 + (size_t)f * NUP + wrow + lane] = 0.f; vec[V_C2U / 4 + (size_t)f * NUP + wrow + lane] = 0.f; } }
            continue; }
        r -= T_UP;
        if (r < T_QKV) { const int j = r / 80, n0 = 32 * (r % 80); const int t = 6 * j + 1;
            tr_strip<true>(a->wqkv + (size_t)j * D * NQKV, NQKV, n0, ws + WS_WQKV + (size_t)j * NQKV * D, n0, D, 0, 32, a->ln_g + (size_t)(t - 1) * D, a->ln_b + (size_t)(t - 1) * D, n0 < 2048 ? 0.125f : 1.f,
                     vec + V_C1Q / 4 + j * NQKV + n0, vec + V_C2Q / 4 + j * NQKV + n0, scr, lane);
            continue; }
        r -= T_QKV;
        if (r < T_MI) { const int j = r / 192, n0 = 32 * (r % 192); const int t = 6 * j + 4;
            if (true) tr_strip<false>(a->win + (size_t)j * D * NMIW, NMIW, n0, (bf16*)(ws + WS_WIN) + (size_t)j * NMI * D, n0, D, 0, 32, a->ln_g + (size_t)(t - 1) * D, a->ln_b + (size_t)(t - 1) * D, (n0 >= 1024 && n0 < 2048) ? 0.0625f : 1.f,
                     vec + V_C1I / 4 + j * NMI + n0, vec + V_C2I / 4 + j * NMI + n0, scr, lane);
            else tr_strip<true>(a->win + (size_t)j * D * NMIW, NMIW, n0, ws + WS_WIN + 32 * MiB + (size_t)j * 2048 * D, n0 - 4096, D, 0, 32, a->ln_g + (size_t)(t - 1) * D, a->ln_b + (size_t)(t - 1) * D, 1.f,
                     vec + V_C1I / 4 + j * NMI + n0, vec + V_C2I / 4 + j * NMI + n0, scr, lane);
            continue; }
        r -= T_MI;
        if (r < T_W2) { const int f = r / 256, rr = r % 256, strip = rr / 4, kq = rr % 4;
            tr_strip<true>(a->w2 + (size_t)f * FF * D, D, 32 * strip, ws + WS_W2 + (size_t)f * D * FF, 32 * strip, FF, 22 * kq, 22, nullptr, nullptr, 1.f, nullptr, nullptr, scr, lane);
            continue; }
        r -= T_W2;
        if (r < T_WO) { const int j = r / 64, strip = r % 64;
            tr_strip<true>(a->wo + (size_t)j * D * D, D, 32 * strip, ws + WS_WO + (size_t)j * D * D, 32 * strip, D, 0, 32, nullptr, nullptr, 1.f, nullptr, nullptr, scr, lane);
            continue; }
        r -= T_WO;
        if (r < T_WMO) { const int j = r / 64, strip = r % 64;
            tr_strip<false>(a->wmo + (size_t)j * D * D, D, 32 * strip, (bf16*)(ws + WS_WMO) + (size_t)j * D * D, 32 * strip, D, 0, 32, nullptr, nullptr, 1.f, nullptr, nullptr, scr, lane);
            continue; }
        r -= T_WMO;
        {
            const int j = r / 8, jj = r % 8; const int t = 6 * j + 4;
            const float* gp = a->ln_g + (size_t)(t - 1) * D; const float* bp = a->ln_b + (size_t)(t - 1) * D;
            const float* W = a->win + (size_t)j * D * NMIW + NMI + jj;
            bf16* wg16 = (bf16*)(vec + V_WG / 4) + (size_t)(j * 8 + jj) * D;
            float s1 = 0.f, s2 = 0.f;
            for (int k = lane; k < D; k += 64) { const float w = W[(size_t)k * NMIW]; const unsigned hv = pk2(w * gp[k], 0.f) & 0xffffu; wg16[k] = (bf16)hv; s1 += bflo(hv); s2 += w * bp[k]; }
            s1 = wave_sum(s1); s2 = wave_sum(s2);
            if (lane == 0) { vec[V_CG / 4 + j * 16 + jj] = s1; vec[V_CG / 4 + j * 16 + 8 + jj] = s2 + a->bg[j * 8 + jj]; }
        }
    }
    bf16* R = (bf16*)(ws + WS_R); float* sp0 = (float*)(ws + WS_SP);
    for (int m = gw; m < M; m += NGW) {
        const GAS f32x4* xr = (const GAS f32x4*)(a->x + (size_t)m * D);
#pragma unroll
        for (int i = 0; i < 4; ++i) { const f32x4 v0 = xr[(i * 64 + lane) * 2], v1 = xr[(i * 64 + lane) * 2 + 1];
            *(GAS v4u*)(R + (size_t)m * D + (i * 64 + lane) * 8) = (v4u){pk2(v0[0], v0[1]), pk2(v0[2], v0[3]), pk2(v1[0], v1[1]), pk2(v1[2], v1[3])};
            { const float xv[8] = {v0[0], v0[1], v0[2], v0[3], v1[0], v1[1], v1[2], v1[3]}; *(GAS v2u*)(ws + WS_R8 + (size_t)m * D + (i * 64 + lane) * 8) = pg8::cvt8_f8(xv, pg8::F8_SR); } }
        if (lane < 8) *(f32x2*)(sp0 + (size_t)m * 16 + lane * 2) = (f32x2){0.f, 256.f * (1.f - LN_EPS)};
    }
    for (int i = gw * 64 + lane; i < D; i += NGW * 64) { vec[V_ONES / 4 + i] = 1.f; vec[V_ZEROS / 4 + i] = 0.f; }
    (void)ones; (void)zeros;
}

DI void gates_phase(LAS unsigned char* lds, const bf16* R, const float* sp, const bf16* wg16, const float* cg, float* GT, int ng, int gx, int gy, int Gy, int wave_in) {
    int wave = wave_in; asm volatile("" : "+s"(wave));
    const int lane = pg8::pg8_lane(), tid = wave * 64 + lane, r32 = lane & 31, hi = lane >> 5;
    LAS float* part = (LAS float*)lds;
    const unsigned mk = (r32 < 8) ? 0xffffffffu : 0u; const v4u mkv = {mk, mk, mk, mk};
    for (int uu = gy; uu < (SEQ / 64) * (BATCH / ng); uu += Gy) { const int b = gx + ng * (uu >> 5), pl = uu & 31;
        const long r0 = (long)b * SEQ + (long)pl * 64;
        const bf16* bsrc = wg16 + (size_t)(r32 & 7) * D + 256 * wave + 8 * hi;
        bf16x8 bfr[16];
#pragma unroll
        for (int ks = 0; ks < 16; ++ks) bfr[ks] = __builtin_bit_cast(bf16x8, *(const v4u*)(bsrc + 16 * ks) & mkv);
#pragma unroll
        for (int rt = 0; rt < 2; ++rt) {
            const bf16* asrc = R + (r0 + 32 * rt + r32) * D + 256 * wave + 8 * hi;
            bf16x8 afr[16];
#pragma unroll
            for (int ks = 0; ks < 16; ++ks) afr[ks] = *(const bf16x8*)(asrc + 16 * ks);
            f32x16 acc = zero16();
#pragma unroll
            for (int ks = 0; ks < 16; ++ks) acc = MFMA32(afr[ks], bfr[ks], acc);
            if (r32 < 8) {
#pragma unroll
                for (int r = 0; r < 16; ++r) part[(wave * 64 + 32 * rt + crow(r, hi)) * 8 + r32] = acc[r];
            }
        }
        WG_BAR();
        {
            const int row = tid >> 3, col = tid & 7;
            float s = 0.f;
#pragma unroll
            for (int w = 0; w < 8; ++w) s += part[(w * 64 + row) * 8 + col];
            const f32x4* spr = (const f32x4*)(sp + (size_t)(r0 + row) * 16);
            const f32x4 v0 = spr[0], v1 = spr[1], v2 = spr[2], v3 = spr[3];
            const float ss = ((v0[0] + v0[2]) + (v1[0] + v1[2])) + ((v2[0] + v2[2]) + (v3[0] + v3[2])), qq = ((v0[1] + v0[3]) + (v1[1] + v1[3])) + ((v2[1] + v2[3]) + (v3[1] + v3[3]));
            const float mean = ss * (1.f / D), var = qq * (1.f / D) - mean * mean, rstd = __builtin_amdgcn_rsqf(var + LN_EPS);
            GT[(size_t)(r0 + row) * 8 + col] = rstd * (s - mean * cg[col]) + cg[8 + col];
        }
        WG_BAR();
    }
}

DI void final_ln(const bf16* R, const float* sp, const float* g, const float* b, float* out, int ng, int gx, int gw, int NGW, int lane) {
    for (int bb = gx; bb < BATCH; bb += ng) for (int m = bb * SEQ + gw; m < (bb + 1) * SEQ; m += NGW) {
        float s, q;
        { const f32x4 v = *(const f32x4*)(sp + (size_t)m * 16 + (lane & 3) * 4); s = v[0] + v[2]; q = v[1] + v[3];
          s += SWZ_XOR(s, 1); q += SWZ_XOR(q, 1); s += SWZ_XOR(s, 2); q += SWZ_XOR(q, 2); }
        const float mean = s * (1.f / D), var = q * (1.f / D) - mean * mean, rstd = __builtin_amdgcn_rsqf(var + LN_EPS);
#pragma unroll
        for (int i = 0; i < 4; ++i) {
            const int k = 8 * lane + 512 * i;
            const v4u rv = *(const v4u*)(R + (size_t)m * D + k);
            const f32x4 g0 = *(const f32x4*)(g + k), g1 = *(const f32x4*)(g + k + 4), b0 = *(const f32x4*)(b + k), b1 = *(const f32x4*)(b + k + 4);
            f32x4 o0, o1;
            o0[0] = (bflo(rv.x) - mean) * rstd * g0[0] + b0[0]; o0[1] = (bfhi(rv.x) - mean) * rstd * g0[1] + b0[1]; o0[2] = (bflo(rv.y) - mean) * rstd * g0[2] + b0[2]; o0[3] = (bfhi(rv.y) - mean) * rstd * g0[3] + b0[3];
            o1[0] = (bflo(rv.z) - mean) * rstd * g1[0] + b1[0]; o1[1] = (bfhi(rv.z) - mean) * rstd * g1[1] + b1[1]; o1[2] = (bflo(rv.w) - mean) * rstd * g1[2] + b1[2]; o1[3] = (bfhi(rv.w) - mean) * rstd * g1[3] + b1[3];
            *(GAS f32x4*)(out + (size_t)m * D + k) = o0; *(GAS f32x4*)(out + (size_t)m * D + k + 4) = o1;
        }
    }
}

#ifndef PROBE_DUP
#define PROBE_DUP 0
#endif
#ifndef PROBE_DRY
#define PROBE_DRY 1
#endif
#ifndef PROBE_MLV
#define PROBE_MLV 0
#endif
#ifndef SKIP_ATT
#define SKIP_ATT 0
#endif
#ifndef SKIP_MLSTM
#define SKIP_MLSTM 0
#endif

#define GRID_BAR1() do { XcdBarrier b_; b_.bar = (unsigned*)(kargs()->ws + WS_CTL) + CW_BAR; b_.x = xb_xcc_id(); b_.st = (volatile LAS unsigned*)(lds + MISC_OFF) + 8; b_.total = gridDim.x; xcd_barrier(b_); } while (0)
#define GRID_BAR() do { GRID_BAR1(); if (PROBE_DUP & 1024) GRID_BAR1(); } while (0)
#define GROUP_BAR1() do { XcdBarrier b_; b_.bar = (unsigned*)(kargs()->ws + WS_CTL) + CW_BAR + (1 + (bid & 7)) * XCD_BAR_WORDS; b_.x = xb_xcc_id(); b_.st = (volatile LAS unsigned*)(lds + MISC_OFF) + 10; b_.total = gridDim.x / 8; xcd_barrier(b_); } while (0)
#define LAYER_BAR() do { if (grouped) { GROUP_BAR1(); if (PROBE_DUP & 1024) GROUP_BAR1(); } else GRID_BAR(); } while (0)

__global__ void __launch_bounds__(NWAVES * 64, 2) fwd_kernel(Args args_by_value) {
    extern __shared__ __attribute__((aligned(16))) unsigned char lds_raw[];
    LAS unsigned char* lds = (LAS unsigned char*)lds_raw;
    const int w0 = __builtin_amdgcn_readfirstlane((int)threadIdx.x >> 6);
    const int G0 = gridDim.x, bid0 = blockIdx.x; const int G = G0, bid = bid0;
    { const int tid0 = threadIdx.x; if (tid0 < 64) ((volatile LAS unsigned*)(lds + MISC_OFF))[tid0] = 0u; }
    __syncthreads();
    (void)xcd_barrier_post((unsigned*)(kargs()->ws + WS_CTL) + CW_BAR, (volatile LAS unsigned*)(lds + MISC_OFF) + 8);
    const bool grouped = (G0 == 256);
    if (grouped) (void)xcd_barrier_post((unsigned*)(kargs()->ws + WS_CTL) + CW_BAR + (1 + (bid0 & 7)) * XCD_BAR_WORDS, (volatile LAS unsigned*)(lds + MISC_OFF) + 10);
    {
        const int vcu = (G % 8 == 0) ? (bid % 8) * (G / 8) + bid / 8 : bid;
        prologue(kargs(), lds, vcu * NWAVES + w0, G * NWAVES, w0, pg8::pg8_lane());
        if (PROBE_DUP & 1) { WG_BAR(); prologue(kargs(), lds, vcu * NWAVES + w0, G * NWAVES, w0, pg8::pg8_lane()); }
    }
    GRID_BAR();
#ifndef GROUP_STAGGER_TICKS
#define GROUP_STAGGER_TICKS 0
#endif
    if (grouped && (bid0 & 1) && GROUP_STAGGER_TICKS > 0) { const unsigned long long t0 = __builtin_amdgcn_s_memrealtime(); while (__builtin_amdgcn_s_memrealtime() - t0 < (unsigned long long)GROUP_STAGGER_TICKS) __builtin_amdgcn_s_sleep(8); }

    for (int t = 0; t < 3 * DEPTH; ++t) {
        int G = G0, bid = bid0; asm volatile("" : "+s"(G), "+s"(bid));
        const int ng = grouped ? 8 : 1, gx = bid % ng, gy = bid / ng, Gy = G / ng;
        const int layer = t / 3, sub = t % 3;
        const int kind = (sub != 1) ? 0 : ((layer & 1) ? 2 : 1);
        const int j = layer >> 1;
        {
            unsigned char* ws = kargs()->ws;
            float* vec = (float*)(ws + WS_VEC);
            const bf16* R = (const bf16*)(ws + WS_R);
            const float* sp_in = (const float*)(ws + WS_SP) + (size_t)(t & 1) * (SP_BYTES / 4);
            if (kind == 0) {
                const int f = 2 * layer + (sub >> 1);
                pg8::Gemm g{(const bf16*)(ws + WS_R8), (const bf16*)(ws + WS_W13 + (size_t)f * NUP * D), M, NUP, D / 2}; pg8::StaticOrder S; S.init(M, NUP, G, bid);
                pg8::EpiUp E{f, t & 1};
                if (PROBE_DUP & 2048) { S.r1 = 5; pg8::gemm_phase<pg8::EpiUp, pg8::StaticOrder, true, PG8_SP2, true>(lds + RING_OFF, g, S, E, w0); LAYER_BAR(); S.r0 = 5; S.r1 = 1 << 20; }
                pg8::gemm_phase<pg8::EpiUp, pg8::StaticOrder, true, PG8_SP2, true>(lds + RING_OFF, g, S, E, w0);
                if (PROBE_DUP & 16) pg8::gemm_phase<pg8::EpiUp, pg8::StaticOrder, true, PG8_SP2, true>(lds + RING_OFF, g, S, E, w0);
                if (PROBE_DUP & 128) { pg8::EpiNull EN{(float*)(ws + WS_GATES)}; pg8::gemm_phase<pg8::EpiNull, pg8::StaticOrder, true, PG8_SP2, true>(lds + RING_OFF, g, S, EN, w0); }
            } else {
                if (kind == 2) {
                    pg8::Gemm g{R, (const bf16*)(ws + WS_WIN) + (size_t)j * NMI * D, M, NMI, D}; pg8::StaticOrder S; S.init(M, NMI, G, bid);
                    pg8::EpiLnOut E{1, j, t & 1};
                    pg8::gemm_phase<pg8::EpiLnOut, pg8::StaticOrder, true, PG8_SP2>(lds + RING_OFF, g, S, E, w0);
                    if (PROBE_DUP & 32) pg8::gemm_phase<pg8::EpiLnOut, pg8::StaticOrder, true, PG8_SP2>(lds + RING_OFF, g, S, E, w0);
                }
                if (kind == 1) {
                    const int N = kind == 1 ? NQKV : 2048;
                    pg8::Gemm g{(const bf16*)(ws + WS_R8), (const bf16*)(kind == 1 ? ws + WS_WQKV + (size_t)j * NQKV * D : ws + WS_WIN + 32 * MiB + (size_t)j * 2048 * D), M, N, D / 2}; pg8::StaticOrder S; S.init(M, N, G, bid);
                    pg8::EpiLnOut E{kind == 1 ? 0 : 2, j, t & 1};
                    pg8::gemm_phase<pg8::EpiLnOut, pg8::StaticOrder, true, PG8_SP2, true>(lds + RING_OFF, g, S, E, w0);
                    if (PROBE_DUP & 32) pg8::gemm_phase<pg8::EpiLnOut, pg8::StaticOrder, true, PG8_SP2, true>(lds + RING_OFF, g, S, E, w0);
                }
                if (kind == 2) {
                    gates_phase(lds, R, sp_in, (const bf16*)(vec + V_WG / 4) + (size_t)j * 8 * D, vec + V_CG / 4 + j * 16, (float*)(ws + WS_GATES), ng, gx, gy, Gy, w0);
                    if (PROBE_DUP & 8) { WG_BAR(); gates_phase(lds, R, sp_in, (const bf16*)(vec + V_WG / 4) + (size_t)j * 8 * D, vec + V_CG / 4 + j * 16, (float*)(ws + WS_GATES), ng, gx, gy, Gy, w0); }
                }
            }
        }
        LAYER_BAR();
        if (kind == 1) {
            if (!SKIP_ATT) { kargs_t ka = kargs(); unsigned char* ws = ka->ws; attn_phase(lds_raw, (const bf16*)(ws + WS_QKV), ws + WS_AO, ka->sinks + j * 32, ng, gx, gy, Gy, w0);
                if (PROBE_DUP & 2) attn_phase(lds_raw, (const bf16*)(ws + WS_QKV), ws + WS_AO, ka->sinks + j * 32, ng, gx, gy, Gy, w0); }
            LAYER_BAR();
        } else if (kind == 2) {
            if (!SKIP_MLSTM) { unsigned char* ws = kargs()->ws; mlstm_phase(lds_raw, (const bf16*)(ws + WS_MP), (const float*)(ws + WS_GATES), (bf16*)(ws + WS_HG), ng, gx, gy, Gy, w0);
                if (PROBE_DUP & 4) mlstm_phase<PROBE_MLV>(lds_raw, (const bf16*)(ws + WS_MP), (const float*)(ws + WS_GATES), (bf16*)(ws + WS_H), ng, gx, gy, Gy, w0); }
            LAYER_BAR();
        }
        {
            kargs_t ka = kargs(); unsigned char* ws = ka->ws;
            float coef = kind == 0 ? 0.5f / (pg8::F8_SH * pg8::F8_SW) : (kind == 1 ? 1.f / (pg8::F8_SO * pg8::F8_SW) : 1.f);
            if ((kind == 1 && SKIP_ATT) || (kind == 2 && SKIP_MLSTM)) coef = 0.f;
            pg8::StaticOrder S; S.init(M, D, G, bid);
            pg8::EpiRes E{t, coef, (LAS float*)(lds + TAB_OFF), w0, 0};
            if (kind != 2) {
                const int f = 2 * layer + (sub >> 1);
                pg8::Gemm g{(const bf16*)(ws + (kind == 0 ? WS_H : WS_AO)), (const bf16*)(kind == 0 ? ws + WS_W2 + (size_t)f * D * FF : ws + WS_WO + (size_t)j * D * D), M, D, kind == 0 ? FF / 2 : D / 2};
                if (PROBE_DUP & 64) { pg8::EpiNull EN{(float*)(ws + WS_GATES)}; pg8::gemm_phase<pg8::EpiNull, pg8::StaticOrder, true, PG8_SP2, true>(lds + RING_OFF, g, S, EN, w0); }
                if (PROBE_DUP & 512) { pg8::EpiRes ED{t, coef, (LAS float*)(lds + TAB_OFF), w0, PROBE_DRY}; pg8::gemm_phase<pg8::EpiRes, pg8::StaticOrder, true, PG8_SP2, true>(lds + RING_OFF, g, S, ED, w0); }
                pg8::gemm_phase<pg8::EpiRes, pg8::StaticOrder, true, PG8_SP2, true>(lds + RING_OFF, g, S, E, w0);
            } else {
                pg8::Gemm g{(const bf16*)(ws + WS_HG), (const bf16*)(ws + WS_WMO) + (size_t)j * D * D, M, D, D};
                if (PROBE_DUP & 256) { pg8::EpiNull EN{(float*)(ws + WS_GATES)}; pg8::gemm_phase<pg8::EpiNull, pg8::StaticOrder, true, PG8_SP2, false>(lds + RING_OFF, g, S, EN, w0); }
                pg8::gemm_phase<pg8::EpiRes, pg8::StaticOrder, true, PG8_SP2, false>(lds + RING_OFF, g, S, E, w0);
            }
        }
        LAYER_BAR();
    }
    {
        kargs_t ka = kargs(); unsigned char* ws = ka->ws;
        const int ng = grouped ? 8 : 1, gx = bid % ng, gy = bid / ng, Gy = G / ng;
        final_ln((const bf16*)(ws + WS_R), (const float*)(ws + WS_SP), ka->ln_g + (size_t)(3 * DEPTH - 1) * D, ka->ln_b + (size_t)(3 * DEPTH - 1) * D, ka->out, ng, gx, gy * NWAVES + w0, Gy * NWAVES, pg8::pg8_lane());
    }
}

extern "C" void kernel_launch(void* const* d_in, const int* in_sizes, int n_in, void* d_out, int out_size, void* d_ws, size_t ws_size, hipStream_t stream) {
    static int grid = 0;
    if (grid == 0) {
        if (n_in != 12 || in_sizes[0] != M * D || out_size != M * D || ws_size < WS_END) { fprintf(stderr, "kernel_launch: unexpected shapes / workspace (n_in %d, ws %zu < %zu); nothing launched\n", n_in, ws_size, (size_t)WS_END); grid = -1; return; }
        int dev = 0, cus = 0;
        if (hipGetDevice(&dev) != hipSuccess || hipDeviceGetAttribute(&cus, hipDeviceAttributeMultiprocessorCount, dev) != hipSuccess) { grid = -1; return; }
        if (hipFuncSetAttribute((const void*)fwd_kernel, hipFuncAttributeMaxDynamicSharedMemorySize, LDS_BYTES) != hipSuccess) { fprintf(stderr, "kernel_launch: hipFuncSetAttribute failed\n"); grid = -1; return; }
        int per_cu = 0;
        if (hipOccupancyMaxActiveBlocksPerMultiprocessor(&per_cu, (const void*)fwd_kernel, NWAVES * 64, LDS_BYTES) != hipSuccess || per_cu < 1) { fprintf(stderr, "kernel_launch: occupancy query says %d\n", per_cu); }
        (void)hipGetLastError();
        grid = cus;
    }
    if (grid < 0) return;
    (void)hipMemsetAsync((char*)d_ws + WS_CTL, 0, CTL_ZERO_BYTES, stream);
    Args a{};
    a.x = (const float*)d_in[0]; a.w1 = (const float*)d_in[1]; a.w3 = (const float*)d_in[2]; a.w2 = (const float*)d_in[3]; a.ln_g = (const float*)d_in[4]; a.ln_b = (const float*)d_in[5];
    a.wqkv = (const float*)d_in[6]; a.sinks = (const float*)d_in[7]; a.wo = (const float*)d_in[8]; a.win = (const float*)d_in[9]; a.bg = (const float*)d_in[10]; a.wmo = (const float*)d_in[11];
    a.out = (float*)d_out; a.ws = (unsigned char*)d_ws;
    hipLaunchKernelGGL(fwd_kernel, dim3(grid), dim3(NWAVES * 64), LDS_BYTES, stream, a);
}
```

```cpp
#include <hip/hip_runtime.h>
#include <hip/hip_bf16.h>
#include <cstdio>
#include <cstdint>
#include <cmath>

constexpr int BATCH = 8, SEQ = 2048, D = 2048, FF = 5632, DEPTH = 4;
constexpr int M = BATCH * SEQ;
constexpr int NUP = 2 * FF;
constexpr int NQKV = 2560;
constexpr int NMI = 6144, NMIW = 6152;
constexpr float LN_EPS = 1e-5f;
constexpr float ALPHA = 1.681792830507429f;
constexpr float LOG2E = 1.4426950408889634f;

constexpr size_t MiB = 1u << 20;
constexpr size_t WS_CTL = 0, CTL_ZERO_BYTES = 192 * 1024;
constexpr size_t WS_W13 = 2 * MiB;
constexpr size_t WS_W2 = 178 * MiB;
constexpr size_t WS_WQKV = 266 * MiB;
constexpr size_t WS_WO = 286 * MiB;
constexpr size_t WS_WIN = 302 * MiB;
constexpr size_t WS_WMO = 350 * MiB;
constexpr size_t WS_VEC = 366 * MiB;
constexpr size_t V_C1U = 0, V_C2U = 360448, V_C1Q = 720896, V_C2Q = 741376, V_C1I = 761856, V_C2I = 811008, V_CG = 860160, V_WG = 860416, V_ONES = 991488, V_ZEROS = 999680;
constexpr size_t WS_R = 368 * MiB;
constexpr size_t WS_R8 = 432 * MiB;
constexpr size_t WS_SP = 464 * MiB;
constexpr size_t SP_BYTES = (size_t)M * 16 * 4;
constexpr size_t WS_H = 466 * MiB;
constexpr size_t WS_QKV = 554 * MiB;
constexpr size_t WS_AO = 634 * MiB;
constexpr size_t WS_MP = 698 * MiB;
constexpr size_t WS_GATES = 890 * MiB;
constexpr size_t WS_HG = 891 * MiB;
constexpr size_t WS_END = 955 * MiB;
constexpr int CW_TMO = 0, CW_BAR = 4096;

struct Args { const float* x; const float* w1; const float* w3; const float* w2; const float* ln_g; const float* ln_b; const float* wqkv; const float* sinks; const float* wo;
              const float* win; const float* bg; const float* wmo; float* out; unsigned char* ws; };
typedef const __attribute__((address_space(4))) Args* kargs_t;
__device__ __forceinline__ kargs_t kargs() { kargs_t p = (kargs_t)__builtin_amdgcn_kernarg_segment_ptr(); asm volatile("" : "+s"(p)); return p; }

namespace pg8 {
#define PG8_LAS __attribute__((address_space(3)))
typedef unsigned short bf16_t;
typedef short bf16x8 __attribute__((ext_vector_type(8)));
typedef _Float16 f16x8 __attribute__((ext_vector_type(8)));
typedef float f32x4 __attribute__((ext_vector_type(4)));
typedef unsigned u32x4 __attribute__((ext_vector_type(4)));
constexpr int BM = 256, BK = 64, HALF = 128, HTB = HALF * BK * 2  , STAGE_BYTES = 8 * HTB, NXCD = 8, WGM = 8;

__host__ __device__ __forceinline__ int lds_byte(int r, int c) { const int st = (r >> 4) * 2 + (c >> 5), rr = r & 15, cc = c & 31, ob = rr * 64 + cc * 2; return st * 1024 + (ob ^ (((ob >> 9) & 1) << 5)); }
__host__ __device__ __forceinline__ void stage_rc(int b, int& R, int& C) { const int st = b / 1024, sb = b % 1024, swz = sb ^ (((sb >> 9) & 1) << 5); R = (st >> 1) * 16 + swz / 64; C = (st & 1) * 32 + (swz % 64) / 2; }
__host__ __device__ __forceinline__ int perm32(int rho) { const int n = rho >> 4, i = rho & 15; return 8 * (i >> 2) + 4 * n + (i & 3); }

typedef int i32x4 __attribute__((ext_vector_type(4)));
typedef int i32x8 __attribute__((ext_vector_type(8)));
constexpr float F8_SR = 8.f, F8_SW = 1024.f, F8_SH = 16.f, F8_SO = 64.f;
__device__ __forceinline__ i32x8 cat_i8(bf16x8 lo, bf16x8 hi) { const i32x4 a = __builtin_bit_cast(i32x4, lo), b = __builtin_bit_cast(i32x4, hi); return __builtin_shufflevector(a, b, 0, 1, 2, 3, 4, 5, 6, 7); }
__device__ __forceinline__ void mfma_f8_inplace(f32x4& c, const i32x8 a, const i32x8 b) { asm volatile("v_mfma_f32_16x16x128_f8f6f4 %0, %1, %2, %0 cbsz:0 blgp:0" : "+v"(c) : "v"(a), "v"(b)); }
typedef unsigned u32x2 __attribute__((ext_vector_type(2)));
__device__ __forceinline__ u32x2 cvt8_f8(const float (&v)[8], float s) {
    int a, b; asm volatile("" : "=v"(a), "=v"(b));
    a = __builtin_amdgcn_cvt_pk_fp8_f32(v[0] * s, v[1] * s, a, false); a = __builtin_amdgcn_cvt_pk_fp8_f32(v[2] * s, v[3] * s, a, true);
    b = __builtin_amdgcn_cvt_pk_fp8_f32(v[4] * s, v[5] * s, b, false); b = __builtin_amdgcn_cvt_pk_fp8_f32(v[6] * s, v[7] * s, b, true);
    return (u32x2){(unsigned)a, (unsigned)b};
}
__device__ __forceinline__ int pg8_lane() { int l; asm volatile("v_mbcnt_lo_u32_b32 %0, -1, 0\n\tv_mbcnt_hi_u32_b32 %0, -1, %0" : "=v"(l)); return l; }
struct Unit { int pm, pn, ord; };
struct Gemm { const bf16_t* A; const bf16_t* Bt; int M, N, K; };

struct StaticOrder {
    int nM, nN, nwg, G, c, r0 = 0, r1 = 1 << 20;
    __host__ __device__ void init(int M_, int N_, int G_, int c_) { nM = M_ / BM; nN = N_ / BM; nwg = nM * nN; G = G_; c = c_; }
    __host__ __device__ bool next(int i, Unit& u) const {
        i += r0; if (i >= r1) return false;
        const long L = (long)i * G + c; if (L >= nwg) return false;
        int wgid = (int)L; { const int q = nwg / NXCD, r = nwg % NXCD, xcd = wgid % NXCD, off = wgid / NXCD; wgid = (xcd < r ? xcd * (q + 1) : r * (q + 1) + (xcd - r) * q) + off; }
        const int nig = WGM * nN, gid = wgid / nig, fm = gid * WGM, gsz = (nM - fm) < WGM ? (nM - fm) : WGM;
        u.pm = fm + ((wgid % nig) % gsz); u.pn = (wgid % nig) / gsz; u.ord = i - r0; return true;
    }
    __device__ __forceinline__ void a_ready(const Unit&) const {}
    __device__ __forceinline__ void done(const Unit&) const {}
};

__device__ __forceinline__ unsigned cvt_pk_bf16(float lo, float hi) { typedef float f2 __attribute__((ext_vector_type(2))); typedef _Float16 b2 __attribute__((ext_vector_type(2))); f2 v = {lo, hi}; b2 b = __builtin_convertvector(v, b2); return __builtin_bit_cast(unsigned, b); }
__device__ __forceinline__ float bf_lo(unsigned w) { typedef _Float16 b2 __attribute__((ext_vector_type(2))); return (float)__builtin_bit_cast(b2, w)[0]; }
__device__ __forceinline__ float bf_hi(unsigned w) { typedef _Float16 b2 __attribute__((ext_vector_type(2))); return (float)__builtin_bit_cast(b2, w)[1]; }
__device__ __forceinline__ float fsigmoid(float x) { return __builtin_amdgcn_rcpf(1.f + __builtin_amdgcn_exp2f(-LOG2E * x)); }

__device__ __forceinline__ float sum_fq(float v) {
    auto a = __builtin_amdgcn_permlane16_swap(__float_as_uint(v), __float_as_uint(v), false, false); v = __uint_as_float(a[0]) + __uint_as_float(a[1]);
    auto b = __builtin_amdgcn_permlane32_swap(__float_as_uint(v), __float_as_uint(v), false, false); return __uint_as_float(b[0]) + __uint_as_float(b[1]);
}
constexpr int STAB_OFF = 131072 + 16384;
__device__ __forceinline__ void stats_prep(const float* sp, int pm, int wave) {
    PG8_LAS float* stab = (PG8_LAS float*)(STAB_OFF);
    const int tid = wave * 64 + pg8_lane();
    if (tid < BM) {
        const f32x4* p = (const f32x4*)(sp + (size_t)(pm * BM + tid) * 16);
        const f32x4 v0 = p[0], v1 = p[1], v2 = p[2], v3 = p[3];
        const float s = ((v0[0] + v0[2]) + (v1[0] + v1[2])) + ((v2[0] + v2[2]) + (v3[0] + v3[2])), q = ((v0[1] + v0[3]) + (v1[1] + v1[3])) + ((v2[1] + v2[3]) + (v3[1] + v3[3]));
        const float mean = s * (1.f / D), var = q * (1.f / D) - mean * mean;
        typedef float f32x2v __attribute__((ext_vector_type(2)));
        *(PG8_LAS f32x2v*)(stab + 2 * tid) = (f32x2v){mean, __builtin_amdgcn_rsqf(var + LN_EPS)};
    }
    if (tid == 0) *(PG8_LAS int*)(stab + 2 * BM) = pm;
}
constexpr int CTAB_OFF = STAB_OFF + 2048 + 64, CTAB_UNITS = 11;
template <class Sched> __device__ __forceinline__ void ctab_prep(const Sched& S, const float* c1, const float* c2, int wave) {
    const int tid = wave * 64 + pg8_lane();
    Unit u;
    for (int i = 0; i < CTAB_UNITS && S.next(i, u); ++i) {
        const float v = tid < BM ? c1[u.pn * BM + tid] : c2[u.pn * BM + tid - BM];
        typedef _Float16 h1;
        *(PG8_LAS h1*)(CTAB_OFF + i * 1024 + tid * 2) = (h1)v;
    }
}
__device__ __forceinline__ void ctab_get8(int ord, int which, int lc, float (&o)[8]) {
    typedef _Float16 h8 __attribute__((ext_vector_type(8)));
    const h8 v = *(PG8_LAS const h8*)(CTAB_OFF + ord * 1024 + which * 512 + lc * 2);
#pragma unroll
    for (int i = 0; i < 8; ++i) o[i] = (float)v[i];
}
__device__ __forceinline__ void row_stats(const float* sp, int row0, int fq, float (&mu)[2][4], float (&rs)[2][4]) {
    { PG8_LAS const float* stab = (PG8_LAS const float*)(STAB_OFF); const int pm = row0 / BM;
      if (*(PG8_LAS const int*)(stab + 2 * BM) == pm) {
          typedef float f32x2v __attribute__((ext_vector_type(2)));
#pragma unroll
          for (int ai = 0; ai < 2; ++ai)
#pragma unroll
              for (int m = 0; m < 4; ++m) { const f32x2v v = *(PG8_LAS const f32x2v*)(stab + 2 * ((row0 % BM) + ai * HALF + m * 16)); mu[ai][m] = v[0]; rs[ai][m] = v[1]; }
          return; } }
#pragma unroll
    for (int ai = 0; ai < 2; ++ai)
#pragma unroll
        for (int m = 0; m < 4; ++m) {
            const f32x4 v = *(const f32x4*)(sp + (size_t)(row0 + ai * HALF + m * 16) * 16 + fq * 4);
            float s = v[0] + v[2], q = v[1] + v[3];
            s = sum_fq(s); q = sum_fq(q);
            const float mean = s * (1.f / D), var = q * (1.f / D) - mean * mean;
            mu[ai][m] = mean; rs[ai][m] = __builtin_amdgcn_rsqf(var + LN_EPS);
        }
}

struct EpiNull {
    static constexpr bool PERM = true, AFTER_DRAIN = false;
    template <class Sched> __device__ __forceinline__ void prep(const Sched&, const Unit&, int) const {}
    float* sink;
    __device__ __forceinline__ void operator()(const f32x4 (&acc)[2][2][4][2], const Unit& u, int wr, int wc, int, int) const {
        float s = 0.f;
#pragma unroll
        for (int ai = 0; ai < 2; ++ai)
#pragma unroll
            for (int bj = 0; bj < 2; ++bj)
#pragma unroll
                for (int m = 0; m < 4; ++m)
#pragma unroll
                    for (int n = 0; n < 2; ++n) s += acc[ai][bj][m][n][0] + acc[ai][bj][m][n][1] + acc[ai][bj][m][n][2] + acc[ai][bj][m][n][3];
        if (s == 123.456f) sink[u.pm + wr + wc] = s;
    }
};

struct EpiUp {
    static constexpr bool PERM = true, AFTER_DRAIN = false;
    template <class Sched> __device__ __forceinline__ void prep(const Sched& S, const Unit& u, int wave) const { unsigned char* ws = kargs()->ws;
        stats_prep((const float*)(ws + WS_SP) + (size_t)tpar * (SP_BYTES / 4), u.pm, wave);
        ctab_prep(S, (const float*)(ws + WS_VEC + V_C1U) + (size_t)f * NUP, (const float*)(ws + WS_VEC + V_C2U) + (size_t)f * NUP, wave); }
    int f, tpar;
    __device__ __forceinline__ void operator()(const f32x4 (&acc)[2][2][4][2], const Unit& u, int wr, int wc, int, int) const {
        const int lane_ = pg8_lane(), fr = lane_ & 15, fq = lane_ >> 4;
        const int row0 = u.pm * BM + wr * 64 + fr;
        int f = this->f, tpar = this->tpar; asm volatile("" : "+s"(f), "+s"(tpar));
        unsigned char* ws = kargs()->ws; unsigned char* H = ws + WS_H;
        const float* c1 = (const float*)(ws + WS_VEC + V_C1U) + (size_t)f * NUP; const float* c2 = (const float*)(ws + WS_VEC + V_C2U) + (size_t)f * NUP; const float* sp = (const float*)(ws + WS_SP) + (size_t)tpar * (SP_BYTES / 4);
        float mu[2][4], rs[2][4]; row_stats(sp, row0, fq, mu, rs);
        const int cb = u.pn * BM + wc * 32 + 8 * fq;
        float k1[2][8], k2[2][8];
        if (u.ord < CTAB_UNITS) {
#pragma unroll
            for (int bj = 0; bj < 2; ++bj) { ctab_get8(u.ord, 0, wc * 32 + 8 * fq + bj * HALF, k1[bj]); ctab_get8(u.ord, 1, wc * 32 + 8 * fq + bj * HALF, k2[bj]); }
        } else {
#pragma unroll
            for (int bj = 0; bj < 2; ++bj)
#pragma unroll
                for (int i = 0; i < 8; ++i) { k1[bj][i] = c1[cb + bj * HALF + i]; k2[bj][i] = c2[cb + bj * HALF + i]; }
        }
        unsigned char* hp = H + (size_t)row0 * FF + u.pn * HALF + wc * 32 + 8 * fq;
#pragma unroll
        for (int ai = 0; ai < 2; ++ai)
#pragma unroll
            for (int m = 0; m < 4; ++m) {
                const float r_ = rs[ai][m], nm = -mu[ai][m] * r_, ra = r_ * (1.f / (F8_SR * F8_SW));
                float hv[8];
#pragma unroll
                for (int n = 0; n < 2; ++n)
#pragma unroll
                    for (int j = 0; j < 4; ++j) {
                        const float ga = acc[ai][0][m][n][j] * ra + (nm * k1[0][4 * n + j] + k2[0][4 * n + j]);
                        const float ub = acc[ai][1][m][n][j] * ra + (nm * k1[1][4 * n + j] + k2[1][4 * n + j]);
                        hv[4 * n + j] = ga * fsigmoid(ga) * ub;
                    }
                *(u32x2*)(hp + (size_t)(ai * HALF + m * 16) * FF) = cvt8_f8(hv, F8_SH);
            }
    }
};

struct EpiLnOut {
    static constexpr bool PERM = true, AFTER_DRAIN = false;
    template <class Sched> __device__ __forceinline__ void prep(const Sched&, const Unit& u, int wave) const { stats_prep((const float*)(kargs()->ws + WS_SP) + (size_t)tpar * (SP_BYTES / 4), u.pm, wave); }
    int mode, j, tpar;
    __device__ __forceinline__ void operator()(const f32x4 (&acc)[2][2][4][2], const Unit& u, int wr, int wc, int, int) const {
        const int lane_ = pg8_lane(), fr = lane_ & 15, fq = lane_ >> 4;
        const int row0 = u.pm * BM + wr * 64 + fr;
        int mode = this->mode, j = this->j, tpar = this->tpar; asm volatile("" : "+s"(mode), "+s"(j), "+s"(tpar));
        const bool att = mode == 0; const int coff = mode == 2 ? 4096 : 0;
        unsigned char* ws = kargs()->ws; bf16_t* O = (bf16_t*)(ws + (att ? WS_QKV : WS_MP)) + coff; const int ldo = att ? NQKV : NMI, sig_from = mode == 2 ? 0 : (mode == 1 ? 16 : 1000);
        const float ascale = mode == 1 ? 1.f : 1.f / (F8_SR * F8_SW);
        const float* c1 = (const float*)(ws + WS_VEC + (att ? V_C1Q : V_C1I)) + j * ldo + coff; const float* c2 = (const float*)(ws + WS_VEC + (att ? V_C2Q : V_C2I)) + j * ldo + coff; const float* sp = (const float*)(ws + WS_SP) + (size_t)tpar * (SP_BYTES / 4);
        float mu[2][4], rs[2][4]; row_stats(sp, row0, fq, mu, rs);
        const int cb = u.pn * BM + wc * 32 + 8 * fq;
        const bool sg = u.pn >= sig_from;
        f32x4 k1[2][2], k2[2][2];
#pragma unroll
        for (int bj = 0; bj < 2; ++bj)
#pragma unroll
            for (int n = 0; n < 2; ++n) { k1[bj][n] = *(const f32x4*)(c1 + cb + bj * HALF + 4 * n); k2[bj][n] = *(const f32x4*)(c2 + cb + bj * HALF + 4 * n); }
        bf16_t* op = O + (size_t)row0 * ldo + cb;
#pragma unroll
        for (int ai = 0; ai < 2; ++ai)
#pragma unroll
            for (int m = 0; m < 4; ++m) {
                const float r_ = rs[ai][m], nm = -mu[ai][m] * r_, ra = r_ * ascale;
#pragma unroll
                for (int bj = 0; bj < 2; ++bj) {
                    float v[8];
#pragma unroll
                    for (int n = 0; n < 2; ++n)
#pragma unroll
                        for (int j = 0; j < 4; ++j) { float t = acc[ai][bj][m][n][j] * ra + (nm * k1[bj][n][j] + k2[bj][n][j]); if (sg) t = fsigmoid(t); v[4 * n + j] = t; }
                    u32x4 w; w.x = cvt_pk_bf16(v[0], v[1]); w.y = cvt_pk_bf16(v[2], v[3]); w.z = cvt_pk_bf16(v[4], v[5]); w.w = cvt_pk_bf16(v[6], v[7]);
                    *(u32x4*)(op + (size_t)(ai * HALF + m * 16) * ldo + bj * HALF) = w;
                }
            }
    }
};

struct EpiRes {
    static constexpr bool PERM = true, AFTER_DRAIN = false;
    template <class Sched> __device__ __forceinline__ void prep(const Sched&, const Unit& u, int wave) const { stats_prep((const float*)(kargs()->ws + WS_SP) + (size_t)(t & 1) * (SP_BYTES / 4), u.pm, wave); }
    int t; float coef; PG8_LAS float* tab; int wave; int dry;
    __device__ __forceinline__ void operator()(const f32x4 (&acc)[2][2][4][2], const Unit& u, int wr, int wc, int, int) const {
        const int lane_ = pg8_lane(), fr = lane_ & 15, fq = lane_ >> 4;
        typedef float f32x2v __attribute__((ext_vector_type(2)));
        const int row0 = u.pm * BM + wr * 64 + fr;
        int t = this->t; asm volatile("" : "+s"(t));
        const bool need8 = (t != 3 && t != 9 && t != 11) || dry;
        kargs_t ka = kargs(); unsigned char* ws = ka->ws; bf16_t* R = (bf16_t*)(ws + WS_R); unsigned char* R8 = ws + (dry ? WS_MP + 64 * MiB : WS_R8); bf16_t* Ro = dry ? (bf16_t*)(ws + WS_MP) : R;
        const float* g = t ? ka->ln_g + (size_t)(t - 1) * D : (const float*)(ws + WS_VEC + V_ONES); const float* b = t ? ka->ln_b + (size_t)(t - 1) * D : (const float*)(ws + WS_VEC + V_ZEROS);
        const float* sp_in = (const float*)(ws + WS_SP) + (size_t)(t & 1) * (SP_BYTES / 4); float* sp_out = dry ? (float*)(ws + WS_MP + 96 * MiB) : (float*)(ws + WS_SP) + (size_t)((t + 1) & 1) * (SP_BYTES / 4);
        const int cb0 = u.pn * BM + wc * 32 + 8 * fq;
        u32x4 cur[4];
#pragma unroll
        for (int m = 0; m < 4; ++m) cur[m] = *(const u32x4*)(R + (size_t)(row0 + m * 16) * D + cb0);
        float mu[2][4], rs[2][4]; row_stats(sp_in, row0, fq, mu, rs);
        f32x4 gv[2], bv[2];
#pragma unroll
        for (int k = 0; k < 4; ++k) {
            const int bj = k >> 1, ai = k & 1, cb = cb0 + bj * HALF;
            if (ai == 0) {
#pragma unroll
                for (int n = 0; n < 2; ++n) { gv[n] = *(const f32x4*)(g + cb + 4 * n); bv[n] = *(const f32x4*)(b + cb + 4 * n) * ALPHA; }
            }
#pragma unroll
            for (int m = 0; m < 4; ++m) {
                const float A_ = ALPHA * rs[ai][m], B_ = -mu[ai][m] * A_;
                const size_t off = (size_t)(row0 + ai * HALF + m * 16) * D + cb;
                const u32x4 o = cur[m];
                if (k < 3 && dry != 3) cur[m] = *(const u32x4*)(R + (size_t)(row0 + ((k + 1) & 1) * HALF + m * 16) * D + cb0 + ((k + 1) >> 1) * HALF);
                const float ro[8] = {bf_lo(o.x), bf_hi(o.x), bf_lo(o.y), bf_hi(o.y), bf_lo(o.z), bf_hi(o.z), bf_lo(o.w), bf_hi(o.w)};
                float nv[8];
#pragma unroll
                for (int n = 0; n < 2; ++n)
#pragma unroll
                    for (int j = 0; j < 4; ++j) nv[4 * n + j] = (ro[4 * n + j] * A_ + B_) * gv[n][j] + bv[n][j] + coef * acc[ai][bj][m][n][j];
                u32x4 w; w.x = cvt_pk_bf16(nv[0], nv[1]); w.y = cvt_pk_bf16(nv[2], nv[3]); w.z = cvt_pk_bf16(nv[4], nv[5]); w.w = cvt_pk_bf16(nv[6], nv[7]);
                if (dry != 2) { *(u32x4*)(Ro + off) = w;
                if (need8) *(u32x2*)(R8 + off) = cvt8_f8(nv, F8_SR); }
                const float f0 = bf_lo(w.x), f1 = bf_hi(w.x), f2 = bf_lo(w.y), f3 = bf_hi(w.y), f4 = bf_lo(w.z), f5 = bf_hi(w.z), f6 = bf_lo(w.w), f7 = bf_hi(w.w);
                float s = ((f0 + f1) + (f2 + f3)) + ((f4 + f5) + (f6 + f7));
                float q = ((f0 * f0 + f1 * f1) + (f2 * f2 + f3 * f3)) + ((f4 * f4 + f5 * f5) + (f6 * f6 + f7 * f7));
                s = sum_fq(s); q = sum_fq(q);
                if (fq == 0) *(PG8_LAS f32x2v*)(tab + (((ai * HALF + wr * 64 + m * 16 + fr) * 4 + wc) * 2 + bj) * 2) = (f32x2v){s, q};
                asm volatile("" ::: "memory");
            }
        }
        asm volatile("s_waitcnt lgkmcnt(0)" ::: "memory"); __builtin_amdgcn_s_barrier(); asm volatile("" ::: "memory");
        const int tid = wave * 64 + pg8_lane();
        if (tid < BM) {
            const PG8_LAS f32x4* t4 = (const PG8_LAS f32x4*)(tab + tid * 16);
            const f32x4 a = t4[0], c = t4[1], d = t4[2], e = t4[3];
            *(f32x2v*)(sp_out + (size_t)(u.pm * BM + tid) * 16 + u.pn * 2) = (f32x2v){((a[0] + a[2]) + (c[0] + c[2])) + ((d[0] + d[2]) + (e[0] + e[2])), ((a[1] + a[3]) + (c[1] + c[3])) + ((d[1] + d[3]) + (e[1] + e[3]))};
        }
    }
};

template <class Epi, class Sched, bool ALIGN_EPI = false, bool SP2 = false, bool F8 = false>
__device__ __forceinline__ void gemm_phase(PG8_LAS unsigned char* lds, const Gemm g, const Sched& S, const Epi& E, int wave_in) {
    int wid = wave_in; asm volatile("" : "+s"(wid));
    const int lane = pg8_lane(), tid = wid * 64 + lane, wr = wid >> 2, wc = wid & 3, fr = lane & 15, fq = lane >> 4;
    const int K = g.K, nt = K / BK;
    unsigned voffA[2], voffB[2];
#pragma unroll
    for (int i = 0; i < 2; ++i) { int R, C; stage_rc(tid * 16 + i * 8192, R, C); const int Rb = Epi::PERM ? ((R & ~31) + perm32(R & 31)) : R;
        voffA[i] = (unsigned)(R * K + C) * 2u; voffB[i] = (unsigned)(Rb * K + C) * 2u; }
    const size_t kstep = (size_t)(BK * 2);
    const size_t hstep = (size_t)HALF * K * 2;
    const size_t tstep = 2 * hstep;
    const unsigned ldsw = (unsigned)wid * 1024u;
    const int aoff = lds_byte(wr * 64 + fr, fq * 8), boff = lds_byte(wc * 32 + fr, fq * 8);
#define PG8_SA(b, h) (((b) * 2 + (h)) * HTB)
#define PG8_SB(b, h) ((4 + (b) * 2 + (h)) * HTB)
#define PG8_STAGE(bufoff, gbase, voff) do { _Pragma("unroll") for (int _i = 0; _i < 2; ++_i) \
        __builtin_amdgcn_global_load_lds((const unsigned*)((const char*)(gbase) + (voff)[_i]), (PG8_LAS unsigned*)(lds + (bufoff) + ldsw + _i * 8192), 16, 0, 0); } while (0)
#define PG8_LDA(dst, b, h) do { _Pragma("unroll") for (int m = 0; m < 4; ++m) _Pragma("unroll") for (int k = 0; k < 2; ++k) dst[m][k] = *(const PG8_LAS bf16x8*)(lds + PG8_SA(b, h) + aoff + m * 2048 + k * 1024); } while (0)
#define PG8_LDB(dst, b, h) do { _Pragma("unroll") for (int n = 0; n < 2; ++n) _Pragma("unroll") for (int k = 0; k < 2; ++k) dst[n][k] = *(const PG8_LAS bf16x8*)(lds + PG8_SB(b, h) + boff + n * 2048 + k * 1024); } while (0)
#define PG8_MMA(ai, bj, At, Bt) do { __builtin_amdgcn_s_setprio(1); _Pragma("unroll") for (int m = 0; m < 4; ++m) _Pragma("unroll") for (int n = 0; n < 2; ++n) { \
        if constexpr (F8) mfma_f8_inplace(acc[ai][bj][m][n], cat_i8(Bt[n][0], Bt[n][1]), cat_i8(At[m][0], At[m][1])); \
        else { _Pragma("unroll") for (int k = 0; k < 2; ++k) acc[ai][bj][m][n] = __builtin_amdgcn_mfma_f32_16x16x32_f16(__builtin_bit_cast(f16x8, Bt[n][k]), __builtin_bit_cast(f16x8, At[m][k]), acc[ai][bj][m][n], 0, 0, 0); } } \
        __builtin_amdgcn_s_setprio(0); } while (0)
#define PG8_WAIT_V(n) asm volatile("s_waitcnt vmcnt(" #n ")" ::: "memory")
#define PG8_WAIT_L(n) asm volatile("s_waitcnt lgkmcnt(" #n ")" ::: "memory")
#define PG8_BAR __builtin_amdgcn_s_barrier()
#define PG8_SCHED __builtin_amdgcn_sched_barrier(0)
    Unit cur, nxt; int ui = 0;
    if (!S.next(0, cur)) return;
    E.prep(S, cur, wave_in);
    f32x4 acc[2][2][4][2];
#pragma unroll
    for (int a = 0; a < 2; ++a)
#pragma unroll
        for (int b = 0; b < 2; ++b)
#pragma unroll
            for (int m = 0; m < 4; ++m)
#pragma unroll
                for (int n = 0; n < 2; ++n) { float z0, z1, z2, z3; asm volatile("v_mov_b32 %0, 0\n\tv_mov_b32 %1, 0\n\tv_mov_b32 %2, 0\n\tv_mov_b32 %3, 0" : "=v"(z0), "=v"(z1), "=v"(z2), "=v"(z3)); acc[a][b][m][n] = (f32x4){z0, z1, z2, z3}; }
    bf16x8 At[4][2], B0[2][2], B1[2][2];
    const char* cA = (const char*)g.A + (size_t)cur.pm * tstep; const char* cB = (const char*)g.Bt + (size_t)cur.pn * tstep;
    S.a_ready(cur);
    if constexpr (SP2) {
        PG8_STAGE(PG8_SB(0, 0), cB, voffB); PG8_STAGE(PG8_SB(0, 1), cB + hstep, voffB); PG8_STAGE(PG8_SA(0, 0), cA, voffA); PG8_STAGE(PG8_SA(0, 1), cA + hstep, voffA);
        if (wr == 1) PG8_BAR;
        PG8_WAIT_V(2); PG8_BAR;
        PG8_STAGE(PG8_SB(1, 0), cB + kstep, voffB); PG8_STAGE(PG8_SA(1, 0), cA + kstep, voffA); PG8_STAGE(PG8_SB(1, 1), cB + hstep + kstep, voffB);
        PG8_WAIT_V(6); PG8_BAR;
    } else {
        PG8_STAGE(PG8_SB(0, 0), cB, voffB); PG8_STAGE(PG8_SA(0, 0), cA, voffA); PG8_STAGE(PG8_SB(0, 1), cB + hstep, voffB); PG8_STAGE(PG8_SA(0, 1), cA + hstep, voffA);
        if (wr == 1) PG8_BAR;
        PG8_WAIT_V(4); PG8_BAR;
        PG8_STAGE(PG8_SB(1, 0), cB + kstep, voffB); PG8_STAGE(PG8_SA(1, 0), cA + kstep, voffA); PG8_STAGE(PG8_SB(1, 1), cB + hstep + kstep, voffB);
        PG8_WAIT_V(6); PG8_BAR;
    }
    for (;;) {
        const bool has_next = S.next(ui + 1, nxt);
        const char* nA = has_next ? (const char*)g.A + (size_t)nxt.pm * tstep : cA; const char* nB = has_next ? (const char*)g.Bt + (size_t)nxt.pn * tstep : cB;
        for (int t = 0; t < nt; t += 2) {
            const bool last = (t == nt - 2);
            const char* a1 = cA + (size_t)(t + 1) * kstep;
            const char* a2 = last ? nA : cA + (size_t)(t + 2) * kstep; const char* b2 = last ? nB : cB + (size_t)(t + 2) * kstep;
            const char* a3 = a2 + kstep; const char* b3 = b2 + kstep;
            if (last && has_next) S.a_ready(nxt);
            if constexpr (SP2) {
            PG8_LDB(B0, 0, 0); PG8_LDB(B1, 0, 1); PG8_SCHED; PG8_LDA(At, 0, 0); PG8_STAGE(PG8_SA(1, 1), a1 + hstep, voffA);
            PG8_WAIT_V(8); PG8_WAIT_L(0); PG8_BAR; PG8_MMA(0, 0, At, B0); PG8_MMA(0, 1, At, B1); PG8_BAR; PG8_SCHED;
            PG8_LDA(At, 0, 1); PG8_STAGE(PG8_SB(0, 0), b2, voffB); PG8_STAGE(PG8_SB(0, 1), b2 + hstep, voffB); PG8_STAGE(PG8_SA(0, 0), a2, voffA);
            PG8_WAIT_V(8); PG8_WAIT_L(0); PG8_BAR; PG8_MMA(1, 0, At, B0); PG8_MMA(1, 1, At, B1); PG8_BAR; PG8_SCHED;
            PG8_LDB(B0, 1, 0); PG8_LDB(B1, 1, 1); PG8_SCHED; PG8_LDA(At, 1, 0); PG8_STAGE(PG8_SA(0, 1), a2 + hstep, voffA);
            PG8_WAIT_V(8); PG8_WAIT_L(0); PG8_BAR; PG8_MMA(0, 0, At, B0); PG8_MMA(0, 1, At, B1); PG8_BAR; PG8_SCHED;
            PG8_LDA(At, 1, 1); PG8_STAGE(PG8_SB(1, 0), b3, voffB); PG8_STAGE(PG8_SB(1, 1), b3 + hstep, voffB); PG8_STAGE(PG8_SA(1, 0), a3, voffA);
            PG8_WAIT_V(8); PG8_WAIT_L(0); PG8_BAR; PG8_MMA(1, 0, At, B0); PG8_MMA(1, 1, At, B1); PG8_BAR; PG8_SCHED;
            } else {
            PG8_LDB(B0, 0, 0); PG8_SCHED; PG8_LDA(At, 0, 0); PG8_STAGE(PG8_SA(1, 1), a1 + hstep, voffA);
            PG8_WAIT_L(8); PG8_BAR; PG8_WAIT_L(0); PG8_MMA(0, 0, At, B0); PG8_BAR; PG8_SCHED;
            PG8_LDB(B1, 0, 1); PG8_STAGE(PG8_SB(0, 0), b2, voffB);
            PG8_BAR; PG8_WAIT_L(0); PG8_MMA(0, 1, At, B1); PG8_BAR;
            PG8_LDA(At, 0, 1); PG8_STAGE(PG8_SA(0, 0), a2, voffA);
            PG8_BAR; PG8_WAIT_L(0); PG8_MMA(1, 0, At, B0); PG8_BAR; PG8_SCHED;
            PG8_STAGE(PG8_SB(0, 1), b2 + hstep, voffB);
            PG8_WAIT_V(6); PG8_BAR; PG8_MMA(1, 1, At, B1); PG8_BAR;
            PG8_LDB(B0, 1, 0); PG8_SCHED; PG8_LDA(At, 1, 0); PG8_STAGE(PG8_SA(0, 1), a2 + hstep, voffA);
            PG8_WAIT_L(8); PG8_BAR; PG8_WAIT_L(0); PG8_MMA(0, 0, At, B0); PG8_BAR; PG8_SCHED;
            PG8_LDB(B1, 1, 1); PG8_STAGE(PG8_SB(1, 0), b3, voffB);
            PG8_BAR; PG8_WAIT_L(0); PG8_MMA(0, 1, At, B1); PG8_BAR;
            PG8_LDA(At, 1, 1); PG8_STAGE(PG8_SA(1, 0), a3, voffA);
            PG8_BAR; PG8_WAIT_L(0); PG8_MMA(1, 0, At, B0); PG8_BAR; PG8_SCHED;
            PG8_STAGE(PG8_SB(1, 1), b3 + hstep, voffB);
            PG8_WAIT_V(6); PG8_BAR; PG8_MMA(1, 1, At, B1); PG8_BAR;
            }
        }
        if constexpr (F8) asm volatile("s_nop 15\n\ts_nop 7" ::: "memory");
        if constexpr (ALIGN_EPI) { if (wr == 0) PG8_BAR; }
        if constexpr (!Epi::AFTER_DRAIN) { E(acc, cur, wr, wc, fr, fq); S.done(cur); }
        if (!has_next) break;
#pragma unroll
        for (int a = 0; a < 2; ++a)
#pragma unroll
            for (int b = 0; b < 2; ++b)
#pragma unroll
                for (int m = 0; m < 4; ++m)
#pragma unroll
                    for (int n = 0; n < 2; ++n) { float z0, z1, z2, z3; asm volatile("v_mov_b32 %0, 0\n\tv_mov_b32 %1, 0\n\tv_mov_b32 %2, 0\n\tv_mov_b32 %3, 0" : "=v"(z0), "=v"(z1), "=v"(z2), "=v"(z3)); acc[a][b][m][n] = (f32x4){z0, z1, z2, z3}; }
        cur = nxt; cA = nA; cB = nB; ++ui;
        if constexpr (ALIGN_EPI) { if (wr == 1) PG8_BAR; }
    }
    PG8_WAIT_V(0);
    if constexpr (!ALIGN_EPI) { if (wr == 0) PG8_BAR; }
    PG8_BAR;
    if constexpr (Epi::AFTER_DRAIN) { E.fused(acc, cur, wr, wc, fr, fq, lds, wid, lane); S.done(cur); }
#undef PG8_SA
#undef PG8_SB
#undef PG8_STAGE
#undef PG8_LDA
#undef PG8_LDB
#undef PG8_MMA
#undef PG8_WAIT_V
#undef PG8_WAIT_L
#undef PG8_BAR
#undef PG8_SCHED
}
}

#ifndef PG8_SP2
#define PG8_SP2 true
#endif

#define GAS __attribute__((address_space(1)))
#define LAS __attribute__((address_space(3)))
typedef unsigned short bf16;
typedef unsigned v4u __attribute__((ext_vector_type(4)));
typedef unsigned v2u __attribute__((ext_vector_type(2)));
typedef float f32x4 __attribute__((ext_vector_type(4)));
typedef float f32x2 __attribute__((ext_vector_type(2)));
typedef float f32x16 __attribute__((ext_vector_type(16)));
typedef short bf16x8 __attribute__((ext_vector_type(8)));
typedef short s16x4 __attribute__((ext_vector_type(4)));
typedef GAS unsigned gu32;
typedef GAS unsigned long long gu64;
typedef LAS const char* lcp;
typedef LAS char* lwp;
#define RLX_AGENT __ATOMIC_RELAXED, __HIP_MEMORY_SCOPE_AGENT
#define LDS_WAIT() asm volatile("s_waitcnt lgkmcnt(0)" ::: "memory")
#define VM_WAIT() asm volatile("s_waitcnt vmcnt(0)" ::: "memory")
#define WG_BAR() do { asm volatile("s_waitcnt vmcnt(0) lgkmcnt(0)" ::: "memory"); __builtin_amdgcn_s_barrier(); asm volatile("" ::: "memory"); } while (0)
#define DI __device__ __forceinline__
#define MFMA32(a, b, c) __builtin_amdgcn_mfma_f32_32x32x16_f16(__builtin_bit_cast(pg8::f16x8, (a)), __builtin_bit_cast(pg8::f16x8, (b)), (c), 0, 0, 0)
DI unsigned pk2(float lo, float hi) { return pg8::cvt_pk_bf16(lo, hi); }
DI float bflo(unsigned w) { return pg8::bf_lo(w); }
DI float bfhi(unsigned w) { return pg8::bf_hi(w); }
DI float ex2(float x) { return __builtin_amdgcn_exp2f(x); }
DI f32x16 zero16() { float z = 0.f; asm volatile("" : "+v"(z)); return (f32x16){z, z, z, z, z, z, z, z, z, z, z, z, z, z, z, z}; }
DI int crow(int r, int hi) { return (r & 3) + 8 * (r >> 2) + 4 * hi; }
#define SWZ_XOR(v, m) __uint_as_float((unsigned)__builtin_amdgcn_ds_swizzle((int)__float_as_uint(v), ((m) << 10) | 0x1f))
DI float half_swap_add(float v);
DI float wave_sum(float v) { v += SWZ_XOR(v, 1); v += SWZ_XOR(v, 2); v += SWZ_XOR(v, 4); v += SWZ_XOR(v, 8); v += SWZ_XOR(v, 16); return half_swap_add(v); }
DI float shfl_lane(float v, int src_lane) { return __uint_as_float((unsigned)__builtin_amdgcn_ds_bpermute(src_lane << 2, (int)__float_as_uint(v))); }
DI float half_swap_add(float v) { auto rr = __builtin_amdgcn_permlane32_swap(__float_as_uint(v), __float_as_uint(v), false, false); return __uint_as_float(rr[0]) + __uint_as_float(rr[1]); }
DI float half_swap_max(float v) { auto rr = __builtin_amdgcn_permlane32_swap(__float_as_uint(v), __float_as_uint(v), false, false); return fmaxf(__uint_as_float(rr[0]), __uint_as_float(rr[1])); }
typedef short v4i16_t __attribute__((ext_vector_type(4)));
DI s16x4 vtr(lcp p) { return __builtin_bit_cast(s16x4, __builtin_amdgcn_ds_read_tr16_b64_v4i16((LAS v4i16_t*)p)); }
DI bf16x8 cat8(s16x4 lo, s16x4 hi) { return (bf16x8){lo[0], lo[1], lo[2], lo[3], hi[0], hi[1], hi[2], hi[3]}; }
DI bf16x8 trfrag(lcp p) { return cat8(vtr(p), vtr(p + 512)); }
DI bf16x8 ldfrag(lcp p) { return *(const LAS bf16x8*)p; }
DI void glds16(const void* gsrc, LAS void* ldst) { __builtin_amdgcn_global_load_lds((const unsigned*)gsrc, (LAS unsigned*)ldst, 16, 0, 0); }
#define PACK8(x, s) ((bf16x8)__builtin_bit_cast(bf16x8, (v4u){pk2((x)[8 * (s) + 0], (x)[8 * (s) + 1]), pk2((x)[8 * (s) + 2], (x)[8 * (s) + 3]), pk2((x)[8 * (s) + 4], (x)[8 * (s) + 5]), pk2((x)[8 * (s) + 6], (x)[8 * (s) + 7])}))

constexpr int RING_OFF = 0, RING_BYTES = 131072;
constexpr int TAB_OFF = 131072;
constexpr int MISC_OFF = 163840 - 256;
constexpr int LDS_BYTES = 163840;
constexpr int AT_K = 0, AT_V = 32768, AT_WS = 65536, AT_STG = 67584;
constexpr int ML_K = 0, ML_V = 65536, ML_VW = 81920, ML_C = 98304, ML_N = 131072, ML_G2 = 131584, ML_M2 = 132096, ML_FI = 132608, ML_EI = 133120, ML_WK = 133632, ML_WKB = 134144, ML_SC = 134400, ML_WS = 134464, ML_STG = 136512;
static_assert(ML_STG + 4 * 4096 <= MISC_OFF && AT_STG + 8 * 4096 <= MISC_OFF && pg8::CTAB_OFF + pg8::CTAB_UNITS * 1024 <= MISC_OFF && pg8::STAB_OFF == TAB_OFF + 16384, "LDS map");

#define XB_TMO      128
#define XB_XCNT(j)  (256  + 64 * (j))
#define XB_XSUB(j)  (1280 + 64 * (j))
#define XB_XGEN(j)  (2304 + 64 * (j))
#define XB_TOP      3328
#define XB_TOPGEN   3392
#define XCD_BAR_WORDS 3456
#define XB_SPIN_CAP (1u << 18)

__device__ __forceinline__ unsigned xb_ld(unsigned* p)              { return __hip_atomic_load(p, __ATOMIC_RELAXED, __HIP_MEMORY_SCOPE_AGENT); }
__device__ __forceinline__ unsigned xb_add(unsigned* p, unsigned v) { return __hip_atomic_fetch_add(p, v, __ATOMIC_RELAXED, __HIP_MEMORY_SCOPE_AGENT); }
__device__ __forceinline__ unsigned xb_xcc_id() { return (unsigned)__builtin_amdgcn_s_getreg((3 << 11) | 20) & 0xFu; }
#define XB_SPIN(cond, bar) do { unsigned _sp = 0; while (cond) { __builtin_amdgcn_s_sleep(1); \
    if ((++_sp & 255u) == 0u) { if (xb_ld(&(bar)[XB_TMO])) break; if (_sp > XB_SPIN_CAP) { atomicAdd(&(bar)[XB_TMO], 1u); break; } } } } while (0)

struct XcdBarrier {
    unsigned* bar; unsigned x;
    volatile LAS unsigned* st;
    unsigned total;
};

__device__ __forceinline__ XcdBarrier xcd_barrier_post(unsigned* bar, volatile LAS unsigned* st) {
    XcdBarrier b; b.bar = bar; b.x = xb_xcc_id(); b.st = st; b.total = gridDim.x * gridDim.y * gridDim.z;
    if (threadIdx.x == 0) (void)xb_add(&bar[XB_XCNT(b.x)], 1u);
    return b;
}
__device__ __forceinline__ void xcd_barrier_complete(unsigned* bar, unsigned x, unsigned G, unsigned& nloc, unsigned& nx) {
    unsigned sum, cnt, mine, sp = 0u;
    for (;;) {
        sum = 0u; cnt = 0u; mine = 0u;
#pragma unroll
        for (unsigned j = 0; j < 16; ++j) { const unsigned c = xb_ld(&bar[XB_XCNT(j)]); sum += c; cnt += (c > 0u) ? 1u : 0u; mine = (j == x) ? c : mine; }
        if (sum == G) break;
        __builtin_amdgcn_s_sleep(1);
        if ((++sp & 255u) == 0u) { if (xb_ld(&bar[XB_TMO])) break; if (sp > XB_SPIN_CAP) { atomicAdd(&bar[XB_TMO], 1u); break; } }
    }
    nloc = mine > 0u ? mine : 1u; nx = cnt > 0u ? cnt : 1u;
}

__device__ __forceinline__ void xcd_barrier(const XcdBarrier& b) {
    asm volatile("s_waitcnt vmcnt(0)" ::: "memory");
    __syncthreads();
    if (threadIdx.x == 0) {
        unsigned* bar = b.bar;
        __builtin_amdgcn_s_waitcnt(0);
        unsigned nloc = b.st[0], nx = b.st[1];
        if (nloc == 0u) { xcd_barrier_complete(bar, b.x, b.total, nloc, nx); b.st[0] = nloc; b.st[1] = nx; }
        const unsigned old = xb_add(&bar[XB_XSUB(b.x)], 1u);
        const unsigned gen = old / nloc;
        if (old + 1u == (gen + 1u) * nloc) {
            __builtin_amdgcn_fence(__ATOMIC_RELEASE, "agent");
            asm volatile("s_waitcnt vmcnt(0)" ::: "memory");
            const unsigned og = xb_add(&bar[XB_TOP], 1u);
            const unsigned tg = og / nx;
            if (og + 1u == (tg + 1u) * nx) xb_add(&bar[XB_TOPGEN], 1u);
            else XB_SPIN(xb_ld(&bar[XB_TOPGEN]) == tg, bar);
            __builtin_amdgcn_fence(__ATOMIC_ACQUIRE, "agent");
            xb_add(&bar[XB_XGEN(b.x)], 1u);
            asm volatile("s_waitcnt vmcnt(0)" ::: "memory");
        } else {
            XB_SPIN(xb_ld(&bar[XB_XGEN(b.x)]) == gen, bar);
            __builtin_amdgcn_fence(__ATOMIC_ACQUIRE, "agent");
            asm volatile("s_waitcnt vmcnt(0)" ::: "memory");
        }
    }
    __syncthreads();
}
DI void attn_phase(unsigned char* ldsg, const bf16* QKV, unsigned char* AO8, const float* sinks, int ng, int gx, int gy, int Gy, int wave_in) {
    int wid = wave_in; asm volatile("" : "+s"(wid));
    const int lane = pg8::pg8_lane(), tid = wid * 64 + lane, r32 = lane & 31, hi = lane >> 5;
    LAS unsigned char* lds = (LAS unsigned char*)ldsg; const lcp L = (lcp)lds;
    LAS float* wsf = (LAS float*)(lds + AT_WS) + wid * 64;
    LAS unsigned char* stg = lds + AT_STG + wid * 4096;
    const lcp vlane = L + AT_V + ((lane >> 4) & 1) * 32 + (lane & 3) * 8 + (4 * hi + ((lane & 15) >> 2)) * 64;
    const lcp klane = L + AT_K + hi * 1024 + r32 * 16;
    for (int uu = gy; uu < 64 * (BATCH / ng); uu += Gy) { const int b = gx + ng * (uu >> 6), ul = uu & 63;
        const int kvh = ul & 3, nb = ul >> 2;
        const long rowq = (long)b * SEQ + nb * 128, rowk = rowq - 128;
        const int slot_lo = (nb == 0) ? 2 : 0;
        for (int sl = slot_lo; sl < 4; ++sl) {
            glds16(QKV + (rowk + 64 * sl + lane) * NQKV + 2048 + 64 * kvh + 8 * wid, lds + AT_K + sl * 8192 + wid * 1024);
            glds16(QKV + (rowk + 64 * sl + 16 * (wid & 3) + (lane >> 2)) * NQKV + 2304 + 64 * kvh + (wid >> 2) * 32 + (lane & 3) * 8, lds + AT_V + sl * 8192 + wid * 1024);
        }
        const int hq = 8 * kvh + wid;
        const bf16* qsrc = QKV + (rowq + r32) * NQKV + 64 * hq + 8 * hi;
        bf16x8 qn[4];
#pragma unroll
        for (int d0 = 0; d0 < 4; ++d0) qn[d0] = *(const bf16x8*)(qsrc + 16 * d0);
        const float slope2 = ex2(-0.25f * (float)(hq + 1)) * LOG2E, sink2 = sinks[hq] * LOG2E;
        const float base_l = -slope2 * (float)(r32 - 4 * hi);
        WG_BAR();
#pragma unroll 1
        for (int j = 0; j < 4; ++j) {
            const int ilo = (nb == 0) ? 4 - j : 0;
            bf16x8 qr[4];
#pragma unroll
            for (int d0 = 0; d0 < 4; ++d0) qr[d0] = qn[d0];
            if (j < 3) {
#pragma unroll
                for (int d0 = 0; d0 < 4; ++d0) qn[d0] = *(const bf16x8*)(qsrc + (size_t)(32 * (j + 1)) * NQKV + 16 * d0);
            }
            float sl2 = slope2, bl = base_l; asm volatile("" : "+v"(sl2), "+v"(bl));
            f32x16 p[5];
#pragma unroll
            for (int i = 0; i < 5; ++i) {
                if (i >= ilo) {
                    const int kt = j + i; const lcp kb = klane + (kt >> 1) * 8192 + (kt & 1) * 512;
                    f32x16 a = zero16();
#pragma unroll
                    for (int d0 = 0; d0 < 4; ++d0) a = MFMA32(ldfrag(kb + d0 * 2048), qr[d0], a);
#pragma unroll
                    for (int r = 0; r < 16; ++r) {
                        const int cr = (r & 3) + 8 * (r >> 2);
                        float s = fmaf(sl2, (float)(cr - 128 + 32 * i), fmaf(a[r], LOG2E, bl));
                        if (i == 0) { if (!(cr + 4 * hi > r32)) s = -INFINITY; }
                        if (i == 4) { if (!(cr + 4 * hi <= r32)) s = -INFINITY; }
                        a[r] = s;
                    }
                    p[i] = a;
                } else {
#pragma unroll
                    for (int r = 0; r < 16; ++r) p[i][r] = -INFINITY;
                }
            }
            float mx = sink2;
#pragma unroll
            for (int i = 0; i < 5; ++i)
#pragma unroll
                for (int r = 0; r < 16; ++r) mx = fmaxf(mx, p[i][r]);
            mx = half_swap_max(mx);
            float ls = 0.f;
#pragma unroll
            for (int i = 0; i < 5; ++i)
#pragma unroll
                for (int r = 0; r < 16; ++r) { const float e = ex2(p[i][r] - mx); p[i][r] = e; ls += e; }
            ls = half_swap_add(ls) + ex2(sink2 - mx);
            f32x16 o0 = zero16(), o1 = zero16();
#pragma unroll
            for (int i = 0; i < 5; ++i) {
                if (i >= ilo) {
                    const int kt = j + i; const lcp vb = vlane + (kt >> 1) * 8192 + (kt & 1) * 2048;
                    const bf16x8 pa = PACK8(p[i], 0), pb = PACK8(p[i], 1);
                    o0 = MFMA32(pa, trfrag(vb), o0);        o0 = MFMA32(pb, trfrag(vb + 1024), o0);
                    o1 = MFMA32(pa, trfrag(vb + 4096), o1); o1 = MFMA32(pb, trfrag(vb + 4096 + 1024), o1);
                }
            }
            if (hi == 0) wsf[r32] = __builtin_amdgcn_rcpf(ls);
#pragma unroll
            for (int r = 0; r < 16; ++r) {
                const int orow = crow(r, hi); const float rl = wsf[orow] * pg8::F8_SO;
                int pk; asm volatile("" : "=v"(pk)); pk = __builtin_amdgcn_cvt_pk_fp8_f32(o0[r] * rl, o1[r] * rl, pk, false);
                stg[orow * 64 + r32] = (unsigned char)(pk & 0xff);
                stg[orow * 64 + 32 + r32] = (unsigned char)((pk >> 8) & 0xff);
            }
#pragma unroll
            for (int i4 = 0; i4 < 2; ++i4) {
                const int row = i4 * 16 + (lane >> 2), ch = lane & 3;
                const v4u v = *(const LAS v4u*)(stg + row * 64 + ch * 16);
                *(v4u*)(AO8 + (rowq + 32 * j + row) * D + 64 * hq + ch * 16) = v;
            }
        }
        WG_BAR();
    }
}

constexpr int ML_GSET = ML_STG + 4 * 4096 - ML_G2;
static_assert(ML_G2 + ML_GSET + (ML_WS - ML_G2) <= MISC_OFF, "LDS map: second gate-array set");
#define DPPF(old, src, ctrl, rmask, bc) __uint_as_float((unsigned)__builtin_amdgcn_update_dpp((int)__float_as_uint(old), (int)__float_as_uint(src), (ctrl), (rmask), 0xf, (bc)))
DI float scan_add64(float v) {
    v += DPPF(0.f, v, 0x111, 0xf, true); v += DPPF(0.f, v, 0x112, 0xf, true); v += DPPF(0.f, v, 0x114, 0xf, true); v += DPPF(0.f, v, 0x118, 0xf, true);
    v += DPPF(0.f, v, 0x142, 0xa, false); v += DPPF(0.f, v, 0x143, 0xc, false); return v;
}
DI float scan_max64(float v) {
    const float ninf = -INFINITY;
    v = fmaxf(v, DPPF(ninf, v, 0x111, 0xf, false)); v = fmaxf(v, DPPF(ninf, v, 0x112, 0xf, false)); v = fmaxf(v, DPPF(ninf, v, 0x114, 0xf, false)); v = fmaxf(v, DPPF(ninf, v, 0x118, 0xf, false));
    v = fmaxf(v, DPPF(ninf, v, 0x142, 0xa, false)); v = fmaxf(v, DPPF(ninf, v, 0x143, 0xc, false)); return v;
}
DI float ml_gate_scan(LAS unsigned char* lds, int gofs, const float* GT, long row0, int h, int lane, float m_prev) {
    LAS float* G2 = (LAS float*)(lds + ML_G2 + gofs); LAS float* M2 = (LAS float*)(lds + ML_M2 + gofs); LAS float* FI = (LAS float*)(lds + ML_FI + gofs); LAS float* EI = (LAS float*)(lds + ML_EI + gofs);
    LAS float* WK = (LAS float*)(lds + ML_WK + gofs); LAS bf16* WKB = (LAS bf16*)(lds + ML_WKB + gofs); LAS float* SC = (LAS float*)(lds + ML_SC + gofs);
    const float* gp = GT + (size_t)(row0 + 2 * lane) * 8;
    const float i0 = gp[h], f0 = gp[4 + h], i1 = gp[8 + h], f1 = gp[12 + h];
    const float lf0 = -0.6931471805599453f * __builtin_amdgcn_logf(1.f + ex2(-LOG2E * f0)), lf1 = -0.6931471805599453f * __builtin_amdgcn_logf(1.f + ex2(-LOG2E * f1));
    const float incl = scan_add64(lf0 + lf1);
    const float b1 = incl, b0 = incl - lf1;
    const float g0 = i0 - b0, g1 = i1 - b1;
    const float cm = scan_max64(fmaxf(g0, g1));
    const float cprev = DPPF(-INFINITY, cm, 0x138, 0xf, false);
    const float M0 = fmaxf(m_prev, fmaxf(cprev, g0)), M1 = fmaxf(m_prev, cm);
    const float Mend = __uint_as_float((unsigned)__builtin_amdgcn_readlane((int)__float_as_uint(M1), 63)), blast = __uint_as_float((unsigned)__builtin_amdgcn_readlane((int)__float_as_uint(b1), 63));
    *(LAS f32x2*)(G2 + 2 * lane) = (f32x2){g0 * LOG2E, g1 * LOG2E};
    *(LAS f32x2*)(M2 + 2 * lane) = (f32x2){M0 * LOG2E, M1 * LOG2E};
    *(LAS f32x2*)(FI + 2 * lane) = (f32x2){ex2((m_prev - M0) * LOG2E), ex2((m_prev - M1) * LOG2E)};
    *(LAS f32x2*)(EI + 2 * lane) = (f32x2){ex2(-(b0 + M0) * LOG2E), ex2(-(b1 + M1) * LOG2E)};
    const float w0 = ex2((g0 - Mend) * LOG2E), w1 = ex2((g1 - Mend) * LOG2E);
    *(LAS f32x2*)(WK + 2 * lane) = (f32x2){w0, w1};
    *(LAS unsigned*)(WKB + 2 * lane) = pk2(w0, w1);
    if (lane == 0) SC[0] = ex2((m_prev - Mend) * LOG2E);
    return blast + Mend;
}
template <int VAR = 0>
DI void mlstm_phase(unsigned char* ldsg, const bf16* MP, const float* GT, bf16* HG, int ng, int gx, int gy, int Gy, int wave_in) {
    int wid = wave_in; asm volatile("" : "+s"(wid));
    const int lane0 = pg8::pg8_lane(), tid = wid * 64 + lane0;
    LAS unsigned char* lds = (LAS unsigned char*)ldsg; const lcp L = (lcp)lds;
    LAS float* wsf = (LAS float*)(lds + ML_WS) + wid * 64;
    for (int uu = gy; uu < 32 * (BATCH / ng); uu += Gy) { const int b = gx + ng * (uu >> 5), ul = uu & 31;
        const int h = ul >> 3, sl = ul & 7;
        const bf16* Qp = MP + 256 * h; const bf16* Kp = MP + 1024 + 256 * h; const bf16* Vp = MP + 2048 + 512 * h + 64 * sl; const bf16* OGp = MP + 4096 + 512 * h + 64 * sl;
        { unsigned z = 0u; asm volatile("" : "+v"(z)); for (int i = tid; i < (32768 + 512) / 16; i += 512) *(LAS v4u*)(lds + ML_C + i * 16) = (v4u){z, z, z, z}; }
        f32x16 T[6];
#pragma unroll
        for (int x = 0; x < 6; ++x) T[x] = zero16();
        float m_prev = 0.f;
        v4u X[16], vreg[2];
        { const long row0 = (long)b * SEQ; const int lane = lane0, r32 = lane & 31, hi = lane >> 5;
          if (wid >= 4) {
#pragma unroll
              for (int i = 0; i < 16; ++i) X[i] = *(const v4u*)(Kp + (row0 + 8 * i + (lane & 7)) * NMI + (8 * (wid - 4) + (lane >> 3)) * 8);
          } else {
#pragma unroll
              for (int ks = 0; ks < 16; ++ks) X[ks] = *(const v4u*)(Qp + (row0 + 32 * wid + r32) * NMI + 16 * ks + 8 * hi);
          }
#pragma unroll
          for (int i = 0; i < 2; ++i) vreg[i] = *(const v4u*)(Vp + (row0 + 64 * i + 16 * (wid & 3) + (lane >> 2)) * NMI + (wid >> 2) * 32 + (lane & 3) * 8);
          if (wid == 4 && !(VAR & 16)) m_prev = ml_gate_scan(lds, 0, GT, row0, h, lane, m_prev);
        }
        WG_BAR();
        for (int c = 0; c < 16; ++c) {
            const long row0 = (long)b * SEQ + 128 * c;
            const int gofs = (c & 1) * ML_GSET;
            const int lane = pg8::pg8_lane(), r32 = lane & 31, hi = lane >> 5;
            const int blk = (lane >> 4) & 1, q4 = (lane & 15) >> 2, p4 = lane & 3;
            const int vlo_ = blk * 32 + p4 * 8 + (4 * hi + q4) * 64;
            const int ktl_ = (2 * blk + (p4 >> 1)) * 2048 + (q4 + 4 * hi) * 16 + (p4 & 1) * 8;
            const int cbl_ = hi * 1024 + r32 * 16, kbl_ = hi * 2048 + r32 * 16;
            const unsigned m0 = (r32 == 0) ? 0xffffffffu : 0u; const v4u m0v = {m0, m0, m0, m0};
            LAS float* G2 = (LAS float*)(lds + ML_G2 + gofs); LAS float* M2 = (LAS float*)(lds + ML_M2 + gofs); LAS float* FI = (LAS float*)(lds + ML_FI + gofs); LAS float* EI = (LAS float*)(lds + ML_EI + gofs);
            LAS float* WK = (LAS float*)(lds + ML_WK + gofs); LAS bf16* WKB = (LAS bf16*)(lds + ML_WKB + gofs); LAS float* SC = (LAS float*)(lds + ML_SC + gofs);
            VM_WAIT();
            if (wid >= 4) {
#pragma unroll
                for (int i = 0; i < 16; ++i) *(LAS v4u*)(lds + ML_K + (8 * (wid - 4) + (lane >> 3)) * 2048 + (8 * i + (lane & 7)) * 16) = X[i];
            }
#pragma unroll
            for (int i = 0; i < 2; ++i) { const float w = WK[64 * i + 16 * (wid & 3) + (lane >> 2)]; const v4u v = vreg[i]; v4u o;
                o.x = pk2(bflo(v.x) * w, bfhi(v.x) * w); o.y = pk2(bflo(v.y) * w, bfhi(v.y) * w); o.z = pk2(bflo(v.z) * w, bfhi(v.z) * w); o.w = pk2(bflo(v.w) * w, bfhi(v.w) * w);
                *(LAS v4u*)(lds + ML_V + i * 8192 + wid * 1024 + lane * 16) = v;
                *(LAS v4u*)(lds + ML_VW + i * 8192 + wid * 1024 + lane * 16) = o; }
            WG_BAR();
            const bool more = c + 1 < 16;
            if (more && !(VAR & 32)) {
                const long row1 = row0 + 128;
                if (wid >= 4) {
#pragma unroll
                    for (int i = 0; i < 16; ++i) X[i] = *(const v4u*)(Kp + (row1 + 8 * i + (lane & 7)) * NMI + (8 * (wid - 4) + (lane >> 3)) * 8);
                }
#pragma unroll
                for (int i = 0; i < 2; ++i) vreg[i] = *(const v4u*)(Vp + (row1 + 64 * i + 16 * (wid & 3) + (lane >> 2)) * NMI + (wid >> 2) * 32 + (lane & 3) * 8);
            }
            if (wid < 4) {
                const int tt = wid;
                v4u ogv[4];
#pragma unroll
                for (int i4 = 0; i4 < 4; ++i4) ogv[i4] = *(const v4u*)(OGp + (row0 + 32 * tt + i4 * 8 + (lane >> 3)) * NMI + (lane & 7) * 8);
                T[0] = zero16(); T[1] = zero16(); T[2] = zero16();
                if (!(VAR & 4)) { const lcp cb = L + ML_C + cbl_; const lcp nbp = L + ML_N + 16 * hi;
#pragma unroll
                  for (int ks = 0; ks < 16; ++ks) {
                      const bf16x8 c0 = ldfrag(cb + ks * 2048), c1 = ldfrag(cb + ks * 2048 + 512);
                      const bf16x8 nf = __builtin_bit_cast(bf16x8, __builtin_bit_cast(v4u, ldfrag(nbp + ks * 32)) & m0v);
                      T[0] = MFMA32(__builtin_bit_cast(bf16x8, X[ks]), c0, T[0]); T[1] = MFMA32(__builtin_bit_cast(bf16x8, X[ks]), c1, T[1]); T[2] = MFMA32(__builtin_bit_cast(bf16x8, X[ks]), nf, T[2]);
                      if ((ks & 3) == 3) __builtin_amdgcn_sched_barrier(0);
                  } }
                { float fi[16];
#pragma unroll
                  for (int r = 0; r < 16; ++r) fi[r] = FI[32 * tt + crow(r, hi)];
#pragma unroll
                  for (int r = 0; r < 16; ++r) { T[0][r] *= fi[r]; T[1][r] *= fi[r]; }
                  if (r32 == 0) {
#pragma unroll
                      for (int r = 0; r < 16; ++r) wsf[crow(r, hi)] = T[2][r] * fi[r];
                  } }
                const float Mt = M2[32 * tt + r32];
                float dsum = 0.f;
                for (int st = 0; st <= ((VAR & 2) ? -1 : tt); ++st) {
                    f32x16 S = zero16();
                    const lcp kb = L + ML_K + kbl_ + st * 512;
#pragma unroll
                    for (int ks = 0; ks < 16; ++ks) S = MFMA32(ldfrag(kb + ks * 4096), __builtin_bit_cast(bf16x8, X[ks]), S);
#pragma unroll
                    for (int r = 0; r < 16; ++r) {
                        const float w = ex2(G2[32 * st + crow(r, hi)] - Mt);
                        float v = S[r] * w;
                        if (st == tt && crow(r, hi) > r32) v = 0.f;
                        S[r] = v; dsum += v;
                    }
                    const bf16x8 pa = PACK8(S, 0), pb = PACK8(S, 1);
                    const lcp vb = L + ML_V + (st >> 1) * 8192 + (st & 1) * 2048 + vlo_;
                    T[0] = MFMA32(pa, trfrag(vb), T[0]);        T[0] = MFMA32(pb, trfrag(vb + 1024), T[0]);
                    T[1] = MFMA32(pa, trfrag(vb + 4096), T[1]); T[1] = MFMA32(pb, trfrag(vb + 4096 + 1024), T[1]);
                }
                if (more && !(VAR & 64)) {
#pragma unroll
                    for (int ks = 0; ks < 16; ++ks) X[ks] = *(const v4u*)(Qp + (row0 + 128 + 32 * wid + r32) * NMI + 16 * ks + 8 * hi);
                }
                dsum = half_swap_add(dsum);
                { const float den = wsf[r32] + dsum; const float dn = fmaxf(fabsf(den), EI[32 * tt + r32]);
                  if (hi == 0) wsf[32 + r32] = __builtin_amdgcn_rcpf(dn); }
                LAS bf16* stg = (LAS bf16*)(lds + ML_STG + tt * 4096);
                if (!(VAR & 8)) {
#pragma unroll
                for (int r = 0; r < 16; ++r) {
                    const int orow = crow(r, hi); const float rd = wsf[32 + orow];
                    stg[orow * 64 + r32] = (bf16)(pk2(T[0][r] * rd, 0.f) & 0xffffu);
                    stg[orow * 64 + 32 + r32] = (bf16)(pk2(T[1][r] * rd, 0.f) & 0xffffu);
                }
#pragma unroll
                for (int i4 = 0; i4 < 4; ++i4) {
                    const int row = i4 * 8 + (lane >> 3), ch = lane & 7;
                    const v4u hv = *(const LAS v4u*)(stg + row * 64 + ch * 8);
                    const v4u og = ogv[i4];
                    v4u o;
                    o.x = pk2(bflo(hv.x) * bflo(og.x), bfhi(hv.x) * bfhi(og.x)); o.y = pk2(bflo(hv.y) * bflo(og.y), bfhi(hv.y) * bfhi(og.y));
                    o.z = pk2(bflo(hv.z) * bflo(og.z), bfhi(hv.z) * bfhi(og.z)); o.w = pk2(bflo(hv.w) * bflo(og.w), bfhi(hv.w) * bfhi(og.w));
                    *(v4u*)(HG + (row0 + 32 * tt + row) * D + 512 * h + 64 * sl + ch * 8) = o;
                }
                }
#pragma unroll
                for (int x = 3; x < 6; ++x) T[x] = zero16();
            } else {
                const float decay = SC[0];
#pragma unroll
                for (int x = 0; x < 6; ++x)
#pragma unroll
                    for (int r = 0; r < 16; ++r) T[x][r] *= decay;
#pragma unroll
                for (int dti = 0; dti < ((VAR & 1) ? 0 : 2); ++dti) {
                    const int dt = 2 * (wid - 4) + dti;
                    const lcp ka0 = L + ML_K + dt * 8192 + ktl_;
#pragma unroll
                    for (int s8 = 0; s8 < 8; ++s8) {
                        const lcp ka = ka0 + s8 * 256;
                        const bf16x8 af = cat8(vtr(ka), vtr(ka + 128));
                        const lcp vwb = L + ML_VW + (s8 >> 2) * 8192 + (s8 & 3) * 1024 + vlo_;
                        const bf16x8 b0 = trfrag(vwb), b1 = trfrag(vwb + 4096);
                        const LAS s16x4* wp = (const LAS s16x4*)(WKB + 16 * s8 + 4 * hi);
                        const bf16x8 nb = __builtin_bit_cast(bf16x8, __builtin_bit_cast(v4u, cat8(wp[0], wp[2])) & m0v);
                        T[2 * dti] = MFMA32(af, b0, T[2 * dti]); T[2 * dti + 1] = MFMA32(af, b1, T[2 * dti + 1]); T[4 + dti] = MFMA32(af, nb, T[4 + dti]);
                        if (s8 & 1) __builtin_amdgcn_sched_barrier(0);
                    }
                }
                if (more && wid == 4 && !(VAR & 16)) m_prev = ml_gate_scan(lds, ML_GSET - gofs, GT, row0 + 128, h, lane, m_prev);
            }
            asm volatile("s_waitcnt lgkmcnt(0)" ::: "memory"); __builtin_amdgcn_s_barrier(); asm volatile("" ::: "memory");
            if (wid >= 4) {
#pragma unroll
                for (int dti = 0; dti < 2; ++dti) {
                    const int dt = 2 * (wid - 4) + dti;
#pragma unroll
                    for (int et = 0; et < 2; ++et)
#pragma unroll
                        for (int g = 0; g < 4; ++g)
                            *(LAS v2u*)(lds + ML_C + (4 * dt + g) * 1024 + (32 * et + r32) * 16 + hi * 8) = (v2u){pk2(T[2 * dti + et][4 * g], T[2 * dti + et][4 * g + 1]), pk2(T[2 * dti + et][4 * g + 2], T[2 * dti + et][4 * g + 3])};
                    if (r32 == 0) {
#pragma unroll
                        for (int g = 0; g < 4; ++g)
                            *(LAS v2u*)(lds + ML_N + (32 * dt + 8 * g + 4 * hi) * 2) = (v2u){pk2(T[4 + dti][4 * g], T[4 + dti][4 * g + 1]), pk2(T[4 + dti][4 * g + 2], T[4 + dti][4 * g + 3])};
                    }
                }
            }
        }
        WG_BAR();
    }
}


constexpr int NWAVES = 8;

template <bool F8> DI void tr_strip(const float* W, int ldw, int n0, void* WTv, size_t wt_row0, int Kdim, int kb0, int nkb, const float* g, const float* bb, float cs, float* c1o, float* c2o, LAS float* scr, int lane) {
    bf16* WT = (bf16*)WTv; unsigned char* WT8 = (unsigned char*)WTv;
    const int c = lane & 7;
    float a1[4] = {0.f, 0.f, 0.f, 0.f}, a2[4] = {0.f, 0.f, 0.f, 0.f};
    for (int kb = kb0; kb < kb0 + nkb; ++kb) {
        const int k0 = kb * 64;
#pragma unroll 8
        for (int i = 0; i < 32; ++i) { const int kk = 2 * i + (lane >> 5); scr[kk * 33 + (lane & 31)] = W[(size_t)(k0 + kk) * ldw + n0 + (lane & 31)]; }
        float gk[8], bk[8];
        if (g) { const f32x4 g0 = *(const f32x4*)(g + k0 + 8 * c), g1 = *(const f32x4*)(g + k0 + 8 * c + 4), b0 = *(const f32x4*)(bb + k0 + 8 * c), b1 = *(const f32x4*)(bb + k0 + 8 * c + 4);
#pragma unroll
            for (int i = 0; i < 4; ++i) { gk[i] = g0[i] * cs; gk[4 + i] = g1[i] * cs; bk[i] = b0[i] * cs; bk[4 + i] = b1[i] * cs; } }
        else {
#pragma unroll
            for (int i = 0; i < 8; ++i) { gk[i] = cs; bk[i] = 0.f; } }
        LDS_WAIT(); asm volatile("" ::: "memory");
#pragma unroll
        for (int j = 0; j < 4; ++j) { const int n = (lane >> 3) + 8 * j; const LAS float* s = scr + (8 * c) * 33 + n;
            float v[8];
#pragma unroll
            for (int i = 0; i < 8; ++i) v[i] = s[i * 33];
            a2[j] += ((v[0] * bk[0] + v[1] * bk[1]) + (v[2] * bk[2] + v[3] * bk[3])) + ((v[4] * bk[4] + v[5] * bk[5]) + (v[6] * bk[6] + v[7] * bk[7]));
            if constexpr (F8) {
                float wv[8];
#pragma unroll
                for (int i = 0; i < 8; ++i) wv[i] = v[i] * gk[i];
                const v2u o = pg8::cvt8_f8(wv, pg8::F8_SW);
                a1[j] += ((__builtin_amdgcn_cvt_f32_fp8((int)o.x, 0) + __builtin_amdgcn_cvt_f32_fp8((int)o.x, 1)) + (__builtin_amdgcn_cvt_f32_fp8((int)o.x, 2) + __builtin_amdgcn_cvt_f32_fp8((int)o.x, 3)))
                       + ((__builtin_amdgcn_cvt_f32_fp8((int)o.y, 0) + __builtin_amdgcn_cvt_f32_fp8((int)o.y, 1)) + (__builtin_amdgcn_cvt_f32_fp8((int)o.y, 2) + __builtin_amdgcn_cvt_f32_fp8((int)o.y, 3)));
                *(GAS v2u*)(WT8 + (wt_row0 + n) * Kdim + k0 + 8 * c) = o;
            } else {
                v4u o; o.x = pk2(v[0] * gk[0], v[1] * gk[1]); o.y = pk2(v[2] * gk[2], v[3] * gk[3]); o.z = pk2(v[4] * gk[4], v[5] * gk[5]); o.w = pk2(v[6] * gk[6], v[7] * gk[7]);
                a1[j] += ((bflo(o.x) + bfhi(o.x)) + (bflo(o.y) + bfhi(o.y))) + ((bflo(o.z) + bfhi(o.z)) + (bflo(o.w) + bfhi(o.w)));
                *(GAS v4u*)(WT + (wt_row0 + n) * Kdim + k0 + 8 * c) = o;
            } }
        LDS_WAIT(); asm volatile("" ::: "memory");
    }
    if (g) {
#pragma unroll
        for (int j = 0; j < 4; ++j) { float s1 = a1[j], s2 = a2[j];
            s1 += SWZ_XOR(s1, 1); s2 += SWZ_XOR(s2, 1); s1 += SWZ_XOR(s1, 2); s2 += SWZ_XOR(s2, 2); s1 += SWZ_XOR(s1, 4); s2 += SWZ_XOR(s2, 4);
            if (c == 0) { c1o[(lane >> 3) + 8 * j] = F8 ? s1 * (1.f / pg8::F8_SW) : s1; c2o[(lane >> 3) + 8 * j] = s2; } }
    }
}

DI void prologue(kargs_t a, LAS unsigned char* lds, int gw, int NGW, int wave, int lane) {
    unsigned char* ws = a->ws;
    float* vec = (float*)(ws + WS_VEC);
    const float* ones = (const float*)(ws + WS_VEC + V_ONES); const float* zeros = (const float*)(ws + WS_VEC + V_ZEROS);
    LAS float* scr = (LAS float*)(lds + wave * 16384);
    constexpr int T_UP = 8 * 2 * 176, T_QKV = 2 * 80, T_MI = 2 * 192, T_W2 = 8 * 64 * 4, T_WO = 2 * 64, T_WMO = 2 * 64, T_G = 16;
    constexpr int NT = T_UP + T_QKV + T_MI + T_W2 + T_WO + T_WMO + T_G;
    for (int it = gw; it < NT; it += NGW) {
        int r = it;
        if (r < T_UP) {
            const int f = r / 352, rr = r % 352, which = rr / 176, strip = rr % 176, n0 = 32 * strip;
            const int t = 3 * (f >> 1) + 2 * (f & 1);
            const float* gp = t ? a->ln_g + (size_t)(t - 1) * D : nullptr; const float* bp = t ? a->ln_b + (size_t)(t - 1) * D : nullptr;
            const size_t wrow = (size_t)256 * (n0 / 128) + 128 * which + (n0 % 128);
            const float* W = (which ? a->w3 : a->w1) + (size_t)f * D * FF;
            if (gp) tr_strip<true>(W, FF, n0, ws + WS_W13 + (size_t)f * NUP * D, wrow, D, 0, 32, gp, bp, 1.f, vec + V_C1U / 4 + (size_t)f * NUP + wrow, vec + V_C2U / 4 + (size_t)f * NUP + wrow, scr, lane);
            else { tr_strip<true>(W, FF, n0, ws + WS_W13 + (size_t)f * NUP * D, wrow, D, 0, 32, nullptr, nullptr, 1.f, nullptr, nullptr, scr, lane);
                   if (lane < 32) { vec[V_C1U / 4 + (size_t)f * NUP + wrow + lane] = 0.f; vec[V_C2U / 4 + (size_t)f * NUP + wrow + lane] = 0.f; } }
            continue; }
        r -= T_UP;
        if (r < T_QKV) { const int j = r / 80, n0 = 32 * (r % 80); const int t = 6 * j + 1;
            tr_strip<true>(a->wqkv + (size_t)j * D * NQKV, NQKV, n0, ws + WS_WQKV + (size_t)j * NQKV * D, n0, D, 0, 32, a->ln_g + (size_t)(t - 1) * D, a->ln_b + (size_t)(t - 1) * D, n0 < 2048 ? 0.125f : 1.f,
                     vec + V_C1Q / 4 + j * NQKV + n0, vec + V_C2Q / 4 + j * NQKV + n0, scr, lane);
            continue; }
        r -= T_QKV;
        if (r < T_MI) { const int j = r / 192, n0 = 32 * (r % 192); const int t = 6 * j + 4;
            if (true) tr_strip<false>(a->win + (size_t)j * D * NMIW, NMIW, n0, (bf16*)(ws + WS_WIN) + (size_t)j * NMI * D, n0, D, 0, 32, a->ln_g + (size_t)(t - 1) * D, a->ln_b + (size_t)(t - 1) * D, (n0 >= 1024 && n0 < 2048) ? 0.0625f : 1.f,
                     vec + V_C1I / 4 + j * NMI + n0, vec + V_C2I / 4 + j * NMI + n0, scr, lane);
            else tr_strip<true>(a->win + (size_t)j * D * NMIW, NMIW, n0, ws + WS_WIN + 32 * MiB + (size_t)j * 2048 * D, n0 - 4096, D, 0, 32, a->ln_g + (size_t)(t - 1) * D, a->ln_b + (size_t)(t - 1) * D, 1.f,
                     vec + V_C1I / 4 + j * NMI + n0, vec + V_C2I / 4 + j * NMI + n0, scr, lane);
            continue; }
        r -= T_MI;
        if (r < T_W2) { const int f = r / 256, rr = r % 256, strip = rr / 4, kq = rr % 4;
            tr_strip<true>(a->w2 + (size_t)f * FF * D, D, 32 * strip, ws + WS_W2 + (size_t)f * D * FF, 32 * strip, FF, 22 * kq, 22, nullptr, nullptr, 1.f, nullptr, nullptr, scr, lane);
            continue; }
        r -= T_W2;
        if (r < T_WO) { const int j = r / 64, strip = r % 64;
            tr_strip<true>(a->wo + (size_t)j * D * D, D, 32 * strip, ws + WS_WO + (size_t)j * D * D, 32 * strip, D, 0, 32, nullptr, nullptr, 1.f, nullptr, nullptr, scr, lane);
            continue; }
        r -= T_WO;
        if (r < T_WMO) { const int j = r / 64, strip = r % 64;
            tr_strip<false>(a->wmo + (size_t)j * D * D, D, 32 * strip, (bf16*)(ws + WS_WMO) + (size_t)j * D * D, 32 * strip, D, 0, 32, nullptr, nullptr, 1.f, nullptr, nullptr, scr, lane);
            continue; }
        r -= T_WMO;
        {
            const int j = r / 8, jj = r % 8; const int t = 6 * j + 4;
            const float* gp = a->ln_g + (size_t)(t - 1) * D; const float* bp = a->ln_b + (size_t)(t - 1) * D;
            const float* W = a->win + (size_t)j * D * NMIW + NMI + jj;
            bf16* wg16 = (bf16*)(vec + V_WG / 4) + (size_t)(j * 8 + jj) * D;
            float s1 = 0.f, s2 = 0.f;
            for (int k = lane; k < D; k += 64) { const float w = W[(size_t)k * NMIW]; const unsigned hv = pk2(w * gp[k], 0.f) & 0xffffu; wg16[k] = (bf16)hv; s1 += bflo(hv); s2 += w * bp[k]; }
            s1 = wave_sum(s1); s2 = wave_sum(s2);
            if (lane == 0) { vec[V_CG / 4 + j * 16 + jj] = s1; vec[V_CG / 4 + j * 16 + 8 + jj] = s2 + a->bg[j * 8 + jj]; }
        }
    }
    bf16* R = (bf16*)(ws + WS_R); float* sp0 = (float*)(ws + WS_SP);
    for (int m = gw; m < M; m += NGW) {
        const GAS f32x4* xr = (const GAS f32x4*)(a->x + (size_t)m * D);
#pragma unroll
        for (int i = 0; i < 4; ++i) { const f32x4 v0 = xr[(i * 64 + lane) * 2], v1 = xr[(i * 64 + lane) * 2 + 1];
            *(GAS v4u*)(R + (size_t)m * D + (i * 64 + lane) * 8) = (v4u){pk2(v0[0], v0[1]), pk2(v0[2], v0[3]), pk2(v1[0], v1[1]), pk2(v1[2], v1[3])};
            { const float xv[8] = {v0[0], v0[1], v0[2], v0[3], v1[0], v1[1], v1[2], v1[3]}; *(GAS v2u*)(ws + WS_R8 + (size_t)m * D + (i * 64 + lane) * 8) = pg8::cvt8_f8(xv, pg8::F8_SR); } }
        if (lane < 8) *(f32x2*)(sp0 + (size_t)m * 16 + lane * 2) = (f32x2){0.f, 256.f * (1.f - LN_EPS)};
    }
    for (int i = gw * 64 + lane; i < D; i += NGW * 64) { vec[V_ONES / 4 + i] = 1.f; vec[V_ZEROS / 4 + i] = 0.f; }
    (void)ones; (void)zeros;
}

DI void gates_phase(LAS unsigned char* lds, const bf16* R, const float* sp, const bf16* wg16, const float* cg, float* GT, int ng, int gx, int gy, int Gy, int wave_in) {
    int wave = wave_in; asm volatile("" : "+s"(wave));
    const int lane = pg8::pg8_lane(), tid = wave * 64 + lane, r32 = lane & 31, hi = lane >> 5;
    LAS float* part = (LAS float*)lds;
    const unsigned mk = (r32 < 8) ? 0xffffffffu : 0u; const v4u mkv = {mk, mk, mk, mk};
    for (int uu = gy; uu < (SEQ / 64) * (BATCH / ng); uu += Gy) { const int b = gx + ng * (uu >> 5), pl = uu & 31;
        const long r0 = (long)b * SEQ + (long)pl * 64;
        const bf16* bsrc = wg16 + (size_t)(r32 & 7) * D + 256 * wave + 8 * hi;
        bf16x8 bfr[16];
#pragma unroll
        for (int ks = 0; ks < 16; ++ks) bfr[ks] = __builtin_bit_cast(bf16x8, *(const v4u*)(bsrc + 16 * ks) & mkv);
#pragma unroll
        for (int rt = 0; rt < 2; ++rt) {
            const bf16* asrc = R + (r0 + 32 * rt + r32) * D + 256 * wave + 8 * hi;
            bf16x8 afr[16];
#pragma unroll
            for (int ks = 0; ks < 16; ++ks) afr[ks] = *(const bf16x8*)(asrc + 16 * ks);
            f32x16 acc = zero16();
#pragma unroll
            for (int ks = 0; ks < 16; ++ks) acc = MFMA32(afr[ks], bfr[ks], acc);
            if (r32 < 8) {
#pragma unroll
                for (int r = 0; r < 16; ++r) part[(wave * 64 + 32 * rt + crow(r, hi)) * 8 + r32] = acc[r];
            }
        }
        WG_BAR();
        {
            const int row = tid >> 3, col = tid & 7;
            float s = 0.f;
#pragma unroll
            for (int w = 0; w < 8; ++w) s += part[(w * 64 + row) * 8 + col];
            const f32x4* spr = (const f32x4*)(sp + (size_t)(r0 + row) * 16);
            const f32x4 v0 = spr[0], v1 = spr[1], v2 = spr[2], v3 = spr[3];
            const float ss = ((v0[0] + v0[2]) + (v1[0] + v1[2])) + ((v2[0] + v2[2]) + (v3[0] + v3[2])), qq = ((v0[1] + v0[3]) + (v1[1] + v1[3])) + ((v2[1] + v2[3]) + (v3[1] + v3[3]));
            const float mean = ss * (1.f / D), var = qq * (1.f / D) - mean * mean, rstd = __builtin_amdgcn_rsqf(var + LN_EPS);
            GT[(size_t)(r0 + row) * 8 + col] = rstd * (s - mean * cg[col]) + cg[8 + col];
        }
        WG_BAR();
    }
}

DI void final_ln(const bf16* R, const float* sp, const float* g, const float* b, float* out, int ng, int gx, int gw, int NGW, int lane) {
    for (int bb = gx; bb < BATCH; bb += ng) for (int m = bb * SEQ + gw; m < (bb + 1) * SEQ; m += NGW) {
        float s, q;
        { const f32x4 v = *(const f32x4*)(sp + (size_t)m * 16 + (lane & 3) * 4); s = v[0] + v[2]; q = v[1] + v[3];
          s += SWZ_XOR(s, 1); q += SWZ_XOR(q, 1); s += SWZ_XOR(s, 2); q += SWZ_XOR(q, 2); }
        const float mean = s * (1.f / D), var = q * (1.f / D) - mean * mean, rstd = __builtin_amdgcn_rsqf(var + LN_EPS);
#pragma unroll
        for (int i = 0; i < 4; ++i) {
            const int k = 8 * lane + 512 * i;
            const v4u rv = *(const v4u*)(R + (size_t)m * D + k);
            const f32x4 g0 = *(const f32x4*)(g + k), g1 = *(const f32x4*)(g + k + 4), b0 = *(const f32x4*)(b + k), b1 = *(const f32x4*)(b + k + 4);
            f32x4 o0, o1;
            o0[0] = (bflo(rv.x) - mean) * rstd * g0[0] + b0[0]; o0[1] = (bfhi(rv.x) - mean) * rstd * g0[1] + b0[1]; o0[2] = (bflo(rv.y) - mean) * rstd * g0[2] + b0[2]; o0[3] = (bfhi(rv.y) - mean) * rstd * g0[3] + b0[3];
            o1[0] = (bflo(rv.z) - mean) * rstd * g1[0] + b1[0]; o1[1] = (bfhi(rv.z) - mean) * rstd * g1[1] + b1[1]; o1[2] = (bflo(rv.w) - mean) * rstd * g1[2] + b1[2]; o1[3] = (bfhi(rv.w) - mean) * rstd * g1[3] + b1[3];
            *(GAS f32x4*)(out + (size_t)m * D + k) = o0; *(GAS f32x4*)(out + (size_t)m * D + k + 4) = o1;
        }
    }
}

#ifndef PROBE_DUP
#define PROBE_DUP 0
#endif
#ifndef PROBE_DRY
#define PROBE_DRY 1
#endif
#ifndef PROBE_MLV
#define PROBE_MLV 0
#endif
#ifndef SKIP_ATT
#define SKIP_ATT 0
#endif
#ifndef SKIP_MLSTM
#define SKIP_MLSTM 0
#endif

#define GRID_BAR1() do { XcdBarrier b_; b_.bar = (unsigned*)(kargs()->ws + WS_CTL) + CW_BAR; b_.x = xb_xcc_id(); b_.st = (volatile LAS unsigned*)(lds + MISC_OFF) + 8; b_.total = gridDim.x; xcd_barrier(b_); } while (0)
#define GRID_BAR() do { GRID_BAR1(); if (PROBE_DUP & 1024) GRID_BAR1(); } while (0)
#define GROUP_BAR1() do { XcdBarrier b_; b_.bar = (unsigned*)(kargs()->ws + WS_CTL) + CW_BAR + (1 + (bid & 7)) * XCD_BAR_WORDS; b_.x = xb_xcc_id(); b_.st = (volatile LAS unsigned*)(lds + MISC_OFF) + 10; b_.total = gridDim.x / 8; xcd_barrier(b_); } while (0)
#define LAYER_BAR() do { if (grouped) { GROUP_BAR1(); if (PROBE_DUP & 1024) GROUP_BAR1(); } else GRID_BAR(); } while (0)

__global__ void __launch_bounds__(NWAVES * 64, 2) fwd_kernel(Args args_by_value) {
    extern __shared__ __attribute__((aligned(16))) unsigned char lds_raw[];
    LAS unsigned char* lds = (LAS unsigned char*)lds_raw;
    const int w0 = __builtin_amdgcn_readfirstlane((int)threadIdx.x >> 6);
    const int G0 = gridDim.x, bid0 = blockIdx.x; const int G = G0, bid = bid0;
    { const int tid0 = threadIdx.x; if (tid0 < 64) ((volatile LAS unsigned*)(lds + MISC_OFF))[tid0] = 0u; }
    __syncthreads();
    (void)xcd_barrier_post((unsigned*)(kargs()->ws + WS_CTL) + CW_BAR, (volatile LAS unsigned*)(lds + MISC_OFF) + 8);
#ifndef FORCE_UNGROUPED
#define FORCE_UNGROUPED 0
#endif
    const bool grouped = (G0 == 256) && !FORCE_UNGROUPED;
    if (grouped) (void)xcd_barrier_post((unsigned*)(kargs()->ws + WS_CTL) + CW_BAR + (1 + (bid0 & 7)) * XCD_BAR_WORDS, (volatile LAS unsigned*)(lds + MISC_OFF) + 10);
    {
        const int vcu = (G % 8 == 0) ? (bid % 8) * (G / 8) + bid / 8 : bid;
        prologue(kargs(), lds, vcu * NWAVES + w0, G * NWAVES, w0, pg8::pg8_lane());
        if (PROBE_DUP & 1) { WG_BAR(); prologue(kargs(), lds, vcu * NWAVES + w0, G * NWAVES, w0, pg8::pg8_lane()); }
    }
    GRID_BAR();
#ifndef GROUP_STAGGER_TICKS
#define GROUP_STAGGER_TICKS 0
#endif
    if (grouped && (bid0 & 1) && GROUP_STAGGER_TICKS > 0) { const unsigned long long t0 = __builtin_amdgcn_s_memrealtime(); while (__builtin_amdgcn_s_memrealtime() - t0 < (unsigned long long)GROUP_STAGGER_TICKS) __builtin_amdgcn_s_sleep(8); }

    for (int t = 0; t < 3 * DEPTH; ++t) {
        int G = G0, bid = bid0; asm volatile("" : "+s"(G), "+s"(bid));
        const int ng = grouped ? 8 : 1, gx = bid % ng, gy = bid / ng, Gy = G / ng;
        const int layer = t / 3, sub = t % 3;
        const int kind = (sub != 1) ? 0 : ((layer & 1) ? 2 : 1);
        const int j = layer >> 1;
        {
            unsigned char* ws = kargs()->ws;
            float* vec = (float*)(ws + WS_VEC);
            const bf16* R = (const bf16*)(ws + WS_R);
            const float* sp_in = (const float*)(ws + WS_SP) + (size_t)(t & 1) * (SP_BYTES / 4);
            if (kind == 0) {
                const int f = 2 * layer + (sub >> 1);
                pg8::Gemm g{(const bf16*)(ws + WS_R8), (const bf16*)(ws + WS_W13 + (size_t)f * NUP * D), M, NUP, D / 2}; pg8::StaticOrder S; S.init(M, NUP, G, bid);
                pg8::EpiUp E{f, t & 1};
                if (PROBE_DUP & 2048) { S.r1 = 5; pg8::gemm_phase<pg8::EpiUp, pg8::StaticOrder, true, PG8_SP2, true>(lds + RING_OFF, g, S, E, w0); LAYER_BAR(); S.r0 = 5; S.r1 = 1 << 20; }
                pg8::gemm_phase<pg8::EpiUp, pg8::StaticOrder, true, PG8_SP2, true>(lds + RING_OFF, g, S, E, w0);
                if (PROBE_DUP & 16) pg8::gemm_phase<pg8::EpiUp, pg8::StaticOrder, true, PG8_SP2, true>(lds + RING_OFF, g, S, E, w0);
                if (PROBE_DUP & 128) { pg8::EpiNull EN{(float*)(ws + WS_GATES)}; pg8::gemm_phase<pg8::EpiNull, pg8::StaticOrder, true, PG8_SP2, true>(lds + RING_OFF, g, S, EN, w0); }
            } else {
                if (kind == 2) {
                    pg8::Gemm g{R, (const bf16*)(ws + WS_WIN) + (size_t)j * NMI * D, M, NMI, D}; pg8::StaticOrder S; S.init(M, NMI, G, bid);
                    pg8::EpiLnOut E{1, j, t & 1};
                    pg8::gemm_phase<pg8::EpiLnOut, pg8::StaticOrder, true, PG8_SP2>(lds + RING_OFF, g, S, E, w0);
                    if (PROBE_DUP & 32) pg8::gemm_phase<pg8::EpiLnOut, pg8::StaticOrder, true, PG8_SP2>(lds + RING_OFF, g, S, E, w0);
                }
                if (kind == 1) {
                    const int N = kind == 1 ? NQKV : 2048;
                    pg8::Gemm g{(const bf16*)(ws + WS_R8), (const bf16*)(kind == 1 ? ws + WS_WQKV + (size_t)j * NQKV * D : ws + WS_WIN + 32 * MiB + (size_t)j * 2048 * D), M, N, D / 2}; pg8::StaticOrder S; S.init(M, N, G, bid);
                    pg8::EpiLnOut E{kind == 1 ? 0 : 2, j, t & 1};
                    pg8::gemm_phase<pg8::EpiLnOut, pg8::StaticOrder, true, PG8_SP2, true>(lds + RING_OFF, g, S, E, w0);
                    if (PROBE_DUP & 32) pg8::gemm_phase<pg8::EpiLnOut, pg8::StaticOrder, true, PG8_SP2, true>(lds + RING_OFF, g, S, E, w0);
                }
                if (kind == 2) {
                    gates_phase(lds, R, sp_in, (const bf16*)(vec + V_WG / 4) + (size_t)j * 8 * D, vec + V_CG / 4 + j * 16, (float*)(ws + WS_GATES), ng, gx, gy, Gy, w0);
                    if (PROBE_DUP & 8) { WG_BAR(); gates_phase(lds, R, sp_in, (const bf16*)(vec + V_WG / 4) + (size_t)j * 8 * D, vec + V_CG / 4 + j * 16, (float*)(ws + WS_GATES), ng, gx, gy, Gy, w0); }
                }
            }
        }
        LAYER_BAR();
        if (kind == 1) {
            if (!SKIP_ATT) { kargs_t ka = kargs(); unsigned char* ws = ka->ws; attn_phase(lds_raw, (const bf16*)(ws + WS_QKV), ws + WS_AO, ka->sinks + j * 32, ng, gx, gy, Gy, w0);
                if (PROBE_DUP & 2) attn_phase(lds_raw, (const bf16*)(ws + WS_QKV), ws + WS_AO, ka->sinks + j * 32, ng, gx, gy, Gy, w0); }
            LAYER_BAR();
        } else if (kind == 2) {
            if (!SKIP_MLSTM) { unsigned char* ws = kargs()->ws; mlstm_phase(lds_raw, (const bf16*)(ws + WS_MP), (const float*)(ws + WS_GATES), (bf16*)(ws + WS_HG), ng, gx, gy, Gy, w0);
                if (PROBE_DUP & 4) mlstm_phase<PROBE_MLV>(lds_raw, (const bf16*)(ws + WS_MP), (const float*)(ws + WS_GATES), (bf16*)(ws + WS_H), ng, gx, gy, Gy, w0); }
            LAYER_BAR();
        }
        {
            kargs_t ka = kargs(); unsigned char* ws = ka->ws;
            float coef = kind == 0 ? 0.5f / (pg8::F8_SH * pg8::F8_SW) : (kind == 1 ? 1.f / (pg8::F8_SO * pg8::F8_SW) : 1.f);
            if ((kind == 1 && SKIP_ATT) || (kind == 2 && SKIP_MLSTM)) coef = 0.f;
            pg8::StaticOrder S; S.init(M, D, G, bid);
            pg8::EpiRes E{t, coef, (LAS float*)(lds + TAB_OFF), w0, 0};
            if (kind != 2) {
                const int f = 2 * layer + (sub >> 1);
                pg8::Gemm g{(const bf16*)(ws + (kind == 0 ? WS_H : WS_AO)), (const bf16*)(kind == 0 ? ws + WS_W2 + (size_t)f * D * FF : ws + WS_WO + (size_t)j * D * D), M, D, kind == 0 ? FF / 2 : D / 2};
                if (PROBE_DUP & 64) { pg8::EpiNull EN{(float*)(ws + WS_GATES)}; pg8::gemm_phase<pg8::EpiNull, pg8::StaticOrder, true, PG8_SP2, true>(lds + RING_OFF, g, S, EN, w0); }
                if (PROBE_DUP & 512) { pg8::EpiRes ED{t, coef, (LAS float*)(lds + TAB_OFF), w0, PROBE_DRY}; pg8::gemm_phase<pg8::EpiRes, pg8::StaticOrder, true, PG8_SP2, true>(lds + RING_OFF, g, S, ED, w0); }
                pg8::gemm_phase<pg8::EpiRes, pg8::StaticOrder, true, PG8_SP2, true>(lds + RING_OFF, g, S, E, w0);
            } else {
                pg8::Gemm g{(const bf16*)(ws + WS_HG), (const bf16*)(ws + WS_WMO) + (size_t)j * D * D, M, D, D};
                if (PROBE_DUP & 256) { pg8::EpiNull EN{(float*)(ws + WS_GATES)}; pg8::gemm_phase<pg8::EpiNull, pg8::StaticOrder, true, PG8_SP2, false>(lds + RING_OFF, g, S, EN, w0); }
                pg8::gemm_phase<pg8::EpiRes, pg8::StaticOrder, true, PG8_SP2, false>(lds + RING_OFF, g, S, E, w0);
            }
        }
        LAYER_BAR();
    }
    {
        kargs_t ka = kargs(); unsigned char* ws = ka->ws;
        const int ng = grouped ? 8 : 1, gx = bid % ng, gy = bid / ng, Gy = G / ng;
        final_ln((const bf16*)(ws + WS_R), (const float*)(ws + WS_SP), ka->ln_g + (size_t)(3 * DEPTH - 1) * D, ka->ln_b + (size_t)(3 * DEPTH - 1) * D, ka->out, ng, gx, gy * NWAVES + w0, Gy * NWAVES, pg8::pg8_lane());
    }
}

extern "C" void kernel_launch(void* const* d_in, const int* in_sizes, int n_in, void* d_out, int out_size, void* d_ws, size_t ws_size, hipStream_t stream) {
    static int grid = 0;
    if (grid == 0) {
        if (n_in != 12 || in_sizes[0] != M * D || out_size != M * D || ws_size < WS_END) { fprintf(stderr, "kernel_launch: unexpected shapes / workspace (n_in %d, ws %zu < %zu); nothing launched\n", n_in, ws_size, (size_t)WS_END); grid = -1; return; }
        int dev = 0, cus = 0;
        if (hipGetDevice(&dev) != hipSuccess || hipDeviceGetAttribute(&cus, hipDeviceAttributeMultiprocessorCount, dev) != hipSuccess) { grid = -1; return; }
        if (hipFuncSetAttribute((const void*)fwd_kernel, hipFuncAttributeMaxDynamicSharedMemorySize, LDS_BYTES) != hipSuccess) { fprintf(stderr, "kernel_launch: hipFuncSetAttribute failed\n"); grid = -1; return; }
        int per_cu = 0;
        if (hipOccupancyMaxActiveBlocksPerMultiprocessor(&per_cu, (const void*)fwd_kernel, NWAVES * 64, LDS_BYTES) != hipSuccess || per_cu < 1) { fprintf(stderr, "kernel_launch: occupancy query says %d\n", per_cu); }
        (void)hipGetLastError();
        grid = cus;
#ifdef FORCE_GRID
        grid = FORCE_GRID;
#endif
    }
    if (grid < 0) return;
    (void)hipMemsetAsync((char*)d_ws + WS_CTL, 0, CTL_ZERO_BYTES, stream);
    Args a{};
    a.x = (const float*)d_in[0]; a.w1 = (const float*)d_in[1]; a.w3 = (const float*)d_in[2]; a.w2 = (const float*)d_in[3]; a.ln_g = (const float*)d_in[4]; a.ln_b = (const float*)d_in[5];
    a.wqkv = (const float*)d_in[6]; a.sinks = (const float*)d_in[7]; a.wo = (const float*)d_in[8]; a.win = (const float*)d_in[9]; a.bg = (const float*)d_in[10]; a.wmo = (const float*)d_in[11];
    a.out = (float*)d_out; a.ws = (unsigned char*)d_ws;
    hipLaunchKernelGGL(fwd_kernel, dim3(grid), dim3(NWAVES * 64), LDS_BYTES, stream, a);
}
```

```cpp
#include <hip/hip_runtime.h>
#include <hip/hip_bf16.h>
#include <cstdio>
#include <cstdint>
#include <cmath>

constexpr int BATCH = 8, SEQ = 2048, D = 2048, FF = 5632, DEPTH = 4;
constexpr int M = BATCH * SEQ;
constexpr int NUP = 2 * FF;
constexpr int NQKV = 2560;
constexpr int NMI = 6144, NMIW = 6152;
constexpr float LN_EPS = 1e-5f;
constexpr float ALPHA = 1.681792830507429f;
constexpr float LOG2E = 1.4426950408889634f;

constexpr size_t MiB = 1u << 20;
constexpr size_t WS_CTL = 0, CTL_ZERO_BYTES = 192 * 1024;
constexpr size_t WS_W13 = 2 * MiB;
constexpr size_t WS_W2 = 178 * MiB;
constexpr size_t WS_WQKV = 266 * MiB;
constexpr size_t WS_WO = 286 * MiB;
constexpr size_t WS_WIN = 302 * MiB;
constexpr size_t WS_WMO = 350 * MiB;
constexpr size_t WS_VEC = 366 * MiB;
constexpr size_t V_C1U = 0, V_C2U = 360448, V_C1Q = 720896, V_C2Q = 741376, V_C1I = 761856, V_C2I = 811008, V_CG = 860160, V_WG = 860416, V_ONES = 991488, V_ZEROS = 999680;
constexpr size_t WS_R = 368 * MiB;
constexpr size_t WS_R8 = 432 * MiB;
constexpr size_t WS_SP = 464 * MiB;
constexpr size_t SP_BYTES = (size_t)M * 16 * 4;
constexpr size_t WS_H = 466 * MiB;
constexpr size_t WS_QKV = 554 * MiB;
constexpr size_t WS_AO = 634 * MiB;
constexpr size_t WS_MP = 698 * MiB;
constexpr size_t WS_GATES = 890 * MiB;
constexpr size_t WS_HG = 891 * MiB;
constexpr size_t WS_END = 955 * MiB;
constexpr int CW_TMO = 0, CW_BAR = 4096;

struct Args { const float* x; const float* w1; const float* w3; const float* w2; const float* ln_g; const float* ln_b; const float* wqkv; const float* sinks; const float* wo;
              const float* win; const float* bg; const float* wmo; float* out; unsigned char* ws; };
typedef const __attribute__((address_space(4))) Args* kargs_t;
__device__ __forceinline__ kargs_t kargs() { kargs_t p = (kargs_t)__builtin_amdgcn_kernarg_segment_ptr(); asm volatile("" : "+s"(p)); return p; }

namespace pg8 {
#define PG8_LAS __attribute__((address_space(3)))
typedef unsigned short bf16_t;
typedef short bf16x8 __attribute__((ext_vector_type(8)));
typedef _Float16 f16x8 __attribute__((ext_vector_type(8)));
typedef float f32x4 __attribute__((ext_vector_type(4)));
typedef unsigned u32x4 __attribute__((ext_vector_type(4)));
constexpr int BM = 256, BK = 64, HALF = 128, HTB = HALF * BK * 2  , STAGE_BYTES = 8 * HTB, NXCD = 8, WGM = 8;

__host__ __device__ __forceinline__ int lds_byte(int r, int c) { const int st = (r >> 4) * 2 + (c >> 5), rr = r & 15, cc = c & 31, ob = rr * 64 + cc * 2; return st * 1024 + (ob ^ (((ob >> 9) & 1) << 5)); }
__host__ __device__ __forceinline__ void stage_rc(int b, int& R, int& C) { const int st = b / 1024, sb = b % 1024, swz = sb ^ (((sb >> 9) & 1) << 5); R = (st >> 1) * 16 + swz / 64; C = (st & 1) * 32 + (swz % 64) / 2; }
__host__ __device__ __forceinline__ int perm32(int rho) { const int n = rho >> 4, i = rho & 15; return 8 * (i >> 2) + 4 * n + (i & 3); }

typedef int i32x4 __attribute__((ext_vector_type(4)));
typedef int i32x8 __attribute__((ext_vector_type(8)));
constexpr float F8_SR = 8.f, F8_SW = 1024.f, F8_SH = 16.f, F8_SO = 64.f;
__device__ __forceinline__ i32x8 cat_i8(bf16x8 lo, bf16x8 hi) { const i32x4 a = __builtin_bit_cast(i32x4, lo), b = __builtin_bit_cast(i32x4, hi); return __builtin_shufflevector(a, b, 0, 1, 2, 3, 4, 5, 6, 7); }
__device__ __forceinline__ void mfma_f8_inplace(f32x4& c, const i32x8 a, const i32x8 b) { asm volatile("v_mfma_f32_16x16x128_f8f6f4 %0, %1, %2, %0 cbsz:0 blgp:0" : "+v"(c) : "v"(a), "v"(b)); }
typedef unsigned u32x2 __attribute__((ext_vector_type(2)));
__device__ __forceinline__ u32x2 cvt8_f8(const float (&v)[8], float s) {
    int a, b; asm volatile("" : "=v"(a), "=v"(b));
    a = __builtin_amdgcn_cvt_pk_fp8_f32(v[0] * s, v[1] * s, a, false); a = __builtin_amdgcn_cvt_pk_fp8_f32(v[2] * s, v[3] * s, a, true);
    b = __builtin_amdgcn_cvt_pk_fp8_f32(v[4] * s, v[5] * s, b, false); b = __builtin_amdgcn_cvt_pk_fp8_f32(v[6] * s, v[7] * s, b, true);
    return (u32x2){(unsigned)a, (unsigned)b};
}
__device__ __forceinline__ int pg8_lane() { int l; asm volatile("v_mbcnt_lo_u32_b32 %0, -1, 0\n\tv_mbcnt_hi_u32_b32 %0, -1, %0" : "=v"(l)); return l; }
struct Unit { int pm, pn, ord; };
struct Gemm { const bf16_t* A; const bf16_t* Bt; int M, N, K; };

struct StaticOrder {
    int nM, nN, nwg, G, c, r0 = 0, r1 = 1 << 20;
    __host__ __device__ void init(int M_, int N_, int G_, int c_) { nM = M_ / BM; nN = N_ / BM; nwg = nM * nN; G = G_; c = c_; }
    __host__ __device__ bool next(int i, Unit& u) const {
        i += r0; if (i >= r1) return false;
        const long L = (long)i * G + c; if (L >= nwg) return false;
        int wgid = (int)L; { const int q = nwg / NXCD, r = nwg % NXCD, xcd = wgid % NXCD, off = wgid / NXCD; wgid = (xcd < r ? xcd * (q + 1) : r * (q + 1) + (xcd - r) * q) + off; }
        const int nig = WGM * nN, gid = wgid / nig, fm = gid * WGM, gsz = (nM - fm) < WGM ? (nM - fm) : WGM;
        u.pm = fm + ((wgid % nig) % gsz); u.pn = (wgid % nig) / gsz; u.ord = i - r0; return true;
    }
    __device__ __forceinline__ void a_ready(const Unit&) const {}
    __device__ __forceinline__ void done(const Unit&) const {}
};

__device__ __forceinline__ unsigned cvt_pk_bf16(float lo, float hi) { typedef float f2 __attribute__((ext_vector_type(2))); typedef _Float16 b2 __attribute__((ext_vector_type(2))); f2 v = {lo, hi}; b2 b = __builtin_convertvector(v, b2); return __builtin_bit_cast(unsigned, b); }
__device__ __forceinline__ float bf_lo(unsigned w) { typedef _Float16 b2 __attribute__((ext_vector_type(2))); return (float)__builtin_bit_cast(b2, w)[0]; }
__device__ __forceinline__ float bf_hi(unsigned w) { typedef _Float16 b2 __attribute__((ext_vector_type(2))); return (float)__builtin_bit_cast(b2, w)[1]; }
__device__ __forceinline__ float fsigmoid(float x) { return __builtin_amdgcn_rcpf(1.f + __builtin_amdgcn_exp2f(-LOG2E * x)); }

__device__ __forceinline__ float sum_fq(float v) {
    auto a = __builtin_amdgcn_permlane16_swap(__float_as_uint(v), __float_as_uint(v), false, false); v = __uint_as_float(a[0]) + __uint_as_float(a[1]);
    auto b = __builtin_amdgcn_permlane32_swap(__float_as_uint(v), __float_as_uint(v), false, false); return __uint_as_float(b[0]) + __uint_as_float(b[1]);
}
constexpr int STAB_OFF = 131072 + 16384;
__device__ __forceinline__ void stats_prep(const float* sp, int pm, int wave) {
    PG8_LAS float* stab = (PG8_LAS float*)(STAB_OFF);
    const int tid = wave * 64 + pg8_lane();
    if (tid < BM) {
        const f32x4* p = (const f32x4*)(sp + (size_t)(pm * BM + tid) * 16);
        const f32x4 v0 = p[0], v1 = p[1], v2 = p[2], v3 = p[3];
        const float s = ((v0[0] + v0[2]) + (v1[0] + v1[2])) + ((v2[0] + v2[2]) + (v3[0] + v3[2])), q = ((v0[1] + v0[3]) + (v1[1] + v1[3])) + ((v2[1] + v2[3]) + (v3[1] + v3[3]));
        const float mean = s * (1.f / D), var = q * (1.f / D) - mean * mean;
        typedef float f32x2v __attribute__((ext_vector_type(2)));
        *(PG8_LAS f32x2v*)(stab + 2 * tid) = (f32x2v){mean, __builtin_amdgcn_rsqf(var + LN_EPS)};
    }
    if (tid == 0) *(PG8_LAS int*)(stab + 2 * BM) = pm;
}
constexpr int CTAB_OFF = STAB_OFF + 2048 + 64, CTAB_UNITS = 11;
template <class Sched> __device__ __forceinline__ void ctab_prep(const Sched& S, const float* c1, const float* c2, int wave) {
    const int tid = wave * 64 + pg8_lane();
    Unit u;
    for (int i = 0; i < CTAB_UNITS && S.next(i, u); ++i) {
        const float v = tid < BM ? c1[u.pn * BM + tid] : c2[u.pn * BM + tid - BM];
        typedef _Float16 h1;
        *(PG8_LAS h1*)(CTAB_OFF + i * 1024 + tid * 2) = (h1)v;
    }
}
__device__ __forceinline__ void ctab_get8(int ord, int which, int lc, float (&o)[8]) {
    typedef _Float16 h8 __attribute__((ext_vector_type(8)));
    const h8 v = *(PG8_LAS const h8*)(CTAB_OFF + ord * 1024 + which * 512 + lc * 2);
#pragma unroll
    for (int i = 0; i < 8; ++i) o[i] = (float)v[i];
}
__device__ __forceinline__ void row_stats(const float* sp, int row0, int fq, float (&mu)[2][4], float (&rs)[2][4]) {
    { PG8_LAS const float* stab = (PG8_LAS const float*)(STAB_OFF); const int pm = row0 / BM;
      if (*(PG8_LAS const int*)(stab + 2 * BM) == pm) {
          typedef float f32x2v __attribute__((ext_vector_type(2)));
#pragma unroll
          for (int ai = 0; ai < 2; ++ai)
#pragma unroll
              for (int m = 0; m < 4; ++m) { const f32x2v v = *(PG8_LAS const f32x2v*)(stab + 2 * ((row0 % BM) + ai * HALF + m * 16)); mu[ai][m] = v[0]; rs[ai][m] = v[1]; }
          return; } }
#pragma unroll
    for (int ai = 0; ai < 2; ++ai)
#pragma unroll
        for (int m = 0; m < 4; ++m) {
            const f32x4 v = *(const f32x4*)(sp + (size_t)(row0 + ai * HALF + m * 16) * 16 + fq * 4);
            float s = v[0] + v[2], q = v[1] + v[3];
            s = sum_fq(s); q = sum_fq(q);
            const float mean = s * (1.f / D), var = q * (1.f / D) - mean * mean;
            mu[ai][m] = mean; rs[ai][m] = __builtin_amdgcn_rsqf(var + LN_EPS);
        }
}

struct EpiNull {
    static constexpr bool PERM = true, AFTER_DRAIN = false;
    template <class Sched> __device__ __forceinline__ void prep(const Sched&, const Unit&, int) const {}
    float* sink;
    __device__ __forceinline__ void operator()(const f32x4 (&acc)[2][2][4][2], const Unit& u, int wr, int wc, int, int) const {
        float s = 0.f;
#pragma unroll
        for (int ai = 0; ai < 2; ++ai)
#pragma unroll
            for (int bj = 0; bj < 2; ++bj)
#pragma unroll
                for (int m = 0; m < 4; ++m)
#pragma unroll
                    for (int n = 0; n < 2; ++n) s += acc[ai][bj][m][n][0] + acc[ai][bj][m][n][1] + acc[ai][bj][m][n][2] + acc[ai][bj][m][n][3];
        if (s == 123.456f) sink[u.pm + wr + wc] = s;
    }
};

struct EpiUp {
    static constexpr bool PERM = true, AFTER_DRAIN = false;
    template <class Sched> __device__ __forceinline__ void prep(const Sched& S, const Unit& u, int wave) const { unsigned char* ws = kargs()->ws;
        stats_prep((const float*)(ws + WS_SP) + (size_t)tpar * (SP_BYTES / 4), u.pm, wave);
        ctab_prep(S, (const float*)(ws + WS_VEC + V_C1U) + (size_t)f * NUP, (const float*)(ws + WS_VEC + V_C2U) + (size_t)f * NUP, wave); }
    int f, tpar;
    __device__ __forceinline__ void operator()(const f32x4 (&acc)[2][2][4][2], const Unit& u, int wr, int wc, int, int) const {
        const int lane_ = pg8_lane(), fr = lane_ & 15, fq = lane_ >> 4;
        const int row0 = u.pm * BM + wr * 64 + fr;
        int f = this->f, tpar = this->tpar; asm volatile("" : "+s"(f), "+s"(tpar));
        unsigned char* ws = kargs()->ws; unsigned char* H = ws + WS_H;
        const float* c1 = (const float*)(ws + WS_VEC + V_C1U) + (size_t)f * NUP; const float* c2 = (const float*)(ws + WS_VEC + V_C2U) + (size_t)f * NUP; const float* sp = (const float*)(ws + WS_SP) + (size_t)tpar * (SP_BYTES / 4);
        float mu[2][4], rs[2][4]; row_stats(sp, row0, fq, mu, rs);
        const int cb = u.pn * BM + wc * 32 + 8 * fq;
        float k1[2][8], k2[2][8];
        if (u.ord < CTAB_UNITS) {
#pragma unroll
            for (int bj = 0; bj < 2; ++bj) { ctab_get8(u.ord, 0, wc * 32 + 8 * fq + bj * HALF, k1[bj]); ctab_get8(u.ord, 1, wc * 32 + 8 * fq + bj * HALF, k2[bj]); }
        } else {
#pragma unroll
            for (int bj = 0; bj < 2; ++bj)
#pragma unroll
                for (int i = 0; i < 8; ++i) { k1[bj][i] = c1[cb + bj * HALF + i]; k2[bj][i] = c2[cb + bj * HALF + i]; }
        }
        unsigned char* hp = H + (size_t)row0 * FF + u.pn * HALF + wc * 32 + 8 * fq;
#pragma unroll
        for (int ai = 0; ai < 2; ++ai)
#pragma unroll
            for (int m = 0; m < 4; ++m) {
                const float r_ = rs[ai][m], nm = -mu[ai][m] * r_, ra = r_ * (1.f / (F8_SR * F8_SW));
                typedef float f2 __attribute__((ext_vector_type(2)));
                f2 ga[4], ub[4], sg[4];
#pragma unroll
                for (int n = 0; n < 2; ++n)
#pragma unroll
                    for (int jj = 0; jj < 2; ++jj) {
                        const int c = 4 * n + 2 * jj;
                        const f2 ag = {acc[ai][0][m][n][2 * jj], acc[ai][0][m][n][2 * jj + 1]}, au = {acc[ai][1][m][n][2 * jj], acc[ai][1][m][n][2 * jj + 1]};
                        const f2 k1g = {k1[0][c], k1[0][c + 1]}, k2g = {k2[0][c], k2[0][c + 1]}, k1u = {k1[1][c], k1[1][c + 1]}, k2u = {k2[1][c], k2[1][c + 1]};
                        ga[2 * n + jj] = ag * ra + (k1g * nm + k2g);
                        ub[2 * n + jj] = au * ra + (k1u * nm + k2u);
                    }
#pragma unroll
                for (int i = 0; i < 4; ++i) { const f2 t = ga[i] * (-LOG2E); sg[i] = (f2){__builtin_amdgcn_exp2f(t[0]), __builtin_amdgcn_exp2f(t[1])}; }
#pragma unroll
                for (int i = 0; i < 4; ++i) { const f2 t = sg[i] + 1.f; sg[i] = (f2){__builtin_amdgcn_rcpf(t[0]), __builtin_amdgcn_rcpf(t[1])}; }
                float hv[8];
#pragma unroll
                for (int i = 0; i < 4; ++i) { const f2 h2 = ga[i] * sg[i] * ub[i]; hv[2 * i] = h2[0]; hv[2 * i + 1] = h2[1]; }
                *(u32x2*)(hp + (size_t)(ai * HALF + m * 16) * FF) = cvt8_f8(hv, F8_SH);
            }
    }
};

struct EpiLnOut {
    static constexpr bool PERM = true, AFTER_DRAIN = false;
    template <class Sched> __device__ __forceinline__ void prep(const Sched&, const Unit& u, int wave) const { stats_prep((const float*)(kargs()->ws + WS_SP) + (size_t)tpar * (SP_BYTES / 4), u.pm, wave); }
    int mode, j, tpar;
    __device__ __forceinline__ void operator()(const f32x4 (&acc)[2][2][4][2], const Unit& u, int wr, int wc, int, int) const {
        const int lane_ = pg8_lane(), fr = lane_ & 15, fq = lane_ >> 4;
        const int row0 = u.pm * BM + wr * 64 + fr;
        int mode = this->mode, j = this->j, tpar = this->tpar; asm volatile("" : "+s"(mode), "+s"(j), "+s"(tpar));
        const bool att = mode == 0; const int coff = mode == 2 ? 4096 : 0;
        unsigned char* ws = kargs()->ws; bf16_t* O = (bf16_t*)(ws + (att ? WS_QKV : WS_MP)) + coff; const int ldo = att ? NQKV : NMI, sig_from = mode == 2 ? 0 : (mode == 1 ? 16 : 1000);
        const float ascale = mode == 1 ? 1.f : 1.f / (F8_SR * F8_SW);
        const float* c1 = (const float*)(ws + WS_VEC + (att ? V_C1Q : V_C1I)) + j * ldo + coff; const float* c2 = (const float*)(ws + WS_VEC + (att ? V_C2Q : V_C2I)) + j * ldo + coff; const float* sp = (const float*)(ws + WS_SP) + (size_t)tpar * (SP_BYTES / 4);
        float mu[2][4], rs[2][4]; row_stats(sp, row0, fq, mu, rs);
        const int cb = u.pn * BM + wc * 32 + 8 * fq;
        const bool sg = u.pn >= sig_from;
        f32x4 k1[2][2], k2[2][2];
#pragma unroll
        for (int bj = 0; bj < 2; ++bj)
#pragma unroll
            for (int n = 0; n < 2; ++n) { k1[bj][n] = *(const f32x4*)(c1 + cb + bj * HALF + 4 * n); k2[bj][n] = *(const f32x4*)(c2 + cb + bj * HALF + 4 * n); }
        bf16_t* op = O + (size_t)row0 * ldo + cb;
#pragma unroll
        for (int ai = 0; ai < 2; ++ai)
#pragma unroll
            for (int m = 0; m < 4; ++m) {
                const float r_ = rs[ai][m], nm = -mu[ai][m] * r_, ra = r_ * ascale;
#pragma unroll
                for (int bj = 0; bj < 2; ++bj) {
                    typedef float f2 __attribute__((ext_vector_type(2)));
                    float v[8];
#pragma unroll
                    for (int n = 0; n < 2; ++n)
#pragma unroll
                        for (int jj = 0; jj < 2; ++jj) {
                            const f2 a2 = {acc[ai][bj][m][n][2 * jj], acc[ai][bj][m][n][2 * jj + 1]}, c1v = {k1[bj][n][2 * jj], k1[bj][n][2 * jj + 1]}, c2v = {k2[bj][n][2 * jj], k2[bj][n][2 * jj + 1]};
                            f2 t = a2 * ra + (c1v * nm + c2v);
                            if (sg) { const f2 e = t * (-LOG2E); const f2 d = (f2){__builtin_amdgcn_exp2f(e[0]), __builtin_amdgcn_exp2f(e[1])} + 1.f; t = (f2){__builtin_amdgcn_rcpf(d[0]), __builtin_amdgcn_rcpf(d[1])}; }
                            v[4 * n + 2 * jj] = t[0]; v[4 * n + 2 * jj + 1] = t[1];
                        }
                    u32x4 w; w.x = cvt_pk_bf16(v[0], v[1]); w.y = cvt_pk_bf16(v[2], v[3]); w.z = cvt_pk_bf16(v[4], v[5]); w.w = cvt_pk_bf16(v[6], v[7]);
                    *(u32x4*)(op + (size_t)(ai * HALF + m * 16) * ldo + bj * HALF) = w;
                }
            }
    }
};

struct EpiRes {
    static constexpr bool PERM = true, AFTER_DRAIN = false;
    template <class Sched> __device__ __forceinline__ void prep(const Sched&, const Unit& u, int wave) const { stats_prep((const float*)(kargs()->ws + WS_SP) + (size_t)(t & 1) * (SP_BYTES / 4), u.pm, wave); }
    int t; float coef; PG8_LAS float* tab; int wave; int dry;
    __device__ __forceinline__ void operator()(const f32x4 (&acc)[2][2][4][2], const Unit& u, int wr, int wc, int, int) const {
        const int lane_ = pg8_lane(), fr = lane_ & 15, fq = lane_ >> 4;
        typedef float f32x2v __attribute__((ext_vector_type(2)));
        const int row0 = u.pm * BM + wr * 64 + fr;
        int t = this->t; asm volatile("" : "+s"(t)); float coef = this->coef; asm volatile("" : "+v"(coef));
        const bool need8 = (t != 3 && t != 9 && t != 11) || dry;
        kargs_t ka = kargs(); unsigned char* ws = ka->ws; bf16_t* R = (bf16_t*)(ws + WS_R); unsigned char* R8 = ws + (dry ? WS_MP + 64 * MiB : WS_R8); bf16_t* Ro = dry ? (bf16_t*)(ws + WS_MP) : R;
        const float* g = t ? ka->ln_g + (size_t)(t - 1) * D : (const float*)(ws + WS_VEC + V_ONES); const float* b = t ? ka->ln_b + (size_t)(t - 1) * D : (const float*)(ws + WS_VEC + V_ZEROS);
        const float* sp_in = (const float*)(ws + WS_SP) + (size_t)(t & 1) * (SP_BYTES / 4); float* sp_out = dry ? (float*)(ws + WS_MP + 96 * MiB) : (float*)(ws + WS_SP) + (size_t)((t + 1) & 1) * (SP_BYTES / 4);
        const int cb0 = u.pn * BM + wc * 32 + 8 * fq;
        u32x4 cur[4];
#pragma unroll
        for (int m = 0; m < 4; ++m) cur[m] = *(const u32x4*)(R + (size_t)(row0 + m * 16) * D + cb0);
        float mu[2][4], rs[2][4]; row_stats(sp_in, row0, fq, mu, rs);
        f32x4 gv[2], bv[2];
#pragma unroll
        for (int k = 0; k < 4; ++k) {
            const int bj = k >> 1, ai = k & 1, cb = cb0 + bj * HALF;
            if (ai == 0) {
#pragma unroll
                for (int n = 0; n < 2; ++n) { gv[n] = *(const f32x4*)(g + cb + 4 * n); bv[n] = *(const f32x4*)(b + cb + 4 * n) * ALPHA; }
            }
#pragma unroll
            for (int m = 0; m < 4; ++m) {
                const float A_ = ALPHA * rs[ai][m], B_ = -mu[ai][m] * A_;
                const size_t off = (size_t)(row0 + ai * HALF + m * 16) * D + cb;
                const u32x4 o = cur[m];
                if (k < 3 && dry != 3) cur[m] = *(const u32x4*)(R + (size_t)(row0 + ((k + 1) & 1) * HALF + m * 16) * D + cb0 + ((k + 1) >> 1) * HALF);
                typedef float fv2 __attribute__((ext_vector_type(2)));
                float nv[8];
#pragma unroll
                for (int n = 0; n < 2; ++n)
#pragma unroll
                    for (int jj = 0; jj < 2; ++jj) {
                        const unsigned w2 = n == 0 ? (jj == 0 ? o.x : o.y) : (jj == 0 ? o.z : o.w); const fv2 r2 = {bf_lo(w2), bf_hi(w2)}, a2 = {acc[ai][bj][m][n][2 * jj], acc[ai][bj][m][n][2 * jj + 1]};
                        const fv2 g2 = {gv[n][2 * jj], gv[n][2 * jj + 1]}, b2 = {bv[n][2 * jj], bv[n][2 * jj + 1]};
                        const fv2 t = (r2 * A_ + B_) * g2 + (a2 * coef + b2);
                        nv[4 * n + 2 * jj] = t[0]; nv[4 * n + 2 * jj + 1] = t[1];
                    }
                u32x4 w; w.x = cvt_pk_bf16(nv[0], nv[1]); w.y = cvt_pk_bf16(nv[2], nv[3]); w.z = cvt_pk_bf16(nv[4], nv[5]); w.w = cvt_pk_bf16(nv[6], nv[7]);
                if (dry != 2) { *(u32x4*)(Ro + off) = w;
                if (need8) *(u32x2*)(R8 + off) = cvt8_f8(nv, F8_SR); }
                const float f0 = bf_lo(w.x), f1 = bf_hi(w.x), f2 = bf_lo(w.y), f3 = bf_hi(w.y), f4 = bf_lo(w.z), f5 = bf_hi(w.z), f6 = bf_lo(w.w), f7 = bf_hi(w.w);
                float s = ((f0 + f1) + (f2 + f3)) + ((f4 + f5) + (f6 + f7));
                float q = ((f0 * f0 + f1 * f1) + (f2 * f2 + f3 * f3)) + ((f4 * f4 + f5 * f5) + (f6 * f6 + f7 * f7));
                s = sum_fq(s); q = sum_fq(q);
                if (fq == 0) *(PG8_LAS f32x2v*)(tab + (((ai * HALF + wr * 64 + m * 16 + fr) * 4 + wc) * 2 + bj) * 2) = (f32x2v){s, q};
                asm volatile("" ::: "memory");
            }
        }
        asm volatile("s_waitcnt lgkmcnt(0)" ::: "memory"); __builtin_amdgcn_s_barrier(); asm volatile("" ::: "memory");
        const int tid = wave * 64 + pg8_lane();
        if (tid < BM) {
            const PG8_LAS f32x4* t4 = (const PG8_LAS f32x4*)(tab + tid * 16);
            const f32x4 a = t4[0], c = t4[1], d = t4[2], e = t4[3];
            *(f32x2v*)(sp_out + (size_t)(u.pm * BM + tid) * 16 + u.pn * 2) = (f32x2v){((a[0] + a[2]) + (c[0] + c[2])) + ((d[0] + d[2]) + (e[0] + e[2])), ((a[1] + a[3]) + (c[1] + c[3])) + ((d[1] + d[3]) + (e[1] + e[3]))};
        }
    }
};

template <class Epi, class Sched, bool ALIGN_EPI = false, bool SP2 = false, bool F8 = false>
__device__ __forceinline__ void gemm_phase(PG8_LAS unsigned char* lds, const Gemm g, const Sched& S, const Epi& E, int wave_in) {
    int wid = wave_in; asm volatile("" : "+s"(wid));
    const int lane = pg8_lane(), tid = wid * 64 + lane, wr = wid >> 2, wc = wid & 3, fr = lane & 15, fq = lane >> 4;
    const int K = g.K, nt = K / BK;
    unsigned voffA[2], voffB[2];
#pragma unroll
    for (int i = 0; i < 2; ++i) { int R, C; stage_rc(tid * 16 + i * 8192, R, C); const int Rb = Epi::PERM ? ((R & ~31) + perm32(R & 31)) : R;
        voffA[i] = (unsigned)(R * K + C) * 2u; voffB[i] = (unsigned)(Rb * K + C) * 2u; }
    const size_t kstep = (size_t)(BK * 2);
    const size_t hstep = (size_t)HALF * K * 2;
    const size_t tstep = 2 * hstep;
    const unsigned ldsw = (unsigned)wid * 1024u;
    const int aoff = lds_byte(wr * 64 + fr, fq * 8), boff = lds_byte(wc * 32 + fr, fq * 8);
#define PG8_SA(b, h) (((b) * 2 + (h)) * HTB)
#define PG8_SB(b, h) ((4 + (b) * 2 + (h)) * HTB)
#define PG8_STAGE(bufoff, gbase, voff) do { _Pragma("unroll") for (int _i = 0; _i < 2; ++_i) \
        __builtin_amdgcn_global_load_lds((const unsigned*)((const char*)(gbase) + (voff)[_i]), (PG8_LAS unsigned*)(lds + (bufoff) + ldsw + _i * 8192), 16, 0, 0); } while (0)
#define PG8_LDA(dst, b, h) do { _Pragma("unroll") for (int m = 0; m < 4; ++m) _Pragma("unroll") for (int k = 0; k < 2; ++k) dst[m][k] = *(const PG8_LAS bf16x8*)(lds + PG8_SA(b, h) + aoff + m * 2048 + k * 1024); } while (0)
#define PG8_LDB(dst, b, h) do { _Pragma("unroll") for (int n = 0; n < 2; ++n) _Pragma("unroll") for (int k = 0; k < 2; ++k) dst[n][k] = *(const PG8_LAS bf16x8*)(lds + PG8_SB(b, h) + boff + n * 2048 + k * 1024); } while (0)
#define PG8_MMA(ai, bj, At, Bt) do { __builtin_amdgcn_s_setprio(1); _Pragma("unroll") for (int m = 0; m < 4; ++m) _Pragma("unroll") for (int n = 0; n < 2; ++n) { \
        if constexpr (F8) mfma_f8_inplace(acc[ai][bj][m][n], cat_i8(Bt[n][0], Bt[n][1]), cat_i8(At[m][0], At[m][1])); \
        else { _Pragma("unroll") for (int k = 0; k < 2; ++k) acc[ai][bj][m][n] = __builtin_amdgcn_mfma_f32_16x16x32_f16(__builtin_bit_cast(f16x8, Bt[n][k]), __builtin_bit_cast(f16x8, At[m][k]), acc[ai][bj][m][n], 0, 0, 0); } } \
        __builtin_amdgcn_s_setprio(0); } while (0)
#define PG8_WAIT_V(n) asm volatile("s_waitcnt vmcnt(" #n ")" ::: "memory")
#define PG8_WAIT_L(n) asm volatile("s_waitcnt lgkmcnt(" #n ")" ::: "memory")
#define PG8_BAR __builtin_amdgcn_s_barrier()
#define PG8_SCHED __builtin_amdgcn_sched_barrier(0)
    Unit cur, nxt; int ui = 0;
    if (!S.next(0, cur)) return;
    E.prep(S, cur, wave_in);
    f32x4 acc[2][2][4][2];
#pragma unroll
    for (int a = 0; a < 2; ++a)
#pragma unroll
        for (int b = 0; b < 2; ++b)
#pragma unroll
            for (int m = 0; m < 4; ++m)
#pragma unroll
                for (int n = 0; n < 2; ++n) { float z0, z1, z2, z3; asm volatile("v_mov_b32 %0, 0\n\tv_mov_b32 %1, 0\n\tv_mov_b32 %2, 0\n\tv_mov_b32 %3, 0" : "=v"(z0), "=v"(z1), "=v"(z2), "=v"(z3)); acc[a][b][m][n] = (f32x4){z0, z1, z2, z3}; }
    bf16x8 At[4][2], B0[2][2], B1[2][2];
    const char* cA = (const char*)g.A + (size_t)cur.pm * tstep; const char* cB = (const char*)g.Bt + (size_t)cur.pn * tstep;
    S.a_ready(cur);
    if constexpr (SP2) {
        PG8_STAGE(PG8_SB(0, 0), cB, voffB); PG8_STAGE(PG8_SB(0, 1), cB + hstep, voffB); PG8_STAGE(PG8_SA(0, 0), cA, voffA); PG8_STAGE(PG8_SA(0, 1), cA + hstep, voffA);
        if (wr == 1) PG8_BAR;
        PG8_WAIT_V(2); PG8_BAR;
        PG8_STAGE(PG8_SB(1, 0), cB + kstep, voffB); PG8_STAGE(PG8_SA(1, 0), cA + kstep, voffA); PG8_STAGE(PG8_SB(1, 1), cB + hstep + kstep, voffB);
        PG8_WAIT_V(6); PG8_BAR;
    } else {
        PG8_STAGE(PG8_SB(0, 0), cB, voffB); PG8_STAGE(PG8_SA(0, 0), cA, voffA); PG8_STAGE(PG8_SB(0, 1), cB + hstep, voffB); PG8_STAGE(PG8_SA(0, 1), cA + hstep, voffA);
        if (wr == 1) PG8_BAR;
        PG8_WAIT_V(4); PG8_BAR;
        PG8_STAGE(PG8_SB(1, 0), cB + kstep, voffB); PG8_STAGE(PG8_SA(1, 0), cA + kstep, voffA); PG8_STAGE(PG8_SB(1, 1), cB + hstep + kstep, voffB);
        PG8_WAIT_V(6); PG8_BAR;
    }
    for (;;) {
        const bool has_next = S.next(ui + 1, nxt);
        const char* nA = has_next ? (const char*)g.A + (size_t)nxt.pm * tstep : cA; const char* nB = has_next ? (const char*)g.Bt + (size_t)nxt.pn * tstep : cB;
        for (int t = 0; t < nt; t += 2) {
            const bool last = (t == nt - 2);
            const char* a1 = cA + (size_t)(t + 1) * kstep;
            const char* a2 = last ? nA : cA + (size_t)(t + 2) * kstep; const char* b2 = last ? nB : cB + (size_t)(t + 2) * kstep;
            const char* a3 = a2 + kstep; const char* b3 = b2 + kstep;
            if (last && has_next) S.a_ready(nxt);
            if constexpr (SP2) {
            PG8_LDB(B0, 0, 0); PG8_LDB(B1, 0, 1); PG8_SCHED; PG8_LDA(At, 0, 0); PG8_STAGE(PG8_SA(1, 1), a1 + hstep, voffA);
            PG8_WAIT_V(8); PG8_WAIT_L(0); PG8_BAR; PG8_MMA(0, 0, At, B0); PG8_MMA(0, 1, At, B1); PG8_BAR; PG8_SCHED;
            PG8_LDA(At, 0, 1); PG8_STAGE(PG8_SB(0, 0), b2, voffB); PG8_STAGE(PG8_SB(0, 1), b2 + hstep, voffB); PG8_STAGE(PG8_SA(0, 0), a2, voffA);
            PG8_WAIT_V(8); PG8_WAIT_L(0); PG8_BAR; PG8_MMA(1, 0, At, B0); PG8_MMA(1, 1, At, B1); PG8_BAR; PG8_SCHED;
            PG8_LDB(B0, 1, 0); PG8_LDB(B1, 1, 1); PG8_SCHED; PG8_LDA(At, 1, 0); PG8_STAGE(PG8_SA(0, 1), a2 + hstep, voffA);
            PG8_WAIT_V(8); PG8_WAIT_L(0); PG8_BAR; PG8_MMA(0, 0, At, B0); PG8_MMA(0, 1, At, B1); PG8_BAR; PG8_SCHED;
            PG8_LDA(At, 1, 1); PG8_STAGE(PG8_SB(1, 0), b3, voffB); PG8_STAGE(PG8_SB(1, 1), b3 + hstep, voffB); PG8_STAGE(PG8_SA(1, 0), a3, voffA);
            PG8_WAIT_V(8); PG8_WAIT_L(0); PG8_BAR; PG8_MMA(1, 0, At, B0); PG8_MMA(1, 1, At, B1); PG8_BAR; PG8_SCHED;
            } else {
            PG8_LDB(B0, 0, 0); PG8_SCHED; PG8_LDA(At, 0, 0); PG8_STAGE(PG8_SA(1, 1), a1 + hstep, voffA);
            PG8_WAIT_L(8); PG8_BAR; PG8_WAIT_L(0); PG8_MMA(0, 0, At, B0); PG8_BAR; PG8_SCHED;
            PG8_LDB(B1, 0, 1); PG8_STAGE(PG8_SB(0, 0), b2, voffB);
            PG8_BAR; PG8_WAIT_L(0); PG8_MMA(0, 1, At, B1); PG8_BAR;
            PG8_LDA(At, 0, 1); PG8_STAGE(PG8_SA(0, 0), a2, voffA);
            PG8_BAR; PG8_WAIT_L(0); PG8_MMA(1, 0, At, B0); PG8_BAR; PG8_SCHED;
            PG8_STAGE(PG8_SB(0, 1), b2 + hstep, voffB);
            PG8_WAIT_V(6); PG8_BAR; PG8_MMA(1, 1, At, B1); PG8_BAR;
            PG8_LDB(B0, 1, 0); PG8_SCHED; PG8_LDA(At, 1, 0); PG8_STAGE(PG8_SA(0, 1), a2 + hstep, voffA);
            PG8_WAIT_L(8); PG8_BAR; PG8_WAIT_L(0); PG8_MMA(0, 0, At, B0); PG8_BAR; PG8_SCHED;
            PG8_LDB(B1, 1, 1); PG8_STAGE(PG8_SB(1, 0), b3, voffB);
            PG8_BAR; PG8_WAIT_L(0); PG8_MMA(0, 1, At, B1); PG8_BAR;
            PG8_LDA(At, 1, 1); PG8_STAGE(PG8_SA(1, 0), a3, voffA);
            PG8_BAR; PG8_WAIT_L(0); PG8_MMA(1, 0, At, B0); PG8_BAR; PG8_SCHED;
            PG8_STAGE(PG8_SB(1, 1), b3 + hstep, voffB);
            PG8_WAIT_V(6); PG8_BAR; PG8_MMA(1, 1, At, B1); PG8_BAR;
            }
        }
        if constexpr (F8) asm volatile("s_nop 15\n\ts_nop 7" ::: "memory");
        if constexpr (ALIGN_EPI) { if (wr == 0) PG8_BAR; }
        if constexpr (!Epi::AFTER_DRAIN) { E(acc, cur, wr, wc, fr, fq); S.done(cur); }
        if (!has_next) break;
#pragma unroll
        for (int a = 0; a < 2; ++a)
#pragma unroll
            for (int b = 0; b < 2; ++b)
#pragma unroll
                for (int m = 0; m < 4; ++m)
#pragma unroll
                    for (int n = 0; n < 2; ++n) { float z0, z1, z2, z3; asm volatile("v_mov_b32 %0, 0\n\tv_mov_b32 %1, 0\n\tv_mov_b32 %2, 0\n\tv_mov_b32 %3, 0" : "=v"(z0), "=v"(z1), "=v"(z2), "=v"(z3)); acc[a][b][m][n] = (f32x4){z0, z1, z2, z3}; }
        cur = nxt; cA = nA; cB = nB; ++ui;
        if constexpr (ALIGN_EPI) { if (wr == 1) PG8_BAR; }
    }
    PG8_WAIT_V(0);
    if constexpr (!ALIGN_EPI) { if (wr == 0) PG8_BAR; }
    PG8_BAR;
    if constexpr (Epi::AFTER_DRAIN) { E.fused(acc, cur, wr, wc, fr, fq, lds, wid, lane); S.done(cur); }
#undef PG8_SA
#undef PG8_SB
#undef PG8_STAGE
#undef PG8_LDA
#undef PG8_LDB
#undef PG8_MMA
#undef PG8_WAIT_V
#undef PG8_WAIT_L
#undef PG8_BAR
#undef PG8_SCHED
}
}

#ifndef PG8_SP2
#define PG8_SP2 true
#endif

#define GAS __attribute__((address_space(1)))
#define LAS __attribute__((address_space(3)))
typedef unsigned short bf16;
typedef unsigned v4u __attribute__((ext_vector_type(4)));
typedef unsigned v2u __attribute__((ext_vector_type(2)));
typedef float f32x4 __attribute__((ext_vector_type(4)));
typedef float f32x2 __attribute__((ext_vector_type(2)));
typedef float f32x16 __attribute__((ext_vector_type(16)));
typedef short bf16x8 __attribute__((ext_vector_type(8)));
typedef short s16x4 __attribute__((ext_vector_type(4)));
typedef GAS unsigned gu32;
typedef GAS unsigned long long gu64;
typedef LAS const char* lcp;
typedef LAS char* lwp;
#define RLX_AGENT __ATOMIC_RELAXED, __HIP_MEMORY_SCOPE_AGENT
#define LDS_WAIT() asm volatile("s_waitcnt lgkmcnt(0)" ::: "memory")
#define VM_WAIT() asm volatile("s_waitcnt vmcnt(0)" ::: "memory")
#define WG_BAR() do { asm volatile("s_waitcnt vmcnt(0) lgkmcnt(0)" ::: "memory"); __builtin_amdgcn_s_barrier(); asm volatile("" ::: "memory"); } while (0)
#define DI __device__ __forceinline__
#define MFMA32(a, b, c) __builtin_amdgcn_mfma_f32_32x32x16_f16(__builtin_bit_cast(pg8::f16x8, (a)), __builtin_bit_cast(pg8::f16x8, (b)), (c), 0, 0, 0)
DI unsigned pk2(float lo, float hi) { return pg8::cvt_pk_bf16(lo, hi); }
DI float bflo(unsigned w) { return pg8::bf_lo(w); }
DI float bfhi(unsigned w) { return pg8::bf_hi(w); }
DI float ex2(float x) { return __builtin_amdgcn_exp2f(x); }
DI f32x16 zero16() { float z = 0.f; asm volatile("" : "+v"(z)); return (f32x16){z, z, z, z, z, z, z, z, z, z, z, z, z, z, z, z}; }
DI int crow(int r, int hi) { return (r & 3) + 8 * (r >> 2) + 4 * hi; }
#define SWZ_XOR(v, m) __uint_as_float((unsigned)__builtin_amdgcn_ds_swizzle((int)__float_as_uint(v), ((m) << 10) | 0x1f))
DI float half_swap_add(float v);
DI float wave_sum(float v) { v += SWZ_XOR(v, 1); v += SWZ_XOR(v, 2); v += SWZ_XOR(v, 4); v += SWZ_XOR(v, 8); v += SWZ_XOR(v, 16); return half_swap_add(v); }
DI float shfl_lane(float v, int src_lane) { return __uint_as_float((unsigned)__builtin_amdgcn_ds_bpermute(src_lane << 2, (int)__float_as_uint(v))); }
DI float half_swap_add(float v) { auto rr = __builtin_amdgcn_permlane32_swap(__float_as_uint(v), __float_as_uint(v), false, false); return __uint_as_float(rr[0]) + __uint_as_float(rr[1]); }
DI float half_swap_max(float v) { auto rr = __builtin_amdgcn_permlane32_swap(__float_as_uint(v), __float_as_uint(v), false, false); return fmaxf(__uint_as_float(rr[0]), __uint_as_float(rr[1])); }
typedef short v4i16_t __attribute__((ext_vector_type(4)));
DI s16x4 vtr(lcp p) { return __builtin_bit_cast(s16x4, __builtin_amdgcn_ds_read_tr16_b64_v4i16((LAS v4i16_t*)p)); }
DI bf16x8 cat8(s16x4 lo, s16x4 hi) { return (bf16x8){lo[0], lo[1], lo[2], lo[3], hi[0], hi[1], hi[2], hi[3]}; }
DI bf16x8 trfrag(lcp p) { return cat8(vtr(p), vtr(p + 512)); }
DI bf16x8 ldfrag(lcp p) { return *(const LAS bf16x8*)p; }
DI void glds16(const void* gsrc, LAS void* ldst) { __builtin_amdgcn_global_load_lds((const unsigned*)gsrc, (LAS unsigned*)ldst, 16, 0, 0); }
#define PACK8(x, s) ((bf16x8)__builtin_bit_cast(bf16x8, (v4u){pk2((x)[8 * (s) + 0], (x)[8 * (s) + 1]), pk2((x)[8 * (s) + 2], (x)[8 * (s) + 3]), pk2((x)[8 * (s) + 4], (x)[8 * (s) + 5]), pk2((x)[8 * (s) + 6], (x)[8 * (s) + 7])}))

constexpr int RING_OFF = 0, RING_BYTES = 131072;
constexpr int TAB_OFF = 131072;
constexpr int MISC_OFF = 163840 - 256;
constexpr int LDS_BYTES = 163840;
constexpr int AT_K = 0, AT_V = 32768, AT_WS = 65536, AT_STG = 67584;
constexpr int ML_K = 0, ML_V = 65536, ML_VW = 81920, ML_C = 98304, ML_N = 131072, ML_G2 = 131584, ML_M2 = 132096, ML_FI = 132608, ML_EI = 133120, ML_WK = 133632, ML_WKB = 134144, ML_SC = 134400, ML_WS = 134464, ML_STG = 136512;
static_assert(ML_STG + 4 * 4096 <= MISC_OFF && AT_STG + 8 * 4096 <= MISC_OFF && pg8::CTAB_OFF + pg8::CTAB_UNITS * 1024 <= MISC_OFF && pg8::STAB_OFF == TAB_OFF + 16384, "LDS map");

#define XB_TMO      128
#define XB_XCNT(j)  (256  + 64 * (j))
#define XB_XSUB(j)  (1280 + 64 * (j))
#define XB_XGEN(j)  (2304 + 64 * (j))
#define XB_TOP      3328
#define XB_TOPGEN   3392
#define XCD_BAR_WORDS 3456
#define XB_SPIN_CAP (1u << 18)

__device__ __forceinline__ unsigned xb_ld(unsigned* p)              { return __hip_atomic_load(p, __ATOMIC_RELAXED, __HIP_MEMORY_SCOPE_AGENT); }
__device__ __forceinline__ unsigned xb_add(unsigned* p, unsigned v) { return __hip_atomic_fetch_add(p, v, __ATOMIC_RELAXED, __HIP_MEMORY_SCOPE_AGENT); }
__device__ __forceinline__ unsigned xb_xcc_id() { return (unsigned)__builtin_amdgcn_s_getreg((3 << 11) | 20) & 0xFu; }
#define XB_SPIN(cond, bar) do { unsigned _sp = 0; while (cond) { __builtin_amdgcn_s_sleep(1); \
    if ((++_sp & 255u) == 0u) { if (xb_ld(&(bar)[XB_TMO])) break; if (_sp > XB_SPIN_CAP) { atomicAdd(&(bar)[XB_TMO], 1u); break; } } } } while (0)

struct XcdBarrier {
    unsigned* bar; unsigned x;
    volatile LAS unsigned* st;
    unsigned total;
};

__device__ __forceinline__ XcdBarrier xcd_barrier_post(unsigned* bar, volatile LAS unsigned* st) {
    XcdBarrier b; b.bar = bar; b.x = xb_xcc_id(); b.st = st; b.total = gridDim.x * gridDim.y * gridDim.z;
    if (threadIdx.x == 0) (void)xb_add(&bar[XB_XCNT(b.x)], 1u);
    return b;
}
__device__ __forceinline__ void xcd_barrier_complete(unsigned* bar, unsigned x, unsigned G, unsigned& nloc, unsigned& nx) {
    unsigned sum, cnt, mine, sp = 0u;
    for (;;) {
        sum = 0u; cnt = 0u; mine = 0u;
#pragma unroll
        for (unsigned j = 0; j < 16; ++j) { const unsigned c = xb_ld(&bar[XB_XCNT(j)]); sum += c; cnt += (c > 0u) ? 1u : 0u; mine = (j == x) ? c : mine; }
        if (sum == G) break;
        __builtin_amdgcn_s_sleep(1);
        if ((++sp & 255u) == 0u) { if (xb_ld(&bar[XB_TMO])) break; if (sp > XB_SPIN_CAP) { atomicAdd(&bar[XB_TMO], 1u); break; } }
    }
    nloc = mine > 0u ? mine : 1u; nx = cnt > 0u ? cnt : 1u;
}

__device__ __forceinline__ void xcd_barrier(const XcdBarrier& b) {
    asm volatile("s_waitcnt vmcnt(0)" ::: "memory");
    __syncthreads();
    if (threadIdx.x == 0) {
        unsigned* bar = b.bar;
        __builtin_amdgcn_s_waitcnt(0);
        unsigned nloc = b.st[0], nx = b.st[1];
        if (nloc == 0u) { xcd_barrier_complete(bar, b.x, b.total, nloc, nx); b.st[0] = nloc; b.st[1] = nx; }
        const unsigned old = xb_add(&bar[XB_XSUB(b.x)], 1u);
        const unsigned gen = old / nloc;
        if (old + 1u == (gen + 1u) * nloc) {
            __builtin_amdgcn_fence(__ATOMIC_RELEASE, "agent");
            asm volatile("s_waitcnt vmcnt(0)" ::: "memory");
            const unsigned og = xb_add(&bar[XB_TOP], 1u);
            const unsigned tg = og / nx;
            if (og + 1u == (tg + 1u) * nx) xb_add(&bar[XB_TOPGEN], 1u);
            else XB_SPIN(xb_ld(&bar[XB_TOPGEN]) == tg, bar);
            __builtin_amdgcn_fence(__ATOMIC_ACQUIRE, "agent");
            xb_add(&bar[XB_XGEN(b.x)], 1u);
            asm volatile("s_waitcnt vmcnt(0)" ::: "memory");
        } else {
            XB_SPIN(xb_ld(&bar[XB_XGEN(b.x)]) == gen, bar);
            __builtin_amdgcn_fence(__ATOMIC_ACQUIRE, "agent");
            asm volatile("s_waitcnt vmcnt(0)" ::: "memory");
        }
    }
    __syncthreads();
}
DI void attn_phase(unsigned char* ldsg, const bf16* QKV, unsigned char* AO8, const float* sinks, int ng, int gx, int gy, int Gy, int wave_in) {
    int wid = wave_in; asm volatile("" : "+s"(wid));
    const int lane = pg8::pg8_lane(), tid = wid * 64 + lane, r32 = lane & 31, hi = lane >> 5;
    LAS unsigned char* lds = (LAS unsigned char*)ldsg; const lcp L = (lcp)lds;
    LAS float* wsf = (LAS float*)(lds + AT_WS) + wid * 64;
    LAS unsigned char* stg = lds + AT_STG + wid * 4096;
    const lcp vlane = L + AT_V + ((lane >> 4) & 1) * 32 + (lane & 3) * 8 + (4 * hi + ((lane & 15) >> 2)) * 64;
    const lcp klane = L + AT_K + hi * 1024 + r32 * 16;
    for (int uu = gy; uu < 64 * (BATCH / ng); uu += Gy) { const int b = gx + ng * (uu >> 6), ul = uu & 63;
        const int kvh = ul & 3, nb = ul >> 2;
        const long rowq = (long)b * SEQ + nb * 128, rowk = rowq - 128;
        const int slot_lo = (nb == 0) ? 2 : 0;
        for (int sl = slot_lo; sl < 4; ++sl) {
            glds16(QKV + (rowk + 64 * sl + lane) * NQKV + 2048 + 64 * kvh + 8 * wid, lds + AT_K + sl * 8192 + wid * 1024);
            glds16(QKV + (rowk + 64 * sl + 16 * (wid & 3) + (lane >> 2)) * NQKV + 2304 + 64 * kvh + (wid >> 2) * 32 + (lane & 3) * 8, lds + AT_V + sl * 8192 + wid * 1024);
        }
        const int hq = 8 * kvh + wid;
        const bf16* qsrc = QKV + (rowq + r32) * NQKV + 64 * hq + 8 * hi;
        bf16x8 qn[4];
#pragma unroll
        for (int d0 = 0; d0 < 4; ++d0) qn[d0] = *(const bf16x8*)(qsrc + 16 * d0);
        const float slope2 = ex2(-0.25f * (float)(hq + 1)) * LOG2E, sink2 = sinks[hq] * LOG2E;
        const float base_l = -slope2 * (float)(r32 - 4 * hi);
        WG_BAR();
#pragma unroll 1
        for (int j = 0; j < 4; ++j) {
            const int ilo = (nb == 0) ? 4 - j : 0;
            bf16x8 qr[4];
#pragma unroll
            for (int d0 = 0; d0 < 4; ++d0) qr[d0] = qn[d0];
            if (j < 3) {
#pragma unroll
                for (int d0 = 0; d0 < 4; ++d0) qn[d0] = *(const bf16x8*)(qsrc + (size_t)(32 * (j + 1)) * NQKV + 16 * d0);
            }
            float sl2 = slope2, bl = base_l; asm volatile("" : "+v"(sl2), "+v"(bl));
            f32x16 p[5];
#pragma unroll
            for (int i = 0; i < 5; ++i) {
                if (i >= ilo) {
                    const int kt = j + i; const lcp kb = klane + (kt >> 1) * 8192 + (kt & 1) * 512;
                    f32x16 a = zero16();
#pragma unroll
                    for (int d0 = 0; d0 < 4; ++d0) a = MFMA32(ldfrag(kb + d0 * 2048), qr[d0], a);
#pragma unroll
                    for (int r = 0; r < 16; ++r) {
                        const int cr = (r & 3) + 8 * (r >> 2);
                        float s = fmaf(sl2, (float)(cr - 128 + 32 * i), fmaf(a[r], LOG2E, bl));
                        if (i == 0) { if (!(cr + 4 * hi > r32)) s = -INFINITY; }
                        if (i == 4) { if (!(cr + 4 * hi <= r32)) s = -INFINITY; }
                        a[r] = s;
                    }
                    p[i] = a;
                } else {
#pragma unroll
                    for (int r = 0; r < 16; ++r) p[i][r] = -INFINITY;
                }
            }
            float mx = sink2;
#pragma unroll
            for (int i = 0; i < 5; ++i)
#pragma unroll
                for (int r = 0; r < 16; ++r) mx = fmaxf(mx, p[i][r]);
            mx = half_swap_max(mx);
            float ls = 0.f;
#pragma unroll
            for (int i = 0; i < 5; ++i)
#pragma unroll
                for (int r = 0; r < 16; ++r) { const float e = ex2(p[i][r] - mx); p[i][r] = e; ls += e; }
            ls = half_swap_add(ls) + ex2(sink2 - mx);
            f32x16 o0 = zero16(), o1 = zero16();
#pragma unroll
            for (int i = 0; i < 5; ++i) {
                if (i >= ilo) {
                    const int kt = j + i; const lcp vb = vlane + (kt >> 1) * 8192 + (kt & 1) * 2048;
                    const bf16x8 pa = PACK8(p[i], 0), pb = PACK8(p[i], 1);
                    o0 = MFMA32(pa, trfrag(vb), o0);        o0 = MFMA32(pb, trfrag(vb + 1024), o0);
                    o1 = MFMA32(pa, trfrag(vb + 4096), o1); o1 = MFMA32(pb, trfrag(vb + 4096 + 1024), o1);
                }
            }
            if (hi == 0) wsf[r32] = __builtin_amdgcn_rcpf(ls);
#pragma unroll
            for (int r = 0; r < 16; ++r) {
                const int orow = crow(r, hi); const float rl = wsf[orow] * pg8::F8_SO;
                int pk; asm volatile("" : "=v"(pk)); pk = __builtin_amdgcn_cvt_pk_fp8_f32(o0[r] * rl, o1[r] * rl, pk, false);
                stg[orow * 64 + r32] = (unsigned char)(pk & 0xff);
                stg[orow * 64 + 32 + r32] = (unsigned char)((pk >> 8) & 0xff);
            }
#pragma unroll
            for (int i4 = 0; i4 < 2; ++i4) {
                const int row = i4 * 16 + (lane >> 2), ch = lane & 3;
                const v4u v = *(const LAS v4u*)(stg + row * 64 + ch * 16);
                *(v4u*)(AO8 + (rowq + 32 * j + row) * D + 64 * hq + ch * 16) = v;
            }
        }
        WG_BAR();
    }
}

constexpr int ML_GSET = ML_STG + 4 * 4096 - ML_G2;
static_assert(ML_G2 + ML_GSET + (ML_WS - ML_G2) <= MISC_OFF, "LDS map: second gate-array set");
#define DPPF(old, src, ctrl, rmask, bc) __uint_as_float((unsigned)__builtin_amdgcn_update_dpp((int)__float_as_uint(old), (int)__float_as_uint(src), (ctrl), (rmask), 0xf, (bc)))
DI float scan_add64(float v) {
    v += DPPF(0.f, v, 0x111, 0xf, true); v += DPPF(0.f, v, 0x112, 0xf, true); v += DPPF(0.f, v, 0x114, 0xf, true); v += DPPF(0.f, v, 0x118, 0xf, true);
    v += DPPF(0.f, v, 0x142, 0xa, false); v += DPPF(0.f, v, 0x143, 0xc, false); return v;
}
DI float scan_max64(float v) {
    const float ninf = -INFINITY;
    v = fmaxf(v, DPPF(ninf, v, 0x111, 0xf, false)); v = fmaxf(v, DPPF(ninf, v, 0x112, 0xf, false)); v = fmaxf(v, DPPF(ninf, v, 0x114, 0xf, false)); v = fmaxf(v, DPPF(ninf, v, 0x118, 0xf, false));
    v = fmaxf(v, DPPF(ninf, v, 0x142, 0xa, false)); v = fmaxf(v, DPPF(ninf, v, 0x143, 0xc, false)); return v;
}
DI float ml_gate_scan(LAS unsigned char* lds, int gofs, const float* GT, long row0, int h, int lane, float m_prev) {
    LAS float* G2 = (LAS float*)(lds + ML_G2 + gofs); LAS float* M2 = (LAS float*)(lds + ML_M2 + gofs); LAS float* FI = (LAS float*)(lds + ML_FI + gofs); LAS float* EI = (LAS float*)(lds + ML_EI + gofs);
    LAS float* WK = (LAS float*)(lds + ML_WK + gofs); LAS bf16* WKB = (LAS bf16*)(lds + ML_WKB + gofs); LAS float* SC = (LAS float*)(lds + ML_SC + gofs);
    const float* gp = GT + (size_t)(row0 + 2 * lane) * 8;
    const float i0 = gp[h], f0 = gp[4 + h], i1 = gp[8 + h], f1 = gp[12 + h];
    const float lf0 = -0.6931471805599453f * __builtin_amdgcn_logf(1.f + ex2(-LOG2E * f0)), lf1 = -0.6931471805599453f * __builtin_amdgcn_logf(1.f + ex2(-LOG2E * f1));
    const float incl = scan_add64(lf0 + lf1);
    const float b1 = incl, b0 = incl - lf1;
    const float g0 = i0 - b0, g1 = i1 - b1;
    const float cm = scan_max64(fmaxf(g0, g1));
    const float cprev = DPPF(-INFINITY, cm, 0x138, 0xf, false);
    const float M0 = fmaxf(m_prev, fmaxf(cprev, g0)), M1 = fmaxf(m_prev, cm);
    const float Mend = __uint_as_float((unsigned)__builtin_amdgcn_readlane((int)__float_as_uint(M1), 63)), blast = __uint_as_float((unsigned)__builtin_amdgcn_readlane((int)__float_as_uint(b1), 63));
    *(LAS f32x2*)(G2 + 2 * lane) = (f32x2){g0 * LOG2E, g1 * LOG2E};
    *(LAS f32x2*)(M2 + 2 * lane) = (f32x2){M0 * LOG2E, M1 * LOG2E};
    *(LAS f32x2*)(FI + 2 * lane) = (f32x2){ex2((m_prev - M0) * LOG2E), ex2((m_prev - M1) * LOG2E)};
    *(LAS f32x2*)(EI + 2 * lane) = (f32x2){ex2(-(b0 + M0) * LOG2E), ex2(-(b1 + M1) * LOG2E)};
    const float w0 = ex2((g0 - Mend) * LOG2E), w1 = ex2((g1 - Mend) * LOG2E);
    *(LAS f32x2*)(WK + 2 * lane) = (f32x2){w0, w1};
    *(LAS unsigned*)(WKB + 2 * lane) = pk2(w0, w1);
    if (lane == 0) SC[0] = ex2((m_prev - Mend) * LOG2E);
    return blast + Mend;
}
template <int VAR = 0>
DI void mlstm_phase(unsigned char* ldsg, const bf16* MP, const float* GT, bf16* HG, int ng, int gx, int gy, int Gy, int wave_in) {
    int wid = wave_in; asm volatile("" : "+s"(wid));
    const int lane0 = pg8::pg8_lane(), tid = wid * 64 + lane0;
    LAS unsigned char* lds = (LAS unsigned char*)ldsg; const lcp L = (lcp)lds;
    LAS float* wsf = (LAS float*)(lds + ML_WS) + wid * 64;
    for (int uu = gy; uu < 32 * (BATCH / ng); uu += Gy) { const int b = gx + ng * (uu >> 5), ul = uu & 31;
        const int h = ul >> 3, sl = ul & 7;
        const bf16* Qp = MP + 256 * h; const bf16* Kp = MP + 1024 + 256 * h; const bf16* Vp = MP + 2048 + 512 * h + 64 * sl; const bf16* OGp = MP + 4096 + 512 * h + 64 * sl;
        { unsigned z = 0u; asm volatile("" : "+v"(z)); for (int i = tid; i < (32768 + 512) / 16; i += 512) *(LAS v4u*)(lds + ML_C + i * 16) = (v4u){z, z, z, z}; }
        f32x16 T[6];
#pragma unroll
        for (int x = 0; x < 6; ++x) T[x] = zero16();
        float m_prev = 0.f;
        v4u X[16], vreg[2];
        { const long row0 = (long)b * SEQ; const int lane = lane0, r32 = lane & 31, hi = lane >> 5;
          if (wid >= 4) {
#pragma unroll
              for (int i = 0; i < 16; ++i) X[i] = *(const v4u*)(Kp + (row0 + 8 * i + (lane & 7)) * NMI + (8 * (wid - 4) + (lane >> 3)) * 8);
          } else {
#pragma unroll
              for (int ks = 0; ks < 16; ++ks) X[ks] = *(const v4u*)(Qp + (row0 + 32 * wid + r32) * NMI + 16 * ks + 8 * hi);
          }
#pragma unroll
          for (int i = 0; i < 2; ++i) vreg[i] = *(const v4u*)(Vp + (row0 + 64 * i + 16 * (wid & 3) + (lane >> 2)) * NMI + (wid >> 2) * 32 + (lane & 3) * 8);
          if (wid == 4 && !(VAR & 16)) m_prev = ml_gate_scan(lds, 0, GT, row0, h, lane, m_prev);
        }
        WG_BAR();
        for (int c = 0; c < 16; ++c) {
            const long row0 = (long)b * SEQ + 128 * c;
            const int gofs = (c & 1) * ML_GSET;
            const int lane = pg8::pg8_lane(), r32 = lane & 31, hi = lane >> 5;
            const int blk = (lane >> 4) & 1, q4 = (lane & 15) >> 2, p4 = lane & 3;
            const int vlo_ = blk * 32 + p4 * 8 + (4 * hi + q4) * 64;
            const int ktl_ = (2 * blk + (p4 >> 1)) * 2048 + (q4 + 4 * hi) * 16 + (p4 & 1) * 8;
            const int cbl_ = hi * 1024 + r32 * 16, kbl_ = hi * 2048 + r32 * 16;
            const unsigned m0 = (r32 == 0) ? 0xffffffffu : 0u; const v4u m0v = {m0, m0, m0, m0};
            LAS float* G2 = (LAS float*)(lds + ML_G2 + gofs); LAS float* M2 = (LAS float*)(lds + ML_M2 + gofs); LAS float* FI = (LAS float*)(lds + ML_FI + gofs); LAS float* EI = (LAS float*)(lds + ML_EI + gofs);
            LAS float* WK = (LAS float*)(lds + ML_WK + gofs); LAS bf16* WKB = (LAS bf16*)(lds + ML_WKB + gofs); LAS float* SC = (LAS float*)(lds + ML_SC + gofs);
            VM_WAIT();
            if (wid >= 4) {
#pragma unroll
                for (int i = 0; i < 16; ++i) *(LAS v4u*)(lds + ML_K + (8 * (wid - 4) + (lane >> 3)) * 2048 + (8 * i + (lane & 7)) * 16) = X[i];
            }
#pragma unroll
            for (int i = 0; i < 2; ++i) { const float w = WK[64 * i + 16 * (wid & 3) + (lane >> 2)]; const v4u v = vreg[i]; v4u o;
                o.x = pk2(bflo(v.x) * w, bfhi(v.x) * w); o.y = pk2(bflo(v.y) * w, bfhi(v.y) * w); o.z = pk2(bflo(v.z) * w, bfhi(v.z) * w); o.w = pk2(bflo(v.w) * w, bfhi(v.w) * w);
                *(LAS v4u*)(lds + ML_V + i * 8192 + wid * 1024 + lane * 16) = v;
                *(LAS v4u*)(lds + ML_VW + i * 8192 + wid * 1024 + lane * 16) = o; }
            WG_BAR();
            const bool more = c + 1 < 16;
            if (more && !(VAR & 32)) {
                const long row1 = row0 + 128;
                if (wid >= 4) {
#pragma unroll
                    for (int i = 0; i < 16; ++i) X[i] = *(const v4u*)(Kp + (row1 + 8 * i + (lane & 7)) * NMI + (8 * (wid - 4) + (lane >> 3)) * 8);
                }
#pragma unroll
                for (int i = 0; i < 2; ++i) vreg[i] = *(const v4u*)(Vp + (row1 + 64 * i + 16 * (wid & 3) + (lane >> 2)) * NMI + (wid >> 2) * 32 + (lane & 3) * 8);
            }
            if (wid < 4) {
                const int tt = wid;
                v4u ogv[4];
#pragma unroll
                for (int i4 = 0; i4 < 4; ++i4) ogv[i4] = *(const v4u*)(OGp + (row0 + 32 * tt + i4 * 8 + (lane >> 3)) * NMI + (lane & 7) * 8);
                T[0] = zero16(); T[1] = zero16(); T[2] = zero16();
                if (!(VAR & 4)) { const lcp cb = L + ML_C + cbl_; const lcp nbp = L + ML_N + 16 * hi;
#pragma unroll
                  for (int ks = 0; ks < 16; ++ks) {
                      const bf16x8 c0 = ldfrag(cb + ks * 2048), c1 = ldfrag(cb + ks * 2048 + 512);
                      const bf16x8 nf = __builtin_bit_cast(bf16x8, __builtin_bit_cast(v4u, ldfrag(nbp + ks * 32)) & m0v);
                      T[0] = MFMA32(__builtin_bit_cast(bf16x8, X[ks]), c0, T[0]); T[1] = MFMA32(__builtin_bit_cast(bf16x8, X[ks]), c1, T[1]); T[2] = MFMA32(__builtin_bit_cast(bf16x8, X[ks]), nf, T[2]);
                      if ((ks & 3) == 3) __builtin_amdgcn_sched_barrier(0);
                  } }
                { float fi[16];
#pragma unroll
                  for (int r = 0; r < 16; ++r) fi[r] = FI[32 * tt + crow(r, hi)];
#pragma unroll
                  for (int r = 0; r < 16; ++r) { T[0][r] *= fi[r]; T[1][r] *= fi[r]; }
                  if (r32 == 0) {
#pragma unroll
                      for (int r = 0; r < 16; ++r) wsf[crow(r, hi)] = T[2][r] * fi[r];
                  } }
                const float Mt = M2[32 * tt + r32];
                float dsum = 0.f;
                for (int st = 0; st <= ((VAR & 2) ? -1 : tt); ++st) {
                    f32x16 S = zero16();
                    const lcp kb = L + ML_K + kbl_ + st * 512;
#pragma unroll
                    for (int ks = 0; ks < 16; ++ks) S = MFMA32(ldfrag(kb + ks * 4096), __builtin_bit_cast(bf16x8, X[ks]), S);
#pragma unroll
                    for (int r = 0; r < 16; ++r) {
                        const float w = ex2(G2[32 * st + crow(r, hi)] - Mt);
                        float v = S[r] * w;
                        if (st == tt && crow(r, hi) > r32) v = 0.f;
                        S[r] = v; dsum += v;
                    }
                    const bf16x8 pa = PACK8(S, 0), pb = PACK8(S, 1);
                    const lcp vb = L + ML_V + (st >> 1) * 8192 + (st & 1) * 2048 + vlo_;
                    T[0] = MFMA32(pa, trfrag(vb), T[0]);        T[0] = MFMA32(pb, trfrag(vb + 1024), T[0]);
                    T[1] = MFMA32(pa, trfrag(vb + 4096), T[1]); T[1] = MFMA32(pb, trfrag(vb + 4096 + 1024), T[1]);
                }
                if (more && !(VAR & 64)) {
#pragma unroll
                    for (int ks = 0; ks < 16; ++ks) X[ks] = *(const v4u*)(Qp + (row0 + 128 + 32 * wid + r32) * NMI + 16 * ks + 8 * hi);
                }
                dsum = half_swap_add(dsum);
                { const float den = wsf[r32] + dsum; const float dn = fmaxf(fabsf(den), EI[32 * tt + r32]);
                  if (hi == 0) wsf[32 + r32] = __builtin_amdgcn_rcpf(dn); }
                LAS bf16* stg = (LAS bf16*)(lds + ML_STG + tt * 4096);
                if (!(VAR & 8)) {
#pragma unroll
                for (int r = 0; r < 16; ++r) {
                    const int orow = crow(r, hi); const float rd = wsf[32 + orow];
                    stg[orow * 64 + r32] = (bf16)(pk2(T[0][r] * rd, 0.f) & 0xffffu);
                    stg[orow * 64 + 32 + r32] = (bf16)(pk2(T[1][r] * rd, 0.f) & 0xffffu);
                }
#pragma unroll
                for (int i4 = 0; i4 < 4; ++i4) {
                    const int row = i4 * 8 + (lane >> 3), ch = lane & 7;
                    const v4u hv = *(const LAS v4u*)(stg + row * 64 + ch * 8);
                    const v4u og = ogv[i4];
                    v4u o;
                    o.x = pk2(bflo(hv.x) * bflo(og.x), bfhi(hv.x) * bfhi(og.x)); o.y = pk2(bflo(hv.y) * bflo(og.y), bfhi(hv.y) * bfhi(og.y));
                    o.z = pk2(bflo(hv.z) * bflo(og.z), bfhi(hv.z) * bfhi(og.z)); o.w = pk2(bflo(hv.w) * bflo(og.w), bfhi(hv.w) * bfhi(og.w));
                    *(v4u*)(HG + (row0 + 32 * tt + row) * D + 512 * h + 64 * sl + ch * 8) = o;
                }
                }
#pragma unroll
                for (int x = 3; x < 6; ++x) T[x] = zero16();
            } else {
                const float decay = SC[0];
#pragma unroll
                for (int x = 0; x < 6; ++x)
#pragma unroll
                    for (int r = 0; r < 16; ++r) T[x][r] *= decay;
#pragma unroll
                for (int dti = 0; dti < ((VAR & 1) ? 0 : 2); ++dti) {
                    const int dt = 2 * (wid - 4) + dti;
                    const lcp ka0 = L + ML_K + dt * 8192 + ktl_;
#pragma unroll
                    for (int s8 = 0; s8 < 8; ++s8) {
                        const lcp ka = ka0 + s8 * 256;
                        const bf16x8 af = cat8(vtr(ka), vtr(ka + 128));
                        const lcp vwb = L + ML_VW + (s8 >> 2) * 8192 + (s8 & 3) * 1024 + vlo_;
                        const bf16x8 b0 = trfrag(vwb), b1 = trfrag(vwb + 4096);
                        const LAS s16x4* wp = (const LAS s16x4*)(WKB + 16 * s8 + 4 * hi);
                        const bf16x8 nb = __builtin_bit_cast(bf16x8, __builtin_bit_cast(v4u, cat8(wp[0], wp[2])) & m0v);
                        T[2 * dti] = MFMA32(af, b0, T[2 * dti]); T[2 * dti + 1] = MFMA32(af, b1, T[2 * dti + 1]); T[4 + dti] = MFMA32(af, nb, T[4 + dti]);
                        if (s8 & 1) __builtin_amdgcn_sched_barrier(0);
                    }
                }
                if (more && wid == 4 && !(VAR & 16)) m_prev = ml_gate_scan(lds, ML_GSET - gofs, GT, row0 + 128, h, lane, m_prev);
            }
            asm volatile("s_waitcnt lgkmcnt(0)" ::: "memory"); __builtin_amdgcn_s_barrier(); asm volatile("" ::: "memory");
            if (wid >= 4) {
#pragma unroll
                for (int dti = 0; dti < 2; ++dti) {
                    const int dt = 2 * (wid - 4) + dti;
#pragma unroll
                    for (int et = 0; et < 2; ++et)
#pragma unroll
                        for (int g = 0; g < 4; ++g)
                            *(LAS v2u*)(lds + ML_C + (4 * dt + g) * 1024 + (32 * et + r32) * 16 + hi * 8) = (v2u){pk2(T[2 * dti + et][4 * g], T[2 * dti + et][4 * g + 1]), pk2(T[2 * dti + et][4 * g + 2], T[2 * dti + et][4 * g + 3])};
                    if (r32 == 0) {
#pragma unroll
                        for (int g = 0; g < 4; ++g)
                            *(LAS v2u*)(lds + ML_N + (32 * dt + 8 * g + 4 * hi) * 2) = (v2u){pk2(T[4 + dti][4 * g], T[4 + dti][4 * g + 1]), pk2(T[4 + dti][4 * g + 2], T[4 + dti][4 * g + 3])};
                    }
                }
            }
        }
        WG_BAR();
    }
}


constexpr int NWAVES = 8;

template <bool F8> DI void tr_strip(const float* W, int ldw, int n0, void* WTv, size_t wt_row0, int Kdim, int kb0, int nkb, const float* g, const float* bb, float cs, float* c1o, float* c2o, LAS float* scr, int lane) {
    bf16* WT = (bf16*)WTv; unsigned char* WT8 = (unsigned char*)WTv;
    const int c = lane & 7;
    float a1[4] = {0.f, 0.f, 0.f, 0.f}, a2[4] = {0.f, 0.f, 0.f, 0.f};
    for (int kb = kb0; kb < kb0 + nkb; ++kb) {
        const int k0 = kb * 64;
#pragma unroll 8
        for (int i = 0; i < 32; ++i) { const int kk = 2 * i + (lane >> 5); scr[kk * 33 + (lane & 31)] = W[(size_t)(k0 + kk) * ldw + n0 + (lane & 31)]; }
        float gk[8], bk[8];
        if (g) { const f32x4 g0 = *(const f32x4*)(g + k0 + 8 * c), g1 = *(const f32x4*)(g + k0 + 8 * c + 4), b0 = *(const f32x4*)(bb + k0 + 8 * c), b1 = *(const f32x4*)(bb + k0 + 8 * c + 4);
#pragma unroll
            for (int i = 0; i < 4; ++i) { gk[i] = g0[i] * cs; gk[4 + i] = g1[i] * cs; bk[i] = b0[i] * cs; bk[4 + i] = b1[i] * cs; } }
        else {
#pragma unroll
            for (int i = 0; i < 8; ++i) { gk[i] = cs; bk[i] = 0.f; } }
        LDS_WAIT(); asm volatile("" ::: "memory");
#pragma unroll
        for (int j = 0; j < 4; ++j) { const int n = (lane >> 3) + 8 * j; const LAS float* s = scr + (8 * c) * 33 + n;
            float v[8];
#pragma unroll
            for (int i = 0; i < 8; ++i) v[i] = s[i * 33];
            a2[j] += ((v[0] * bk[0] + v[1] * bk[1]) + (v[2] * bk[2] + v[3] * bk[3])) + ((v[4] * bk[4] + v[5] * bk[5]) + (v[6] * bk[6] + v[7] * bk[7]));
            if constexpr (F8) {
                float wv[8];
#pragma unroll
                for (int i = 0; i < 8; ++i) wv[i] = v[i] * gk[i];
                const v2u o = pg8::cvt8_f8(wv, pg8::F8_SW);
                a1[j] += ((__builtin_amdgcn_cvt_f32_fp8((int)o.x, 0) + __builtin_amdgcn_cvt_f32_fp8((int)o.x, 1)) + (__builtin_amdgcn_cvt_f32_fp8((int)o.x, 2) + __builtin_amdgcn_cvt_f32_fp8((int)o.x, 3)))
                       + ((__builtin_amdgcn_cvt_f32_fp8((int)o.y, 0) + __builtin_amdgcn_cvt_f32_fp8((int)o.y, 1)) + (__builtin_amdgcn_cvt_f32_fp8((int)o.y, 2) + __builtin_amdgcn_cvt_f32_fp8((int)o.y, 3)));
                *(GAS v2u*)(WT8 + (wt_row0 + n) * Kdim + k0 + 8 * c) = o;
            } else {
                v4u o; o.x = pk2(v[0] * gk[0], v[1] * gk[1]); o.y = pk2(v[2] * gk[2], v[3] * gk[3]); o.z = pk2(v[4] * gk[4], v[5] * gk[5]); o.w = pk2(v[6] * gk[6], v[7] * gk[7]);
                a1[j] += ((bflo(o.x) + bfhi(o.x)) + (bflo(o.y) + bfhi(o.y))) + ((bflo(o.z) + bfhi(o.z)) + (bflo(o.w) + bfhi(o.w)));
                *(GAS v4u*)(WT + (wt_row0 + n) * Kdim + k0 + 8 * c) = o;
            } }
        LDS_WAIT(); asm volatile("" ::: "memory");
    }
    if (g) {
#pragma unroll
        for (int j = 0; j < 4; ++j) { float s1 = a1[j], s2 = a2[j];
            s1 += SWZ_XOR(s1, 1); s2 += SWZ_XOR(s2, 1); s1 += SWZ_XOR(s1, 2); s2 += SWZ_XOR(s2, 2); s1 += SWZ_XOR(s1, 4); s2 += SWZ_XOR(s2, 4);
            if (c == 0) { c1o[(lane >> 3) + 8 * j] = F8 ? s1 * (1.f / pg8::F8_SW) : s1; c2o[(lane >> 3) + 8 * j] = s2; } }
    }
}

DI void prologue(kargs_t a, LAS unsigned char* lds, int gw, int NGW, int wave, int lane) {
    unsigned char* ws = a->ws;
    float* vec = (float*)(ws + WS_VEC);
    const float* ones = (const float*)(ws + WS_VEC + V_ONES); const float* zeros = (const float*)(ws + WS_VEC + V_ZEROS);
    LAS float* scr = (LAS float*)(lds + wave * 16384);
    constexpr int T_UP = 8 * 2 * 176, T_QKV = 2 * 80, T_MI = 2 * 192, T_W2 = 8 * 64 * 4, T_WO = 2 * 64, T_WMO = 2 * 64, T_G = 16;
    constexpr int NT = T_UP + T_QKV + T_MI + T_W2 + T_WO + T_WMO + T_G;
    for (int it = gw; it < NT; it += NGW) {
        int r = it;
        if (r < T_UP) {
            const int f = r / 352, rr = r % 352, which = rr / 176, strip = rr % 176, n0 = 32 * strip;
            const int t = 3 * (f >> 1) + 2 * (f & 1);
            const float* gp = t ? a->ln_g + (size_t)(t - 1) * D : nullptr; const float* bp = t ? a->ln_b + (size_t)(t - 1) * D : nullptr;
            const size_t wrow = (size_t)256 * (n0 / 128) + 128 * which + (n0 % 128);
            const float* W = (which ? a->w3 : a->w1) + (size_t)f * D * FF;
            if (gp) tr_strip<true>(W, FF, n0, ws + WS_W13 + (size_t)f * NUP * D, wrow, D, 0, 32, gp, bp, 1.f, vec + V_C1U / 4 + (size_t)f * NUP + wrow, vec + V_C2U / 4 + (size_t)f * NUP + wrow, scr, lane);
            else { tr_strip<true>(W, FF, n0, ws + WS_W13 + (size_t)f * NUP * D, wrow, D, 0, 32, nullptr, nullptr, 1.f, nullptr, nullptr, scr, lane);
                   if (lane < 32) { vec[V_C1U / 4 + (size_t)f * NUP + wrow + lane] = 0.f; vec[V_C2U / 4 + (size_t)f * NUP + wrow + lane] = 0.f; } }
            continue; }
        r -= T_UP;
        if (r < T_QKV) { const int j = r / 80, n0 = 32 * (r % 80); const int t = 6 * j + 1;
            tr_strip<true>(a->wqkv + (size_t)j * D * NQKV, NQKV, n0, ws + WS_WQKV + (size_t)j * NQKV * D, n0, D, 0, 32, a->ln_g + (size_t)(t - 1) * D, a->ln_b + (size_t)(t - 1) * D, n0 < 2048 ? 0.125f : 1.f,
                     vec + V_C1Q / 4 + j * NQKV + n0, vec + V_C2Q / 4 + j * NQKV + n0, scr, lane);
            continue; }
        r -= T_QKV;
        if (r < T_MI) { const int j = r / 192, n0 = 32 * (r % 192); const int t = 6 * j + 4;
            if (true) tr_strip<false>(a->win + (size_t)j * D * NMIW, NMIW, n0, (bf16*)(ws + WS_WIN) + (size_t)j * NMI * D, n0, D, 0, 32, a->ln_g + (size_t)(t - 1) * D, a->ln_b + (size_t)(t - 1) * D, (n0 >= 1024 && n0 < 2048) ? 0.0625f : 1.f,
                     vec + V_C1I / 4 + j * NMI + n0, vec + V_C2I / 4 + j * NMI + n0, scr, lane);
            else tr_strip<true>(a->win + (size_t)j * D * NMIW, NMIW, n0, ws + WS_WIN + 32 * MiB + (size_t)j * 2048 * D, n0 - 4096, D, 0, 32, a->ln_g + (size_t)(t - 1) * D, a->ln_b + (size_t)(t - 1) * D, 1.f,
                     vec + V_C1I / 4 + j * NMI + n0, vec + V_C2I / 4 + j * NMI + n0, scr, lane);
            continue; }
        r -= T_MI;
        if (r < T_W2) { const int f = r / 256, rr = r % 256, strip = rr / 4, kq = rr % 4;
            tr_strip<true>(a->w2 + (size_t)f * FF * D, D, 32 * strip, ws + WS_W2 + (size_t)f * D * FF, 32 * strip, FF, 22 * kq, 22, nullptr, nullptr, 1.f, nullptr, nullptr, scr, lane);
            continue; }
        r -= T_W2;
        if (r < T_WO) { const int j = r / 64, strip = r % 64;
            tr_strip<true>(a->wo + (size_t)j * D * D, D, 32 * strip, ws + WS_WO + (size_t)j * D * D, 32 * strip, D, 0, 32, nullptr, nullptr, 1.f, nullptr, nullptr, scr, lane);
            continue; }
        r -= T_WO;
        if (r < T_WMO) { const int j = r / 64, strip = r % 64;
            tr_strip<false>(a->wmo + (size_t)j * D * D, D, 32 * strip, (bf16*)(ws + WS_WMO) + (size_t)j * D * D, 32 * strip, D, 0, 32, nullptr, nullptr, 1.f, nullptr, nullptr, scr, lane);
            continue; }
        r -= T_WMO;
        {
            const int j = r / 8, jj = r % 8; const int t = 6 * j + 4;
            const float* gp = a->ln_g + (size_t)(t - 1) * D; const float* bp = a->ln_b + (size_t)(t - 1) * D;
            const float* W = a->win + (size_t)j * D * NMIW + NMI + jj;
            bf16* wg16 = (bf16*)(vec + V_WG / 4) + (size_t)(j * 8 + jj) * D;
            float s1 = 0.f, s2 = 0.f;
            for (int k = lane; k < D; k += 64) { const float w = W[(size_t)k * NMIW]; const unsigned hv = pk2(w * gp[k], 0.f) & 0xffffu; wg16[k] = (bf16)hv; s1 += bflo(hv); s2 += w * bp[k]; }
            s1 = wave_sum(s1); s2 = wave_sum(s2);
            if (lane == 0) { vec[V_CG / 4 + j * 16 + jj] = s1; vec[V_CG / 4 + j * 16 + 8 + jj] = s2 + a->bg[j * 8 + jj]; }
        }
    }
    bf16* R = (bf16*)(ws + WS_R); float* sp0 = (float*)(ws + WS_SP);
    for (int m = gw; m < M; m += NGW) {
        const GAS f32x4* xr = (const GAS f32x4*)(a->x + (size_t)m * D);
#pragma unroll
        for (int i = 0; i < 4; ++i) { const f32x4 v0 = xr[(i * 64 + lane) * 2], v1 = xr[(i * 64 + lane) * 2 + 1];
            *(GAS v4u*)(R + (size_t)m * D + (i * 64 + lane) * 8) = (v4u){pk2(v0[0], v0[1]), pk2(v0[2], v0[3]), pk2(v1[0], v1[1]), pk2(v1[2], v1[3])};
            { const float xv[8] = {v0[0], v0[1], v0[2], v0[3], v1[0], v1[1], v1[2], v1[3]}; *(GAS v2u*)(ws + WS_R8 + (size_t)m * D + (i * 64 + lane) * 8) = pg8::cvt8_f8(xv, pg8::F8_SR); } }
        if (lane < 8) *(f32x2*)(sp0 + (size_t)m * 16 + lane * 2) = (f32x2){0.f, 256.f * (1.f - LN_EPS)};
    }
    for (int i = gw * 64 + lane; i < D; i += NGW * 64) { vec[V_ONES / 4 + i] = 1.f; vec[V_ZEROS / 4 + i] = 0.f; }
    (void)ones; (void)zeros;
}

DI void gates_phase(LAS unsigned char* lds, const bf16* R, const float* sp, const bf16* wg16, const float* cg, float* GT, int ng, int gx, int gy, int Gy, int wave_in) {
    int wave = wave_in; asm volatile("" : "+s"(wave));
    const int lane = pg8::pg8_lane(), tid = wave * 64 + lane, r32 = lane & 31, hi = lane >> 5;
    LAS float* part = (LAS float*)lds;
    const unsigned mk = (r32 < 8) ? 0xffffffffu : 0u; const v4u mkv = {mk, mk, mk, mk};
    for (int uu = gy; uu < (SEQ / 64) * (BATCH / ng); uu += Gy) { const int b = gx + ng * (uu >> 5), pl = uu & 31;
        const long r0 = (long)b * SEQ + (long)pl * 64;
        const bf16* bsrc = wg16 + (size_t)(r32 & 7) * D + 256 * wave + 8 * hi;
        bf16x8 bfr[16];
#pragma unroll
        for (int ks = 0; ks < 16; ++ks) bfr[ks] = __builtin_bit_cast(bf16x8, *(const v4u*)(bsrc + 16 * ks) & mkv);
#pragma unroll
        for (int rt = 0; rt < 2; ++rt) {
            const bf16* asrc = R + (r0 + 32 * rt + r32) * D + 256 * wave + 8 * hi;
            bf16x8 afr[16];
#pragma unroll
            for (int ks = 0; ks < 16; ++ks) afr[ks] = *(const bf16x8*)(asrc + 16 * ks);
            f32x16 acc = zero16();
#pragma unroll
            for (int ks = 0; ks < 16; ++ks) acc = MFMA32(afr[ks], bfr[ks], acc);
            if (r32 < 8) {
#pragma unroll
                for (int r = 0; r < 16; ++r) part[(wave * 64 + 32 * rt + crow(r, hi)) * 8 + r32] = acc[r];
            }
        }
        WG_BAR();
        {
            const int row = tid >> 3, col = tid & 7;
            float s = 0.f;
#pragma unroll
            for (int w = 0; w < 8; ++w) s += part[(w * 64 + row) * 8 + col];
            const f32x4* spr = (const f32x4*)(sp + (size_t)(r0 + row) * 16);
            const f32x4 v0 = spr[0], v1 = spr[1], v2 = spr[2], v3 = spr[3];
            const float ss = ((v0[0] + v0[2]) + (v1[0] + v1[2])) + ((v2[0] + v2[2]) + (v3[0] + v3[2])), qq = ((v0[1] + v0[3]) + (v1[1] + v1[3])) + ((v2[1] + v2[3]) + (v3[1] + v3[3]));
            const float mean = ss * (1.f / D), var = qq * (1.f / D) - mean * mean, rstd = __builtin_amdgcn_rsqf(var + LN_EPS);
            GT[(size_t)(r0 + row) * 8 + col] = rstd * (s - mean * cg[col]) + cg[8 + col];
        }
        WG_BAR();
    }
}

DI void final_ln(const bf16* R, const float* sp, const float* g, const float* b, float* out, int ng, int gx, int gw, int NGW, int lane) {
    for (int bb = gx; bb < BATCH; bb += ng) for (int m = bb * SEQ + gw; m < (bb + 1) * SEQ; m += NGW) {
        float s, q;
        { const f32x4 v = *(const f32x4*)(sp + (size_t)m * 16 + (lane & 3) * 4); s = v[0] + v[2]; q = v[1] + v[3];
          s += SWZ_XOR(s, 1); q += SWZ_XOR(q, 1); s += SWZ_XOR(s, 2); q += SWZ_XOR(q, 2); }
        const float mean = s * (1.f / D), var = q * (1.f / D) - mean * mean, rstd = __builtin_amdgcn_rsqf(var + LN_EPS);
#pragma unroll
        for (int i = 0; i < 4; ++i) {
            const int k = 8 * lane + 512 * i;
            const v4u rv = *(const v4u*)(R + (size_t)m * D + k);
            const f32x4 g0 = *(const f32x4*)(g + k), g1 = *(const f32x4*)(g + k + 4), b0 = *(const f32x4*)(b + k), b1 = *(const f32x4*)(b + k + 4);
            f32x4 o0, o1;
            o0[0] = (bflo(rv.x) - mean) * rstd * g0[0] + b0[0]; o0[1] = (bfhi(rv.x) - mean) * rstd * g0[1] + b0[1]; o0[2] = (bflo(rv.y) - mean) * rstd * g0[2] + b0[2]; o0[3] = (bfhi(rv.y) - mean) * rstd * g0[3] + b0[3];
            o1[0] = (bflo(rv.z) - mean) * rstd * g1[0] + b1[0]; o1[1] = (bfhi(rv.z) - mean) * rstd * g1[1] + b1[1]; o1[2] = (bflo(rv.w) - mean) * rstd * g1[2] + b1[2]; o1[3] = (bfhi(rv.w) - mean) * rstd * g1[3] + b1[3];
            *(GAS f32x4*)(out + (size_t)m * D + k) = o0; *(GAS f32x4*)(out + (size_t)m * D + k + 4) = o1;
        }
    }
}

#ifndef PROBE_DUP
#define PROBE_DUP 0
#endif
#ifndef PROBE_DRY
#define PROBE_DRY 1
#endif
#ifndef PROBE_MLV
#define PROBE_MLV 0
#endif
#ifndef SKIP_ATT
#define SKIP_ATT 0
#endif
#ifndef SKIP_MLSTM
#define SKIP_MLSTM 0
#endif

#define GRID_BAR1() do { XcdBarrier b_; b_.bar = (unsigned*)(kargs()->ws + WS_CTL) + CW_BAR; b_.x = xb_xcc_id(); b_.st = (volatile LAS unsigned*)(lds + MISC_OFF) + 8; b_.total = gridDim.x; xcd_barrier(b_); } while (0)
#define GRID_BAR() do { GRID_BAR1(); if (PROBE_DUP & 1024) GRID_BAR1(); } while (0)
#define GROUP_BAR1() do { XcdBarrier b_; b_.bar = (unsigned*)(kargs()->ws + WS_CTL) + CW_BAR + (1 + (bid & 7)) * XCD_BAR_WORDS; b_.x = xb_xcc_id(); b_.st = (volatile LAS unsigned*)(lds + MISC_OFF) + 10; b_.total = gridDim.x / 8; xcd_barrier(b_); } while (0)
#define LAYER_BAR() do { if (grouped) { GROUP_BAR1(); if (PROBE_DUP & 1024) GROUP_BAR1(); } else GRID_BAR(); } while (0)

__global__ void __launch_bounds__(NWAVES * 64, 2) fwd_kernel(Args args_by_value) {
    extern __shared__ __attribute__((aligned(16))) unsigned char lds_raw[];
    LAS unsigned char* lds = (LAS unsigned char*)lds_raw;
    const int w0 = __builtin_amdgcn_readfirstlane((int)threadIdx.x >> 6);
    const int G0 = gridDim.x, bid0 = blockIdx.x; const int G = G0, bid = bid0;
    { const int tid0 = threadIdx.x; if (tid0 < 64) ((volatile LAS unsigned*)(lds + MISC_OFF))[tid0] = 0u; }
    __syncthreads();
    (void)xcd_barrier_post((unsigned*)(kargs()->ws + WS_CTL) + CW_BAR, (volatile LAS unsigned*)(lds + MISC_OFF) + 8);
#ifndef FORCE_UNGROUPED
#define FORCE_UNGROUPED 0
#endif
    const bool grouped = (G0 == 256) && !FORCE_UNGROUPED;
    if (grouped) (void)xcd_barrier_post((unsigned*)(kargs()->ws + WS_CTL) + CW_BAR + (1 + (bid0 & 7)) * XCD_BAR_WORDS, (volatile LAS unsigned*)(lds + MISC_OFF) + 10);
    {
        const int vcu = (G % 8 == 0) ? (bid % 8) * (G / 8) + bid / 8 : bid;
        prologue(kargs(), lds, vcu * NWAVES + w0, G * NWAVES, w0, pg8::pg8_lane());
        if (PROBE_DUP & 1) { WG_BAR(); prologue(kargs(), lds, vcu * NWAVES + w0, G * NWAVES, w0, pg8::pg8_lane()); }
    }
    GRID_BAR();
#ifndef GROUP_STAGGER_TICKS
#define GROUP_STAGGER_TICKS 0
#endif
    if (grouped && (bid0 & 1) && GROUP_STAGGER_TICKS > 0) { const unsigned long long t0 = __builtin_amdgcn_s_memrealtime(); while (__builtin_amdgcn_s_memrealtime() - t0 < (unsigned long long)GROUP_STAGGER_TICKS) __builtin_amdgcn_s_sleep(8); }

    for (int t = 0; t < 3 * DEPTH; ++t) {
        int G = G0, bid = bid0; asm volatile("" : "+s"(G), "+s"(bid));
        const int ng = grouped ? 8 : 1, gx = bid % ng, gy = bid / ng, Gy = G / ng;
        const int layer = t / 3, sub = t % 3;
        const int kind = (sub != 1) ? 0 : ((layer & 1) ? 2 : 1);
        const int j = layer >> 1;
        {
            unsigned char* ws = kargs()->ws;
            float* vec = (float*)(ws + WS_VEC);
            const bf16* R = (const bf16*)(ws + WS_R);
            const float* sp_in = (const float*)(ws + WS_SP) + (size_t)(t & 1) * (SP_BYTES / 4);
            if (kind == 0) {
                const int f = 2 * layer + (sub >> 1);
                pg8::Gemm g{(const bf16*)(ws + WS_R8), (const bf16*)(ws + WS_W13 + (size_t)f * NUP * D), M, NUP, D / 2}; pg8::StaticOrder S; S.init(M, NUP, G, bid);
                pg8::EpiUp E{f, t & 1};
                if (PROBE_DUP & 2048) { S.r1 = 5; pg8::gemm_phase<pg8::EpiUp, pg8::StaticOrder, true, PG8_SP2, true>(lds + RING_OFF, g, S, E, w0); LAYER_BAR(); S.r0 = 5; S.r1 = 1 << 20; }
                pg8::gemm_phase<pg8::EpiUp, pg8::StaticOrder, true, PG8_SP2, true>(lds + RING_OFF, g, S, E, w0);
                if (PROBE_DUP & 16) pg8::gemm_phase<pg8::EpiUp, pg8::StaticOrder, true, PG8_SP2, true>(lds + RING_OFF, g, S, E, w0);
                if (PROBE_DUP & 128) { pg8::EpiNull EN{(float*)(ws + WS_GATES)}; pg8::gemm_phase<pg8::EpiNull, pg8::StaticOrder, true, PG8_SP2, true>(lds + RING_OFF, g, S, EN, w0); }
            } else {
                if (kind == 2) {
                    pg8::Gemm g{R, (const bf16*)(ws + WS_WIN) + (size_t)j * NMI * D, M, NMI, D}; pg8::StaticOrder S; S.init(M, NMI, G, bid);
                    pg8::EpiLnOut E{1, j, t & 1};
                    pg8::gemm_phase<pg8::EpiLnOut, pg8::StaticOrder, true, PG8_SP2>(lds + RING_OFF, g, S, E, w0);
                    if (PROBE_DUP & 32) pg8::gemm_phase<pg8::EpiLnOut, pg8::StaticOrder, true, PG8_SP2>(lds + RING_OFF, g, S, E, w0);
                }
                if (kind == 1) {
                    const int N = kind == 1 ? NQKV : 2048;
                    pg8::Gemm g{(const bf16*)(ws + WS_R8), (const bf16*)(kind == 1 ? ws + WS_WQKV + (size_t)j * NQKV * D : ws + WS_WIN + 32 * MiB + (size_t)j * 2048 * D), M, N, D / 2}; pg8::StaticOrder S; S.init(M, N, G, bid);
                    pg8::EpiLnOut E{kind == 1 ? 0 : 2, j, t & 1};
                    pg8::gemm_phase<pg8::EpiLnOut, pg8::StaticOrder, true, PG8_SP2, true>(lds + RING_OFF, g, S, E, w0);
                    if (PROBE_DUP & 32) pg8::gemm_phase<pg8::EpiLnOut, pg8::StaticOrder, true, PG8_SP2, true>(lds + RING_OFF, g, S, E, w0);
                }
                if (kind == 2) {
                    gates_phase(lds, R, sp_in, (const bf16*)(vec + V_WG / 4) + (size_t)j * 8 * D, vec + V_CG / 4 + j * 16, (float*)(ws + WS_GATES), ng, gx, gy, Gy, w0);
                    if (PROBE_DUP & 8) { WG_BAR(); gates_phase(lds, R, sp_in, (const bf16*)(vec + V_WG / 4) + (size_t)j * 8 * D, vec + V_CG / 4 + j * 16, (float*)(ws + WS_GATES), ng, gx, gy, Gy, w0); }
                }
            }
        }
        LAYER_BAR();
        if (kind == 1) {
            if (!SKIP_ATT) { kargs_t ka = kargs(); unsigned char* ws = ka->ws; attn_phase(lds_raw, (const bf16*)(ws + WS_QKV), ws + WS_AO, ka->sinks + j * 32, ng, gx, gy, Gy, w0);
                if (PROBE_DUP & 2) attn_phase(lds_raw, (const bf16*)(ws + WS_QKV), ws + WS_AO, ka->sinks + j * 32, ng, gx, gy, Gy, w0); }
            LAYER_BAR();
        } else if (kind == 2) {
            if (!SKIP_MLSTM) { unsigned char* ws = kargs()->ws; mlstm_phase(lds_raw, (const bf16*)(ws + WS_MP), (const float*)(ws + WS_GATES), (bf16*)(ws + WS_HG), ng, gx, gy, Gy, w0);
                if (PROBE_DUP & 4) mlstm_phase<PROBE_MLV>(lds_raw, (const bf16*)(ws + WS_MP), (const float*)(ws + WS_GATES), (bf16*)(ws + WS_H), ng, gx, gy, Gy, w0); }
            LAYER_BAR();
        }
        {
            kargs_t ka = kargs(); unsigned char* ws = ka->ws;
            float coef = kind == 0 ? 0.5f / (pg8::F8_SH * pg8::F8_SW) : (kind == 1 ? 1.f / (pg8::F8_SO * pg8::F8_SW) : 1.f);
            if ((kind == 1 && SKIP_ATT) || (kind == 2 && SKIP_MLSTM)) coef = 0.f;
            pg8::StaticOrder S; S.init(M, D, G, bid);
            pg8::EpiRes E{t, coef, (LAS float*)(lds + TAB_OFF), w0, 0};
            if (kind != 2) {
                const int f = 2 * layer + (sub >> 1);
                pg8::Gemm g{(const bf16*)(ws + (kind == 0 ? WS_H : WS_AO)), (const bf16*)(kind == 0 ? ws + WS_W2 + (size_t)f * D * FF : ws + WS_WO + (size_t)j * D * D), M, D, kind == 0 ? FF / 2 : D / 2};
                if (PROBE_DUP & 64) { pg8::EpiNull EN{(float*)(ws + WS_GATES)}; pg8::gemm_phase<pg8::EpiNull, pg8::StaticOrder, true, PG8_SP2, true>(lds + RING_OFF, g, S, EN, w0); }
                if (PROBE_DUP & 512) { pg8::EpiRes ED{t, coef, (LAS float*)(lds + TAB_OFF), w0, PROBE_DRY}; pg8::gemm_phase<pg8::EpiRes, pg8::StaticOrder, true, PG8_SP2, true>(lds + RING_OFF, g, S, ED, w0); }
                pg8::gemm_phase<pg8::EpiRes, pg8::StaticOrder, true, PG8_SP2, true>(lds + RING_OFF, g, S, E, w0);
            } else {
                pg8::Gemm g{(const bf16*)(ws + WS_HG), (const bf16*)(ws + WS_WMO) + (size_t)j * D * D, M, D, D};
                if (PROBE_DUP & 256) { pg8::EpiNull EN{(float*)(ws + WS_GATES)}; pg8::gemm_phase<pg8::EpiNull, pg8::StaticOrder, true, PG8_SP2, false>(lds + RING_OFF, g, S, EN, w0); }
                pg8::gemm_phase<pg8::EpiRes, pg8::StaticOrder, true, PG8_SP2, false>(lds + RING_OFF, g, S, E, w0);
            }
        }
        LAYER_BAR();
    }
    {
        kargs_t ka = kargs(); unsigned char* ws = ka->ws;
        const int ng = grouped ? 8 : 1, gx = bid % ng, gy = bid / ng, Gy = G / ng;
        final_ln((const bf16*)(ws + WS_R), (const float*)(ws + WS_SP), ka->ln_g + (size_t)(3 * DEPTH - 1) * D, ka->ln_b + (size_t)(3 * DEPTH - 1) * D, ka->out, ng, gx, gy * NWAVES + w0, Gy * NWAVES, pg8::pg8_lane());
    }
}

extern "C" void kernel_launch(void* const* d_in, const int* in_sizes, int n_in, void* d_out, int out_size, void* d_ws, size_t ws_size, hipStream_t stream) {
    static int grid = 0;
    if (grid == 0) {
        if (n_in != 12 || in_sizes[0] != M * D || out_size != M * D || ws_size < WS_END) { fprintf(stderr, "kernel_launch: unexpected shapes / workspace (n_in %d, ws %zu < %zu); nothing launched\n", n_in, ws_size, (size_t)WS_END); grid = -1; return; }
        int dev = 0, cus = 0;
        if (hipGetDevice(&dev) != hipSuccess || hipDeviceGetAttribute(&cus, hipDeviceAttributeMultiprocessorCount, dev) != hipSuccess) { grid = -1; return; }
        if (hipFuncSetAttribute((const void*)fwd_kernel, hipFuncAttributeMaxDynamicSharedMemorySize, LDS_BYTES) != hipSuccess) { fprintf(stderr, "kernel_launch: hipFuncSetAttribute failed\n"); grid = -1; return; }
        int per_cu = 0;
        if (hipOccupancyMaxActiveBlocksPerMultiprocessor(&per_cu, (const void*)fwd_kernel, NWAVES * 64, LDS_BYTES) != hipSuccess || per_cu < 1) { fprintf(stderr, "kernel_launch: occupancy query says %d\n", per_cu); }
        (void)hipGetLastError();
        grid = cus;
#ifdef FORCE_GRID
        grid = FORCE_GRID;
#endif
    }
    if (grid < 0) return;
    (void)hipMemsetAsync((char*)d_ws + WS_CTL, 0, CTL_ZERO_BYTES, stream);
    Args a{};
    a.x = (const float*)d_in[0]; a.w1 = (const float*)d_in[1]; a.w3 = (const float*)d_in[2]; a.w2 = (const float*)d_in[3]; a.ln_g = (const float*)d_in[4]; a.ln_b = (const float*)d_in[5];
    a.wqkv = (const float*)d_in[6]; a.sinks = (const float*)d_in[7]; a.wo = (const float*)d_in[8]; a.win = (const float*)d_in[9]; a.bg = (const float*)d_in[10]; a.wmo = (const float*)d_in[11];
    a.out = (float*)d_out; a.ws = (unsigned char*)d_ws;
    hipLaunchKernelGGL(fwd_kernel, dim3(grid), dim3(NWAVES * 64), LDS_BYTES, stream, a);
}
```

```cpp
#include <hip/hip_runtime.h>
#include <hip/hip_bf16.h>
#include <cstdio>
#include <cstdint>
#include <cmath>

constexpr int BATCH = 8, SEQ = 2048, D = 2048, FF = 5632, DEPTH = 4;
constexpr int M = BATCH * SEQ;
constexpr int NUP = 2 * FF;
constexpr int NQKV = 2560;
constexpr int NMI = 6144, NMIW = 6152;
constexpr float LN_EPS = 1e-5f;
constexpr float ALPHA = 1.681792830507429f;
constexpr float LOG2E = 1.4426950408889634f;

constexpr size_t MiB = 1u << 20;
constexpr size_t WS_CTL = 0, CTL_ZERO_BYTES = 192 * 1024;
constexpr size_t WS_W13 = 2 * MiB;
constexpr size_t WS_W2 = 178 * MiB;
constexpr size_t WS_WQKV = 266 * MiB;
constexpr size_t WS_WO = 286 * MiB;
constexpr size_t WS_WIN = 302 * MiB;
constexpr size_t WS_WMO = 350 * MiB;
constexpr size_t WS_VEC = 366 * MiB;
constexpr size_t V_C1U = 0, V_C2U = 360448, V_C1Q = 720896, V_C2Q = 741376, V_C1I = 761856, V_C2I = 811008, V_CG = 860160, V_WG = 860416, V_ONES = 991488, V_ZEROS = 999680;
constexpr size_t WS_R = 368 * MiB;
constexpr size_t WS_R8 = 432 * MiB;
constexpr size_t WS_SP = 464 * MiB;
constexpr size_t SP_BYTES = (size_t)M * 16 * 4;
constexpr size_t WS_H = 466 * MiB;
constexpr size_t WS_QKV = 554 * MiB;
constexpr size_t WS_AO = 634 * MiB;
constexpr size_t WS_MP = 698 * MiB;
constexpr size_t WS_GATES = 890 * MiB;
constexpr size_t WS_HG = 891 * MiB;
constexpr size_t WS_END = 955 * MiB;
constexpr int CW_TMO = 0, CW_BAR = 4096;

struct Args { const float* x; const float* w1; const float* w3; const float* w2; const float* ln_g; const float* ln_b; const float* wqkv; const float* sinks; const float* wo;
              const float* win; const float* bg; const float* wmo; float* out; unsigned char* ws; };
typedef const __attribute__((address_space(4))) Args* kargs_t;
__device__ __forceinline__ kargs_t kargs() { kargs_t p = (kargs_t)__builtin_amdgcn_kernarg_segment_ptr(); asm volatile("" : "+s"(p)); return p; }

namespace pg8 {
#define PG8_LAS __attribute__((address_space(3)))
typedef unsigned short bf16_t;
typedef short bf16x8 __attribute__((ext_vector_type(8)));
typedef _Float16 f16x8 __attribute__((ext_vector_type(8)));
typedef float f32x4 __attribute__((ext_vector_type(4)));
typedef unsigned u32x4 __attribute__((ext_vector_type(4)));
constexpr int BM = 256, BK = 64, HALF = 128, HTB = HALF * BK * 2  , STAGE_BYTES = 8 * HTB, NXCD = 8, WGM = 8;

__host__ __device__ __forceinline__ int lds_byte(int r, int c) { const int st = (r >> 4) * 2 + (c >> 5), rr = r & 15, cc = c & 31, ob = rr * 64 + cc * 2; return st * 1024 + (ob ^ (((ob >> 9) & 1) << 5)); }
__host__ __device__ __forceinline__ void stage_rc(int b, int& R, int& C) { const int st = b / 1024, sb = b % 1024, swz = sb ^ (((sb >> 9) & 1) << 5); R = (st >> 1) * 16 + swz / 64; C = (st & 1) * 32 + (swz % 64) / 2; }
__host__ __device__ __forceinline__ int perm32(int rho) { const int n = rho >> 4, i = rho & 15; return 8 * (i >> 2) + 4 * n + (i & 3); }

typedef int i32x4 __attribute__((ext_vector_type(4)));
typedef int i32x8 __attribute__((ext_vector_type(8)));
constexpr float F8_SR = 8.f, F8_SW = 1024.f, F8_SH = 16.f, F8_SO = 64.f;
__device__ __forceinline__ i32x8 cat_i8(bf16x8 lo, bf16x8 hi) { const i32x4 a = __builtin_bit_cast(i32x4, lo), b = __builtin_bit_cast(i32x4, hi); return __builtin_shufflevector(a, b, 0, 1, 2, 3, 4, 5, 6, 7); }
__device__ __forceinline__ void mfma_f8_inplace(f32x4& c, const i32x8 a, const i32x8 b) { asm volatile("v_mfma_f32_16x16x128_f8f6f4 %0, %1, %2, %0 cbsz:0 blgp:0" : "+v"(c) : "v"(a), "v"(b)); }
typedef unsigned u32x2 __attribute__((ext_vector_type(2)));
__device__ __forceinline__ u32x2 cvt8_f8(const float (&v)[8], float s) {
    int a, b; asm volatile("" : "=v"(a), "=v"(b));
    a = __builtin_amdgcn_cvt_pk_fp8_f32(v[0] * s, v[1] * s, a, false); a = __builtin_amdgcn_cvt_pk_fp8_f32(v[2] * s, v[3] * s, a, true);
    b = __builtin_amdgcn_cvt_pk_fp8_f32(v[4] * s, v[5] * s, b, false); b = __builtin_amdgcn_cvt_pk_fp8_f32(v[6] * s, v[7] * s, b, true);
    return (u32x2){(unsigned)a, (unsigned)b};
}
__device__ __forceinline__ int pg8_lane() { int l; asm volatile("v_mbcnt_lo_u32_b32 %0, -1, 0\n\tv_mbcnt_hi_u32_b32 %0, -1, %0" : "=v"(l)); return l; }
struct Unit { int pm, pn, ord; };
struct Gemm { const bf16_t* A; const bf16_t* Bt; int M, N, K; };

struct StaticOrder {
    int nM, nN, nwg, G, c, r0 = 0, r1 = 1 << 20;
    __host__ __device__ void init(int M_, int N_, int G_, int c_) { nM = M_ / BM; nN = N_ / BM; nwg = nM * nN; G = G_; c = c_; }
    __host__ __device__ bool next(int i, Unit& u) const {
        i += r0; if (i >= r1) return false;
        const long L = (long)i * G + c; if (L >= nwg) return false;
        int wgid = (int)L; { const int q = nwg / NXCD, r = nwg % NXCD, xcd = wgid % NXCD, off = wgid / NXCD; wgid = (xcd < r ? xcd * (q + 1) : r * (q + 1) + (xcd - r) * q) + off; }
        const int nig = WGM * nN, gid = wgid / nig, fm = gid * WGM, gsz = (nM - fm) < WGM ? (nM - fm) : WGM;
        u.pm = fm + ((wgid % nig) % gsz); u.pn = (wgid % nig) / gsz; u.ord = i - r0; return true;
    }
    __device__ __forceinline__ void a_ready(const Unit&) const {}
    __device__ __forceinline__ void done(const Unit&) const {}
};

__device__ __forceinline__ unsigned cvt_pk_bf16(float lo, float hi) { typedef float f2 __attribute__((ext_vector_type(2))); typedef _Float16 b2 __attribute__((ext_vector_type(2))); f2 v = {lo, hi}; b2 b = __builtin_convertvector(v, b2); return __builtin_bit_cast(unsigned, b); }
__device__ __forceinline__ float bf_lo(unsigned w) { typedef _Float16 b2 __attribute__((ext_vector_type(2))); return (float)__builtin_bit_cast(b2, w)[0]; }
__device__ __forceinline__ float bf_hi(unsigned w) { typedef _Float16 b2 __attribute__((ext_vector_type(2))); return (float)__builtin_bit_cast(b2, w)[1]; }
__device__ __forceinline__ float fsigmoid(float x) { return __builtin_amdgcn_rcpf(1.f + __builtin_amdgcn_exp2f(-LOG2E * x)); }

__device__ __forceinline__ float sum_fq(float v) {
    auto a = __builtin_amdgcn_permlane16_swap(__float_as_uint(v), __float_as_uint(v), false, false); v = __uint_as_float(a[0]) + __uint_as_float(a[1]);
    auto b = __builtin_amdgcn_permlane32_swap(__float_as_uint(v), __float_as_uint(v), false, false); return __uint_as_float(b[0]) + __uint_as_float(b[1]);
}
constexpr int STAB_OFF = 131072 + 16384;
__device__ __forceinline__ void stats_prep(const float* sp, int pm, int wave) {
    PG8_LAS float* stab = (PG8_LAS float*)(STAB_OFF);
    const int tid = wave * 64 + pg8_lane();
    if (tid < BM) {
        const f32x4* p = (const f32x4*)(sp + (size_t)(pm * BM + tid) * 16);
        const f32x4 v0 = p[0], v1 = p[1], v2 = p[2], v3 = p[3];
        const float s = ((v0[0] + v0[2]) + (v1[0] + v1[2])) + ((v2[0] + v2[2]) + (v3[0] + v3[2])), q = ((v0[1] + v0[3]) + (v1[1] + v1[3])) + ((v2[1] + v2[3]) + (v3[1] + v3[3]));
        const float mean = s * (1.f / D), var = q * (1.f / D) - mean * mean;
        typedef float f32x2v __attribute__((ext_vector_type(2)));
        *(PG8_LAS f32x2v*)(stab + 2 * tid) = (f32x2v){mean, __builtin_amdgcn_rsqf(var + LN_EPS)};
    }
    if (tid == 0) *(PG8_LAS int*)(stab + 2 * BM) = pm;
}
constexpr int CTAB_OFF = STAB_OFF + 2048 + 64, CTAB_UNITS = 11;
template <class Sched> __device__ __forceinline__ void ctab_prep(const Sched& S, const float* c1, const float* c2, int wave) {
    const int tid = wave * 64 + pg8_lane();
    Unit u;
    for (int i = 0; i < CTAB_UNITS && S.next(i, u); ++i) {
        const float v = tid < BM ? c1[u.pn * BM + tid] : c2[u.pn * BM + tid - BM];
        typedef _Float16 h1;
        *(PG8_LAS h1*)(CTAB_OFF + i * 1024 + tid * 2) = (h1)v;
    }
}
__device__ __forceinline__ void ctab_get8(int ord, int which, int lc, float (&o)[8]) {
    typedef _Float16 h8 __attribute__((ext_vector_type(8)));
    const h8 v = *(PG8_LAS const h8*)(CTAB_OFF + ord * 1024 + which * 512 + lc * 2);
#pragma unroll
    for (int i = 0; i < 8; ++i) o[i] = (float)v[i];
}
__device__ __forceinline__ void row_stats(const float* sp, int row0, int fq, float (&mu)[2][4], float (&rs)[2][4]) {
    { PG8_LAS const float* stab = (PG8_LAS const float*)(STAB_OFF); const int pm = row0 / BM;
      if (*(PG8_LAS const int*)(stab + 2 * BM) == pm) {
          typedef float f32x2v __attribute__((ext_vector_type(2)));
#pragma unroll
          for (int ai = 0; ai < 2; ++ai)
#pragma unroll
              for (int m = 0; m < 4; ++m) { const f32x2v v = *(PG8_LAS const f32x2v*)(stab + 2 * ((row0 % BM) + ai * HALF + m * 16)); mu[ai][m] = v[0]; rs[ai][m] = v[1]; }
          return; } }
#pragma unroll
    for (int ai = 0; ai < 2; ++ai)
#pragma unroll
        for (int m = 0; m < 4; ++m) {
            const f32x4 v = *(const f32x4*)(sp + (size_t)(row0 + ai * HALF + m * 16) * 16 + fq * 4);
            float s = v[0] + v[2], q = v[1] + v[3];
            s = sum_fq(s); q = sum_fq(q);
            const float mean = s * (1.f / D), var = q * (1.f / D) - mean * mean;
            mu[ai][m] = mean; rs[ai][m] = __builtin_amdgcn_rsqf(var + LN_EPS);
        }
}

struct EpiNull {
    static constexpr bool PERM = true, AFTER_DRAIN = false;
    template <class Sched> __device__ __forceinline__ void prep(const Sched&, const Unit&, int) const {}
    float* sink;
    __device__ __forceinline__ void operator()(const f32x4 (&acc)[2][2][4][2], const Unit& u, int wr, int wc, int, int) const {
        float s = 0.f;
#pragma unroll
        for (int ai = 0; ai < 2; ++ai)
#pragma unroll
            for (int bj = 0; bj < 2; ++bj)
#pragma unroll
                for (int m = 0; m < 4; ++m)
#pragma unroll
                    for (int n = 0; n < 2; ++n) s += acc[ai][bj][m][n][0] + acc[ai][bj][m][n][1] + acc[ai][bj][m][n][2] + acc[ai][bj][m][n][3];
        if (s == 123.456f) sink[u.pm + wr + wc] = s;
    }
};

struct EpiUp {
    static constexpr bool PERM = true, AFTER_DRAIN = false;
    template <class Sched> __device__ __forceinline__ void prep(const Sched& S, const Unit& u, int wave) const { unsigned char* ws = kargs()->ws;
        stats_prep((const float*)(ws + WS_SP) + (size_t)tpar * (SP_BYTES / 4), u.pm, wave);
        ctab_prep(S, (const float*)(ws + WS_VEC + V_C1U) + (size_t)f * NUP, (const float*)(ws + WS_VEC + V_C2U) + (size_t)f * NUP, wave); }
    int f, tpar;
    __device__ __forceinline__ void operator()(const f32x4 (&acc)[2][2][4][2], const Unit& u, int wr, int wc, int, int) const {
        const int lane_ = pg8_lane(), fr = lane_ & 15, fq = lane_ >> 4;
        const int row0 = u.pm * BM + wr * 64 + fr;
        int f = this->f, tpar = this->tpar; asm volatile("" : "+s"(f), "+s"(tpar));
        unsigned char* ws = kargs()->ws; unsigned char* H = ws + WS_H;
        const float* c1 = (const float*)(ws + WS_VEC + V_C1U) + (size_t)f * NUP; const float* c2 = (const float*)(ws + WS_VEC + V_C2U) + (size_t)f * NUP; const float* sp = (const float*)(ws + WS_SP) + (size_t)tpar * (SP_BYTES / 4);
        float mu[2][4], rs[2][4]; row_stats(sp, row0, fq, mu, rs);
        const int cb = u.pn * BM + wc * 32 + 8 * fq;
        float k1[2][8], k2[2][8];
        if (u.ord < CTAB_UNITS) {
#pragma unroll
            for (int bj = 0; bj < 2; ++bj) { ctab_get8(u.ord, 0, wc * 32 + 8 * fq + bj * HALF, k1[bj]); ctab_get8(u.ord, 1, wc * 32 + 8 * fq + bj * HALF, k2[bj]); }
        } else {
#pragma unroll
            for (int bj = 0; bj < 2; ++bj)
#pragma unroll
                for (int i = 0; i < 8; ++i) { k1[bj][i] = c1[cb + bj * HALF + i]; k2[bj][i] = c2[cb + bj * HALF + i]; }
        }
        unsigned char* hp = H + (size_t)row0 * FF + u.pn * HALF + wc * 32 + 8 * fq;
#pragma unroll
        for (int ai = 0; ai < 2; ++ai)
#pragma unroll
            for (int m = 0; m < 4; ++m) {
                const float r_ = rs[ai][m], nm = -mu[ai][m] * r_, ra = r_ * (1.f / (F8_SR * F8_SW));
                typedef float f2 __attribute__((ext_vector_type(2)));
                f2 ga[4], ub[4], sg[4];
#pragma unroll
                for (int n = 0; n < 2; ++n)
#pragma unroll
                    for (int jj = 0; jj < 2; ++jj) {
                        const int c = 4 * n + 2 * jj;
                        const f2 ag = {acc[ai][0][m][n][2 * jj], acc[ai][0][m][n][2 * jj + 1]}, au = {acc[ai][1][m][n][2 * jj], acc[ai][1][m][n][2 * jj + 1]};
                        const f2 k1g = {k1[0][c], k1[0][c + 1]}, k2g = {k2[0][c], k2[0][c + 1]}, k1u = {k1[1][c], k1[1][c + 1]}, k2u = {k2[1][c], k2[1][c + 1]};
                        ga[2 * n + jj] = ag * ra + (k1g * nm + k2g);
                        ub[2 * n + jj] = au * ra + (k1u * nm + k2u);
                    }
#pragma unroll
                for (int i = 0; i < 4; ++i) { const f2 t = ga[i] * (-LOG2E); sg[i] = (f2){__builtin_amdgcn_exp2f(t[0]), __builtin_amdgcn_exp2f(t[1])}; }
#pragma unroll
                for (int i = 0; i < 4; ++i) { const f2 t = sg[i] + 1.f; sg[i] = (f2){__builtin_amdgcn_rcpf(t[0]), __builtin_amdgcn_rcpf(t[1])}; }
                float hv[8];
#pragma unroll
                for (int i = 0; i < 4; ++i) { const f2 h2 = ga[i] * sg[i] * ub[i]; hv[2 * i] = h2[0]; hv[2 * i + 1] = h2[1]; }
                *(u32x2*)(hp + (size_t)(ai * HALF + m * 16) * FF) = cvt8_f8(hv, F8_SH);
            }
    }
};

struct EpiLnOut {
    static constexpr bool PERM = true, AFTER_DRAIN = false;
    template <class Sched> __device__ __forceinline__ void prep(const Sched&, const Unit& u, int wave) const { stats_prep((const float*)(kargs()->ws + WS_SP) + (size_t)tpar * (SP_BYTES / 4), u.pm, wave); }
    int mode, j, tpar;
    __device__ __forceinline__ void operator()(const f32x4 (&acc)[2][2][4][2], const Unit& u, int wr, int wc, int, int) const {
        const int lane_ = pg8_lane(), fr = lane_ & 15, fq = lane_ >> 4;
        const int row0 = u.pm * BM + wr * 64 + fr;
        int mode = this->mode, j = this->j, tpar = this->tpar; asm volatile("" : "+s"(mode), "+s"(j), "+s"(tpar));
        const bool att = mode == 0; const int coff = mode == 2 ? 4096 : 0;
        unsigned char* ws = kargs()->ws; bf16_t* O = (bf16_t*)(ws + (att ? WS_QKV : WS_MP)) + coff; const int ldo = att ? NQKV : NMI, sig_from = mode == 2 ? 0 : (mode == 1 ? 16 : 1000);
        const float ascale = mode == 1 ? 1.f : 1.f / (F8_SR * F8_SW);
        const float* c1 = (const float*)(ws + WS_VEC + (att ? V_C1Q : V_C1I)) + j * ldo + coff; const float* c2 = (const float*)(ws + WS_VEC + (att ? V_C2Q : V_C2I)) + j * ldo + coff; const float* sp = (const float*)(ws + WS_SP) + (size_t)tpar * (SP_BYTES / 4);
        float mu[2][4], rs[2][4]; row_stats(sp, row0, fq, mu, rs);
        const int cb = u.pn * BM + wc * 32 + 8 * fq;
        const bool sg = u.pn >= sig_from;
        f32x4 k1[2][2], k2[2][2];
#pragma unroll
        for (int bj = 0; bj < 2; ++bj)
#pragma unroll
            for (int n = 0; n < 2; ++n) { k1[bj][n] = *(const f32x4*)(c1 + cb + bj * HALF + 4 * n); k2[bj][n] = *(const f32x4*)(c2 + cb + bj * HALF + 4 * n); }
        bf16_t* op = O + (size_t)row0 * ldo + cb;
#define LNOUT_ROWS(SIG) _Pragma("unroll") for (int ai = 0; ai < 2; ++ai) _Pragma("unroll") for (int m = 0; m < 4; ++m) { \
            const float r_ = rs[ai][m], nm = -mu[ai][m] * r_, ra = r_ * ascale; \
            _Pragma("unroll") for (int bj = 0; bj < 2; ++bj) { \
                typedef float f2 __attribute__((ext_vector_type(2))); float v[8]; \
                _Pragma("unroll") for (int n = 0; n < 2; ++n) _Pragma("unroll") for (int jj = 0; jj < 2; ++jj) { \
                    const f2 a2 = {acc[ai][bj][m][n][2 * jj], acc[ai][bj][m][n][2 * jj + 1]}, c1v = {k1[bj][n][2 * jj], k1[bj][n][2 * jj + 1]}, c2v = {k2[bj][n][2 * jj], k2[bj][n][2 * jj + 1]}; \
                    f2 t = a2 * ra + (c1v * nm + c2v); \
                    if (SIG) { const f2 e = t * (-LOG2E); const f2 d = (f2){__builtin_amdgcn_exp2f(e[0]), __builtin_amdgcn_exp2f(e[1])} + 1.f; t = (f2){__builtin_amdgcn_rcpf(d[0]), __builtin_amdgcn_rcpf(d[1])}; } \
                    v[4 * n + 2 * jj] = t[0]; v[4 * n + 2 * jj + 1] = t[1]; } \
                u32x4 w; w.x = cvt_pk_bf16(v[0], v[1]); w.y = cvt_pk_bf16(v[2], v[3]); w.z = cvt_pk_bf16(v[4], v[5]); w.w = cvt_pk_bf16(v[6], v[7]); \
                *(u32x4*)(op + (size_t)(ai * HALF + m * 16) * ldo + bj * HALF) = w; } }
        const int sgi = __builtin_amdgcn_readfirstlane(sg ? 1 : 0);
        if (sgi) { LNOUT_ROWS(true) } else { LNOUT_ROWS(false) }
#undef LNOUT_ROWS
    }
};

struct EpiRes {
    static constexpr bool PERM = true, AFTER_DRAIN = false;
    template <class Sched> __device__ __forceinline__ void prep(const Sched&, const Unit& u, int wave) const { stats_prep((const float*)(kargs()->ws + WS_SP) + (size_t)(t & 1) * (SP_BYTES / 4), u.pm, wave); }
    int t; float coef; PG8_LAS float* tab; int wave; int dry;
    __device__ __forceinline__ void operator()(const f32x4 (&acc)[2][2][4][2], const Unit& u, int wr, int wc, int, int) const {
        const int lane_ = pg8_lane(), fr = lane_ & 15, fq = lane_ >> 4;
        typedef float f32x2v __attribute__((ext_vector_type(2)));
        const int row0 = u.pm * BM + wr * 64 + fr;
        int t = this->t; asm volatile("" : "+s"(t)); float coef = this->coef; asm volatile("" : "+v"(coef));
        const bool need8 = (t != 3 && t != 9 && t != 11) || dry;
        kargs_t ka = kargs(); unsigned char* ws = ka->ws; bf16_t* R = (bf16_t*)(ws + WS_R); unsigned char* R8 = ws + (dry ? WS_MP + 64 * MiB : WS_R8); bf16_t* Ro = dry ? (bf16_t*)(ws + WS_MP) : R;
        const float* g = t ? ka->ln_g + (size_t)(t - 1) * D : (const float*)(ws + WS_VEC + V_ONES); const float* b = t ? ka->ln_b + (size_t)(t - 1) * D : (const float*)(ws + WS_VEC + V_ZEROS);
        const float* sp_in = (const float*)(ws + WS_SP) + (size_t)(t & 1) * (SP_BYTES / 4); float* sp_out = dry ? (float*)(ws + WS_MP + 96 * MiB) : (float*)(ws + WS_SP) + (size_t)((t + 1) & 1) * (SP_BYTES / 4);
        const int cb0 = u.pn * BM + wc * 32 + 8 * fq;
        u32x4 cur[4];
#pragma unroll
        for (int m = 0; m < 4; ++m) cur[m] = *(const u32x4*)(R + (size_t)(row0 + m * 16) * D + cb0);
        float mu[2][4], rs[2][4]; row_stats(sp_in, row0, fq, mu, rs);
        f32x4 gv[2], bv[2];
#pragma unroll
        for (int k = 0; k < 4; ++k) {
            const int bj = k >> 1, ai = k & 1, cb = cb0 + bj * HALF;
            if (ai == 0) {
#pragma unroll
                for (int n = 0; n < 2; ++n) { gv[n] = *(const f32x4*)(g + cb + 4 * n); bv[n] = *(const f32x4*)(b + cb + 4 * n) * ALPHA; }
            }
#pragma unroll
            for (int m = 0; m < 4; ++m) {
                const float A_ = ALPHA * rs[ai][m], B_ = -mu[ai][m] * A_;
                const size_t off = (size_t)(row0 + ai * HALF + m * 16) * D + cb;
                const u32x4 o = cur[m];
                if (k < 3 && dry != 3) cur[m] = *(const u32x4*)(R + (size_t)(row0 + ((k + 1) & 1) * HALF + m * 16) * D + cb0 + ((k + 1) >> 1) * HALF);
                typedef float fv2 __attribute__((ext_vector_type(2)));
                float nv[8];
#pragma unroll
                for (int n = 0; n < 2; ++n)
#pragma unroll
                    for (int jj = 0; jj < 2; ++jj) {
                        const unsigned w2 = n == 0 ? (jj == 0 ? o.x : o.y) : (jj == 0 ? o.z : o.w); const fv2 r2 = {bf_lo(w2), bf_hi(w2)}, a2 = {acc[ai][bj][m][n][2 * jj], acc[ai][bj][m][n][2 * jj + 1]};
                        const fv2 g2 = {gv[n][2 * jj], gv[n][2 * jj + 1]}, b2 = {bv[n][2 * jj], bv[n][2 * jj + 1]};
                        const fv2 t = (r2 * A_ + B_) * g2 + (a2 * coef + b2);
                        nv[4 * n + 2 * jj] = t[0]; nv[4 * n + 2 * jj + 1] = t[1];
                    }
                u32x4 w; w.x = cvt_pk_bf16(nv[0], nv[1]); w.y = cvt_pk_bf16(nv[2], nv[3]); w.z = cvt_pk_bf16(nv[4], nv[5]); w.w = cvt_pk_bf16(nv[6], nv[7]);
                if (dry != 2) { *(u32x4*)(Ro + off) = w;
                if (need8) *(u32x2*)(R8 + off) = cvt8_f8(nv, F8_SR); }
                const float f0 = bf_lo(w.x), f1 = bf_hi(w.x), f2 = bf_lo(w.y), f3 = bf_hi(w.y), f4 = bf_lo(w.z), f5 = bf_hi(w.z), f6 = bf_lo(w.w), f7 = bf_hi(w.w);
                float s = ((f0 + f1) + (f2 + f3)) + ((f4 + f5) + (f6 + f7));
                float q = ((f0 * f0 + f1 * f1) + (f2 * f2 + f3 * f3)) + ((f4 * f4 + f5 * f5) + (f6 * f6 + f7 * f7));
                s = sum_fq(s); q = sum_fq(q);
                if (fq == 0) *(PG8_LAS f32x2v*)(tab + (((ai * HALF + wr * 64 + m * 16 + fr) * 4 + wc) * 2 + bj) * 2) = (f32x2v){s, q};
                asm volatile("" ::: "memory");
            }
        }
        asm volatile("s_waitcnt lgkmcnt(0)" ::: "memory"); __builtin_amdgcn_s_barrier(); asm volatile("" ::: "memory");
        const int tid = wave * 64 + pg8_lane();
        if (tid < BM) {
            const PG8_LAS f32x4* t4 = (const PG8_LAS f32x4*)(tab + tid * 16);
            const f32x4 a = t4[0], c = t4[1], d = t4[2], e = t4[3];
            *(f32x2v*)(sp_out + (size_t)(u.pm * BM + tid) * 16 + u.pn * 2) = (f32x2v){((a[0] + a[2]) + (c[0] + c[2])) + ((d[0] + d[2]) + (e[0] + e[2])), ((a[1] + a[3]) + (c[1] + c[3])) + ((d[1] + d[3]) + (e[1] + e[3]))};
        }
    }
};

template <class Epi, class Sched, bool ALIGN_EPI = false, bool SP2 = false, bool F8 = false>
__device__ __forceinline__ void gemm_phase(PG8_LAS unsigned char* lds, const Gemm g, const Sched& S, const Epi& E, int wave_in) {
    int wid = wave_in; asm volatile("" : "+s"(wid));
    const int lane = pg8_lane(), tid = wid * 64 + lane, wr = wid >> 2, wc = wid & 3, fr = lane & 15, fq = lane >> 4;
    const int K = g.K, nt = K / BK;
    unsigned voffA[2], voffB[2];
#pragma unroll
    for (int i = 0; i < 2; ++i) { int R, C; stage_rc(tid * 16 + i * 8192, R, C); const int Rb = Epi::PERM ? ((R & ~31) + perm32(R & 31)) : R;
        voffA[i] = (unsigned)(R * K + C) * 2u; voffB[i] = (unsigned)(Rb * K + C) * 2u; }
    const size_t kstep = (size_t)(BK * 2);
    const size_t hstep = (size_t)HALF * K * 2;
    const size_t tstep = 2 * hstep;
    const unsigned ldsw = (unsigned)wid * 1024u;
    const int aoff = lds_byte(wr * 64 + fr, fq * 8), boff = lds_byte(wc * 32 + fr, fq * 8);
#define PG8_SA(b, h) (((b) * 2 + (h)) * HTB)
#define PG8_SB(b, h) ((4 + (b) * 2 + (h)) * HTB)
#define PG8_STAGE(bufoff, gbase, voff) do { _Pragma("unroll") for (int _i = 0; _i < 2; ++_i) \
        __builtin_amdgcn_global_load_lds((const unsigned*)((const char*)(gbase) + (voff)[_i]), (PG8_LAS unsigned*)(lds + (bufoff) + ldsw + _i * 8192), 16, 0, 0); } while (0)
#define PG8_LDA(dst, b, h) do { _Pragma("unroll") for (int m = 0; m < 4; ++m) _Pragma("unroll") for (int k = 0; k < 2; ++k) dst[m][k] = *(const PG8_LAS bf16x8*)(lds + PG8_SA(b, h) + aoff + m * 2048 + k * 1024); } while (0)
#define PG8_LDB(dst, b, h) do { _Pragma("unroll") for (int n = 0; n < 2; ++n) _Pragma("unroll") for (int k = 0; k < 2; ++k) dst[n][k] = *(const PG8_LAS bf16x8*)(lds + PG8_SB(b, h) + boff + n * 2048 + k * 1024); } while (0)
#define PG8_MMA(ai, bj, At, Bt) do { __builtin_amdgcn_s_setprio(1); _Pragma("unroll") for (int m = 0; m < 4; ++m) _Pragma("unroll") for (int n = 0; n < 2; ++n) { \
        if constexpr (F8) mfma_f8_inplace(acc[ai][bj][m][n], cat_i8(Bt[n][0], Bt[n][1]), cat_i8(At[m][0], At[m][1])); \
        else { _Pragma("unroll") for (int k = 0; k < 2; ++k) acc[ai][bj][m][n] = __builtin_amdgcn_mfma_f32_16x16x32_f16(__builtin_bit_cast(f16x8, Bt[n][k]), __builtin_bit_cast(f16x8, At[m][k]), acc[ai][bj][m][n], 0, 0, 0); } } \
        __builtin_amdgcn_s_setprio(0); } while (0)
#define PG8_WAIT_V(n) asm volatile("s_waitcnt vmcnt(" #n ")" ::: "memory")
#define PG8_WAIT_L(n) asm volatile("s_waitcnt lgkmcnt(" #n ")" ::: "memory")
#define PG8_BAR __builtin_amdgcn_s_barrier()
#define PG8_SCHED __builtin_amdgcn_sched_barrier(0)
    Unit cur, nxt; int ui = 0;
    if (!S.next(0, cur)) return;
    E.prep(S, cur, wave_in);
    f32x4 acc[2][2][4][2];
#pragma unroll
    for (int a = 0; a < 2; ++a)
#pragma unroll
        for (int b = 0; b < 2; ++b)
#pragma unroll
            for (int m = 0; m < 4; ++m)
#pragma unroll
                for (int n = 0; n < 2; ++n) { float z0, z1, z2, z3; asm volatile("v_mov_b32 %0, 0\n\tv_mov_b32 %1, 0\n\tv_mov_b32 %2, 0\n\tv_mov_b32 %3, 0" : "=v"(z0), "=v"(z1), "=v"(z2), "=v"(z3)); acc[a][b][m][n] = (f32x4){z0, z1, z2, z3}; }
    bf16x8 At[4][2], B0[2][2], B1[2][2];
    const char* cA = (const char*)g.A + (size_t)cur.pm * tstep; const char* cB = (const char*)g.Bt + (size_t)cur.pn * tstep;
    S.a_ready(cur);
    if constexpr (SP2) {
        PG8_STAGE(PG8_SB(0, 0), cB, voffB); PG8_STAGE(PG8_SB(0, 1), cB + hstep, voffB); PG8_STAGE(PG8_SA(0, 0), cA, voffA); PG8_STAGE(PG8_SA(0, 1), cA + hstep, voffA);
        if (wr == 1) PG8_BAR;
        PG8_WAIT_V(2); PG8_BAR;
        PG8_STAGE(PG8_SB(1, 0), cB + kstep, voffB); PG8_STAGE(PG8_SA(1, 0), cA + kstep, voffA); PG8_STAGE(PG8_SB(1, 1), cB + hstep + kstep, voffB);
        PG8_WAIT_V(6); PG8_BAR;
    } else {
        PG8_STAGE(PG8_SB(0, 0), cB, voffB); PG8_STAGE(PG8_SA(0, 0), cA, voffA); PG8_STAGE(PG8_SB(0, 1), cB + hstep, voffB); PG8_STAGE(PG8_SA(0, 1), cA + hstep, voffA);
        if (wr == 1) PG8_BAR;
        PG8_WAIT_V(4); PG8_BAR;
        PG8_STAGE(PG8_SB(1, 0), cB + kstep, voffB); PG8_STAGE(PG8_SA(1, 0), cA + kstep, voffA); PG8_STAGE(PG8_SB(1, 1), cB + hstep + kstep, voffB);
        PG8_WAIT_V(6); PG8_BAR;
    }
    for (;;) {
        const bool has_next = S.next(ui + 1, nxt);
        const char* nA = has_next ? (const char*)g.A + (size_t)nxt.pm * tstep : cA; const char* nB = has_next ? (const char*)g.Bt + (size_t)nxt.pn * tstep : cB;
        for (int t = 0; t < nt; t += 2) {
            const bool last = (t == nt - 2);
            const char* a1 = cA + (size_t)(t + 1) * kstep;
            const char* a2 = last ? nA : cA + (size_t)(t + 2) * kstep; const char* b2 = last ? nB : cB + (size_t)(t + 2) * kstep;
            const char* a3 = a2 + kstep; const char* b3 = b2 + kstep;
            if (last && has_next) S.a_ready(nxt);
            if constexpr (SP2) {
            PG8_LDB(B0, 0, 0); PG8_LDB(B1, 0, 1); PG8_SCHED; PG8_LDA(At, 0, 0); PG8_STAGE(PG8_SA(1, 1), a1 + hstep, voffA);
            PG8_WAIT_V(8); PG8_WAIT_L(0); PG8_BAR; PG8_MMA(0, 0, At, B0); PG8_MMA(0, 1, At, B1); PG8_BAR; PG8_SCHED;
            PG8_LDA(At, 0, 1); PG8_STAGE(PG8_SB(0, 0), b2, voffB); PG8_STAGE(PG8_SB(0, 1), b2 + hstep, voffB); PG8_STAGE(PG8_SA(0, 0), a2, voffA);
            PG8_WAIT_V(8); PG8_WAIT_L(0); PG8_BAR; PG8_MMA(1, 0, At, B0); PG8_MMA(1, 1, At, B1); PG8_BAR; PG8_SCHED;
            PG8_LDB(B0, 1, 0); PG8_LDB(B1, 1, 1); PG8_SCHED; PG8_LDA(At, 1, 0); PG8_STAGE(PG8_SA(0, 1), a2 + hstep, voffA);
            PG8_WAIT_V(8); PG8_WAIT_L(0); PG8_BAR; PG8_MMA(0, 0, At, B0); PG8_MMA(0, 1, At, B1); PG8_BAR; PG8_SCHED;
            PG8_LDA(At, 1, 1); PG8_STAGE(PG8_SB(1, 0), b3, voffB); PG8_STAGE(PG8_SB(1, 1), b3 + hstep, voffB); PG8_STAGE(PG8_SA(1, 0), a3, voffA);
            PG8_WAIT_V(8); PG8_WAIT_L(0); PG8_BAR; PG8_MMA(1, 0, At, B0); PG8_MMA(1, 1, At, B1); PG8_BAR; PG8_SCHED;
            } else {
            PG8_LDB(B0, 0, 0); PG8_SCHED; PG8_LDA(At, 0, 0); PG8_STAGE(PG8_SA(1, 1), a1 + hstep, voffA);
            PG8_WAIT_L(8); PG8_BAR; PG8_WAIT_L(0); PG8_MMA(0, 0, At, B0); PG8_BAR; PG8_SCHED;
            PG8_LDB(B1, 0, 1); PG8_STAGE(PG8_SB(0, 0), b2, voffB);
            PG8_BAR; PG8_WAIT_L(0); PG8_MMA(0, 1, At, B1); PG8_BAR;
            PG8_LDA(At, 0, 1); PG8_STAGE(PG8_SA(0, 0), a2, voffA);
            PG8_BAR; PG8_WAIT_L(0); PG8_MMA(1, 0, At, B0); PG8_BAR; PG8_SCHED;
            PG8_STAGE(PG8_SB(0, 1), b2 + hstep, voffB);
            PG8_WAIT_V(6); PG8_BAR; PG8_MMA(1, 1, At, B1); PG8_BAR;
            PG8_LDB(B0, 1, 0); PG8_SCHED; PG8_LDA(At, 1, 0); PG8_STAGE(PG8_SA(0, 1), a2 + hstep, voffA);
            PG8_WAIT_L(8); PG8_BAR; PG8_WAIT_L(0); PG8_MMA(0, 0, At, B0); PG8_BAR; PG8_SCHED;
            PG8_LDB(B1, 1, 1); PG8_STAGE(PG8_SB(1, 0), b3, voffB);
            PG8_BAR; PG8_WAIT_L(0); PG8_MMA(0, 1, At, B1); PG8_BAR;
            PG8_LDA(At, 1, 1); PG8_STAGE(PG8_SA(1, 0), a3, voffA);
            PG8_BAR; PG8_WAIT_L(0); PG8_MMA(1, 0, At, B0); PG8_BAR; PG8_SCHED;
            PG8_STAGE(PG8_SB(1, 1), b3 + hstep, voffB);
            PG8_WAIT_V(6); PG8_BAR; PG8_MMA(1, 1, At, B1); PG8_BAR;
            }
        }
        if constexpr (F8) asm volatile("s_nop 15\n\ts_nop 7" ::: "memory");
        if constexpr (ALIGN_EPI) { if (wr == 0) PG8_BAR; }
        if constexpr (!Epi::AFTER_DRAIN) { E(acc, cur, wr, wc, fr, fq); S.done(cur); }
        if (!has_next) break;
#pragma unroll
        for (int a = 0; a < 2; ++a)
#pragma unroll
            for (int b = 0; b < 2; ++b)
#pragma unroll
                for (int m = 0; m < 4; ++m)
#pragma unroll
                    for (int n = 0; n < 2; ++n) { float z0, z1, z2, z3; asm volatile("v_mov_b32 %0, 0\n\tv_mov_b32 %1, 0\n\tv_mov_b32 %2, 0\n\tv_mov_b32 %3, 0" : "=v"(z0), "=v"(z1), "=v"(z2), "=v"(z3)); acc[a][b][m][n] = (f32x4){z0, z1, z2, z3}; }
        cur = nxt; cA = nA; cB = nB; ++ui;
        if constexpr (ALIGN_EPI) { if (wr == 1) PG8_BAR; }
    }
    PG8_WAIT_V(0);
    if constexpr (!ALIGN_EPI) { if (wr == 0) PG8_BAR; }
    PG8_BAR;
    if constexpr (Epi::AFTER_DRAIN) { E.fused(acc, cur, wr, wc, fr, fq, lds, wid, lane); S.done(cur); }
#undef PG8_SA
#undef PG8_SB
#undef PG8_STAGE
#undef PG8_LDA
#undef PG8_LDB
#undef PG8_MMA
#undef PG8_WAIT_V
#undef PG8_WAIT_L
#undef PG8_BAR
#undef PG8_SCHED
}
}

#ifndef PG8_SP2
#define PG8_SP2 true
#endif

#define GAS __attribute__((address_space(1)))
#define LAS __attribute__((address_space(3)))
typedef unsigned short bf16;
typedef unsigned v4u __attribute__((ext_vector_type(4)));
typedef unsigned v2u __attribute__((ext_vector_type(2)));
typedef float f32x4 __attribute__((ext_vector_type(4)));
typedef float f32x2 __attribute__((ext_vector_type(2)));
typedef float f32x16 __attribute__((ext_vector_type(16)));
typedef short bf16x8 __attribute__((ext_vector_type(8)));
typedef short s16x4 __attribute__((ext_vector_type(4)));
typedef GAS unsigned gu32;
typedef GAS unsigned long long gu64;
typedef LAS const char* lcp;
typedef LAS char* lwp;
#define RLX_AGENT __ATOMIC_RELAXED, __HIP_MEMORY_SCOPE_AGENT
#define LDS_WAIT() asm volatile("s_waitcnt lgkmcnt(0)" ::: "memory")
#define VM_WAIT() asm volatile("s_waitcnt vmcnt(0)" ::: "memory")
#define WG_BAR() do { asm volatile("s_waitcnt vmcnt(0) lgkmcnt(0)" ::: "memory"); __builtin_amdgcn_s_barrier(); asm volatile("" ::: "memory"); } while (0)
#define DI __device__ __forceinline__
#define MFMA32(a, b, c) __builtin_amdgcn_mfma_f32_32x32x16_f16(__builtin_bit_cast(pg8::f16x8, (a)), __builtin_bit_cast(pg8::f16x8, (b)), (c), 0, 0, 0)
DI unsigned pk2(float lo, float hi) { return pg8::cvt_pk_bf16(lo, hi); }
DI float bflo(unsigned w) { return pg8::bf_lo(w); }
DI float bfhi(unsigned w) { return pg8::bf_hi(w); }
DI float ex2(float x) { return __builtin_amdgcn_exp2f(x); }
DI f32x16 zero16() { float z = 0.f; asm volatile("" : "+v"(z)); return (f32x16){z, z, z, z, z, z, z, z, z, z, z, z, z, z, z, z}; }
DI int crow(int r, int hi) { return (r & 3) + 8 * (r >> 2) + 4 * hi; }
#define SWZ_XOR(v, m) __uint_as_float((unsigned)__builtin_amdgcn_ds_swizzle((int)__float_as_uint(v), ((m) << 10) | 0x1f))
DI float half_swap_add(float v);
DI float wave_sum(float v) { v += SWZ_XOR(v, 1); v += SWZ_XOR(v, 2); v += SWZ_XOR(v, 4); v += SWZ_XOR(v, 8); v += SWZ_XOR(v, 16); return half_swap_add(v); }
DI float shfl_lane(float v, int src_lane) { return __uint_as_float((unsigned)__builtin_amdgcn_ds_bpermute(src_lane << 2, (int)__float_as_uint(v))); }
DI float half_swap_add(float v) { auto rr = __builtin_amdgcn_permlane32_swap(__float_as_uint(v), __float_as_uint(v), false, false); return __uint_as_float(rr[0]) + __uint_as_float(rr[1]); }
DI float half_swap_max(float v) { auto rr = __builtin_amdgcn_permlane32_swap(__float_as_uint(v), __float_as_uint(v), false, false); return fmaxf(__uint_as_float(rr[0]), __uint_as_float(rr[1])); }
typedef short v4i16_t __attribute__((ext_vector_type(4)));
DI s16x4 vtr(lcp p) { return __builtin_bit_cast(s16x4, __builtin_amdgcn_ds_read_tr16_b64_v4i16((LAS v4i16_t*)p)); }
DI bf16x8 cat8(s16x4 lo, s16x4 hi) { return __builtin_shufflevector(lo, hi, 0, 1, 2, 3, 4, 5, 6, 7); }
DI bf16x8 trfrag(lcp p) { return cat8(vtr(p), vtr(p + 512)); }
DI bf16x8 ldfrag(lcp p) { return *(const LAS bf16x8*)p; }
DI bf16x8 mask_frag(v4u v, unsigned m) { v4u o; asm("v_and_b32 %0, %4, %8\n\tv_and_b32 %1, %5, %8\n\tv_and_b32 %2, %6, %8\n\tv_and_b32 %3, %7, %8\n\ts_nop 1" : "=&v"(o.x), "=&v"(o.y), "=&v"(o.z), "=&v"(o.w) : "v"(v.x), "v"(v.y), "v"(v.z), "v"(v.w), "v"(m)); return __builtin_bit_cast(bf16x8, o); }
DI void glds16(const void* gsrc, LAS void* ldst) { __builtin_amdgcn_global_load_lds((const unsigned*)gsrc, (LAS unsigned*)ldst, 16, 0, 0); }
#define PACK8(x, s) ((bf16x8)__builtin_bit_cast(bf16x8, (v4u){pk2((x)[8 * (s) + 0], (x)[8 * (s) + 1]), pk2((x)[8 * (s) + 2], (x)[8 * (s) + 3]), pk2((x)[8 * (s) + 4], (x)[8 * (s) + 5]), pk2((x)[8 * (s) + 6], (x)[8 * (s) + 7])}))

constexpr int RING_OFF = 0, RING_BYTES = 131072;
constexpr int TAB_OFF = 131072;
constexpr int MISC_OFF = 163840 - 256;
constexpr int LDS_BYTES = 163840;
constexpr int AT_K = 0, AT_V = 32768, AT_WS = 65536, AT_STG = 67584;
constexpr int ML_K = 0, ML_V = 65536, ML_VW = 81920, ML_C = 98304, ML_N = 131072, ML_G2 = 131584, ML_M2 = 132096, ML_FI = 132608, ML_EI = 133120, ML_WK = 133632, ML_WKB = 134144, ML_SC = 134400, ML_WS = 134464, ML_STG = 136512;
static_assert(ML_STG + 4 * 4096 <= MISC_OFF && AT_STG + 8 * 4096 <= MISC_OFF && pg8::CTAB_OFF + pg8::CTAB_UNITS * 1024 <= MISC_OFF && pg8::STAB_OFF == TAB_OFF + 16384, "LDS map");

#define XB_TMO      128
#define XB_XCNT(j)  (256  + 64 * (j))
#define XB_XSUB(j)  (1280 + 64 * (j))
#define XB_XGEN(j)  (2304 + 64 * (j))
#define XB_TOP      3328
#define XB_TOPGEN   3392
#define XCD_BAR_WORDS 3456
#define XB_SPIN_CAP (1u << 18)

__device__ __forceinline__ unsigned xb_ld(unsigned* p)              { return __hip_atomic_load(p, __ATOMIC_RELAXED, __HIP_MEMORY_SCOPE_AGENT); }
__device__ __forceinline__ unsigned xb_add(unsigned* p, unsigned v) { return __hip_atomic_fetch_add(p, v, __ATOMIC_RELAXED, __HIP_MEMORY_SCOPE_AGENT); }
__device__ __forceinline__ unsigned xb_xcc_id() { return (unsigned)__builtin_amdgcn_s_getreg((3 << 11) | 20) & 0xFu; }
#define XB_SPIN(cond, bar) do { unsigned _sp = 0; while (cond) { __builtin_amdgcn_s_sleep(1); \
    if ((++_sp & 255u) == 0u) { if (xb_ld(&(bar)[XB_TMO])) break; if (_sp > XB_SPIN_CAP) { atomicAdd(&(bar)[XB_TMO], 1u); break; } } } } while (0)

struct XcdBarrier {
    unsigned* bar; unsigned x;
    volatile LAS unsigned* st;
    unsigned total;
};

__device__ __forceinline__ XcdBarrier xcd_barrier_post(unsigned* bar, volatile LAS unsigned* st) {
    XcdBarrier b; b.bar = bar; b.x = xb_xcc_id(); b.st = st; b.total = gridDim.x * gridDim.y * gridDim.z;
    if (threadIdx.x == 0) (void)xb_add(&bar[XB_XCNT(b.x)], 1u);
    return b;
}
__device__ __forceinline__ void xcd_barrier_complete(unsigned* bar, unsigned x, unsigned G, unsigned& nloc, unsigned& nx) {
    unsigned sum, cnt, mine, sp = 0u;
    for (;;) {
        sum = 0u; cnt = 0u; mine = 0u;
#pragma unroll
        for (unsigned j = 0; j < 16; ++j) { const unsigned c = xb_ld(&bar[XB_XCNT(j)]); sum += c; cnt += (c > 0u) ? 1u : 0u; mine = (j == x) ? c : mine; }
        if (sum == G) break;
        __builtin_amdgcn_s_sleep(1);
        if ((++sp & 255u) == 0u) { if (xb_ld(&bar[XB_TMO])) break; if (sp > XB_SPIN_CAP) { atomicAdd(&bar[XB_TMO], 1u); break; } }
    }
    nloc = mine > 0u ? mine : 1u; nx = cnt > 0u ? cnt : 1u;
}

__device__ __forceinline__ void xcd_barrier(const XcdBarrier& b) {
    asm volatile("s_waitcnt vmcnt(0)" ::: "memory");
    __syncthreads();
    if (threadIdx.x == 0) {
        unsigned* bar = b.bar;
        __builtin_amdgcn_s_waitcnt(0);
        unsigned nloc = b.st[0], nx = b.st[1];
        if (nloc == 0u) { xcd_barrier_complete(bar, b.x, b.total, nloc, nx); b.st[0] = nloc; b.st[1] = nx; }
        const unsigned old = xb_add(&bar[XB_XSUB(b.x)], 1u);
        const unsigned gen = old / nloc;
        if (old + 1u == (gen + 1u) * nloc) {
            __builtin_amdgcn_fence(__ATOMIC_RELEASE, "agent");
            asm volatile("s_waitcnt vmcnt(0)" ::: "memory");
            const unsigned og = xb_add(&bar[XB_TOP], 1u);
            const unsigned tg = og / nx;
            if (og + 1u == (tg + 1u) * nx) xb_add(&bar[XB_TOPGEN], 1u);
            else XB_SPIN(xb_ld(&bar[XB_TOPGEN]) == tg, bar);
            __builtin_amdgcn_fence(__ATOMIC_ACQUIRE, "agent");
            xb_add(&bar[XB_XGEN(b.x)], 1u);
            asm volatile("s_waitcnt vmcnt(0)" ::: "memory");
        } else {
            XB_SPIN(xb_ld(&bar[XB_XGEN(b.x)]) == gen, bar);
            __builtin_amdgcn_fence(__ATOMIC_ACQUIRE, "agent");
            asm volatile("s_waitcnt vmcnt(0)" ::: "memory");
        }
    }
    __syncthreads();
}
DI void attn_phase(unsigned char* ldsg, const bf16* QKV, unsigned char* AO8, const float* sinks, int ng, int gx, int gy, int Gy, int wave_in) {
    int wid = wave_in; asm volatile("" : "+s"(wid));
    const int lane = pg8::pg8_lane(), tid = wid * 64 + lane, r32 = lane & 31, hi = lane >> 5;
    LAS unsigned char* lds = (LAS unsigned char*)ldsg; const lcp L = (lcp)lds;
    LAS float* wsf = (LAS float*)(lds + AT_WS) + wid * 64;
    LAS unsigned char* stg = lds + AT_STG + wid * 4096;
    const lcp vlane = L + AT_V + ((lane >> 4) & 1) * 32 + (lane & 3) * 8 + (4 * hi + ((lane & 15) >> 2)) * 64;
    const lcp klane = L + AT_K + hi * 1024 + r32 * 16;
    for (int uu = gy; uu < 64 * (BATCH / ng); uu += Gy) { const int b = gx + ng * (uu >> 6), ul = uu & 63;
        const int kvh = ul & 3, nb = ul >> 2;
        const long rowq = (long)b * SEQ + nb * 128, rowk = rowq - 128;
        const int slot_lo = (nb == 0) ? 2 : 0;
        for (int sl = slot_lo; sl < 4; ++sl) {
            glds16(QKV + (rowk + 64 * sl + lane) * NQKV + 2048 + 64 * kvh + 8 * wid, lds + AT_K + sl * 8192 + wid * 1024);
            glds16(QKV + (rowk + 64 * sl + 16 * (wid & 3) + (lane >> 2)) * NQKV + 2304 + 64 * kvh + (wid >> 2) * 32 + (lane & 3) * 8, lds + AT_V + sl * 8192 + wid * 1024);
        }
        const int hq = 8 * kvh + wid;
        const bf16* qsrc = QKV + (rowq + r32) * NQKV + 64 * hq + 8 * hi;
        bf16x8 qn[4];
#pragma unroll
        for (int d0 = 0; d0 < 4; ++d0) qn[d0] = *(const bf16x8*)(qsrc + 16 * d0);
        const float slope2 = ex2(-0.25f * (float)(hq + 1)) * LOG2E, sink2 = sinks[hq] * LOG2E;
        const float base_l = -slope2 * (float)(r32 - 4 * hi);
        WG_BAR();
#pragma unroll 1
        for (int j = 0; j < 4; ++j) {
            const int ilo = (nb == 0) ? 4 - j : 0;
            bf16x8 qr[4];
#pragma unroll
            for (int d0 = 0; d0 < 4; ++d0) qr[d0] = qn[d0];
            if (j < 3) {
#pragma unroll
                for (int d0 = 0; d0 < 4; ++d0) qn[d0] = *(const bf16x8*)(qsrc + (size_t)(32 * (j + 1)) * NQKV + 16 * d0);
            }
            float sl2 = slope2, bl = base_l; asm volatile("" : "+v"(sl2), "+v"(bl));
            f32x16 p[5];
#pragma unroll
            for (int i = 0; i < 5; ++i) {
                if (i >= ilo) {
                    const int kt = j + i; const lcp kb = klane + (kt >> 1) * 8192 + (kt & 1) * 512;
                    f32x16 a = zero16();
#pragma unroll
                    for (int d0 = 0; d0 < 4; ++d0) a = MFMA32(ldfrag(kb + d0 * 2048), qr[d0], a);
#pragma unroll
                    for (int r = 0; r < 16; ++r) {
                        const int cr = (r & 3) + 8 * (r >> 2);
                        float s = fmaf(sl2, (float)(cr - 128 + 32 * i), fmaf(a[r], LOG2E, bl));
                        if (i == 0) { if (!(cr + 4 * hi > r32)) s = -INFINITY; }
                        if (i == 4) { if (!(cr + 4 * hi <= r32)) s = -INFINITY; }
                        a[r] = s;
                    }
                    p[i] = a;
                } else {
#pragma unroll
                    for (int r = 0; r < 16; ++r) p[i][r] = -INFINITY;
                }
            }
            float mx = sink2;
#pragma unroll
            for (int i = 0; i < 5; ++i)
#pragma unroll
                for (int r = 0; r < 16; ++r) mx = fmaxf(mx, p[i][r]);
            mx = half_swap_max(mx);
            float ls = 0.f;
#pragma unroll
            for (int i = 0; i < 5; ++i)
#pragma unroll
                for (int r = 0; r < 16; ++r) { const float e = ex2(p[i][r] - mx); p[i][r] = e; ls += e; }
            ls = half_swap_add(ls) + ex2(sink2 - mx);
            f32x16 o0 = zero16(), o1 = zero16();
#pragma unroll
            for (int i = 0; i < 5; ++i) {
                if (i >= ilo) {
                    const int kt = j + i; const lcp vb = vlane + (kt >> 1) * 8192 + (kt & 1) * 2048;
                    const bf16x8 pa = PACK8(p[i], 0), pb = PACK8(p[i], 1);
                    o0 = MFMA32(pa, trfrag(vb), o0);        o0 = MFMA32(pb, trfrag(vb + 1024), o0);
                    o1 = MFMA32(pa, trfrag(vb + 4096), o1); o1 = MFMA32(pb, trfrag(vb + 4096 + 1024), o1);
                }
            }
            if (hi == 0) wsf[r32] = __builtin_amdgcn_rcpf(ls);
#pragma unroll
            for (int r = 0; r < 16; ++r) {
                const int orow = crow(r, hi); const float rl = wsf[orow] * pg8::F8_SO;
                int pk; asm volatile("" : "=v"(pk)); pk = __builtin_amdgcn_cvt_pk_fp8_f32(o0[r] * rl, o1[r] * rl, pk, false);
                stg[orow * 64 + r32] = (unsigned char)(pk & 0xff);
                stg[orow * 64 + 32 + r32] = (unsigned char)((pk >> 8) & 0xff);
            }
#pragma unroll
            for (int i4 = 0; i4 < 2; ++i4) {
                const int row = i4 * 16 + (lane >> 2), ch = lane & 3;
                const v4u v = *(const LAS v4u*)(stg + row * 64 + ch * 16);
                *(v4u*)(AO8 + (rowq + 32 * j + row) * D + 64 * hq + ch * 16) = v;
            }
        }
        WG_BAR();
    }
}

constexpr int ML_GSET = ML_STG + 4 * 4096 - ML_G2;
static_assert(ML_G2 + ML_GSET + (ML_WS - ML_G2) <= MISC_OFF, "LDS map: second gate-array set");
#define DPPF(old, src, ctrl, rmask, bc) __uint_as_float((unsigned)__builtin_amdgcn_update_dpp((int)__float_as_uint(old), (int)__float_as_uint(src), (ctrl), (rmask), 0xf, (bc)))
DI float scan_add64(float v) {
    v += DPPF(0.f, v, 0x111, 0xf, true); v += DPPF(0.f, v, 0x112, 0xf, true); v += DPPF(0.f, v, 0x114, 0xf, true); v += DPPF(0.f, v, 0x118, 0xf, true);
    v += DPPF(0.f, v, 0x142, 0xa, false); v += DPPF(0.f, v, 0x143, 0xc, false); return v;
}
DI float scan_max64(float v) {
    const float ninf = -INFINITY;
    v = fmaxf(v, DPPF(ninf, v, 0x111, 0xf, false)); v = fmaxf(v, DPPF(ninf, v, 0x112, 0xf, false)); v = fmaxf(v, DPPF(ninf, v, 0x114, 0xf, false)); v = fmaxf(v, DPPF(ninf, v, 0x118, 0xf, false));
    v = fmaxf(v, DPPF(ninf, v, 0x142, 0xa, false)); v = fmaxf(v, DPPF(ninf, v, 0x143, 0xc, false)); return v;
}
DI float ml_gate_scan(LAS unsigned char* lds, int gofs, const float* GT, long row0, int h, int lane, float m_prev) {
    LAS float* G2 = (LAS float*)(lds + ML_G2 + gofs); LAS float* M2 = (LAS float*)(lds + ML_M2 + gofs); LAS float* FI = (LAS float*)(lds + ML_FI + gofs); LAS float* EI = (LAS float*)(lds + ML_EI + gofs);
    LAS float* WK = (LAS float*)(lds + ML_WK + gofs); LAS bf16* WKB = (LAS bf16*)(lds + ML_WKB + gofs); LAS float* SC = (LAS float*)(lds + ML_SC + gofs);
    const float* gp = GT + (size_t)(row0 + 2 * lane) * 8;
    const float i0 = gp[h], f0 = gp[4 + h], i1 = gp[8 + h], f1 = gp[12 + h];
    const float lf0 = -0.6931471805599453f * __builtin_amdgcn_logf(1.f + ex2(-LOG2E * f0)), lf1 = -0.6931471805599453f * __builtin_amdgcn_logf(1.f + ex2(-LOG2E * f1));
    const float incl = scan_add64(lf0 + lf1);
    const float b1 = incl, b0 = incl - lf1;
    const float g0 = i0 - b0, g1 = i1 - b1;
    const float cm = scan_max64(fmaxf(g0, g1));
    const float cprev = DPPF(-INFINITY, cm, 0x138, 0xf, false);
    const float M0 = fmaxf(m_prev, fmaxf(cprev, g0)), M1 = fmaxf(m_prev, cm);
    const float Mend = __uint_as_float((unsigned)__builtin_amdgcn_readlane((int)__float_as_uint(M1), 63)), blast = __uint_as_float((unsigned)__builtin_amdgcn_readlane((int)__float_as_uint(b1), 63));
    *(LAS f32x2*)(G2 + 2 * lane) = (f32x2){g0 * LOG2E, g1 * LOG2E};
    *(LAS f32x2*)(M2 + 2 * lane) = (f32x2){M0 * LOG2E, M1 * LOG2E};
    *(LAS f32x2*)(FI + 2 * lane) = (f32x2){ex2((m_prev - M0) * LOG2E), ex2((m_prev - M1) * LOG2E)};
    *(LAS f32x2*)(EI + 2 * lane) = (f32x2){ex2(-(b0 + M0) * LOG2E), ex2(-(b1 + M1) * LOG2E)};
    const float w0 = ex2((g0 - Mend) * LOG2E), w1 = ex2((g1 - Mend) * LOG2E);
    *(LAS f32x2*)(WK + 2 * lane) = (f32x2){w0, w1};
    *(LAS unsigned*)(WKB + 2 * lane) = pk2(w0, w1);
    if (lane == 0) SC[0] = ex2((m_prev - Mend) * LOG2E);
    return blast + Mend;
}
template <int VAR = 0>
DI void mlstm_phase(unsigned char* ldsg, const bf16* MP, const float* GT, bf16* HG, int ng, int gx, int gy, int Gy, int wave_in) {
    int wid = wave_in; asm volatile("" : "+s"(wid));
    const int lane0 = pg8::pg8_lane(), tid = wid * 64 + lane0;
    LAS unsigned char* lds = (LAS unsigned char*)ldsg; const lcp L = (lcp)lds;
    LAS float* wsf = (LAS float*)(lds + ML_WS) + wid * 64;
    for (int uu = gy; uu < 32 * (BATCH / ng); uu += Gy) { const int b = gx + ng * (uu >> 5), ul = uu & 31;
        const int h = ul >> 3, sl = ul & 7;
        const bf16* Qp = MP + 256 * h; const bf16* Kp = MP + 1024 + 256 * h; const bf16* Vp = MP + 2048 + 512 * h + 64 * sl; const bf16* OGp = MP + 4096 + 512 * h + 64 * sl;
        { unsigned z = 0u; asm volatile("" : "+v"(z)); for (int i = tid; i < (32768 + 512) / 16; i += 512) *(LAS v4u*)(lds + ML_C + i * 16) = (v4u){z, z, z, z}; }
        f32x16 T[6];
#pragma unroll
        for (int x = 0; x < 6; ++x) T[x] = zero16();
        float m_prev = 0.f;
        v4u X[16], vreg[2];
        { const long row0 = (long)b * SEQ; const int lane = lane0, r32 = lane & 31, hi = lane >> 5;
          if (wid >= 4) {
#pragma unroll
              for (int i = 0; i < 16; ++i) X[i] = *(const v4u*)(Kp + (row0 + 8 * i + (lane & 7)) * NMI + (8 * (wid - 4) + (lane >> 3)) * 8);
          } else {
#pragma unroll
              for (int ks = 0; ks < 16; ++ks) X[ks] = *(const v4u*)(Qp + (row0 + 32 * wid + r32) * NMI + 16 * ks + 8 * hi);
          }
#pragma unroll
          for (int i = 0; i < 2; ++i) vreg[i] = *(const v4u*)(Vp + (row0 + 64 * i + 16 * (wid & 3) + (lane >> 2)) * NMI + (wid >> 2) * 32 + (lane & 3) * 8);
          if (wid == 4 && !(VAR & 16)) m_prev = ml_gate_scan(lds, 0, GT, row0, h, lane, m_prev);
        }
        WG_BAR();
        for (int c = 0; c < 16; ++c) {
            const long row0 = (long)b * SEQ + 128 * c;
            const int gofs = (c & 1) * ML_GSET;
            const int lane = pg8::pg8_lane(), r32 = lane & 31, hi = lane >> 5;
            const int blk = (lane >> 4) & 1, q4 = (lane & 15) >> 2, p4 = lane & 3;
            const int vlo_ = blk * 32 + p4 * 8 + (4 * hi + q4) * 64;
            const int ktl_ = (2 * blk + (p4 >> 1)) * 2048 + (q4 + 4 * hi) * 16 + (p4 & 1) * 8;
            const int cbl_ = hi * 1024 + r32 * 16, kbl_ = hi * 2048 + r32 * 16;
            const unsigned m0 = (r32 == 0) ? 0xffffffffu : 0u;
            LAS float* G2 = (LAS float*)(lds + ML_G2 + gofs); LAS float* M2 = (LAS float*)(lds + ML_M2 + gofs); LAS float* FI = (LAS float*)(lds + ML_FI + gofs); LAS float* EI = (LAS float*)(lds + ML_EI + gofs);
            LAS float* WK = (LAS float*)(lds + ML_WK + gofs); LAS bf16* WKB = (LAS bf16*)(lds + ML_WKB + gofs); LAS float* SC = (LAS float*)(lds + ML_SC + gofs);
            VM_WAIT();
            if (wid >= 4) {
#pragma unroll
                for (int i = 0; i < 16; ++i) *(LAS v4u*)(lds + ML_K + (8 * (wid - 4) + (lane >> 3)) * 2048 + (8 * i + (lane & 7)) * 16) = X[i];
            }
#pragma unroll
            for (int i = 0; i < 2; ++i) { const float w = WK[64 * i + 16 * (wid & 3) + (lane >> 2)]; const v4u v = vreg[i]; v4u o;
                o.x = pk2(bflo(v.x) * w, bfhi(v.x) * w); o.y = pk2(bflo(v.y) * w, bfhi(v.y) * w); o.z = pk2(bflo(v.z) * w, bfhi(v.z) * w); o.w = pk2(bflo(v.w) * w, bfhi(v.w) * w);
                *(LAS v4u*)(lds + ML_V + i * 8192 + wid * 1024 + lane * 16) = v;
                *(LAS v4u*)(lds + ML_VW + i * 8192 + wid * 1024 + lane * 16) = o; }
            WG_BAR();
            const bool more = c + 1 < 16;
            if (more && !(VAR & 32)) {
                const long row1 = row0 + 128;
                if (wid >= 4) {
#pragma unroll
                    for (int i = 0; i < 16; ++i) X[i] = *(const v4u*)(Kp + (row1 + 8 * i + (lane & 7)) * NMI + (8 * (wid - 4) + (lane >> 3)) * 8);
                }
#pragma unroll
                for (int i = 0; i < 2; ++i) vreg[i] = *(const v4u*)(Vp + (row1 + 64 * i + 16 * (wid & 3) + (lane >> 2)) * NMI + (wid >> 2) * 32 + (lane & 3) * 8);
            }
            if (wid < 4) {
                const int tt = wid;
                v4u ogv[4];
#pragma unroll
                for (int i4 = 0; i4 < 4; ++i4) ogv[i4] = *(const v4u*)(OGp + (row0 + 32 * tt + i4 * 8 + (lane >> 3)) * NMI + (lane & 7) * 8);
                T[0] = zero16(); T[1] = zero16(); T[2] = zero16();
                if (!(VAR & 4)) { const lcp cb = L + ML_C + cbl_; const lcp nbp = L + ML_N + 16 * hi;
#pragma unroll
                  for (int ks = 0; ks < 16; ++ks) {
                      const bf16x8 c0 = ldfrag(cb + ks * 2048), c1 = ldfrag(cb + ks * 2048 + 512);
                      const bf16x8 nf = mask_frag(*(const LAS v4u*)(nbp + ks * 32), m0);
                      T[0] = MFMA32(__builtin_bit_cast(bf16x8, X[ks]), c0, T[0]); T[1] = MFMA32(__builtin_bit_cast(bf16x8, X[ks]), c1, T[1]); T[2] = MFMA32(__builtin_bit_cast(bf16x8, X[ks]), nf, T[2]);
                      if ((ks & 3) == 3) __builtin_amdgcn_sched_barrier(0);
                  } }
                { float fi[16];
#pragma unroll
                  for (int r = 0; r < 16; ++r) fi[r] = FI[32 * tt + crow(r, hi)];
#pragma unroll
                  for (int r = 0; r < 16; ++r) { T[0][r] *= fi[r]; T[1][r] *= fi[r]; }
                  if (r32 == 0) {
#pragma unroll
                      for (int r = 0; r < 16; ++r) wsf[crow(r, hi)] = T[2][r] * fi[r];
                  } }
                const float Mt = M2[32 * tt + r32];
                float dsum = 0.f;
                for (int st = 0; st <= ((VAR & 2) ? -1 : tt); ++st) {
                    f32x16 S = zero16();
                    const lcp kb = L + ML_K + kbl_ + st * 512;
#pragma unroll
                    for (int ks = 0; ks < 16; ++ks) S = MFMA32(ldfrag(kb + ks * 4096), __builtin_bit_cast(bf16x8, X[ks]), S);
#pragma unroll
                    for (int r = 0; r < 16; ++r) {
                        const float w = ex2(G2[32 * st + crow(r, hi)] - Mt);
                        float v = S[r] * w;
                        if (st == tt && crow(r, hi) > r32) v = 0.f;
                        S[r] = v; dsum += v;
                    }
                    const bf16x8 pa = PACK8(S, 0), pb = PACK8(S, 1);
                    const lcp vb = L + ML_V + (st >> 1) * 8192 + (st & 1) * 2048 + vlo_;
                    T[0] = MFMA32(pa, trfrag(vb), T[0]);        T[0] = MFMA32(pb, trfrag(vb + 1024), T[0]);
                    T[1] = MFMA32(pa, trfrag(vb + 4096), T[1]); T[1] = MFMA32(pb, trfrag(vb + 4096 + 1024), T[1]);
                }
                if (more && !(VAR & 64)) {
#pragma unroll
                    for (int ks = 0; ks < 16; ++ks) X[ks] = *(const v4u*)(Qp + (row0 + 128 + 32 * wid + r32) * NMI + 16 * ks + 8 * hi);
                }
                dsum = half_swap_add(dsum);
                { const float den = wsf[r32] + dsum; const float dn = fmaxf(fabsf(den), EI[32 * tt + r32]);
                  if (hi == 0) wsf[32 + r32] = __builtin_amdgcn_rcpf(dn); }
                LAS bf16* stg = (LAS bf16*)(lds + ML_STG + tt * 4096);
                if (!(VAR & 8)) {
#pragma unroll
                for (int r = 0; r < 16; ++r) {
                    const int orow = crow(r, hi); const float rd = wsf[32 + orow];
                    stg[orow * 64 + r32] = (bf16)(pk2(T[0][r] * rd, 0.f) & 0xffffu);
                    stg[orow * 64 + 32 + r32] = (bf16)(pk2(T[1][r] * rd, 0.f) & 0xffffu);
                }
#pragma unroll
                for (int i4 = 0; i4 < 4; ++i4) {
                    const int row = i4 * 8 + (lane >> 3), ch = lane & 7;
                    const v4u hv = *(const LAS v4u*)(stg + row * 64 + ch * 8);
                    const v4u og = ogv[i4];
                    v4u o;
                    o.x = pk2(bflo(hv.x) * bflo(og.x), bfhi(hv.x) * bfhi(og.x)); o.y = pk2(bflo(hv.y) * bflo(og.y), bfhi(hv.y) * bfhi(og.y));
                    o.z = pk2(bflo(hv.z) * bflo(og.z), bfhi(hv.z) * bfhi(og.z)); o.w = pk2(bflo(hv.w) * bflo(og.w), bfhi(hv.w) * bfhi(og.w));
                    *(v4u*)(HG + (row0 + 32 * tt + row) * D + 512 * h + 64 * sl + ch * 8) = o;
                }
                }
#pragma unroll
                for (int x = 3; x < 6; ++x) T[x] = zero16();
            } else {
                const float decay = SC[0];
#pragma unroll
                for (int x = 0; x < 6; ++x)
#pragma unroll
                    for (int r = 0; r < 16; ++r) T[x][r] *= decay;
#pragma unroll
                for (int dti = 0; dti < ((VAR & 1) ? 0 : 2); ++dti) {
                    const int dt = 2 * (wid - 4) + dti;
                    const lcp ka0 = L + ML_K + dt * 8192 + ktl_;
#pragma unroll
                    for (int s8 = 0; s8 < 8; ++s8) {
                        const lcp ka = ka0 + s8 * 256;
                        const bf16x8 af = cat8(vtr(ka), vtr(ka + 128));
                        const lcp vwb = L + ML_VW + (s8 >> 2) * 8192 + (s8 & 3) * 1024 + vlo_;
                        const bf16x8 b0 = trfrag(vwb), b1 = trfrag(vwb + 4096);
                        const v2u wlo = *(const LAS v2u*)(WKB + 16 * s8 + 4 * hi), whi = *(const LAS v2u*)(WKB + 16 * s8 + 4 * hi + 8); const bf16x8 nb = mask_frag((v4u){wlo.x, wlo.y, whi.x, whi.y}, m0);
                        T[2 * dti] = MFMA32(af, b0, T[2 * dti]); T[2 * dti + 1] = MFMA32(af, b1, T[2 * dti + 1]); T[4 + dti] = MFMA32(af, nb, T[4 + dti]);
                        if (s8 & 1) __builtin_amdgcn_sched_barrier(0);
                    }
                }
                if (more && wid == 4 && !(VAR & 16)) m_prev = ml_gate_scan(lds, ML_GSET - gofs, GT, row0 + 128, h, lane, m_prev);
            }
            asm volatile("s_waitcnt lgkmcnt(0)" ::: "memory"); __builtin_amdgcn_s_barrier(); asm volatile("" ::: "memory");
            if (wid >= 4) {
#pragma unroll
                for (int dti = 0; dti < 2; ++dti) {
                    const int dt = 2 * (wid - 4) + dti;
#pragma unroll
                    for (int et = 0; et < 2; ++et)
#pragma unroll
                        for (int g = 0; g < 4; ++g)
                            *(LAS v2u*)(lds + ML_C + (4 * dt + g) * 1024 + (32 * et + r32) * 16 + hi * 8) = (v2u){pk2(T[2 * dti + et][4 * g], T[2 * dti + et][4 * g + 1]), pk2(T[2 * dti + et][4 * g + 2], T[2 * dti + et][4 * g + 3])};
                    if (r32 == 0) {
#pragma unroll
                        for (int g = 0; g < 4; ++g)
                            *(LAS v2u*)(lds + ML_N + (32 * dt + 8 * g + 4 * hi) * 2) = (v2u){pk2(T[4 + dti][4 * g], T[4 + dti][4 * g + 1]), pk2(T[4 + dti][4 * g + 2], T[4 + dti][4 * g + 3])};
                    }
                }
            }
        }
        WG_BAR();
    }
}


constexpr int NWAVES = 8;

template <bool F8> DI void tr_strip(const float* W, int ldw, int n0, void* WTv, size_t wt_row0, int Kdim, int kb0, int nkb, const float* g, const float* bb, float cs, float* c1o, float* c2o, LAS float* scr, int lane) {
    bf16* WT = (bf16*)WTv; unsigned char* WT8 = (unsigned char*)WTv;
    const int c = lane & 7;
    float a1[4] = {0.f, 0.f, 0.f, 0.f}, a2[4] = {0.f, 0.f, 0.f, 0.f};
    for (int kb = kb0; kb < kb0 + nkb; ++kb) {
        const int k0 = kb * 64;
#pragma unroll 8
        for (int i = 0; i < 32; ++i) { const int kk = 2 * i + (lane >> 5); scr[kk * 33 + (lane & 31)] = W[(size_t)(k0 + kk) * ldw + n0 + (lane & 31)]; }
        float gk[8], bk[8];
        if (g) { const f32x4 g0 = *(const f32x4*)(g + k0 + 8 * c), g1 = *(const f32x4*)(g + k0 + 8 * c + 4), b0 = *(const f32x4*)(bb + k0 + 8 * c), b1 = *(const f32x4*)(bb + k0 + 8 * c + 4);
#pragma unroll
            for (int i = 0; i < 4; ++i) { gk[i] = g0[i] * cs; gk[4 + i] = g1[i] * cs; bk[i] = b0[i] * cs; bk[4 + i] = b1[i] * cs; } }
        else {
#pragma unroll
            for (int i = 0; i < 8; ++i) { gk[i] = cs; bk[i] = 0.f; } }
        LDS_WAIT(); asm volatile("" ::: "memory");
#pragma unroll
        for (int j = 0; j < 4; ++j) { const int n = (lane >> 3) + 8 * j; const LAS float* s = scr + (8 * c) * 33 + n;
            float v[8];
#pragma unroll
            for (int i = 0; i < 8; ++i) v[i] = s[i * 33];
            a2[j] += ((v[0] * bk[0] + v[1] * bk[1]) + (v[2] * bk[2] + v[3] * bk[3])) + ((v[4] * bk[4] + v[5] * bk[5]) + (v[6] * bk[6] + v[7] * bk[7]));
            if constexpr (F8) {
                float wv[8];
#pragma unroll
                for (int i = 0; i < 8; ++i) wv[i] = v[i] * gk[i];
                const v2u o = pg8::cvt8_f8(wv, pg8::F8_SW);
                a1[j] += ((__builtin_amdgcn_cvt_f32_fp8((int)o.x, 0) + __builtin_amdgcn_cvt_f32_fp8((int)o.x, 1)) + (__builtin_amdgcn_cvt_f32_fp8((int)o.x, 2) + __builtin_amdgcn_cvt_f32_fp8((int)o.x, 3)))
                       + ((__builtin_amdgcn_cvt_f32_fp8((int)o.y, 0) + __builtin_amdgcn_cvt_f32_fp8((int)o.y, 1)) + (__builtin_amdgcn_cvt_f32_fp8((int)o.y, 2) + __builtin_amdgcn_cvt_f32_fp8((int)o.y, 3)));
                *(GAS v2u*)(WT8 + (wt_row0 + n) * Kdim + k0 + 8 * c) = o;
            } else {
                v4u o; o.x = pk2(v[0] * gk[0], v[1] * gk[1]); o.y = pk2(v[2] * gk[2], v[3] * gk[3]); o.z = pk2(v[4] * gk[4], v[5] * gk[5]); o.w = pk2(v[6] * gk[6], v[7] * gk[7]);
                a1[j] += ((bflo(o.x) + bfhi(o.x)) + (bflo(o.y) + bfhi(o.y))) + ((bflo(o.z) + bfhi(o.z)) + (bflo(o.w) + bfhi(o.w)));
                *(GAS v4u*)(WT + (wt_row0 + n) * Kdim + k0 + 8 * c) = o;
            } }
        LDS_WAIT(); asm volatile("" ::: "memory");
    }
    if (g) {
#pragma unroll
        for (int j = 0; j < 4; ++j) { float s1 = a1[j], s2 = a2[j];
            s1 += SWZ_XOR(s1, 1); s2 += SWZ_XOR(s2, 1); s1 += SWZ_XOR(s1, 2); s2 += SWZ_XOR(s2, 2); s1 += SWZ_XOR(s1, 4); s2 += SWZ_XOR(s2, 4);
            if (c == 0) { c1o[(lane >> 3) + 8 * j] = F8 ? s1 * (1.f / pg8::F8_SW) : s1; c2o[(lane >> 3) + 8 * j] = s2; } }
    }
}

DI void prologue(kargs_t a, LAS unsigned char* lds, int gw, int NGW, int wave, int lane) {
    unsigned char* ws = a->ws;
    float* vec = (float*)(ws + WS_VEC);
    const float* ones = (const float*)(ws + WS_VEC + V_ONES); const float* zeros = (const float*)(ws + WS_VEC + V_ZEROS);
    LAS float* scr = (LAS float*)(lds + wave * 16384);
    constexpr int T_UP = 8 * 2 * 176, T_QKV = 2 * 80, T_MI = 2 * 192, T_W2 = 8 * 64 * 4, T_WO = 2 * 64, T_WMO = 2 * 64, T_G = 16;
    constexpr int NT = T_UP + T_QKV + T_MI + T_W2 + T_WO + T_WMO + T_G;
    for (int it = gw; it < NT; it += NGW) {
        int r = it;
        if (r < T_UP) {
            const int f = r / 352, rr = r % 352, which = rr / 176, strip = rr % 176, n0 = 32 * strip;
            const int t = 3 * (f >> 1) + 2 * (f & 1);
            const float* gp = t ? a->ln_g + (size_t)(t - 1) * D : nullptr; const float* bp = t ? a->ln_b + (size_t)(t - 1) * D : nullptr;
            const size_t wrow = (size_t)256 * (n0 / 128) + 128 * which + (n0 % 128);
            const float* W = (which ? a->w3 : a->w1) + (size_t)f * D * FF;
            if (gp) tr_strip<true>(W, FF, n0, ws + WS_W13 + (size_t)f * NUP * D, wrow, D, 0, 32, gp, bp, 1.f, vec + V_C1U / 4 + (size_t)f * NUP + wrow, vec + V_C2U / 4 + (size_t)f * NUP + wrow, scr, lane);
            else { tr_strip<true>(W, FF, n0, ws + WS_W13 + (size_t)f * NUP * D, wrow, D, 0, 32, nullptr, nullptr, 1.f, nullptr, nullptr, scr, lane);
                   if (lane < 32) { vec[V_C1U / 4 + (size_t)f * NUP + wrow + lane] = 0.f; vec[V_C2U / 4 + (size_t)f * NUP + wrow + lane] = 0.f; } }
            continue; }
        r -= T_UP;
        if (r < T_QKV) { const int j = r / 80, n0 = 32 * (r % 80); const int t = 6 * j + 1;
            tr_strip<true>(a->wqkv + (size_t)j * D * NQKV, NQKV, n0, ws + WS_WQKV + (size_t)j * NQKV * D, n0, D, 0, 32, a->ln_g + (size_t)(t - 1) * D, a->ln_b + (size_t)(t - 1) * D, n0 < 2048 ? 0.125f : 1.f,
                     vec + V_C1Q / 4 + j * NQKV + n0, vec + V_C2Q / 4 + j * NQKV + n0, scr, lane);
            continue; }
        r -= T_QKV;
        if (r < T_MI) { const int j = r / 192, n0 = 32 * (r % 192); const int t = 6 * j + 4;
            if (true) tr_strip<false>(a->win + (size_t)j * D * NMIW, NMIW, n0, (bf16*)(ws + WS_WIN) + (size_t)j * NMI * D, n0, D, 0, 32, a->ln_g + (size_t)(t - 1) * D, a->ln_b + (size_t)(t - 1) * D, (n0 >= 1024 && n0 < 2048) ? 0.0625f : 1.f,
                     vec + V_C1I / 4 + j * NMI + n0, vec + V_C2I / 4 + j * NMI + n0, scr, lane);
            else tr_strip<true>(a->win + (size_t)j * D * NMIW, NMIW, n0, ws + WS_WIN + 32 * MiB + (size_t)j * 2048 * D, n0 - 4096, D, 0, 32, a->ln_g + (size_t)(t - 1) * D, a->ln_b + (size_t)(t - 1) * D, 1.f,
                     vec + V_C1I / 4 + j * NMI + n0, vec + V_C2I / 4 + j * NMI + n0, scr, lane);
            continue; }
        r -= T_MI;
        if (r < T_W2) { const int f = r / 256, rr = r % 256, strip = rr / 4, kq = rr % 4;
            tr_strip<true>(a->w2 + (size_t)f * FF * D, D, 32 * strip, ws + WS_W2 + (size_t)f * D * FF, 32 * strip, FF, 22 * kq, 22, nullptr, nullptr, 1.f, nullptr, nullptr, scr, lane);
            continue; }
        r -= T_W2;
        if (r < T_WO) { const int j = r / 64, strip = r % 64;
            tr_strip<true>(a->wo + (size_t)j * D * D, D, 32 * strip, ws + WS_WO + (size_t)j * D * D, 32 * strip, D, 0, 32, nullptr, nullptr, 1.f, nullptr, nullptr, scr, lane);
            continue; }
        r -= T_WO;
        if (r < T_WMO) { const int j = r / 64, strip = r % 64;
            tr_strip<false>(a->wmo + (size_t)j * D * D, D, 32 * strip, (bf16*)(ws + WS_WMO) + (size_t)j * D * D, 32 * strip, D, 0, 32, nullptr, nullptr, 1.f, nullptr, nullptr, scr, lane);
            continue; }
        r -= T_WMO;
        {
            const int j = r / 8, jj = r % 8; const int t = 6 * j + 4;
            const float* gp = a->ln_g + (size_t)(t - 1) * D; const float* bp = a->ln_b + (size_t)(t - 1) * D;
            const float* W = a->win + (size_t)j * D * NMIW + NMI + jj;
            bf16* wg16 = (bf16*)(vec + V_WG / 4) + (size_t)(j * 8 + jj) * D;
            float s1 = 0.f, s2 = 0.f;
            for (int k = lane; k < D; k += 64) { const float w = W[(size_t)k * NMIW]; const unsigned hv = pk2(w * gp[k], 0.f) & 0xffffu; wg16[k] = (bf16)hv; s1 += bflo(hv); s2 += w * bp[k]; }
            s1 = wave_sum(s1); s2 = wave_sum(s2);
            if (lane == 0) { vec[V_CG / 4 + j * 16 + jj] = s1; vec[V_CG / 4 + j * 16 + 8 + jj] = s2 + a->bg[j * 8 + jj]; }
        }
    }
    bf16* R = (bf16*)(ws + WS_R); float* sp0 = (float*)(ws + WS_SP);
    for (int m = gw; m < M; m += NGW) {
        const GAS f32x4* xr = (const GAS f32x4*)(a->x + (size_t)m * D);
#pragma unroll
        for (int i = 0; i < 4; ++i) { const f32x4 v0 = xr[(i * 64 + lane) * 2], v1 = xr[(i * 64 + lane) * 2 + 1];
            *(GAS v4u*)(R + (size_t)m * D + (i * 64 + lane) * 8) = (v4u){pk2(v0[0], v0[1]), pk2(v0[2], v0[3]), pk2(v1[0], v1[1]), pk2(v1[2], v1[3])};
            { const float xv[8] = {v0[0], v0[1], v0[2], v0[3], v1[0], v1[1], v1[2], v1[3]}; *(GAS v2u*)(ws + WS_R8 + (size_t)m * D + (i * 64 + lane) * 8) = pg8::cvt8_f8(xv, pg8::F8_SR); } }
        if (lane < 8) *(f32x2*)(sp0 + (size_t)m * 16 + lane * 2) = (f32x2){0.f, 256.f * (1.f - LN_EPS)};
    }
    for (int i = gw * 64 + lane; i < D; i += NGW * 64) { vec[V_ONES / 4 + i] = 1.f; vec[V_ZEROS / 4 + i] = 0.f; }
    (void)ones; (void)zeros;
}

DI void gates_phase(LAS unsigned char* lds, const bf16* R, const float* sp, const bf16* wg16, const float* cg, float* GT, int ng, int gx, int gy, int Gy, int wave_in) {
    int wave = wave_in; asm volatile("" : "+s"(wave));
    const int lane = pg8::pg8_lane(), tid = wave * 64 + lane, r32 = lane & 31, hi = lane >> 5;
    LAS float* part = (LAS float*)lds;
    const unsigned mk = (r32 < 8) ? 0xffffffffu : 0u; const v4u mkv = {mk, mk, mk, mk};
    for (int uu = gy; uu < (SEQ / 64) * (BATCH / ng); uu += Gy) { const int b = gx + ng * (uu >> 5), pl = uu & 31;
        const long r0 = (long)b * SEQ + (long)pl * 64;
        const bf16* bsrc = wg16 + (size_t)(r32 & 7) * D + 256 * wave + 8 * hi;
        bf16x8 bfr[16];
#pragma unroll
        for (int ks = 0; ks < 16; ++ks) bfr[ks] = __builtin_bit_cast(bf16x8, *(const v4u*)(bsrc + 16 * ks) & mkv);
#pragma unroll
        for (int rt = 0; rt < 2; ++rt) {
            const bf16* asrc = R + (r0 + 32 * rt + r32) * D + 256 * wave + 8 * hi;
            bf16x8 afr[16];
#pragma unroll
            for (int ks = 0; ks < 16; ++ks) afr[ks] = *(const bf16x8*)(asrc + 16 * ks);
            f32x16 acc = zero16();
#pragma unroll
            for (int ks = 0; ks < 16; ++ks) acc = MFMA32(afr[ks], bfr[ks], acc);
            if (r32 < 8) {
#pragma unroll
                for (int r = 0; r < 16; ++r) part[(wave * 64 + 32 * rt + crow(r, hi)) * 8 + r32] = acc[r];
            }
        }
        WG_BAR();
        {
            const int row = tid >> 3, col = tid & 7;
            float s = 0.f;
#pragma unroll
            for (int w = 0; w < 8; ++w) s += part[(w * 64 + row) * 8 + col];
            const f32x4* spr = (const f32x4*)(sp + (size_t)(r0 + row) * 16);
            const f32x4 v0 = spr[0], v1 = spr[1], v2 = spr[2], v3 = spr[3];
            const float ss = ((v0[0] + v0[2]) + (v1[0] + v1[2])) + ((v2[0] + v2[2]) + (v3[0] + v3[2])), qq = ((v0[1] + v0[3]) + (v1[1] + v1[3])) + ((v2[1] + v2[3]) + (v3[1] + v3[3]));
            const float mean = ss * (1.f / D), var = qq * (1.f / D) - mean * mean, rstd = __builtin_amdgcn_rsqf(var + LN_EPS);
            GT[(size_t)(r0 + row) * 8 + col] = rstd * (s - mean * cg[col]) + cg[8 + col];
        }
        WG_BAR();
    }
}

DI void final_ln(const bf16* R, const float* sp, const float* g, const float* b, float* out, int ng, int gx, int gw, int NGW, int lane) {
    for (int bb = gx; bb < BATCH; bb += ng) for (int m = bb * SEQ + gw; m < (bb + 1) * SEQ; m += NGW) {
        float s, q;
        { const f32x4 v = *(const f32x4*)(sp + (size_t)m * 16 + (lane & 3) * 4); s = v[0] + v[2]; q = v[1] + v[3];
          s += SWZ_XOR(s, 1); q += SWZ_XOR(q, 1); s += SWZ_XOR(s, 2); q += SWZ_XOR(q, 2); }
        const float mean = s * (1.f / D), var = q * (1.f / D) - mean * mean, rstd = __builtin_amdgcn_rsqf(var + LN_EPS);
#pragma unroll
        for (int i = 0; i < 4; ++i) {
            const int k = 8 * lane + 512 * i;
            const v4u rv = *(const v4u*)(R + (size_t)m * D + k);
            const f32x4 g0 = *(const f32x4*)(g + k), g1 = *(const f32x4*)(g + k + 4), b0 = *(const f32x4*)(b + k), b1 = *(const f32x4*)(b + k + 4);
            f32x4 o0, o1;
            o0[0] = (bflo(rv.x) - mean) * rstd * g0[0] + b0[0]; o0[1] = (bfhi(rv.x) - mean) * rstd * g0[1] + b0[1]; o0[2] = (bflo(rv.y) - mean) * rstd * g0[2] + b0[2]; o0[3] = (bfhi(rv.y) - mean) * rstd * g0[3] + b0[3];
            o1[0] = (bflo(rv.z) - mean) * rstd * g1[0] + b1[0]; o1[1] = (bfhi(rv.z) - mean) * rstd * g1[1] + b1[1]; o1[2] = (bflo(rv.w) - mean) * rstd * g1[2] + b1[2]; o1[3] = (bfhi(rv.w) - mean) * rstd * g1[3] + b1[3];
            *(GAS f32x4*)(out + (size_t)m * D + k) = o0; *(GAS f32x4*)(out + (size_t)m * D + k + 4) = o1;
        }
    }
}

#ifndef PROBE_DUP
#define PROBE_DUP 0
#endif
#ifndef PROBE_DRY
#define PROBE_DRY 1
#endif
#ifndef PROBE_MLV
#define PROBE_MLV 0
#endif
#ifndef SKIP_ATT
#define SKIP_ATT 0
#endif
#ifndef SKIP_MLSTM
#define SKIP_MLSTM 0
#endif

#define GRID_BAR1() do { XcdBarrier b_; b_.bar = (unsigned*)(kargs()->ws + WS_CTL) + CW_BAR; b_.x = xb_xcc_id(); b_.st = (volatile LAS unsigned*)(lds + MISC_OFF) + 8; b_.total = gridDim.x; xcd_barrier(b_); } while (0)
#define GRID_BAR() do { GRID_BAR1(); if (PROBE_DUP & 1024) GRID_BAR1(); } while (0)
#define GROUP_BAR1() do { XcdBarrier b_; b_.bar = (unsigned*)(kargs()->ws + WS_CTL) + CW_BAR + (1 + (bid & 7)) * XCD_BAR_WORDS; b_.x = xb_xcc_id(); b_.st = (volatile LAS unsigned*)(lds + MISC_OFF) + 10; b_.total = gridDim.x / 8; xcd_barrier(b_); } while (0)
#define LAYER_BAR() do { if (grouped) { GROUP_BAR1(); if (PROBE_DUP & 1024) GROUP_BAR1(); } else GRID_BAR(); } while (0)

__global__ void __launch_bounds__(NWAVES * 64, 2) fwd_kernel(Args args_by_value) {
    extern __shared__ __attribute__((aligned(16))) unsigned char lds_raw[];
    LAS unsigned char* lds = (LAS unsigned char*)lds_raw;
    const int w0 = __builtin_amdgcn_readfirstlane((int)threadIdx.x >> 6);
    const int G0 = gridDim.x, bid0 = blockIdx.x; const int G = G0, bid = bid0;
    { const int tid0 = threadIdx.x; if (tid0 < 64) ((volatile LAS unsigned*)(lds + MISC_OFF))[tid0] = 0u; }
    __syncthreads();
    (void)xcd_barrier_post((unsigned*)(kargs()->ws + WS_CTL) + CW_BAR, (volatile LAS unsigned*)(lds + MISC_OFF) + 8);
#ifndef FORCE_UNGROUPED
#define FORCE_UNGROUPED 0
#endif
    const bool grouped = (G0 == 256) && !FORCE_UNGROUPED;
    if (grouped) (void)xcd_barrier_post((unsigned*)(kargs()->ws + WS_CTL) + CW_BAR + (1 + (bid0 & 7)) * XCD_BAR_WORDS, (volatile LAS unsigned*)(lds + MISC_OFF) + 10);
    {
        const int vcu = (G % 8 == 0) ? (bid % 8) * (G / 8) + bid / 8 : bid;
        prologue(kargs(), lds, vcu * NWAVES + w0, G * NWAVES, w0, pg8::pg8_lane());
        if (PROBE_DUP & 1) { WG_BAR(); prologue(kargs(), lds, vcu * NWAVES + w0, G * NWAVES, w0, pg8::pg8_lane()); }
    }
    GRID_BAR();
#ifndef GROUP_STAGGER_TICKS
#define GROUP_STAGGER_TICKS 0
#endif
    if (grouped && (bid0 & 1) && GROUP_STAGGER_TICKS > 0) { const unsigned long long t0 = __builtin_amdgcn_s_memrealtime(); while (__builtin_amdgcn_s_memrealtime() - t0 < (unsigned long long)GROUP_STAGGER_TICKS) __builtin_amdgcn_s_sleep(8); }

    for (int t = 0; t < 3 * DEPTH; ++t) {
        int G = G0, bid = bid0; asm volatile("" : "+s"(G), "+s"(bid));
        const int ng = grouped ? 8 : 1, gx = bid % ng, gy = bid / ng, Gy = G / ng;
        const int layer = t / 3, sub = t % 3;
        const int kind = (sub != 1) ? 0 : ((layer & 1) ? 2 : 1);
        const int j = layer >> 1;
        {
            unsigned char* ws = kargs()->ws;
            float* vec = (float*)(ws + WS_VEC);
            const bf16* R = (const bf16*)(ws + WS_R);
            const float* sp_in = (const float*)(ws + WS_SP) + (size_t)(t & 1) * (SP_BYTES / 4);
            if (kind == 0) {
                const int f = 2 * layer + (sub >> 1);
                pg8::Gemm g{(const bf16*)(ws + WS_R8), (const bf16*)(ws + WS_W13 + (size_t)f * NUP * D), M, NUP, D / 2}; pg8::StaticOrder S; S.init(M, NUP, G, bid);
                pg8::EpiUp E{f, t & 1};
                if (PROBE_DUP & 2048) { S.r1 = 5; pg8::gemm_phase<pg8::EpiUp, pg8::StaticOrder, true, PG8_SP2, true>(lds + RING_OFF, g, S, E, w0); LAYER_BAR(); S.r0 = 5; S.r1 = 1 << 20; }
                pg8::gemm_phase<pg8::EpiUp, pg8::StaticOrder, true, PG8_SP2, true>(lds + RING_OFF, g, S, E, w0);
                if (PROBE_DUP & 16) pg8::gemm_phase<pg8::EpiUp, pg8::StaticOrder, true, PG8_SP2, true>(lds + RING_OFF, g, S, E, w0);
                if (PROBE_DUP & 128) { pg8::EpiNull EN{(float*)(ws + WS_GATES)}; pg8::gemm_phase<pg8::EpiNull, pg8::StaticOrder, true, PG8_SP2, true>(lds + RING_OFF, g, S, EN, w0); }
            } else {
                if (kind == 2) {
                    pg8::Gemm g{R, (const bf16*)(ws + WS_WIN) + (size_t)j * NMI * D, M, NMI, D}; pg8::StaticOrder S; S.init(M, NMI, G, bid);
                    pg8::EpiLnOut E{1, j, t & 1};
                    pg8::gemm_phase<pg8::EpiLnOut, pg8::StaticOrder, true, PG8_SP2>(lds + RING_OFF, g, S, E, w0);
                    if (PROBE_DUP & 32) pg8::gemm_phase<pg8::EpiLnOut, pg8::StaticOrder, true, PG8_SP2>(lds + RING_OFF, g, S, E, w0);
                }
                if (kind == 1) {
                    const int N = kind == 1 ? NQKV : 2048;
                    pg8::Gemm g{(const bf16*)(ws + WS_R8), (const bf16*)(kind == 1 ? ws + WS_WQKV + (size_t)j * NQKV * D : ws + WS_WIN + 32 * MiB + (size_t)j * 2048 * D), M, N, D / 2}; pg8::StaticOrder S; S.init(M, N, G, bid);
                    pg8::EpiLnOut E{kind == 1 ? 0 : 2, j, t & 1};
                    pg8::gemm_phase<pg8::EpiLnOut, pg8::StaticOrder, true, PG8_SP2, true>(lds + RING_OFF, g, S, E, w0);
                    if (PROBE_DUP & 32) pg8::gemm_phase<pg8::EpiLnOut, pg8::StaticOrder, true, PG8_SP2, true>(lds + RING_OFF, g, S, E, w0);
                }
                if (kind == 2) {
                    gates_phase(lds, R, sp_in, (const bf16*)(vec + V_WG / 4) + (size_t)j * 8 * D, vec + V_CG / 4 + j * 16, (float*)(ws + WS_GATES), ng, gx, gy, Gy, w0);
                    if (PROBE_DUP & 8) { WG_BAR(); gates_phase(lds, R, sp_in, (const bf16*)(vec + V_WG / 4) + (size_t)j * 8 * D, vec + V_CG / 4 + j * 16, (float*)(ws + WS_GATES), ng, gx, gy, Gy, w0); }
                }
            }
        }
        LAYER_BAR();
        if (kind == 1) {
            if (!SKIP_ATT) { kargs_t ka = kargs(); unsigned char* ws = ka->ws; attn_phase(lds_raw, (const bf16*)(ws + WS_QKV), ws + WS_AO, ka->sinks + j * 32, ng, gx, gy, Gy, w0);
                if (PROBE_DUP & 2) attn_phase(lds_raw, (const bf16*)(ws + WS_QKV), ws + WS_AO, ka->sinks + j * 32, ng, gx, gy, Gy, w0); }
            LAYER_BAR();
        } else if (kind == 2) {
            if (!SKIP_MLSTM) { unsigned char* ws = kargs()->ws; mlstm_phase(lds_raw, (const bf16*)(ws + WS_MP), (const float*)(ws + WS_GATES), (bf16*)(ws + WS_HG), ng, gx, gy, Gy, w0);
                if (PROBE_DUP & 4) mlstm_phase<PROBE_MLV>(lds_raw, (const bf16*)(ws + WS_MP), (const float*)(ws + WS_GATES), (bf16*)(ws + WS_H), ng, gx, gy, Gy, w0); }
            LAYER_BAR();
        }
        {
            kargs_t ka = kargs(); unsigned char* ws = ka->ws;
            float coef = kind == 0 ? 0.5f / (pg8::F8_SH * pg8::F8_SW) : (kind == 1 ? 1.f / (pg8::F8_SO * pg8::F8_SW) : 1.f);
            if ((kind == 1 && SKIP_ATT) || (kind == 2 && SKIP_MLSTM)) coef = 0.f;
            pg8::StaticOrder S; S.init(M, D, G, bid);
            pg8::EpiRes E{t, coef, (LAS float*)(lds + TAB_OFF), w0, 0};
            if (kind != 2) {
                const int f = 2 * layer + (sub >> 1);
                pg8::Gemm g{(const bf16*)(ws + (kind == 0 ? WS_H : WS_AO)), (const bf16*)(kind == 0 ? ws + WS_W2 + (size_t)f * D * FF : ws + WS_WO + (size_t)j * D * D), M, D, kind == 0 ? FF / 2 : D / 2};
                if (PROBE_DUP & 64) { pg8::EpiNull EN{(float*)(ws + WS_GATES)}; pg8::gemm_phase<pg8::EpiNull, pg8::StaticOrder, true, PG8_SP2, true>(lds + RING_OFF, g, S, EN, w0); }
                if (PROBE_DUP & 512) { pg8::EpiRes ED{t, coef, (LAS float*)(lds + TAB_OFF), w0, PROBE_DRY}; pg8::gemm_phase<pg8::EpiRes, pg8::StaticOrder, true, PG8_SP2, true>(lds + RING_OFF, g, S, ED, w0); }
                pg8::gemm_phase<pg8::EpiRes, pg8::StaticOrder, true, PG8_SP2, true>(lds + RING_OFF, g, S, E, w0);
            } else {
                pg8::Gemm g{(const bf16*)(ws + WS_HG), (const bf16*)(ws + WS_WMO) + (size_t)j * D * D, M, D, D};
                if (PROBE_DUP & 256) { pg8::EpiNull EN{(float*)(ws + WS_GATES)}; pg8::gemm_phase<pg8::EpiNull, pg8::StaticOrder, true, PG8_SP2, false>(lds + RING_OFF, g, S, EN, w0); }
                pg8::gemm_phase<pg8::EpiRes, pg8::StaticOrder, true, PG8_SP2, false>(lds + RING_OFF, g, S, E, w0);
            }
        }
        LAYER_BAR();
    }
    {
        kargs_t ka = kargs(); unsigned char* ws = ka->ws;
        const int ng = grouped ? 8 : 1, gx = bid % ng, gy = bid / ng, Gy = G / ng;
        final_ln((const bf16*)(ws + WS_R), (const float*)(ws + WS_SP), ka->ln_g + (size_t)(3 * DEPTH - 1) * D, ka->ln_b + (size_t)(3 * DEPTH - 1) * D, ka->out, ng, gx, gy * NWAVES + w0, Gy * NWAVES, pg8::pg8_lane());
    }
}

extern "C" void kernel_launch(void* const* d_in, const int* in_sizes, int n_in, void* d_out, int out_size, void* d_ws, size_t ws_size, hipStream_t stream) {
    static int grid = 0;
    if (grid == 0) {
        if (n_in != 12 || in_sizes[0] != M * D || out_size != M * D || ws_size < WS_END) { fprintf(stderr, "kernel_launch: unexpected shapes / workspace (n_in %d, ws %zu < %zu); nothing launched\n", n_in, ws_size, (size_t)WS_END); grid = -1; return; }
        int dev = 0, cus = 0;
        if (hipGetDevice(&dev) != hipSuccess || hipDeviceGetAttribute(&cus, hipDeviceAttributeMultiprocessorCount, dev) != hipSuccess) { grid = -1; return; }
        if (hipFuncSetAttribute((const void*)fwd_kernel, hipFuncAttributeMaxDynamicSharedMemorySize, LDS_BYTES) != hipSuccess) { fprintf(stderr, "kernel_launch: hipFuncSetAttribute failed\n"); grid = -1; return; }
        int per_cu = 0;
        if (hipOccupancyMaxActiveBlocksPerMultiprocessor(&per_cu, (const void*)fwd_kernel, NWAVES * 64, LDS_BYTES) != hipSuccess || per_cu < 1) { fprintf(stderr, "kernel_launch: occupancy query says %d\n", per_cu); }
        (void)hipGetLastError();
        grid = cus;
#ifdef FORCE_GRID
        grid = FORCE_GRID;
#endif
    }
    if (grid < 0) return;
    (void)hipMemsetAsync((char*)d_ws + WS_CTL, 0, CTL_ZERO_BYTES, stream);
    Args a{};
    a.x = (const float*)d_in[0]; a.w1 = (const float*)d_in[1]; a.w3 = (const float*)d_in[2]; a.w2 = (const float*)d_in[3]; a.ln_g = (const float*)d_in[4]; a.ln_b = (const float*)d_in[5];
    a.wqkv = (const float*)d_in[6]; a.sinks = (const float*)d_in[7]; a.wo = (const float*)d_in[8]; a.win = (const float*)d_in[9]; a.bg = (const float*)d_in[10]; a.wmo = (const float*)d_in[11];
    a.out = (float*)d_out; a.ws = (unsigned char*)d_ws;
    hipLaunchKernelGGL(fwd_kernel, dim3(grid), dim3(NWAVES * 64), LDS_BYTES, stream, a);
}
```

```cpp
#include <hip/hip_runtime.h>
#include <hip/hip_bf16.h>
#include <cstdio>
#include <cstdint>
#include <cmath>

constexpr int BATCH = 8, SEQ = 2048, D = 2048, FF = 5632, DEPTH = 4;
constexpr int M = BATCH * SEQ;
constexpr int NUP = 2 * FF;
constexpr int NQKV = 2560;
constexpr int NMI = 6144, NMIW = 6152;
constexpr float LN_EPS = 1e-5f;
constexpr float ALPHA = 1.681792830507429f;
constexpr float LOG2E = 1.4426950408889634f;

constexpr size_t MiB = 1u << 20;
constexpr size_t WS_CTL = 0, CTL_ZERO_BYTES = 192 * 1024;
constexpr size_t WS_W13 = 2 * MiB;
constexpr size_t WS_W2 = 178 * MiB;
constexpr size_t WS_WQKV = 266 * MiB;
constexpr size_t WS_WO = 286 * MiB;
constexpr size_t WS_WIN = 302 * MiB;
constexpr size_t WS_WMO = 350 * MiB;
constexpr size_t WS_VEC = 366 * MiB;
constexpr size_t V_C1U = 0, V_C2U = 360448, V_C1Q = 720896, V_C2Q = 741376, V_C1I = 761856, V_C2I = 811008, V_CG = 860160, V_WG = 860416, V_ONES = 991488, V_ZEROS = 999680;
constexpr size_t WS_R = 368 * MiB;
constexpr size_t WS_R8 = 432 * MiB;
constexpr size_t WS_SP = 464 * MiB;
constexpr size_t SP_BYTES = (size_t)M * 16 * 4;
constexpr size_t WS_H = 466 * MiB;
constexpr size_t WS_QKV = 554 * MiB;
constexpr size_t WS_AO = 634 * MiB;
constexpr size_t WS_MP = 698 * MiB;
constexpr size_t WS_GATES = 890 * MiB;
constexpr size_t WS_HG = 891 * MiB;
constexpr size_t WS_END = 955 * MiB;
constexpr int CW_TMO = 0, CW_BAR = 4096;

struct Args { const float* x; const float* w1; const float* w3; const float* w2; const float* ln_g; const float* ln_b; const float* wqkv; const float* sinks; const float* wo;
              const float* win; const float* bg; const float* wmo; float* out; unsigned char* ws; };
typedef const __attribute__((address_space(4))) Args* kargs_t;
__device__ __forceinline__ kargs_t kargs() { kargs_t p = (kargs_t)__builtin_amdgcn_kernarg_segment_ptr(); asm volatile("" : "+s"(p)); return p; }

namespace pg8 {
#define PG8_LAS __attribute__((address_space(3)))
typedef unsigned short bf16_t;
typedef short bf16x8 __attribute__((ext_vector_type(8)));
typedef _Float16 f16x8 __attribute__((ext_vector_type(8)));
typedef float f32x4 __attribute__((ext_vector_type(4)));
typedef unsigned u32x4 __attribute__((ext_vector_type(4)));
constexpr int BM = 256, BK = 64, HALF = 128, HTB = HALF * BK * 2  , STAGE_BYTES = 8 * HTB, NXCD = 8, WGM = 8;

__host__ __device__ __forceinline__ int lds_byte(int r, int c) { const int st = (r >> 4) * 2 + (c >> 5), rr = r & 15, cc = c & 31, ob = rr * 64 + cc * 2; return st * 1024 + (ob ^ (((ob >> 9) & 1) << 5)); }
__host__ __device__ __forceinline__ void stage_rc(int b, int& R, int& C) { const int st = b / 1024, sb = b % 1024, swz = sb ^ (((sb >> 9) & 1) << 5); R = (st >> 1) * 16 + swz / 64; C = (st & 1) * 32 + (swz % 64) / 2; }
__host__ __device__ __forceinline__ int perm32(int rho) { const int n = rho >> 4, i = rho & 15; return 8 * (i >> 2) + 4 * n + (i & 3); }

typedef int i32x4 __attribute__((ext_vector_type(4)));
typedef int i32x8 __attribute__((ext_vector_type(8)));
constexpr float F8_SR = 8.f, F8_SW = 1024.f, F8_SH = 16.f, F8_SO = 64.f;
__device__ __forceinline__ i32x8 cat_i8(bf16x8 lo, bf16x8 hi) { const i32x4 a = __builtin_bit_cast(i32x4, lo), b = __builtin_bit_cast(i32x4, hi); return __builtin_shufflevector(a, b, 0, 1, 2, 3, 4, 5, 6, 7); }
__device__ __forceinline__ void mfma_f8_inplace(f32x4& c, const i32x8 a, const i32x8 b) { asm volatile("v_mfma_f32_16x16x128_f8f6f4 %0, %1, %2, %0 cbsz:0 blgp:0" : "+v"(c) : "v"(a), "v"(b)); }
typedef unsigned u32x2 __attribute__((ext_vector_type(2)));
__device__ __forceinline__ u32x2 cvt8_f8(const float (&v)[8], float s) {
    int a, b; asm volatile("" : "=v"(a), "=v"(b));
    a = __builtin_amdgcn_cvt_pk_fp8_f32(v[0] * s, v[1] * s, a, false); a = __builtin_amdgcn_cvt_pk_fp8_f32(v[2] * s, v[3] * s, a, true);
    b = __builtin_amdgcn_cvt_pk_fp8_f32(v[4] * s, v[5] * s, b, false); b = __builtin_amdgcn_cvt_pk_fp8_f32(v[6] * s, v[7] * s, b, true);
    return (u32x2){(unsigned)a, (unsigned)b};
}
__device__ __forceinline__ int pg8_lane() { int l; asm volatile("v_mbcnt_lo_u32_b32 %0, -1, 0\n\tv_mbcnt_hi_u32_b32 %0, -1, %0" : "=v"(l)); return l; }
struct Unit { int pm, pn, ord; };
struct Gemm { const bf16_t* A; const bf16_t* Bt; int M, N, K; };

struct StaticOrder {
    int nM, nN, nwg, G, c, r0 = 0, r1 = 1 << 20;
    __host__ __device__ void init(int M_, int N_, int G_, int c_) { nM = M_ / BM; nN = N_ / BM; nwg = nM * nN; G = G_; c = c_; }
    __host__ __device__ bool next(int i, Unit& u) const {
        i += r0; if (i >= r1) return false;
        const long L = (long)i * G + c; if (L >= nwg) return false;
        int wgid = (int)L; { const int q = nwg / NXCD, r = nwg % NXCD, xcd = wgid % NXCD, off = wgid / NXCD; wgid = (xcd < r ? xcd * (q + 1) : r * (q + 1) + (xcd - r) * q) + off; }
        const int nig = WGM * nN, gid = wgid / nig, fm = gid * WGM, gsz = (nM - fm) < WGM ? (nM - fm) : WGM;
        u.pm = fm + ((wgid % nig) % gsz); u.pn = (wgid % nig) / gsz; u.ord = i - r0; return true;
    }
    __device__ __forceinline__ void a_ready(const Unit&) const {}
    __device__ __forceinline__ void done(const Unit&) const {}
};

__device__ __forceinline__ unsigned cvt_pk_bf16(float lo, float hi) { typedef float f2 __attribute__((ext_vector_type(2))); typedef _Float16 b2 __attribute__((ext_vector_type(2))); f2 v = {lo, hi}; b2 b = __builtin_convertvector(v, b2); return __builtin_bit_cast(unsigned, b); }
__device__ __forceinline__ float bf_lo(unsigned w) { typedef _Float16 b2 __attribute__((ext_vector_type(2))); return (float)__builtin_bit_cast(b2, w)[0]; }
__device__ __forceinline__ float bf_hi(unsigned w) { typedef _Float16 b2 __attribute__((ext_vector_type(2))); return (float)__builtin_bit_cast(b2, w)[1]; }
__device__ __forceinline__ float fsigmoid(float x) { return __builtin_amdgcn_rcpf(1.f + __builtin_amdgcn_exp2f(-LOG2E * x)); }

__device__ __forceinline__ float sum_fq(float v) {
    auto a = __builtin_amdgcn_permlane16_swap(__float_as_uint(v), __float_as_uint(v), false, false); v = __uint_as_float(a[0]) + __uint_as_float(a[1]);
    auto b = __builtin_amdgcn_permlane32_swap(__float_as_uint(v), __float_as_uint(v), false, false); return __uint_as_float(b[0]) + __uint_as_float(b[1]);
}
constexpr int STAB_OFF = 131072 + 16384;
__device__ __forceinline__ void stats_prep(const float* sp, int pm, int wave) {
    PG8_LAS float* stab = (PG8_LAS float*)(STAB_OFF);
    const int tid = wave * 64 + pg8_lane();
    if (tid < BM) {
        const f32x4* p = (const f32x4*)(sp + (size_t)(pm * BM + tid) * 16);
        const f32x4 v0 = p[0], v1 = p[1], v2 = p[2], v3 = p[3];
        const float s = ((v0[0] + v0[2]) + (v1[0] + v1[2])) + ((v2[0] + v2[2]) + (v3[0] + v3[2])), q = ((v0[1] + v0[3]) + (v1[1] + v1[3])) + ((v2[1] + v2[3]) + (v3[1] + v3[3]));
        const float mean = s * (1.f / D), var = q * (1.f / D) - mean * mean;
        typedef float f32x2v __attribute__((ext_vector_type(2)));
        *(PG8_LAS f32x2v*)(stab + 2 * tid) = (f32x2v){mean, __builtin_amdgcn_rsqf(var + LN_EPS)};
    }
    if (tid == 0) *(PG8_LAS int*)(stab + 2 * BM) = pm;
}
constexpr int CTAB_OFF = STAB_OFF + 2048 + 64, CTAB_UNITS = 11;
template <class Sched> __device__ __forceinline__ void ctab_prep(const Sched& S, const float* c1, const float* c2, int wave) {
    const int tid = wave * 64 + pg8_lane();
    Unit u;
    for (int i = 0; i < CTAB_UNITS && S.next(i, u); ++i) {
        const float v = tid < BM ? c1[u.pn * BM + tid] : c2[u.pn * BM + tid - BM];
        typedef _Float16 h1;
        *(PG8_LAS h1*)(CTAB_OFF + i * 1024 + tid * 2) = (h1)v;
    }
}
__device__ __forceinline__ void ctab_get8(int ord, int which, int lc, float (&o)[8]) {
    typedef _Float16 h8 __attribute__((ext_vector_type(8)));
    const h8 v = *(PG8_LAS const h8*)(CTAB_OFF + ord * 1024 + which * 512 + lc * 2);
#pragma unroll
    for (int i = 0; i < 8; ++i) o[i] = (float)v[i];
}
__device__ __forceinline__ void row_stats(const float* sp, int row0, int fq, float (&mu)[2][4], float (&rs)[2][4]) {
    { PG8_LAS const float* stab = (PG8_LAS const float*)(STAB_OFF); const int pm = row0 / BM;
      if (*(PG8_LAS const int*)(stab + 2 * BM) == pm) {
          typedef float f32x2v __attribute__((ext_vector_type(2)));
#pragma unroll
          for (int ai = 0; ai < 2; ++ai)
#pragma unroll
              for (int m = 0; m < 4; ++m) { const f32x2v v = *(PG8_LAS const f32x2v*)(stab + 2 * ((row0 % BM) + ai * HALF + m * 16)); mu[ai][m] = v[0]; rs[ai][m] = v[1]; }
          return; } }
#pragma unroll
    for (int ai = 0; ai < 2; ++ai)
#pragma unroll
        for (int m = 0; m < 4; ++m) {
            const f32x4 v = *(const f32x4*)(sp + (size_t)(row0 + ai * HALF + m * 16) * 16 + fq * 4);
            float s = v[0] + v[2], q = v[1] + v[3];
            s = sum_fq(s); q = sum_fq(q);
            const float mean = s * (1.f / D), var = q * (1.f / D) - mean * mean;
            mu[ai][m] = mean; rs[ai][m] = __builtin_amdgcn_rsqf(var + LN_EPS);
        }
}

struct EpiNull {
    static constexpr bool PERM = true, AFTER_DRAIN = false;
    template <class Sched> __device__ __forceinline__ void prep(const Sched&, const Unit&, int) const {}
    float* sink;
    __device__ __forceinline__ void operator()(const f32x4 (&acc)[2][2][4][2], const Unit& u, int wr, int wc, int, int) const {
        float s = 0.f;
#pragma unroll
        for (int ai = 0; ai < 2; ++ai)
#pragma unroll
            for (int bj = 0; bj < 2; ++bj)
#pragma unroll
                for (int m = 0; m < 4; ++m)
#pragma unroll
                    for (int n = 0; n < 2; ++n) s += acc[ai][bj][m][n][0] + acc[ai][bj][m][n][1] + acc[ai][bj][m][n][2] + acc[ai][bj][m][n][3];
        if (s == 123.456f) sink[u.pm + wr + wc] = s;
    }
};

struct EpiUp {
    static constexpr bool PERM = true, AFTER_DRAIN = false;
    template <class Sched> __device__ __forceinline__ void prep(const Sched& S, const Unit& u, int wave) const { unsigned char* ws = kargs()->ws;
        stats_prep((const float*)(ws + WS_SP) + (size_t)tpar * (SP_BYTES / 4), u.pm, wave);
        ctab_prep(S, (const float*)(ws + WS_VEC + V_C1U) + (size_t)f * NUP, (const float*)(ws + WS_VEC + V_C2U) + (size_t)f * NUP, wave); }
    int f, tpar;
    __device__ __forceinline__ void operator()(const f32x4 (&acc)[2][2][4][2], const Unit& u, int wr, int wc, int, int) const {
        const int lane_ = pg8_lane(), fr = lane_ & 15, fq = lane_ >> 4;
        const int row0 = u.pm * BM + wr * 64 + fr;
        int f = this->f, tpar = this->tpar; asm volatile("" : "+s"(f), "+s"(tpar));
        unsigned char* ws = kargs()->ws; unsigned char* H = ws + WS_H;
        const float* c1 = (const float*)(ws + WS_VEC + V_C1U) + (size_t)f * NUP; const float* c2 = (const float*)(ws + WS_VEC + V_C2U) + (size_t)f * NUP; const float* sp = (const float*)(ws + WS_SP) + (size_t)tpar * (SP_BYTES / 4);
        float mu[2][4], rs[2][4]; row_stats(sp, row0, fq, mu, rs);
        const int cb = u.pn * BM + wc * 32 + 8 * fq;
        float k1[2][8], k2[2][8];
        if (u.ord < CTAB_UNITS) {
#pragma unroll
            for (int bj = 0; bj < 2; ++bj) { ctab_get8(u.ord, 0, wc * 32 + 8 * fq + bj * HALF, k1[bj]); ctab_get8(u.ord, 1, wc * 32 + 8 * fq + bj * HALF, k2[bj]); }
        } else {
#pragma unroll
            for (int bj = 0; bj < 2; ++bj)
#pragma unroll
                for (int i = 0; i < 8; ++i) { k1[bj][i] = c1[cb + bj * HALF + i]; k2[bj][i] = c2[cb + bj * HALF + i]; }
        }
        unsigned char* hp = H + (size_t)row0 * FF + u.pn * HALF + wc * 32 + 8 * fq;
#pragma unroll
        for (int ai = 0; ai < 2; ++ai)
#pragma unroll
            for (int m = 0; m < 4; ++m) {
                const float r_ = rs[ai][m], nm = -mu[ai][m] * r_, ra = r_ * (1.f / (F8_SR * F8_SW));
                typedef float f2 __attribute__((ext_vector_type(2)));
                f2 ga[4], ub[4], sg[4];
#pragma unroll
                for (int n = 0; n < 2; ++n)
#pragma unroll
                    for (int jj = 0; jj < 2; ++jj) {
                        const int c = 4 * n + 2 * jj;
                        const f2 ag = {acc[ai][0][m][n][2 * jj], acc[ai][0][m][n][2 * jj + 1]}, au = {acc[ai][1][m][n][2 * jj], acc[ai][1][m][n][2 * jj + 1]};
                        const f2 k1g = {k1[0][c], k1[0][c + 1]}, k2g = {k2[0][c], k2[0][c + 1]}, k1u = {k1[1][c], k1[1][c + 1]}, k2u = {k2[1][c], k2[1][c + 1]};
                        ga[2 * n + jj] = ag * ra + (k1g * nm + k2g);
                        ub[2 * n + jj] = au * ra + (k1u * nm + k2u);
                    }
#pragma unroll
                for (int i = 0; i < 4; ++i) { const f2 t = ga[i] * (-LOG2E); sg[i] = (f2){__builtin_amdgcn_exp2f(t[0]), __builtin_amdgcn_exp2f(t[1])}; }
#pragma unroll
                for (int i = 0; i < 4; ++i) { const f2 t = sg[i] + 1.f; sg[i] = (f2){__builtin_amdgcn_rcpf(t[0]), __builtin_amdgcn_rcpf(t[1])}; }
                float hv[8];
#pragma unroll
                for (int i = 0; i < 4; ++i) { const f2 h2 = ga[i] * sg[i] * ub[i]; hv[2 * i] = h2[0]; hv[2 * i + 1] = h2[1]; }
                *(u32x2*)(hp + (size_t)(ai * HALF + m * 16) * FF) = cvt8_f8(hv, F8_SH);
            }
    }
};

struct EpiLnOut {
    static constexpr bool PERM = true, AFTER_DRAIN = false;
    template <class Sched> __device__ __forceinline__ void prep(const Sched&, const Unit& u, int wave) const { stats_prep((const float*)(kargs()->ws + WS_SP) + (size_t)tpar * (SP_BYTES / 4), u.pm, wave); }
    int mode, j, tpar;
    __device__ __forceinline__ void operator()(const f32x4 (&acc)[2][2][4][2], const Unit& u, int wr, int wc, int, int) const {
        const int lane_ = pg8_lane(), fr = lane_ & 15, fq = lane_ >> 4;
        const int row0 = u.pm * BM + wr * 64 + fr;
        int mode = this->mode, j = this->j, tpar = this->tpar; asm volatile("" : "+s"(mode), "+s"(j), "+s"(tpar));
        const bool att = mode == 0; const int coff = mode == 2 ? 4096 : 0;
        unsigned char* ws = kargs()->ws; bf16_t* O = (bf16_t*)(ws + (att ? WS_QKV : WS_MP)) + coff; const int ldo = att ? NQKV : NMI, sig_from = mode == 2 ? 0 : (mode == 1 ? 16 : 1000);
        const float ascale = mode == 1 ? 1.f : 1.f / (F8_SR * F8_SW);
        const float* c1 = (const float*)(ws + WS_VEC + (att ? V_C1Q : V_C1I)) + j * ldo + coff; const float* c2 = (const float*)(ws + WS_VEC + (att ? V_C2Q : V_C2I)) + j * ldo + coff; const float* sp = (const float*)(ws + WS_SP) + (size_t)tpar * (SP_BYTES / 4);
        float mu[2][4], rs[2][4]; row_stats(sp, row0, fq, mu, rs);
        const int cb = u.pn * BM + wc * 32 + 8 * fq;
        const bool sg = u.pn >= sig_from;
        f32x4 k1[2][2], k2[2][2];
#pragma unroll
        for (int bj = 0; bj < 2; ++bj)
#pragma unroll
            for (int n = 0; n < 2; ++n) { k1[bj][n] = *(const f32x4*)(c1 + cb + bj * HALF + 4 * n); k2[bj][n] = *(const f32x4*)(c2 + cb + bj * HALF + 4 * n); }
        bf16_t* op = O + (size_t)row0 * ldo + cb;
#define LNOUT_ROWS(SIG) _Pragma("unroll") for (int ai = 0; ai < 2; ++ai) _Pragma("unroll") for (int m = 0; m < 4; ++m) { \
            const float r_ = rs[ai][m], nm = -mu[ai][m] * r_, ra = r_ * ascale; \
            _Pragma("unroll") for (int bj = 0; bj < 2; ++bj) { \
                typedef float f2 __attribute__((ext_vector_type(2))); float v[8]; \
                _Pragma("unroll") for (int n = 0; n < 2; ++n) _Pragma("unroll") for (int jj = 0; jj < 2; ++jj) { \
                    const f2 a2 = {acc[ai][bj][m][n][2 * jj], acc[ai][bj][m][n][2 * jj + 1]}, c1v = {k1[bj][n][2 * jj], k1[bj][n][2 * jj + 1]}, c2v = {k2[bj][n][2 * jj], k2[bj][n][2 * jj + 1]}; \
                    f2 t = a2 * ra + (c1v * nm + c2v); \
                    if (SIG) { const f2 e = t * (-LOG2E); const f2 d = (f2){__builtin_amdgcn_exp2f(e[0]), __builtin_amdgcn_exp2f(e[1])} + 1.f; t = (f2){__builtin_amdgcn_rcpf(d[0]), __builtin_amdgcn_rcpf(d[1])}; } \
                    v[4 * n + 2 * jj] = t[0]; v[4 * n + 2 * jj + 1] = t[1]; } \
                u32x4 w; w.x = cvt_pk_bf16(v[0], v[1]); w.y = cvt_pk_bf16(v[2], v[3]); w.z = cvt_pk_bf16(v[4], v[5]); w.w = cvt_pk_bf16(v[6], v[7]); \
                *(u32x4*)(op + (size_t)(ai * HALF + m * 16) * ldo + bj * HALF) = w; } }
        const int sgi = __builtin_amdgcn_readfirstlane(sg ? 1 : 0);
        if (sgi) { LNOUT_ROWS(true) } else { LNOUT_ROWS(false) }
#undef LNOUT_ROWS
    }
};

struct EpiRes {
    static constexpr bool PERM = true, AFTER_DRAIN = false;
    template <class Sched> __device__ __forceinline__ void prep(const Sched&, const Unit& u, int wave) const { stats_prep((const float*)(kargs()->ws + WS_SP) + (size_t)(t & 1) * (SP_BYTES / 4), u.pm, wave); }
    int t; float coef; PG8_LAS float* tab; int wave; int dry;
    __device__ __forceinline__ void operator()(const f32x4 (&acc)[2][2][4][2], const Unit& u, int wr, int wc, int, int) const {
        const int lane_ = pg8_lane(), fr = lane_ & 15, fq = lane_ >> 4;
        typedef float f32x2v __attribute__((ext_vector_type(2)));
        const int row0 = u.pm * BM + wr * 64 + fr;
        int t = this->t; asm volatile("" : "+s"(t)); float coef = this->coef; asm volatile("" : "+v"(coef));
        const bool need8 = (t != 3 && t != 9 && t != 11) || dry;
        kargs_t ka = kargs(); unsigned char* ws = ka->ws; bf16_t* R = (bf16_t*)(ws + WS_R); unsigned char* R8 = ws + (dry ? WS_MP + 64 * MiB : WS_R8); bf16_t* Ro = dry ? (bf16_t*)(ws + WS_MP) : R;
        const float* g = t ? ka->ln_g + (size_t)(t - 1) * D : (const float*)(ws + WS_VEC + V_ONES); const float* b = t ? ka->ln_b + (size_t)(t - 1) * D : (const float*)(ws + WS_VEC + V_ZEROS);
        const float* sp_in = (const float*)(ws + WS_SP) + (size_t)(t & 1) * (SP_BYTES / 4); float* sp_out = dry ? (float*)(ws + WS_MP + 96 * MiB) : (float*)(ws + WS_SP) + (size_t)((t + 1) & 1) * (SP_BYTES / 4);
        const int cb0 = u.pn * BM + wc * 32 + 8 * fq;
        u32x4 cur[4];
#pragma unroll
        for (int m = 0; m < 4; ++m) cur[m] = *(const u32x4*)(R + (size_t)(row0 + m * 16) * D + cb0);
        float mu[2][4], rs[2][4]; row_stats(sp_in, row0, fq, mu, rs);
        f32x4 gv[2], bv[2];
#pragma unroll
        for (int k = 0; k < 4; ++k) {
            const int bj = k >> 1, ai = k & 1, cb = cb0 + bj * HALF;
            if (ai == 0) {
#pragma unroll
                for (int n = 0; n < 2; ++n) { gv[n] = *(const f32x4*)(g + cb + 4 * n); bv[n] = *(const f32x4*)(b + cb + 4 * n) * ALPHA; }
            }
#pragma unroll
            for (int m = 0; m < 4; ++m) {
                const float A_ = ALPHA * rs[ai][m], B_ = -mu[ai][m] * A_;
                const size_t off = (size_t)(row0 + ai * HALF + m * 16) * D + cb;
                const u32x4 o = cur[m];
                if (k < 3 && dry != 3) cur[m] = *(const u32x4*)(R + (size_t)(row0 + ((k + 1) & 1) * HALF + m * 16) * D + cb0 + ((k + 1) >> 1) * HALF);
                typedef float fv2 __attribute__((ext_vector_type(2)));
                float nv[8];
#pragma unroll
                for (int n = 0; n < 2; ++n)
#pragma unroll
                    for (int jj = 0; jj < 2; ++jj) {
                        const unsigned w2 = n == 0 ? (jj == 0 ? o.x : o.y) : (jj == 0 ? o.z : o.w); const fv2 r2 = {bf_lo(w2), bf_hi(w2)}, a2 = {acc[ai][bj][m][n][2 * jj], acc[ai][bj][m][n][2 * jj + 1]};
                        const fv2 g2 = {gv[n][2 * jj], gv[n][2 * jj + 1]}, b2 = {bv[n][2 * jj], bv[n][2 * jj + 1]};
                        const fv2 t = (r2 * A_ + B_) * g2 + (a2 * coef + b2);
                        nv[4 * n + 2 * jj] = t[0]; nv[4 * n + 2 * jj + 1] = t[1];
                    }
                u32x4 w; w.x = cvt_pk_bf16(nv[0], nv[1]); w.y = cvt_pk_bf16(nv[2], nv[3]); w.z = cvt_pk_bf16(nv[4], nv[5]); w.w = cvt_pk_bf16(nv[6], nv[7]);
                if (dry != 2) { *(u32x4*)(Ro + off) = w;
                if (need8) *(u32x2*)(R8 + off) = cvt8_f8(nv, F8_SR); }
                const float f0 = bf_lo(w.x), f1 = bf_hi(w.x), f2 = bf_lo(w.y), f3 = bf_hi(w.y), f4 = bf_lo(w.z), f5 = bf_hi(w.z), f6 = bf_lo(w.w), f7 = bf_hi(w.w);
                float s = ((f0 + f1) + (f2 + f3)) + ((f4 + f5) + (f6 + f7));
                float q = ((f0 * f0 + f1 * f1) + (f2 * f2 + f3 * f3)) + ((f4 * f4 + f5 * f5) + (f6 * f6 + f7 * f7));
                s = sum_fq(s); q = sum_fq(q);
                if (fq == 0) *(PG8_LAS f32x2v*)(tab + (((ai * HALF + wr * 64 + m * 16 + fr) * 4 + wc) * 2 + bj) * 2) = (f32x2v){s, q};
                asm volatile("" ::: "memory");
            }
        }
        asm volatile("s_waitcnt lgkmcnt(0)" ::: "memory"); __builtin_amdgcn_s_barrier(); asm volatile("" ::: "memory");
        const int tid = wave * 64 + pg8_lane();
        if (tid < BM) {
            const PG8_LAS f32x4* t4 = (const PG8_LAS f32x4*)(tab + tid * 16);
            const f32x4 a = t4[0], c = t4[1], d = t4[2], e = t4[3];
            *(f32x2v*)(sp_out + (size_t)(u.pm * BM + tid) * 16 + u.pn * 2) = (f32x2v){((a[0] + a[2]) + (c[0] + c[2])) + ((d[0] + d[2]) + (e[0] + e[2])), ((a[1] + a[3]) + (c[1] + c[3])) + ((d[1] + d[3]) + (e[1] + e[3]))};
        }
    }
};

template <class Epi, class Sched, bool ALIGN_EPI = false, bool SP2 = false, bool F8 = false>
__device__ __forceinline__ void gemm_phase(PG8_LAS unsigned char* lds, const Gemm g, const Sched& S, const Epi& E, int wave_in) {
    int wid = wave_in; asm volatile("" : "+s"(wid));
    const int lane = pg8_lane(), tid = wid * 64 + lane, wr = wid >> 2, wc = wid & 3, fr = lane & 15, fq = lane >> 4;
    const int K = g.K, nt = K / BK;
    unsigned voffA[2], voffB[2];
#pragma unroll
    for (int i = 0; i < 2; ++i) { int R, C; stage_rc(tid * 16 + i * 8192, R, C); const int Rb = Epi::PERM ? ((R & ~31) + perm32(R & 31)) : R;
        voffA[i] = (unsigned)(R * K + C) * 2u; voffB[i] = (unsigned)(Rb * K + C) * 2u; }
    const size_t kstep = (size_t)(BK * 2);
    const size_t hstep = (size_t)HALF * K * 2;
    const size_t tstep = 2 * hstep;
    const unsigned ldsw = (unsigned)wid * 1024u;
    const int aoff = lds_byte(wr * 64 + fr, fq * 8), boff = lds_byte(wc * 32 + fr, fq * 8);
#define PG8_SA(b, h) (((b) * 2 + (h)) * HTB)
#define PG8_SB(b, h) ((4 + (b) * 2 + (h)) * HTB)
#define PG8_STAGE(bufoff, gbase, voff) do { _Pragma("unroll") for (int _i = 0; _i < 2; ++_i) \
        __builtin_amdgcn_global_load_lds((const unsigned*)((const char*)(gbase) + (voff)[_i]), (PG8_LAS unsigned*)(lds + (bufoff) + ldsw + _i * 8192), 16, 0, 0); } while (0)
#define PG8_LDA(dst, b, h) do { _Pragma("unroll") for (int m = 0; m < 4; ++m) _Pragma("unroll") for (int k = 0; k < 2; ++k) dst[m][k] = *(const PG8_LAS bf16x8*)(lds + PG8_SA(b, h) + aoff + m * 2048 + k * 1024); } while (0)
#define PG8_LDB(dst, b, h) do { _Pragma("unroll") for (int n = 0; n < 2; ++n) _Pragma("unroll") for (int k = 0; k < 2; ++k) dst[n][k] = *(const PG8_LAS bf16x8*)(lds + PG8_SB(b, h) + boff + n * 2048 + k * 1024); } while (0)
#define PG8_MMA(ai, bj, At, Bt) do { __builtin_amdgcn_s_setprio(1); _Pragma("unroll") for (int m = 0; m < 4; ++m) _Pragma("unroll") for (int n = 0; n < 2; ++n) { \
        if constexpr (F8) mfma_f8_inplace(acc[ai][bj][m][n], cat_i8(Bt[n][0], Bt[n][1]), cat_i8(At[m][0], At[m][1])); \
        else { _Pragma("unroll") for (int k = 0; k < 2; ++k) acc[ai][bj][m][n] = __builtin_amdgcn_mfma_f32_16x16x32_f16(__builtin_bit_cast(f16x8, Bt[n][k]), __builtin_bit_cast(f16x8, At[m][k]), acc[ai][bj][m][n], 0, 0, 0); } } \
        __builtin_amdgcn_s_setprio(0); } while (0)
#define PG8_WAIT_V(n) asm volatile("s_waitcnt vmcnt(" #n ")" ::: "memory")
#define PG8_WAIT_L(n) asm volatile("s_waitcnt lgkmcnt(" #n ")" ::: "memory")
#define PG8_BAR __builtin_amdgcn_s_barrier()
#define PG8_SCHED __builtin_amdgcn_sched_barrier(0)
    Unit cur, nxt; int ui = 0;
    if (!S.next(0, cur)) return;
    f32x4 acc[2][2][4][2];
#pragma unroll
    for (int a = 0; a < 2; ++a)
#pragma unroll
        for (int b = 0; b < 2; ++b)
#pragma unroll
            for (int m = 0; m < 4; ++m)
#pragma unroll
                for (int n = 0; n < 2; ++n) { float z0, z1, z2, z3; asm volatile("v_mov_b32 %0, 0\n\tv_mov_b32 %1, 0\n\tv_mov_b32 %2, 0\n\tv_mov_b32 %3, 0" : "=v"(z0), "=v"(z1), "=v"(z2), "=v"(z3)); acc[a][b][m][n] = (f32x4){z0, z1, z2, z3}; }
    bf16x8 At[4][2], B0[2][2], B1[2][2];
    const char* cA = (const char*)g.A + (size_t)cur.pm * tstep; const char* cB = (const char*)g.Bt + (size_t)cur.pn * tstep;
    S.a_ready(cur);
    if constexpr (SP2) {
        PG8_STAGE(PG8_SB(0, 0), cB, voffB); PG8_STAGE(PG8_SB(0, 1), cB + hstep, voffB); PG8_STAGE(PG8_SA(0, 0), cA, voffA); PG8_STAGE(PG8_SA(0, 1), cA + hstep, voffA);
        E.prep(S, cur, wave_in);
        if (wr == 1) PG8_BAR;
        PG8_WAIT_V(2); PG8_BAR;
        PG8_STAGE(PG8_SB(1, 0), cB + kstep, voffB); PG8_STAGE(PG8_SA(1, 0), cA + kstep, voffA); PG8_STAGE(PG8_SB(1, 1), cB + hstep + kstep, voffB);
        PG8_WAIT_V(6); PG8_BAR;
    } else {
        PG8_STAGE(PG8_SB(0, 0), cB, voffB); PG8_STAGE(PG8_SA(0, 0), cA, voffA); PG8_STAGE(PG8_SB(0, 1), cB + hstep, voffB); PG8_STAGE(PG8_SA(0, 1), cA + hstep, voffA);
        E.prep(S, cur, wave_in);
        if (wr == 1) PG8_BAR;
        PG8_WAIT_V(4); PG8_BAR;
        PG8_STAGE(PG8_SB(1, 0), cB + kstep, voffB); PG8_STAGE(PG8_SA(1, 0), cA + kstep, voffA); PG8_STAGE(PG8_SB(1, 1), cB + hstep + kstep, voffB);
        PG8_WAIT_V(6); PG8_BAR;
    }
    for (;;) {
        const bool has_next = S.next(ui + 1, nxt);
        const char* nA = has_next ? (const char*)g.A + (size_t)nxt.pm * tstep : cA; const char* nB = has_next ? (const char*)g.Bt + (size_t)nxt.pn * tstep : cB;
        for (int t = 0; t < nt; t += 2) {
            const bool last = (t == nt - 2);
            const char* a1 = cA + (size_t)(t + 1) * kstep;
            const char* a2 = last ? nA : cA + (size_t)(t + 2) * kstep; const char* b2 = last ? nB : cB + (size_t)(t + 2) * kstep;
            const char* a3 = a2 + kstep; const char* b3 = b2 + kstep;
            if (last && has_next) S.a_ready(nxt);
            if constexpr (SP2) {
            PG8_LDB(B0, 0, 0); PG8_LDB(B1, 0, 1); PG8_SCHED; PG8_LDA(At, 0, 0); PG8_STAGE(PG8_SA(1, 1), a1 + hstep, voffA);
            PG8_WAIT_V(8); PG8_WAIT_L(0); PG8_BAR; PG8_MMA(0, 0, At, B0); PG8_MMA(0, 1, At, B1); PG8_BAR; PG8_SCHED;
            PG8_LDA(At, 0, 1); PG8_STAGE(PG8_SB(0, 0), b2, voffB); PG8_STAGE(PG8_SB(0, 1), b2 + hstep, voffB); PG8_STAGE(PG8_SA(0, 0), a2, voffA);
            PG8_WAIT_V(8); PG8_WAIT_L(0); PG8_BAR; PG8_MMA(1, 0, At, B0); PG8_MMA(1, 1, At, B1); PG8_BAR; PG8_SCHED;
            PG8_LDB(B0, 1, 0); PG8_LDB(B1, 1, 1); PG8_SCHED; PG8_LDA(At, 1, 0); PG8_STAGE(PG8_SA(0, 1), a2 + hstep, voffA);
            PG8_WAIT_V(8); PG8_WAIT_L(0); PG8_BAR; PG8_MMA(0, 0, At, B0); PG8_MMA(0, 1, At, B1); PG8_BAR; PG8_SCHED;
            PG8_LDA(At, 1, 1); PG8_STAGE(PG8_SB(1, 0), b3, voffB); PG8_STAGE(PG8_SB(1, 1), b3 + hstep, voffB); PG8_STAGE(PG8_SA(1, 0), a3, voffA);
            PG8_WAIT_V(8); PG8_WAIT_L(0); PG8_BAR; PG8_MMA(1, 0, At, B0); PG8_MMA(1, 1, At, B1); PG8_BAR; PG8_SCHED;
            } else {
            PG8_LDB(B0, 0, 0); PG8_SCHED; PG8_LDA(At, 0, 0); PG8_STAGE(PG8_SA(1, 1), a1 + hstep, voffA);
            PG8_WAIT_L(8); PG8_BAR; PG8_WAIT_L(0); PG8_MMA(0, 0, At, B0); PG8_BAR; PG8_SCHED;
            PG8_LDB(B1, 0, 1); PG8_STAGE(PG8_SB(0, 0), b2, voffB);
            PG8_BAR; PG8_WAIT_L(0); PG8_MMA(0, 1, At, B1); PG8_BAR;
            PG8_LDA(At, 0, 1); PG8_STAGE(PG8_SA(0, 0), a2, voffA);
            PG8_BAR; PG8_WAIT_L(0); PG8_MMA(1, 0, At, B0); PG8_BAR; PG8_SCHED;
            PG8_STAGE(PG8_SB(0, 1), b2 + hstep, voffB);
            PG8_WAIT_V(6); PG8_BAR; PG8_MMA(1, 1, At, B1); PG8_BAR;
            PG8_LDB(B0, 1, 0); PG8_SCHED; PG8_LDA(At, 1, 0); PG8_STAGE(PG8_SA(0, 1), a2 + hstep, voffA);
            PG8_WAIT_L(8); PG8_BAR; PG8_WAIT_L(0); PG8_MMA(0, 0, At, B0); PG8_BAR; PG8_SCHED;
            PG8_LDB(B1, 1, 1); PG8_STAGE(PG8_SB(1, 0), b3, voffB);
            PG8_BAR; PG8_WAIT_L(0); PG8_MMA(0, 1, At, B1); PG8_BAR;
            PG8_LDA(At, 1, 1); PG8_STAGE(PG8_SA(1, 0), a3, voffA);
            PG8_BAR; PG8_WAIT_L(0); PG8_MMA(1, 0, At, B0); PG8_BAR; PG8_SCHED;
            PG8_STAGE(PG8_SB(1, 1), b3 + hstep, voffB);
            PG8_WAIT_V(6); PG8_BAR; PG8_MMA(1, 1, At, B1); PG8_BAR;
            }
        }
        if constexpr (F8) asm volatile("s_nop 15\n\ts_nop 7" ::: "memory");
        if constexpr (ALIGN_EPI) { if (wr == 0) PG8_BAR; }
        if constexpr (!Epi::AFTER_DRAIN) { E(acc, cur, wr, wc, fr, fq); S.done(cur); }
        if (!has_next) break;
#pragma unroll
        for (int a = 0; a < 2; ++a)
#pragma unroll
            for (int b = 0; b < 2; ++b)
#pragma unroll
                for (int m = 0; m < 4; ++m)
#pragma unroll
                    for (int n = 0; n < 2; ++n) { float z0, z1, z2, z3; asm volatile("v_mov_b32 %0, 0\n\tv_mov_b32 %1, 0\n\tv_mov_b32 %2, 0\n\tv_mov_b32 %3, 0" : "=v"(z0), "=v"(z1), "=v"(z2), "=v"(z3)); acc[a][b][m][n] = (f32x4){z0, z1, z2, z3}; }
        cur = nxt; cA = nA; cB = nB; ++ui;
        if constexpr (ALIGN_EPI) { if (wr == 1) PG8_BAR; }
    }
    PG8_WAIT_V(0);
    if constexpr (!ALIGN_EPI) { if (wr == 0) PG8_BAR; }
    PG8_BAR;
    if constexpr (Epi::AFTER_DRAIN) { E.fused(acc, cur, wr, wc, fr, fq, lds, wid, lane); S.done(cur); }
#undef PG8_SA
#undef PG8_SB
#undef PG8_STAGE
#undef PG8_LDA
#undef PG8_LDB
#undef PG8_MMA
#undef PG8_WAIT_V
#undef PG8_WAIT_L
#undef PG8_BAR
#undef PG8_SCHED
}
}

#ifndef PG8_SP2
#define PG8_SP2 true
#endif

#define GAS __attribute__((address_space(1)))
#define LAS __attribute__((address_space(3)))
typedef unsigned short bf16;
typedef unsigned v4u __attribute__((ext_vector_type(4)));
typedef unsigned v2u __attribute__((ext_vector_type(2)));
typedef float f32x4 __attribute__((ext_vector_type(4)));
typedef float f32x2 __attribute__((ext_vector_type(2)));
typedef float f32x16 __attribute__((ext_vector_type(16)));
typedef short bf16x8 __attribute__((ext_vector_type(8)));
typedef short s16x4 __attribute__((ext_vector_type(4)));
typedef GAS unsigned gu32;
typedef GAS unsigned long long gu64;
typedef LAS const char* lcp;
typedef LAS char* lwp;
#define RLX_AGENT __ATOMIC_RELAXED, __HIP_MEMORY_SCOPE_AGENT
#define LDS_WAIT() asm volatile("s_waitcnt lgkmcnt(0)" ::: "memory")
#define VM_WAIT() asm volatile("s_waitcnt vmcnt(0)" ::: "memory")
#define WG_BAR() do { asm volatile("s_waitcnt vmcnt(0) lgkmcnt(0)" ::: "memory"); __builtin_amdgcn_s_barrier(); asm volatile("" ::: "memory"); } while (0)
#define DI __device__ __forceinline__
#define MFMA32(a, b, c) __builtin_amdgcn_mfma_f32_32x32x16_f16(__builtin_bit_cast(pg8::f16x8, (a)), __builtin_bit_cast(pg8::f16x8, (b)), (c), 0, 0, 0)
DI unsigned pk2(float lo, float hi) { return pg8::cvt_pk_bf16(lo, hi); }
DI float bflo(unsigned w) { return pg8::bf_lo(w); }
DI float bfhi(unsigned w) { return pg8::bf_hi(w); }
DI float ex2(float x) { return __builtin_amdgcn_exp2f(x); }
DI f32x16 zero16() { float z = 0.f; asm volatile("" : "+v"(z)); return (f32x16){z, z, z, z, z, z, z, z, z, z, z, z, z, z, z, z}; }
DI int crow(int r, int hi) { return (r & 3) + 8 * (r >> 2) + 4 * hi; }
#define SWZ_XOR(v, m) __uint_as_float((unsigned)__builtin_amdgcn_ds_swizzle((int)__float_as_uint(v), ((m) << 10) | 0x1f))
DI float half_swap_add(float v);
DI float wave_sum(float v) { v += SWZ_XOR(v, 1); v += SWZ_XOR(v, 2); v += SWZ_XOR(v, 4); v += SWZ_XOR(v, 8); v += SWZ_XOR(v, 16); return half_swap_add(v); }
DI float shfl_lane(float v, int src_lane) { return __uint_as_float((unsigned)__builtin_amdgcn_ds_bpermute(src_lane << 2, (int)__float_as_uint(v))); }
DI float half_swap_add(float v) { auto rr = __builtin_amdgcn_permlane32_swap(__float_as_uint(v), __float_as_uint(v), false, false); return __uint_as_float(rr[0]) + __uint_as_float(rr[1]); }
DI float half_swap_max(float v) { auto rr = __builtin_amdgcn_permlane32_swap(__float_as_uint(v), __float_as_uint(v), false, false); return fmaxf(__uint_as_float(rr[0]), __uint_as_float(rr[1])); }
typedef short v4i16_t __attribute__((ext_vector_type(4)));
DI s16x4 vtr(lcp p) { return __builtin_bit_cast(s16x4, __builtin_amdgcn_ds_read_tr16_b64_v4i16((LAS v4i16_t*)p)); }
DI bf16x8 cat8(s16x4 lo, s16x4 hi) { return __builtin_shufflevector(lo, hi, 0, 1, 2, 3, 4, 5, 6, 7); }
DI bf16x8 trfrag(lcp p) { return cat8(vtr(p), vtr(p + 512)); }
DI bf16x8 ldfrag(lcp p) { return *(const LAS bf16x8*)p; }
DI bf16x8 mask_frag(v4u v, unsigned m) { v4u o; asm("v_and_b32 %0, %4, %8\n\tv_and_b32 %1, %5, %8\n\tv_and_b32 %2, %6, %8\n\tv_and_b32 %3, %7, %8\n\ts_nop 1" : "=&v"(o.x), "=&v"(o.y), "=&v"(o.z), "=&v"(o.w) : "v"(v.x), "v"(v.y), "v"(v.z), "v"(v.w), "v"(m)); return __builtin_bit_cast(bf16x8, o); }
DI void glds16(const void* gsrc, LAS void* ldst) { __builtin_amdgcn_global_load_lds((const unsigned*)gsrc, (LAS unsigned*)ldst, 16, 0, 0); }
#define PACK8(x, s) ((bf16x8)__builtin_bit_cast(bf16x8, (v4u){pk2((x)[8 * (s) + 0], (x)[8 * (s) + 1]), pk2((x)[8 * (s) + 2], (x)[8 * (s) + 3]), pk2((x)[8 * (s) + 4], (x)[8 * (s) + 5]), pk2((x)[8 * (s) + 6], (x)[8 * (s) + 7])}))

constexpr int RING_OFF = 0, RING_BYTES = 131072;
constexpr int TAB_OFF = 131072;
constexpr int MISC_OFF = 163840 - 256;
constexpr int LDS_BYTES = 163840;
constexpr int AT_K = 0, AT_V = 32768, AT_WS = 65536, AT_STG = 67584;
constexpr int ML_K = 0, ML_V = 65536, ML_VW = 81920, ML_C = 98304, ML_N = 131072, ML_G2 = 131584, ML_M2 = 132096, ML_FI = 132608, ML_EI = 133120, ML_WK = 133632, ML_WKB = 134144, ML_SC = 134400, ML_WS = 134464, ML_STG = 136512;
static_assert(ML_STG + 4 * 4096 <= MISC_OFF && AT_STG + 8 * 4096 <= MISC_OFF && pg8::CTAB_OFF + pg8::CTAB_UNITS * 1024 <= MISC_OFF && pg8::STAB_OFF == TAB_OFF + 16384, "LDS map");

#define XB_TMO      128
#define XB_XCNT(j)  (256  + 64 * (j))
#define XB_XSUB(j)  (1280 + 64 * (j))
#define XB_XGEN(j)  (2304 + 64 * (j))
#define XB_TOP      3328
#define XB_TOPGEN   3392
#define XCD_BAR_WORDS 3456
#define XB_SPIN_CAP (1u << 18)

__device__ __forceinline__ unsigned xb_ld(unsigned* p)              { return __hip_atomic_load(p, __ATOMIC_RELAXED, __HIP_MEMORY_SCOPE_AGENT); }
__device__ __forceinline__ unsigned xb_add(unsigned* p, unsigned v) { return __hip_atomic_fetch_add(p, v, __ATOMIC_RELAXED, __HIP_MEMORY_SCOPE_AGENT); }
__device__ __forceinline__ unsigned xb_xcc_id() { return (unsigned)__builtin_amdgcn_s_getreg((3 << 11) | 20) & 0xFu; }
#define XB_SPIN(cond, bar) do { unsigned _sp = 0; while (cond) { __builtin_amdgcn_s_sleep(1); \
    if ((++_sp & 255u) == 0u) { if (xb_ld(&(bar)[XB_TMO])) break; if (_sp > XB_SPIN_CAP) { atomicAdd(&(bar)[XB_TMO], 1u); break; } } } } while (0)

struct XcdBarrier {
    unsigned* bar; unsigned x;
    volatile LAS unsigned* st;
    unsigned total;
};

__device__ __forceinline__ XcdBarrier xcd_barrier_post(unsigned* bar, volatile LAS unsigned* st) {
    XcdBarrier b; b.bar = bar; b.x = xb_xcc_id(); b.st = st; b.total = gridDim.x * gridDim.y * gridDim.z;
    if (threadIdx.x == 0) (void)xb_add(&bar[XB_XCNT(b.x)], 1u);
    return b;
}
__device__ __forceinline__ void xcd_barrier_complete(unsigned* bar, unsigned x, unsigned G, unsigned& nloc, unsigned& nx) {
    unsigned sum, cnt, mine, sp = 0u;
    for (;;) {
        sum = 0u; cnt = 0u; mine = 0u;
#pragma unroll
        for (unsigned j = 0; j < 16; ++j) { const unsigned c = xb_ld(&bar[XB_XCNT(j)]); sum += c; cnt += (c > 0u) ? 1u : 0u; mine = (j == x) ? c : mine; }
        if (sum == G) break;
        __builtin_amdgcn_s_sleep(1);
        if ((++sp & 255u) == 0u) { if (xb_ld(&bar[XB_TMO])) break; if (sp > XB_SPIN_CAP) { atomicAdd(&bar[XB_TMO], 1u); break; } }
    }
    nloc = mine > 0u ? mine : 1u; nx = cnt > 0u ? cnt : 1u;
}

__device__ __forceinline__ void xcd_barrier(const XcdBarrier& b) {
    asm volatile("s_waitcnt vmcnt(0)" ::: "memory");
    __syncthreads();
    if (threadIdx.x == 0) {
        unsigned* bar = b.bar;
        __builtin_amdgcn_s_waitcnt(0);
        unsigned nloc = b.st[0], nx = b.st[1];
        if (nloc == 0u) { xcd_barrier_complete(bar, b.x, b.total, nloc, nx); b.st[0] = nloc; b.st[1] = nx; }
        const unsigned old = xb_add(&bar[XB_XSUB(b.x)], 1u);
        const unsigned gen = old / nloc;
        if (old + 1u == (gen + 1u) * nloc) {
            __builtin_amdgcn_fence(__ATOMIC_RELEASE, "agent");
            asm volatile("s_waitcnt vmcnt(0)" ::: "memory");
            const unsigned og = xb_add(&bar[XB_TOP], 1u);
            const unsigned tg = og / nx;
            if (og + 1u == (tg + 1u) * nx) xb_add(&bar[XB_TOPGEN], 1u);
            else XB_SPIN(xb_ld(&bar[XB_TOPGEN]) == tg, bar);
            __builtin_amdgcn_fence(__ATOMIC_ACQUIRE, "agent");
            xb_add(&bar[XB_XGEN(b.x)], 1u);
            asm volatile("s_waitcnt vmcnt(0)" ::: "memory");
        } else {
            XB_SPIN(xb_ld(&bar[XB_XGEN(b.x)]) == gen, bar);
            __builtin_amdgcn_fence(__ATOMIC_ACQUIRE, "agent");
            asm volatile("s_waitcnt vmcnt(0)" ::: "memory");
        }
    }
    __syncthreads();
}
DI void attn_phase(unsigned char* ldsg, const bf16* QKV, unsigned char* AO8, const float* sinks, int ng, int gx, int gy, int Gy, int wave_in) {
    int wid = wave_in; asm volatile("" : "+s"(wid));
    const int lane = pg8::pg8_lane(), tid = wid * 64 + lane, r32 = lane & 31, hi = lane >> 5;
    LAS unsigned char* lds = (LAS unsigned char*)ldsg; const lcp L = (lcp)lds;
    LAS float* wsf = (LAS float*)(lds + AT_WS) + wid * 64;
    LAS unsigned char* stg = lds + AT_STG + wid * 4096;
    const lcp vlane = L + AT_V + ((lane >> 4) & 1) * 32 + (lane & 3) * 8 + (4 * hi + ((lane & 15) >> 2)) * 64;
    const lcp klane = L + AT_K + hi * 1024 + r32 * 16;
    for (int uu = gy; uu < 64 * (BATCH / ng); uu += Gy) { const int b = gx + ng * (uu >> 6), ul = uu & 63;
        const int kvh = ul & 3, nb = ul >> 2;
        const long rowq = (long)b * SEQ + nb * 128, rowk = rowq - 128;
        const int slot_lo = (nb == 0) ? 2 : 0;
        for (int sl = slot_lo; sl < 4; ++sl) {
            glds16(QKV + (rowk + 64 * sl + lane) * NQKV + 2048 + 64 * kvh + 8 * wid, lds + AT_K + sl * 8192 + wid * 1024);
            glds16(QKV + (rowk + 64 * sl + 16 * (wid & 3) + (lane >> 2)) * NQKV + 2304 + 64 * kvh + (wid >> 2) * 32 + (lane & 3) * 8, lds + AT_V + sl * 8192 + wid * 1024);
        }
        const int hq = 8 * kvh + wid;
        const bf16* qsrc = QKV + (rowq + r32) * NQKV + 64 * hq + 8 * hi;
        bf16x8 qn[4];
#pragma unroll
        for (int d0 = 0; d0 < 4; ++d0) qn[d0] = *(const bf16x8*)(qsrc + 16 * d0);
        const float slope2 = ex2(-0.25f * (float)(hq + 1)) * LOG2E, sink2 = sinks[hq] * LOG2E;
        const float base_l = -slope2 * (float)(r32 - 4 * hi);
        WG_BAR();
#pragma unroll 1
        for (int j = 0; j < 4; ++j) {
            const int ilo = (nb == 0) ? 4 - j : 0;
            bf16x8 qr[4];
#pragma unroll
            for (int d0 = 0; d0 < 4; ++d0) qr[d0] = qn[d0];
            if (j < 3) {
#pragma unroll
                for (int d0 = 0; d0 < 4; ++d0) qn[d0] = *(const bf16x8*)(qsrc + (size_t)(32 * (j + 1)) * NQKV + 16 * d0);
            }
            float sl2 = slope2, bl = base_l; asm volatile("" : "+v"(sl2), "+v"(bl));
            f32x16 p[5];
#pragma unroll
            for (int i = 0; i < 5; ++i) {
                if (i >= ilo) {
                    const int kt = j + i; const lcp kb = klane + (kt >> 1) * 8192 + (kt & 1) * 512;
                    f32x16 a = zero16();
#pragma unroll
                    for (int d0 = 0; d0 < 4; ++d0) a = MFMA32(ldfrag(kb + d0 * 2048), qr[d0], a);
#pragma unroll
                    for (int r = 0; r < 16; ++r) {
                        const int cr = (r & 3) + 8 * (r >> 2);
                        float s = fmaf(sl2, (float)(cr - 128 + 32 * i), fmaf(a[r], LOG2E, bl));
                        if (i == 0) { if (!(cr + 4 * hi > r32)) s = -INFINITY; }
                        if (i == 4) { if (!(cr + 4 * hi <= r32)) s = -INFINITY; }
                        a[r] = s;
                    }
                    p[i] = a;
                } else {
#pragma unroll
                    for (int r = 0; r < 16; ++r) p[i][r] = -INFINITY;
                }
            }
            float mx = sink2;
#pragma unroll
            for (int i = 0; i < 5; ++i)
#pragma unroll
                for (int r = 0; r < 16; ++r) mx = fmaxf(mx, p[i][r]);
            mx = half_swap_max(mx);
            float ls = 0.f;
#pragma unroll
            for (int i = 0; i < 5; ++i)
#pragma unroll
                for (int r = 0; r < 16; ++r) { const float e = ex2(p[i][r] - mx); p[i][r] = e; ls += e; }
            ls = half_swap_add(ls) + ex2(sink2 - mx);
            f32x16 o0 = zero16(), o1 = zero16();
#pragma unroll
            for (int i = 0; i < 5; ++i) {
                if (i >= ilo) {
                    const int kt = j + i; const lcp vb = vlane + (kt >> 1) * 8192 + (kt & 1) * 2048;
                    const bf16x8 pa = PACK8(p[i], 0), pb = PACK8(p[i], 1);
                    o0 = MFMA32(pa, trfrag(vb), o0);        o0 = MFMA32(pb, trfrag(vb + 1024), o0);
                    o1 = MFMA32(pa, trfrag(vb + 4096), o1); o1 = MFMA32(pb, trfrag(vb + 4096 + 1024), o1);
                }
            }
            if (hi == 0) wsf[r32] = __builtin_amdgcn_rcpf(ls);
#pragma unroll
            for (int r = 0; r < 16; ++r) {
                const int orow = crow(r, hi); const float rl = wsf[orow] * pg8::F8_SO;
                int pk; asm volatile("" : "=v"(pk)); pk = __builtin_amdgcn_cvt_pk_fp8_f32(o0[r] * rl, o1[r] * rl, pk, false);
                stg[orow * 64 + r32] = (unsigned char)(pk & 0xff);
                stg[orow * 64 + 32 + r32] = (unsigned char)((pk >> 8) & 0xff);
            }
#pragma unroll
            for (int i4 = 0; i4 < 2; ++i4) {
                const int row = i4 * 16 + (lane >> 2), ch = lane & 3;
                const v4u v = *(const LAS v4u*)(stg + row * 64 + ch * 16);
                *(v4u*)(AO8 + (rowq + 32 * j + row) * D + 64 * hq + ch * 16) = v;
            }
        }
        WG_BAR();
    }
}

constexpr int ML_GSET = ML_STG + 4 * 4096 - ML_G2;
static_assert(ML_G2 + ML_GSET + (ML_WS - ML_G2) <= MISC_OFF, "LDS map: second gate-array set");
#define DPPF(old, src, ctrl, rmask, bc) __uint_as_float((unsigned)__builtin_amdgcn_update_dpp((int)__float_as_uint(old), (int)__float_as_uint(src), (ctrl), (rmask), 0xf, (bc)))
DI float scan_add64(float v) {
    v += DPPF(0.f, v, 0x111, 0xf, true); v += DPPF(0.f, v, 0x112, 0xf, true); v += DPPF(0.f, v, 0x114, 0xf, true); v += DPPF(0.f, v, 0x118, 0xf, true);
    v += DPPF(0.f, v, 0x142, 0xa, false); v += DPPF(0.f, v, 0x143, 0xc, false); return v;
}
DI float scan_max64(float v) {
    const float ninf = -INFINITY;
    v = fmaxf(v, DPPF(ninf, v, 0x111, 0xf, false)); v = fmaxf(v, DPPF(ninf, v, 0x112, 0xf, false)); v = fmaxf(v, DPPF(ninf, v, 0x114, 0xf, false)); v = fmaxf(v, DPPF(ninf, v, 0x118, 0xf, false));
    v = fmaxf(v, DPPF(ninf, v, 0x142, 0xa, false)); v = fmaxf(v, DPPF(ninf, v, 0x143, 0xc, false)); return v;
}
DI float ml_gate_scan(LAS unsigned char* lds, int gofs, const float* GT, long row0, int h, int lane, float m_prev) {
    LAS float* G2 = (LAS float*)(lds + ML_G2 + gofs); LAS float* M2 = (LAS float*)(lds + ML_M2 + gofs); LAS float* FI = (LAS float*)(lds + ML_FI + gofs); LAS float* EI = (LAS float*)(lds + ML_EI + gofs);
    LAS float* WK = (LAS float*)(lds + ML_WK + gofs); LAS bf16* WKB = (LAS bf16*)(lds + ML_WKB + gofs); LAS float* SC = (LAS float*)(lds + ML_SC + gofs);
    const float* gp = GT + (size_t)(row0 + 2 * lane) * 8;
    const float i0 = gp[h], f0 = gp[4 + h], i1 = gp[8 + h], f1 = gp[12 + h];
    const float lf0 = -0.6931471805599453f * __builtin_amdgcn_logf(1.f + ex2(-LOG2E * f0)), lf1 = -0.6931471805599453f * __builtin_amdgcn_logf(1.f + ex2(-LOG2E * f1));
    const float incl = scan_add64(lf0 + lf1);
    const float b1 = incl, b0 = incl - lf1;
    const float g0 = i0 - b0, g1 = i1 - b1;
    const float cm = scan_max64(fmaxf(g0, g1));
    const float cprev = DPPF(-INFINITY, cm, 0x138, 0xf, false);
    const float M0 = fmaxf(m_prev, fmaxf(cprev, g0)), M1 = fmaxf(m_prev, cm);
    const float Mend = __uint_as_float((unsigned)__builtin_amdgcn_readlane((int)__float_as_uint(M1), 63)), blast = __uint_as_float((unsigned)__builtin_amdgcn_readlane((int)__float_as_uint(b1), 63));
    *(LAS f32x2*)(G2 + 2 * lane) = (f32x2){g0 * LOG2E, g1 * LOG2E};
    *(LAS f32x2*)(M2 + 2 * lane) = (f32x2){M0 * LOG2E, M1 * LOG2E};
    *(LAS f32x2*)(FI + 2 * lane) = (f32x2){ex2((m_prev - M0) * LOG2E), ex2((m_prev - M1) * LOG2E)};
    *(LAS f32x2*)(EI + 2 * lane) = (f32x2){ex2(-(b0 + M0) * LOG2E), ex2(-(b1 + M1) * LOG2E)};
    const float w0 = ex2((g0 - Mend) * LOG2E), w1 = ex2((g1 - Mend) * LOG2E);
    *(LAS f32x2*)(WK + 2 * lane) = (f32x2){w0, w1};
    *(LAS unsigned*)(WKB + 2 * lane) = pk2(w0, w1);
    if (lane == 0) SC[0] = ex2((m_prev - Mend) * LOG2E);
    return blast + Mend;
}
template <int VAR = 0>
DI void mlstm_phase(unsigned char* ldsg, const bf16* MP, const float* GT, bf16* HG, int ng, int gx, int gy, int Gy, int wave_in) {
    int wid = wave_in; asm volatile("" : "+s"(wid));
    const int lane0 = pg8::pg8_lane(), tid = wid * 64 + lane0;
    LAS unsigned char* lds = (LAS unsigned char*)ldsg; const lcp L = (lcp)lds;
    LAS float* wsf = (LAS float*)(lds + ML_WS) + wid * 64;
    for (int uu = gy; uu < 32 * (BATCH / ng); uu += Gy) { const int b = gx + ng * (uu >> 5), ul = uu & 31;
        const int h = ul >> 3, sl = ul & 7;
        const bf16* Qp = MP + 256 * h; const bf16* Kp = MP + 1024 + 256 * h; const bf16* Vp = MP + 2048 + 512 * h + 64 * sl; const bf16* OGp = MP + 4096 + 512 * h + 64 * sl;
        { unsigned z = 0u; asm volatile("" : "+v"(z)); for (int i = tid; i < (32768 + 512) / 16; i += 512) *(LAS v4u*)(lds + ML_C + i * 16) = (v4u){z, z, z, z}; }
        f32x16 T[6];
#pragma unroll
        for (int x = 0; x < 6; ++x) T[x] = zero16();
        float m_prev = 0.f;
        v4u X[16], vreg[2];
        { const long row0 = (long)b * SEQ; const int lane = lane0, r32 = lane & 31, hi = lane >> 5;
          if (wid >= 4) {
#pragma unroll
              for (int i = 0; i < 16; ++i) X[i] = *(const v4u*)(Kp + (row0 + 8 * i + (lane & 7)) * NMI + (8 * (wid - 4) + (lane >> 3)) * 8);
          } else {
#pragma unroll
              for (int ks = 0; ks < 16; ++ks) X[ks] = *(const v4u*)(Qp + (row0 + 32 * wid + r32) * NMI + 16 * ks + 8 * hi);
          }
#pragma unroll
          for (int i = 0; i < 2; ++i) vreg[i] = *(const v4u*)(Vp + (row0 + 64 * i + 16 * (wid & 3) + (lane >> 2)) * NMI + (wid >> 2) * 32 + (lane & 3) * 8);
          if (wid == 4 && !(VAR & 16)) m_prev = ml_gate_scan(lds, 0, GT, row0, h, lane, m_prev);
        }
        WG_BAR();
        for (int c = 0; c < 16; ++c) {
            const long row0 = (long)b * SEQ + 128 * c;
            const int gofs = (c & 1) * ML_GSET;
            const int lane = pg8::pg8_lane(), r32 = lane & 31, hi = lane >> 5;
            const int blk = (lane >> 4) & 1, q4 = (lane & 15) >> 2, p4 = lane & 3;
            const int vlo_ = blk * 32 + p4 * 8 + (4 * hi + q4) * 64;
            const int ktl_ = (2 * blk + (p4 >> 1)) * 2048 + (q4 + 4 * hi) * 16 + (p4 & 1) * 8;
            const int cbl_ = hi * 1024 + r32 * 16, kbl_ = hi * 2048 + r32 * 16;
            const unsigned m0 = (r32 == 0) ? 0xffffffffu : 0u;
            LAS float* G2 = (LAS float*)(lds + ML_G2 + gofs); LAS float* M2 = (LAS float*)(lds + ML_M2 + gofs); LAS float* FI = (LAS float*)(lds + ML_FI + gofs); LAS float* EI = (LAS float*)(lds + ML_EI + gofs);
            LAS float* WK = (LAS float*)(lds + ML_WK + gofs); LAS bf16* WKB = (LAS bf16*)(lds + ML_WKB + gofs); LAS float* SC = (LAS float*)(lds + ML_SC + gofs);
            if (wid >= 4) {
#pragma unroll
                for (int i = 0; i < 16; ++i) *(LAS v4u*)(lds + ML_K + (8 * (wid - 4) + (lane >> 3)) * 2048 + (8 * i + (lane & 7)) * 16) = X[i];
            }
#pragma unroll
            for (int i = 0; i < 2; ++i) { const float w = WK[64 * i + 16 * (wid & 3) + (lane >> 2)]; const v4u v = vreg[i]; v4u o;
                o.x = pk2(bflo(v.x) * w, bfhi(v.x) * w); o.y = pk2(bflo(v.y) * w, bfhi(v.y) * w); o.z = pk2(bflo(v.z) * w, bfhi(v.z) * w); o.w = pk2(bflo(v.w) * w, bfhi(v.w) * w);
                *(LAS v4u*)(lds + ML_V + i * 8192 + wid * 1024 + lane * 16) = v;
                *(LAS v4u*)(lds + ML_VW + i * 8192 + wid * 1024 + lane * 16) = o; }
            asm volatile("s_waitcnt lgkmcnt(0)" ::: "memory"); __builtin_amdgcn_s_barrier(); asm volatile("" ::: "memory");
            const bool more = c + 1 < 16;
            if (more && !(VAR & 32)) {
                const long row1 = row0 + 128;
                if (wid >= 4) {
#pragma unroll
                    for (int i = 0; i < 16; ++i) X[i] = *(const v4u*)(Kp + (row1 + 8 * i + (lane & 7)) * NMI + (8 * (wid - 4) + (lane >> 3)) * 8);
                }
#pragma unroll
                for (int i = 0; i < 2; ++i) vreg[i] = *(const v4u*)(Vp + (row1 + 64 * i + 16 * (wid & 3) + (lane >> 2)) * NMI + (wid >> 2) * 32 + (lane & 3) * 8);
            }
            if (wid < 4) {
                const int tt = wid;
                v4u ogv[4];
#pragma unroll
                for (int i4 = 0; i4 < 4; ++i4) ogv[i4] = *(const v4u*)(OGp + (row0 + 32 * tt + i4 * 8 + (lane >> 3)) * NMI + (lane & 7) * 8);
                T[0] = zero16(); T[1] = zero16(); T[2] = zero16();
                if (!(VAR & 4)) { const lcp cb = L + ML_C + cbl_; const lcp nbp = L + ML_N + 16 * hi;
#pragma unroll
                  for (int ks = 0; ks < 16; ++ks) {
                      const bf16x8 c0 = ldfrag(cb + ks * 2048), c1 = ldfrag(cb + ks * 2048 + 512);
                      const bf16x8 nf = mask_frag(*(const LAS v4u*)(nbp + ks * 32), m0);
                      T[0] = MFMA32(__builtin_bit_cast(bf16x8, X[ks]), c0, T[0]); T[1] = MFMA32(__builtin_bit_cast(bf16x8, X[ks]), c1, T[1]); T[2] = MFMA32(__builtin_bit_cast(bf16x8, X[ks]), nf, T[2]);
                      if ((ks & 3) == 3) __builtin_amdgcn_sched_barrier(0);
                  } }
                { float fi[16];
#pragma unroll
                  for (int r = 0; r < 16; ++r) fi[r] = FI[32 * tt + crow(r, hi)];
#pragma unroll
                  for (int r = 0; r < 16; ++r) { T[0][r] *= fi[r]; T[1][r] *= fi[r]; }
                  if (r32 == 0) {
#pragma unroll
                      for (int r = 0; r < 16; ++r) wsf[crow(r, hi)] = T[2][r] * fi[r];
                  } }
                const float Mt = M2[32 * tt + r32];
                float dsum = 0.f;
                for (int st = 0; st <= ((VAR & 2) ? -1 : tt); ++st) {
                    f32x16 S = zero16();
                    const lcp kb = L + ML_K + kbl_ + st * 512;
#pragma unroll
                    for (int ks = 0; ks < 16; ++ks) S = MFMA32(ldfrag(kb + ks * 4096), __builtin_bit_cast(bf16x8, X[ks]), S);
#pragma unroll
                    for (int r = 0; r < 16; ++r) {
                        const float w = ex2(G2[32 * st + crow(r, hi)] - Mt);
                        float v = S[r] * w;
                        if (st == tt && crow(r, hi) > r32) v = 0.f;
                        S[r] = v; dsum += v;
                    }
                    const bf16x8 pa = PACK8(S, 0), pb = PACK8(S, 1);
                    const lcp vb = L + ML_V + (st >> 1) * 8192 + (st & 1) * 2048 + vlo_;
                    T[0] = MFMA32(pa, trfrag(vb), T[0]);        T[0] = MFMA32(pb, trfrag(vb + 1024), T[0]);
                    T[1] = MFMA32(pa, trfrag(vb + 4096), T[1]); T[1] = MFMA32(pb, trfrag(vb + 4096 + 1024), T[1]);
                }
                if (more && !(VAR & 64)) {
#pragma unroll
                    for (int ks = 0; ks < 16; ++ks) X[ks] = *(const v4u*)(Qp + (row0 + 128 + 32 * wid + r32) * NMI + 16 * ks + 8 * hi);
                }
                dsum = half_swap_add(dsum);
                { const float den = wsf[r32] + dsum; const float dn = fmaxf(fabsf(den), EI[32 * tt + r32]);
                  if (hi == 0) wsf[32 + r32] = __builtin_amdgcn_rcpf(dn); }
                LAS bf16* stg = (LAS bf16*)(lds + ML_STG + tt * 4096);
                if (!(VAR & 8)) {
#pragma unroll
                for (int r = 0; r < 16; ++r) {
                    const int orow = crow(r, hi); const float rd = wsf[32 + orow];
                    stg[orow * 64 + r32] = (bf16)(pk2(T[0][r] * rd, 0.f) & 0xffffu);
                    stg[orow * 64 + 32 + r32] = (bf16)(pk2(T[1][r] * rd, 0.f) & 0xffffu);
                }
#pragma unroll
                for (int i4 = 0; i4 < 4; ++i4) {
                    const int row = i4 * 8 + (lane >> 3), ch = lane & 7;
                    const v4u hv = *(const LAS v4u*)(stg + row * 64 + ch * 8);
                    const v4u og = ogv[i4];
                    v4u o;
                    o.x = pk2(bflo(hv.x) * bflo(og.x), bfhi(hv.x) * bfhi(og.x)); o.y = pk2(bflo(hv.y) * bflo(og.y), bfhi(hv.y) * bfhi(og.y));
                    o.z = pk2(bflo(hv.z) * bflo(og.z), bfhi(hv.z) * bfhi(og.z)); o.w = pk2(bflo(hv.w) * bflo(og.w), bfhi(hv.w) * bfhi(og.w));
                    *(v4u*)(HG + (row0 + 32 * tt + row) * D + 512 * h + 64 * sl + ch * 8) = o;
                }
                }
#pragma unroll
                for (int x = 3; x < 6; ++x) T[x] = zero16();
            } else {
                const float decay = SC[0];
#pragma unroll
                for (int x = 0; x < 6; ++x)
#pragma unroll
                    for (int r = 0; r < 16; ++r) T[x][r] *= decay;
#pragma unroll
                for (int dti = 0; dti < ((VAR & 1) ? 0 : 2); ++dti) {
                    const int dt = 2 * (wid - 4) + dti;
                    const lcp ka0 = L + ML_K + dt * 8192 + ktl_;
#pragma unroll
                    for (int s8 = 0; s8 < 8; ++s8) {
                        const lcp ka = ka0 + s8 * 256;
                        const bf16x8 af = cat8(vtr(ka), vtr(ka + 128));
                        const lcp vwb = L + ML_VW + (s8 >> 2) * 8192 + (s8 & 3) * 1024 + vlo_;
                        const bf16x8 b0 = trfrag(vwb), b1 = trfrag(vwb + 4096);
                        const v2u wlo = *(const LAS v2u*)(WKB + 16 * s8 + 4 * hi), whi = *(const LAS v2u*)(WKB + 16 * s8 + 4 * hi + 8); const bf16x8 nb = mask_frag((v4u){wlo.x, wlo.y, whi.x, whi.y}, m0);
                        T[2 * dti] = MFMA32(af, b0, T[2 * dti]); T[2 * dti + 1] = MFMA32(af, b1, T[2 * dti + 1]); T[4 + dti] = MFMA32(af, nb, T[4 + dti]);
                        if (s8 & 1) __builtin_amdgcn_sched_barrier(0);
                    }
                }
                if (more && wid == 4 && !(VAR & 16)) m_prev = ml_gate_scan(lds, ML_GSET - gofs, GT, row0 + 128, h, lane, m_prev);
            }
            asm volatile("s_waitcnt lgkmcnt(0)" ::: "memory"); __builtin_amdgcn_s_barrier(); asm volatile("" ::: "memory");
            if (wid >= 4) {
#pragma unroll
                for (int dti = 0; dti < 2; ++dti) {
                    const int dt = 2 * (wid - 4) + dti;
#pragma unroll
                    for (int et = 0; et < 2; ++et)
#pragma unroll
                        for (int g = 0; g < 4; ++g)
                            *(LAS v2u*)(lds + ML_C + (4 * dt + g) * 1024 + (32 * et + r32) * 16 + hi * 8) = (v2u){pk2(T[2 * dti + et][4 * g], T[2 * dti + et][4 * g + 1]), pk2(T[2 * dti + et][4 * g + 2], T[2 * dti + et][4 * g + 3])};
                    if (r32 == 0) {
#pragma unroll
                        for (int g = 0; g < 4; ++g)
                            *(LAS v2u*)(lds + ML_N + (32 * dt + 8 * g + 4 * hi) * 2) = (v2u){pk2(T[4 + dti][4 * g], T[4 + dti][4 * g + 1]), pk2(T[4 + dti][4 * g + 2], T[4 + dti][4 * g + 3])};
                    }
                }
            }
        }
        WG_BAR();
    }
}


constexpr int NWAVES = 8;

template <bool F8> DI void tr_strip(const float* W, int ldw, int n0, void* WTv, size_t wt_row0, int Kdim, int kb0, int nkb, const float* g, const float* bb, float cs, float* c1o, float* c2o, LAS float* scr, int lane) {
    bf16* WT = (bf16*)WTv; unsigned char* WT8 = (unsigned char*)WTv;
    const int c = lane & 7;
    float a1[4] = {0.f, 0.f, 0.f, 0.f}, a2[4] = {0.f, 0.f, 0.f, 0.f};
    for (int kb = kb0; kb < kb0 + nkb; ++kb) {
        const int k0 = kb * 64;
#pragma unroll 8
        for (int i = 0; i < 32; ++i) { const int kk = 2 * i + (lane >> 5); scr[kk * 33 + (lane & 31)] = __builtin_nontemporal_load(W + (size_t)(k0 + kk) * ldw + n0 + (lane & 31)); }
        float gk[8], bk[8];
        if (g) { const f32x4 g0 = *(const f32x4*)(g + k0 + 8 * c), g1 = *(const f32x4*)(g + k0 + 8 * c + 4), b0 = *(const f32x4*)(bb + k0 + 8 * c), b1 = *(const f32x4*)(bb + k0 + 8 * c + 4);
#pragma unroll
            for (int i = 0; i < 4; ++i) { gk[i] = g0[i] * cs; gk[4 + i] = g1[i] * cs; bk[i] = b0[i] * cs; bk[4 + i] = b1[i] * cs; } }
        else {
#pragma unroll
            for (int i = 0; i < 8; ++i) { gk[i] = cs; bk[i] = 0.f; } }
        LDS_WAIT(); asm volatile("" ::: "memory");
#pragma unroll
        for (int j = 0; j < 4; ++j) { const int n = (lane >> 3) + 8 * j; const LAS float* s = scr + (8 * c) * 33 + n;
            float v[8];
#pragma unroll
            for (int i = 0; i < 8; ++i) v[i] = s[i * 33];
            a2[j] += ((v[0] * bk[0] + v[1] * bk[1]) + (v[2] * bk[2] + v[3] * bk[3])) + ((v[4] * bk[4] + v[5] * bk[5]) + (v[6] * bk[6] + v[7] * bk[7]));
            if constexpr (F8) {
                float wv[8];
#pragma unroll
                for (int i = 0; i < 8; ++i) wv[i] = v[i] * gk[i];
                const v2u o = pg8::cvt8_f8(wv, pg8::F8_SW);
                a1[j] += ((__builtin_amdgcn_cvt_f32_fp8((int)o.x, 0) + __builtin_amdgcn_cvt_f32_fp8((int)o.x, 1)) + (__builtin_amdgcn_cvt_f32_fp8((int)o.x, 2) + __builtin_amdgcn_cvt_f32_fp8((int)o.x, 3)))
                       + ((__builtin_amdgcn_cvt_f32_fp8((int)o.y, 0) + __builtin_amdgcn_cvt_f32_fp8((int)o.y, 1)) + (__builtin_amdgcn_cvt_f32_fp8((int)o.y, 2) + __builtin_amdgcn_cvt_f32_fp8((int)o.y, 3)));
                *(GAS v2u*)(WT8 + (wt_row0 + n) * Kdim + k0 + 8 * c) = o;
            } else {
                v4u o; o.x = pk2(v[0] * gk[0], v[1] * gk[1]); o.y = pk2(v[2] * gk[2], v[3] * gk[3]); o.z = pk2(v[4] * gk[4], v[5] * gk[5]); o.w = pk2(v[6] * gk[6], v[7] * gk[7]);
                a1[j] += ((bflo(o.x) + bfhi(o.x)) + (bflo(o.y) + bfhi(o.y))) + ((bflo(o.z) + bfhi(o.z)) + (bflo(o.w) + bfhi(o.w)));
                *(GAS v4u*)(WT + (wt_row0 + n) * Kdim + k0 + 8 * c) = o;
            } }
        LDS_WAIT(); asm volatile("" ::: "memory");
    }
    if (g) {
#pragma unroll
        for (int j = 0; j < 4; ++j) { float s1 = a1[j], s2 = a2[j];
            s1 += SWZ_XOR(s1, 1); s2 += SWZ_XOR(s2, 1); s1 += SWZ_XOR(s1, 2); s2 += SWZ_XOR(s2, 2); s1 += SWZ_XOR(s1, 4); s2 += SWZ_XOR(s2, 4);
            if (c == 0) { c1o[(lane >> 3) + 8 * j] = F8 ? s1 * (1.f / pg8::F8_SW) : s1; c2o[(lane >> 3) + 8 * j] = s2; } }
    }
}

DI void prologue(kargs_t a, LAS unsigned char* lds, int gw, int NGW, int wave, int lane) {
    unsigned char* ws = a->ws;
    float* vec = (float*)(ws + WS_VEC);
    const float* ones = (const float*)(ws + WS_VEC + V_ONES); const float* zeros = (const float*)(ws + WS_VEC + V_ZEROS);
    LAS float* scr = (LAS float*)(lds + wave * 16384);
    constexpr int T_UP = 8 * 2 * 176, T_QKV = 2 * 80, T_MI = 2 * 192, T_W2 = 8 * 64 * 4, T_WO = 2 * 64, T_WMO = 2 * 64, T_G = 16;
    constexpr int NT = T_UP + T_QKV + T_MI + T_W2 + T_WO + T_WMO + T_G;
    for (int it = gw; it < NT; it += NGW) {
        int r = it;
        if (r < T_UP) {
            const int f = r / 352, rr = r % 352, which = rr / 176, strip = rr % 176, n0 = 32 * strip;
            const int t = 3 * (f >> 1) + 2 * (f & 1);
            const float* gp = t ? a->ln_g + (size_t)(t - 1) * D : nullptr; const float* bp = t ? a->ln_b + (size_t)(t - 1) * D : nullptr;
            const size_t wrow = (size_t)256 * (n0 / 128) + 128 * which + (n0 % 128);
            const float* W = (which ? a->w3 : a->w1) + (size_t)f * D * FF;
            if (gp) tr_strip<true>(W, FF, n0, ws + WS_W13 + (size_t)f * NUP * D, wrow, D, 0, 32, gp, bp, 1.f, vec + V_C1U / 4 + (size_t)f * NUP + wrow, vec + V_C2U / 4 + (size_t)f * NUP + wrow, scr, lane);
            else { tr_strip<true>(W, FF, n0, ws + WS_W13 + (size_t)f * NUP * D, wrow, D, 0, 32, nullptr, nullptr, 1.f, nullptr, nullptr, scr, lane);
                   if (lane < 32) { vec[V_C1U / 4 + (size_t)f * NUP + wrow + lane] = 0.f; vec[V_C2U / 4 + (size_t)f * NUP + wrow + lane] = 0.f; } }
            continue; }
        r -= T_UP;
        if (r < T_QKV) { const int j = r / 80, n0 = 32 * (r % 80); const int t = 6 * j + 1;
            tr_strip<true>(a->wqkv + (size_t)j * D * NQKV, NQKV, n0, ws + WS_WQKV + (size_t)j * NQKV * D, n0, D, 0, 32, a->ln_g + (size_t)(t - 1) * D, a->ln_b + (size_t)(t - 1) * D, n0 < 2048 ? 0.125f : 1.f,
                     vec + V_C1Q / 4 + j * NQKV + n0, vec + V_C2Q / 4 + j * NQKV + n0, scr, lane);
            continue; }
        r -= T_QKV;
        if (r < T_MI) { const int j = r / 192, n0 = 32 * (r % 192); const int t = 6 * j + 4;
            if (true) tr_strip<false>(a->win + (size_t)j * D * NMIW, NMIW, n0, (bf16*)(ws + WS_WIN) + (size_t)j * NMI * D, n0, D, 0, 32, a->ln_g + (size_t)(t - 1) * D, a->ln_b + (size_t)(t - 1) * D, (n0 >= 1024 && n0 < 2048) ? 0.0625f : 1.f,
                     vec + V_C1I / 4 + j * NMI + n0, vec + V_C2I / 4 + j * NMI + n0, scr, lane);
            else tr_strip<true>(a->win + (size_t)j * D * NMIW, NMIW, n0, ws + WS_WIN + 32 * MiB + (size_t)j * 2048 * D, n0 - 4096, D, 0, 32, a->ln_g + (size_t)(t - 1) * D, a->ln_b + (size_t)(t - 1) * D, 1.f,
                     vec + V_C1I / 4 + j * NMI + n0, vec + V_C2I / 4 + j * NMI + n0, scr, lane);
            continue; }
        r -= T_MI;
        if (r < T_W2) { const int f = r / 256, rr = r % 256, strip = rr / 4, kq = rr % 4;
            tr_strip<true>(a->w2 + (size_t)f * FF * D, D, 32 * strip, ws + WS_W2 + (size_t)f * D * FF, 32 * strip, FF, 22 * kq, 22, nullptr, nullptr, 1.f, nullptr, nullptr, scr, lane);
            continue; }
        r -= T_W2;
        if (r < T_WO) { const int j = r / 64, strip = r % 64;
            tr_strip<true>(a->wo + (size_t)j * D * D, D, 32 * strip, ws + WS_WO + (size_t)j * D * D, 32 * strip, D, 0, 32, nullptr, nullptr, 1.f, nullptr, nullptr, scr, lane);
            continue; }
        r -= T_WO;
        if (r < T_WMO) { const int j = r / 64, strip = r % 64;
            tr_strip<false>(a->wmo + (size_t)j * D * D, D, 32 * strip, (bf16*)(ws + WS_WMO) + (size_t)j * D * D, 32 * strip, D, 0, 32, nullptr, nullptr, 1.f, nullptr, nullptr, scr, lane);
            continue; }
        r -= T_WMO;
        {
            const int j = r / 8, jj = r % 8; const int t = 6 * j + 4;
            const float* gp = a->ln_g + (size_t)(t - 1) * D; const float* bp = a->ln_b + (size_t)(t - 1) * D;
            const float* W = a->win + (size_t)j * D * NMIW + NMI + jj;
            bf16* wg16 = (bf16*)(vec + V_WG / 4) + (size_t)(j * 8 + jj) * D;
            float s1 = 0.f, s2 = 0.f;
            for (int k = lane; k < D; k += 64) { const float w = W[(size_t)k * NMIW]; const unsigned hv = pk2(w * gp[k], 0.f) & 0xffffu; wg16[k] = (bf16)hv; s1 += bflo(hv); s2 += w * bp[k]; }
            s1 = wave_sum(s1); s2 = wave_sum(s2);
            if (lane == 0) { vec[V_CG / 4 + j * 16 + jj] = s1; vec[V_CG / 4 + j * 16 + 8 + jj] = s2 + a->bg[j * 8 + jj]; }
        }
    }
    bf16* R = (bf16*)(ws + WS_R); float* sp0 = (float*)(ws + WS_SP);
    for (int m = gw; m < M; m += NGW) {
        const GAS f32x4* xr = (const GAS f32x4*)(a->x + (size_t)m * D);
#pragma unroll
        for (int i = 0; i < 4; ++i) { const f32x4 v0 = xr[(i * 64 + lane) * 2], v1 = xr[(i * 64 + lane) * 2 + 1];
            *(GAS v4u*)(R + (size_t)m * D + (i * 64 + lane) * 8) = (v4u){pk2(v0[0], v0[1]), pk2(v0[2], v0[3]), pk2(v1[0], v1[1]), pk2(v1[2], v1[3])};
            { const float xv[8] = {v0[0], v0[1], v0[2], v0[3], v1[0], v1[1], v1[2], v1[3]}; *(GAS v2u*)(ws + WS_R8 + (size_t)m * D + (i * 64 + lane) * 8) = pg8::cvt8_f8(xv, pg8::F8_SR); } }
        if (lane < 8) *(f32x2*)(sp0 + (size_t)m * 16 + lane * 2) = (f32x2){0.f, 256.f * (1.f - LN_EPS)};
    }
    for (int i = gw * 64 + lane; i < D; i += NGW * 64) { vec[V_ONES / 4 + i] = 1.f; vec[V_ZEROS / 4 + i] = 0.f; }
    (void)ones; (void)zeros;
}

DI void gates_phase(LAS unsigned char* lds, const bf16* R, const float* sp, const bf16* wg16, const float* cg, float* GT, int ng, int gx, int gy, int Gy, int wave_in) {
    int wave = wave_in; asm volatile("" : "+s"(wave));
    const int lane = pg8::pg8_lane(), tid = wave * 64 + lane, r32 = lane & 31, hi = lane >> 5;
    LAS float* part = (LAS float*)lds;
    const unsigned mk = (r32 < 8) ? 0xffffffffu : 0u; const v4u mkv = {mk, mk, mk, mk};
    for (int uu = gy; uu < (SEQ / 64) * (BATCH / ng); uu += Gy) { const int b = gx + ng * (uu >> 5), pl = uu & 31;
        const long r0 = (long)b * SEQ + (long)pl * 64;
        const bf16* bsrc = wg16 + (size_t)(r32 & 7) * D + 256 * wave + 8 * hi;
        bf16x8 bfr[16];
#pragma unroll
        for (int ks = 0; ks < 16; ++ks) bfr[ks] = __builtin_bit_cast(bf16x8, *(const v4u*)(bsrc + 16 * ks) & mkv);
#pragma unroll
        for (int rt = 0; rt < 2; ++rt) {
            const bf16* asrc = R + (r0 + 32 * rt + r32) * D + 256 * wave + 8 * hi;
            bf16x8 afr[16];
#pragma unroll
            for (int ks = 0; ks < 16; ++ks) afr[ks] = *(const bf16x8*)(asrc + 16 * ks);
            f32x16 acc = zero16();
#pragma unroll
            for (int ks = 0; ks < 16; ++ks) acc = MFMA32(afr[ks], bfr[ks], acc);
            if (r32 < 8) {
#pragma unroll
                for (int r = 0; r < 16; ++r) part[(wave * 64 + 32 * rt + crow(r, hi)) * 8 + r32] = acc[r];
            }
        }
        WG_BAR();
        {
            const int row = tid >> 3, col = tid & 7;
            float s = 0.f;
#pragma unroll
            for (int w = 0; w < 8; ++w) s += part[(w * 64 + row) * 8 + col];
            const f32x4* spr = (const f32x4*)(sp + (size_t)(r0 + row) * 16);
            const f32x4 v0 = spr[0], v1 = spr[1], v2 = spr[2], v3 = spr[3];
            const float ss = ((v0[0] + v0[2]) + (v1[0] + v1[2])) + ((v2[0] + v2[2]) + (v3[0] + v3[2])), qq = ((v0[1] + v0[3]) + (v1[1] + v1[3])) + ((v2[1] + v2[3]) + (v3[1] + v3[3]));
            const float mean = ss * (1.f / D), var = qq * (1.f / D) - mean * mean, rstd = __builtin_amdgcn_rsqf(var + LN_EPS);
            GT[(size_t)(r0 + row) * 8 + col] = rstd * (s - mean * cg[col]) + cg[8 + col];
        }
        WG_BAR();
    }
}

DI void final_ln(const bf16* R, const float* sp, const float* g, const float* b, float* out, int ng, int gx, int gw, int NGW, int lane) {
    for (int bb = gx; bb < BATCH; bb += ng) for (int m = bb * SEQ + gw; m < (bb + 1) * SEQ; m += NGW) {
        float s, q;
        { const f32x4 v = *(const f32x4*)(sp + (size_t)m * 16 + (lane & 3) * 4); s = v[0] + v[2]; q = v[1] + v[3];
          s += SWZ_XOR(s, 1); q += SWZ_XOR(q, 1); s += SWZ_XOR(s, 2); q += SWZ_XOR(q, 2); }
        const float mean = s * (1.f / D), var = q * (1.f / D) - mean * mean, rstd = __builtin_amdgcn_rsqf(var + LN_EPS);
#pragma unroll
        for (int i = 0; i < 4; ++i) {
            const int k = 8 * lane + 512 * i;
            const v4u rv = *(const v4u*)(R + (size_t)m * D + k);
            const f32x4 g0 = *(const f32x4*)(g + k), g1 = *(const f32x4*)(g + k + 4), b0 = *(const f32x4*)(b + k), b1 = *(const f32x4*)(b + k + 4);
            f32x4 o0, o1;
            o0[0] = (bflo(rv.x) - mean) * rstd * g0[0] + b0[0]; o0[1] = (bfhi(rv.x) - mean) * rstd * g0[1] + b0[1]; o0[2] = (bflo(rv.y) - mean) * rstd * g0[2] + b0[2]; o0[3] = (bfhi(rv.y) - mean) * rstd * g0[3] + b0[3];
            o1[0] = (bflo(rv.z) - mean) * rstd * g1[0] + b1[0]; o1[1] = (bfhi(rv.z) - mean) * rstd * g1[1] + b1[1]; o1[2] = (bflo(rv.w) - mean) * rstd * g1[2] + b1[2]; o1[3] = (bfhi(rv.w) - mean) * rstd * g1[3] + b1[3];
            *(GAS f32x4*)(out + (size_t)m * D + k) = o0; *(GAS f32x4*)(out + (size_t)m * D + k + 4) = o1;
        }
    }
}

#ifndef PROBE_DUP
#define PROBE_DUP 0
#endif
#ifndef PROBE_DRY
#define PROBE_DRY 1
#endif
#ifndef PROBE_MLV
#define PROBE_MLV 0
#endif
#ifndef SKIP_ATT
#define SKIP_ATT 0
#endif
#ifndef SKIP_MLSTM
#define SKIP_MLSTM 0
#endif

#define GRID_BAR1() do { XcdBarrier b_; b_.bar = (unsigned*)(kargs()->ws + WS_CTL) + CW_BAR; b_.x = xb_xcc_id(); b_.st = (volatile LAS unsigned*)(lds + MISC_OFF) + 8; b_.total = gridDim.x; xcd_barrier(b_); } while (0)
#define GRID_BAR() do { GRID_BAR1(); if (PROBE_DUP & 1024) GRID_BAR1(); } while (0)
#define GROUP_BAR1() do { XcdBarrier b_; b_.bar = (unsigned*)(kargs()->ws + WS_CTL) + CW_BAR + (1 + (bid & 7)) * XCD_BAR_WORDS; b_.x = xb_xcc_id(); b_.st = (volatile LAS unsigned*)(lds + MISC_OFF) + 10; b_.total = gridDim.x / 8; xcd_barrier(b_); } while (0)
#define LAYER_BAR() do { if (grouped) { GROUP_BAR1(); if (PROBE_DUP & 1024) GROUP_BAR1(); } else GRID_BAR(); } while (0)

__global__ void __launch_bounds__(NWAVES * 64, 2) fwd_kernel(Args args_by_value) {
    extern __shared__ __attribute__((aligned(16))) unsigned char lds_raw[];
    LAS unsigned char* lds = (LAS unsigned char*)lds_raw;
    const int w0 = __builtin_amdgcn_readfirstlane((int)threadIdx.x >> 6);
    const int G0 = gridDim.x, bid0 = blockIdx.x; const int G = G0, bid = bid0;
    { const int tid0 = threadIdx.x; if (tid0 < 64) ((volatile LAS unsigned*)(lds + MISC_OFF))[tid0] = 0u; }
    __syncthreads();
    (void)xcd_barrier_post((unsigned*)(kargs()->ws + WS_CTL) + CW_BAR, (volatile LAS unsigned*)(lds + MISC_OFF) + 8);
#ifndef FORCE_UNGROUPED
#define FORCE_UNGROUPED 0
#endif
    const bool grouped = (G0 == 256) && !FORCE_UNGROUPED;
    if (grouped) (void)xcd_barrier_post((unsigned*)(kargs()->ws + WS_CTL) + CW_BAR + (1 + (bid0 & 7)) * XCD_BAR_WORDS, (volatile LAS unsigned*)(lds + MISC_OFF) + 10);
    {
        const int vcu = (G % 8 == 0) ? (bid % 8) * (G / 8) + bid / 8 : bid;
        prologue(kargs(), lds, vcu * NWAVES + w0, G * NWAVES, w0, pg8::pg8_lane());
        if (PROBE_DUP & 1) { WG_BAR(); prologue(kargs(), lds, vcu * NWAVES + w0, G * NWAVES, w0, pg8::pg8_lane()); }
    }
    GRID_BAR();
#ifndef GROUP_STAGGER_TICKS
#define GROUP_STAGGER_TICKS 0
#endif
    if (grouped && (bid0 & 1) && GROUP_STAGGER_TICKS > 0) { const unsigned long long t0 = __builtin_amdgcn_s_memrealtime(); while (__builtin_amdgcn_s_memrealtime() - t0 < (unsigned long long)GROUP_STAGGER_TICKS) __builtin_amdgcn_s_sleep(8); }

    for (int t = 0; t < 3 * DEPTH; ++t) {
        int G = G0, bid = bid0; asm volatile("" : "+s"(G), "+s"(bid));
        const int ng = grouped ? 8 : 1, gx = bid % ng, gy = bid / ng, Gy = G / ng;
        const int layer = t / 3, sub = t % 3;
        const int kind = (sub != 1) ? 0 : ((layer & 1) ? 2 : 1);
        const int j = layer >> 1;
        {
            unsigned char* ws = kargs()->ws;
            float* vec = (float*)(ws + WS_VEC);
            const bf16* R = (const bf16*)(ws + WS_R);
            const float* sp_in = (const float*)(ws + WS_SP) + (size_t)(t & 1) * (SP_BYTES / 4);
            if (kind == 0) {
                const int f = 2 * layer + (sub >> 1);
                pg8::Gemm g{(const bf16*)(ws + WS_R8), (const bf16*)(ws + WS_W13 + (size_t)f * NUP * D), M, NUP, D / 2}; pg8::StaticOrder S; S.init(M, NUP, G, bid);
                pg8::EpiUp E{f, t & 1};
                if (PROBE_DUP & 2048) { S.r1 = 5; pg8::gemm_phase<pg8::EpiUp, pg8::StaticOrder, true, PG8_SP2, true>(lds + RING_OFF, g, S, E, w0); LAYER_BAR(); S.r0 = 5; S.r1 = 1 << 20; }
                pg8::gemm_phase<pg8::EpiUp, pg8::StaticOrder, true, PG8_SP2, true>(lds + RING_OFF, g, S, E, w0);
                if (PROBE_DUP & 16) pg8::gemm_phase<pg8::EpiUp, pg8::StaticOrder, true, PG8_SP2, true>(lds + RING_OFF, g, S, E, w0);
                if (PROBE_DUP & 128) { pg8::EpiNull EN{(float*)(ws + WS_GATES)}; pg8::gemm_phase<pg8::EpiNull, pg8::StaticOrder, true, PG8_SP2, true>(lds + RING_OFF, g, S, EN, w0); }
            } else {
                if (kind == 2) {
                    pg8::Gemm g{R, (const bf16*)(ws + WS_WIN) + (size_t)j * NMI * D, M, NMI, D}; pg8::StaticOrder S; S.init(M, NMI, G, bid);
                    pg8::EpiLnOut E{1, j, t & 1};
                    pg8::gemm_phase<pg8::EpiLnOut, pg8::StaticOrder, true, PG8_SP2>(lds + RING_OFF, g, S, E, w0);
                    if (PROBE_DUP & 32) pg8::gemm_phase<pg8::EpiLnOut, pg8::StaticOrder, true, PG8_SP2>(lds + RING_OFF, g, S, E, w0);
                }
                if (kind == 1) {
                    const int N = kind == 1 ? NQKV : 2048;
                    pg8::Gemm g{(const bf16*)(ws + WS_R8), (const bf16*)(kind == 1 ? ws + WS_WQKV + (size_t)j * NQKV * D : ws + WS_WIN + 32 * MiB + (size_t)j * 2048 * D), M, N, D / 2}; pg8::StaticOrder S; S.init(M, N, G, bid);
                    pg8::EpiLnOut E{kind == 1 ? 0 : 2, j, t & 1};
                    pg8::gemm_phase<pg8::EpiLnOut, pg8::StaticOrder, true, PG8_SP2, true>(lds + RING_OFF, g, S, E, w0);
                    if (PROBE_DUP & 32) pg8::gemm_phase<pg8::EpiLnOut, pg8::StaticOrder, true, PG8_SP2, true>(lds + RING_OFF, g, S, E, w0);
                }
                if (kind == 2) {
                    gates_phase(lds, R, sp_in, (const bf16*)(vec + V_WG / 4) + (size_t)j * 8 * D, vec + V_CG / 4 + j * 16, (float*)(ws + WS_GATES), ng, gx, gy, Gy, w0);
                    if (PROBE_DUP & 8) { WG_BAR(); gates_phase(lds, R, sp_in, (const bf16*)(vec + V_WG / 4) + (size_t)j * 8 * D, vec + V_CG / 4 + j * 16, (float*)(ws + WS_GATES), ng, gx, gy, Gy, w0); }
                }
            }
        }
        LAYER_BAR();
        if (kind == 1) {
            if (!SKIP_ATT) { kargs_t ka = kargs(); unsigned char* ws = ka->ws; attn_phase(lds_raw, (const bf16*)(ws + WS_QKV), ws + WS_AO, ka->sinks + j * 32, ng, gx, gy, Gy, w0);
                if (PROBE_DUP & 2) attn_phase(lds_raw, (const bf16*)(ws + WS_QKV), ws + WS_AO, ka->sinks + j * 32, ng, gx, gy, Gy, w0); }
            LAYER_BAR();
        } else if (kind == 2) {
            if (!SKIP_MLSTM) { unsigned char* ws = kargs()->ws; mlstm_phase(lds_raw, (const bf16*)(ws + WS_MP), (const float*)(ws + WS_GATES), (bf16*)(ws + WS_HG), ng, gx, gy, Gy, w0);
                if (PROBE_DUP & 4) mlstm_phase<PROBE_MLV>(lds_raw, (const bf16*)(ws + WS_MP), (const float*)(ws + WS_GATES), (bf16*)(ws + WS_H), ng, gx, gy, Gy, w0); }
            LAYER_BAR();
        }
        {
            kargs_t ka = kargs(); unsigned char* ws = ka->ws;
            float coef = kind == 0 ? 0.5f / (pg8::F8_SH * pg8::F8_SW) : (kind == 1 ? 1.f / (pg8::F8_SO * pg8::F8_SW) : 1.f);
            if ((kind == 1 && SKIP_ATT) || (kind == 2 && SKIP_MLSTM)) coef = 0.f;
            pg8::StaticOrder S; S.init(M, D, G, bid);
            pg8::EpiRes E{t, coef, (LAS float*)(lds + TAB_OFF), w0, 0};
            if (kind != 2) {
                const int f = 2 * layer + (sub >> 1);
                pg8::Gemm g{(const bf16*)(ws + (kind == 0 ? WS_H : WS_AO)), (const bf16*)(kind == 0 ? ws + WS_W2 + (size_t)f * D * FF : ws + WS_WO + (size_t)j * D * D), M, D, kind == 0 ? FF / 2 : D / 2};
                if (PROBE_DUP & 64) { pg8::EpiNull EN{(float*)(ws + WS_GATES)}; pg8::gemm_phase<pg8::EpiNull, pg8::StaticOrder, true, PG8_SP2, true>(lds + RING_OFF, g, S, EN, w0); }
                if (PROBE_DUP & 512) { pg8::EpiRes ED{t, coef, (LAS float*)(lds + TAB_OFF), w0, PROBE_DRY}; pg8::gemm_phase<pg8::EpiRes, pg8::StaticOrder, true, PG8_SP2, true>(lds + RING_OFF, g, S, ED, w0); }
                pg8::gemm_phase<pg8::EpiRes, pg8::StaticOrder, true, PG8_SP2, true>(lds + RING_OFF, g, S, E, w0);
            } else {
                pg8::Gemm g{(const bf16*)(ws + WS_HG), (const bf16*)(ws + WS_WMO) + (size_t)j * D * D, M, D, D};
                if (PROBE_DUP & 256) { pg8::EpiNull EN{(float*)(ws + WS_GATES)}; pg8::gemm_phase<pg8::EpiNull, pg8::StaticOrder, true, PG8_SP2, false>(lds + RING_OFF, g, S, EN, w0); }
                pg8::gemm_phase<pg8::EpiRes, pg8::StaticOrder, true, PG8_SP2, false>(lds + RING_OFF, g, S, E, w0);
            }
        }
        LAYER_BAR();
    }
    {
        kargs_t ka = kargs(); unsigned char* ws = ka->ws;
        const int ng = grouped ? 8 : 1, gx = bid % ng, gy = bid / ng, Gy = G / ng;
        final_ln((const bf16*)(ws + WS_R), (const float*)(ws + WS_SP), ka->ln_g + (size_t)(3 * DEPTH - 1) * D, ka->ln_b + (size_t)(3 * DEPTH - 1) * D, ka->out, ng, gx, gy * NWAVES + w0, Gy * NWAVES, pg8::pg8_lane());
    }
}

extern "C" void kernel_launch(void* const* d_in, const int* in_sizes, int n_in, void* d_out, int out_size, void* d_ws, size_t ws_size, hipStream_t stream) {
    static int grid = 0;
    if (grid == 0) {
        if (n_in != 12 || in_sizes[0] != M * D || out_size != M * D || ws_size < WS_END) { fprintf(stderr, "kernel_launch: unexpected shapes / workspace (n_in %d, ws %zu < %zu); nothing launched\n", n_in, ws_size, (size_t)WS_END); grid = -1; return; }
        int dev = 0, cus = 0;
        if (hipGetDevice(&dev) != hipSuccess || hipDeviceGetAttribute(&cus, hipDeviceAttributeMultiprocessorCount, dev) != hipSuccess) { grid = -1; return; }
        if (hipFuncSetAttribute((const void*)fwd_kernel, hipFuncAttributeMaxDynamicSharedMemorySize, LDS_BYTES) != hipSuccess) { fprintf(stderr, "kernel_launch: hipFuncSetAttribute failed\n"); grid = -1; return; }
        int per_cu = 0;
        if (hipOccupancyMaxActiveBlocksPerMultiprocessor(&per_cu, (const void*)fwd_kernel, NWAVES * 64, LDS_BYTES) != hipSuccess || per_cu < 1) { fprintf(stderr, "kernel_launch: occupancy query says %d\n", per_cu); }
        (void)hipGetLastError();
        grid = cus;
#ifdef FORCE_GRID
        grid = FORCE_GRID;
#endif
    }
    if (grid < 0) return;
    (void)hipMemsetAsync((char*)d_ws + WS_CTL, 0, CTL_ZERO_BYTES, stream);
    Args a{};
    a.x = (const float*)d_in[0]; a.w1 = (const float*)d_in[1]; a.w3 = (const float*)d_in[2]; a.w2 = (const float*)d_in[3]; a.ln_g = (const float*)d_in[4]; a.ln_b = (const float*)d_in[5];
    a.wqkv = (const float*)d_in[6]; a.sinks = (const float*)d_in[7]; a.wo = (const float*)d_in[8]; a.win = (const float*)d_in[9]; a.bg = (const float*)d_in[10]; a.wmo = (const float*)d_in[11];
    a.out = (float*)d_out; a.ws = (unsigned char*)d_ws;
    hipLaunchKernelGGL(fwd_kernel, dim3(grid), dim3(NWAVES * 64), LDS_BYTES, stream, a);
}
```

```cpp
#include <hip/hip_runtime.h>
#include <hip/hip_bf16.h>
#include <cstdio>
#include <cstdint>
#include <cmath>

constexpr int BATCH = 8, SEQ = 2048, D = 2048, FF = 5632, DEPTH = 4;
constexpr int M = BATCH * SEQ;
constexpr int NUP = 2 * FF;
constexpr int NQKV = 2560;
constexpr int NMI = 6144, NMIW = 6152;
constexpr float LN_EPS = 1e-5f;
constexpr float ALPHA = 1.681792830507429f;
constexpr float LOG2E = 1.4426950408889634f;

constexpr size_t MiB = 1u << 20;
constexpr size_t WS_CTL = 0, CTL_ZERO_BYTES = 192 * 1024;
constexpr size_t WS_W13 = 2 * MiB;
constexpr size_t WS_W2 = 178 * MiB;
constexpr size_t WS_WQKV = 266 * MiB;
constexpr size_t WS_WO = 286 * MiB;
constexpr size_t WS_WIN = 302 * MiB;
constexpr size_t WS_WMO = 350 * MiB;
constexpr size_t WS_VEC = 366 * MiB;
constexpr size_t V_C1U = 0, V_C2U = 360448, V_C1Q = 720896, V_C2Q = 741376, V_C1I = 761856, V_C2I = 811008, V_CG = 860160, V_WG = 860416, V_ONES = 991488, V_ZEROS = 999680;
constexpr size_t WS_R = 368 * MiB;
constexpr size_t WS_R8 = 432 * MiB;
constexpr size_t WS_SP = 464 * MiB;
constexpr size_t SP_BYTES = (size_t)M * 16 * 4;
constexpr size_t WS_H = 466 * MiB;
constexpr size_t WS_QKV = 554 * MiB;
constexpr size_t WS_AO = 634 * MiB;
constexpr size_t WS_MP = 698 * MiB;
constexpr size_t WS_GATES = 890 * MiB;
constexpr size_t WS_HG = 891 * MiB;
constexpr size_t WS_END = 955 * MiB;
constexpr int CW_TMO = 0, CW_BAR = 4096;

struct Args { const float* x; const float* w1; const float* w3; const float* w2; const float* ln_g; const float* ln_b; const float* wqkv; const float* sinks; const float* wo;
              const float* win; const float* bg; const float* wmo; float* out; unsigned char* ws; };
typedef const __attribute__((address_space(4))) Args* kargs_t;
__device__ __forceinline__ kargs_t kargs() { kargs_t p = (kargs_t)__builtin_amdgcn_kernarg_segment_ptr(); asm volatile("" : "+s"(p)); return p; }

namespace pg8 {
#define PG8_LAS __attribute__((address_space(3)))
typedef unsigned short bf16_t;
typedef short bf16x8 __attribute__((ext_vector_type(8)));
typedef _Float16 f16x8 __attribute__((ext_vector_type(8)));
typedef float f32x4 __attribute__((ext_vector_type(4)));
typedef unsigned u32x4 __attribute__((ext_vector_type(4)));
constexpr int BM = 256, BK = 64, HALF = 128, HTB = HALF * BK * 2  , STAGE_BYTES = 8 * HTB, NXCD = 8, WGM = 8;

__host__ __device__ __forceinline__ int lds_byte(int r, int c) { const int st = (r >> 4) * 2 + (c >> 5), rr = r & 15, cc = c & 31, ob = rr * 64 + cc * 2; return st * 1024 + (ob ^ (((ob >> 9) & 1) << 5)); }
__host__ __device__ __forceinline__ void stage_rc(int b, int& R, int& C) { const int st = b / 1024, sb = b % 1024, swz = sb ^ (((sb >> 9) & 1) << 5); R = (st >> 1) * 16 + swz / 64; C = (st & 1) * 32 + (swz % 64) / 2; }
__host__ __device__ __forceinline__ int perm32(int rho) { const int n = rho >> 4, i = rho & 15; return 8 * (i >> 2) + 4 * n + (i & 3); }

typedef int i32x4 __attribute__((ext_vector_type(4)));
typedef int i32x8 __attribute__((ext_vector_type(8)));
constexpr float F8_SR = 8.f, F8_SW = 1024.f, F8_SH = 16.f, F8_SO = 64.f;
__device__ __forceinline__ i32x8 cat_i8(bf16x8 lo, bf16x8 hi) { const i32x4 a = __builtin_bit_cast(i32x4, lo), b = __builtin_bit_cast(i32x4, hi); return __builtin_shufflevector(a, b, 0, 1, 2, 3, 4, 5, 6, 7); }
__device__ __forceinline__ void mfma_f8_inplace(f32x4& c, const i32x8 a, const i32x8 b) { asm volatile("v_mfma_f32_16x16x128_f8f6f4 %0, %1, %2, %0 cbsz:0 blgp:0" : "+v"(c) : "v"(a), "v"(b)); }
typedef unsigned u32x2 __attribute__((ext_vector_type(2)));
__device__ __forceinline__ u32x2 cvt8_f8(const float (&v)[8], float s) {
    int a, b; asm volatile("" : "=v"(a), "=v"(b));
    a = __builtin_amdgcn_cvt_pk_fp8_f32(v[0] * s, v[1] * s, a, false); a = __builtin_amdgcn_cvt_pk_fp8_f32(v[2] * s, v[3] * s, a, true);
    b = __builtin_amdgcn_cvt_pk_fp8_f32(v[4] * s, v[5] * s, b, false); b = __builtin_amdgcn_cvt_pk_fp8_f32(v[6] * s, v[7] * s, b, true);
    return (u32x2){(unsigned)a, (unsigned)b};
}
__device__ __forceinline__ u32x2 cvt8_f8_raw(const float (&v)[8]) {
    int a, b; asm volatile("" : "=v"(a), "=v"(b));
    a = __builtin_amdgcn_cvt_pk_fp8_f32(v[0], v[1], a, false); a = __builtin_amdgcn_cvt_pk_fp8_f32(v[2], v[3], a, true);
    b = __builtin_amdgcn_cvt_pk_fp8_f32(v[4], v[5], b, false); b = __builtin_amdgcn_cvt_pk_fp8_f32(v[6], v[7], b, true);
    return (u32x2){(unsigned)a, (unsigned)b};
}
__device__ __forceinline__ int pg8_lane() { int l; asm volatile("v_mbcnt_lo_u32_b32 %0, -1, 0\n\tv_mbcnt_hi_u32_b32 %0, -1, %0" : "=v"(l)); return l; }
struct Unit { int pm, pn, ord; };
struct Gemm { const bf16_t* A; const bf16_t* Bt; int M, N, K; };

struct StaticOrder {
    int nM, nN, nwg, G, c, r0 = 0, r1 = 1 << 20;
    __host__ __device__ void init(int M_, int N_, int G_, int c_) { nM = M_ / BM; nN = N_ / BM; nwg = nM * nN; G = G_; c = c_; }
    __host__ __device__ bool next(int i, Unit& u) const {
        i += r0; if (i >= r1) return false;
        const long L = (long)i * G + c; if (L >= nwg) return false;
        int wgid = (int)L; { const int q = nwg / NXCD, r = nwg % NXCD, xcd = wgid % NXCD, off = wgid / NXCD; wgid = (xcd < r ? xcd * (q + 1) : r * (q + 1) + (xcd - r) * q) + off; }
        const int nig = WGM * nN, gid = wgid / nig, fm = gid * WGM, gsz = (nM - fm) < WGM ? (nM - fm) : WGM;
        u.pm = fm + ((wgid % nig) % gsz); u.pn = (wgid % nig) / gsz; u.ord = i - r0; return true;
    }
    __device__ __forceinline__ void a_ready(const Unit&) const {}
    __device__ __forceinline__ void done(const Unit&) const {}
};

__device__ __forceinline__ unsigned cvt_pk_bf16(float lo, float hi) { typedef float f2 __attribute__((ext_vector_type(2))); typedef _Float16 b2 __attribute__((ext_vector_type(2))); f2 v = {lo, hi}; b2 b = __builtin_convertvector(v, b2); return __builtin_bit_cast(unsigned, b); }
__device__ __forceinline__ float bf_lo(unsigned w) { typedef _Float16 b2 __attribute__((ext_vector_type(2))); return (float)__builtin_bit_cast(b2, w)[0]; }
__device__ __forceinline__ float bf_hi(unsigned w) { typedef _Float16 b2 __attribute__((ext_vector_type(2))); return (float)__builtin_bit_cast(b2, w)[1]; }
__device__ __forceinline__ float fsigmoid(float x) { return __builtin_amdgcn_rcpf(1.f + __builtin_amdgcn_exp2f(-LOG2E * x)); }

__device__ __forceinline__ float sum_fq(float v) {
    auto a = __builtin_amdgcn_permlane16_swap(__float_as_uint(v), __float_as_uint(v), false, false); v = __uint_as_float(a[0]) + __uint_as_float(a[1]);
    auto b = __builtin_amdgcn_permlane32_swap(__float_as_uint(v), __float_as_uint(v), false, false); return __uint_as_float(b[0]) + __uint_as_float(b[1]);
}
constexpr int STAB_OFF = 131072 + 16384;
__device__ __forceinline__ void stats_prep(const float* sp, int pm, int wave) {
    PG8_LAS float* stab = (PG8_LAS float*)(STAB_OFF);
    const int tid = wave * 64 + pg8_lane();
    if (tid < BM) {
        const f32x4* p = (const f32x4*)(sp + (size_t)(pm * BM + tid) * 16);
        const f32x4 v0 = p[0], v1 = p[1], v2 = p[2], v3 = p[3];
        const float s = ((v0[0] + v0[2]) + (v1[0] + v1[2])) + ((v2[0] + v2[2]) + (v3[0] + v3[2])), q = ((v0[1] + v0[3]) + (v1[1] + v1[3])) + ((v2[1] + v2[3]) + (v3[1] + v3[3]));
        const float mean = s * (1.f / D), var = q * (1.f / D) - mean * mean;
        typedef float f32x2v __attribute__((ext_vector_type(2)));
        *(PG8_LAS f32x2v*)(stab + 2 * tid) = (f32x2v){mean, __builtin_amdgcn_rsqf(var + LN_EPS)};
    }
    if (tid == 0) *(PG8_LAS int*)(stab + 2 * BM) = pm;
}
constexpr int CTAB_OFF = STAB_OFF + 2048 + 64, CTAB_UNITS = 11;
template <class Sched> __device__ __forceinline__ void ctab_prep(const Sched& S, const float* c1, const float* c2, int wave, float s_lo, float s_hi) {
    const int tid = wave * 64 + pg8_lane();
    const float sc = (tid & HALF) ? s_hi : s_lo;
    Unit u;
    for (int i = 0; i < CTAB_UNITS && S.next(i, u); ++i) {
        const float v = tid < BM ? c1[u.pn * BM + tid] : c2[u.pn * BM + tid - BM];
        typedef _Float16 h1;
        *(PG8_LAS h1*)(CTAB_OFF + i * 1024 + tid * 2) = (h1)(v * sc);
    }
}
__device__ __forceinline__ void ctab_get8(int ord, int which, int lc, float (&o)[8]) {
    typedef _Float16 h8 __attribute__((ext_vector_type(8)));
    const h8 v = *(PG8_LAS const h8*)(CTAB_OFF + ord * 1024 + which * 512 + lc * 2);
#pragma unroll
    for (int i = 0; i < 8; ++i) o[i] = (float)v[i];
}
__device__ __forceinline__ void row_stats(const float* sp, int row0, int fq, float (&mu)[2][4], float (&rs)[2][4]) {
    { PG8_LAS const float* stab = (PG8_LAS const float*)(STAB_OFF); const int pm = row0 / BM;
      if (*(PG8_LAS const int*)(stab + 2 * BM) == pm) {
          typedef float f32x2v __attribute__((ext_vector_type(2)));
#pragma unroll
          for (int ai = 0; ai < 2; ++ai)
#pragma unroll
              for (int m = 0; m < 4; ++m) { const f32x2v v = *(PG8_LAS const f32x2v*)(stab + 2 * ((row0 % BM) + ai * HALF + m * 16)); mu[ai][m] = v[0]; rs[ai][m] = v[1]; }
          return; } }
#pragma unroll
    for (int ai = 0; ai < 2; ++ai)
#pragma unroll
        for (int m = 0; m < 4; ++m) {
            const f32x4 v = *(const f32x4*)(sp + (size_t)(row0 + ai * HALF + m * 16) * 16 + fq * 4);
            float s = v[0] + v[2], q = v[1] + v[3];
            s = sum_fq(s); q = sum_fq(q);
            const float mean = s * (1.f / D), var = q * (1.f / D) - mean * mean;
            mu[ai][m] = mean; rs[ai][m] = __builtin_amdgcn_rsqf(var + LN_EPS);
        }
}

struct EpiNull {
    static constexpr bool PERM = true, AFTER_DRAIN = false; static constexpr int MIN_VM_OPS = 0;
    template <class Sched> __device__ __forceinline__ void prep(const Sched&, const Unit&, int) const {}
    float* sink;
    __device__ __forceinline__ void operator()(const f32x4 (&acc)[2][2][4][2], const Unit& u, int wr, int wc, int, int) const {
        float s = 0.f;
#pragma unroll
        for (int ai = 0; ai < 2; ++ai)
#pragma unroll
            for (int bj = 0; bj < 2; ++bj)
#pragma unroll
                for (int m = 0; m < 4; ++m)
#pragma unroll
                    for (int n = 0; n < 2; ++n) s += acc[ai][bj][m][n][0] + acc[ai][bj][m][n][1] + acc[ai][bj][m][n][2] + acc[ai][bj][m][n][3];
        if (s == 123.456f) sink[u.pm + wr + wc] = s;
    }
};

template <bool TAB, int PRB = 0> struct EpiUpT {
    static constexpr bool PERM = true, AFTER_DRAIN = false; static constexpr int MIN_VM_OPS = 4;
    static constexpr float CG = -LOG2E, CU = -F8_SH / LOG2E;
    template <class Sched> __device__ __forceinline__ void prep(const Sched& S, const Unit& u, int wave) const { unsigned char* ws = kargs()->ws;
        stats_prep((const float*)(ws + WS_SP) + (size_t)tpar * (SP_BYTES / 4), u.pm, wave);
        ctab_prep(S, (const float*)(ws + WS_VEC + V_C1U) + (size_t)f * NUP, (const float*)(ws + WS_VEC + V_C2U) + (size_t)f * NUP, wave, CG, CU); }
    int f, tpar;
    __device__ __forceinline__ void operator()(const f32x4 (&acc)[2][2][4][2], const Unit& u, int wr, int wc, int, int) const {
        const int lane_ = pg8_lane(), fr = lane_ & 15, fq = lane_ >> 4;
        const int row0 = u.pm * BM + wr * 64 + fr;
        int f = this->f, tpar = this->tpar; asm volatile("" : "+s"(f), "+s"(tpar));
        unsigned char* ws = kargs()->ws; unsigned char* H = ws + ((PRB & 4) ? WS_MP : WS_H);
        float mu[2][4], rs[2][4];
        float k1[2][8], k2[2][8];
        if constexpr (TAB) {
            typedef float f32x2v __attribute__((ext_vector_type(2))); PG8_LAS const float* stab = (PG8_LAS const float*)(STAB_OFF);
#pragma unroll
            for (int ai = 0; ai < 2; ++ai)
#pragma unroll
                for (int m = 0; m < 4; ++m) { const f32x2v v = *(PG8_LAS const f32x2v*)(stab + 2 * ((row0 % BM) + ai * HALF + m * 16)); mu[ai][m] = v[0]; rs[ai][m] = v[1]; }
#pragma unroll
            for (int bj = 0; bj < 2; ++bj) { ctab_get8(u.ord, 0, wc * 32 + 8 * fq + bj * HALF, k1[bj]); ctab_get8(u.ord, 1, wc * 32 + 8 * fq + bj * HALF, k2[bj]); }
        } else {
            const float* c1 = (const float*)(ws + WS_VEC + V_C1U) + (size_t)f * NUP; const float* c2 = (const float*)(ws + WS_VEC + V_C2U) + (size_t)f * NUP; const float* sp = (const float*)(ws + WS_SP) + (size_t)tpar * (SP_BYTES / 4);
            row_stats(sp, row0, fq, mu, rs);
            const int cb = u.pn * BM + wc * 32 + 8 * fq;
            if (u.ord < CTAB_UNITS) {
#pragma unroll
                for (int bj = 0; bj < 2; ++bj) { ctab_get8(u.ord, 0, wc * 32 + 8 * fq + bj * HALF, k1[bj]); ctab_get8(u.ord, 1, wc * 32 + 8 * fq + bj * HALF, k2[bj]); }
            } else {
#pragma unroll
                for (int bj = 0; bj < 2; ++bj)
#pragma unroll
                    for (int i = 0; i < 8; ++i) { k1[bj][i] = c1[cb + bj * HALF + i] * (bj ? CU : CG); k2[bj][i] = c2[cb + bj * HALF + i] * (bj ? CU : CG); }
            }
        }
        unsigned char* hp = H + (size_t)(row0 + (fq & 1) * 16) * FF + u.pn * HALF + wc * 32 + 8 * (fq & 2);
        u32x2 keep = {0u, 0u};
#pragma unroll
        for (int ai = 0; ai < 2; ++ai)
#pragma unroll
            for (int m = 0; m < 4; ++m) {
                const float r_ = rs[ai][m], nm = -mu[ai][m] * r_, ra = r_ * (1.f / (F8_SR * F8_SW)), raG = ra * CG, raU = ra * CU;
                typedef float f2 __attribute__((ext_vector_type(2)));
                f2 ga[4], ub[4], sg[4];
#pragma unroll
                for (int n = 0; n < 2; ++n)
#pragma unroll
                    for (int jj = 0; jj < 2; ++jj) {
                        const int c = 4 * n + 2 * jj;
                        const f2 ag = {acc[ai][0][m][n][2 * jj], acc[ai][0][m][n][2 * jj + 1]}, au = {acc[ai][1][m][n][2 * jj], acc[ai][1][m][n][2 * jj + 1]};
                        const f2 k1g = {k1[0][c], k1[0][c + 1]}, k2g = {k2[0][c], k2[0][c + 1]}, k1u = {k1[1][c], k1[1][c + 1]}, k2u = {k2[1][c], k2[1][c + 1]};
                        ga[2 * n + jj] = ag * raG + (k1g * nm + k2g);
                        ub[2 * n + jj] = au * raU + (k1u * nm + k2u);
                    }
#pragma unroll
                for (int i = 0; i < 4; ++i) sg[i] = (PRB & 1) ? ga[i] : (f2){__builtin_amdgcn_exp2f(ga[i][0]), __builtin_amdgcn_exp2f(ga[i][1])};
#pragma unroll
                for (int i = 0; i < 4; ++i) { const f2 t = sg[i] + 1.f; sg[i] = (PRB & 1) ? t : (f2){__builtin_amdgcn_rcpf(t[0]), __builtin_amdgcn_rcpf(t[1])}; }
                float hv[8];
#pragma unroll
                for (int i = 0; i < 4; ++i) { const f2 h2 = ga[i] * sg[i] * ub[i]; hv[2 * i] = h2[0]; hv[2 * i + 1] = h2[1]; }
                const u32x2 xb = cvt8_f8_raw(hv);
                if ((m & 1) == 0) keep = xb;
                else {
                    const auto s0 = __builtin_amdgcn_permlane16_swap(keep.x, xb.x, false, false), s1 = __builtin_amdgcn_permlane16_swap(keep.y, xb.y, false, false);
                    if (!(PRB & 2) || ((hv[0] + hv[1]) + (hv[2] + hv[3])) + ((hv[4] + hv[5]) + (hv[6] + hv[7])) == 123.456f) *(u32x4*)(hp + (size_t)(ai * HALF + (m - 1) * 16) * FF) = (u32x4){s0[0], s1[0], s0[1], s1[1]};
                }
            }
    }
};
typedef EpiUpT<false> EpiUp;

struct EpiLnOut {
    static constexpr bool PERM = true, AFTER_DRAIN = false; static constexpr int MIN_VM_OPS = 0 * 16;
    template <class Sched> __device__ __forceinline__ void prep(const Sched&, const Unit& u, int wave) const { stats_prep((const float*)(kargs()->ws + WS_SP) + (size_t)tpar * (SP_BYTES / 4), u.pm, wave); }
    int mode, j, tpar;
    __device__ __forceinline__ void operator()(const f32x4 (&acc)[2][2][4][2], const Unit& u, int wr, int wc, int, int) const {
        const int lane_ = pg8_lane(), fr = lane_ & 15, fq = lane_ >> 4;
        const int row0 = u.pm * BM + wr * 64 + fr;
        int mode = this->mode, j = this->j, tpar = this->tpar; asm volatile("" : "+s"(mode), "+s"(j), "+s"(tpar));
        const bool att = mode == 0; const int coff = mode == 2 ? 4096 : 0;
        unsigned char* ws = kargs()->ws; bf16_t* O = (bf16_t*)(ws + (att ? WS_QKV : WS_MP)) + coff; const int ldo = att ? NQKV : NMI, sig_from = mode == 2 ? 0 : (mode == 1 ? 16 : 1000);
        const float ascale = mode == 1 ? 1.f : 1.f / (F8_SR * F8_SW);
        const float* c1 = (const float*)(ws + WS_VEC + (att ? V_C1Q : V_C1I)) + j * ldo + coff; const float* c2 = (const float*)(ws + WS_VEC + (att ? V_C2Q : V_C2I)) + j * ldo + coff; const float* sp = (const float*)(ws + WS_SP) + (size_t)tpar * (SP_BYTES / 4);
        float mu[2][4], rs[2][4]; row_stats(sp, row0, fq, mu, rs);
        const int cb = u.pn * BM + wc * 32 + 8 * fq;
        const bool sg = u.pn >= sig_from;
        f32x4 k1[2][2], k2[2][2];
#pragma unroll
        for (int bj = 0; bj < 2; ++bj)
#pragma unroll
            for (int n = 0; n < 2; ++n) { k1[bj][n] = *(const f32x4*)(c1 + cb + bj * HALF + 4 * n); k2[bj][n] = *(const f32x4*)(c2 + cb + bj * HALF + 4 * n); }
        bf16_t* op = O + (size_t)row0 * ldo + cb;
#define LNOUT_ROWS(SIG) _Pragma("unroll") for (int ai = 0; ai < 2; ++ai) _Pragma("unroll") for (int m = 0; m < 4; ++m) { \
            const float r_ = rs[ai][m], nm = -mu[ai][m] * r_, ra = r_ * ascale; \
            _Pragma("unroll") for (int bj = 0; bj < 2; ++bj) { \
                typedef float f2 __attribute__((ext_vector_type(2))); float v[8]; \
                _Pragma("unroll") for (int n = 0; n < 2; ++n) _Pragma("unroll") for (int jj = 0; jj < 2; ++jj) { \
                    const f2 a2 = {acc[ai][bj][m][n][2 * jj], acc[ai][bj][m][n][2 * jj + 1]}, c1v = {k1[bj][n][2 * jj], k1[bj][n][2 * jj + 1]}, c2v = {k2[bj][n][2 * jj], k2[bj][n][2 * jj + 1]}; \
                    f2 t = a2 * ra + (c1v * nm + c2v); \
                    if (SIG) { const f2 e = t * (-LOG2E); const f2 d = (f2){__builtin_amdgcn_exp2f(e[0]), __builtin_amdgcn_exp2f(e[1])} + 1.f; t = (f2){__builtin_amdgcn_rcpf(d[0]), __builtin_amdgcn_rcpf(d[1])}; } \
                    v[4 * n + 2 * jj] = t[0]; v[4 * n + 2 * jj + 1] = t[1]; } \
                u32x4 w; w.x = cvt_pk_bf16(v[0], v[1]); w.y = cvt_pk_bf16(v[2], v[3]); w.z = cvt_pk_bf16(v[4], v[5]); w.w = cvt_pk_bf16(v[6], v[7]); \
                *(u32x4*)(op + (size_t)(ai * HALF + m * 16) * ldo + bj * HALF) = w; } }
        const int sgi = __builtin_amdgcn_readfirstlane(sg ? 1 : 0);
        if (sgi) { LNOUT_ROWS(true) } else { LNOUT_ROWS(false) }
#undef LNOUT_ROWS
    }
};

struct EpiRes {
    static constexpr bool PERM = true, AFTER_DRAIN = false; static constexpr int MIN_VM_OPS = 0 * 32;
    template <class Sched> __device__ __forceinline__ void prep(const Sched&, const Unit& u, int wave) const { stats_prep((const float*)(kargs()->ws + WS_SP) + (size_t)(t & 1) * (SP_BYTES / 4), u.pm, wave); }
    int t; float coef; PG8_LAS float* tab; int wave; int dry;
    __device__ __forceinline__ void operator()(const f32x4 (&acc)[2][2][4][2], const Unit& u, int wr, int wc, int, int) const {
        const int lane_ = pg8_lane(), fr = lane_ & 15, fq = lane_ >> 4;
        typedef float f32x2v __attribute__((ext_vector_type(2)));
        const int row0 = u.pm * BM + wr * 64 + fr;
        int t = this->t; asm volatile("" : "+s"(t)); float coef = this->coef; asm volatile("" : "+v"(coef));
        const bool need8 = (t != 3 && t != 9 && t != 11) || dry;
        kargs_t ka = kargs(); unsigned char* ws = ka->ws; bf16_t* R = (bf16_t*)(ws + WS_R); unsigned char* R8 = ws + (dry ? WS_MP + 64 * MiB : WS_R8); bf16_t* Ro = dry ? (bf16_t*)(ws + WS_MP) : R;
        const float* g = t ? ka->ln_g + (size_t)(t - 1) * D : (const float*)(ws + WS_VEC + V_ONES); const float* b = t ? ka->ln_b + (size_t)(t - 1) * D : (const float*)(ws + WS_VEC + V_ZEROS);
        const float* sp_in = (const float*)(ws + WS_SP) + (size_t)(t & 1) * (SP_BYTES / 4); float* sp_out = dry ? (float*)(ws + WS_MP + 96 * MiB) : (float*)(ws + WS_SP) + (size_t)((t + 1) & 1) * (SP_BYTES / 4);
        const int cb0 = u.pn * BM + wc * 32 + 8 * fq;
        u32x4 cur[4];
#pragma unroll
        for (int m = 0; m < 4; ++m) cur[m] = *(const u32x4*)(R + (size_t)(row0 + m * 16) * D + cb0);
        float mu[2][4], rs[2][4]; row_stats(sp_in, row0, fq, mu, rs);
        f32x4 gv[2], bv[2];
#pragma unroll
        for (int k = 0; k < 4; ++k) {
            const int bj = k >> 1, ai = k & 1, cb = cb0 + bj * HALF;
            if (ai == 0) {
#pragma unroll
                for (int n = 0; n < 2; ++n) { gv[n] = *(const f32x4*)(g + cb + 4 * n); bv[n] = *(const f32x4*)(b + cb + 4 * n) * ALPHA; }
            }
#pragma unroll
            for (int m = 0; m < 4; ++m) {
                const float A_ = ALPHA * rs[ai][m], B_ = -mu[ai][m] * A_;
                const size_t off = (size_t)(row0 + ai * HALF + m * 16) * D + cb;
                const u32x4 o = cur[m];
                if (k < 3 && dry != 3) cur[m] = *(const u32x4*)(R + (size_t)(row0 + ((k + 1) & 1) * HALF + m * 16) * D + cb0 + ((k + 1) >> 1) * HALF);
                typedef float fv2 __attribute__((ext_vector_type(2)));
                float nv[8];
#pragma unroll
                for (int n = 0; n < 2; ++n)
#pragma unroll
                    for (int jj = 0; jj < 2; ++jj) {
                        const unsigned w2 = n == 0 ? (jj == 0 ? o.x : o.y) : (jj == 0 ? o.z : o.w); const fv2 r2 = {bf_lo(w2), bf_hi(w2)}, a2 = {acc[ai][bj][m][n][2 * jj], acc[ai][bj][m][n][2 * jj + 1]};
                        const fv2 g2 = {gv[n][2 * jj], gv[n][2 * jj + 1]}, b2 = {bv[n][2 * jj], bv[n][2 * jj + 1]};
                        const fv2 t = (r2 * A_ + B_) * g2 + (a2 * coef + b2);
                        nv[4 * n + 2 * jj] = t[0]; nv[4 * n + 2 * jj + 1] = t[1];
                    }
                u32x4 w; w.x = cvt_pk_bf16(nv[0], nv[1]); w.y = cvt_pk_bf16(nv[2], nv[3]); w.z = cvt_pk_bf16(nv[4], nv[5]); w.w = cvt_pk_bf16(nv[6], nv[7]);
                if (dry != 2) { *(u32x4*)(Ro + off) = w;
                if (need8) *(u32x2*)(R8 + off) = cvt8_f8(nv, F8_SR); }
                const float f0 = bf_lo(w.x), f1 = bf_hi(w.x), f2 = bf_lo(w.y), f3 = bf_hi(w.y), f4 = bf_lo(w.z), f5 = bf_hi(w.z), f6 = bf_lo(w.w), f7 = bf_hi(w.w);
                float s = ((f0 + f1) + (f2 + f3)) + ((f4 + f5) + (f6 + f7));
                float q = ((f0 * f0 + f1 * f1) + (f2 * f2 + f3 * f3)) + ((f4 * f4 + f5 * f5) + (f6 * f6 + f7 * f7));
                s = sum_fq(s); q = sum_fq(q);
                if (fq == 0) *(PG8_LAS f32x2v*)(tab + (((ai * HALF + wr * 64 + m * 16 + fr) * 4 + wc) * 2 + bj) * 2) = (f32x2v){s, q};
                asm volatile("" ::: "memory");
            }
        }
        asm volatile("s_waitcnt lgkmcnt(0)" ::: "memory"); __builtin_amdgcn_s_barrier(); asm volatile("" ::: "memory");
        const int tid = wave * 64 + pg8_lane();
        if (tid < BM) {
            const PG8_LAS f32x4* t4 = (const PG8_LAS f32x4*)(tab + tid * 16);
            const f32x4 a = t4[0], c = t4[1], d = t4[2], e = t4[3];
            *(f32x2v*)(sp_out + (size_t)(u.pm * BM + tid) * 16 + u.pn * 2) = (f32x2v){((a[0] + a[2]) + (c[0] + c[2])) + ((d[0] + d[2]) + (e[0] + e[2])), ((a[1] + a[3]) + (c[1] + c[3])) + ((d[1] + d[3]) + (e[1] + e[3]))};
        }
    }
};

template <class Epi, class Sched, bool ALIGN_EPI = false, bool SP2 = false, bool F8 = false>
__device__ __forceinline__ void gemm_phase(PG8_LAS unsigned char* lds, const Gemm g, const Sched& S, const Epi& E, int wave_in) {
    int wid = wave_in; asm volatile("" : "+s"(wid));
    const int lane = pg8_lane(), tid = wid * 64 + lane, wr = wid >> 2, wc = wid & 3, fr = lane & 15, fq = lane >> 4;
    const int K = g.K, nt = K / BK;
    unsigned voffA[2], voffB[2];
#pragma unroll
    for (int i = 0; i < 2; ++i) { int R, C; stage_rc(tid * 16 + i * 8192, R, C); const int Rb = Epi::PERM ? ((R & ~31) + perm32(R & 31)) : R;
        voffA[i] = (unsigned)(R * K + C) * 2u; voffB[i] = (unsigned)(Rb * K + C) * 2u; }
    const size_t kstep = (size_t)(BK * 2);
    const size_t hstep = (size_t)HALF * K * 2;
    const size_t tstep = 2 * hstep;
    const unsigned ldsw = (unsigned)wid * 1024u;
    const int aoff = lds_byte(wr * 64 + fr, fq * 8), boff = lds_byte(wc * 32 + fr, fq * 8);
#define PG8_SA(b, h) (((b) * 2 + (h)) * HTB)
#define PG8_SB(b, h) ((4 + (b) * 2 + (h)) * HTB)
#ifndef PG8_B_AUX
#define PG8_B_AUX 0
#endif
#define PG8_STAGE_AUX(bufoff, gbase, voff, aux) do { _Pragma("unroll") for (int _i = 0; _i < 2; ++_i) \
        __builtin_amdgcn_global_load_lds((const unsigned*)((const char*)(gbase) + (voff)[_i]), (PG8_LAS unsigned*)(lds + (bufoff) + ldsw + _i * 8192), 16, 0, aux); } while (0)
#define PG8_STAGE(bufoff, gbase, voff) PG8_STAGE_AUX(bufoff, gbase, voff, PG8_IS_B(bufoff) ? PG8_B_AUX : 0)
#define PG8_IS_B(bufoff) ((bufoff) >= 4 * HTB)
#define PG8_LDA(dst, b, h) do { _Pragma("unroll") for (int m = 0; m < 4; ++m) _Pragma("unroll") for (int k = 0; k < 2; ++k) dst[m][k] = *(const PG8_LAS bf16x8*)(lds + PG8_SA(b, h) + aoff + m * 2048 + k * 1024); } while (0)
#define PG8_LDB(dst, b, h) do { _Pragma("unroll") for (int n = 0; n < 2; ++n) _Pragma("unroll") for (int k = 0; k < 2; ++k) dst[n][k] = *(const PG8_LAS bf16x8*)(lds + PG8_SB(b, h) + boff + n * 2048 + k * 1024); } while (0)
#define PG8_MMA(ai, bj, At, Bt) do { __builtin_amdgcn_s_setprio(1); _Pragma("unroll") for (int m = 0; m < 4; ++m) _Pragma("unroll") for (int n = 0; n < 2; ++n) { \
        if constexpr (F8) mfma_f8_inplace(acc[ai][bj][m][n], cat_i8(Bt[n][0], Bt[n][1]), cat_i8(At[m][0], At[m][1])); \
        else { _Pragma("unroll") for (int k = 0; k < 2; ++k) acc[ai][bj][m][n] = __builtin_amdgcn_mfma_f32_16x16x32_f16(__builtin_bit_cast(f16x8, Bt[n][k]), __builtin_bit_cast(f16x8, At[m][k]), acc[ai][bj][m][n], 0, 0, 0); } } \
        __builtin_amdgcn_s_setprio(0); } while (0)
#define PG8_WAIT_V(n) asm volatile("s_waitcnt vmcnt(" #n ")" ::: "memory")
#define PG8_WAIT_L(n) asm volatile("s_waitcnt lgkmcnt(" #n ")" ::: "memory")
#define PG8_WAIT_VN(n) asm volatile("s_waitcnt vmcnt(%0)" :: "n"(n) : "memory")
#define PG8_BAR __builtin_amdgcn_s_barrier()
#define PG8_SCHED __builtin_amdgcn_sched_barrier(0)
    Unit cur, nxt; int ui = 0;
    constexpr int NS = Epi::MIN_VM_OPS;
    if (!S.next(0, cur)) return;
    f32x4 acc[2][2][4][2];
#pragma unroll
    for (int a = 0; a < 2; ++a)
#pragma unroll
        for (int b = 0; b < 2; ++b)
#pragma unroll
            for (int m = 0; m < 4; ++m)
#pragma unroll
                for (int n = 0; n < 2; ++n) { float z0, z1, z2, z3; asm volatile("v_mov_b32 %0, 0\n\tv_mov_b32 %1, 0\n\tv_mov_b32 %2, 0\n\tv_mov_b32 %3, 0" : "=v"(z0), "=v"(z1), "=v"(z2), "=v"(z3)); acc[a][b][m][n] = (f32x4){z0, z1, z2, z3}; }
    bf16x8 At[4][2], B0[2][2], B1[2][2];
    const char* cA = (const char*)g.A + (size_t)cur.pm * tstep; const char* cB = (const char*)g.Bt + (size_t)cur.pn * tstep;
    S.a_ready(cur);
    if constexpr (SP2) {
        PG8_STAGE(PG8_SB(0, 0), cB, voffB); PG8_STAGE(PG8_SB(0, 1), cB + hstep, voffB); PG8_STAGE(PG8_SA(0, 0), cA, voffA); PG8_STAGE(PG8_SA(0, 1), cA + hstep, voffA);
        E.prep(S, cur, wave_in);
        if (wr == 1) PG8_BAR;
        PG8_WAIT_V(2); PG8_BAR;
        PG8_STAGE(PG8_SB(1, 0), cB + kstep, voffB); PG8_STAGE(PG8_SA(1, 0), cA + kstep, voffA); PG8_STAGE(PG8_SB(1, 1), cB + hstep + kstep, voffB);
        PG8_WAIT_V(6); PG8_BAR;
    } else {
        PG8_STAGE(PG8_SB(0, 0), cB, voffB); PG8_STAGE(PG8_SA(0, 0), cA, voffA); PG8_STAGE(PG8_SB(0, 1), cB + hstep, voffB); PG8_STAGE(PG8_SA(0, 1), cA + hstep, voffA);
        E.prep(S, cur, wave_in);
        if (wr == 1) PG8_BAR;
        PG8_WAIT_V(4); PG8_BAR;
        PG8_STAGE(PG8_SB(1, 0), cB + kstep, voffB); PG8_STAGE(PG8_SA(1, 0), cA + kstep, voffA); PG8_STAGE(PG8_SB(1, 1), cB + hstep + kstep, voffB);
        PG8_WAIT_V(6); PG8_BAR;
    }
    for (;;) {
        const bool has_next = S.next(ui + 1, nxt);
        const char* nA = has_next ? (const char*)g.A + (size_t)nxt.pm * tstep : cA; const char* nB = has_next ? (const char*)g.Bt + (size_t)nxt.pn * tstep : cB;
        for (int t = 0; t < nt; t += 2) {
            const bool last = (t == nt - 2);
            const char* a1 = cA + (size_t)(t + 1) * kstep;
            const char* a2 = last ? nA : cA + (size_t)(t + 2) * kstep; const char* b2 = last ? nB : cB + (size_t)(t + 2) * kstep;
            const char* a3 = a2 + kstep; const char* b3 = b2 + kstep;
            if (last && has_next) S.a_ready(nxt);
            if constexpr (SP2) {
            const bool after_epi = NS > 0 && t == 0 && ui > 0;
            PG8_LDB(B0, 0, 0); PG8_LDB(B1, 0, 1); PG8_SCHED; PG8_LDA(At, 0, 0); PG8_STAGE(PG8_SA(1, 1), a1 + hstep, voffA);
            if (after_epi) PG8_WAIT_VN(8 + NS); else PG8_WAIT_V(8);
            PG8_WAIT_L(0); PG8_BAR; PG8_MMA(0, 0, At, B0); PG8_MMA(0, 1, At, B1); PG8_BAR; PG8_SCHED;
            PG8_LDA(At, 0, 1); PG8_STAGE(PG8_SB(0, 0), b2, voffB); PG8_STAGE(PG8_SB(0, 1), b2 + hstep, voffB); PG8_STAGE(PG8_SA(0, 0), a2, voffA);
            if (after_epi) PG8_WAIT_VN(8 + NS); else PG8_WAIT_V(8);
            PG8_WAIT_L(0); PG8_BAR; PG8_MMA(1, 0, At, B0); PG8_MMA(1, 1, At, B1); PG8_BAR; PG8_SCHED;
            PG8_LDB(B0, 1, 0); PG8_LDB(B1, 1, 1); PG8_SCHED; PG8_LDA(At, 1, 0); PG8_STAGE(PG8_SA(0, 1), a2 + hstep, voffA);
            PG8_WAIT_V(8); PG8_WAIT_L(0); PG8_BAR; PG8_MMA(0, 0, At, B0); PG8_MMA(0, 1, At, B1); PG8_BAR; PG8_SCHED;
            PG8_LDA(At, 1, 1); PG8_STAGE(PG8_SB(1, 0), b3, voffB); PG8_STAGE(PG8_SB(1, 1), b3 + hstep, voffB); PG8_STAGE(PG8_SA(1, 0), a3, voffA);
            PG8_WAIT_V(8); PG8_WAIT_L(0); PG8_BAR; PG8_MMA(1, 0, At, B0); PG8_MMA(1, 1, At, B1); PG8_BAR; PG8_SCHED;
            } else {
            PG8_LDB(B0, 0, 0); PG8_SCHED; PG8_LDA(At, 0, 0); PG8_STAGE(PG8_SA(1, 1), a1 + hstep, voffA);
            PG8_WAIT_L(8); PG8_BAR; PG8_WAIT_L(0); PG8_MMA(0, 0, At, B0); PG8_BAR; PG8_SCHED;
            PG8_LDB(B1, 0, 1); PG8_STAGE(PG8_SB(0, 0), b2, voffB);
            PG8_BAR; PG8_WAIT_L(0); PG8_MMA(0, 1, At, B1); PG8_BAR;
            PG8_LDA(At, 0, 1); PG8_STAGE(PG8_SA(0, 0), a2, voffA);
            PG8_BAR; PG8_WAIT_L(0); PG8_MMA(1, 0, At, B0); PG8_BAR; PG8_SCHED;
            PG8_STAGE(PG8_SB(0, 1), b2 + hstep, voffB);
            PG8_WAIT_V(6); PG8_BAR; PG8_MMA(1, 1, At, B1); PG8_BAR;
            PG8_LDB(B0, 1, 0); PG8_SCHED; PG8_LDA(At, 1, 0); PG8_STAGE(PG8_SA(0, 1), a2 + hstep, voffA);
            PG8_WAIT_L(8); PG8_BAR; PG8_WAIT_L(0); PG8_MMA(0, 0, At, B0); PG8_BAR; PG8_SCHED;
            PG8_LDB(B1, 1, 1); PG8_STAGE(PG8_SB(1, 0), b3, voffB);
            PG8_BAR; PG8_WAIT_L(0); PG8_MMA(0, 1, At, B1); PG8_BAR;
            PG8_LDA(At, 1, 1); PG8_STAGE(PG8_SA(1, 0), a3, voffA);
            PG8_BAR; PG8_WAIT_L(0); PG8_MMA(1, 0, At, B0); PG8_BAR; PG8_SCHED;
            PG8_STAGE(PG8_SB(1, 1), b3 + hstep, voffB);
            PG8_WAIT_V(6); PG8_BAR; PG8_MMA(1, 1, At, B1); PG8_BAR;
            }
        }
        if constexpr (F8) asm volatile("s_nop 15\n\ts_nop 7" ::: "memory");
        if constexpr (ALIGN_EPI) { if (wr == 0) PG8_BAR; }
        if constexpr (!Epi::AFTER_DRAIN) { E(acc, cur, wr, wc, fr, fq); S.done(cur); }
        if (!has_next) break;
#pragma unroll
        for (int a = 0; a < 2; ++a)
#pragma unroll
            for (int b = 0; b < 2; ++b)
#pragma unroll
                for (int m = 0; m < 4; ++m)
#pragma unroll
                    for (int n = 0; n < 2; ++n) { float z0, z1, z2, z3; asm volatile("v_mov_b32 %0, 0\n\tv_mov_b32 %1, 0\n\tv_mov_b32 %2, 0\n\tv_mov_b32 %3, 0" : "=v"(z0), "=v"(z1), "=v"(z2), "=v"(z3)); acc[a][b][m][n] = (f32x4){z0, z1, z2, z3}; }
        cur = nxt; cA = nA; cB = nB; ++ui;
        if constexpr (ALIGN_EPI) { if (wr == 1) PG8_BAR; }
    }
    PG8_WAIT_V(0);
    if constexpr (!ALIGN_EPI) { if (wr == 0) PG8_BAR; }
    PG8_BAR;
    if constexpr (Epi::AFTER_DRAIN) { E.fused(acc, cur, wr, wc, fr, fq, lds, wid, lane); S.done(cur); }
#undef PG8_SA
#undef PG8_SB
#undef PG8_STAGE
#undef PG8_STAGE_AUX
#undef PG8_IS_B
#undef PG8_LDA
#undef PG8_LDB
#undef PG8_MMA
#undef PG8_WAIT_V
#undef PG8_WAIT_L
#undef PG8_WAIT_VN
#undef PG8_BAR
#undef PG8_SCHED
}
}

#ifndef PG8_SP2
#define PG8_SP2 true
#endif

#define GAS __attribute__((address_space(1)))
#define LAS __attribute__((address_space(3)))
typedef unsigned short bf16;
typedef unsigned v4u __attribute__((ext_vector_type(4)));
typedef unsigned v2u __attribute__((ext_vector_type(2)));
typedef float f32x4 __attribute__((ext_vector_type(4)));
typedef float f32x2 __attribute__((ext_vector_type(2)));
typedef float f32x16 __attribute__((ext_vector_type(16)));
typedef short bf16x8 __attribute__((ext_vector_type(8)));
typedef short s16x4 __attribute__((ext_vector_type(4)));
typedef GAS unsigned gu32;
typedef GAS unsigned long long gu64;
typedef LAS const char* lcp;
typedef LAS char* lwp;
#define RLX_AGENT __ATOMIC_RELAXED, __HIP_MEMORY_SCOPE_AGENT
#define LDS_WAIT() asm volatile("s_waitcnt lgkmcnt(0)" ::: "memory")
#define VM_WAIT() asm volatile("s_waitcnt vmcnt(0)" ::: "memory")
#define WG_BAR() do { asm volatile("s_waitcnt vmcnt(0) lgkmcnt(0)" ::: "memory"); __builtin_amdgcn_s_barrier(); asm volatile("" ::: "memory"); } while (0)
#define DI __device__ __forceinline__
#define MFMA32(a, b, c) __builtin_amdgcn_mfma_f32_32x32x16_f16(__builtin_bit_cast(pg8::f16x8, (a)), __builtin_bit_cast(pg8::f16x8, (b)), (c), 0, 0, 0)
DI unsigned pk2(float lo, float hi) { return pg8::cvt_pk_bf16(lo, hi); }
DI float bflo(unsigned w) { return pg8::bf_lo(w); }
DI float bfhi(unsigned w) { return pg8::bf_hi(w); }
DI float ex2(float x) { return __builtin_amdgcn_exp2f(x); }
DI f32x16 zero16() { float z = 0.f; asm volatile("" : "+v"(z)); return (f32x16){z, z, z, z, z, z, z, z, z, z, z, z, z, z, z, z}; }
DI int crow(int r, int hi) { return (r & 3) + 8 * (r >> 2) + 4 * hi; }
#define SWZ_XOR(v, m) __uint_as_float((unsigned)__builtin_amdgcn_ds_swizzle((int)__float_as_uint(v), ((m) << 10) | 0x1f))
DI float half_swap_add(float v);
DI float wave_sum(float v) { v += SWZ_XOR(v, 1); v += SWZ_XOR(v, 2); v += SWZ_XOR(v, 4); v += SWZ_XOR(v, 8); v += SWZ_XOR(v, 16); return half_swap_add(v); }
DI float shfl_lane(float v, int src_lane) { return __uint_as_float((unsigned)__builtin_amdgcn_ds_bpermute(src_lane << 2, (int)__float_as_uint(v))); }
DI float half_swap_add(float v) { auto rr = __builtin_amdgcn_permlane32_swap(__float_as_uint(v), __float_as_uint(v), false, false); return __uint_as_float(rr[0]) + __uint_as_float(rr[1]); }
DI float half_swap_max(float v) { auto rr = __builtin_amdgcn_permlane32_swap(__float_as_uint(v), __float_as_uint(v), false, false); return fmaxf(__uint_as_float(rr[0]), __uint_as_float(rr[1])); }
typedef short v4i16_t __attribute__((ext_vector_type(4)));
DI s16x4 vtr(lcp p) { return __builtin_bit_cast(s16x4, __builtin_amdgcn_ds_read_tr16_b64_v4i16((LAS v4i16_t*)p)); }
DI bf16x8 cat8(s16x4 lo, s16x4 hi) { return __builtin_shufflevector(lo, hi, 0, 1, 2, 3, 4, 5, 6, 7); }
DI bf16x8 trfrag(lcp p) { return cat8(vtr(p), vtr(p + 512)); }
DI bf16x8 ldfrag(lcp p) { return *(const LAS bf16x8*)p; }
DI bf16x8 mask_frag(v4u v, unsigned m) { v4u o; asm("v_and_b32 %0, %4, %8\n\tv_and_b32 %1, %5, %8\n\tv_and_b32 %2, %6, %8\n\tv_and_b32 %3, %7, %8\n\ts_nop 1" : "=&v"(o.x), "=&v"(o.y), "=&v"(o.z), "=&v"(o.w) : "v"(v.x), "v"(v.y), "v"(v.z), "v"(v.w), "v"(m)); return __builtin_bit_cast(bf16x8, o); }
DI void glds16(const void* gsrc, LAS void* ldst) { __builtin_amdgcn_global_load_lds((const unsigned*)gsrc, (LAS unsigned*)ldst, 16, 0, 0); }
#define PACK8(x, s) ((bf16x8)__builtin_bit_cast(bf16x8, (v4u){pk2((x)[8 * (s) + 0], (x)[8 * (s) + 1]), pk2((x)[8 * (s) + 2], (x)[8 * (s) + 3]), pk2((x)[8 * (s) + 4], (x)[8 * (s) + 5]), pk2((x)[8 * (s) + 6], (x)[8 * (s) + 7])}))

constexpr int RING_OFF = 0, RING_BYTES = 131072;
constexpr int TAB_OFF = 131072;
constexpr int MISC_OFF = 163840 - 256;
constexpr int LDS_BYTES = 163840;
constexpr int AT_K = 0, AT_V = 32768, AT_WS = 65536, AT_STG = 67584;
constexpr int ML_K = 0, ML_V = 65536, ML_VW = 81920, ML_C = 98304, ML_N = 131072, ML_G2 = 131584, ML_M2 = 132096, ML_FI = 132608, ML_EI = 133120, ML_WK = 133632, ML_WKB = 134144, ML_SC = 134400, ML_WS = 134464, ML_STG = 136512;
static_assert(ML_STG + 4 * 4096 <= MISC_OFF && AT_STG + 8 * 4096 <= MISC_OFF && pg8::CTAB_OFF + pg8::CTAB_UNITS * 1024 <= MISC_OFF && pg8::STAB_OFF == TAB_OFF + 16384, "LDS map");

#define XB_TMO      128
#define XB_XCNT(j)  (256  + 64 * (j))
#define XB_XSUB(j)  (1280 + 64 * (j))
#define XB_XGEN(j)  (2304 + 64 * (j))
#define XB_TOP      3328
#define XB_TOPGEN   3392
#define XCD_BAR_WORDS 3456
#define XB_SPIN_CAP (1u << 18)

__device__ __forceinline__ unsigned xb_ld(unsigned* p)              { return __hip_atomic_load(p, __ATOMIC_RELAXED, __HIP_MEMORY_SCOPE_AGENT); }
__device__ __forceinline__ unsigned xb_add(unsigned* p, unsigned v) { return __hip_atomic_fetch_add(p, v, __ATOMIC_RELAXED, __HIP_MEMORY_SCOPE_AGENT); }
__device__ __forceinline__ unsigned xb_xcc_id() { return (unsigned)__builtin_amdgcn_s_getreg((3 << 11) | 20) & 0xFu; }
#define XB_SPIN(cond, bar) do { unsigned _sp = 0; while (cond) { __builtin_amdgcn_s_sleep(1); \
    if ((++_sp & 255u) == 0u) { if (xb_ld(&(bar)[XB_TMO])) break; if (_sp > XB_SPIN_CAP) { atomicAdd(&(bar)[XB_TMO], 1u); break; } } } } while (0)

struct XcdBarrier {
    unsigned* bar; unsigned x;
    volatile LAS unsigned* st;
    unsigned total;
};

__device__ __forceinline__ XcdBarrier xcd_barrier_post(unsigned* bar, volatile LAS unsigned* st) {
    XcdBarrier b; b.bar = bar; b.x = xb_xcc_id(); b.st = st; b.total = gridDim.x * gridDim.y * gridDim.z;
    if (threadIdx.x == 0) (void)xb_add(&bar[XB_XCNT(b.x)], 1u);
    return b;
}
__device__ __forceinline__ void xcd_barrier_complete(unsigned* bar, unsigned x, unsigned G, unsigned& nloc, unsigned& nx) {
    unsigned sum, cnt, mine, sp = 0u;
    for (;;) {
        sum = 0u; cnt = 0u; mine = 0u;
#pragma unroll
        for (unsigned j = 0; j < 16; ++j) { const unsigned c = xb_ld(&bar[XB_XCNT(j)]); sum += c; cnt += (c > 0u) ? 1u : 0u; mine = (j == x) ? c : mine; }
        if (sum == G) break;
        __builtin_amdgcn_s_sleep(1);
        if ((++sp & 255u) == 0u) { if (xb_ld(&bar[XB_TMO])) break; if (sp > XB_SPIN_CAP) { atomicAdd(&bar[XB_TMO], 1u); break; } }
    }
    nloc = mine > 0u ? mine : 1u; nx = cnt > 0u ? cnt : 1u;
}

__device__ __forceinline__ void xcd_barrier(const XcdBarrier& b) {
    asm volatile("s_waitcnt vmcnt(0)" ::: "memory");
    __syncthreads();
    if (threadIdx.x == 0) {
        unsigned* bar = b.bar;
        __builtin_amdgcn_s_waitcnt(0);
        unsigned nloc = b.st[0], nx = b.st[1];
        if (nloc == 0u) { xcd_barrier_complete(bar, b.x, b.total, nloc, nx); b.st[0] = nloc; b.st[1] = nx; }
        const unsigned old = xb_add(&bar[XB_XSUB(b.x)], 1u);
        const unsigned gen = old / nloc;
        if (old + 1u == (gen + 1u) * nloc) {
            __builtin_amdgcn_fence(__ATOMIC_RELEASE, "agent");
            asm volatile("s_waitcnt vmcnt(0)" ::: "memory");
            const unsigned og = xb_add(&bar[XB_TOP], 1u);
            const unsigned tg = og / nx;
            if (og + 1u == (tg + 1u) * nx) xb_add(&bar[XB_TOPGEN], 1u);
            else XB_SPIN(xb_ld(&bar[XB_TOPGEN]) == tg, bar);
            __builtin_amdgcn_fence(__ATOMIC_ACQUIRE, "agent");
            xb_add(&bar[XB_XGEN(b.x)], 1u);
            asm volatile("s_waitcnt vmcnt(0)" ::: "memory");
        } else {
            XB_SPIN(xb_ld(&bar[XB_XGEN(b.x)]) == gen, bar);
            __builtin_amdgcn_fence(__ATOMIC_ACQUIRE, "agent");
            asm volatile("s_waitcnt vmcnt(0)" ::: "memory");
        }
    }
    __syncthreads();
}
DI void glds16_nt(const void* gsrc, LAS void* ldst) { __builtin_amdgcn_global_load_lds((const unsigned*)gsrc, (LAS unsigned*)ldst, 16, 0, 2); }
DI void attn_phase(unsigned char* ldsg, const bf16* QKV, unsigned char* AO8, const float* sinks, int ng, int gx, int gy, int Gy, int wave_in) {
    int wid = wave_in; asm volatile("" : "+s"(wid));
    const int lane = pg8::pg8_lane(), tid = wid * 64 + lane, r32 = lane & 31, hi = lane >> 5;
    LAS unsigned char* lds = (LAS unsigned char*)ldsg; const lcp L = (lcp)lds;
    LAS float* wsf = (LAS float*)(lds + AT_WS) + wid * 64;
    LAS unsigned char* stg = lds + AT_STG + wid * 4096;
    const lcp vlane = L + AT_V + ((lane >> 4) & 1) * 32 + (lane & 3) * 8 + (4 * hi + ((lane & 15) >> 2)) * 64;
    const lcp klane = L + AT_K + hi * 1024 + r32 * 16;
    for (int uu = gy; uu < 64 * (BATCH / ng); uu += Gy) { const int b = gx + ng * (uu >> 6), ul = uu & 63;
        const int kvh = ul & 3, nb = ul >> 2;
        const long rowq = (long)b * SEQ + nb * 128, rowk = rowq - 128;
        const int slot_lo = (nb == 0) ? 2 : 0;
        for (int sl = slot_lo; sl < 4; ++sl) {
            glds16(QKV + (rowk + 64 * sl + lane) * NQKV + 2048 + 64 * kvh + 8 * wid, lds + AT_K + sl * 8192 + wid * 1024);
            glds16(QKV + (rowk + 64 * sl + 16 * (wid & 3) + (lane >> 2)) * NQKV + 2304 + 64 * kvh + (wid >> 2) * 32 + (lane & 3) * 8, lds + AT_V + sl * 8192 + wid * 1024);
        }
        const int hq = 8 * kvh + wid;
        const bf16* qsrc = QKV + (rowq + r32) * NQKV + 64 * hq + 8 * hi;
        bf16x8 qn[4];
#pragma unroll
        for (int d0 = 0; d0 < 4; ++d0) qn[d0] = *(const bf16x8*)(qsrc + 16 * d0);
        const float slope2 = ex2(-0.25f * (float)(hq + 1)) * LOG2E, sink2 = sinks[hq] * LOG2E;
        const float base_l = -slope2 * (float)(r32 - 4 * hi);
        WG_BAR();
#pragma unroll 1
        for (int j = 0; j < 4; ++j) {
            const int ilo = (nb == 0) ? 4 - j : 0;
            bf16x8 qr[4];
#pragma unroll
            for (int d0 = 0; d0 < 4; ++d0) qr[d0] = qn[d0];
            if (j < 3) {
#pragma unroll
                for (int d0 = 0; d0 < 4; ++d0) qn[d0] = *(const bf16x8*)(qsrc + (size_t)(32 * (j + 1)) * NQKV + 16 * d0);
            }
            float sl2 = slope2, bl = base_l; asm volatile("" : "+v"(sl2), "+v"(bl));
            f32x16 p[5];
#pragma unroll
            for (int i = 0; i < 5; ++i) {
                if (i >= ilo) {
                    const int kt = j + i; const lcp kb = klane + (kt >> 1) * 8192 + (kt & 1) * 512;
                    f32x16 a = zero16();
#pragma unroll
                    for (int d0 = 0; d0 < 4; ++d0) a = MFMA32(ldfrag(kb + d0 * 2048), qr[d0], a);
#pragma unroll
                    for (int r = 0; r < 16; ++r) {
                        const int cr = (r & 3) + 8 * (r >> 2);
                        float s = fmaf(sl2, (float)(cr - 128 + 32 * i), fmaf(a[r], LOG2E, bl));
                        if (i == 0) { if (!(cr + 4 * hi > r32)) s = -INFINITY; }
                        if (i == 4) { if (!(cr + 4 * hi <= r32)) s = -INFINITY; }
                        a[r] = s;
                    }
                    p[i] = a;
                } else {
#pragma unroll
                    for (int r = 0; r < 16; ++r) p[i][r] = -INFINITY;
                }
            }
            float mx = sink2;
#pragma unroll
            for (int i = 0; i < 5; ++i)
#pragma unroll
                for (int r = 0; r < 16; ++r) mx = fmaxf(mx, p[i][r]);
            mx = half_swap_max(mx);
            float ls = 0.f;
#pragma unroll
            for (int i = 0; i < 5; ++i)
#pragma unroll
                for (int r = 0; r < 16; ++r) { const float e = ex2(p[i][r] - mx); p[i][r] = e; ls += e; }
            ls = half_swap_add(ls) + ex2(sink2 - mx);
            f32x16 o0 = zero16(), o1 = zero16();
#pragma unroll
            for (int i = 0; i < 5; ++i) {
                if (i >= ilo) {
                    const int kt = j + i; const lcp vb = vlane + (kt >> 1) * 8192 + (kt & 1) * 2048;
                    const bf16x8 pa = PACK8(p[i], 0), pb = PACK8(p[i], 1);
                    o0 = MFMA32(pa, trfrag(vb), o0);        o0 = MFMA32(pb, trfrag(vb + 1024), o0);
                    o1 = MFMA32(pa, trfrag(vb + 4096), o1); o1 = MFMA32(pb, trfrag(vb + 4096 + 1024), o1);
                }
            }
            if (hi == 0) wsf[r32] = __builtin_amdgcn_rcpf(ls);
#pragma unroll
            for (int r = 0; r < 16; ++r) {
                const int orow = crow(r, hi); const float rl = wsf[orow] * pg8::F8_SO;
                int pk; asm volatile("" : "=v"(pk)); pk = __builtin_amdgcn_cvt_pk_fp8_f32(o0[r] * rl, o1[r] * rl, pk, false);
                stg[orow * 64 + r32] = (unsigned char)(pk & 0xff);
                stg[orow * 64 + 32 + r32] = (unsigned char)((pk >> 8) & 0xff);
            }
#pragma unroll
            for (int i4 = 0; i4 < 2; ++i4) {
                const int row = i4 * 16 + (lane >> 2), ch = lane & 3;
                const v4u v = *(const LAS v4u*)(stg + row * 64 + ch * 16);
                *(v4u*)(AO8 + (rowq + 32 * j + row) * D + 64 * hq + ch * 16) = v;
            }
        }
        WG_BAR();
    }
}

constexpr int ML_GSET = ML_STG + 4 * 4096 - ML_G2;
static_assert(ML_G2 + ML_GSET + (ML_WS - ML_G2) <= MISC_OFF, "LDS map: second gate-array set");
#define DPPF(old, src, ctrl, rmask, bc) __uint_as_float((unsigned)__builtin_amdgcn_update_dpp((int)__float_as_uint(old), (int)__float_as_uint(src), (ctrl), (rmask), 0xf, (bc)))
DI float scan_add64(float v) {
    v += DPPF(0.f, v, 0x111, 0xf, true); v += DPPF(0.f, v, 0x112, 0xf, true); v += DPPF(0.f, v, 0x114, 0xf, true); v += DPPF(0.f, v, 0x118, 0xf, true);
    v += DPPF(0.f, v, 0x142, 0xa, false); v += DPPF(0.f, v, 0x143, 0xc, false); return v;
}
DI float scan_max64(float v) {
    const float ninf = -INFINITY;
    v = fmaxf(v, DPPF(ninf, v, 0x111, 0xf, false)); v = fmaxf(v, DPPF(ninf, v, 0x112, 0xf, false)); v = fmaxf(v, DPPF(ninf, v, 0x114, 0xf, false)); v = fmaxf(v, DPPF(ninf, v, 0x118, 0xf, false));
    v = fmaxf(v, DPPF(ninf, v, 0x142, 0xa, false)); v = fmaxf(v, DPPF(ninf, v, 0x143, 0xc, false)); return v;
}
DI float ml_gate_scan(LAS unsigned char* lds, int gofs, const float* GT, long row0, int h, int lane, float m_prev) {
    LAS float* G2 = (LAS float*)(lds + ML_G2 + gofs); LAS float* M2 = (LAS float*)(lds + ML_M2 + gofs); LAS float* FI = (LAS float*)(lds + ML_FI + gofs); LAS float* EI = (LAS float*)(lds + ML_EI + gofs);
    LAS float* WK = (LAS float*)(lds + ML_WK + gofs); LAS bf16* WKB = (LAS bf16*)(lds + ML_WKB + gofs); LAS float* SC = (LAS float*)(lds + ML_SC + gofs);
    const float* gp = GT + (size_t)(row0 + 2 * lane) * 8;
    const float i0 = gp[h], f0 = gp[4 + h], i1 = gp[8 + h], f1 = gp[12 + h];
    const float lf0 = -0.6931471805599453f * __builtin_amdgcn_logf(1.f + ex2(-LOG2E * f0)), lf1 = -0.6931471805599453f * __builtin_amdgcn_logf(1.f + ex2(-LOG2E * f1));
    const float incl = scan_add64(lf0 + lf1);
    const float b1 = incl, b0 = incl - lf1;
    const float g0 = i0 - b0, g1 = i1 - b1;
    const float cm = scan_max64(fmaxf(g0, g1));
    const float cprev = DPPF(-INFINITY, cm, 0x138, 0xf, false);
    const float M0 = fmaxf(m_prev, fmaxf(cprev, g0)), M1 = fmaxf(m_prev, cm);
    const float Mend = __uint_as_float((unsigned)__builtin_amdgcn_readlane((int)__float_as_uint(M1), 63)), blast = __uint_as_float((unsigned)__builtin_amdgcn_readlane((int)__float_as_uint(b1), 63));
    *(LAS f32x2*)(G2 + 2 * lane) = (f32x2){g0 * LOG2E, g1 * LOG2E};
    *(LAS f32x2*)(M2 + 2 * lane) = (f32x2){M0 * LOG2E, M1 * LOG2E};
    *(LAS f32x2*)(FI + 2 * lane) = (f32x2){ex2((m_prev - M0) * LOG2E), ex2((m_prev - M1) * LOG2E)};
    *(LAS f32x2*)(EI + 2 * lane) = (f32x2){ex2(-(b0 + M0) * LOG2E), ex2(-(b1 + M1) * LOG2E)};
    const float w0 = ex2((g0 - Mend) * LOG2E), w1 = ex2((g1 - Mend) * LOG2E);
    *(LAS f32x2*)(WK + 2 * lane) = (f32x2){w0, w1};
    *(LAS unsigned*)(WKB + 2 * lane) = pk2(w0, w1);
    if (lane == 0) SC[0] = ex2((m_prev - Mend) * LOG2E);
    return blast + Mend;
}
template <int VAR = 0>
DI void mlstm_phase(unsigned char* ldsg, const bf16* MP, const float* GT, bf16* HG, int ng, int gx, int gy, int Gy, int wave_in) {
    int wid = wave_in; asm volatile("" : "+s"(wid));
    const int lane0 = pg8::pg8_lane(), tid = wid * 64 + lane0;
    LAS unsigned char* lds = (LAS unsigned char*)ldsg; const lcp L = (lcp)lds;
    LAS float* wsf = (LAS float*)(lds + ML_WS) + wid * 64;
    for (int uu = gy; uu < 32 * (BATCH / ng); uu += Gy) { const int b = gx + ng * (uu >> 5), ul = uu & 31;
        const int h = ul >> 3, sl = ul & 7;
        const bf16* Qp = MP + 256 * h; const bf16* Kp = MP + 1024 + 256 * h; const bf16* Vp = MP + 2048 + 512 * h + 64 * sl; const bf16* OGp = MP + 4096 + 512 * h + 64 * sl;
        { unsigned z = 0u; asm volatile("" : "+v"(z)); for (int i = tid; i < (32768 + 512) / 16; i += 512) *(LAS v4u*)(lds + ML_C + i * 16) = (v4u){z, z, z, z}; }
        f32x16 T[6];
#pragma unroll
        for (int x = 0; x < 6; ++x) T[x] = zero16();
        float m_prev = 0.f;
        v4u X[16], vreg[2];
        { const long row0 = (long)b * SEQ; const int lane = lane0, r32 = lane & 31, hi = lane >> 5;
          if (wid >= 4) {
#pragma unroll
              for (int i = 0; i < 16; ++i) X[i] = *(const v4u*)(Kp + (row0 + 8 * i + (lane & 7)) * NMI + (8 * (wid - 4) + (lane >> 3)) * 8);
          } else {
#pragma unroll
              for (int ks = 0; ks < 16; ++ks) X[ks] = *(const v4u*)(Qp + (row0 + 32 * wid + r32) * NMI + 16 * ks + 8 * hi);
          }
#pragma unroll
          for (int i = 0; i < 2; ++i) vreg[i] = *(const v4u*)(Vp + (row0 + 64 * i + 16 * (wid & 3) + (lane >> 2)) * NMI + (wid >> 2) * 32 + (lane & 3) * 8);
          if (wid == 4 && !(VAR & 16)) m_prev = ml_gate_scan(lds, 0, GT, row0, h, lane, m_prev);
        }
        WG_BAR();
        for (int c = 0; c < 16; ++c) {
            const long row0 = (long)b * SEQ + 128 * c;
            const int gofs = (c & 1) * ML_GSET;
            const int lane = pg8::pg8_lane(), r32 = lane & 31, hi = lane >> 5;
            const int blk = (lane >> 4) & 1, q4 = (lane & 15) >> 2, p4 = lane & 3;
            const int vlo_ = blk * 32 + p4 * 8 + (4 * hi + q4) * 64;
            const int ktl_ = (2 * blk + (p4 >> 1)) * 2048 + (q4 + 4 * hi) * 16 + (p4 & 1) * 8;
            const int cbl_ = hi * 1024 + r32 * 16, kbl_ = hi * 2048 + r32 * 16;
            const unsigned m0 = (r32 == 0) ? 0xffffffffu : 0u;
            LAS float* G2 = (LAS float*)(lds + ML_G2 + gofs); LAS float* M2 = (LAS float*)(lds + ML_M2 + gofs); LAS float* FI = (LAS float*)(lds + ML_FI + gofs); LAS float* EI = (LAS float*)(lds + ML_EI + gofs);
            LAS float* WK = (LAS float*)(lds + ML_WK + gofs); LAS bf16* WKB = (LAS bf16*)(lds + ML_WKB + gofs); LAS float* SC = (LAS float*)(lds + ML_SC + gofs);
            if (wid >= 4) {
#pragma unroll
                for (int i = 0; i < 16; ++i) *(LAS v4u*)(lds + ML_K + (8 * (wid - 4) + (lane >> 3)) * 2048 + (8 * i + (lane & 7)) * 16) = X[i];
            }
#pragma unroll
            for (int i = 0; i < 2; ++i) { const float w = WK[64 * i + 16 * (wid & 3) + (lane >> 2)]; const v4u v = vreg[i]; v4u o;
                o.x = pk2(bflo(v.x) * w, bfhi(v.x) * w); o.y = pk2(bflo(v.y) * w, bfhi(v.y) * w); o.z = pk2(bflo(v.z) * w, bfhi(v.z) * w); o.w = pk2(bflo(v.w) * w, bfhi(v.w) * w);
                *(LAS v4u*)(lds + ML_V + i * 8192 + wid * 1024 + lane * 16) = v;
                *(LAS v4u*)(lds + ML_VW + i * 8192 + wid * 1024 + lane * 16) = o; }
            asm volatile("s_waitcnt lgkmcnt(0)" ::: "memory"); __builtin_amdgcn_s_barrier(); asm volatile("" ::: "memory");
            const bool more = c + 1 < 16;
            if (more && !(VAR & 32)) {
                const long row1 = row0 + 128;
                if (wid >= 4) {
#pragma unroll
                    for (int i = 0; i < 16; ++i) X[i] = *(const v4u*)(Kp + (row1 + 8 * i + (lane & 7)) * NMI + (8 * (wid - 4) + (lane >> 3)) * 8);
                }
#pragma unroll
                for (int i = 0; i < 2; ++i) vreg[i] = *(const v4u*)(Vp + (row1 + 64 * i + 16 * (wid & 3) + (lane >> 2)) * NMI + (wid >> 2) * 32 + (lane & 3) * 8);
            }
            if (wid < 4) {
                const int tt = wid;
                v4u ogv[4];
#pragma unroll
                for (int i4 = 0; i4 < 4; ++i4) ogv[i4] = *(const v4u*)(OGp + (row0 + 32 * tt + i4 * 8 + (lane >> 3)) * NMI + (lane & 7) * 8);
                T[0] = zero16(); T[1] = zero16(); T[2] = zero16();
                if (!(VAR & 4)) { const lcp cb = L + ML_C + cbl_; const lcp nbp = L + ML_N + 16 * hi;
#pragma unroll
                  for (int ks = 0; ks < 16; ++ks) {
                      const bf16x8 c0 = ldfrag(cb + ks * 2048), c1 = ldfrag(cb + ks * 2048 + 512);
                      const bf16x8 nf = mask_frag(*(const LAS v4u*)(nbp + ks * 32), m0);
                      T[0] = MFMA32(__builtin_bit_cast(bf16x8, X[ks]), c0, T[0]); T[1] = MFMA32(__builtin_bit_cast(bf16x8, X[ks]), c1, T[1]); T[2] = MFMA32(__builtin_bit_cast(bf16x8, X[ks]), nf, T[2]);
                      if ((ks & 3) == 3) __builtin_amdgcn_sched_barrier(0);
                  } }
                { float fi[16];
#pragma unroll
                  for (int r = 0; r < 16; ++r) fi[r] = FI[32 * tt + crow(r, hi)];
#pragma unroll
                  for (int r = 0; r < 16; ++r) { T[0][r] *= fi[r]; T[1][r] *= fi[r]; }
                  if (r32 == 0) {
#pragma unroll
                      for (int r = 0; r < 16; ++r) wsf[crow(r, hi)] = T[2][r] * fi[r];
                  } }
                const float Mt = M2[32 * tt + r32];
                float dsum = 0.f;
                for (int st = 0; st <= ((VAR & 2) ? -1 : tt); ++st) {
                    f32x16 S = zero16();
                    const lcp kb = L + ML_K + kbl_ + st * 512;
#pragma unroll
                    for (int ks = 0; ks < 16; ++ks) S = MFMA32(ldfrag(kb + ks * 4096), __builtin_bit_cast(bf16x8, X[ks]), S);
#pragma unroll
                    for (int r = 0; r < 16; ++r) {
                        const float w = ex2(G2[32 * st + crow(r, hi)] - Mt);
                        float v = S[r] * w;
                        if (st == tt && crow(r, hi) > r32) v = 0.f;
                        S[r] = v; dsum += v;
                    }
                    const bf16x8 pa = PACK8(S, 0), pb = PACK8(S, 1);
                    const lcp vb = L + ML_V + (st >> 1) * 8192 + (st & 1) * 2048 + vlo_;
                    T[0] = MFMA32(pa, trfrag(vb), T[0]);        T[0] = MFMA32(pb, trfrag(vb + 1024), T[0]);
                    T[1] = MFMA32(pa, trfrag(vb + 4096), T[1]); T[1] = MFMA32(pb, trfrag(vb + 4096 + 1024), T[1]);
                }
                if (more && !(VAR & 64)) {
#pragma unroll
                    for (int ks = 0; ks < 16; ++ks) X[ks] = *(const v4u*)(Qp + (row0 + 128 + 32 * wid + r32) * NMI + 16 * ks + 8 * hi);
                }
                dsum = half_swap_add(dsum);
                { const float den = wsf[r32] + dsum; const float dn = fmaxf(fabsf(den), EI[32 * tt + r32]);
                  if (hi == 0) wsf[32 + r32] = __builtin_amdgcn_rcpf(dn); }
                LAS bf16* stg = (LAS bf16*)(lds + ML_STG + tt * 4096);
                if (!(VAR & 8)) {
#pragma unroll
                for (int r = 0; r < 16; ++r) {
                    const int orow = crow(r, hi); const float rd = wsf[32 + orow];
                    stg[orow * 64 + r32] = (bf16)(pk2(T[0][r] * rd, 0.f) & 0xffffu);
                    stg[orow * 64 + 32 + r32] = (bf16)(pk2(T[1][r] * rd, 0.f) & 0xffffu);
                }
#pragma unroll
                for (int i4 = 0; i4 < 4; ++i4) {
                    const int row = i4 * 8 + (lane >> 3), ch = lane & 7;
                    const v4u hv = *(const LAS v4u*)(stg + row * 64 + ch * 8);
                    const v4u og = ogv[i4];
                    v4u o;
                    o.x = pk2(bflo(hv.x) * bflo(og.x), bfhi(hv.x) * bfhi(og.x)); o.y = pk2(bflo(hv.y) * bflo(og.y), bfhi(hv.y) * bfhi(og.y));
                    o.z = pk2(bflo(hv.z) * bflo(og.z), bfhi(hv.z) * bfhi(og.z)); o.w = pk2(bflo(hv.w) * bflo(og.w), bfhi(hv.w) * bfhi(og.w));
                    *(v4u*)(HG + (row0 + 32 * tt + row) * D + 512 * h + 64 * sl + ch * 8) = o;
                }
                }
#pragma unroll
                for (int x = 3; x < 6; ++x) T[x] = zero16();
            } else {
                const float decay = SC[0];
#pragma unroll
                for (int x = 0; x < 6; ++x)
#pragma unroll
                    for (int r = 0; r < 16; ++r) T[x][r] *= decay;
#pragma unroll
                for (int dti = 0; dti < ((VAR & 1) ? 0 : 2); ++dti) {
                    const int dt = 2 * (wid - 4) + dti;
                    const lcp ka0 = L + ML_K + dt * 8192 + ktl_;
#pragma unroll
                    for (int s8 = 0; s8 < 8; ++s8) {
                        const lcp ka = ka0 + s8 * 256;
                        const bf16x8 af = cat8(vtr(ka), vtr(ka + 128));
                        const lcp vwb = L + ML_VW + (s8 >> 2) * 8192 + (s8 & 3) * 1024 + vlo_;
                        const bf16x8 b0 = trfrag(vwb), b1 = trfrag(vwb + 4096);
                        const v2u wlo = *(const LAS v2u*)(WKB + 16 * s8 + 4 * hi), whi = *(const LAS v2u*)(WKB + 16 * s8 + 4 * hi + 8); const bf16x8 nb = mask_frag((v4u){wlo.x, wlo.y, whi.x, whi.y}, m0);
                        T[2 * dti] = MFMA32(af, b0, T[2 * dti]); T[2 * dti + 1] = MFMA32(af, b1, T[2 * dti + 1]); T[4 + dti] = MFMA32(af, nb, T[4 + dti]);
                        if (s8 & 1) __builtin_amdgcn_sched_barrier(0);
                    }
                }
                if (more && wid == 4 && !(VAR & 16)) m_prev = ml_gate_scan(lds, ML_GSET - gofs, GT, row0 + 128, h, lane, m_prev);
            }
            asm volatile("s_waitcnt lgkmcnt(0)" ::: "memory"); __builtin_amdgcn_s_barrier(); asm volatile("" ::: "memory");
            if (wid >= 4) {
#pragma unroll
                for (int dti = 0; dti < 2; ++dti) {
                    const int dt = 2 * (wid - 4) + dti;
#pragma unroll
                    for (int et = 0; et < 2; ++et)
#pragma unroll
                        for (int g = 0; g < 4; ++g)
                            *(LAS v2u*)(lds + ML_C + (4 * dt + g) * 1024 + (32 * et + r32) * 16 + hi * 8) = (v2u){pk2(T[2 * dti + et][4 * g], T[2 * dti + et][4 * g + 1]), pk2(T[2 * dti + et][4 * g + 2], T[2 * dti + et][4 * g + 3])};
                    if (r32 == 0) {
#pragma unroll
                        for (int g = 0; g < 4; ++g)
                            *(LAS v2u*)(lds + ML_N + (32 * dt + 8 * g + 4 * hi) * 2) = (v2u){pk2(T[4 + dti][4 * g], T[4 + dti][4 * g + 1]), pk2(T[4 + dti][4 * g + 2], T[4 + dti][4 * g + 3])};
                    }
                }
            }
        }
        WG_BAR();
    }
}


constexpr int NWAVES = 8;

template <bool F8> DI void tr_strip(const float* W, int ldw, int n0, void* WTv, size_t wt_row0, int Kdim, int kb0, int nkb, const float* g, const float* bb, float cs, float* c1o, float* c2o, LAS float* scr, int lane) {
    bf16* WT = (bf16*)WTv; unsigned char* WT8 = (unsigned char*)WTv;
    const int c = lane & 7;
    float a1[4] = {0.f, 0.f, 0.f, 0.f}, a2[4] = {0.f, 0.f, 0.f, 0.f};
    for (int kb = kb0; kb < kb0 + nkb; ++kb) {
        const int k0 = kb * 64;
#pragma unroll 8
        for (int i = 0; i < 32; ++i) { const int kk = 2 * i + (lane >> 5); scr[kk * 33 + (lane & 31)] = __builtin_nontemporal_load(W + (size_t)(k0 + kk) * ldw + n0 + (lane & 31)); }
        float gk[8], bk[8];
        if (g) { const f32x4 g0 = *(const f32x4*)(g + k0 + 8 * c), g1 = *(const f32x4*)(g + k0 + 8 * c + 4), b0 = *(const f32x4*)(bb + k0 + 8 * c), b1 = *(const f32x4*)(bb + k0 + 8 * c + 4);
#pragma unroll
            for (int i = 0; i < 4; ++i) { gk[i] = g0[i] * cs; gk[4 + i] = g1[i] * cs; bk[i] = b0[i] * cs; bk[4 + i] = b1[i] * cs; } }
        else {
#pragma unroll
            for (int i = 0; i < 8; ++i) { gk[i] = cs; bk[i] = 0.f; } }
        LDS_WAIT(); asm volatile("" ::: "memory");
#pragma unroll
        for (int j = 0; j < 4; ++j) { const int n = (lane >> 3) + 8 * j; const LAS float* s = scr + (8 * c) * 33 + n;
            float v[8];
#pragma unroll
            for (int i = 0; i < 8; ++i) v[i] = s[i * 33];
            a2[j] += ((v[0] * bk[0] + v[1] * bk[1]) + (v[2] * bk[2] + v[3] * bk[3])) + ((v[4] * bk[4] + v[5] * bk[5]) + (v[6] * bk[6] + v[7] * bk[7]));
            if constexpr (F8) {
                float wv[8];
#pragma unroll
                for (int i = 0; i < 8; ++i) wv[i] = v[i] * gk[i];
                const v2u o = pg8::cvt8_f8(wv, pg8::F8_SW);
                a1[j] += ((__builtin_amdgcn_cvt_f32_fp8((int)o.x, 0) + __builtin_amdgcn_cvt_f32_fp8((int)o.x, 1)) + (__builtin_amdgcn_cvt_f32_fp8((int)o.x, 2) + __builtin_amdgcn_cvt_f32_fp8((int)o.x, 3)))
                       + ((__builtin_amdgcn_cvt_f32_fp8((int)o.y, 0) + __builtin_amdgcn_cvt_f32_fp8((int)o.y, 1)) + (__builtin_amdgcn_cvt_f32_fp8((int)o.y, 2) + __builtin_amdgcn_cvt_f32_fp8((int)o.y, 3)));
                *(GAS v2u*)(WT8 + (wt_row0 + n) * Kdim + k0 + 8 * c) = o;
            } else {
                v4u o; o.x = pk2(v[0] * gk[0], v[1] * gk[1]); o.y = pk2(v[2] * gk[2], v[3] * gk[3]); o.z = pk2(v[4] * gk[4], v[5] * gk[5]); o.w = pk2(v[6] * gk[6], v[7] * gk[7]);
                a1[j] += ((bflo(o.x) + bfhi(o.x)) + (bflo(o.y) + bfhi(o.y))) + ((bflo(o.z) + bfhi(o.z)) + (bflo(o.w) + bfhi(o.w)));
                *(GAS v4u*)(WT + (wt_row0 + n) * Kdim + k0 + 8 * c) = o;
            } }
        LDS_WAIT(); asm volatile("" ::: "memory");
    }
    if (g) {
#pragma unroll
        for (int j = 0; j < 4; ++j) { float s1 = a1[j], s2 = a2[j];
            s1 += SWZ_XOR(s1, 1); s2 += SWZ_XOR(s2, 1); s1 += SWZ_XOR(s1, 2); s2 += SWZ_XOR(s2, 2); s1 += SWZ_XOR(s1, 4); s2 += SWZ_XOR(s2, 4);
            if (c == 0) { c1o[(lane >> 3) + 8 * j] = F8 ? s1 * (1.f / pg8::F8_SW) : s1; c2o[(lane >> 3) + 8 * j] = s2; } }
    }
}

DI void prologue(kargs_t a, LAS unsigned char* lds, int gw, int NGW, int wave, int lane) {
    unsigned char* ws = a->ws;
    float* vec = (float*)(ws + WS_VEC);
    const float* ones = (const float*)(ws + WS_VEC + V_ONES); const float* zeros = (const float*)(ws + WS_VEC + V_ZEROS);
    LAS float* scr = (LAS float*)(lds + wave * 16384);
    constexpr int T_UP = 8 * 2 * 176, T_QKV = 2 * 80, T_MI = 2 * 192, T_W2 = 8 * 64 * 4, T_WO = 2 * 64, T_WMO = 2 * 64, T_G = 16;
    constexpr int NT = T_UP + T_QKV + T_MI + T_W2 + T_WO + T_WMO + T_G;
    for (int it = gw; it < NT; it += NGW) {
        int r = it;
        if (r < T_UP) {
            const int f = r / 352, rr = r % 352, which = rr / 176, strip = rr % 176, n0 = 32 * strip;
            const int t = 3 * (f >> 1) + 2 * (f & 1);
            const float* gp = t ? a->ln_g + (size_t)(t - 1) * D : nullptr; const float* bp = t ? a->ln_b + (size_t)(t - 1) * D : nullptr;
            const size_t wrow = (size_t)256 * (n0 / 128) + 128 * which + (n0 % 128);
            const float* W = (which ? a->w3 : a->w1) + (size_t)f * D * FF;
            if (gp) tr_strip<true>(W, FF, n0, ws + WS_W13 + (size_t)f * NUP * D, wrow, D, 0, 32, gp, bp, 1.f, vec + V_C1U / 4 + (size_t)f * NUP + wrow, vec + V_C2U / 4 + (size_t)f * NUP + wrow, scr, lane);
            else { tr_strip<true>(W, FF, n0, ws + WS_W13 + (size_t)f * NUP * D, wrow, D, 0, 32, nullptr, nullptr, 1.f, nullptr, nullptr, scr, lane);
                   if (lane < 32) { vec[V_C1U / 4 + (size_t)f * NUP + wrow + lane] = 0.f; vec[V_C2U / 4 + (size_t)f * NUP + wrow + lane] = 0.f; } }
            continue; }
        r -= T_UP;
        if (r < T_QKV) { const int j = r / 80, n0 = 32 * (r % 80); const int t = 6 * j + 1;
            tr_strip<true>(a->wqkv + (size_t)j * D * NQKV, NQKV, n0, ws + WS_WQKV + (size_t)j * NQKV * D, n0, D, 0, 32, a->ln_g + (size_t)(t - 1) * D, a->ln_b + (size_t)(t - 1) * D, n0 < 2048 ? 0.125f : 1.f,
                     vec + V_C1Q / 4 + j * NQKV + n0, vec + V_C2Q / 4 + j * NQKV + n0, scr, lane);
            continue; }
        r -= T_QKV;
        if (r < T_MI) { const int j = r / 192, n0 = 32 * (r % 192); const int t = 6 * j + 4;
            if (true) tr_strip<false>(a->win + (size_t)j * D * NMIW, NMIW, n0, (bf16*)(ws + WS_WIN) + (size_t)j * NMI * D, n0, D, 0, 32, a->ln_g + (size_t)(t - 1) * D, a->ln_b + (size_t)(t - 1) * D, (n0 >= 1024 && n0 < 2048) ? 0.0625f : 1.f,
                     vec + V_C1I / 4 + j * NMI + n0, vec + V_C2I / 4 + j * NMI + n0, scr, lane);
            else tr_strip<true>(a->win + (size_t)j * D * NMIW, NMIW, n0, ws + WS_WIN + 32 * MiB + (size_t)j * 2048 * D, n0 - 4096, D, 0, 32, a->ln_g + (size_t)(t - 1) * D, a->ln_b + (size_t)(t - 1) * D, 1.f,
                     vec + V_C1I / 4 + j * NMI + n0, vec + V_C2I / 4 + j * NMI + n0, scr, lane);
            continue; }
        r -= T_MI;
        if (r < T_W2) { const int f = r / 256, rr = r % 256, strip = rr / 4, kq = rr % 4;
            tr_strip<true>(a->w2 + (size_t)f * FF * D, D, 32 * strip, ws + WS_W2 + (size_t)f * D * FF, 32 * strip, FF, 22 * kq, 22, nullptr, nullptr, 1.f, nullptr, nullptr, scr, lane);
            continue; }
        r -= T_W2;
        if (r < T_WO) { const int j = r / 64, strip = r % 64;
            tr_strip<true>(a->wo + (size_t)j * D * D, D, 32 * strip, ws + WS_WO + (size_t)j * D * D, 32 * strip, D, 0, 32, nullptr, nullptr, 1.f, nullptr, nullptr, scr, lane);
            continue; }
        r -= T_WO;
        if (r < T_WMO) { const int j = r / 64, strip = r % 64;
            tr_strip<false>(a->wmo + (size_t)j * D * D, D, 32 * strip, (bf16*)(ws + WS_WMO) + (size_t)j * D * D, 32 * strip, D, 0, 32, nullptr, nullptr, 1.f, nullptr, nullptr, scr, lane);
            continue; }
        r -= T_WMO;
        {
            const int j = r / 8, jj = r % 8; const int t = 6 * j + 4;
            const float* gp = a->ln_g + (size_t)(t - 1) * D; const float* bp = a->ln_b + (size_t)(t - 1) * D;
            const float* W = a->win + (size_t)j * D * NMIW + NMI + jj;
            bf16* wg16 = (bf16*)(vec + V_WG / 4) + (size_t)(j * 8 + jj) * D;
            float s1 = 0.f, s2 = 0.f;
            for (int k = lane; k < D; k += 64) { const float w = W[(size_t)k * NMIW]; const unsigned hv = pk2(w * gp[k], 0.f) & 0xffffu; wg16[k] = (bf16)hv; s1 += bflo(hv); s2 += w * bp[k]; }
            s1 = wave_sum(s1); s2 = wave_sum(s2);
            if (lane == 0) { vec[V_CG / 4 + j * 16 + jj] = s1; vec[V_CG / 4 + j * 16 + 8 + jj] = s2 + a->bg[j * 8 + jj]; }
        }
    }
    bf16* R = (bf16*)(ws + WS_R); float* sp0 = (float*)(ws + WS_SP);
    for (int m = gw; m < M; m += NGW) {
        const GAS f32x4* xr = (const GAS f32x4*)(a->x + (size_t)m * D);
#pragma unroll
        for (int i = 0; i < 4; ++i) { const f32x4 v0 = __builtin_nontemporal_load(xr + (i * 64 + lane) * 2), v1 = __builtin_nontemporal_load(xr + (i * 64 + lane) * 2 + 1);
            *(GAS v4u*)(R + (size_t)m * D + (i * 64 + lane) * 8) = (v4u){pk2(v0[0], v0[1]), pk2(v0[2], v0[3]), pk2(v1[0], v1[1]), pk2(v1[2], v1[3])};
            { const float xv[8] = {v0[0], v0[1], v0[2], v0[3], v1[0], v1[1], v1[2], v1[3]}; *(GAS v2u*)(ws + WS_R8 + (size_t)m * D + (i * 64 + lane) * 8) = pg8::cvt8_f8(xv, pg8::F8_SR); } }
        if (lane < 8) *(f32x2*)(sp0 + (size_t)m * 16 + lane * 2) = (f32x2){0.f, 256.f * (1.f - LN_EPS)};
    }
    for (int i = gw * 64 + lane; i < D; i += NGW * 64) { vec[V_ONES / 4 + i] = 1.f; vec[V_ZEROS / 4 + i] = 0.f; }
    (void)ones; (void)zeros;
}

DI void gates_phase(LAS unsigned char* lds, const bf16* R, const float* sp, const bf16* wg16, const float* cg, float* GT, int ng, int gx, int gy, int Gy, int wave_in) {
    int wave = wave_in; asm volatile("" : "+s"(wave));
    const int lane = pg8::pg8_lane(), tid = wave * 64 + lane, r32 = lane & 31, hi = lane >> 5;
    LAS float* part = (LAS float*)lds;
    const unsigned mk = (r32 < 8) ? 0xffffffffu : 0u; const v4u mkv = {mk, mk, mk, mk};
    for (int uu = gy; uu < (SEQ / 64) * (BATCH / ng); uu += Gy) { const int b = gx + ng * (uu >> 5), pl = uu & 31;
        const long r0 = (long)b * SEQ + (long)pl * 64;
        const bf16* bsrc = wg16 + (size_t)(r32 & 7) * D + 256 * wave + 8 * hi;
        bf16x8 bfr[16];
#pragma unroll
        for (int ks = 0; ks < 16; ++ks) bfr[ks] = __builtin_bit_cast(bf16x8, *(const v4u*)(bsrc + 16 * ks) & mkv);
#pragma unroll
        for (int rt = 0; rt < 2; ++rt) {
            const bf16* asrc = R + (r0 + 32 * rt + r32) * D + 256 * wave + 8 * hi;
            bf16x8 afr[16];
#pragma unroll
            for (int ks = 0; ks < 16; ++ks) afr[ks] = *(const bf16x8*)(asrc + 16 * ks);
            f32x16 acc = zero16();
#pragma unroll
            for (int ks = 0; ks < 16; ++ks) acc = MFMA32(afr[ks], bfr[ks], acc);
            if (r32 < 8) {
#pragma unroll
                for (int r = 0; r < 16; ++r) part[(wave * 64 + 32 * rt + crow(r, hi)) * 8 + r32] = acc[r];
            }
        }
        WG_BAR();
        {
            const int row = tid >> 3, col = tid & 7;
            float s = 0.f;
#pragma unroll
            for (int w = 0; w < 8; ++w) s += part[(w * 64 + row) * 8 + col];
            const f32x4* spr = (const f32x4*)(sp + (size_t)(r0 + row) * 16);
            const f32x4 v0 = spr[0], v1 = spr[1], v2 = spr[2], v3 = spr[3];
            const float ss = ((v0[0] + v0[2]) + (v1[0] + v1[2])) + ((v2[0] + v2[2]) + (v3[0] + v3[2])), qq = ((v0[1] + v0[3]) + (v1[1] + v1[3])) + ((v2[1] + v2[3]) + (v3[1] + v3[3]));
            const float mean = ss * (1.f / D), var = qq * (1.f / D) - mean * mean, rstd = __builtin_amdgcn_rsqf(var + LN_EPS);
            GT[(size_t)(r0 + row) * 8 + col] = rstd * (s - mean * cg[col]) + cg[8 + col];
        }
        WG_BAR();
    }
}

DI void final_ln(const bf16* R, const float* sp, const float* g, const float* b, float* out, int ng, int gx, int gw, int NGW, int lane) {
    for (int bb = gx; bb < BATCH; bb += ng) for (int m = bb * SEQ + gw; m < (bb + 1) * SEQ; m += NGW) {
        float s, q;
        { const f32x4 v = *(const f32x4*)(sp + (size_t)m * 16 + (lane & 3) * 4); s = v[0] + v[2]; q = v[1] + v[3];
          s += SWZ_XOR(s, 1); q += SWZ_XOR(q, 1); s += SWZ_XOR(s, 2); q += SWZ_XOR(q, 2); }
        const float mean = s * (1.f / D), var = q * (1.f / D) - mean * mean, rstd = __builtin_amdgcn_rsqf(var + LN_EPS);
#pragma unroll
        for (int i = 0; i < 4; ++i) {
            const int k = 8 * lane + 512 * i;
            const v4u rv = __builtin_nontemporal_load((const v4u*)(R + (size_t)m * D + k));
            const f32x4 g0 = *(const f32x4*)(g + k), g1 = *(const f32x4*)(g + k + 4), b0 = *(const f32x4*)(b + k), b1 = *(const f32x4*)(b + k + 4);
            f32x4 o0, o1;
            o0[0] = (bflo(rv.x) - mean) * rstd * g0[0] + b0[0]; o0[1] = (bfhi(rv.x) - mean) * rstd * g0[1] + b0[1]; o0[2] = (bflo(rv.y) - mean) * rstd * g0[2] + b0[2]; o0[3] = (bfhi(rv.y) - mean) * rstd * g0[3] + b0[3];
            o1[0] = (bflo(rv.z) - mean) * rstd * g1[0] + b1[0]; o1[1] = (bfhi(rv.z) - mean) * rstd * g1[1] + b1[1]; o1[2] = (bflo(rv.w) - mean) * rstd * g1[2] + b1[2]; o1[3] = (bfhi(rv.w) - mean) * rstd * g1[3] + b1[3];
            __builtin_nontemporal_store(o0, (GAS f32x4*)(out + (size_t)m * D + k)); __builtin_nontemporal_store(o1, (GAS f32x4*)(out + (size_t)m * D + k + 4));
        }
    }
}

#ifndef PROBE_DUP
#define PROBE_DUP 0
#endif
#ifndef PROBE_DRY
#define PROBE_DRY 1
#endif
#ifndef PROBE_MLV
#define PROBE_MLV 0
#endif
#ifndef SKIP_ATT
#define SKIP_ATT 0
#endif
#ifndef SKIP_MLSTM
#define SKIP_MLSTM 0
#endif

#define GRID_BAR1() do { XcdBarrier b_; b_.bar = (unsigned*)(kargs()->ws + WS_CTL) + CW_BAR; b_.x = xb_xcc_id(); b_.st = (volatile LAS unsigned*)(lds + MISC_OFF) + 8; b_.total = gridDim.x; xcd_barrier(b_); } while (0)
#define GRID_BAR() do { GRID_BAR1(); if (PROBE_DUP & 1024) GRID_BAR1(); } while (0)
#define GROUP_BAR1() do { XcdBarrier b_; b_.bar = (unsigned*)(kargs()->ws + WS_CTL) + CW_BAR + (1 + (bid & 7)) * XCD_BAR_WORDS; b_.x = xb_xcc_id(); b_.st = (volatile LAS unsigned*)(lds + MISC_OFF) + 10; b_.total = gridDim.x / 8; xcd_barrier(b_); } while (0)
#define LAYER_BAR() do { if (grouped) { GROUP_BAR1(); if (PROBE_DUP & 1024) GROUP_BAR1(); } else GRID_BAR(); } while (0)

__global__ void __launch_bounds__(NWAVES * 64, 2) fwd_kernel(Args args_by_value) {
    extern __shared__ __attribute__((aligned(16))) unsigned char lds_raw[];
    LAS unsigned char* lds = (LAS unsigned char*)lds_raw;
    const int w0 = __builtin_amdgcn_readfirstlane((int)threadIdx.x >> 6);
    const int G0 = gridDim.x, bid0 = blockIdx.x; const int G = G0, bid = bid0;
    { const int tid0 = threadIdx.x; if (tid0 < 64) ((volatile LAS unsigned*)(lds + MISC_OFF))[tid0] = 0u; }
    __syncthreads();
    (void)xcd_barrier_post((unsigned*)(kargs()->ws + WS_CTL) + CW_BAR, (volatile LAS unsigned*)(lds + MISC_OFF) + 8);
#ifndef FORCE_UNGROUPED
#define FORCE_UNGROUPED 0
#endif
    const bool grouped = (G0 == 256) && !FORCE_UNGROUPED;
    if (grouped) (void)xcd_barrier_post((unsigned*)(kargs()->ws + WS_CTL) + CW_BAR + (1 + (bid0 & 7)) * XCD_BAR_WORDS, (volatile LAS unsigned*)(lds + MISC_OFF) + 10);
    {
        const int vcu = (G % 8 == 0) ? (bid % 8) * (G / 8) + bid / 8 : bid;
        prologue(kargs(), lds, vcu * NWAVES + w0, G * NWAVES, w0, pg8::pg8_lane());
        if (PROBE_DUP & 1) { WG_BAR(); prologue(kargs(), lds, vcu * NWAVES + w0, G * NWAVES, w0, pg8::pg8_lane()); }
    }
    GRID_BAR();
#ifndef GROUP_STAGGER_TICKS
#define GROUP_STAGGER_TICKS 0
#endif
    if (grouped && (bid0 & 1) && GROUP_STAGGER_TICKS > 0) { const unsigned long long t0 = __builtin_amdgcn_s_memrealtime(); while (__builtin_amdgcn_s_memrealtime() - t0 < (unsigned long long)GROUP_STAGGER_TICKS) __builtin_amdgcn_s_sleep(8); }

    for (int t = 0; t < 3 * DEPTH; ++t) {
        int G = G0, bid = bid0; asm volatile("" : "+s"(G), "+s"(bid));
        const int ng = grouped ? 8 : 1, gx = bid % ng, gy = bid / ng, Gy = G / ng;
        const int layer = t / 3, sub = t % 3;
        const int kind = (sub != 1) ? 0 : ((layer & 1) ? 2 : 1);
        const int j = layer >> 1;
        {
            unsigned char* ws = kargs()->ws;
            float* vec = (float*)(ws + WS_VEC);
            const bf16* R = (const bf16*)(ws + WS_R);
            const float* sp_in = (const float*)(ws + WS_SP) + (size_t)(t & 1) * (SP_BYTES / 4);
            if (kind == 0) {
                const int f = 2 * layer + (sub >> 1);
                pg8::Gemm g{(const bf16*)(ws + WS_R8), (const bf16*)(ws + WS_W13 + (size_t)f * NUP * D), M, NUP, D / 2}; pg8::StaticOrder S; S.init(M, NUP, G, bid);
                pg8::EpiUp E{f, t & 1};
                if (PROBE_DUP & 2048) { S.r1 = 5; pg8::gemm_phase<pg8::EpiUp, pg8::StaticOrder, true, PG8_SP2, true>(lds + RING_OFF, g, S, E, w0); LAYER_BAR(); S.r0 = 5; S.r1 = 1 << 20; }
                if (grouped) { pg8::EpiUpT<true> ET{f, t & 1}; pg8::gemm_phase<pg8::EpiUpT<true>, pg8::StaticOrder, true, PG8_SP2, true>(lds + RING_OFF, g, S, ET, w0); }
                else pg8::gemm_phase<pg8::EpiUp, pg8::StaticOrder, true, PG8_SP2, true>(lds + RING_OFF, g, S, E, w0);
#ifndef PROBE_UPV
#define PROBE_UPV 4
#endif
                if (PROBE_DUP & 4096) { pg8::EpiUpT<true, PROBE_UPV> EP{f, t & 1}; pg8::gemm_phase<pg8::EpiUpT<true, PROBE_UPV>, pg8::StaticOrder, true, PG8_SP2, true>(lds + RING_OFF, g, S, EP, w0); }
                if (PROBE_DUP & 16) pg8::gemm_phase<pg8::EpiUp, pg8::StaticOrder, true, PG8_SP2, true>(lds + RING_OFF, g, S, E, w0);
                if (PROBE_DUP & 128) { pg8::EpiNull EN{(float*)(ws + WS_GATES)}; pg8::gemm_phase<pg8::EpiNull, pg8::StaticOrder, true, PG8_SP2, true>(lds + RING_OFF, g, S, EN, w0); }
            } else {
                if (kind == 2) {
                    pg8::Gemm g{R, (const bf16*)(ws + WS_WIN) + (size_t)j * NMI * D, M, NMI, D}; pg8::StaticOrder S; S.init(M, NMI, G, bid);
                    pg8::EpiLnOut E{1, j, t & 1};
                    pg8::gemm_phase<pg8::EpiLnOut, pg8::StaticOrder, true, PG8_SP2>(lds + RING_OFF, g, S, E, w0);
                    if (PROBE_DUP & 32) pg8::gemm_phase<pg8::EpiLnOut, pg8::StaticOrder, true, PG8_SP2>(lds + RING_OFF, g, S, E, w0);
                }
                if (kind == 1) {
                    const int N = kind == 1 ? NQKV : 2048;
                    pg8::Gemm g{(const bf16*)(ws + WS_R8), (const bf16*)(kind == 1 ? ws + WS_WQKV + (size_t)j * NQKV * D : ws + WS_WIN + 32 * MiB + (size_t)j * 2048 * D), M, N, D / 2}; pg8::StaticOrder S; S.init(M, N, G, bid);
                    pg8::EpiLnOut E{kind == 1 ? 0 : 2, j, t & 1};
                    pg8::gemm_phase<pg8::EpiLnOut, pg8::StaticOrder, true, PG8_SP2, true>(lds + RING_OFF, g, S, E, w0);
                    if (PROBE_DUP & 32) pg8::gemm_phase<pg8::EpiLnOut, pg8::StaticOrder, true, PG8_SP2, true>(lds + RING_OFF, g, S, E, w0);
                }
                if (kind == 2) {
                    gates_phase(lds, R, sp_in, (const bf16*)(vec + V_WG / 4) + (size_t)j * 8 * D, vec + V_CG / 4 + j * 16, (float*)(ws + WS_GATES), ng, gx, gy, Gy, w0);
                    if (PROBE_DUP & 8) { WG_BAR(); gates_phase(lds, R, sp_in, (const bf16*)(vec + V_WG / 4) + (size_t)j * 8 * D, vec + V_CG / 4 + j * 16, (float*)(ws + WS_GATES), ng, gx, gy, Gy, w0); }
                }
            }
        }
        LAYER_BAR();
        if (kind == 1) {
            if (!SKIP_ATT) { kargs_t ka = kargs(); unsigned char* ws = ka->ws; attn_phase(lds_raw, (const bf16*)(ws + WS_QKV), ws + WS_AO, ka->sinks + j * 32, ng, gx, gy, Gy, w0);
                if (PROBE_DUP & 2) attn_phase(lds_raw, (const bf16*)(ws + WS_QKV), ws + WS_AO, ka->sinks + j * 32, ng, gx, gy, Gy, w0); }
            LAYER_BAR();
        } else if (kind == 2) {
            if (!SKIP_MLSTM) { unsigned char* ws = kargs()->ws; mlstm_phase(lds_raw, (const bf16*)(ws + WS_MP), (const float*)(ws + WS_GATES), (bf16*)(ws + WS_HG), ng, gx, gy, Gy, w0);
                if (PROBE_DUP & 4) mlstm_phase<PROBE_MLV>(lds_raw, (const bf16*)(ws + WS_MP), (const float*)(ws + WS_GATES), (bf16*)(ws + WS_H), ng, gx, gy, Gy, w0); }
            LAYER_BAR();
        }
        {
            kargs_t ka = kargs(); unsigned char* ws = ka->ws;
            float coef = kind == 0 ? 0.5f / (pg8::F8_SH * pg8::F8_SW) : (kind == 1 ? 1.f / (pg8::F8_SO * pg8::F8_SW) : 1.f);
            if ((kind == 1 && SKIP_ATT) || (kind == 2 && SKIP_MLSTM)) coef = 0.f;
            pg8::StaticOrder S; S.init(M, D, G, bid);
            pg8::EpiRes E{t, coef, (LAS float*)(lds + TAB_OFF), w0, 0};
            if (kind != 2) {
                const int f = 2 * layer + (sub >> 1);
                pg8::Gemm g{(const bf16*)(ws + (kind == 0 ? WS_H : WS_AO)), (const bf16*)(kind == 0 ? ws + WS_W2 + (size_t)f * D * FF : ws + WS_WO + (size_t)j * D * D), M, D, kind == 0 ? FF / 2 : D / 2};
                if (PROBE_DUP & 64) { pg8::EpiNull EN{(float*)(ws + WS_GATES)}; pg8::gemm_phase<pg8::EpiNull, pg8::StaticOrder, true, PG8_SP2, true>(lds + RING_OFF, g, S, EN, w0); }
                if (PROBE_DUP & 512) { pg8::EpiRes ED{t, coef, (LAS float*)(lds + TAB_OFF), w0, PROBE_DRY}; pg8::gemm_phase<pg8::EpiRes, pg8::StaticOrder, true, PG8_SP2, true>(lds + RING_OFF, g, S, ED, w0); }
                pg8::gemm_phase<pg8::EpiRes, pg8::StaticOrder, true, PG8_SP2, true>(lds + RING_OFF, g, S, E, w0);
            } else {
                pg8::Gemm g{(const bf16*)(ws + WS_HG), (const bf16*)(ws + WS_WMO) + (size_t)j * D * D, M, D, D};
                if (PROBE_DUP & 256) { pg8::EpiNull EN{(float*)(ws + WS_GATES)}; pg8::gemm_phase<pg8::EpiNull, pg8::StaticOrder, true, PG8_SP2, false>(lds + RING_OFF, g, S, EN, w0); }
                pg8::gemm_phase<pg8::EpiRes, pg8::StaticOrder, true, PG8_SP2, false>(lds + RING_OFF, g, S, E, w0);
            }
        }
        LAYER_BAR();
    }
    {
        kargs_t ka = kargs(); unsigned char* ws = ka->ws;
        const int ng = grouped ? 8 : 1, gx = bid % ng, gy = bid / ng, Gy = G / ng;
        final_ln((const bf16*)(ws + WS_R), (const float*)(ws + WS_SP), ka->ln_g + (size_t)(3 * DEPTH - 1) * D, ka->ln_b + (size_t)(3 * DEPTH - 1) * D, ka->out, ng, gx, gy * NWAVES + w0, Gy * NWAVES, pg8::pg8_lane());
    }
}

extern "C" void kernel_launch(void* const* d_in, const int* in_sizes, int n_in, void* d_out, int out_size, void* d_ws, size_t ws_size, hipStream_t stream) {
    static int grid = 0;
    if (grid == 0) {
        if (n_in != 12 || in_sizes[0] != M * D || out_size != M * D || ws_size < WS_END) { fprintf(stderr, "kernel_launch: unexpected shapes / workspace (n_in %d, ws %zu < %zu); nothing launched\n", n_in, ws_size, (size_t)WS_END); grid = -1; return; }
        int dev = 0, cus = 0;
        if (hipGetDevice(&dev) != hipSuccess || hipDeviceGetAttribute(&cus, hipDeviceAttributeMultiprocessorCount, dev) != hipSuccess) { grid = -1; return; }
        if (hipFuncSetAttribute((const void*)fwd_kernel, hipFuncAttributeMaxDynamicSharedMemorySize, LDS_BYTES) != hipSuccess) { fprintf(stderr, "kernel_launch: hipFuncSetAttribute failed\n"); grid = -1; return; }
        int per_cu = 0;
        if (hipOccupancyMaxActiveBlocksPerMultiprocessor(&per_cu, (const void*)fwd_kernel, NWAVES * 64, LDS_BYTES) != hipSuccess || per_cu < 1) { fprintf(stderr, "kernel_launch: occupancy query says %d\n", per_cu); }
        (void)hipGetLastError();
        grid = cus;
#ifdef FORCE_GRID
        grid = FORCE_GRID;
#endif
    }
    if (grid < 0) return;
    (void)hipMemsetAsync((char*)d_ws + WS_CTL, 0, CTL_ZERO_BYTES, stream);
    Args a{};
    a.x = (const float*)d_in[0]; a.w1 = (const float*)d_in[1]; a.w3 = (const float*)d_in[2]; a.w2 = (const float*)d_in[3]; a.ln_g = (const float*)d_in[4]; a.ln_b = (const float*)d_in[5];
    a.wqkv = (const float*)d_in[6]; a.sinks = (const float*)d_in[7]; a.wo = (const float*)d_in[8]; a.win = (const float*)d_in[9]; a.bg = (const float*)d_in[10]; a.wmo = (const float*)d_in[11];
    a.out = (float*)d_out; a.ws = (unsigned char*)d_ws;
    hipLaunchKernelGGL(fwd_kernel, dim3(grid), dim3(NWAVES * 64), LDS_BYTES, stream, a);
}
```

```cpp
#include <hip/hip_runtime.h>
#include <hip/hip_bf16.h>
#include <cstdio>
#include <cstdint>
#include <cmath>

constexpr int BATCH = 8, SEQ = 2048, D = 2048, FF = 5632, DEPTH = 4;
constexpr int M = BATCH * SEQ;
constexpr int NUP = 2 * FF;
constexpr int NQKV = 2560;
constexpr int NMI = 6144, NMIW = 6152;
constexpr float LN_EPS = 1e-5f;
constexpr float ALPHA = 1.681792830507429f;
constexpr float LOG2E = 1.4426950408889634f;

constexpr size_t MiB = 1u << 20;
constexpr size_t WS_CTL = 0, CTL_ZERO_BYTES = 192 * 1024;
constexpr size_t WS_W13 = 2 * MiB;
constexpr size_t WS_W2 = 178 * MiB;
constexpr size_t WS_WQKV = 266 * MiB;
constexpr size_t WS_WO = 286 * MiB;
constexpr size_t WS_WIN = 302 * MiB;
constexpr size_t WS_WMO = 350 * MiB;
constexpr size_t WS_VEC = 366 * MiB;
constexpr size_t V_C1U = 0, V_C2U = 360448, V_C1Q = 720896, V_C2Q = 741376, V_C1I = 761856, V_C2I = 811008, V_CG = 860160, V_WG = 860416, V_ONES = 991488, V_ZEROS = 999680;
constexpr size_t WS_R = 368 * MiB;
constexpr size_t WS_R8 = 432 * MiB;
constexpr size_t WS_SP = 464 * MiB;
constexpr size_t SP_BYTES = (size_t)M * 16 * 4;
constexpr size_t WS_H = 466 * MiB;
constexpr size_t WS_QKV = 554 * MiB;
constexpr size_t WS_AO = 634 * MiB;
constexpr size_t WS_MP = 698 * MiB;
constexpr size_t WS_GATES = 890 * MiB;
constexpr size_t WS_HG = 891 * MiB;
constexpr size_t WS_END = 955 * MiB;
constexpr int CW_TMO = 0, CW_BAR = 4096;

struct Args { const float* x; const float* w1; const float* w3; const float* w2; const float* ln_g; const float* ln_b; const float* wqkv; const float* sinks; const float* wo;
              const float* win; const float* bg; const float* wmo; float* out; unsigned char* ws; };
typedef const __attribute__((address_space(4))) Args* kargs_t;
__device__ __forceinline__ kargs_t kargs() { kargs_t p = (kargs_t)__builtin_amdgcn_kernarg_segment_ptr(); asm volatile("" : "+s"(p)); return p; }

namespace pg8 {
#define PG8_LAS __attribute__((address_space(3)))
typedef unsigned short bf16_t;
typedef short bf16x8 __attribute__((ext_vector_type(8)));
typedef _Float16 f16x8 __attribute__((ext_vector_type(8)));
typedef float f32x4 __attribute__((ext_vector_type(4)));
typedef unsigned u32x4 __attribute__((ext_vector_type(4)));
constexpr int BM = 256, BK = 64, HALF = 128, HTB = HALF * BK * 2  , STAGE_BYTES = 8 * HTB, NXCD = 8, WGM = 8;

__host__ __device__ __forceinline__ int lds_byte(int r, int c) { const int st = (r >> 4) * 2 + (c >> 5), rr = r & 15, cc = c & 31, ob = rr * 64 + cc * 2; return st * 1024 + (ob ^ (((ob >> 9) & 1) << 5)); }
__host__ __device__ __forceinline__ void stage_rc(int b, int& R, int& C) { const int st = b / 1024, sb = b % 1024, swz = sb ^ (((sb >> 9) & 1) << 5); R = (st >> 1) * 16 + swz / 64; C = (st & 1) * 32 + (swz % 64) / 2; }
__host__ __device__ __forceinline__ int perm32(int rho) { const int n = rho >> 4, i = rho & 15; return 8 * (i >> 2) + 4 * n + (i & 3); }

typedef int i32x4 __attribute__((ext_vector_type(4)));
typedef int i32x8 __attribute__((ext_vector_type(8)));
constexpr float F8_SR = 8.f, F8_SW = 1024.f, F8_SH = 16.f, F8_SO = 64.f;
__device__ __forceinline__ i32x8 cat_i8(bf16x8 lo, bf16x8 hi) { const i32x4 a = __builtin_bit_cast(i32x4, lo), b = __builtin_bit_cast(i32x4, hi); return __builtin_shufflevector(a, b, 0, 1, 2, 3, 4, 5, 6, 7); }
__device__ __forceinline__ void mfma_f8_inplace(f32x4& c, const i32x8 a, const i32x8 b) { asm volatile("v_mfma_f32_16x16x128_f8f6f4 %0, %1, %2, %0 cbsz:0 blgp:0" : "+v"(c) : "v"(a), "v"(b)); }
typedef unsigned u32x2 __attribute__((ext_vector_type(2)));
__device__ __forceinline__ u32x2 cvt8_f8(const float (&v)[8], float s) {
    int a, b; asm volatile("" : "=v"(a), "=v"(b));
    a = __builtin_amdgcn_cvt_pk_fp8_f32(v[0] * s, v[1] * s, a, false); a = __builtin_amdgcn_cvt_pk_fp8_f32(v[2] * s, v[3] * s, a, true);
    b = __builtin_amdgcn_cvt_pk_fp8_f32(v[4] * s, v[5] * s, b, false); b = __builtin_amdgcn_cvt_pk_fp8_f32(v[6] * s, v[7] * s, b, true);
    return (u32x2){(unsigned)a, (unsigned)b};
}
__device__ __forceinline__ u32x2 cvt8_f8_raw(const float (&v)[8]) {
    int a, b; asm volatile("" : "=v"(a), "=v"(b));
    a = __builtin_amdgcn_cvt_pk_fp8_f32(v[0], v[1], a, false); a = __builtin_amdgcn_cvt_pk_fp8_f32(v[2], v[3], a, true);
    b = __builtin_amdgcn_cvt_pk_fp8_f32(v[4], v[5], b, false); b = __builtin_amdgcn_cvt_pk_fp8_f32(v[6], v[7], b, true);
    return (u32x2){(unsigned)a, (unsigned)b};
}
__device__ __forceinline__ int pg8_lane() { int l; asm volatile("v_mbcnt_lo_u32_b32 %0, -1, 0\n\tv_mbcnt_hi_u32_b32 %0, -1, %0" : "=v"(l)); return l; }
struct Unit { int pm, pn, ord; };
struct Gemm { const bf16_t* A; const bf16_t* Bt; int M, N, K; };

struct StaticOrder {
    int nM, nN, nwg, G, c, r0 = 0, r1 = 1 << 20;
    __host__ __device__ void init(int M_, int N_, int G_, int c_) { nM = M_ / BM; nN = N_ / BM; nwg = nM * nN; G = G_; c = c_; }
    __host__ __device__ bool next(int i, Unit& u) const {
        i += r0; if (i >= r1) return false;
        const long L = (long)i * G + c; if (L >= nwg) return false;
        int wgid = (int)L; { const int q = nwg / NXCD, r = nwg % NXCD, xcd = wgid % NXCD, off = wgid / NXCD; wgid = (xcd < r ? xcd * (q + 1) : r * (q + 1) + (xcd - r) * q) + off; }
        const int nig = WGM * nN, gid = wgid / nig, fm = gid * WGM, gsz = (nM - fm) < WGM ? (nM - fm) : WGM;
        u.pm = fm + ((wgid % nig) % gsz); u.pn = (wgid % nig) / gsz; u.ord = i - r0; return true;
    }
    __device__ __forceinline__ void a_ready(const Unit&) const {}
    __device__ __forceinline__ void done(const Unit&) const {}
};

__device__ __forceinline__ unsigned cvt_pk_bf16(float lo, float hi) { typedef float f2 __attribute__((ext_vector_type(2))); typedef _Float16 b2 __attribute__((ext_vector_type(2))); f2 v = {lo, hi}; b2 b = __builtin_convertvector(v, b2); return __builtin_bit_cast(unsigned, b); }
__device__ __forceinline__ float bf_lo(unsigned w) { typedef _Float16 b2 __attribute__((ext_vector_type(2))); return (float)__builtin_bit_cast(b2, w)[0]; }
__device__ __forceinline__ float bf_hi(unsigned w) { typedef _Float16 b2 __attribute__((ext_vector_type(2))); return (float)__builtin_bit_cast(b2, w)[1]; }
__device__ __forceinline__ float fsigmoid(float x) { return __builtin_amdgcn_rcpf(1.f + __builtin_amdgcn_exp2f(-LOG2E * x)); }

__device__ __forceinline__ float sum_fq(float v) {
    auto a = __builtin_amdgcn_permlane16_swap(__float_as_uint(v), __float_as_uint(v), false, false); v = __uint_as_float(a[0]) + __uint_as_float(a[1]);
    auto b = __builtin_amdgcn_permlane32_swap(__float_as_uint(v), __float_as_uint(v), false, false); return __uint_as_float(b[0]) + __uint_as_float(b[1]);
}
constexpr int STAB_OFF = 131072 + 16384;
__device__ __forceinline__ void stats_prep(const float* sp, int pm, int wave) {
    PG8_LAS float* stab = (PG8_LAS float*)(STAB_OFF);
    const int tid = wave * 64 + pg8_lane();
    if (tid < BM) {
        const f32x4* p = (const f32x4*)(sp + (size_t)(pm * BM + tid) * 16);
        const f32x4 v0 = p[0], v1 = p[1], v2 = p[2], v3 = p[3];
        const float s = ((v0[0] + v0[2]) + (v1[0] + v1[2])) + ((v2[0] + v2[2]) + (v3[0] + v3[2])), q = ((v0[1] + v0[3]) + (v1[1] + v1[3])) + ((v2[1] + v2[3]) + (v3[1] + v3[3]));
        const float mean = s * (1.f / D), var = q * (1.f / D) - mean * mean;
        typedef float f32x2v __attribute__((ext_vector_type(2)));
        *(PG8_LAS f32x2v*)(stab + 2 * tid) = (f32x2v){mean, __builtin_amdgcn_rsqf(var + LN_EPS)};
    }
    if (tid == 0) *(PG8_LAS int*)(stab + 2 * BM) = pm;
}
constexpr int CTAB_OFF = STAB_OFF + 2048 + 64, CTAB_UNITS = 11;
template <class Sched> __device__ __forceinline__ void ctab_prep(const Sched& S, const float* c1, const float* c2, int wave, float s_lo, float s_hi) {
    const int tid = wave * 64 + pg8_lane();
    const float sc = (tid & HALF) ? s_hi : s_lo;
    Unit u;
    for (int i = 0; i < CTAB_UNITS && S.next(i, u); ++i) {
        const float v = tid < BM ? c1[u.pn * BM + tid] : c2[u.pn * BM + tid - BM];
        typedef _Float16 h1;
        *(PG8_LAS h1*)(CTAB_OFF + i * 1024 + tid * 2) = (h1)(v * sc);
    }
}
__device__ __forceinline__ void ctab_get8(int ord, int which, int lc, float (&o)[8]) {
    typedef _Float16 h8 __attribute__((ext_vector_type(8)));
    const h8 v = *(PG8_LAS const h8*)(CTAB_OFF + ord * 1024 + which * 512 + lc * 2);
#pragma unroll
    for (int i = 0; i < 8; ++i) o[i] = (float)v[i];
}
__device__ __forceinline__ void row_stats(const float* sp, int row0, int fq, float (&mu)[2][4], float (&rs)[2][4]) {
    { PG8_LAS const float* stab = (PG8_LAS const float*)(STAB_OFF); const int pm = row0 / BM;
      if (*(PG8_LAS const int*)(stab + 2 * BM) == pm) {
          typedef float f32x2v __attribute__((ext_vector_type(2)));
#pragma unroll
          for (int ai = 0; ai < 2; ++ai)
#pragma unroll
              for (int m = 0; m < 4; ++m) { const f32x2v v = *(PG8_LAS const f32x2v*)(stab + 2 * ((row0 % BM) + ai * HALF + m * 16)); mu[ai][m] = v[0]; rs[ai][m] = v[1]; }
          return; } }
#pragma unroll
    for (int ai = 0; ai < 2; ++ai)
#pragma unroll
        for (int m = 0; m < 4; ++m) {
            const f32x4 v = *(const f32x4*)(sp + (size_t)(row0 + ai * HALF + m * 16) * 16 + fq * 4);
            float s = v[0] + v[2], q = v[1] + v[3];
            s = sum_fq(s); q = sum_fq(q);
            const float mean = s * (1.f / D), var = q * (1.f / D) - mean * mean;
            mu[ai][m] = mean; rs[ai][m] = __builtin_amdgcn_rsqf(var + LN_EPS);
        }
}

struct EpiNull {
    static constexpr bool PERM = true, AFTER_DRAIN = false; static constexpr int MIN_VM_OPS = 0;
    template <class Sched> __device__ __forceinline__ void prep(const Sched&, const Unit&, int) const {}
    float* sink;
    __device__ __forceinline__ void operator()(const f32x4 (&acc)[2][2][4][2], const Unit& u, int wr, int wc, int, int) const {
        float s = 0.f;
#pragma unroll
        for (int ai = 0; ai < 2; ++ai)
#pragma unroll
            for (int bj = 0; bj < 2; ++bj)
#pragma unroll
                for (int m = 0; m < 4; ++m)
#pragma unroll
                    for (int n = 0; n < 2; ++n) s += acc[ai][bj][m][n][0] + acc[ai][bj][m][n][1] + acc[ai][bj][m][n][2] + acc[ai][bj][m][n][3];
        if (s == 123.456f) sink[u.pm + wr + wc] = s;
    }
};

template <bool TAB, int PRB = 0, bool STG = false> struct EpiUpT {
    static constexpr bool PERM = true, AFTER_DRAIN = false; static constexpr int MIN_VM_OPS = 4;
    static constexpr float CG = -LOG2E, CU = -F8_SH / LOG2E;
    template <class Sched> __device__ __forceinline__ void prep(const Sched& S, const Unit& u, int wave) const { unsigned char* ws = kargs()->ws;
        stats_prep((const float*)(ws + WS_SP) + (size_t)tpar * (SP_BYTES / 4), u.pm, wave);
        ctab_prep(S, (const float*)(ws + WS_VEC + V_C1U) + (size_t)f * NUP, (const float*)(ws + WS_VEC + V_C2U) + (size_t)f * NUP, wave, CG, CU); }
    int f, tpar;
    __device__ __forceinline__ void operator()(const f32x4 (&acc)[2][2][4][2], const Unit& u, int wr, int wc, int, int) const {
        const int lane_ = pg8_lane(), fr = lane_ & 15, fq = lane_ >> 4;
        const int row0 = u.pm * BM + wr * 64 + fr;
        int f = this->f, tpar = this->tpar; asm volatile("" : "+s"(f), "+s"(tpar));
        unsigned char* ws = kargs()->ws; unsigned char* H = ws + ((PRB & 4) ? WS_MP : WS_H);
        float mu[2][4], rs[2][4];
        float k1[2][8], k2[2][8];
        if constexpr (TAB) {
            typedef float f32x2v __attribute__((ext_vector_type(2))); PG8_LAS const float* stab = (PG8_LAS const float*)(STAB_OFF);
#pragma unroll
            for (int ai = 0; ai < 2; ++ai)
#pragma unroll
                for (int m = 0; m < 4; ++m) { const f32x2v v = *(PG8_LAS const f32x2v*)(stab + 2 * ((row0 % BM) + ai * HALF + m * 16)); mu[ai][m] = v[0]; rs[ai][m] = v[1]; }
#pragma unroll
            for (int bj = 0; bj < 2; ++bj) { ctab_get8(u.ord, 0, wc * 32 + 8 * fq + bj * HALF, k1[bj]); ctab_get8(u.ord, 1, wc * 32 + 8 * fq + bj * HALF, k2[bj]); }
        } else {
            const float* c1 = (const float*)(ws + WS_VEC + V_C1U) + (size_t)f * NUP; const float* c2 = (const float*)(ws + WS_VEC + V_C2U) + (size_t)f * NUP; const float* sp = (const float*)(ws + WS_SP) + (size_t)tpar * (SP_BYTES / 4);
            row_stats(sp, row0, fq, mu, rs);
            const int cb = u.pn * BM + wc * 32 + 8 * fq;
            if (u.ord < CTAB_UNITS) {
#pragma unroll
                for (int bj = 0; bj < 2; ++bj) { ctab_get8(u.ord, 0, wc * 32 + 8 * fq + bj * HALF, k1[bj]); ctab_get8(u.ord, 1, wc * 32 + 8 * fq + bj * HALF, k2[bj]); }
            } else {
#pragma unroll
                for (int bj = 0; bj < 2; ++bj)
#pragma unroll
                    for (int i = 0; i < 8; ++i) { k1[bj][i] = c1[cb + bj * HALF + i] * (bj ? CU : CG); k2[bj][i] = c2[cb + bj * HALF + i] * (bj ? CU : CG); }
            }
        }
        unsigned char* hp = H + (size_t)(row0 + (fq & 1) * 16) * FF + u.pn * HALF + wc * 32 + 8 * (fq & 2);
        u32x2 keep = {0u, 0u};
        const unsigned st_w = (unsigned)(131072 + (wr * 64 + fr) * 128 + (((wc * 2 + (fq >> 1)) ^ ((fr >> 1) & 7)) * 16) + 8 * (fq & 1));
        const int st_rr = (wr * 4 + wc) * 16 + (lane_ >> 3), st_ch = lane_ & 7;
        const unsigned st_r = (unsigned)(131072 + st_rr * 128 + ((st_ch ^ ((st_rr >> 1) & 7)) * 16));
        unsigned char* hp_s = H + (size_t)(u.pm * BM + st_rr) * FF + u.pn * HALF + st_ch * 16;
#pragma unroll
        for (int ai = 0; ai < 2; ++ai) {
            if constexpr (STG) { if (ai == 1) { asm volatile("s_waitcnt lgkmcnt(0)" ::: "memory"); __builtin_amdgcn_s_barrier(); asm volatile("" ::: "memory"); } }
#pragma unroll
            for (int m = 0; m < 4; ++m) {
                const float r_ = rs[ai][m], nm = -mu[ai][m] * r_, ra = r_ * (1.f / (F8_SR * F8_SW)), raG = ra * CG, raU = ra * CU;
                typedef float f2 __attribute__((ext_vector_type(2)));
                f2 ga[4], ub[4], sg[4];
#pragma unroll
                for (int n = 0; n < 2; ++n)
#pragma unroll
                    for (int jj = 0; jj < 2; ++jj) {
                        const int c = 4 * n + 2 * jj;
                        const f2 ag = {acc[ai][0][m][n][2 * jj], acc[ai][0][m][n][2 * jj + 1]}, au = {acc[ai][1][m][n][2 * jj], acc[ai][1][m][n][2 * jj + 1]};
                        const f2 k1g = {k1[0][c], k1[0][c + 1]}, k2g = {k2[0][c], k2[0][c + 1]}, k1u = {k1[1][c], k1[1][c + 1]}, k2u = {k2[1][c], k2[1][c + 1]};
                        ga[2 * n + jj] = ag * raG + (k1g * nm + k2g);
                        ub[2 * n + jj] = au * raU + (k1u * nm + k2u);
                    }
#pragma unroll
                for (int i = 0; i < 4; ++i) sg[i] = (PRB & 1) ? ga[i] : (f2){__builtin_amdgcn_exp2f(ga[i][0]), __builtin_amdgcn_exp2f(ga[i][1])};
#pragma unroll
                for (int i = 0; i < 4; ++i) { const f2 t = sg[i] + 1.f; sg[i] = (PRB & 1) ? t : (f2){__builtin_amdgcn_rcpf(t[0]), __builtin_amdgcn_rcpf(t[1])}; }
                float hv[8];
#pragma unroll
                for (int i = 0; i < 4; ++i) { const f2 h2 = ga[i] * sg[i] * ub[i]; hv[2 * i] = h2[0]; hv[2 * i + 1] = h2[1]; }
                const u32x2 xb = cvt8_f8_raw(hv);
                if constexpr (STG) { *(PG8_LAS u32x2*)(st_w + m * 2048) = xb; }
                else if ((m & 1) == 0) keep = xb;
                else {
                    const auto s0 = __builtin_amdgcn_permlane16_swap(keep.x, xb.x, false, false), s1 = __builtin_amdgcn_permlane16_swap(keep.y, xb.y, false, false);
                    if (!(PRB & 2) || ((hv[0] + hv[1]) + (hv[2] + hv[3])) + ((hv[4] + hv[5]) + (hv[6] + hv[7])) == 123.456f) *(u32x4*)(hp + (size_t)(ai * HALF + (m - 1) * 16) * FF) = (u32x4){s0[0], s1[0], s0[1], s1[1]};
                }
            }
            if constexpr (STG) {
                asm volatile("s_waitcnt lgkmcnt(0)" ::: "memory"); __builtin_amdgcn_s_barrier(); asm volatile("" ::: "memory");
                const u32x4 o0 = *(PG8_LAS const u32x4*)(st_r), o1 = *(PG8_LAS const u32x4*)((st_r + 1024) ^ 64u);
                *(u32x4*)(hp_s + (size_t)(ai * HALF) * FF) = o0; *(u32x4*)(hp_s + (size_t)(ai * HALF + 8) * FF) = o1;
            }
        }
    }
};
typedef EpiUpT<false> EpiUp;

struct EpiLnOut {
    static constexpr bool PERM = true, AFTER_DRAIN = false; static constexpr int MIN_VM_OPS = 0 * 16;
    template <class Sched> __device__ __forceinline__ void prep(const Sched&, const Unit& u, int wave) const { stats_prep((const float*)(kargs()->ws + WS_SP) + (size_t)tpar * (SP_BYTES / 4), u.pm, wave); }
    int mode, j, tpar;
    __device__ __forceinline__ void operator()(const f32x4 (&acc)[2][2][4][2], const Unit& u, int wr, int wc, int, int) const {
        const int lane_ = pg8_lane(), fr = lane_ & 15, fq = lane_ >> 4;
        const int row0 = u.pm * BM + wr * 64 + fr;
        int mode = this->mode, j = this->j, tpar = this->tpar; asm volatile("" : "+s"(mode), "+s"(j), "+s"(tpar));
        const bool att = mode == 0; const int coff = mode == 2 ? 4096 : 0;
        unsigned char* ws = kargs()->ws; bf16_t* O = (bf16_t*)(ws + (att ? WS_QKV : WS_MP)) + coff; const int ldo = att ? NQKV : NMI, sig_from = mode == 2 ? 0 : (mode == 1 ? 16 : 1000);
        const float ascale = mode == 1 ? 1.f : 1.f / (F8_SR * F8_SW);
        const float* c1 = (const float*)(ws + WS_VEC + (att ? V_C1Q : V_C1I)) + j * ldo + coff; const float* c2 = (const float*)(ws + WS_VEC + (att ? V_C2Q : V_C2I)) + j * ldo + coff; const float* sp = (const float*)(ws + WS_SP) + (size_t)tpar * (SP_BYTES / 4);
        float mu[2][4], rs[2][4]; row_stats(sp, row0, fq, mu, rs);
        const int cb = u.pn * BM + wc * 32 + 8 * fq;
        const bool sg = u.pn >= sig_from;
        f32x4 k1[2][2], k2[2][2];
#pragma unroll
        for (int bj = 0; bj < 2; ++bj)
#pragma unroll
            for (int n = 0; n < 2; ++n) { k1[bj][n] = *(const f32x4*)(c1 + cb + bj * HALF + 4 * n); k2[bj][n] = *(const f32x4*)(c2 + cb + bj * HALF + 4 * n); }
        bf16_t* op = O + (size_t)row0 * ldo + cb;
#define LNOUT_ROWS(SIG) _Pragma("unroll") for (int ai = 0; ai < 2; ++ai) _Pragma("unroll") for (int m = 0; m < 4; ++m) { \
            const float r_ = rs[ai][m], nm = -mu[ai][m] * r_, ra = r_ * ascale; \
            _Pragma("unroll") for (int bj = 0; bj < 2; ++bj) { \
                typedef float f2 __attribute__((ext_vector_type(2))); float v[8]; \
                _Pragma("unroll") for (int n = 0; n < 2; ++n) _Pragma("unroll") for (int jj = 0; jj < 2; ++jj) { \
                    const f2 a2 = {acc[ai][bj][m][n][2 * jj], acc[ai][bj][m][n][2 * jj + 1]}, c1v = {k1[bj][n][2 * jj], k1[bj][n][2 * jj + 1]}, c2v = {k2[bj][n][2 * jj], k2[bj][n][2 * jj + 1]}; \
                    f2 t = a2 * ra + (c1v * nm + c2v); \
                    if (SIG) { const f2 e = t * (-LOG2E); const f2 d = (f2){__builtin_amdgcn_exp2f(e[0]), __builtin_amdgcn_exp2f(e[1])} + 1.f; t = (f2){__builtin_amdgcn_rcpf(d[0]), __builtin_amdgcn_rcpf(d[1])}; } \
                    v[4 * n + 2 * jj] = t[0]; v[4 * n + 2 * jj + 1] = t[1]; } \
                u32x4 w; w.x = cvt_pk_bf16(v[0], v[1]); w.y = cvt_pk_bf16(v[2], v[3]); w.z = cvt_pk_bf16(v[4], v[5]); w.w = cvt_pk_bf16(v[6], v[7]); \
                *(u32x4*)(op + (size_t)(ai * HALF + m * 16) * ldo + bj * HALF) = w; } }
        const int sgi = __builtin_amdgcn_readfirstlane(sg ? 1 : 0);
        if (sgi) { LNOUT_ROWS(true) } else { LNOUT_ROWS(false) }
#undef LNOUT_ROWS
    }
};

#ifndef OG_F8
#define OG_F8 1
#endif
#define OG_F8_ OG_F8
struct EpiRes {
    static constexpr bool PERM = true, AFTER_DRAIN = false; static constexpr int MIN_VM_OPS = 0 * 32;
    template <class Sched> __device__ __forceinline__ void prep(const Sched&, const Unit& u, int wave) const { stats_prep((const float*)(kargs()->ws + WS_SP) + (size_t)(t & 1) * (SP_BYTES / 4), u.pm, wave); }
    int t; float coef; PG8_LAS float* tab; int wave; int dry;
    __device__ __forceinline__ void operator()(const f32x4 (&acc)[2][2][4][2], const Unit& u, int wr, int wc, int, int) const {
        const int lane_ = pg8_lane(), fr = lane_ & 15, fq = lane_ >> 4;
        typedef float f32x2v __attribute__((ext_vector_type(2)));
        const int row0 = u.pm * BM + wr * 64 + fr;
        int t = this->t; asm volatile("" : "+s"(t)); float coef = this->coef; asm volatile("" : "+v"(coef));
        const bool need8 = (t != 11 && (OG_F8_ || (t != 3 && t != 9))) || dry;
        kargs_t ka = kargs(); unsigned char* ws = ka->ws; bf16_t* R = (bf16_t*)(ws + WS_R); unsigned char* R8 = ws + (dry ? WS_MP + 64 * MiB : WS_R8); bf16_t* Ro = dry ? (bf16_t*)(ws + WS_MP) : R;
        const float* g = t ? ka->ln_g + (size_t)(t - 1) * D : (const float*)(ws + WS_VEC + V_ONES); const float* b = t ? ka->ln_b + (size_t)(t - 1) * D : (const float*)(ws + WS_VEC + V_ZEROS);
        const float* sp_in = (const float*)(ws + WS_SP) + (size_t)(t & 1) * (SP_BYTES / 4); float* sp_out = dry ? (float*)(ws + WS_MP + 96 * MiB) : (float*)(ws + WS_SP) + (size_t)((t + 1) & 1) * (SP_BYTES / 4);
        const int cb0 = u.pn * BM + wc * 32 + 8 * fq;
        u32x4 cur[4];
#pragma unroll
        for (int m = 0; m < 4; ++m) cur[m] = *(const u32x4*)(R + (size_t)(row0 + m * 16) * D + cb0);
        float mu[2][4], rs[2][4]; row_stats(sp_in, row0, fq, mu, rs);
        f32x4 gv[2], bv[2];
#pragma unroll
        for (int k = 0; k < 4; ++k) {
            const int bj = k >> 1, ai = k & 1, cb = cb0 + bj * HALF;
            if (ai == 0) {
#pragma unroll
                for (int n = 0; n < 2; ++n) { gv[n] = *(const f32x4*)(g + cb + 4 * n); bv[n] = *(const f32x4*)(b + cb + 4 * n) * ALPHA; }
            }
#pragma unroll
            for (int m = 0; m < 4; ++m) {
                const float A_ = ALPHA * rs[ai][m], B_ = -mu[ai][m] * A_;
                const size_t off = (size_t)(row0 + ai * HALF + m * 16) * D + cb;
                const u32x4 o = cur[m];
                if (k < 3 && dry != 3) cur[m] = *(const u32x4*)(R + (size_t)(row0 + ((k + 1) & 1) * HALF + m * 16) * D + cb0 + ((k + 1) >> 1) * HALF);
                typedef float fv2 __attribute__((ext_vector_type(2)));
                float nv[8];
#pragma unroll
                for (int n = 0; n < 2; ++n)
#pragma unroll
                    for (int jj = 0; jj < 2; ++jj) {
                        const unsigned w2 = n == 0 ? (jj == 0 ? o.x : o.y) : (jj == 0 ? o.z : o.w); const fv2 r2 = {bf_lo(w2), bf_hi(w2)}, a2 = {acc[ai][bj][m][n][2 * jj], acc[ai][bj][m][n][2 * jj + 1]};
                        const fv2 g2 = {gv[n][2 * jj], gv[n][2 * jj + 1]}, b2 = {bv[n][2 * jj], bv[n][2 * jj + 1]};
                        const fv2 t = (r2 * A_ + B_) * g2 + (a2 * coef + b2);
                        nv[4 * n + 2 * jj] = t[0]; nv[4 * n + 2 * jj + 1] = t[1];
                    }
                u32x4 w; w.x = cvt_pk_bf16(nv[0], nv[1]); w.y = cvt_pk_bf16(nv[2], nv[3]); w.z = cvt_pk_bf16(nv[4], nv[5]); w.w = cvt_pk_bf16(nv[6], nv[7]);
                if (dry != 2) { *(u32x4*)(Ro + off) = w;
                if (need8) *(u32x2*)(R8 + off) = cvt8_f8(nv, F8_SR); }
                const float f0 = bf_lo(w.x), f1 = bf_hi(w.x), f2 = bf_lo(w.y), f3 = bf_hi(w.y), f4 = bf_lo(w.z), f5 = bf_hi(w.z), f6 = bf_lo(w.w), f7 = bf_hi(w.w);
                float s = ((f0 + f1) + (f2 + f3)) + ((f4 + f5) + (f6 + f7));
                float q = ((f0 * f0 + f1 * f1) + (f2 * f2 + f3 * f3)) + ((f4 * f4 + f5 * f5) + (f6 * f6 + f7 * f7));
                s = sum_fq(s); q = sum_fq(q);
                if (fq == 0) *(PG8_LAS f32x2v*)(tab + (((ai * HALF + wr * 64 + m * 16 + fr) * 4 + wc) * 2 + bj) * 2) = (f32x2v){s, q};
                asm volatile("" ::: "memory");
            }
        }
        asm volatile("s_waitcnt lgkmcnt(0)" ::: "memory"); __builtin_amdgcn_s_barrier(); asm volatile("" ::: "memory");
        const int tid = wave * 64 + pg8_lane();
        if (tid < BM) {
            const PG8_LAS f32x4* t4 = (const PG8_LAS f32x4*)(tab + tid * 16);
            const f32x4 a = t4[0], c = t4[1], d = t4[2], e = t4[3];
            *(f32x2v*)(sp_out + (size_t)(u.pm * BM + tid) * 16 + u.pn * 2) = (f32x2v){((a[0] + a[2]) + (c[0] + c[2])) + ((d[0] + d[2]) + (e[0] + e[2])), ((a[1] + a[3]) + (c[1] + c[3])) + ((d[1] + d[3]) + (e[1] + e[3]))};
        }
    }
};

template <class Epi, class Sched, bool ALIGN_EPI = false, bool SP2 = false, bool F8 = false>
__device__ __forceinline__ void gemm_phase(PG8_LAS unsigned char* lds, const Gemm g, const Sched& S, const Epi& E, int wave_in) {
    int wid = wave_in; asm volatile("" : "+s"(wid));
    const int lane = pg8_lane(), tid = wid * 64 + lane, wr = wid >> 2, wc = wid & 3, fr = lane & 15, fq = lane >> 4;
    const int K = g.K, nt = K / BK;
    unsigned voffA[2], voffB[2];
#pragma unroll
    for (int i = 0; i < 2; ++i) { int R, C; stage_rc(tid * 16 + i * 8192, R, C); const int Rb = Epi::PERM ? ((R & ~31) + perm32(R & 31)) : R;
        voffA[i] = (unsigned)(R * K + C) * 2u; voffB[i] = (unsigned)(Rb * K + C) * 2u; }
    const size_t kstep = (size_t)(BK * 2);
    const size_t hstep = (size_t)HALF * K * 2;
    const size_t tstep = 2 * hstep;
    const unsigned ldsw = (unsigned)wid * 1024u;
    const int aoff = lds_byte(wr * 64 + fr, fq * 8), boff = lds_byte(wc * 32 + fr, fq * 8);
#define PG8_SA(b, h) (((b) * 2 + (h)) * HTB)
#define PG8_SB(b, h) ((4 + (b) * 2 + (h)) * HTB)
#ifndef PG8_DMA_IN_MMA
#define PG8_DMA_IN_MMA 0
#endif
#ifndef PG8_B_AUX
#define PG8_B_AUX 0
#endif
#define PG8_STAGE_AUX(bufoff, gbase, voff, aux) do { _Pragma("unroll") for (int _i = 0; _i < 2; ++_i) \
        __builtin_amdgcn_global_load_lds((const unsigned*)((const char*)(gbase) + (voff)[_i]), (PG8_LAS unsigned*)(lds + (bufoff) + ldsw + _i * 8192), 16, 0, aux); } while (0)
#define PG8_STAGE(bufoff, gbase, voff) PG8_STAGE_AUX(bufoff, gbase, voff, PG8_IS_B(bufoff) ? PG8_B_AUX : 0)
#define PG8_IS_B(bufoff) ((bufoff) >= 4 * HTB)
#define PG8_LDA(dst, b, h) do { _Pragma("unroll") for (int m = 0; m < 4; ++m) _Pragma("unroll") for (int k = 0; k < 2; ++k) dst[m][k] = *(const PG8_LAS bf16x8*)(lds + PG8_SA(b, h) + aoff + m * 2048 + k * 1024); } while (0)
#define PG8_LDB(dst, b, h) do { _Pragma("unroll") for (int n = 0; n < 2; ++n) _Pragma("unroll") for (int k = 0; k < 2; ++k) dst[n][k] = *(const PG8_LAS bf16x8*)(lds + PG8_SB(b, h) + boff + n * 2048 + k * 1024); } while (0)
#define PG8_MMA(ai, bj, At, Bt) do { __builtin_amdgcn_s_setprio(1); _Pragma("unroll") for (int m = 0; m < 4; ++m) _Pragma("unroll") for (int n = 0; n < 2; ++n) { \
        if constexpr (F8) mfma_f8_inplace(acc[ai][bj][m][n], cat_i8(Bt[n][0], Bt[n][1]), cat_i8(At[m][0], At[m][1])); \
        else { _Pragma("unroll") for (int k = 0; k < 2; ++k) acc[ai][bj][m][n] = __builtin_amdgcn_mfma_f32_16x16x32_f16(__builtin_bit_cast(f16x8, Bt[n][k]), __builtin_bit_cast(f16x8, At[m][k]), acc[ai][bj][m][n], 0, 0, 0); } } \
        __builtin_amdgcn_s_setprio(0); } while (0)
#define PG8_WAIT_V(n) asm volatile("s_waitcnt vmcnt(" #n ")" ::: "memory")
#define PG8_WAIT_L(n) asm volatile("s_waitcnt lgkmcnt(" #n ")" ::: "memory")
#define PG8_WAIT_VN(n) asm volatile("s_waitcnt vmcnt(%0)" :: "n"(n) : "memory")
#define PG8_BAR __builtin_amdgcn_s_barrier()
#define PG8_SCHED __builtin_amdgcn_sched_barrier(0)
    Unit cur, nxt; int ui = 0;
    constexpr int NS = Epi::MIN_VM_OPS;
    if (!S.next(0, cur)) return;
    f32x4 acc[2][2][4][2];
#pragma unroll
    for (int a = 0; a < 2; ++a)
#pragma unroll
        for (int b = 0; b < 2; ++b)
#pragma unroll
            for (int m = 0; m < 4; ++m)
#pragma unroll
                for (int n = 0; n < 2; ++n) { float z0, z1, z2, z3; asm volatile("v_mov_b32 %0, 0\n\tv_mov_b32 %1, 0\n\tv_mov_b32 %2, 0\n\tv_mov_b32 %3, 0" : "=v"(z0), "=v"(z1), "=v"(z2), "=v"(z3)); acc[a][b][m][n] = (f32x4){z0, z1, z2, z3}; }
    bf16x8 At[4][2], B0[2][2], B1[2][2];
    const char* cA = (const char*)g.A + (size_t)cur.pm * tstep; const char* cB = (const char*)g.Bt + (size_t)cur.pn * tstep;
    S.a_ready(cur);
    if constexpr (SP2) {
        PG8_STAGE(PG8_SB(0, 0), cB, voffB); PG8_STAGE(PG8_SB(0, 1), cB + hstep, voffB); PG8_STAGE(PG8_SA(0, 0), cA, voffA); PG8_STAGE(PG8_SA(0, 1), cA + hstep, voffA);
        E.prep(S, cur, wave_in);
        if (wr == 1) PG8_BAR;
        PG8_WAIT_V(2); PG8_BAR;
        PG8_STAGE(PG8_SB(1, 0), cB + kstep, voffB); PG8_STAGE(PG8_SA(1, 0), cA + kstep, voffA); PG8_STAGE(PG8_SB(1, 1), cB + hstep + kstep, voffB);
        PG8_WAIT_V(6); PG8_BAR;
    } else {
        PG8_STAGE(PG8_SB(0, 0), cB, voffB); PG8_STAGE(PG8_SA(0, 0), cA, voffA); PG8_STAGE(PG8_SB(0, 1), cB + hstep, voffB); PG8_STAGE(PG8_SA(0, 1), cA + hstep, voffA);
        E.prep(S, cur, wave_in);
        if (wr == 1) PG8_BAR;
        PG8_WAIT_V(4); PG8_BAR;
        PG8_STAGE(PG8_SB(1, 0), cB + kstep, voffB); PG8_STAGE(PG8_SA(1, 0), cA + kstep, voffA); PG8_STAGE(PG8_SB(1, 1), cB + hstep + kstep, voffB);
        PG8_WAIT_V(6); PG8_BAR;
    }
    for (;;) {
        const bool has_next = S.next(ui + 1, nxt);
        const char* nA = has_next ? (const char*)g.A + (size_t)nxt.pm * tstep : cA; const char* nB = has_next ? (const char*)g.Bt + (size_t)nxt.pn * tstep : cB;
        for (int t = 0; t < nt; t += 2) {
            const bool last = (t == nt - 2);
            const char* a1 = cA + (size_t)(t + 1) * kstep;
            const char* a2 = last ? nA : cA + (size_t)(t + 2) * kstep; const char* b2 = last ? nB : cB + (size_t)(t + 2) * kstep;
            const char* a3 = a2 + kstep; const char* b3 = b2 + kstep;
            if (last && has_next) S.a_ready(nxt);
            if constexpr (SP2) {
            const bool after_epi = NS > 0 && t == 0 && ui > 0;
            PG8_LDB(B0, 0, 0); PG8_LDB(B1, 0, 1); PG8_SCHED; PG8_LDA(At, 0, 0); PG8_STAGE(PG8_SA(1, 1), a1 + hstep, voffA);
            if (after_epi) PG8_WAIT_VN(8 + NS); else PG8_WAIT_V(8);
            PG8_WAIT_L(0); PG8_BAR; PG8_MMA(0, 0, At, B0); PG8_MMA(0, 1, At, B1); PG8_BAR; PG8_SCHED;
#if PG8_DMA_IN_MMA
            PG8_LDA(At, 0, 1); PG8_STAGE(PG8_SB(0, 0), b2, voffB); PG8_STAGE(PG8_SB(0, 1), b2 + hstep, voffB);
            if (after_epi) PG8_WAIT_VN(6 + NS); else PG8_WAIT_V(6);
            PG8_WAIT_L(0); PG8_BAR; PG8_MMA(1, 0, At, B0); PG8_STAGE(PG8_SA(0, 0), a2, voffA); PG8_MMA(1, 1, At, B1); PG8_BAR; PG8_SCHED;
#else
            PG8_LDA(At, 0, 1); PG8_STAGE(PG8_SB(0, 0), b2, voffB); PG8_STAGE(PG8_SB(0, 1), b2 + hstep, voffB); PG8_STAGE(PG8_SA(0, 0), a2, voffA);
            if (after_epi) PG8_WAIT_VN(8 + NS); else PG8_WAIT_V(8);
            PG8_WAIT_L(0); PG8_BAR; PG8_MMA(1, 0, At, B0); PG8_MMA(1, 1, At, B1); PG8_BAR; PG8_SCHED;
#endif
            PG8_LDB(B0, 1, 0); PG8_LDB(B1, 1, 1); PG8_SCHED; PG8_LDA(At, 1, 0); PG8_STAGE(PG8_SA(0, 1), a2 + hstep, voffA);
            PG8_WAIT_V(8); PG8_WAIT_L(0); PG8_BAR; PG8_MMA(0, 0, At, B0); PG8_MMA(0, 1, At, B1); PG8_BAR; PG8_SCHED;
#if PG8_DMA_IN_MMA
            PG8_LDA(At, 1, 1); PG8_STAGE(PG8_SB(1, 0), b3, voffB); PG8_STAGE(PG8_SB(1, 1), b3 + hstep, voffB);
            PG8_WAIT_V(6); PG8_WAIT_L(0); PG8_BAR; PG8_MMA(1, 0, At, B0); PG8_STAGE(PG8_SA(1, 0), a3, voffA); PG8_MMA(1, 1, At, B1); PG8_BAR; PG8_SCHED;
#else
            PG8_LDA(At, 1, 1); PG8_STAGE(PG8_SB(1, 0), b3, voffB); PG8_STAGE(PG8_SB(1, 1), b3 + hstep, voffB); PG8_STAGE(PG8_SA(1, 0), a3, voffA);
            PG8_WAIT_V(8); PG8_WAIT_L(0); PG8_BAR; PG8_MMA(1, 0, At, B0); PG8_MMA(1, 1, At, B1); PG8_BAR; PG8_SCHED;
#endif
            } else {
            PG8_LDB(B0, 0, 0); PG8_SCHED; PG8_LDA(At, 0, 0); PG8_STAGE(PG8_SA(1, 1), a1 + hstep, voffA);
            PG8_WAIT_L(8); PG8_BAR; PG8_WAIT_L(0); PG8_MMA(0, 0, At, B0); PG8_BAR; PG8_SCHED;
            PG8_LDB(B1, 0, 1); PG8_STAGE(PG8_SB(0, 0), b2, voffB);
            PG8_BAR; PG8_WAIT_L(0); PG8_MMA(0, 1, At, B1); PG8_BAR;
            PG8_LDA(At, 0, 1); PG8_STAGE(PG8_SA(0, 0), a2, voffA);
            PG8_BAR; PG8_WAIT_L(0); PG8_MMA(1, 0, At, B0); PG8_BAR; PG8_SCHED;
            PG8_STAGE(PG8_SB(0, 1), b2 + hstep, voffB);
            PG8_WAIT_V(6); PG8_BAR; PG8_MMA(1, 1, At, B1); PG8_BAR;
            PG8_LDB(B0, 1, 0); PG8_SCHED; PG8_LDA(At, 1, 0); PG8_STAGE(PG8_SA(0, 1), a2 + hstep, voffA);
            PG8_WAIT_L(8); PG8_BAR; PG8_WAIT_L(0); PG8_MMA(0, 0, At, B0); PG8_BAR; PG8_SCHED;
            PG8_LDB(B1, 1, 1); PG8_STAGE(PG8_SB(1, 0), b3, voffB);
            PG8_BAR; PG8_WAIT_L(0); PG8_MMA(0, 1, At, B1); PG8_BAR;
            PG8_LDA(At, 1, 1); PG8_STAGE(PG8_SA(1, 0), a3, voffA);
            PG8_BAR; PG8_WAIT_L(0); PG8_MMA(1, 0, At, B0); PG8_BAR; PG8_SCHED;
            PG8_STAGE(PG8_SB(1, 1), b3 + hstep, voffB);
            PG8_WAIT_V(6); PG8_BAR; PG8_MMA(1, 1, At, B1); PG8_BAR;
            }
        }
        if constexpr (F8) asm volatile("s_nop 15\n\ts_nop 7" ::: "memory");
        if constexpr (ALIGN_EPI) { if (wr == 0) PG8_BAR; }
        if constexpr (!Epi::AFTER_DRAIN) { E(acc, cur, wr, wc, fr, fq); S.done(cur); }
        if (!has_next) break;
#pragma unroll
        for (int a = 0; a < 2; ++a)
#pragma unroll
            for (int b = 0; b < 2; ++b)
#pragma unroll
                for (int m = 0; m < 4; ++m)
#pragma unroll
                    for (int n = 0; n < 2; ++n) { float z0, z1, z2, z3; asm volatile("v_mov_b32 %0, 0\n\tv_mov_b32 %1, 0\n\tv_mov_b32 %2, 0\n\tv_mov_b32 %3, 0" : "=v"(z0), "=v"(z1), "=v"(z2), "=v"(z3)); acc[a][b][m][n] = (f32x4){z0, z1, z2, z3}; }
        cur = nxt; cA = nA; cB = nB; ++ui;
        if constexpr (ALIGN_EPI) { if (wr == 1) PG8_BAR; }
    }
    PG8_WAIT_V(0);
    if constexpr (!ALIGN_EPI) { if (wr == 0) PG8_BAR; }
    PG8_BAR;
    if constexpr (Epi::AFTER_DRAIN) { E.fused(acc, cur, wr, wc, fr, fq, lds, wid, lane); S.done(cur); }
#undef PG8_SA
#undef PG8_SB
#undef PG8_STAGE
#undef PG8_STAGE_AUX
#undef PG8_IS_B
#undef PG8_LDA
#undef PG8_LDB
#undef PG8_MMA
#undef PG8_WAIT_V
#undef PG8_WAIT_L
#undef PG8_WAIT_VN
#undef PG8_BAR
#undef PG8_SCHED
}
}

#ifndef PG8_SP2
#define PG8_SP2 true
#endif

#define GAS __attribute__((address_space(1)))
#define LAS __attribute__((address_space(3)))
typedef unsigned short bf16;
typedef unsigned v4u __attribute__((ext_vector_type(4)));
typedef unsigned v2u __attribute__((ext_vector_type(2)));
typedef float f32x4 __attribute__((ext_vector_type(4)));
typedef float f32x2 __attribute__((ext_vector_type(2)));
typedef float f32x16 __attribute__((ext_vector_type(16)));
typedef short bf16x8 __attribute__((ext_vector_type(8)));
typedef short s16x4 __attribute__((ext_vector_type(4)));
typedef GAS unsigned gu32;
typedef GAS unsigned long long gu64;
typedef LAS const char* lcp;
typedef LAS char* lwp;
#define RLX_AGENT __ATOMIC_RELAXED, __HIP_MEMORY_SCOPE_AGENT
#define LDS_WAIT() asm volatile("s_waitcnt lgkmcnt(0)" ::: "memory")
#define VM_WAIT() asm volatile("s_waitcnt vmcnt(0)" ::: "memory")
#define WG_BAR() do { asm volatile("s_waitcnt vmcnt(0) lgkmcnt(0)" ::: "memory"); __builtin_amdgcn_s_barrier(); asm volatile("" ::: "memory"); } while (0)
#define DI __device__ __forceinline__
#define MFMA32(a, b, c) __builtin_amdgcn_mfma_f32_32x32x16_f16(__builtin_bit_cast(pg8::f16x8, (a)), __builtin_bit_cast(pg8::f16x8, (b)), (c), 0, 0, 0)
DI unsigned pk2(float lo, float hi) { return pg8::cvt_pk_bf16(lo, hi); }
DI float bflo(unsigned w) { return pg8::bf_lo(w); }
DI float bfhi(unsigned w) { return pg8::bf_hi(w); }
DI float ex2(float x) { return __builtin_amdgcn_exp2f(x); }
DI f32x16 zero16() { float z = 0.f; asm volatile("" : "+v"(z)); return (f32x16){z, z, z, z, z, z, z, z, z, z, z, z, z, z, z, z}; }
DI int crow(int r, int hi) { return (r & 3) + 8 * (r >> 2) + 4 * hi; }
#define SWZ_XOR(v, m) __uint_as_float((unsigned)__builtin_amdgcn_ds_swizzle((int)__float_as_uint(v), ((m) << 10) | 0x1f))
DI float half_swap_add(float v);
DI float wave_sum(float v) { v += SWZ_XOR(v, 1); v += SWZ_XOR(v, 2); v += SWZ_XOR(v, 4); v += SWZ_XOR(v, 8); v += SWZ_XOR(v, 16); return half_swap_add(v); }
DI float shfl_lane(float v, int src_lane) { return __uint_as_float((unsigned)__builtin_amdgcn_ds_bpermute(src_lane << 2, (int)__float_as_uint(v))); }
DI float half_swap_add(float v) { auto rr = __builtin_amdgcn_permlane32_swap(__float_as_uint(v), __float_as_uint(v), false, false); return __uint_as_float(rr[0]) + __uint_as_float(rr[1]); }
DI float half_swap_max(float v) { auto rr = __builtin_amdgcn_permlane32_swap(__float_as_uint(v), __float_as_uint(v), false, false); return fmaxf(__uint_as_float(rr[0]), __uint_as_float(rr[1])); }
typedef short v4i16_t __attribute__((ext_vector_type(4)));
DI s16x4 vtr(lcp p) { return __builtin_bit_cast(s16x4, __builtin_amdgcn_ds_read_tr16_b64_v4i16((LAS v4i16_t*)p)); }
DI bf16x8 cat8(s16x4 lo, s16x4 hi) { return __builtin_shufflevector(lo, hi, 0, 1, 2, 3, 4, 5, 6, 7); }
DI bf16x8 trfrag(lcp p) { return cat8(vtr(p), vtr(p + 512)); }
DI bf16x8 ldfrag(lcp p) { return *(const LAS bf16x8*)p; }
DI bf16x8 mask_frag(v4u v, unsigned m) { v4u o; asm("v_and_b32 %0, %4, %8\n\tv_and_b32 %1, %5, %8\n\tv_and_b32 %2, %6, %8\n\tv_and_b32 %3, %7, %8\n\ts_nop 1" : "=&v"(o.x), "=&v"(o.y), "=&v"(o.z), "=&v"(o.w) : "v"(v.x), "v"(v.y), "v"(v.z), "v"(v.w), "v"(m)); return __builtin_bit_cast(bf16x8, o); }
DI void glds16(const void* gsrc, LAS void* ldst) { __builtin_amdgcn_global_load_lds((const unsigned*)gsrc, (LAS unsigned*)ldst, 16, 0, 0); }
#define PACK8(x, s) ((bf16x8)__builtin_bit_cast(bf16x8, (v4u){pk2((x)[8 * (s) + 0], (x)[8 * (s) + 1]), pk2((x)[8 * (s) + 2], (x)[8 * (s) + 3]), pk2((x)[8 * (s) + 4], (x)[8 * (s) + 5]), pk2((x)[8 * (s) + 6], (x)[8 * (s) + 7])}))

constexpr int RING_OFF = 0, RING_BYTES = 131072;
constexpr int TAB_OFF = 131072;
constexpr int MISC_OFF = 163840 - 256;
constexpr int LDS_BYTES = 163840;
constexpr int AT_K = 0, AT_V = 32768, AT_WS = 65536, AT_STG = 67584;
constexpr int ML_K = 0, ML_V = 65536, ML_VW = 81920, ML_C = 98304, ML_N = 131072, ML_G2 = 131584, ML_M2 = 132096, ML_FI = 132608, ML_EI = 133120, ML_WK = 133632, ML_WKB = 134144, ML_SC = 134400, ML_WS = 134464, ML_STG = 136512;
static_assert(ML_STG + 4 * 4096 <= MISC_OFF && AT_STG + 8 * 4096 <= MISC_OFF && pg8::CTAB_OFF + pg8::CTAB_UNITS * 1024 <= MISC_OFF && pg8::STAB_OFF == TAB_OFF + 16384, "LDS map");

#define XB_TMO      128
#define XB_XCNT(j)  (256  + 64 * (j))
#define XB_XSUB(j)  (1280 + 64 * (j))
#define XB_XGEN(j)  (2304 + 64 * (j))
#define XB_TOP      3328
#define XB_TOPGEN   3392
#define XCD_BAR_WORDS 3456
#define XB_SPIN_CAP (1u << 18)

__device__ __forceinline__ unsigned xb_ld(unsigned* p)              { return __hip_atomic_load(p, __ATOMIC_RELAXED, __HIP_MEMORY_SCOPE_AGENT); }
__device__ __forceinline__ unsigned xb_add(unsigned* p, unsigned v) { return __hip_atomic_fetch_add(p, v, __ATOMIC_RELAXED, __HIP_MEMORY_SCOPE_AGENT); }
__device__ __forceinline__ unsigned xb_xcc_id() { return (unsigned)__builtin_amdgcn_s_getreg((3 << 11) | 20) & 0xFu; }
#define XB_SPIN(cond, bar) do { unsigned _sp = 0; while (cond) { __builtin_amdgcn_s_sleep(1); \
    if ((++_sp & 255u) == 0u) { if (xb_ld(&(bar)[XB_TMO])) break; if (_sp > XB_SPIN_CAP) { atomicAdd(&(bar)[XB_TMO], 1u); break; } } } } while (0)

struct XcdBarrier {
    unsigned* bar; unsigned x;
    volatile LAS unsigned* st;
    unsigned total;
};

__device__ __forceinline__ XcdBarrier xcd_barrier_post(unsigned* bar, volatile LAS unsigned* st) {
    XcdBarrier b; b.bar = bar; b.x = xb_xcc_id(); b.st = st; b.total = gridDim.x * gridDim.y * gridDim.z;
    if (threadIdx.x == 0) (void)xb_add(&bar[XB_XCNT(b.x)], 1u);
    return b;
}
__device__ __forceinline__ void xcd_barrier_complete(unsigned* bar, unsigned x, unsigned G, unsigned& nloc, unsigned& nx) {
    unsigned sum, cnt, mine, sp = 0u;
    for (;;) {
        sum = 0u; cnt = 0u; mine = 0u;
#pragma unroll
        for (unsigned j = 0; j < 16; ++j) { const unsigned c = xb_ld(&bar[XB_XCNT(j)]); sum += c; cnt += (c > 0u) ? 1u : 0u; mine = (j == x) ? c : mine; }
        if (sum == G) break;
        __builtin_amdgcn_s_sleep(1);
        if ((++sp & 255u) == 0u) { if (xb_ld(&bar[XB_TMO])) break; if (sp > XB_SPIN_CAP) { atomicAdd(&bar[XB_TMO], 1u); break; } }
    }
    nloc = mine > 0u ? mine : 1u; nx = cnt > 0u ? cnt : 1u;
}

__device__ __forceinline__ void xcd_barrier(const XcdBarrier& b) {
    asm volatile("s_waitcnt vmcnt(0)" ::: "memory");
    __syncthreads();
    if (threadIdx.x == 0) {
        unsigned* bar = b.bar;
        __builtin_amdgcn_s_waitcnt(0);
        unsigned nloc = b.st[0], nx = b.st[1];
        if (nloc == 0u) { xcd_barrier_complete(bar, b.x, b.total, nloc, nx); b.st[0] = nloc; b.st[1] = nx; }
        const unsigned old = xb_add(&bar[XB_XSUB(b.x)], 1u);
        const unsigned gen = old / nloc;
        if (old + 1u == (gen + 1u) * nloc) {
            __builtin_amdgcn_fence(__ATOMIC_RELEASE, "agent");
            asm volatile("s_waitcnt vmcnt(0)" ::: "memory");
            if (nx > 1u) {
            const unsigned og = xb_add(&bar[XB_TOP], 1u);
            const unsigned tg = og / nx;
            if (og + 1u == (tg + 1u) * nx) xb_add(&bar[XB_TOPGEN], 1u);
            else XB_SPIN(xb_ld(&bar[XB_TOPGEN]) == tg, bar);
            }
            __builtin_amdgcn_fence(__ATOMIC_ACQUIRE, "agent");
            xb_add(&bar[XB_XGEN(b.x)], 1u);
            asm volatile("s_waitcnt vmcnt(0)" ::: "memory");
        } else {
            XB_SPIN(xb_ld(&bar[XB_XGEN(b.x)]) == gen, bar);
            __builtin_amdgcn_fence(__ATOMIC_ACQUIRE, "agent");
            asm volatile("s_waitcnt vmcnt(0)" ::: "memory");
        }
    }
    __syncthreads();
}
DI void glds16_nt(const void* gsrc, LAS void* ldst) { __builtin_amdgcn_global_load_lds((const unsigned*)gsrc, (LAS unsigned*)ldst, 16, 0, 2); }
DI void attn_phase(unsigned char* ldsg, const bf16* QKV, unsigned char* AO8, const float* sinks, int ng, int gx, int gy, int Gy, int wave_in) {
    int wid = wave_in; asm volatile("" : "+s"(wid));
    const int lane = pg8::pg8_lane(), tid = wid * 64 + lane, r32 = lane & 31, hi = lane >> 5;
    LAS unsigned char* lds = (LAS unsigned char*)ldsg; const lcp L = (lcp)lds;
    LAS float* wsf = (LAS float*)(lds + AT_WS) + wid * 64;
    LAS unsigned char* stg = lds + AT_STG + wid * 4096;
    const lcp vlane = L + AT_V + ((lane >> 4) & 1) * 32 + (lane & 3) * 8 + (4 * hi + ((lane & 15) >> 2)) * 64;
    const lcp klane = L + AT_K + hi * 1024 + r32 * 16;
    for (int uu = gy; uu < 64 * (BATCH / ng); uu += Gy) { const int b = gx + ng * (uu >> 6), ul = uu & 63;
        const int kvh = ul & 3, nb = ul >> 2;
        const long rowq = (long)b * SEQ + nb * 128, rowk = rowq - 128;
        const int slot_lo = (nb == 0) ? 2 : 0;
        for (int sl = slot_lo; sl < 4; ++sl) {
            glds16(QKV + (rowk + 64 * sl + lane) * NQKV + 2048 + 64 * kvh + 8 * wid, lds + AT_K + sl * 8192 + wid * 1024);
            glds16(QKV + (rowk + 64 * sl + 16 * (wid & 3) + (lane >> 2)) * NQKV + 2304 + 64 * kvh + (wid >> 2) * 32 + (lane & 3) * 8, lds + AT_V + sl * 8192 + wid * 1024);
        }
        const int hq = 8 * kvh + wid;
        const bf16* qsrc = QKV + (rowq + r32) * NQKV + 64 * hq + 8 * hi;
        bf16x8 qn[4];
#pragma unroll
        for (int d0 = 0; d0 < 4; ++d0) qn[d0] = *(const bf16x8*)(qsrc + 16 * d0);
        const float slope2 = ex2(-0.25f * (float)(hq + 1)) * LOG2E, sink2 = sinks[hq] * LOG2E;
        const float base_l = -slope2 * (float)(r32 - 4 * hi);
        WG_BAR();
#pragma unroll 1
        for (int j = 0; j < 4; ++j) {
            const int ilo = (nb == 0) ? 4 - j : 0;
            bf16x8 qr[4];
#pragma unroll
            for (int d0 = 0; d0 < 4; ++d0) qr[d0] = qn[d0];
            if (j < 3) {
#pragma unroll
                for (int d0 = 0; d0 < 4; ++d0) qn[d0] = *(const bf16x8*)(qsrc + (size_t)(32 * (j + 1)) * NQKV + 16 * d0);
            }
            float sl2 = slope2, bl = base_l; asm volatile("" : "+v"(sl2), "+v"(bl));
            f32x16 p[5];
#pragma unroll
            for (int i = 0; i < 5; ++i) {
                if (i >= ilo) {
                    const int kt = j + i; const lcp kb = klane + (kt >> 1) * 8192 + (kt & 1) * 512;
                    f32x16 a = zero16();
#pragma unroll
                    for (int d0 = 0; d0 < 4; ++d0) a = MFMA32(ldfrag(kb + d0 * 2048), qr[d0], a);
#pragma unroll
                    for (int r = 0; r < 16; ++r) {
                        const int cr = (r & 3) + 8 * (r >> 2);
                        float s = fmaf(sl2, (float)(cr - 128 + 32 * i), fmaf(a[r], LOG2E, bl));
                        if (i == 0) { if (!(cr + 4 * hi > r32)) s = -INFINITY; }
                        if (i == 4) { if (!(cr + 4 * hi <= r32)) s = -INFINITY; }
                        a[r] = s;
                    }
                    p[i] = a;
                } else {
#pragma unroll
                    for (int r = 0; r < 16; ++r) p[i][r] = -INFINITY;
                }
            }
            float mx = sink2;
#pragma unroll
            for (int i = 0; i < 5; ++i)
#pragma unroll
                for (int r = 0; r < 16; ++r) mx = fmaxf(mx, p[i][r]);
            mx = half_swap_max(mx);
            float ls = 0.f;
#pragma unroll
            for (int i = 0; i < 5; ++i)
#pragma unroll
                for (int r = 0; r < 16; ++r) { const float e = ex2(p[i][r] - mx); p[i][r] = e; ls += e; }
            ls = half_swap_add(ls) + ex2(sink2 - mx);
            f32x16 o0 = zero16(), o1 = zero16();
#pragma unroll
            for (int i = 0; i < 5; ++i) {
                if (i >= ilo) {
                    const int kt = j + i; const lcp vb = vlane + (kt >> 1) * 8192 + (kt & 1) * 2048;
                    const bf16x8 pa = PACK8(p[i], 0), pb = PACK8(p[i], 1);
                    o0 = MFMA32(pa, trfrag(vb), o0);        o0 = MFMA32(pb, trfrag(vb + 1024), o0);
                    o1 = MFMA32(pa, trfrag(vb + 4096), o1); o1 = MFMA32(pb, trfrag(vb + 4096 + 1024), o1);
                }
            }
            if (hi == 0) wsf[r32] = __builtin_amdgcn_rcpf(ls);
#pragma unroll
            for (int r = 0; r < 16; ++r) {
                const int orow = crow(r, hi); const float rl = wsf[orow] * pg8::F8_SO;
                int pk; asm volatile("" : "=v"(pk)); pk = __builtin_amdgcn_cvt_pk_fp8_f32(o0[r] * rl, o1[r] * rl, pk, false);
                stg[orow * 64 + r32] = (unsigned char)(pk & 0xff);
                stg[orow * 64 + 32 + r32] = (unsigned char)((pk >> 8) & 0xff);
            }
#pragma unroll
            for (int i4 = 0; i4 < 2; ++i4) {
                const int row = i4 * 16 + (lane >> 2), ch = lane & 3;
                const v4u v = *(const LAS v4u*)(stg + row * 64 + ch * 16);
                *(v4u*)(AO8 + (rowq + 32 * j + row) * D + 64 * hq + ch * 16) = v;
            }
        }
        WG_BAR();
    }
}

constexpr int ML_GSET = ML_STG + 4 * 4096 - ML_G2;
static_assert(ML_G2 + ML_GSET + (ML_WS - ML_G2) <= MISC_OFF, "LDS map: second gate-array set");
#define DPPF(old, src, ctrl, rmask, bc) __uint_as_float((unsigned)__builtin_amdgcn_update_dpp((int)__float_as_uint(old), (int)__float_as_uint(src), (ctrl), (rmask), 0xf, (bc)))
DI float scan_add64(float v) {
    v += DPPF(0.f, v, 0x111, 0xf, true); v += DPPF(0.f, v, 0x112, 0xf, true); v += DPPF(0.f, v, 0x114, 0xf, true); v += DPPF(0.f, v, 0x118, 0xf, true);
    v += DPPF(0.f, v, 0x142, 0xa, false); v += DPPF(0.f, v, 0x143, 0xc, false); return v;
}
DI float scan_max64(float v) {
    const float ninf = -INFINITY;
    v = fmaxf(v, DPPF(ninf, v, 0x111, 0xf, false)); v = fmaxf(v, DPPF(ninf, v, 0x112, 0xf, false)); v = fmaxf(v, DPPF(ninf, v, 0x114, 0xf, false)); v = fmaxf(v, DPPF(ninf, v, 0x118, 0xf, false));
    v = fmaxf(v, DPPF(ninf, v, 0x142, 0xa, false)); v = fmaxf(v, DPPF(ninf, v, 0x143, 0xc, false)); return v;
}
DI float ml_gate_scan(LAS unsigned char* lds, int gofs, const float* GT, long row0, int h, int lane, float m_prev) {
    LAS float* G2 = (LAS float*)(lds + ML_G2 + gofs); LAS float* M2 = (LAS float*)(lds + ML_M2 + gofs); LAS float* FI = (LAS float*)(lds + ML_FI + gofs); LAS float* EI = (LAS float*)(lds + ML_EI + gofs);
    LAS float* WK = (LAS float*)(lds + ML_WK + gofs); LAS bf16* WKB = (LAS bf16*)(lds + ML_WKB + gofs); LAS float* SC = (LAS float*)(lds + ML_SC + gofs);
    const float* gp = GT + (size_t)(row0 + 2 * lane) * 8;
    const float i0 = gp[h], f0 = gp[4 + h], i1 = gp[8 + h], f1 = gp[12 + h];
    const float lf0 = -0.6931471805599453f * __builtin_amdgcn_logf(1.f + ex2(-LOG2E * f0)), lf1 = -0.6931471805599453f * __builtin_amdgcn_logf(1.f + ex2(-LOG2E * f1));
    const float incl = scan_add64(lf0 + lf1);
    const float b1 = incl, b0 = incl - lf1;
    const float g0 = i0 - b0, g1 = i1 - b1;
    const float cm = scan_max64(fmaxf(g0, g1));
    const float cprev = DPPF(-INFINITY, cm, 0x138, 0xf, false);
    const float M0 = fmaxf(m_prev, fmaxf(cprev, g0)), M1 = fmaxf(m_prev, cm);
    const float Mend = __uint_as_float((unsigned)__builtin_amdgcn_readlane((int)__float_as_uint(M1), 63)), blast = __uint_as_float((unsigned)__builtin_amdgcn_readlane((int)__float_as_uint(b1), 63));
    *(LAS f32x2*)(G2 + 2 * lane) = (f32x2){g0 * LOG2E, g1 * LOG2E};
    *(LAS f32x2*)(M2 + 2 * lane) = (f32x2){M0 * LOG2E, M1 * LOG2E};
    *(LAS f32x2*)(FI + 2 * lane) = (f32x2){ex2((m_prev - M0) * LOG2E), ex2((m_prev - M1) * LOG2E)};
    *(LAS f32x2*)(EI + 2 * lane) = (f32x2){ex2(-(b0 + M0) * LOG2E), ex2(-(b1 + M1) * LOG2E)};
    const float w0 = ex2((g0 - Mend) * LOG2E), w1 = ex2((g1 - Mend) * LOG2E);
    *(LAS f32x2*)(WK + 2 * lane) = (f32x2){w0, w1};
    *(LAS unsigned*)(WKB + 2 * lane) = pk2(w0, w1);
    if (lane == 0) SC[0] = ex2((m_prev - Mend) * LOG2E);
    return blast + Mend;
}
template <int VAR = 0>
DI void mlstm_phase(unsigned char* ldsg, const bf16* MP, const float* GT, bf16* HG, int ng, int gx, int gy, int Gy, int wave_in) {
    int wid = wave_in; asm volatile("" : "+s"(wid));
    const int lane0 = pg8::pg8_lane(), tid = wid * 64 + lane0;
    LAS unsigned char* lds = (LAS unsigned char*)ldsg; const lcp L = (lcp)lds;
    LAS float* wsf = (LAS float*)(lds + ML_WS) + wid * 64;
    for (int uu = gy; uu < 32 * (BATCH / ng); uu += Gy) { const int b = gx + ng * (uu >> 5), ul = uu & 31;
        const int h = ul >> 3, sl = ul & 7;
        const bf16* Qp = MP + 256 * h; const bf16* Kp = MP + 1024 + 256 * h; const bf16* Vp = MP + 2048 + 512 * h + 64 * sl; const bf16* OGp = MP + 4096 + 512 * h + 64 * sl;
        { unsigned z = 0u; asm volatile("" : "+v"(z)); for (int i = tid; i < (32768 + 512) / 16; i += 512) *(LAS v4u*)(lds + ML_C + i * 16) = (v4u){z, z, z, z}; }
        f32x16 T[6];
#pragma unroll
        for (int x = 0; x < 6; ++x) T[x] = zero16();
        float m_prev = 0.f;
        v4u X[16], vreg[2];
        { const long row0 = (long)b * SEQ; const int lane = lane0, r32 = lane & 31, hi = lane >> 5;
          if (wid >= 4) {
#pragma unroll
              for (int i = 0; i < 16; ++i) X[i] = *(const v4u*)(Kp + (row0 + 8 * i + (lane & 7)) * NMI + (8 * (wid - 4) + (lane >> 3)) * 8);
          } else {
#pragma unroll
              for (int ks = 0; ks < 16; ++ks) X[ks] = *(const v4u*)(Qp + (row0 + 32 * wid + r32) * NMI + 16 * ks + 8 * hi);
          }
#pragma unroll
          for (int i = 0; i < 2; ++i) vreg[i] = *(const v4u*)(Vp + (row0 + 64 * i + 16 * (wid & 3) + (lane >> 2)) * NMI + (wid >> 2) * 32 + (lane & 3) * 8);
          if (wid == 4 && !(VAR & 16)) m_prev = ml_gate_scan(lds, 0, GT, row0, h, lane, m_prev);
        }
        WG_BAR();
        for (int c = 0; c < 16; ++c) {
            const long row0 = (long)b * SEQ + 128 * c;
            const int gofs = (c & 1) * ML_GSET;
            const int lane = pg8::pg8_lane(), r32 = lane & 31, hi = lane >> 5;
            const int blk = (lane >> 4) & 1, q4 = (lane & 15) >> 2, p4 = lane & 3;
            const int vlo_ = blk * 32 + p4 * 8 + (4 * hi + q4) * 64;
            const int ktl_ = (2 * blk + (p4 >> 1)) * 2048 + (q4 + 4 * hi) * 16 + (p4 & 1) * 8;
            const int cbl_ = hi * 1024 + r32 * 16, kbl_ = hi * 2048 + r32 * 16;
            const unsigned m0 = (r32 == 0) ? 0xffffffffu : 0u;
            LAS float* G2 = (LAS float*)(lds + ML_G2 + gofs); LAS float* M2 = (LAS float*)(lds + ML_M2 + gofs); LAS float* FI = (LAS float*)(lds + ML_FI + gofs); LAS float* EI = (LAS float*)(lds + ML_EI + gofs);
            LAS float* WK = (LAS float*)(lds + ML_WK + gofs); LAS bf16* WKB = (LAS bf16*)(lds + ML_WKB + gofs); LAS float* SC = (LAS float*)(lds + ML_SC + gofs);
            if (wid >= 4) {
#pragma unroll
                for (int i = 0; i < 16; ++i) *(LAS v4u*)(lds + ML_K + (8 * (wid - 4) + (lane >> 3)) * 2048 + (8 * i + (lane & 7)) * 16) = X[i];
            }
#pragma unroll
            for (int i = 0; i < 2; ++i) { const float w = WK[64 * i + 16 * (wid & 3) + (lane >> 2)]; const v4u v = vreg[i]; v4u o;
                o.x = pk2(bflo(v.x) * w, bfhi(v.x) * w); o.y = pk2(bflo(v.y) * w, bfhi(v.y) * w); o.z = pk2(bflo(v.z) * w, bfhi(v.z) * w); o.w = pk2(bflo(v.w) * w, bfhi(v.w) * w);
                *(LAS v4u*)(lds + ML_V + i * 8192 + wid * 1024 + lane * 16) = v;
                *(LAS v4u*)(lds + ML_VW + i * 8192 + wid * 1024 + lane * 16) = o; }
            asm volatile("s_waitcnt lgkmcnt(0)" ::: "memory"); __builtin_amdgcn_s_barrier(); asm volatile("" ::: "memory");
            const bool more = c + 1 < 16;
            if (more && !(VAR & 32)) {
                const long row1 = row0 + 128;
                if (wid >= 4) {
#pragma unroll
                    for (int i = 0; i < 16; ++i) X[i] = *(const v4u*)(Kp + (row1 + 8 * i + (lane & 7)) * NMI + (8 * (wid - 4) + (lane >> 3)) * 8);
                }
#pragma unroll
                for (int i = 0; i < 2; ++i) vreg[i] = *(const v4u*)(Vp + (row1 + 64 * i + 16 * (wid & 3) + (lane >> 2)) * NMI + (wid >> 2) * 32 + (lane & 3) * 8);
            }
            if (wid < 4) {
                const int tt = wid;
                v4u ogv[4];
#pragma unroll
                for (int i4 = 0; i4 < 4; ++i4) ogv[i4] = *(const v4u*)(OGp + (row0 + 32 * tt + i4 * 8 + (lane >> 3)) * NMI + (lane & 7) * 8);
                T[0] = zero16(); T[1] = zero16(); T[2] = zero16();
                if (!(VAR & 4)) { const lcp cb = L + ML_C + cbl_; const lcp nbp = L + ML_N + 16 * hi;
#pragma unroll
                  for (int ks = 0; ks < 16; ++ks) {
                      const bf16x8 c0 = ldfrag(cb + ks * 2048), c1 = ldfrag(cb + ks * 2048 + 512);
                      const bf16x8 nf = mask_frag(*(const LAS v4u*)(nbp + ks * 32), m0);
                      T[0] = MFMA32(__builtin_bit_cast(bf16x8, X[ks]), c0, T[0]); T[1] = MFMA32(__builtin_bit_cast(bf16x8, X[ks]), c1, T[1]); T[2] = MFMA32(__builtin_bit_cast(bf16x8, X[ks]), nf, T[2]);
                      if ((ks & 3) == 3) __builtin_amdgcn_sched_barrier(0);
                  } }
                { float fi[16];
#pragma unroll
                  for (int r = 0; r < 16; ++r) fi[r] = FI[32 * tt + crow(r, hi)];
#pragma unroll
                  for (int r = 0; r < 16; ++r) { T[0][r] *= fi[r]; T[1][r] *= fi[r]; }
                  if (r32 == 0) {
#pragma unroll
                      for (int r = 0; r < 16; ++r) wsf[crow(r, hi)] = T[2][r] * fi[r];
                  } }
                const float Mt = M2[32 * tt + r32];
                float dsum = 0.f;
                for (int st = 0; st <= ((VAR & 2) ? -1 : tt); ++st) {
                    f32x16 S = zero16();
                    const lcp kb = L + ML_K + kbl_ + st * 512;
#pragma unroll
                    for (int ks = 0; ks < 16; ++ks) S = MFMA32(ldfrag(kb + ks * 4096), __builtin_bit_cast(bf16x8, X[ks]), S);
#pragma unroll
                    for (int r = 0; r < 16; ++r) {
                        const float w = ex2(G2[32 * st + crow(r, hi)] - Mt);
                        float v = S[r] * w;
                        if (st == tt && crow(r, hi) > r32) v = 0.f;
                        S[r] = v; dsum += v;
                    }
                    const bf16x8 pa = PACK8(S, 0), pb = PACK8(S, 1);
                    const lcp vb = L + ML_V + (st >> 1) * 8192 + (st & 1) * 2048 + vlo_;
                    T[0] = MFMA32(pa, trfrag(vb), T[0]);        T[0] = MFMA32(pb, trfrag(vb + 1024), T[0]);
                    T[1] = MFMA32(pa, trfrag(vb + 4096), T[1]); T[1] = MFMA32(pb, trfrag(vb + 4096 + 1024), T[1]);
                }
                if (more && !(VAR & 64)) {
#pragma unroll
                    for (int ks = 0; ks < 16; ++ks) X[ks] = *(const v4u*)(Qp + (row0 + 128 + 32 * wid + r32) * NMI + 16 * ks + 8 * hi);
                }
                dsum = half_swap_add(dsum);
                { const float den = wsf[r32] + dsum; const float dn = fmaxf(fabsf(den), EI[32 * tt + r32]);
                  if (hi == 0) wsf[32 + r32] = __builtin_amdgcn_rcpf(dn); }
                LAS bf16* stg = (LAS bf16*)(lds + ML_STG + tt * 4096);
                if (!(VAR & 8)) {
#pragma unroll
                for (int r = 0; r < 16; ++r) {
                    const int orow = crow(r, hi); const float rd = wsf[32 + orow];
                    stg[orow * 64 + r32] = (bf16)(pk2(T[0][r] * rd, 0.f) & 0xffffu);
                    stg[orow * 64 + 32 + r32] = (bf16)(pk2(T[1][r] * rd, 0.f) & 0xffffu);
                }
#pragma unroll
                for (int i4 = 0; i4 < 4; ++i4) {
                    const int row = i4 * 8 + (lane >> 3), ch = lane & 7;
                    const v4u hv = *(const LAS v4u*)(stg + row * 64 + ch * 8);
                    const v4u og = ogv[i4];
                    v4u o;
                    o.x = pk2(bflo(hv.x) * bflo(og.x), bfhi(hv.x) * bfhi(og.x)); o.y = pk2(bflo(hv.y) * bflo(og.y), bfhi(hv.y) * bfhi(og.y));
                    o.z = pk2(bflo(hv.z) * bflo(og.z), bfhi(hv.z) * bfhi(og.z)); o.w = pk2(bflo(hv.w) * bflo(og.w), bfhi(hv.w) * bfhi(og.w));
                    *(v4u*)(HG + (row0 + 32 * tt + row) * D + 512 * h + 64 * sl + ch * 8) = o;
                }
                }
#pragma unroll
                for (int x = 3; x < 6; ++x) T[x] = zero16();
            } else {
                const float decay = SC[0];
#pragma unroll
                for (int x = 0; x < 6; ++x)
#pragma unroll
                    for (int r = 0; r < 16; ++r) T[x][r] *= decay;
#pragma unroll
                for (int dti = 0; dti < ((VAR & 1) ? 0 : 2); ++dti) {
                    const int dt = 2 * (wid - 4) + dti;
                    const lcp ka0 = L + ML_K + dt * 8192 + ktl_;
#pragma unroll
                    for (int s8 = 0; s8 < 8; ++s8) {
                        const lcp ka = ka0 + s8 * 256;
                        const bf16x8 af = cat8(vtr(ka), vtr(ka + 128));
                        const lcp vwb = L + ML_VW + (s8 >> 2) * 8192 + (s8 & 3) * 1024 + vlo_;
                        const bf16x8 b0 = trfrag(vwb), b1 = trfrag(vwb + 4096);
                        const v2u wlo = *(const LAS v2u*)(WKB + 16 * s8 + 4 * hi), whi = *(const LAS v2u*)(WKB + 16 * s8 + 4 * hi + 8); const bf16x8 nb = mask_frag((v4u){wlo.x, wlo.y, whi.x, whi.y}, m0);
                        T[2 * dti] = MFMA32(af, b0, T[2 * dti]); T[2 * dti + 1] = MFMA32(af, b1, T[2 * dti + 1]); T[4 + dti] = MFMA32(af, nb, T[4 + dti]);
                        if (s8 & 1) __builtin_amdgcn_sched_barrier(0);
                    }
                }
                if (more && wid == 4 && !(VAR & 16)) m_prev = ml_gate_scan(lds, ML_GSET - gofs, GT, row0 + 128, h, lane, m_prev);
            }
            asm volatile("s_waitcnt lgkmcnt(0)" ::: "memory"); __builtin_amdgcn_s_barrier(); asm volatile("" ::: "memory");
            if (wid >= 4) {
#pragma unroll
                for (int dti = 0; dti < 2; ++dti) {
                    const int dt = 2 * (wid - 4) + dti;
#pragma unroll
                    for (int et = 0; et < 2; ++et)
#pragma unroll
                        for (int g = 0; g < 4; ++g)
                            *(LAS v2u*)(lds + ML_C + (4 * dt + g) * 1024 + (32 * et + r32) * 16 + hi * 8) = (v2u){pk2(T[2 * dti + et][4 * g], T[2 * dti + et][4 * g + 1]), pk2(T[2 * dti + et][4 * g + 2], T[2 * dti + et][4 * g + 3])};
                    if (r32 == 0) {
#pragma unroll
                        for (int g = 0; g < 4; ++g)
                            *(LAS v2u*)(lds + ML_N + (32 * dt + 8 * g + 4 * hi) * 2) = (v2u){pk2(T[4 + dti][4 * g], T[4 + dti][4 * g + 1]), pk2(T[4 + dti][4 * g + 2], T[4 + dti][4 * g + 3])};
                    }
                }
            }
        }
        WG_BAR();
    }
}


constexpr int NWAVES = 8;

template <bool F8> DI void tr_strip(const float* W, int ldw, int n0, void* WTv, size_t wt_row0, int Kdim, int kb0, int nkb, const float* g, const float* bb, float cs, float* c1o, float* c2o, LAS float* scr, int lane) {
    bf16* WT = (bf16*)WTv; unsigned char* WT8 = (unsigned char*)WTv;
    const int c = lane & 7;
    float a1[4] = {0.f, 0.f, 0.f, 0.f}, a2[4] = {0.f, 0.f, 0.f, 0.f};
    for (int kb = kb0; kb < kb0 + nkb; ++kb) {
        const int k0 = kb * 64;
#pragma unroll 8
        for (int i = 0; i < 32; ++i) { const int kk = 2 * i + (lane >> 5); scr[kk * 33 + (lane & 31)] = __builtin_nontemporal_load(W + (size_t)(k0 + kk) * ldw + n0 + (lane & 31)); }
        float gk[8], bk[8];
        if (g) { const f32x4 g0 = *(const f32x4*)(g + k0 + 8 * c), g1 = *(const f32x4*)(g + k0 + 8 * c + 4), b0 = *(const f32x4*)(bb + k0 + 8 * c), b1 = *(const f32x4*)(bb + k0 + 8 * c + 4);
#pragma unroll
            for (int i = 0; i < 4; ++i) { gk[i] = g0[i] * cs; gk[4 + i] = g1[i] * cs; bk[i] = b0[i] * cs; bk[4 + i] = b1[i] * cs; } }
        else {
#pragma unroll
            for (int i = 0; i < 8; ++i) { gk[i] = cs; bk[i] = 0.f; } }
        LDS_WAIT(); asm volatile("" ::: "memory");
#pragma unroll
        for (int j = 0; j < 4; ++j) { const int n = (lane >> 3) + 8 * j; const LAS float* s = scr + (8 * c) * 33 + n;
            float v[8];
#pragma unroll
            for (int i = 0; i < 8; ++i) v[i] = s[i * 33];
            a2[j] += ((v[0] * bk[0] + v[1] * bk[1]) + (v[2] * bk[2] + v[3] * bk[3])) + ((v[4] * bk[4] + v[5] * bk[5]) + (v[6] * bk[6] + v[7] * bk[7]));
            if constexpr (F8) {
                float wv[8];
#pragma unroll
                for (int i = 0; i < 8; ++i) wv[i] = v[i] * gk[i];
                const v2u o = pg8::cvt8_f8(wv, pg8::F8_SW);
                a1[j] += ((__builtin_amdgcn_cvt_f32_fp8((int)o.x, 0) + __builtin_amdgcn_cvt_f32_fp8((int)o.x, 1)) + (__builtin_amdgcn_cvt_f32_fp8((int)o.x, 2) + __builtin_amdgcn_cvt_f32_fp8((int)o.x, 3)))
                       + ((__builtin_amdgcn_cvt_f32_fp8((int)o.y, 0) + __builtin_amdgcn_cvt_f32_fp8((int)o.y, 1)) + (__builtin_amdgcn_cvt_f32_fp8((int)o.y, 2) + __builtin_amdgcn_cvt_f32_fp8((int)o.y, 3)));
                *(GAS v2u*)(WT8 + (wt_row0 + n) * Kdim + k0 + 8 * c) = o;
            } else {
                v4u o; o.x = pk2(v[0] * gk[0], v[1] * gk[1]); o.y = pk2(v[2] * gk[2], v[3] * gk[3]); o.z = pk2(v[4] * gk[4], v[5] * gk[5]); o.w = pk2(v[6] * gk[6], v[7] * gk[7]);
                a1[j] += ((bflo(o.x) + bfhi(o.x)) + (bflo(o.y) + bfhi(o.y))) + ((bflo(o.z) + bfhi(o.z)) + (bflo(o.w) + bfhi(o.w)));
                *(GAS v4u*)(WT + (wt_row0 + n) * Kdim + k0 + 8 * c) = o;
            } }
        LDS_WAIT(); asm volatile("" ::: "memory");
    }
    if (g) {
#pragma unroll
        for (int j = 0; j < 4; ++j) { float s1 = a1[j], s2 = a2[j];
            s1 += SWZ_XOR(s1, 1); s2 += SWZ_XOR(s2, 1); s1 += SWZ_XOR(s1, 2); s2 += SWZ_XOR(s2, 2); s1 += SWZ_XOR(s1, 4); s2 += SWZ_XOR(s2, 4);
            if (c == 0) { c1o[(lane >> 3) + 8 * j] = F8 ? s1 * (1.f / pg8::F8_SW) : s1; c2o[(lane >> 3) + 8 * j] = s2; } }
    }
}

DI void prologue(kargs_t a, LAS unsigned char* lds, int gw, int NGW, int wave, int lane) {
    unsigned char* ws = a->ws;
    float* vec = (float*)(ws + WS_VEC);
    const float* ones = (const float*)(ws + WS_VEC + V_ONES); const float* zeros = (const float*)(ws + WS_VEC + V_ZEROS);
    LAS float* scr = (LAS float*)(lds + wave * 16384);
    constexpr int T_UP = 8 * 2 * 176, T_QKV = 2 * 80, T_MI = 2 * 192, T_W2 = 8 * 64 * 4, T_WO = 2 * 64, T_WMO = 2 * 64, T_G = 16;
    constexpr int NT = T_UP + T_QKV + T_MI + T_W2 + T_WO + T_WMO + T_G;
#ifndef PROBE_PERM
#define PROBE_PERM 0
#endif
    for (int it = (PROBE_PERM && NGW == 2048) ? (gw & 7) * 256 + (gw >> 3) : gw; it < NT; it += NGW) {
        int r = it;
        if (r < T_UP) {
            const int f = r / 352, rr = r % 352, which = rr / 176, strip = rr % 176, n0 = 32 * strip;
            const int t = 3 * (f >> 1) + 2 * (f & 1);
            const float* gp = t ? a->ln_g + (size_t)(t - 1) * D : nullptr; const float* bp = t ? a->ln_b + (size_t)(t - 1) * D : nullptr;
            const size_t wrow = (size_t)256 * (n0 / 128) + 128 * which + (n0 % 128);
            const float* W = (which ? a->w3 : a->w1) + (size_t)f * D * FF;
            if (gp) tr_strip<true>(W, FF, n0, ws + WS_W13 + (size_t)f * NUP * D, wrow, D, 0, 32, gp, bp, 1.f, vec + V_C1U / 4 + (size_t)f * NUP + wrow, vec + V_C2U / 4 + (size_t)f * NUP + wrow, scr, lane);
            else { tr_strip<true>(W, FF, n0, ws + WS_W13 + (size_t)f * NUP * D, wrow, D, 0, 32, nullptr, nullptr, 1.f, nullptr, nullptr, scr, lane);
                   if (lane < 32) { vec[V_C1U / 4 + (size_t)f * NUP + wrow + lane] = 0.f; vec[V_C2U / 4 + (size_t)f * NUP + wrow + lane] = 0.f; } }
            continue; }
        r -= T_UP;
        if (r < T_QKV) { const int j = r / 80, n0 = 32 * (r % 80); const int t = 6 * j + 1;
            tr_strip<true>(a->wqkv + (size_t)j * D * NQKV, NQKV, n0, ws + WS_WQKV + (size_t)j * NQKV * D, n0, D, 0, 32, a->ln_g + (size_t)(t - 1) * D, a->ln_b + (size_t)(t - 1) * D, n0 < 2048 ? 0.125f : 1.f,
                     vec + V_C1Q / 4 + j * NQKV + n0, vec + V_C2Q / 4 + j * NQKV + n0, scr, lane);
            continue; }
        r -= T_QKV;
        if (r < T_MI) { const int j = r / 192, n0 = 32 * (r % 192); const int t = 6 * j + 4;
            if (!OG_F8 || n0 < 4096) tr_strip<false>(a->win + (size_t)j * D * NMIW, NMIW, n0, (bf16*)(ws + WS_WIN) + (size_t)j * NMI * D, n0, D, 0, 32, a->ln_g + (size_t)(t - 1) * D, a->ln_b + (size_t)(t - 1) * D, (n0 >= 1024 && n0 < 2048) ? 0.0625f : 1.f,
                     vec + V_C1I / 4 + j * NMI + n0, vec + V_C2I / 4 + j * NMI + n0, scr, lane);
            else tr_strip<true>(a->win + (size_t)j * D * NMIW, NMIW, n0, ws + WS_WIN + ((size_t)j * NMI + 4096) * D * 2, n0 - 4096, D, 0, 32, a->ln_g + (size_t)(t - 1) * D, a->ln_b + (size_t)(t - 1) * D, 1.f,
                     vec + V_C1I / 4 + j * NMI + n0, vec + V_C2I / 4 + j * NMI + n0, scr, lane);
            continue; }
        r -= T_MI;
        if (r < T_W2) { const int f = r / 256, rr = r % 256, strip = rr / 4, kq = rr % 4;
            tr_strip<true>(a->w2 + (size_t)f * FF * D, D, 32 * strip, ws + WS_W2 + (size_t)f * D * FF, 32 * strip, FF, 22 * kq, 22, nullptr, nullptr, 1.f, nullptr, nullptr, scr, lane);
            continue; }
        r -= T_W2;
        if (r < T_WO) { const int j = r / 64, strip = r % 64;
            tr_strip<true>(a->wo + (size_t)j * D * D, D, 32 * strip, ws + WS_WO + (size_t)j * D * D, 32 * strip, D, 0, 32, nullptr, nullptr, 1.f, nullptr, nullptr, scr, lane);
            continue; }
        r -= T_WO;
        if (r < T_WMO) { const int j = r / 64, strip = r % 64;
            tr_strip<false>(a->wmo + (size_t)j * D * D, D, 32 * strip, (bf16*)(ws + WS_WMO) + (size_t)j * D * D, 32 * strip, D, 0, 32, nullptr, nullptr, 1.f, nullptr, nullptr, scr, lane);
            continue; }
        r -= T_WMO;
        {
            const int j = r / 8, jj = r % 8; const int t = 6 * j + 4;
            const float* gp = a->ln_g + (size_t)(t - 1) * D; const float* bp = a->ln_b + (size_t)(t - 1) * D;
            const float* W = a->win + (size_t)j * D * NMIW + NMI + jj;
            bf16* wg16 = (bf16*)(vec + V_WG / 4) + (size_t)(j * 8 + jj) * D;
            float s1 = 0.f, s2 = 0.f;
            for (int k = lane; k < D; k += 64) { const float w = W[(size_t)k * NMIW]; const unsigned hv = pk2(w * gp[k], 0.f) & 0xffffu; wg16[k] = (bf16)hv; s1 += bflo(hv); s2 += w * bp[k]; }
            s1 = wave_sum(s1); s2 = wave_sum(s2);
            if (lane == 0) { vec[V_CG / 4 + j * 16 + jj] = s1; vec[V_CG / 4 + j * 16 + 8 + jj] = s2 + a->bg[j * 8 + jj]; }
        }
    }
    bf16* R = (bf16*)(ws + WS_R); float* sp0 = (float*)(ws + WS_SP);
    for (int m = gw; m < M; m += NGW) {
        const GAS f32x4* xr = (const GAS f32x4*)(a->x + (size_t)m * D);
#pragma unroll
        for (int i = 0; i < 4; ++i) { const f32x4 v0 = __builtin_nontemporal_load(xr + (i * 64 + lane) * 2), v1 = __builtin_nontemporal_load(xr + (i * 64 + lane) * 2 + 1);
            *(GAS v4u*)(R + (size_t)m * D + (i * 64 + lane) * 8) = (v4u){pk2(v0[0], v0[1]), pk2(v0[2], v0[3]), pk2(v1[0], v1[1]), pk2(v1[2], v1[3])};
            { const float xv[8] = {v0[0], v0[1], v0[2], v0[3], v1[0], v1[1], v1[2], v1[3]}; *(GAS v2u*)(ws + WS_R8 + (size_t)m * D + (i * 64 + lane) * 8) = pg8::cvt8_f8(xv, pg8::F8_SR); } }
        if (lane < 8) *(f32x2*)(sp0 + (size_t)m * 16 + lane * 2) = (f32x2){0.f, 256.f * (1.f - LN_EPS)};
    }
    for (int i = gw * 64 + lane; i < D; i += NGW * 64) { vec[V_ONES / 4 + i] = 1.f; vec[V_ZEROS / 4 + i] = 0.f; }
    (void)ones; (void)zeros;
}

DI void gates_phase(LAS unsigned char* lds, const bf16* R, const float* sp, const bf16* wg16, const float* cg, float* GT, int ng, int gx, int gy, int Gy, int wave_in) {
    int wave = wave_in; asm volatile("" : "+s"(wave));
    const int lane = pg8::pg8_lane(), tid = wave * 64 + lane, r32 = lane & 31, hi = lane >> 5;
    LAS float* part = (LAS float*)lds;
    const unsigned mk = (r32 < 8) ? 0xffffffffu : 0u; const v4u mkv = {mk, mk, mk, mk};
    for (int uu = gy; uu < (SEQ / 64) * (BATCH / ng); uu += Gy) { const int b = gx + ng * (uu >> 5), pl = uu & 31;
        const long r0 = (long)b * SEQ + (long)pl * 64;
        const bf16* bsrc = wg16 + (size_t)(r32 & 7) * D + 256 * wave + 8 * hi;
        bf16x8 bfr[16];
#pragma unroll
        for (int ks = 0; ks < 16; ++ks) bfr[ks] = __builtin_bit_cast(bf16x8, *(const v4u*)(bsrc + 16 * ks) & mkv);
#pragma unroll
        for (int rt = 0; rt < 2; ++rt) {
            const bf16* asrc = R + (r0 + 32 * rt + r32) * D + 256 * wave + 8 * hi;
            bf16x8 afr[16];
#pragma unroll
            for (int ks = 0; ks < 16; ++ks) afr[ks] = *(const bf16x8*)(asrc + 16 * ks);
            f32x16 acc = zero16();
#pragma unroll
            for (int ks = 0; ks < 16; ++ks) acc = MFMA32(afr[ks], bfr[ks], acc);
            if (r32 < 8) {
#pragma unroll
                for (int r = 0; r < 16; ++r) part[(wave * 64 + 32 * rt + crow(r, hi)) * 8 + r32] = acc[r];
            }
        }
        WG_BAR();
        {
            const int row = tid >> 3, col = tid & 7;
            float s = 0.f;
#pragma unroll
            for (int w = 0; w < 8; ++w) s += part[(w * 64 + row) * 8 + col];
            const f32x4* spr = (const f32x4*)(sp + (size_t)(r0 + row) * 16);
            const f32x4 v0 = spr[0], v1 = spr[1], v2 = spr[2], v3 = spr[3];
            const float ss = ((v0[0] + v0[2]) + (v1[0] + v1[2])) + ((v2[0] + v2[2]) + (v3[0] + v3[2])), qq = ((v0[1] + v0[3]) + (v1[1] + v1[3])) + ((v2[1] + v2[3]) + (v3[1] + v3[3]));
            const float mean = ss * (1.f / D), var = qq * (1.f / D) - mean * mean, rstd = __builtin_amdgcn_rsqf(var + LN_EPS);
            GT[(size_t)(r0 + row) * 8 + col] = rstd * (s - mean * cg[col]) + cg[8 + col];
        }
        WG_BAR();
    }
}

DI void final_ln(const bf16* R, const float* sp, const float* g, const float* b, float* out, int ng, int gx, int gw, int NGW, int lane) {
    for (int bb = gx; bb < BATCH; bb += ng) for (int m = bb * SEQ + gw; m < (bb + 1) * SEQ; m += NGW) {
        float s, q;
        { const f32x4 v = *(const f32x4*)(sp + (size_t)m * 16 + (lane & 3) * 4); s = v[0] + v[2]; q = v[1] + v[3];
          s += SWZ_XOR(s, 1); q += SWZ_XOR(q, 1); s += SWZ_XOR(s, 2); q += SWZ_XOR(q, 2); }
        const float mean = s * (1.f / D), var = q * (1.f / D) - mean * mean, rstd = __builtin_amdgcn_rsqf(var + LN_EPS);
#pragma unroll
        for (int i = 0; i < 4; ++i) {
            const int k = 8 * lane + 512 * i;
            const v4u rv = __builtin_nontemporal_load((const v4u*)(R + (size_t)m * D + k));
            const f32x4 g0 = *(const f32x4*)(g + k), g1 = *(const f32x4*)(g + k + 4), b0 = *(const f32x4*)(b + k), b1 = *(const f32x4*)(b + k + 4);
            f32x4 o0, o1;
            o0[0] = (bflo(rv.x) - mean) * rstd * g0[0] + b0[0]; o0[1] = (bfhi(rv.x) - mean) * rstd * g0[1] + b0[1]; o0[2] = (bflo(rv.y) - mean) * rstd * g0[2] + b0[2]; o0[3] = (bfhi(rv.y) - mean) * rstd * g0[3] + b0[3];
            o1[0] = (bflo(rv.z) - mean) * rstd * g1[0] + b1[0]; o1[1] = (bfhi(rv.z) - mean) * rstd * g1[1] + b1[1]; o1[2] = (bflo(rv.w) - mean) * rstd * g1[2] + b1[2]; o1[3] = (bfhi(rv.w) - mean) * rstd * g1[3] + b1[3];
            __builtin_nontemporal_store(o0, (GAS f32x4*)(out + (size_t)m * D + k)); __builtin_nontemporal_store(o1, (GAS f32x4*)(out + (size_t)m * D + k + 4));
        }
    }
}

#ifndef PROBE_DUP
#define PROBE_DUP 0
#endif
#ifndef UP_STG
#define UP_STG false
#endif
#ifndef PROBE_DRY
#define PROBE_DRY 1
#endif
#ifndef PROBE_MLV
#define PROBE_MLV 0
#endif
#ifndef SKIP_ATT
#define SKIP_ATT 0
#endif
#ifndef SKIP_MLSTM
#define SKIP_MLSTM 0
#endif

#define GRID_BAR1() do { XcdBarrier b_; b_.bar = (unsigned*)(kargs()->ws + WS_CTL) + CW_BAR; b_.x = xb_xcc_id(); b_.st = (volatile LAS unsigned*)(lds + MISC_OFF) + 8; b_.total = gridDim.x; xcd_barrier(b_); } while (0)
#define GRID_BAR() do { GRID_BAR1(); if (PROBE_DUP & 1024) GRID_BAR1(); } while (0)
#define GROUP_BAR1() do { XcdBarrier b_; b_.bar = (unsigned*)(kargs()->ws + WS_CTL) + CW_BAR + (1 + (bid & 7)) * XCD_BAR_WORDS; b_.x = xb_xcc_id(); b_.st = (volatile LAS unsigned*)(lds + MISC_OFF) + 10; b_.total = gridDim.x / 8; xcd_barrier(b_); } while (0)
#define LAYER_BAR() do { if (grouped) { GROUP_BAR1(); if (PROBE_DUP & 1024) GROUP_BAR1(); } else GRID_BAR(); } while (0)

__global__ void __launch_bounds__(NWAVES * 64, 2) fwd_kernel(Args args_by_value) {
    extern __shared__ __attribute__((aligned(16))) unsigned char lds_raw[];
    LAS unsigned char* lds = (LAS unsigned char*)lds_raw;
    const int w0 = __builtin_amdgcn_readfirstlane((int)threadIdx.x >> 6);
    const int G0 = gridDim.x, bid0 = blockIdx.x; const int G = G0, bid = bid0;
    { const int tid0 = threadIdx.x; if (tid0 < 64) ((volatile LAS unsigned*)(lds + MISC_OFF))[tid0] = 0u; }
    __syncthreads();
    (void)xcd_barrier_post((unsigned*)(kargs()->ws + WS_CTL) + CW_BAR, (volatile LAS unsigned*)(lds + MISC_OFF) + 8);
#ifndef FORCE_UNGROUPED
#define FORCE_UNGROUPED 0
#endif
    const bool grouped = (G0 == 256) && !FORCE_UNGROUPED;
    if (grouped) (void)xcd_barrier_post((unsigned*)(kargs()->ws + WS_CTL) + CW_BAR + (1 + (bid0 & 7)) * XCD_BAR_WORDS, (volatile LAS unsigned*)(lds + MISC_OFF) + 10);
    {
        const int vcu = (G % 8 == 0) ? (bid % 8) * (G / 8) + bid / 8 : bid;
        prologue(kargs(), lds, vcu * NWAVES + w0, G * NWAVES, w0, pg8::pg8_lane());
        if (PROBE_DUP & 1) { WG_BAR(); prologue(kargs(), lds, vcu * NWAVES + w0, G * NWAVES, w0, pg8::pg8_lane()); }
        if (PROBE_DUP & 8192) {
            kargs_t ka = kargs(); const int gwv = vcu * NWAVES + w0, lane = pg8::pg8_lane(); f32x4 s = {0.f, 0.f, 0.f, 0.f};
            const f32x4* ps[3] = {(const f32x4*)ka->w1, (const f32x4*)ka->w3, (const f32x4*)ka->w2};
            const size_t n4 = (size_t)8 * D * FF / 4;
            for (int a3 = 0; a3 < 3; ++a3) { const f32x4* p = a3 == 0 ? (const f32x4*)ka->w1 : (a3 == 1 ? (const f32x4*)ka->w3 : (const f32x4*)ka->w2);
                for (size_t i = (size_t)gwv * 256 + lane; i < n4; i += (size_t)G * NWAVES * 256) { s += __builtin_nontemporal_load(p + i) + __builtin_nontemporal_load(p + i + 64) + __builtin_nontemporal_load(p + i + 128) + __builtin_nontemporal_load(p + i + 192); } }
            (void)ps; if (s[0] + s[1] + s[2] + s[3] == 123.456f) ((float*)(ka->ws + WS_GATES))[0] = s[0];
        }
    }
    GRID_BAR();
#ifndef GROUP_STAGGER_TICKS
#define GROUP_STAGGER_TICKS 0
#endif
    if (grouped && (bid0 & 1) && GROUP_STAGGER_TICKS > 0) { const unsigned long long t0 = __builtin_amdgcn_s_memrealtime(); while (__builtin_amdgcn_s_memrealtime() - t0 < (unsigned long long)GROUP_STAGGER_TICKS) __builtin_amdgcn_s_sleep(8); }

    for (int t = 0; t < 3 * DEPTH; ++t) {
        int G = G0, bid = bid0; asm volatile("" : "+s"(G), "+s"(bid));
        const int ng = grouped ? 8 : 1, gx = bid % ng, gy = bid / ng, Gy = G / ng;
        const int layer = t / 3, sub = t % 3;
        const int kind = (sub != 1) ? 0 : ((layer & 1) ? 2 : 1);
        const int j = layer >> 1;
        {
            unsigned char* ws = kargs()->ws;
            float* vec = (float*)(ws + WS_VEC);
            const bf16* R = (const bf16*)(ws + WS_R);
            const float* sp_in = (const float*)(ws + WS_SP) + (size_t)(t & 1) * (SP_BYTES / 4);
            if (kind == 0) {
                const int f = 2 * layer + (sub >> 1);
                pg8::Gemm g{(const bf16*)(ws + WS_R8), (const bf16*)(ws + WS_W13 + (size_t)f * NUP * D), M, NUP, D / 2}; pg8::StaticOrder S; S.init(M, NUP, G, bid);
                pg8::EpiUp E{f, t & 1};
                if (PROBE_DUP & 2048) { S.r1 = 5; pg8::gemm_phase<pg8::EpiUp, pg8::StaticOrder, true, PG8_SP2, true>(lds + RING_OFF, g, S, E, w0); LAYER_BAR(); S.r0 = 5; S.r1 = 1 << 20; }
                if (grouped) { pg8::EpiUpT<true, 0, UP_STG> ET{f, t & 1}; pg8::gemm_phase<pg8::EpiUpT<true, 0, UP_STG>, pg8::StaticOrder, true, PG8_SP2, true>(lds + RING_OFF, g, S, ET, w0); }
                else pg8::gemm_phase<pg8::EpiUp, pg8::StaticOrder, true, PG8_SP2, true>(lds + RING_OFF, g, S, E, w0);
#ifndef PROBE_UPV
#define PROBE_UPV 4
#endif
                if (PROBE_DUP & 4096) { pg8::EpiUpT<true, PROBE_UPV> EP{f, t & 1}; pg8::gemm_phase<pg8::EpiUpT<true, PROBE_UPV>, pg8::StaticOrder, true, PG8_SP2, true>(lds + RING_OFF, g, S, EP, w0); }
                if (PROBE_DUP & 16) pg8::gemm_phase<pg8::EpiUp, pg8::StaticOrder, true, PG8_SP2, true>(lds + RING_OFF, g, S, E, w0);
                if (PROBE_DUP & 128) { pg8::EpiNull EN{(float*)(ws + WS_GATES)}; pg8::gemm_phase<pg8::EpiNull, pg8::StaticOrder, true, PG8_SP2, true>(lds + RING_OFF, g, S, EN, w0); }
            } else {
                if (kind == 2) {
                    pg8::Gemm g{R, (const bf16*)(ws + WS_WIN) + (size_t)j * NMI * D, M, OG_F8 ? 4096 : NMI, D}; pg8::StaticOrder S; S.init(M, OG_F8 ? 4096 : NMI, G, bid);
                    pg8::EpiLnOut E{1, j, t & 1};
                    pg8::gemm_phase<pg8::EpiLnOut, pg8::StaticOrder, true, PG8_SP2>(lds + RING_OFF, g, S, E, w0);
                    if (PROBE_DUP & 32) pg8::gemm_phase<pg8::EpiLnOut, pg8::StaticOrder, true, PG8_SP2>(lds + RING_OFF, g, S, E, w0);
                }
                if (kind == 1 || (kind == 2 && OG_F8)) {
                    const int N = kind == 1 ? NQKV : 2048;
                    pg8::Gemm g{(const bf16*)(ws + WS_R8), (const bf16*)(kind == 1 ? ws + WS_WQKV + (size_t)j * NQKV * D : ws + WS_WIN + ((size_t)j * NMI + 4096) * D * 2), M, N, D / 2}; pg8::StaticOrder S; S.init(M, N, G, bid);
                    pg8::EpiLnOut E{kind == 1 ? 0 : 2, j, t & 1};
                    pg8::gemm_phase<pg8::EpiLnOut, pg8::StaticOrder, true, PG8_SP2, true>(lds + RING_OFF, g, S, E, w0);
                    if (PROBE_DUP & 32) pg8::gemm_phase<pg8::EpiLnOut, pg8::StaticOrder, true, PG8_SP2, true>(lds + RING_OFF, g, S, E, w0);
                }
                if (kind == 2) {
                    gates_phase(lds, R, sp_in, (const bf16*)(vec + V_WG / 4) + (size_t)j * 8 * D, vec + V_CG / 4 + j * 16, (float*)(ws + WS_GATES), ng, gx, gy, Gy, w0);
                    if (PROBE_DUP & 8) { WG_BAR(); gates_phase(lds, R, sp_in, (const bf16*)(vec + V_WG / 4) + (size_t)j * 8 * D, vec + V_CG / 4 + j * 16, (float*)(ws + WS_GATES), ng, gx, gy, Gy, w0); }
                }
            }
        }
        LAYER_BAR();
        if (kind == 1) {
            if (!SKIP_ATT) { kargs_t ka = kargs(); unsigned char* ws = ka->ws; attn_phase(lds_raw, (const bf16*)(ws + WS_QKV), ws + WS_AO, ka->sinks + j * 32, ng, gx, gy, Gy, w0);
                if (PROBE_DUP & 2) attn_phase(lds_raw, (const bf16*)(ws + WS_QKV), ws + WS_AO, ka->sinks + j * 32, ng, gx, gy, Gy, w0); }
            LAYER_BAR();
        } else if (kind == 2) {
            if (!SKIP_MLSTM) { unsigned char* ws = kargs()->ws; mlstm_phase(lds_raw, (const bf16*)(ws + WS_MP), (const float*)(ws + WS_GATES), (bf16*)(ws + WS_HG), ng, gx, gy, Gy, w0);
                if (PROBE_DUP & 4) mlstm_phase<PROBE_MLV>(lds_raw, (const bf16*)(ws + WS_MP), (const float*)(ws + WS_GATES), (bf16*)(ws + WS_H), ng, gx, gy, Gy, w0); }
            LAYER_BAR();
        }
        {
            kargs_t ka = kargs(); unsigned char* ws = ka->ws;
            float coef = kind == 0 ? 0.5f / (pg8::F8_SH * pg8::F8_SW) : (kind == 1 ? 1.f / (pg8::F8_SO * pg8::F8_SW) : 1.f);
            if ((kind == 1 && SKIP_ATT) || (kind == 2 && SKIP_MLSTM)) coef = 0.f;
            pg8::StaticOrder S; S.init(M, D, G, bid);
            pg8::EpiRes E{t, coef, (LAS float*)(lds + TAB_OFF), w0, 0};
            if (kind != 2) {
                const int f = 2 * layer + (sub >> 1);
                pg8::Gemm g{(const bf16*)(ws + (kind == 0 ? WS_H : WS_AO)), (const bf16*)(kind == 0 ? ws + WS_W2 + (size_t)f * D * FF : ws + WS_WO + (size_t)j * D * D), M, D, kind == 0 ? FF / 2 : D / 2};
                if (PROBE_DUP & 64) { pg8::EpiNull EN{(float*)(ws + WS_GATES)}; pg8::gemm_phase<pg8::EpiNull, pg8::StaticOrder, true, PG8_SP2, true>(lds + RING_OFF, g, S, EN, w0); }
                if (PROBE_DUP & 512) { pg8::EpiRes ED{t, coef, (LAS float*)(lds + TAB_OFF), w0, PROBE_DRY}; pg8::gemm_phase<pg8::EpiRes, pg8::StaticOrder, true, PG8_SP2, true>(lds + RING_OFF, g, S, ED, w0); }
                pg8::gemm_phase<pg8::EpiRes, pg8::StaticOrder, true, PG8_SP2, true>(lds + RING_OFF, g, S, E, w0);
            } else {
                pg8::Gemm g{(const bf16*)(ws + WS_HG), (const bf16*)(ws + WS_WMO) + (size_t)j * D * D, M, D, D};
                if (PROBE_DUP & 256) { pg8::EpiNull EN{(float*)(ws + WS_GATES)}; pg8::gemm_phase<pg8::EpiNull, pg8::StaticOrder, true, PG8_SP2, false>(lds + RING_OFF, g, S, EN, w0); }
                pg8::gemm_phase<pg8::EpiRes, pg8::StaticOrder, true, PG8_SP2, false>(lds + RING_OFF, g, S, E, w0);
            }
        }
        LAYER_BAR();
    }
    {
        kargs_t ka = kargs(); unsigned char* ws = ka->ws;
        const int ng = grouped ? 8 : 1, gx = bid % ng, gy = bid / ng, Gy = G / ng;
        final_ln((const bf16*)(ws + WS_R), (const float*)(ws + WS_SP), ka->ln_g + (size_t)(3 * DEPTH - 1) * D, ka->ln_b + (size_t)(3 * DEPTH - 1) * D, ka->out, ng, gx, gy * NWAVES + w0, Gy * NWAVES, pg8::pg8_lane());
    }
}

extern "C" void kernel_launch(void* const* d_in, const int* in_sizes, int n_in, void* d_out, int out_size, void* d_ws, size_t ws_size, hipStream_t stream) {
    static int grid = 0;
    if (grid == 0) {
        if (n_in != 12 || in_sizes[0] != M * D || out_size != M * D || ws_size < WS_END) { fprintf(stderr, "kernel_launch: unexpected shapes / workspace (n_in %d, ws %zu < %zu); nothing launched\n", n_in, ws_size, (size_t)WS_END); grid = -1; return; }
        int dev = 0, cus = 0;
        if (hipGetDevice(&dev) != hipSuccess || hipDeviceGetAttribute(&cus, hipDeviceAttributeMultiprocessorCount, dev) != hipSuccess) { grid = -1; return; }
        if (hipFuncSetAttribute((const void*)fwd_kernel, hipFuncAttributeMaxDynamicSharedMemorySize, LDS_BYTES) != hipSuccess) { fprintf(stderr, "kernel_launch: hipFuncSetAttribute failed\n"); grid = -1; return; }
        int per_cu = 0;
        if (hipOccupancyMaxActiveBlocksPerMultiprocessor(&per_cu, (const void*)fwd_kernel, NWAVES * 64, LDS_BYTES) != hipSuccess || per_cu < 1) { fprintf(stderr, "kernel_launch: occupancy query says %d\n", per_cu); }
        (void)hipGetLastError();
        grid = cus;
#ifdef FORCE_GRID
        grid = FORCE_GRID;
#endif
    }
    if (grid < 0) return;
    (void)hipMemsetAsync((char*)d_ws + WS_CTL, 0, CTL_ZERO_BYTES, stream);
    Args a{};
    a.x = (const float*)d_in[0]; a.w1 = (const float*)d_in[1]; a.w3 = (const float*)d_in[2]; a.w2 = (const float*)d_in[3]; a.ln_g = (const float*)d_in[4]; a.ln_b = (const float*)d_in[5];
    a.wqkv = (const float*)d_in[6]; a.sinks = (const float*)d_in[7]; a.wo = (const float*)d_in[8]; a.win = (const float*)d_in[9]; a.bg = (const float*)d_in[10]; a.wmo = (const float*)d_in[11];
    a.out = (float*)d_out; a.ws = (unsigned char*)d_ws;
    hipLaunchKernelGGL(fwd_kernel, dim3(grid), dim3(NWAVES * 64), LDS_BYTES, stream, a);
}
```

```cpp
#include <hip/hip_runtime.h>
#include <hip/hip_bf16.h>
#include <cstdio>
#include <cstdint>
#include <cmath>

constexpr int BATCH = 8, SEQ = 2048, D = 2048, FF = 5632, DEPTH = 4;
constexpr int M = BATCH * SEQ;
constexpr int NUP = 2 * FF;
constexpr int NQKV = 2560;
constexpr int NMI = 6144, NMIW = 6152;
constexpr float LN_EPS = 1e-5f;
constexpr float ALPHA = 1.681792830507429f;
constexpr float LOG2E = 1.4426950408889634f;

constexpr size_t MiB = 1u << 20;
constexpr size_t WS_CTL = 0, CTL_ZERO_BYTES = 192 * 1024;
constexpr size_t WS_W13 = 2 * MiB;
constexpr size_t WS_W2 = 178 * MiB;
constexpr size_t WS_WQKV = 266 * MiB;
constexpr size_t WS_WO = 286 * MiB;
constexpr size_t WS_WIN = 302 * MiB;
constexpr size_t WS_WMO = 350 * MiB;
constexpr size_t WS_VEC = 366 * MiB;
constexpr size_t V_C1U = 0, V_C2U = 360448, V_C1Q = 720896, V_C2Q = 741376, V_C1I = 761856, V_C2I = 811008, V_CG = 860160, V_WG = 860416, V_ONES = 991488, V_ZEROS = 999680;
constexpr size_t WS_R = 368 * MiB;
constexpr size_t WS_R8 = 432 * MiB;
constexpr size_t WS_SP = 464 * MiB;
constexpr size_t SP_BYTES = (size_t)M * 16 * 4;
constexpr size_t WS_H = 466 * MiB;
constexpr size_t WS_QKV = 554 * MiB;
constexpr size_t WS_AO = 634 * MiB;
constexpr size_t WS_MP = 698 * MiB;
constexpr size_t WS_GATES = 890 * MiB;
constexpr size_t WS_HG = 891 * MiB;
constexpr size_t WS_END = 955 * MiB;
constexpr int CW_TMO = 0, CW_BAR = 4096;

struct Args { const float* x; const float* w1; const float* w3; const float* w2; const float* ln_g; const float* ln_b; const float* wqkv; const float* sinks; const float* wo;
              const float* win; const float* bg; const float* wmo; float* out; unsigned char* ws; };
typedef const __attribute__((address_space(4))) Args* kargs_t;
__device__ __forceinline__ kargs_t kargs() { kargs_t p = (kargs_t)__builtin_amdgcn_kernarg_segment_ptr(); asm volatile("" : "+s"(p)); return p; }

namespace pg8 {
#define PG8_LAS __attribute__((address_space(3)))
typedef unsigned short bf16_t;
typedef short bf16x8 __attribute__((ext_vector_type(8)));
typedef _Float16 f16x8 __attribute__((ext_vector_type(8)));
typedef float f32x4 __attribute__((ext_vector_type(4)));
typedef unsigned u32x4 __attribute__((ext_vector_type(4)));
constexpr int BM = 256, BK = 64, HALF = 128, HTB = HALF * BK * 2  , STAGE_BYTES = 8 * HTB, NXCD = 8, WGM = 8;

__host__ __device__ __forceinline__ int lds_byte(int r, int c) { const int st = (r >> 4) * 2 + (c >> 5), rr = r & 15, cc = c & 31, ob = rr * 64 + cc * 2; return st * 1024 + (ob ^ (((ob >> 9) & 1) << 5)); }
__host__ __device__ __forceinline__ void stage_rc(int b, int& R, int& C) { const int st = b / 1024, sb = b % 1024, swz = sb ^ (((sb >> 9) & 1) << 5); R = (st >> 1) * 16 + swz / 64; C = (st & 1) * 32 + (swz % 64) / 2; }
__host__ __device__ __forceinline__ int perm32(int rho) { const int n = rho >> 4, i = rho & 15; return 8 * (i >> 2) + 4 * n + (i & 3); }

typedef int i32x4 __attribute__((ext_vector_type(4)));
typedef int i32x8 __attribute__((ext_vector_type(8)));
constexpr float F8_SR = 8.f, F8_SW = 1024.f, F8_SH = 16.f, F8_SO = 64.f;
__device__ __forceinline__ i32x8 cat_i8(bf16x8 lo, bf16x8 hi) { const i32x4 a = __builtin_bit_cast(i32x4, lo), b = __builtin_bit_cast(i32x4, hi); return __builtin_shufflevector(a, b, 0, 1, 2, 3, 4, 5, 6, 7); }
__device__ __forceinline__ void mfma_f8_zero(f32x4& c, const i32x8 a, const i32x8 b) { asm volatile("v_mfma_f32_16x16x128_f8f6f4 %0, %1, %2, 0 cbsz:0 blgp:0" : "=&v"(c) : "v"(a), "v"(b)); }
__device__ __forceinline__ void mfma_f8_inplace(f32x4& c, const i32x8 a, const i32x8 b) { asm volatile("v_mfma_f32_16x16x128_f8f6f4 %0, %1, %2, %0 cbsz:0 blgp:0" : "+v"(c) : "v"(a), "v"(b)); }
typedef unsigned u32x2 __attribute__((ext_vector_type(2)));
__device__ __forceinline__ u32x2 cvt8_f8(const float (&v)[8], float s) {
    int a, b; asm volatile("" : "=v"(a), "=v"(b));
    a = __builtin_amdgcn_cvt_pk_fp8_f32(v[0] * s, v[1] * s, a, false); a = __builtin_amdgcn_cvt_pk_fp8_f32(v[2] * s, v[3] * s, a, true);
    b = __builtin_amdgcn_cvt_pk_fp8_f32(v[4] * s, v[5] * s, b, false); b = __builtin_amdgcn_cvt_pk_fp8_f32(v[6] * s, v[7] * s, b, true);
    return (u32x2){(unsigned)a, (unsigned)b};
}
__device__ __forceinline__ u32x2 cvt8_f8_raw(const float (&v)[8]) {
    int a, b; asm volatile("" : "=v"(a), "=v"(b));
    a = __builtin_amdgcn_cvt_pk_fp8_f32(v[0], v[1], a, false); a = __builtin_amdgcn_cvt_pk_fp8_f32(v[2], v[3], a, true);
    b = __builtin_amdgcn_cvt_pk_fp8_f32(v[4], v[5], b, false); b = __builtin_amdgcn_cvt_pk_fp8_f32(v[6], v[7], b, true);
    return (u32x2){(unsigned)a, (unsigned)b};
}
__device__ __forceinline__ int pg8_lane() { int l; asm volatile("v_mbcnt_lo_u32_b32 %0, -1, 0\n\tv_mbcnt_hi_u32_b32 %0, -1, %0" : "=v"(l)); return l; }
struct Unit { int pm, pn, ord; };
struct Gemm { const bf16_t* A; const bf16_t* Bt; int M, N, K; };

struct StaticOrder {
    int nM, nN, nwg, G, c, r0 = 0, r1 = 1 << 20;
    __host__ __device__ void init(int M_, int N_, int G_, int c_) { nM = M_ / BM; nN = N_ / BM; nwg = nM * nN; G = G_; c = c_; }
    __host__ __device__ bool next(int i, Unit& u) const {
        i += r0; if (i >= r1) return false;
        const long L = (long)i * G + c; if (L >= nwg) return false;
        int wgid = (int)L; { const int q = nwg / NXCD, r = nwg % NXCD, xcd = wgid % NXCD, off = wgid / NXCD; wgid = (xcd < r ? xcd * (q + 1) : r * (q + 1) + (xcd - r) * q) + off; }
        const int nig = WGM * nN, gid = wgid / nig, fm = gid * WGM, gsz = (nM - fm) < WGM ? (nM - fm) : WGM;
        u.pm = fm + ((wgid % nig) % gsz); u.pn = (wgid % nig) / gsz; u.ord = i - r0; return true;
    }
    __device__ __forceinline__ void a_ready(const Unit&) const {}
    __device__ __forceinline__ void done(const Unit&) const {}
};

__device__ __forceinline__ unsigned cvt_pk_bf16(float lo, float hi) { typedef float f2 __attribute__((ext_vector_type(2))); typedef _Float16 b2 __attribute__((ext_vector_type(2))); f2 v = {lo, hi}; b2 b = __builtin_convertvector(v, b2); return __builtin_bit_cast(unsigned, b); }
__device__ __forceinline__ float bf_lo(unsigned w) { typedef _Float16 b2 __attribute__((ext_vector_type(2))); return (float)__builtin_bit_cast(b2, w)[0]; }
__device__ __forceinline__ float bf_hi(unsigned w) { typedef _Float16 b2 __attribute__((ext_vector_type(2))); return (float)__builtin_bit_cast(b2, w)[1]; }
__device__ __forceinline__ float fsigmoid(float x) { return __builtin_amdgcn_rcpf(1.f + __builtin_amdgcn_exp2f(-LOG2E * x)); }

__device__ __forceinline__ float sum_fq(float v) {
    auto a = __builtin_amdgcn_permlane16_swap(__float_as_uint(v), __float_as_uint(v), false, false); v = __uint_as_float(a[0]) + __uint_as_float(a[1]);
    auto b = __builtin_amdgcn_permlane32_swap(__float_as_uint(v), __float_as_uint(v), false, false); return __uint_as_float(b[0]) + __uint_as_float(b[1]);
}
constexpr int STAB_OFF = 131072 + 16384;
__device__ __forceinline__ void stats_prep(const float* sp, int pm, int wave) {
    PG8_LAS float* stab = (PG8_LAS float*)(STAB_OFF);
    const int tid = wave * 64 + pg8_lane();
    if (tid < BM) {
        const f32x4* p = (const f32x4*)(sp + (size_t)(pm * BM + tid) * 16);
        const f32x4 v0 = p[0], v1 = p[1], v2 = p[2], v3 = p[3];
        const float s = ((v0[0] + v0[2]) + (v1[0] + v1[2])) + ((v2[0] + v2[2]) + (v3[0] + v3[2])), q = ((v0[1] + v0[3]) + (v1[1] + v1[3])) + ((v2[1] + v2[3]) + (v3[1] + v3[3]));
        const float mean = s * (1.f / D), var = q * (1.f / D) - mean * mean;
        typedef float f32x2v __attribute__((ext_vector_type(2)));
        *(PG8_LAS f32x2v*)(stab + 2 * tid) = (f32x2v){mean, __builtin_amdgcn_rsqf(var + LN_EPS)};
    }
    if (tid == 0) *(PG8_LAS int*)(stab + 2 * BM) = pm;
}
constexpr int CTAB_OFF = STAB_OFF + 2048 + 64, CTAB_UNITS = 11;
template <class Sched> __device__ __forceinline__ void ctab_prep(const Sched& S, const float* c1, const float* c2, int wave, float s_lo, float s_hi) {
    const int tid = wave * 64 + pg8_lane();
    const float sc = (tid & HALF) ? s_hi : s_lo;
    float v[CTAB_UNITS];
#pragma unroll
    for (int i = 0; i < CTAB_UNITS; ++i) { Unit u; const int pn = S.next(i, u) ? u.pn : 0; v[i] = tid < BM ? c1[pn * BM + tid] : c2[pn * BM + tid - BM]; }
    typedef _Float16 h1;
#pragma unroll
    for (int i = 0; i < CTAB_UNITS; ++i) *(PG8_LAS h1*)(CTAB_OFF + i * 1024 + tid * 2) = (h1)(v[i] * sc);
}
__device__ __forceinline__ void ctab_get8(int ord, int which, int lc, float (&o)[8]) {
    typedef _Float16 h8 __attribute__((ext_vector_type(8)));
    const h8 v = *(PG8_LAS const h8*)(CTAB_OFF + ord * 1024 + which * 512 + lc * 2);
#pragma unroll
    for (int i = 0; i < 8; ++i) o[i] = (float)v[i];
}
__device__ __forceinline__ void row_stats(const float* sp, int row0, int fq, float (&mu)[2][4], float (&rs)[2][4]) {
    { PG8_LAS const float* stab = (PG8_LAS const float*)(STAB_OFF); const int pm = row0 / BM;
      if (*(PG8_LAS const int*)(stab + 2 * BM) == pm) {
          typedef float f32x2v __attribute__((ext_vector_type(2)));
#pragma unroll
          for (int ai = 0; ai < 2; ++ai)
#pragma unroll
              for (int m = 0; m < 4; ++m) { const f32x2v v = *(PG8_LAS const f32x2v*)(stab + 2 * ((row0 % BM) + ai * HALF + m * 16)); mu[ai][m] = v[0]; rs[ai][m] = v[1]; }
          return; } }
#pragma unroll
    for (int ai = 0; ai < 2; ++ai)
#pragma unroll
        for (int m = 0; m < 4; ++m) {
            const f32x4 v = *(const f32x4*)(sp + (size_t)(row0 + ai * HALF + m * 16) * 16 + fq * 4);
            float s = v[0] + v[2], q = v[1] + v[3];
            s = sum_fq(s); q = sum_fq(q);
            const float mean = s * (1.f / D), var = q * (1.f / D) - mean * mean;
            mu[ai][m] = mean; rs[ai][m] = __builtin_amdgcn_rsqf(var + LN_EPS);
        }
}

struct EpiNull {
    static constexpr bool PERM = true, AFTER_DRAIN = false; static constexpr int MIN_VM_OPS = 0;
    template <class Sched> __device__ __forceinline__ void prep(const Sched&, const Unit&, int) const {}
    float* sink;
    __device__ __forceinline__ void operator()(const f32x4 (&acc)[2][2][4][2], const Unit& u, int wr, int wc, int, int) const {
        float s = 0.f;
#pragma unroll
        for (int ai = 0; ai < 2; ++ai)
#pragma unroll
            for (int bj = 0; bj < 2; ++bj)
#pragma unroll
                for (int m = 0; m < 4; ++m)
#pragma unroll
                    for (int n = 0; n < 2; ++n) s += acc[ai][bj][m][n][0] + acc[ai][bj][m][n][1] + acc[ai][bj][m][n][2] + acc[ai][bj][m][n][3];
        if (s == 123.456f) sink[u.pm + wr + wc] = s;
    }
};

template <bool TAB, int PRB = 0, bool STG = false> struct EpiUpT {
    static constexpr bool PERM = true, AFTER_DRAIN = false; static constexpr int MIN_VM_OPS = 4;
    static constexpr float CG = -LOG2E, CU = -F8_SH / LOG2E;
    template <class Sched> __device__ __forceinline__ void prep(const Sched& S, const Unit& u, int wave) const { unsigned char* ws = kargs()->ws;
        stats_prep((const float*)(ws + WS_SP) + (size_t)tpar * (SP_BYTES / 4), u.pm, wave);
        ctab_prep(S, (const float*)(ws + WS_VEC + V_C1U) + (size_t)f * NUP, (const float*)(ws + WS_VEC + V_C2U) + (size_t)f * NUP, wave, CG, CU); }
    int f, tpar;
    __device__ __forceinline__ void operator()(const f32x4 (&acc)[2][2][4][2], const Unit& u, int wr, int wc, int, int) const {
        const int lane_ = pg8_lane(), fr = lane_ & 15, fq = lane_ >> 4;
        const int row0 = u.pm * BM + wr * 64 + fr;
        int f = this->f, tpar = this->tpar; asm volatile("" : "+s"(f), "+s"(tpar));
        unsigned char* ws = kargs()->ws; unsigned char* H = ws + ((PRB & 4) ? WS_MP : WS_H);
        float mu[2][4], rs[2][4];
        float k1[2][8], k2[2][8];
        if constexpr (TAB) {
            typedef float f32x2v __attribute__((ext_vector_type(2))); PG8_LAS const float* stab = (PG8_LAS const float*)(STAB_OFF);
#pragma unroll
            for (int ai = 0; ai < 2; ++ai)
#pragma unroll
                for (int m = 0; m < 4; ++m) { const f32x2v v = *(PG8_LAS const f32x2v*)(stab + 2 * ((row0 % BM) + ai * HALF + m * 16)); mu[ai][m] = v[0]; rs[ai][m] = v[1]; }
#pragma unroll
            for (int bj = 0; bj < 2; ++bj) { ctab_get8(u.ord, 0, wc * 32 + 8 * fq + bj * HALF, k1[bj]); ctab_get8(u.ord, 1, wc * 32 + 8 * fq + bj * HALF, k2[bj]); }
        } else {
            const float* c1 = (const float*)(ws + WS_VEC + V_C1U) + (size_t)f * NUP; const float* c2 = (const float*)(ws + WS_VEC + V_C2U) + (size_t)f * NUP; const float* sp = (const float*)(ws + WS_SP) + (size_t)tpar * (SP_BYTES / 4);
            row_stats(sp, row0, fq, mu, rs);
            const int cb = u.pn * BM + wc * 32 + 8 * fq;
            if (u.ord < CTAB_UNITS) {
#pragma unroll
                for (int bj = 0; bj < 2; ++bj) { ctab_get8(u.ord, 0, wc * 32 + 8 * fq + bj * HALF, k1[bj]); ctab_get8(u.ord, 1, wc * 32 + 8 * fq + bj * HALF, k2[bj]); }
            } else {
#pragma unroll
                for (int bj = 0; bj < 2; ++bj)
#pragma unroll
                    for (int i = 0; i < 8; ++i) { k1[bj][i] = c1[cb + bj * HALF + i] * (bj ? CU : CG); k2[bj][i] = c2[cb + bj * HALF + i] * (bj ? CU : CG); }
            }
        }
        unsigned char* hp = H + (size_t)(row0 + (fq & 1) * 16) * FF + u.pn * HALF + wc * 32 + 8 * (fq & 2);
        u32x2 keep = {0u, 0u};
        const unsigned st_w = (unsigned)(131072 + (wr * 64 + fr) * 128 + (((wc * 2 + (fq >> 1)) ^ ((fr >> 1) & 7)) * 16) + 8 * (fq & 1));
        const int st_rr = (wr * 4 + wc) * 16 + (lane_ >> 3), st_ch = lane_ & 7;
        const unsigned st_r = (unsigned)(131072 + st_rr * 128 + ((st_ch ^ ((st_rr >> 1) & 7)) * 16));
        unsigned char* hp_s = H + (size_t)(u.pm * BM + st_rr) * FF + u.pn * HALF + st_ch * 16;
#pragma unroll
        for (int ai = 0; ai < 2; ++ai) {
            if constexpr (STG) { if (ai == 1) { asm volatile("s_waitcnt lgkmcnt(0)" ::: "memory"); __builtin_amdgcn_s_barrier(); asm volatile("" ::: "memory"); } }
#pragma unroll
            for (int m = 0; m < 4; ++m) {
                const float r_ = rs[ai][m], nm = -mu[ai][m] * r_, ra = r_ * (1.f / (F8_SR * F8_SW)), raG = ra * CG, raU = ra * CU;
                typedef float f2 __attribute__((ext_vector_type(2)));
                f2 ga[4], ub[4], sg[4];
#pragma unroll
                for (int n = 0; n < 2; ++n)
#pragma unroll
                    for (int jj = 0; jj < 2; ++jj) {
                        const int c = 4 * n + 2 * jj;
                        const f2 ag = {acc[ai][0][m][n][2 * jj], acc[ai][0][m][n][2 * jj + 1]}, au = {acc[ai][1][m][n][2 * jj], acc[ai][1][m][n][2 * jj + 1]};
                        const f2 k1g = {k1[0][c], k1[0][c + 1]}, k2g = {k2[0][c], k2[0][c + 1]}, k1u = {k1[1][c], k1[1][c + 1]}, k2u = {k2[1][c], k2[1][c + 1]};
                        ga[2 * n + jj] = ag * raG + (k1g * nm + k2g);
                        ub[2 * n + jj] = au * raU + (k1u * nm + k2u);
                    }
#pragma unroll
                for (int i = 0; i < 4; ++i) sg[i] = (PRB & 1) ? ga[i] : (f2){__builtin_amdgcn_exp2f(ga[i][0]), __builtin_amdgcn_exp2f(ga[i][1])};
#pragma unroll
                for (int i = 0; i < 4; ++i) { const f2 t = sg[i] + 1.f; sg[i] = (PRB & 1) ? t : (f2){__builtin_amdgcn_rcpf(t[0]), __builtin_amdgcn_rcpf(t[1])}; }
                float hv[8];
#pragma unroll
                for (int i = 0; i < 4; ++i) { const f2 h2 = ga[i] * sg[i] * ub[i]; hv[2 * i] = h2[0]; hv[2 * i + 1] = h2[1]; }
                const u32x2 xb = cvt8_f8_raw(hv);
                if constexpr (STG) { *(PG8_LAS u32x2*)(st_w + m * 2048) = xb; }
                else if ((m & 1) == 0) keep = xb;
                else {
                    const auto s0 = __builtin_amdgcn_permlane16_swap(keep.x, xb.x, false, false), s1 = __builtin_amdgcn_permlane16_swap(keep.y, xb.y, false, false);
                    if (!(PRB & 2) || ((hv[0] + hv[1]) + (hv[2] + hv[3])) + ((hv[4] + hv[5]) + (hv[6] + hv[7])) == 123.456f) *(u32x4*)(hp + (size_t)(ai * HALF + (m - 1) * 16) * FF) = (u32x4){s0[0], s1[0], s0[1], s1[1]};
                }
            }
            if constexpr (STG) {
                asm volatile("s_waitcnt lgkmcnt(0)" ::: "memory"); __builtin_amdgcn_s_barrier(); asm volatile("" ::: "memory");
                const u32x4 o0 = *(PG8_LAS const u32x4*)(st_r), o1 = *(PG8_LAS const u32x4*)((st_r + 1024) ^ 64u);
                *(u32x4*)(hp_s + (size_t)(ai * HALF) * FF) = o0; *(u32x4*)(hp_s + (size_t)(ai * HALF + 8) * FF) = o1;
            }
        }
    }
};
typedef EpiUpT<false> EpiUp;

struct EpiLnOut {
    static constexpr bool PERM = true, AFTER_DRAIN = false; static constexpr int MIN_VM_OPS = 0 * 16;
    template <class Sched> __device__ __forceinline__ void prep(const Sched&, const Unit& u, int wave) const { stats_prep((const float*)(kargs()->ws + WS_SP) + (size_t)tpar * (SP_BYTES / 4), u.pm, wave); }
    int mode, j, tpar;
    __device__ __forceinline__ void operator()(const f32x4 (&acc)[2][2][4][2], const Unit& u, int wr, int wc, int, int) const {
        const int lane_ = pg8_lane(), fr = lane_ & 15, fq = lane_ >> 4;
        const int row0 = u.pm * BM + wr * 64 + fr;
        int mode = this->mode, j = this->j, tpar = this->tpar; asm volatile("" : "+s"(mode), "+s"(j), "+s"(tpar));
        const bool att = mode == 0; const int coff = mode == 2 ? 4096 : 0;
        unsigned char* ws = kargs()->ws; bf16_t* O = (bf16_t*)(ws + (att ? WS_QKV : WS_MP)) + coff; const int ldo = att ? NQKV : NMI, sig_from = mode == 2 ? 0 : (mode == 1 ? 16 : 1000);
        const float ascale = mode == 1 ? 1.f : 1.f / (F8_SR * F8_SW);
        const float* c1 = (const float*)(ws + WS_VEC + (att ? V_C1Q : V_C1I)) + j * ldo + coff; const float* c2 = (const float*)(ws + WS_VEC + (att ? V_C2Q : V_C2I)) + j * ldo + coff; const float* sp = (const float*)(ws + WS_SP) + (size_t)tpar * (SP_BYTES / 4);
        float mu[2][4], rs[2][4]; row_stats(sp, row0, fq, mu, rs);
        const int cb = u.pn * BM + wc * 32 + 8 * fq;
        const bool sg = u.pn >= sig_from;
        f32x4 k1[2][2], k2[2][2];
#pragma unroll
        for (int bj = 0; bj < 2; ++bj)
#pragma unroll
            for (int n = 0; n < 2; ++n) { k1[bj][n] = *(const f32x4*)(c1 + cb + bj * HALF + 4 * n); k2[bj][n] = *(const f32x4*)(c2 + cb + bj * HALF + 4 * n); }
        bf16_t* op = O + (size_t)row0 * ldo + cb;
#define LNOUT_ROWS(SIG) _Pragma("unroll") for (int ai = 0; ai < 2; ++ai) _Pragma("unroll") for (int m = 0; m < 4; ++m) { \
            const float r_ = rs[ai][m], nm = -mu[ai][m] * r_, ra = r_ * ascale; \
            _Pragma("unroll") for (int bj = 0; bj < 2; ++bj) { \
                typedef float f2 __attribute__((ext_vector_type(2))); float v[8]; \
                _Pragma("unroll") for (int n = 0; n < 2; ++n) _Pragma("unroll") for (int jj = 0; jj < 2; ++jj) { \
                    const f2 a2 = {acc[ai][bj][m][n][2 * jj], acc[ai][bj][m][n][2 * jj + 1]}, c1v = {k1[bj][n][2 * jj], k1[bj][n][2 * jj + 1]}, c2v = {k2[bj][n][2 * jj], k2[bj][n][2 * jj + 1]}; \
                    f2 t = a2 * ra + (c1v * nm + c2v); \
                    if (SIG) { const f2 e = t * (-LOG2E); const f2 d = (f2){__builtin_amdgcn_exp2f(e[0]), __builtin_amdgcn_exp2f(e[1])} + 1.f; t = (f2){__builtin_amdgcn_rcpf(d[0]), __builtin_amdgcn_rcpf(d[1])}; } \
                    v[4 * n + 2 * jj] = t[0]; v[4 * n + 2 * jj + 1] = t[1]; } \
                u32x4 w; w.x = cvt_pk_bf16(v[0], v[1]); w.y = cvt_pk_bf16(v[2], v[3]); w.z = cvt_pk_bf16(v[4], v[5]); w.w = cvt_pk_bf16(v[6], v[7]); \
                *(u32x4*)(op + (size_t)(ai * HALF + m * 16) * ldo + bj * HALF) = w; } }
        const int sgi = __builtin_amdgcn_readfirstlane(sg ? 1 : 0);
        if (sgi) { LNOUT_ROWS(true) } else { LNOUT_ROWS(false) }
#undef LNOUT_ROWS
    }
};

#ifndef OG_F8
#define OG_F8 1
#endif
#define OG_F8_ OG_F8
struct EpiRes {
    static constexpr bool PERM = true, AFTER_DRAIN = false; static constexpr int MIN_VM_OPS = 0 * 32;
    template <class Sched> __device__ __forceinline__ void prep(const Sched&, const Unit& u, int wave) const { stats_prep((const float*)(kargs()->ws + WS_SP) + (size_t)(t & 1) * (SP_BYTES / 4), u.pm, wave); }
    int t; float coef; PG8_LAS float* tab; int wave; int dry;
    __device__ __forceinline__ void operator()(const f32x4 (&acc)[2][2][4][2], const Unit& u, int wr, int wc, int, int) const {
        const int lane_ = pg8_lane(), fr = lane_ & 15, fq = lane_ >> 4;
        typedef float f32x2v __attribute__((ext_vector_type(2)));
        const int row0 = u.pm * BM + wr * 64 + fr;
        int t = this->t; asm volatile("" : "+s"(t)); float coef = this->coef; asm volatile("" : "+v"(coef));
        const bool need8 = (t != 11 && (OG_F8_ || (t != 3 && t != 9))) || dry;
        kargs_t ka = kargs(); unsigned char* ws = ka->ws; bf16_t* R = (bf16_t*)(ws + WS_R); unsigned char* R8 = ws + (dry ? WS_MP + 64 * MiB : WS_R8); bf16_t* Ro = dry ? (bf16_t*)(ws + WS_MP) : R;
        const float* g = t ? ka->ln_g + (size_t)(t - 1) * D : (const float*)(ws + WS_VEC + V_ONES); const float* b = t ? ka->ln_b + (size_t)(t - 1) * D : (const float*)(ws + WS_VEC + V_ZEROS);
        const float* sp_in = (const float*)(ws + WS_SP) + (size_t)(t & 1) * (SP_BYTES / 4); float* sp_out = dry ? (float*)(ws + WS_MP + 96 * MiB) : (float*)(ws + WS_SP) + (size_t)((t + 1) & 1) * (SP_BYTES / 4);
        const int cb0 = u.pn * BM + wc * 32 + 8 * fq;
        u32x4 cur[4];
#pragma unroll
        for (int m = 0; m < 4; ++m) cur[m] = *(const u32x4*)(R + (size_t)(row0 + m * 16) * D + cb0);
        float mu[2][4], rs[2][4]; row_stats(sp_in, row0, fq, mu, rs);
        f32x4 gv[2], bv[2];
#pragma unroll
        for (int k = 0; k < 4; ++k) {
            const int bj = k >> 1, ai = k & 1, cb = cb0 + bj * HALF;
            if (ai == 0) {
#pragma unroll
                for (int n = 0; n < 2; ++n) { gv[n] = *(const f32x4*)(g + cb + 4 * n); bv[n] = *(const f32x4*)(b + cb + 4 * n) * ALPHA; }
            }
#pragma unroll
            for (int m = 0; m < 4; ++m) {
                const float A_ = ALPHA * rs[ai][m], B_ = -mu[ai][m] * A_;
                const size_t off = (size_t)(row0 + ai * HALF + m * 16) * D + cb;
                const u32x4 o = cur[m];
                if (k < 3 && dry != 3) cur[m] = *(const u32x4*)(R + (size_t)(row0 + ((k + 1) & 1) * HALF + m * 16) * D + cb0 + ((k + 1) >> 1) * HALF);
                typedef float fv2 __attribute__((ext_vector_type(2)));
                float nv[8];
#pragma unroll
                for (int n = 0; n < 2; ++n)
#pragma unroll
                    for (int jj = 0; jj < 2; ++jj) {
                        const unsigned w2 = n == 0 ? (jj == 0 ? o.x : o.y) : (jj == 0 ? o.z : o.w); const fv2 r2 = {bf_lo(w2), bf_hi(w2)}, a2 = {acc[ai][bj][m][n][2 * jj], acc[ai][bj][m][n][2 * jj + 1]};
                        const fv2 g2 = {gv[n][2 * jj], gv[n][2 * jj + 1]}, b2 = {bv[n][2 * jj], bv[n][2 * jj + 1]};
                        const fv2 t = (r2 * A_ + B_) * g2 + (a2 * coef + b2);
                        nv[4 * n + 2 * jj] = t[0]; nv[4 * n + 2 * jj + 1] = t[1];
                    }
                u32x4 w; w.x = cvt_pk_bf16(nv[0], nv[1]); w.y = cvt_pk_bf16(nv[2], nv[3]); w.z = cvt_pk_bf16(nv[4], nv[5]); w.w = cvt_pk_bf16(nv[6], nv[7]);
                if (dry != 2) { *(u32x4*)(Ro + off) = w;
                if (need8) *(u32x2*)(R8 + off) = cvt8_f8(nv, F8_SR); }
                const float f0 = bf_lo(w.x), f1 = bf_hi(w.x), f2 = bf_lo(w.y), f3 = bf_hi(w.y), f4 = bf_lo(w.z), f5 = bf_hi(w.z), f6 = bf_lo(w.w), f7 = bf_hi(w.w);
                float s = ((f0 + f1) + (f2 + f3)) + ((f4 + f5) + (f6 + f7));
                float q = ((f0 * f0 + f1 * f1) + (f2 * f2 + f3 * f3)) + ((f4 * f4 + f5 * f5) + (f6 * f6 + f7 * f7));
                s = sum_fq(s); q = sum_fq(q);
                if (fq == 0) *(PG8_LAS f32x2v*)(tab + (((ai * HALF + wr * 64 + m * 16 + fr) * 4 + wc) * 2 + bj) * 2) = (f32x2v){s, q};
                asm volatile("" ::: "memory");
            }
        }
        asm volatile("s_waitcnt lgkmcnt(0)" ::: "memory"); __builtin_amdgcn_s_barrier(); asm volatile("" ::: "memory");
        const int tid = wave * 64 + pg8_lane();
        if (tid < BM) {
            const PG8_LAS f32x4* t4 = (const PG8_LAS f32x4*)(tab + tid * 16);
            const f32x4 a = t4[0], c = t4[1], d = t4[2], e = t4[3];
            *(f32x2v*)(sp_out + (size_t)(u.pm * BM + tid) * 16 + u.pn * 2) = (f32x2v){((a[0] + a[2]) + (c[0] + c[2])) + ((d[0] + d[2]) + (e[0] + e[2])), ((a[1] + a[3]) + (c[1] + c[3])) + ((d[1] + d[3]) + (e[1] + e[3]))};
        }
    }
};

#ifndef PG8_ZF_F8
#define PG8_ZF_F8 1
#endif
#ifndef PG8_ZF_F16
#define PG8_ZF_F16 0
#endif
template <class Epi, class Sched, bool ALIGN_EPI = false, bool SP2 = false, bool F8 = false>
__device__ __forceinline__ void gemm_phase(PG8_LAS unsigned char* lds, const Gemm g, const Sched& S, const Epi& E, int wave_in) {
    int wid = wave_in; asm volatile("" : "+s"(wid));
    const int lane = pg8_lane(), tid = wid * 64 + lane, wr = wid >> 2, wc = wid & 3, fr = lane & 15, fq = lane >> 4;
    const int K = g.K, nt = K / BK;
    unsigned voffA[2], voffB[2];
#pragma unroll
    for (int i = 0; i < 2; ++i) { int R, C; stage_rc(tid * 16 + i * 8192, R, C); const int Rb = Epi::PERM ? ((R & ~31) + perm32(R & 31)) : R;
        voffA[i] = (unsigned)(R * K + C) * 2u; voffB[i] = (unsigned)(Rb * K + C) * 2u; }
    const size_t kstep = (size_t)(BK * 2);
    const size_t hstep = (size_t)HALF * K * 2;
    const size_t tstep = 2 * hstep;
    const unsigned ldsw = (unsigned)wid * 1024u;
    const int aoff = lds_byte(wr * 64 + fr, fq * 8), boff = lds_byte(wc * 32 + fr, fq * 8);
#define PG8_SA(b, h) (((b) * 2 + (h)) * HTB)
#define PG8_SB(b, h) ((4 + (b) * 2 + (h)) * HTB)
#ifndef PG8_DMA_IN_MMA
#define PG8_DMA_IN_MMA 0
#endif
#ifndef PG8_B_AUX
#define PG8_B_AUX 0
#endif
#define PG8_STAGE_AUX(bufoff, gbase, voff, aux) do { _Pragma("unroll") for (int _i = 0; _i < 2; ++_i) \
        __builtin_amdgcn_global_load_lds((const unsigned*)((const char*)(gbase) + (voff)[_i]), (PG8_LAS unsigned*)(lds + (bufoff) + ldsw + _i * 8192), 16, 0, aux); } while (0)
#define PG8_STAGE(bufoff, gbase, voff) PG8_STAGE_AUX(bufoff, gbase, voff, PG8_IS_B(bufoff) ? PG8_B_AUX : 0)
#define PG8_IS_B(bufoff) ((bufoff) >= 4 * HTB)
#define PG8_LDA(dst, b, h) do { _Pragma("unroll") for (int m = 0; m < 4; ++m) _Pragma("unroll") for (int k = 0; k < 2; ++k) dst[m][k] = *(const PG8_LAS bf16x8*)(lds + PG8_SA(b, h) + aoff + m * 2048 + k * 1024); } while (0)
#define PG8_LDB(dst, b, h) do { _Pragma("unroll") for (int n = 0; n < 2; ++n) _Pragma("unroll") for (int k = 0; k < 2; ++k) dst[n][k] = *(const PG8_LAS bf16x8*)(lds + PG8_SB(b, h) + boff + n * 2048 + k * 1024); } while (0)
#define PG8_MMA(ai, bj, At, Bt) do { __builtin_amdgcn_s_setprio(1); _Pragma("unroll") for (int m = 0; m < 4; ++m) _Pragma("unroll") for (int n = 0; n < 2; ++n) { \
        if constexpr (F8) mfma_f8_inplace(acc[ai][bj][m][n], cat_i8(Bt[n][0], Bt[n][1]), cat_i8(At[m][0], At[m][1])); \
        else { _Pragma("unroll") for (int k = 0; k < 2; ++k) acc[ai][bj][m][n] = __builtin_amdgcn_mfma_f32_16x16x32_f16(__builtin_bit_cast(f16x8, Bt[n][k]), __builtin_bit_cast(f16x8, At[m][k]), acc[ai][bj][m][n], 0, 0, 0); } } \
        __builtin_amdgcn_s_setprio(0); } while (0)
#define PG8_MMAZ(ai, bj, At, Bt) do { __builtin_amdgcn_s_setprio(1); _Pragma("unroll") for (int m = 0; m < 4; ++m) _Pragma("unroll") for (int n = 0; n < 2; ++n) { \
        if constexpr (F8) mfma_f8_zero(acc[ai][bj][m][n], cat_i8(Bt[n][0], Bt[n][1]), cat_i8(At[m][0], At[m][1])); \
        else { acc[ai][bj][m][n] = __builtin_amdgcn_mfma_f32_16x16x32_f16(__builtin_bit_cast(f16x8, Bt[n][0]), __builtin_bit_cast(f16x8, At[m][0]), (f32x4){0.f, 0.f, 0.f, 0.f}, 0, 0, 0); \
               acc[ai][bj][m][n] = __builtin_amdgcn_mfma_f32_16x16x32_f16(__builtin_bit_cast(f16x8, Bt[n][1]), __builtin_bit_cast(f16x8, At[m][1]), acc[ai][bj][m][n], 0, 0, 0); } } \
        __builtin_amdgcn_s_setprio(0); } while (0)
#define PG8_WAIT_V(n) asm volatile("s_waitcnt vmcnt(" #n ")" ::: "memory")
#define PG8_WAIT_L(n) asm volatile("s_waitcnt lgkmcnt(" #n ")" ::: "memory")
#define PG8_WAIT_VN(n) asm volatile("s_waitcnt vmcnt(%0)" :: "n"(n) : "memory")
#define PG8_BAR __builtin_amdgcn_s_barrier()
#define PG8_SCHED __builtin_amdgcn_sched_barrier(0)
    constexpr bool ZF = SP2 && (F8 ? PG8_ZF_F8 : PG8_ZF_F16);
    Unit cur, nxt; int ui = 0;
    constexpr int NS = Epi::MIN_VM_OPS;
    if (!S.next(0, cur)) return;
    f32x4 acc[2][2][4][2];
    if constexpr (!ZF)
#pragma unroll
    for (int a = 0; a < 2; ++a)
#pragma unroll
        for (int b = 0; b < 2; ++b)
#pragma unroll
            for (int m = 0; m < 4; ++m)
#pragma unroll
                for (int n = 0; n < 2; ++n) { float z0, z1, z2, z3; asm volatile("v_mov_b32 %0, 0\n\tv_mov_b32 %1, 0\n\tv_mov_b32 %2, 0\n\tv_mov_b32 %3, 0" : "=v"(z0), "=v"(z1), "=v"(z2), "=v"(z3)); acc[a][b][m][n] = (f32x4){z0, z1, z2, z3}; }
    bf16x8 At[4][2], B0[2][2], B1[2][2];
    const char* cA = (const char*)g.A + (size_t)cur.pm * tstep; const char* cB = (const char*)g.Bt + (size_t)cur.pn * tstep;
    S.a_ready(cur);
    if constexpr (SP2) {
        PG8_STAGE(PG8_SB(0, 0), cB, voffB); PG8_STAGE(PG8_SB(0, 1), cB + hstep, voffB); PG8_STAGE(PG8_SA(0, 0), cA, voffA); PG8_STAGE(PG8_SA(0, 1), cA + hstep, voffA);
        E.prep(S, cur, wave_in);
        if (wr == 1) PG8_BAR;
        PG8_WAIT_V(2); PG8_BAR;
        PG8_STAGE(PG8_SB(1, 0), cB + kstep, voffB); PG8_STAGE(PG8_SA(1, 0), cA + kstep, voffA); PG8_STAGE(PG8_SB(1, 1), cB + hstep + kstep, voffB);
        PG8_WAIT_V(6); PG8_BAR;
    } else {
        PG8_STAGE(PG8_SB(0, 0), cB, voffB); PG8_STAGE(PG8_SA(0, 0), cA, voffA); PG8_STAGE(PG8_SB(0, 1), cB + hstep, voffB); PG8_STAGE(PG8_SA(0, 1), cA + hstep, voffA);
        E.prep(S, cur, wave_in);
        if (wr == 1) PG8_BAR;
        PG8_WAIT_V(4); PG8_BAR;
        PG8_STAGE(PG8_SB(1, 0), cB + kstep, voffB); PG8_STAGE(PG8_SA(1, 0), cA + kstep, voffA); PG8_STAGE(PG8_SB(1, 1), cB + hstep + kstep, voffB);
        PG8_WAIT_V(6); PG8_BAR;
    }
    for (;;) {
        const bool has_next = S.next(ui + 1, nxt);
        const char* nA = has_next ? (const char*)g.A + (size_t)nxt.pm * tstep : cA; const char* nB = has_next ? (const char*)g.Bt + (size_t)nxt.pn * tstep : cB;
        for (int t = 0; t < nt; t += 2) {
            const bool last = (t == nt - 2);
            const char* a1 = cA + (size_t)(t + 1) * kstep;
            const char* a2 = last ? nA : cA + (size_t)(t + 2) * kstep; const char* b2 = last ? nB : cB + (size_t)(t + 2) * kstep;
            const char* a3 = a2 + kstep; const char* b3 = b2 + kstep;
            if (last && has_next) S.a_ready(nxt);
            if constexpr (SP2) {
            const bool after_epi = NS > 0 && t == 0 && ui > 0;
            PG8_LDB(B0, 0, 0); PG8_LDB(B1, 0, 1); PG8_SCHED; PG8_LDA(At, 0, 0); PG8_STAGE(PG8_SA(1, 1), a1 + hstep, voffA);
            if (after_epi) PG8_WAIT_VN(8 + NS); else PG8_WAIT_V(8);
            PG8_WAIT_L(0); PG8_BAR; if (ZF && t == 0) { PG8_MMAZ(0, 0, At, B0); PG8_MMAZ(0, 1, At, B1); } else { PG8_MMA(0, 0, At, B0); PG8_MMA(0, 1, At, B1); } PG8_BAR; PG8_SCHED;
#if PG8_DMA_IN_MMA
            PG8_LDA(At, 0, 1); PG8_STAGE(PG8_SB(0, 0), b2, voffB); PG8_STAGE(PG8_SB(0, 1), b2 + hstep, voffB);
            if (after_epi) PG8_WAIT_VN(6 + NS); else PG8_WAIT_V(6);
            PG8_WAIT_L(0); PG8_BAR; PG8_MMA(1, 0, At, B0); PG8_STAGE(PG8_SA(0, 0), a2, voffA); PG8_MMA(1, 1, At, B1); PG8_BAR; PG8_SCHED;
#else
            PG8_LDA(At, 0, 1); PG8_STAGE(PG8_SB(0, 0), b2, voffB); PG8_STAGE(PG8_SB(0, 1), b2 + hstep, voffB); PG8_STAGE(PG8_SA(0, 0), a2, voffA);
            if (after_epi) PG8_WAIT_VN(8 + NS); else PG8_WAIT_V(8);
            PG8_WAIT_L(0); PG8_BAR; if (ZF && t == 0) { PG8_MMAZ(1, 0, At, B0); PG8_MMAZ(1, 1, At, B1); } else { PG8_MMA(1, 0, At, B0); PG8_MMA(1, 1, At, B1); } PG8_BAR; PG8_SCHED;
#endif
            PG8_LDB(B0, 1, 0); PG8_LDB(B1, 1, 1); PG8_SCHED; PG8_LDA(At, 1, 0); PG8_STAGE(PG8_SA(0, 1), a2 + hstep, voffA);
            PG8_WAIT_V(8); PG8_WAIT_L(0); PG8_BAR; PG8_MMA(0, 0, At, B0); PG8_MMA(0, 1, At, B1); PG8_BAR; PG8_SCHED;
#if PG8_DMA_IN_MMA
            PG8_LDA(At, 1, 1); PG8_STAGE(PG8_SB(1, 0), b3, voffB); PG8_STAGE(PG8_SB(1, 1), b3 + hstep, voffB);
            PG8_WAIT_V(6); PG8_WAIT_L(0); PG8_BAR; PG8_MMA(1, 0, At, B0); PG8_STAGE(PG8_SA(1, 0), a3, voffA); PG8_MMA(1, 1, At, B1); PG8_BAR; PG8_SCHED;
#else
            PG8_LDA(At, 1, 1); PG8_STAGE(PG8_SB(1, 0), b3, voffB); PG8_STAGE(PG8_SB(1, 1), b3 + hstep, voffB); PG8_STAGE(PG8_SA(1, 0), a3, voffA);
            PG8_WAIT_V(8); PG8_WAIT_L(0); PG8_BAR; PG8_MMA(1, 0, At, B0); PG8_MMA(1, 1, At, B1); PG8_BAR; PG8_SCHED;
#endif
            } else {
            PG8_LDB(B0, 0, 0); PG8_SCHED; PG8_LDA(At, 0, 0); PG8_STAGE(PG8_SA(1, 1), a1 + hstep, voffA);
            PG8_WAIT_L(8); PG8_BAR; PG8_WAIT_L(0); PG8_MMA(0, 0, At, B0); PG8_BAR; PG8_SCHED;
            PG8_LDB(B1, 0, 1); PG8_STAGE(PG8_SB(0, 0), b2, voffB);
            PG8_BAR; PG8_WAIT_L(0); PG8_MMA(0, 1, At, B1); PG8_BAR;
            PG8_LDA(At, 0, 1); PG8_STAGE(PG8_SA(0, 0), a2, voffA);
            PG8_BAR; PG8_WAIT_L(0); PG8_MMA(1, 0, At, B0); PG8_BAR; PG8_SCHED;
            PG8_STAGE(PG8_SB(0, 1), b2 + hstep, voffB);
            PG8_WAIT_V(6); PG8_BAR; PG8_MMA(1, 1, At, B1); PG8_BAR;
            PG8_LDB(B0, 1, 0); PG8_SCHED; PG8_LDA(At, 1, 0); PG8_STAGE(PG8_SA(0, 1), a2 + hstep, voffA);
            PG8_WAIT_L(8); PG8_BAR; PG8_WAIT_L(0); PG8_MMA(0, 0, At, B0); PG8_BAR; PG8_SCHED;
            PG8_LDB(B1, 1, 1); PG8_STAGE(PG8_SB(1, 0), b3, voffB);
            PG8_BAR; PG8_WAIT_L(0); PG8_MMA(0, 1, At, B1); PG8_BAR;
            PG8_LDA(At, 1, 1); PG8_STAGE(PG8_SA(1, 0), a3, voffA);
            PG8_BAR; PG8_WAIT_L(0); PG8_MMA(1, 0, At, B0); PG8_BAR; PG8_SCHED;
            PG8_STAGE(PG8_SB(1, 1), b3 + hstep, voffB);
            PG8_WAIT_V(6); PG8_BAR; PG8_MMA(1, 1, At, B1); PG8_BAR;
            }
        }
        if constexpr (F8) asm volatile("s_nop 15\n\ts_nop 7" ::: "memory");
        if constexpr (ALIGN_EPI) { if (wr == 0) PG8_BAR; }
        if constexpr (!Epi::AFTER_DRAIN) { E(acc, cur, wr, wc, fr, fq); S.done(cur); }
        if (!has_next) break;
        if constexpr (!ZF)
#pragma unroll
        for (int a = 0; a < 2; ++a)
#pragma unroll
            for (int b = 0; b < 2; ++b)
#pragma unroll
                for (int m = 0; m < 4; ++m)
#pragma unroll
                    for (int n = 0; n < 2; ++n) { float z0, z1, z2, z3; asm volatile("v_mov_b32 %0, 0\n\tv_mov_b32 %1, 0\n\tv_mov_b32 %2, 0\n\tv_mov_b32 %3, 0" : "=v"(z0), "=v"(z1), "=v"(z2), "=v"(z3)); acc[a][b][m][n] = (f32x4){z0, z1, z2, z3}; }
        cur = nxt; cA = nA; cB = nB; ++ui;
        if constexpr (ALIGN_EPI) { if (wr == 1) PG8_BAR; }
    }
    PG8_WAIT_V(0);
    if constexpr (!ALIGN_EPI) { if (wr == 0) PG8_BAR; }
    PG8_BAR;
    if constexpr (Epi::AFTER_DRAIN) { E.fused(acc, cur, wr, wc, fr, fq, lds, wid, lane); S.done(cur); }
#undef PG8_SA
#undef PG8_SB
#undef PG8_STAGE
#undef PG8_STAGE_AUX
#undef PG8_IS_B
#undef PG8_LDA
#undef PG8_LDB
#undef PG8_MMA
#undef PG8_MMAZ
#undef PG8_WAIT_V
#undef PG8_WAIT_L
#undef PG8_WAIT_VN
#undef PG8_BAR
#undef PG8_SCHED
}
}

#ifndef PG8_SP2
#define PG8_SP2 true
#endif

#define GAS __attribute__((address_space(1)))
#define LAS __attribute__((address_space(3)))
typedef unsigned short bf16;
typedef unsigned v4u __attribute__((ext_vector_type(4)));
typedef unsigned v2u __attribute__((ext_vector_type(2)));
typedef float f32x4 __attribute__((ext_vector_type(4)));
typedef float f32x2 __attribute__((ext_vector_type(2)));
typedef float f32x16 __attribute__((ext_vector_type(16)));
typedef short bf16x8 __attribute__((ext_vector_type(8)));
typedef short s16x4 __attribute__((ext_vector_type(4)));
typedef GAS unsigned gu32;
typedef GAS unsigned long long gu64;
typedef LAS const char* lcp;
typedef LAS char* lwp;
#define RLX_AGENT __ATOMIC_RELAXED, __HIP_MEMORY_SCOPE_AGENT
#define LDS_WAIT() asm volatile("s_waitcnt lgkmcnt(0)" ::: "memory")
#define VM_WAIT() asm volatile("s_waitcnt vmcnt(0)" ::: "memory")
#define WG_BAR() do { asm volatile("s_waitcnt vmcnt(0) lgkmcnt(0)" ::: "memory"); __builtin_amdgcn_s_barrier(); asm volatile("" ::: "memory"); } while (0)
#define DI __device__ __forceinline__
#define MFMA32(a, b, c) __builtin_amdgcn_mfma_f32_32x32x16_f16(__builtin_bit_cast(pg8::f16x8, (a)), __builtin_bit_cast(pg8::f16x8, (b)), (c), 0, 0, 0)
DI unsigned pk2(float lo, float hi) { return pg8::cvt_pk_bf16(lo, hi); }
DI float bflo(unsigned w) { return pg8::bf_lo(w); }
DI float bfhi(unsigned w) { return pg8::bf_hi(w); }
DI float ex2(float x) { return __builtin_amdgcn_exp2f(x); }
DI f32x16 zero16() { float z = 0.f; asm volatile("" : "+v"(z)); return (f32x16){z, z, z, z, z, z, z, z, z, z, z, z, z, z, z, z}; }
DI int crow(int r, int hi) { return (r & 3) + 8 * (r >> 2) + 4 * hi; }
#define SWZ_XOR(v, m) __uint_as_float((unsigned)__builtin_amdgcn_ds_swizzle((int)__float_as_uint(v), ((m) << 10) | 0x1f))
DI float half_swap_add(float v);
DI float wave_sum(float v) { v += SWZ_XOR(v, 1); v += SWZ_XOR(v, 2); v += SWZ_XOR(v, 4); v += SWZ_XOR(v, 8); v += SWZ_XOR(v, 16); return half_swap_add(v); }
DI float shfl_lane(float v, int src_lane) { return __uint_as_float((unsigned)__builtin_amdgcn_ds_bpermute(src_lane << 2, (int)__float_as_uint(v))); }
DI float half_swap_add(float v) { auto rr = __builtin_amdgcn_permlane32_swap(__float_as_uint(v), __float_as_uint(v), false, false); return __uint_as_float(rr[0]) + __uint_as_float(rr[1]); }
DI float half_swap_max(float v) { auto rr = __builtin_amdgcn_permlane32_swap(__float_as_uint(v), __float_as_uint(v), false, false); return fmaxf(__uint_as_float(rr[0]), __uint_as_float(rr[1])); }
typedef short v4i16_t __attribute__((ext_vector_type(4)));
DI s16x4 vtr(lcp p) { return __builtin_bit_cast(s16x4, __builtin_amdgcn_ds_read_tr16_b64_v4i16((LAS v4i16_t*)p)); }
DI bf16x8 cat8(s16x4 lo, s16x4 hi) { return __builtin_shufflevector(lo, hi, 0, 1, 2, 3, 4, 5, 6, 7); }
DI bf16x8 trfrag(lcp p) { return cat8(vtr(p), vtr(p + 512)); }
DI bf16x8 ldfrag(lcp p) { return *(const LAS bf16x8*)p; }
DI bf16x8 mask_frag(v4u v, unsigned m) { v4u o; asm("v_and_b32 %0, %4, %8\n\tv_and_b32 %1, %5, %8\n\tv_and_b32 %2, %6, %8\n\tv_and_b32 %3, %7, %8\n\ts_nop 1" : "=&v"(o.x), "=&v"(o.y), "=&v"(o.z), "=&v"(o.w) : "v"(v.x), "v"(v.y), "v"(v.z), "v"(v.w), "v"(m)); return __builtin_bit_cast(bf16x8, o); }
DI void glds16(const void* gsrc, LAS void* ldst) { __builtin_amdgcn_global_load_lds((const unsigned*)gsrc, (LAS unsigned*)ldst, 16, 0, 0); }
#define PACK8(x, s) ((bf16x8)__builtin_bit_cast(bf16x8, (v4u){pk2((x)[8 * (s) + 0], (x)[8 * (s) + 1]), pk2((x)[8 * (s) + 2], (x)[8 * (s) + 3]), pk2((x)[8 * (s) + 4], (x)[8 * (s) + 5]), pk2((x)[8 * (s) + 6], (x)[8 * (s) + 7])}))

constexpr int RING_OFF = 0, RING_BYTES = 131072;
constexpr int TAB_OFF = 131072;
constexpr int MISC_OFF = 163840 - 256;
constexpr int LDS_BYTES = 163840;
constexpr int AT_K = 0, AT_V = 32768, AT_WS = 65536, AT_STG = 67584;
constexpr int ML_K = 0, ML_V = 65536, ML_VW = 81920, ML_C = 98304, ML_N = 131072, ML_G2 = 131584, ML_M2 = 132096, ML_FI = 132608, ML_EI = 133120, ML_WK = 133632, ML_WKB = 134144, ML_SC = 134400, ML_WS = 134464, ML_STG = 136512;
static_assert(ML_STG + 4 * 4096 <= MISC_OFF && AT_STG + 8 * 4096 <= MISC_OFF && pg8::CTAB_OFF + pg8::CTAB_UNITS * 1024 <= MISC_OFF && pg8::STAB_OFF == TAB_OFF + 16384, "LDS map");

#define XB_TMO      128
#define XB_XCNT(j)  (256  + 64 * (j))
#define XB_XSUB(j)  (1280 + 64 * (j))
#define XB_XGEN(j)  (2304 + 64 * (j))
#define XB_TOP      3328
#define XB_TOPGEN   3392
#define XCD_BAR_WORDS 3456
#define XB_SPIN_CAP (1u << 18)

__device__ __forceinline__ unsigned xb_ld(unsigned* p)              { return __hip_atomic_load(p, __ATOMIC_RELAXED, __HIP_MEMORY_SCOPE_AGENT); }
__device__ __forceinline__ unsigned xb_add(unsigned* p, unsigned v) { return __hip_atomic_fetch_add(p, v, __ATOMIC_RELAXED, __HIP_MEMORY_SCOPE_AGENT); }
__device__ __forceinline__ unsigned xb_xcc_id() { return (unsigned)__builtin_amdgcn_s_getreg((3 << 11) | 20) & 0xFu; }
#define XB_SPIN(cond, bar) do { unsigned _sp = 0; while (cond) { __builtin_amdgcn_s_sleep(1); \
    if ((++_sp & 255u) == 0u) { if (xb_ld(&(bar)[XB_TMO])) break; if (_sp > XB_SPIN_CAP) { atomicAdd(&(bar)[XB_TMO], 1u); break; } } } } while (0)

struct XcdBarrier {
    unsigned* bar; unsigned x;
    volatile LAS unsigned* st;
    unsigned total;
};

__device__ __forceinline__ XcdBarrier xcd_barrier_post(unsigned* bar, volatile LAS unsigned* st) {
    XcdBarrier b; b.bar = bar; b.x = xb_xcc_id(); b.st = st; b.total = gridDim.x * gridDim.y * gridDim.z;
    if (threadIdx.x == 0) (void)xb_add(&bar[XB_XCNT(b.x)], 1u);
    return b;
}
__device__ __forceinline__ void xcd_barrier_complete(unsigned* bar, unsigned x, unsigned G, unsigned& nloc, unsigned& nx) {
    unsigned sum, cnt, mine, sp = 0u;
    for (;;) {
        sum = 0u; cnt = 0u; mine = 0u;
#pragma unroll
        for (unsigned j = 0; j < 16; ++j) { const unsigned c = xb_ld(&bar[XB_XCNT(j)]); sum += c; cnt += (c > 0u) ? 1u : 0u; mine = (j == x) ? c : mine; }
        if (sum == G) break;
        __builtin_amdgcn_s_sleep(1);
        if ((++sp & 255u) == 0u) { if (xb_ld(&bar[XB_TMO])) break; if (sp > XB_SPIN_CAP) { atomicAdd(&bar[XB_TMO], 1u); break; } }
    }
    nloc = mine > 0u ? mine : 1u; nx = cnt > 0u ? cnt : 1u;
}

__device__ __forceinline__ void xcd_barrier(const XcdBarrier& b) {
    asm volatile("s_waitcnt vmcnt(0)" ::: "memory");
    __syncthreads();
    if (threadIdx.x == 0) {
        unsigned* bar = b.bar;
        __builtin_amdgcn_s_waitcnt(0);
        unsigned nloc = b.st[0], nx = b.st[1];
        if (nloc == 0u) { xcd_barrier_complete(bar, b.x, b.total, nloc, nx); b.st[0] = nloc; b.st[1] = nx; }
        const unsigned old = xb_add(&bar[XB_XSUB(b.x)], 1u);
        const unsigned gen = old / nloc;
        if (old + 1u == (gen + 1u) * nloc) {
            __builtin_amdgcn_fence(__ATOMIC_RELEASE, "agent");
            asm volatile("s_waitcnt vmcnt(0)" ::: "memory");
            if (nx > 1u) {
            const unsigned og = xb_add(&bar[XB_TOP], 1u);
            const unsigned tg = og / nx;
            if (og + 1u == (tg + 1u) * nx) xb_add(&bar[XB_TOPGEN], 1u);
            else XB_SPIN(xb_ld(&bar[XB_TOPGEN]) == tg, bar);
            }
            __builtin_amdgcn_fence(__ATOMIC_ACQUIRE, "agent");
            xb_add(&bar[XB_XGEN(b.x)], 1u);
            asm volatile("s_waitcnt vmcnt(0)" ::: "memory");
        } else {
            XB_SPIN(xb_ld(&bar[XB_XGEN(b.x)]) == gen, bar);
            __builtin_amdgcn_fence(__ATOMIC_ACQUIRE, "agent");
            asm volatile("s_waitcnt vmcnt(0)" ::: "memory");
        }
    }
    __syncthreads();
}
DI void glds16_nt(const void* gsrc, LAS void* ldst) { __builtin_amdgcn_global_load_lds((const unsigned*)gsrc, (LAS unsigned*)ldst, 16, 0, 2); }
DI void attn_phase(unsigned char* ldsg, const bf16* QKV, unsigned char* AO8, const float* sinks, int ng, int gx, int gy, int Gy, int wave_in) {
    int wid = wave_in; asm volatile("" : "+s"(wid));
    const int lane = pg8::pg8_lane(), tid = wid * 64 + lane, r32 = lane & 31, hi = lane >> 5;
    LAS unsigned char* lds = (LAS unsigned char*)ldsg; const lcp L = (lcp)lds;
    LAS float* wsf = (LAS float*)(lds + AT_WS) + wid * 64;
    LAS unsigned char* stg = lds + AT_STG + wid * 4096;
    const lcp vlane = L + AT_V + ((lane >> 4) & 1) * 32 + (lane & 3) * 8 + (4 * hi + ((lane & 15) >> 2)) * 64;
    const lcp klane = L + AT_K + hi * 1024 + r32 * 16;
    for (int uu = gy; uu < 64 * (BATCH / ng); uu += Gy) { const int b = gx + ng * (uu >> 6), ul = uu & 63;
        const int kvh = ul & 3, nb = ul >> 2;
        const long rowq = (long)b * SEQ + nb * 128, rowk = rowq - 128;
        const int slot_lo = (nb == 0) ? 2 : 0;
        for (int sl = slot_lo; sl < 4; ++sl) {
            glds16(QKV + (rowk + 64 * sl + lane) * NQKV + 2048 + 64 * kvh + 8 * wid, lds + AT_K + sl * 8192 + wid * 1024);
            glds16(QKV + (rowk + 64 * sl + 16 * (wid & 3) + (lane >> 2)) * NQKV + 2304 + 64 * kvh + (wid >> 2) * 32 + (lane & 3) * 8, lds + AT_V + sl * 8192 + wid * 1024);
        }
        const int hq = 8 * kvh + wid;
        const bf16* qsrc = QKV + (rowq + r32) * NQKV + 64 * hq + 8 * hi;
        bf16x8 qn[4];
#pragma unroll
        for (int d0 = 0; d0 < 4; ++d0) qn[d0] = *(const bf16x8*)(qsrc + 16 * d0);
        const float slope2 = ex2(-0.25f * (float)(hq + 1)) * LOG2E, sink2 = sinks[hq] * LOG2E;
        const float base_l = -slope2 * (float)(r32 - 4 * hi);
        WG_BAR();
#pragma unroll 1
        for (int j = 0; j < 4; ++j) {
            const int ilo = (nb == 0) ? 4 - j : 0;
            bf16x8 qr[4];
#pragma unroll
            for (int d0 = 0; d0 < 4; ++d0) qr[d0] = qn[d0];
            if (j < 3) {
#pragma unroll
                for (int d0 = 0; d0 < 4; ++d0) qn[d0] = *(const bf16x8*)(qsrc + (size_t)(32 * (j + 1)) * NQKV + 16 * d0);
            }
            float sl2 = slope2, bl = base_l; asm volatile("" : "+v"(sl2), "+v"(bl));
            f32x16 p[5];
#pragma unroll
            for (int i = 0; i < 5; ++i) {
                if (i >= ilo) {
                    const int kt = j + i; const lcp kb = klane + (kt >> 1) * 8192 + (kt & 1) * 512;
                    f32x16 a = zero16();
#pragma unroll
                    for (int d0 = 0; d0 < 4; ++d0) a = MFMA32(ldfrag(kb + d0 * 2048), qr[d0], a);
#pragma unroll
                    for (int r = 0; r < 16; ++r) {
                        const int cr = (r & 3) + 8 * (r >> 2);
                        float s = fmaf(sl2, (float)(cr - 128 + 32 * i), fmaf(a[r], LOG2E, bl));
                        if (i == 0) { if (!(cr + 4 * hi > r32)) s = -INFINITY; }
                        if (i == 4) { if (!(cr + 4 * hi <= r32)) s = -INFINITY; }
                        a[r] = s;
                    }
                    p[i] = a;
                } else {
#pragma unroll
                    for (int r = 0; r < 16; ++r) p[i][r] = -INFINITY;
                }
            }
            float mx = sink2;
#pragma unroll
            for (int i = 0; i < 5; ++i)
#pragma unroll
                for (int r = 0; r < 16; ++r) mx = fmaxf(mx, p[i][r]);
            mx = half_swap_max(mx);
            float ls = 0.f;
#pragma unroll
            for (int i = 0; i < 5; ++i)
#pragma unroll
                for (int r = 0; r < 16; ++r) { const float e = ex2(p[i][r] - mx); p[i][r] = e; ls += e; }
            ls = half_swap_add(ls) + ex2(sink2 - mx);
            f32x16 o0 = zero16(), o1 = zero16();
#pragma unroll
            for (int i = 0; i < 5; ++i) {
                if (i >= ilo) {
                    const int kt = j + i; const lcp vb = vlane + (kt >> 1) * 8192 + (kt & 1) * 2048;
                    const bf16x8 pa = PACK8(p[i], 0), pb = PACK8(p[i], 1);
                    o0 = MFMA32(pa, trfrag(vb), o0);        o0 = MFMA32(pb, trfrag(vb + 1024), o0);
                    o1 = MFMA32(pa, trfrag(vb + 4096), o1); o1 = MFMA32(pb, trfrag(vb + 4096 + 1024), o1);
                }
            }
            if (hi == 0) wsf[r32] = __builtin_amdgcn_rcpf(ls);
#pragma unroll
            for (int r = 0; r < 16; ++r) {
                const int orow = crow(r, hi); const float rl = wsf[orow] * pg8::F8_SO;
                int pk; asm volatile("" : "=v"(pk)); pk = __builtin_amdgcn_cvt_pk_fp8_f32(o0[r] * rl, o1[r] * rl, pk, false);
                stg[orow * 64 + r32] = (unsigned char)(pk & 0xff);
                stg[orow * 64 + 32 + r32] = (unsigned char)((pk >> 8) & 0xff);
            }
#pragma unroll
            for (int i4 = 0; i4 < 2; ++i4) {
                const int row = i4 * 16 + (lane >> 2), ch = lane & 3;
                const v4u v = *(const LAS v4u*)(stg + row * 64 + ch * 16);
                *(v4u*)(AO8 + (rowq + 32 * j + row) * D + 64 * hq + ch * 16) = v;
            }
        }
        WG_BAR();
    }
}

constexpr int ML_GSET = ML_STG + 4 * 4096 - ML_G2;
static_assert(ML_G2 + ML_GSET + (ML_WS - ML_G2) <= MISC_OFF, "LDS map: second gate-array set");
#define DPPF(old, src, ctrl, rmask, bc) __uint_as_float((unsigned)__builtin_amdgcn_update_dpp((int)__float_as_uint(old), (int)__float_as_uint(src), (ctrl), (rmask), 0xf, (bc)))
DI float scan_add64(float v) {
    v += DPPF(0.f, v, 0x111, 0xf, true); v += DPPF(0.f, v, 0x112, 0xf, true); v += DPPF(0.f, v, 0x114, 0xf, true); v += DPPF(0.f, v, 0x118, 0xf, true);
    v += DPPF(0.f, v, 0x142, 0xa, false); v += DPPF(0.f, v, 0x143, 0xc, false); return v;
}
DI float scan_max64(float v) {
    const float ninf = -INFINITY;
    v = fmaxf(v, DPPF(ninf, v, 0x111, 0xf, false)); v = fmaxf(v, DPPF(ninf, v, 0x112, 0xf, false)); v = fmaxf(v, DPPF(ninf, v, 0x114, 0xf, false)); v = fmaxf(v, DPPF(ninf, v, 0x118, 0xf, false));
    v = fmaxf(v, DPPF(ninf, v, 0x142, 0xa, false)); v = fmaxf(v, DPPF(ninf, v, 0x143, 0xc, false)); return v;
}
DI float ml_gate_scan(LAS unsigned char* lds, int gofs, const float* GT, long row0, int h, int lane, float m_prev) {
    LAS float* G2 = (LAS float*)(lds + ML_G2 + gofs); LAS float* M2 = (LAS float*)(lds + ML_M2 + gofs); LAS float* FI = (LAS float*)(lds + ML_FI + gofs); LAS float* EI = (LAS float*)(lds + ML_EI + gofs);
    LAS float* WK = (LAS float*)(lds + ML_WK + gofs); LAS bf16* WKB = (LAS bf16*)(lds + ML_WKB + gofs); LAS float* SC = (LAS float*)(lds + ML_SC + gofs);
    const float* gp = GT + (size_t)(row0 + 2 * lane) * 8;
    const float i0 = gp[h], f0 = gp[4 + h], i1 = gp[8 + h], f1 = gp[12 + h];
    const float lf0 = -0.6931471805599453f * __builtin_amdgcn_logf(1.f + ex2(-LOG2E * f0)), lf1 = -0.6931471805599453f * __builtin_amdgcn_logf(1.f + ex2(-LOG2E * f1));
    const float incl = scan_add64(lf0 + lf1);
    const float b1 = incl, b0 = incl - lf1;
    const float g0 = i0 - b0, g1 = i1 - b1;
    const float cm = scan_max64(fmaxf(g0, g1));
    const float cprev = DPPF(-INFINITY, cm, 0x138, 0xf, false);
    const float M0 = fmaxf(m_prev, fmaxf(cprev, g0)), M1 = fmaxf(m_prev, cm);
    const float Mend = __uint_as_float((unsigned)__builtin_amdgcn_readlane((int)__float_as_uint(M1), 63)), blast = __uint_as_float((unsigned)__builtin_amdgcn_readlane((int)__float_as_uint(b1), 63));
    *(LAS f32x2*)(G2 + 2 * lane) = (f32x2){g0 * LOG2E, g1 * LOG2E};
    *(LAS f32x2*)(M2 + 2 * lane) = (f32x2){M0 * LOG2E, M1 * LOG2E};
    *(LAS f32x2*)(FI + 2 * lane) = (f32x2){ex2((m_prev - M0) * LOG2E), ex2((m_prev - M1) * LOG2E)};
    *(LAS f32x2*)(EI + 2 * lane) = (f32x2){ex2(-(b0 + M0) * LOG2E), ex2(-(b1 + M1) * LOG2E)};
    const float w0 = ex2((g0 - Mend) * LOG2E), w1 = ex2((g1 - Mend) * LOG2E);
    *(LAS f32x2*)(WK + 2 * lane) = (f32x2){w0, w1};
    *(LAS unsigned*)(WKB + 2 * lane) = pk2(w0, w1);
    if (lane == 0) SC[0] = ex2((m_prev - Mend) * LOG2E);
    return blast + Mend;
}
template <int VAR = 0>
DI void mlstm_phase(unsigned char* ldsg, const bf16* MP, const float* GT, bf16* HG, int ng, int gx, int gy, int Gy, int wave_in) {
    int wid = wave_in; asm volatile("" : "+s"(wid));
    const int lane0 = pg8::pg8_lane(), tid = wid * 64 + lane0;
    LAS unsigned char* lds = (LAS unsigned char*)ldsg; const lcp L = (lcp)lds;
    LAS float* wsf = (LAS float*)(lds + ML_WS) + wid * 64;
    for (int uu = gy; uu < 32 * (BATCH / ng); uu += Gy) { const int b = gx + ng * (uu >> 5), ul = uu & 31;
        const int h = ul >> 3, sl = ul & 7;
        const bf16* Qp = MP + 256 * h; const bf16* Kp = MP + 1024 + 256 * h; const bf16* Vp = MP + 2048 + 512 * h + 64 * sl; const bf16* OGp = MP + 4096 + 512 * h + 64 * sl;
        { unsigned z = 0u; asm volatile("" : "+v"(z)); for (int i = tid; i < (32768 + 512) / 16; i += 512) *(LAS v4u*)(lds + ML_C + i * 16) = (v4u){z, z, z, z}; }
        f32x16 T[6];
#pragma unroll
        for (int x = 0; x < 6; ++x) T[x] = zero16();
        float m_prev = 0.f;
        v4u X[16], vreg[2];
        { const long row0 = (long)b * SEQ; const int lane = lane0, r32 = lane & 31, hi = lane >> 5;
          if (wid >= 4) {
#pragma unroll
              for (int i = 0; i < 16; ++i) X[i] = *(const v4u*)(Kp + (row0 + 8 * i + (lane & 7)) * NMI + (8 * (wid - 4) + (lane >> 3)) * 8);
          } else {
#pragma unroll
              for (int ks = 0; ks < 16; ++ks) X[ks] = *(const v4u*)(Qp + (row0 + 32 * wid + r32) * NMI + 16 * ks + 8 * hi);
          }
#pragma unroll
          for (int i = 0; i < 2; ++i) vreg[i] = *(const v4u*)(Vp + (row0 + 64 * i + 16 * (wid & 3) + (lane >> 2)) * NMI + (wid >> 2) * 32 + (lane & 3) * 8);
          if (wid == 4 && !(VAR & 16)) m_prev = ml_gate_scan(lds, 0, GT, row0, h, lane, m_prev);
        }
        WG_BAR();
        for (int c = 0; c < 16; ++c) {
            const long row0 = (long)b * SEQ + 128 * c;
            const int gofs = (c & 1) * ML_GSET;
            const int lane = pg8::pg8_lane(), r32 = lane & 31, hi = lane >> 5;
            const int blk = (lane >> 4) & 1, q4 = (lane & 15) >> 2, p4 = lane & 3;
            const int vlo_ = blk * 32 + p4 * 8 + (4 * hi + q4) * 64;
            const int ktl_ = (2 * blk + (p4 >> 1)) * 2048 + (q4 + 4 * hi) * 16 + (p4 & 1) * 8;
            const int cbl_ = hi * 1024 + r32 * 16, kbl_ = hi * 2048 + r32 * 16;
            const unsigned m0 = (r32 == 0) ? 0xffffffffu : 0u;
            LAS float* G2 = (LAS float*)(lds + ML_G2 + gofs); LAS float* M2 = (LAS float*)(lds + ML_M2 + gofs); LAS float* FI = (LAS float*)(lds + ML_FI + gofs); LAS float* EI = (LAS float*)(lds + ML_EI + gofs);
            LAS float* WK = (LAS float*)(lds + ML_WK + gofs); LAS bf16* WKB = (LAS bf16*)(lds + ML_WKB + gofs); LAS float* SC = (LAS float*)(lds + ML_SC + gofs);
            if (wid >= 4) {
#pragma unroll
                for (int i = 0; i < 16; ++i) *(LAS v4u*)(lds + ML_K + (8 * (wid - 4) + (lane >> 3)) * 2048 + (8 * i + (lane & 7)) * 16) = X[i];
            }
#pragma unroll
            for (int i = 0; i < 2; ++i) { const float w = WK[64 * i + 16 * (wid & 3) + (lane >> 2)]; const v4u v = vreg[i]; v4u o;
                o.x = pk2(bflo(v.x) * w, bfhi(v.x) * w); o.y = pk2(bflo(v.y) * w, bfhi(v.y) * w); o.z = pk2(bflo(v.z) * w, bfhi(v.z) * w); o.w = pk2(bflo(v.w) * w, bfhi(v.w) * w);
                *(LAS v4u*)(lds + ML_V + i * 8192 + wid * 1024 + lane * 16) = v;
                *(LAS v4u*)(lds + ML_VW + i * 8192 + wid * 1024 + lane * 16) = o; }
            asm volatile("s_waitcnt lgkmcnt(0)" ::: "memory"); __builtin_amdgcn_s_barrier(); asm volatile("" ::: "memory");
            const bool more = c + 1 < 16;
            if (more && !(VAR & 32)) {
                const long row1 = row0 + 128;
                if (wid >= 4) {
#pragma unroll
                    for (int i = 0; i < 16; ++i) X[i] = *(const v4u*)(Kp + (row1 + 8 * i + (lane & 7)) * NMI + (8 * (wid - 4) + (lane >> 3)) * 8);
                }
#pragma unroll
                for (int i = 0; i < 2; ++i) vreg[i] = *(const v4u*)(Vp + (row1 + 64 * i + 16 * (wid & 3) + (lane >> 2)) * NMI + (wid >> 2) * 32 + (lane & 3) * 8);
            }
            if (wid < 4) {
                const int tt = wid;
                v4u ogv[4];
#pragma unroll
                for (int i4 = 0; i4 < 4; ++i4) ogv[i4] = *(const v4u*)(OGp + (row0 + 32 * tt + i4 * 8 + (lane >> 3)) * NMI + (lane & 7) * 8);
                T[0] = zero16(); T[1] = zero16(); T[2] = zero16();
                if (!(VAR & 4)) { const lcp cb = L + ML_C + cbl_; const lcp nbp = L + ML_N + 16 * hi;
#pragma unroll
                  for (int ks = 0; ks < 16; ++ks) {
                      const bf16x8 c0 = ldfrag(cb + ks * 2048), c1 = ldfrag(cb + ks * 2048 + 512);
                      const bf16x8 nf = mask_frag(*(const LAS v4u*)(nbp + ks * 32), m0);
                      T[0] = MFMA32(__builtin_bit_cast(bf16x8, X[ks]), c0, T[0]); T[1] = MFMA32(__builtin_bit_cast(bf16x8, X[ks]), c1, T[1]); T[2] = MFMA32(__builtin_bit_cast(bf16x8, X[ks]), nf, T[2]);
                      if ((ks & 3) == 3) __builtin_amdgcn_sched_barrier(0);
                  } }
                { float fi[16];
#pragma unroll
                  for (int r = 0; r < 16; ++r) fi[r] = FI[32 * tt + crow(r, hi)];
#pragma unroll
                  for (int r = 0; r < 16; ++r) { T[0][r] *= fi[r]; T[1][r] *= fi[r]; }
                  if (r32 == 0) {
#pragma unroll
                      for (int r = 0; r < 16; ++r) wsf[crow(r, hi)] = T[2][r] * fi[r];
                  } }
                const float Mt = M2[32 * tt + r32];
                float dsum = 0.f;
                for (int st = 0; st <= ((VAR & 2) ? -1 : tt); ++st) {
                    f32x16 S = zero16();
                    const lcp kb = L + ML_K + kbl_ + st * 512;
#pragma unroll
                    for (int ks = 0; ks < 16; ++ks) S = MFMA32(ldfrag(kb + ks * 4096), __builtin_bit_cast(bf16x8, X[ks]), S);
#pragma unroll
                    for (int r = 0; r < 16; ++r) {
                        const float w = ex2(G2[32 * st + crow(r, hi)] - Mt);
                        float v = S[r] * w;
                        if (st == tt && crow(r, hi) > r32) v = 0.f;
                        S[r] = v; dsum += v;
                    }
                    const bf16x8 pa = PACK8(S, 0), pb = PACK8(S, 1);
                    const lcp vb = L + ML_V + (st >> 1) * 8192 + (st & 1) * 2048 + vlo_;
                    T[0] = MFMA32(pa, trfrag(vb), T[0]);        T[0] = MFMA32(pb, trfrag(vb + 1024), T[0]);
                    T[1] = MFMA32(pa, trfrag(vb + 4096), T[1]); T[1] = MFMA32(pb, trfrag(vb + 4096 + 1024), T[1]);
                }
                if (more && !(VAR & 64)) {
#pragma unroll
                    for (int ks = 0; ks < 16; ++ks) X[ks] = *(const v4u*)(Qp + (row0 + 128 + 32 * wid + r32) * NMI + 16 * ks + 8 * hi);
                }
                dsum = half_swap_add(dsum);
                { const float den = wsf[r32] + dsum; const float dn = fmaxf(fabsf(den), EI[32 * tt + r32]);
                  if (hi == 0) wsf[32 + r32] = __builtin_amdgcn_rcpf(dn); }
                LAS bf16* stg = (LAS bf16*)(lds + ML_STG + tt * 4096);
                if (!(VAR & 8)) {
#pragma unroll
                for (int r = 0; r < 16; ++r) {
                    const int orow = crow(r, hi); const float rd = wsf[32 + orow];
                    stg[orow * 64 + r32] = (bf16)(pk2(T[0][r] * rd, 0.f) & 0xffffu);
                    stg[orow * 64 + 32 + r32] = (bf16)(pk2(T[1][r] * rd, 0.f) & 0xffffu);
                }
#pragma unroll
                for (int i4 = 0; i4 < 4; ++i4) {
                    const int row = i4 * 8 + (lane >> 3), ch = lane & 7;
                    const v4u hv = *(const LAS v4u*)(stg + row * 64 + ch * 8);
                    const v4u og = ogv[i4];
                    v4u o;
                    o.x = pk2(bflo(hv.x) * bflo(og.x), bfhi(hv.x) * bfhi(og.x)); o.y = pk2(bflo(hv.y) * bflo(og.y), bfhi(hv.y) * bfhi(og.y));
                    o.z = pk2(bflo(hv.z) * bflo(og.z), bfhi(hv.z) * bfhi(og.z)); o.w = pk2(bflo(hv.w) * bflo(og.w), bfhi(hv.w) * bfhi(og.w));
                    *(v4u*)(HG + (row0 + 32 * tt + row) * D + 512 * h + 64 * sl + ch * 8) = o;
                }
                }
#pragma unroll
                for (int x = 3; x < 6; ++x) T[x] = zero16();
            } else {
                const float decay = SC[0];
#pragma unroll
                for (int x = 0; x < 6; ++x)
#pragma unroll
                    for (int r = 0; r < 16; ++r) T[x][r] *= decay;
#pragma unroll
                for (int dti = 0; dti < ((VAR & 1) ? 0 : 2); ++dti) {
                    const int dt = 2 * (wid - 4) + dti;
                    const lcp ka0 = L + ML_K + dt * 8192 + ktl_;
#pragma unroll
                    for (int s8 = 0; s8 < 8; ++s8) {
                        const lcp ka = ka0 + s8 * 256;
                        const bf16x8 af = cat8(vtr(ka), vtr(ka + 128));
                        const lcp vwb = L + ML_VW + (s8 >> 2) * 8192 + (s8 & 3) * 1024 + vlo_;
                        const bf16x8 b0 = trfrag(vwb), b1 = trfrag(vwb + 4096);
                        const v2u wlo = *(const LAS v2u*)(WKB + 16 * s8 + 4 * hi), whi = *(const LAS v2u*)(WKB + 16 * s8 + 4 * hi + 8); const bf16x8 nb = mask_frag((v4u){wlo.x, wlo.y, whi.x, whi.y}, m0);
                        T[2 * dti] = MFMA32(af, b0, T[2 * dti]); T[2 * dti + 1] = MFMA32(af, b1, T[2 * dti + 1]); T[4 + dti] = MFMA32(af, nb, T[4 + dti]);
                        if (s8 & 1) __builtin_amdgcn_sched_barrier(0);
                    }
                }
                if (more && wid == 4 && !(VAR & 16)) m_prev = ml_gate_scan(lds, ML_GSET - gofs, GT, row0 + 128, h, lane, m_prev);
            }
            asm volatile("s_waitcnt lgkmcnt(0)" ::: "memory"); __builtin_amdgcn_s_barrier(); asm volatile("" ::: "memory");
            if (wid >= 4) {
#pragma unroll
                for (int dti = 0; dti < 2; ++dti) {
                    const int dt = 2 * (wid - 4) + dti;
#pragma unroll
                    for (int et = 0; et < 2; ++et)
#pragma unroll
                        for (int g = 0; g < 4; ++g)
                            *(LAS v2u*)(lds + ML_C + (4 * dt + g) * 1024 + (32 * et + r32) * 16 + hi * 8) = (v2u){pk2(T[2 * dti + et][4 * g], T[2 * dti + et][4 * g + 1]), pk2(T[2 * dti + et][4 * g + 2], T[2 * dti + et][4 * g + 3])};
                    if (r32 == 0) {
#pragma unroll
                        for (int g = 0; g < 4; ++g)
                            *(LAS v2u*)(lds + ML_N + (32 * dt + 8 * g + 4 * hi) * 2) = (v2u){pk2(T[4 + dti][4 * g], T[4 + dti][4 * g + 1]), pk2(T[4 + dti][4 * g + 2], T[4 + dti][4 * g + 3])};
                    }
                }
            }
        }
        WG_BAR();
    }
}


constexpr int NWAVES = 8;

template <bool F8> DI void tr_strip(const float* W, int ldw, int n0, void* WTv, size_t wt_row0, int Kdim, int kb0, int nkb, const float* g, const float* bb, float cs, float* c1o, float* c2o, LAS float* scr, int lane) {
    bf16* WT = (bf16*)WTv; unsigned char* WT8 = (unsigned char*)WTv;
    const int c = lane & 7;
    float a1[4] = {0.f, 0.f, 0.f, 0.f}, a2[4] = {0.f, 0.f, 0.f, 0.f};
    for (int kb = kb0; kb < kb0 + nkb; ++kb) {
        const int k0 = kb * 64;
#pragma unroll 8
        for (int i = 0; i < 32; ++i) { const int kk = 2 * i + (lane >> 5); scr[kk * 33 + (lane & 31)] = __builtin_nontemporal_load(W + (size_t)(k0 + kk) * ldw + n0 + (lane & 31)); }
        float gk[8], bk[8];
        if (g) { const f32x4 g0 = *(const f32x4*)(g + k0 + 8 * c), g1 = *(const f32x4*)(g + k0 + 8 * c + 4), b0 = *(const f32x4*)(bb + k0 + 8 * c), b1 = *(const f32x4*)(bb + k0 + 8 * c + 4);
#pragma unroll
            for (int i = 0; i < 4; ++i) { gk[i] = g0[i] * cs; gk[4 + i] = g1[i] * cs; bk[i] = b0[i] * cs; bk[4 + i] = b1[i] * cs; } }
        else {
#pragma unroll
            for (int i = 0; i < 8; ++i) { gk[i] = cs; bk[i] = 0.f; } }
        LDS_WAIT(); asm volatile("" ::: "memory");
#pragma unroll
        for (int j = 0; j < 4; ++j) { const int n = (lane >> 3) + 8 * j; const LAS float* s = scr + (8 * c) * 33 + n;
            float v[8];
#pragma unroll
            for (int i = 0; i < 8; ++i) v[i] = s[i * 33];
            a2[j] += ((v[0] * bk[0] + v[1] * bk[1]) + (v[2] * bk[2] + v[3] * bk[3])) + ((v[4] * bk[4] + v[5] * bk[5]) + (v[6] * bk[6] + v[7] * bk[7]));
            if constexpr (F8) {
                float wv[8];
#pragma unroll
                for (int i = 0; i < 8; ++i) wv[i] = v[i] * gk[i];
                const v2u o = pg8::cvt8_f8(wv, pg8::F8_SW);
                a1[j] += ((__builtin_amdgcn_cvt_f32_fp8((int)o.x, 0) + __builtin_amdgcn_cvt_f32_fp8((int)o.x, 1)) + (__builtin_amdgcn_cvt_f32_fp8((int)o.x, 2) + __builtin_amdgcn_cvt_f32_fp8((int)o.x, 3)))
                       + ((__builtin_amdgcn_cvt_f32_fp8((int)o.y, 0) + __builtin_amdgcn_cvt_f32_fp8((int)o.y, 1)) + (__builtin_amdgcn_cvt_f32_fp8((int)o.y, 2) + __builtin_amdgcn_cvt_f32_fp8((int)o.y, 3)));
                *(GAS v2u*)(WT8 + (wt_row0 + n) * Kdim + k0 + 8 * c) = o;
            } else {
                v4u o; o.x = pk2(v[0] * gk[0], v[1] * gk[1]); o.y = pk2(v[2] * gk[2], v[3] * gk[3]); o.z = pk2(v[4] * gk[4], v[5] * gk[5]); o.w = pk2(v[6] * gk[6], v[7] * gk[7]);
                a1[j] += ((bflo(o.x) + bfhi(o.x)) + (bflo(o.y) + bfhi(o.y))) + ((bflo(o.z) + bfhi(o.z)) + (bflo(o.w) + bfhi(o.w)));
                *(GAS v4u*)(WT + (wt_row0 + n) * Kdim + k0 + 8 * c) = o;
            } }
        LDS_WAIT(); asm volatile("" ::: "memory");
    }
    if (g) {
#pragma unroll
        for (int j = 0; j < 4; ++j) { float s1 = a1[j], s2 = a2[j];
            s1 += SWZ_XOR(s1, 1); s2 += SWZ_XOR(s2, 1); s1 += SWZ_XOR(s1, 2); s2 += SWZ_XOR(s2, 2); s1 += SWZ_XOR(s1, 4); s2 += SWZ_XOR(s2, 4);
            if (c == 0) { c1o[(lane >> 3) + 8 * j] = F8 ? s1 * (1.f / pg8::F8_SW) : s1; c2o[(lane >> 3) + 8 * j] = s2; } }
    }
}

DI void prologue(kargs_t a, LAS unsigned char* lds, int gw, int NGW, int wave, int lane) {
    unsigned char* ws = a->ws;
    float* vec = (float*)(ws + WS_VEC);
    const float* ones = (const float*)(ws + WS_VEC + V_ONES); const float* zeros = (const float*)(ws + WS_VEC + V_ZEROS);
    LAS float* scr = (LAS float*)(lds + wave * 16384);
    constexpr int T_UP = 8 * 2 * 176, T_QKV = 2 * 80, T_MI = 2 * 192, T_W2 = 8 * 64 * 4, T_WO = 2 * 64, T_WMO = 2 * 64, T_G = 16;
    constexpr int NT = T_UP + T_QKV + T_MI + T_W2 + T_WO + T_WMO + T_G;
#ifndef PROBE_PERM
#define PROBE_PERM 0
#endif
    for (int it = (PROBE_PERM && NGW == 2048) ? (gw & 7) * 256 + (gw >> 3) : gw; it < NT; it += NGW) {
        int r = it;
        if (r < T_UP) {
            const int f = r / 352, rr = r % 352, which = rr / 176, strip = rr % 176, n0 = 32 * strip;
            const int t = 3 * (f >> 1) + 2 * (f & 1);
            const float* gp = t ? a->ln_g + (size_t)(t - 1) * D : nullptr; const float* bp = t ? a->ln_b + (size_t)(t - 1) * D : nullptr;
            const size_t wrow = (size_t)256 * (n0 / 128) + 128 * which + (n0 % 128);
            const float* W = (which ? a->w3 : a->w1) + (size_t)f * D * FF;
            if (gp) tr_strip<true>(W, FF, n0, ws + WS_W13 + (size_t)f * NUP * D, wrow, D, 0, 32, gp, bp, 1.f, vec + V_C1U / 4 + (size_t)f * NUP + wrow, vec + V_C2U / 4 + (size_t)f * NUP + wrow, scr, lane);
            else { tr_strip<true>(W, FF, n0, ws + WS_W13 + (size_t)f * NUP * D, wrow, D, 0, 32, nullptr, nullptr, 1.f, nullptr, nullptr, scr, lane);
                   if (lane < 32) { vec[V_C1U / 4 + (size_t)f * NUP + wrow + lane] = 0.f; vec[V_C2U / 4 + (size_t)f * NUP + wrow + lane] = 0.f; } }
            continue; }
        r -= T_UP;
        if (r < T_QKV) { const int j = r / 80, n0 = 32 * (r % 80); const int t = 6 * j + 1;
            tr_strip<true>(a->wqkv + (size_t)j * D * NQKV, NQKV, n0, ws + WS_WQKV + (size_t)j * NQKV * D, n0, D, 0, 32, a->ln_g + (size_t)(t - 1) * D, a->ln_b + (size_t)(t - 1) * D, n0 < 2048 ? 0.125f : 1.f,
                     vec + V_C1Q / 4 + j * NQKV + n0, vec + V_C2Q / 4 + j * NQKV + n0, scr, lane);
            continue; }
        r -= T_QKV;
        if (r < T_MI) { const int j = r / 192, n0 = 32 * (r % 192); const int t = 6 * j + 4;
            if (!OG_F8 || n0 < 4096) tr_strip<false>(a->win + (size_t)j * D * NMIW, NMIW, n0, (bf16*)(ws + WS_WIN) + (size_t)j * NMI * D, n0, D, 0, 32, a->ln_g + (size_t)(t - 1) * D, a->ln_b + (size_t)(t - 1) * D, (n0 >= 1024 && n0 < 2048) ? 0.0625f : 1.f,
                     vec + V_C1I / 4 + j * NMI + n0, vec + V_C2I / 4 + j * NMI + n0, scr, lane);
            else tr_strip<true>(a->win + (size_t)j * D * NMIW, NMIW, n0, ws + WS_WIN + ((size_t)j * NMI + 4096) * D * 2, n0 - 4096, D, 0, 32, a->ln_g + (size_t)(t - 1) * D, a->ln_b + (size_t)(t - 1) * D, 1.f,
                     vec + V_C1I / 4 + j * NMI + n0, vec + V_C2I / 4 + j * NMI + n0, scr, lane);
            continue; }
        r -= T_MI;
        if (r < T_W2) { const int f = r / 256, rr = r % 256, strip = rr / 4, kq = rr % 4;
            tr_strip<true>(a->w2 + (size_t)f * FF * D, D, 32 * strip, ws + WS_W2 + (size_t)f * D * FF, 32 * strip, FF, 22 * kq, 22, nullptr, nullptr, 1.f, nullptr, nullptr, scr, lane);
            continue; }
        r -= T_W2;
        if (r < T_WO) { const int j = r / 64, strip = r % 64;
            tr_strip<true>(a->wo + (size_t)j * D * D, D, 32 * strip, ws + WS_WO + (size_t)j * D * D, 32 * strip, D, 0, 32, nullptr, nullptr, 1.f, nullptr, nullptr, scr, lane);
            continue; }
        r -= T_WO;
        if (r < T_WMO) { const int j = r / 64, strip = r % 64;
            tr_strip<false>(a->wmo + (size_t)j * D * D, D, 32 * strip, (bf16*)(ws + WS_WMO) + (size_t)j * D * D, 32 * strip, D, 0, 32, nullptr, nullptr, 1.f, nullptr, nullptr, scr, lane);
            continue; }
        r -= T_WMO;
        {
            const int j = r / 8, jj = r % 8; const int t = 6 * j + 4;
            const float* gp = a->ln_g + (size_t)(t - 1) * D; const float* bp = a->ln_b + (size_t)(t - 1) * D;
            const float* W = a->win + (size_t)j * D * NMIW + NMI + jj;
            bf16* wg16 = (bf16*)(vec + V_WG / 4) + (size_t)(j * 8 + jj) * D;
            float s1 = 0.f, s2 = 0.f;
            for (int k = lane; k < D; k += 64) { const float w = W[(size_t)k * NMIW]; const unsigned hv = pk2(w * gp[k], 0.f) & 0xffffu; wg16[k] = (bf16)hv; s1 += bflo(hv); s2 += w * bp[k]; }
            s1 = wave_sum(s1); s2 = wave_sum(s2);
            if (lane == 0) { vec[V_CG / 4 + j * 16 + jj] = s1; vec[V_CG / 4 + j * 16 + 8 + jj] = s2 + a->bg[j * 8 + jj]; }
        }
    }
    bf16* R = (bf16*)(ws + WS_R); float* sp0 = (float*)(ws + WS_SP);
    for (int m = gw; m < M; m += NGW) {
        const GAS f32x4* xr = (const GAS f32x4*)(a->x + (size_t)m * D);
#pragma unroll
        for (int i = 0; i < 4; ++i) { const f32x4 v0 = __builtin_nontemporal_load(xr + (i * 64 + lane) * 2), v1 = __builtin_nontemporal_load(xr + (i * 64 + lane) * 2 + 1);
            *(GAS v4u*)(R + (size_t)m * D + (i * 64 + lane) * 8) = (v4u){pk2(v0[0], v0[1]), pk2(v0[2], v0[3]), pk2(v1[0], v1[1]), pk2(v1[2], v1[3])};
            { const float xv[8] = {v0[0], v0[1], v0[2], v0[3], v1[0], v1[1], v1[2], v1[3]}; *(GAS v2u*)(ws + WS_R8 + (size_t)m * D + (i * 64 + lane) * 8) = pg8::cvt8_f8(xv, pg8::F8_SR); } }
        if (lane < 8) *(f32x2*)(sp0 + (size_t)m * 16 + lane * 2) = (f32x2){0.f, 256.f * (1.f - LN_EPS)};
    }
    for (int i = gw * 64 + lane; i < D; i += NGW * 64) { vec[V_ONES / 4 + i] = 1.f; vec[V_ZEROS / 4 + i] = 0.f; }
    (void)ones; (void)zeros;
}

DI void gates_phase(LAS unsigned char* lds, const bf16* R, const float* sp, const bf16* wg16, const float* cg, float* GT, int ng, int gx, int gy, int Gy, int wave_in) {
    int wave = wave_in; asm volatile("" : "+s"(wave));
    const int lane = pg8::pg8_lane(), tid = wave * 64 + lane, r32 = lane & 31, hi = lane >> 5;
    LAS float* part = (LAS float*)lds;
    const unsigned mk = (r32 < 8) ? 0xffffffffu : 0u; const v4u mkv = {mk, mk, mk, mk};
    for (int uu = gy; uu < (SEQ / 64) * (BATCH / ng); uu += Gy) { const int b = gx + ng * (uu >> 5), pl = uu & 31;
        const long r0 = (long)b * SEQ + (long)pl * 64;
        const bf16* bsrc = wg16 + (size_t)(r32 & 7) * D + 256 * wave + 8 * hi;
        bf16x8 bfr[16];
#pragma unroll
        for (int ks = 0; ks < 16; ++ks) bfr[ks] = __builtin_bit_cast(bf16x8, *(const v4u*)(bsrc + 16 * ks) & mkv);
#pragma unroll
        for (int rt = 0; rt < 2; ++rt) {
            const bf16* asrc = R + (r0 + 32 * rt + r32) * D + 256 * wave + 8 * hi;
            bf16x8 afr[16];
#pragma unroll
            for (int ks = 0; ks < 16; ++ks) afr[ks] = *(const bf16x8*)(asrc + 16 * ks);
            f32x16 acc = zero16();
#pragma unroll
            for (int ks = 0; ks < 16; ++ks) acc = MFMA32(afr[ks], bfr[ks], acc);
            if (r32 < 8) {
#pragma unroll
                for (int r = 0; r < 16; ++r) part[(wave * 64 + 32 * rt + crow(r, hi)) * 8 + r32] = acc[r];
            }
        }
        WG_BAR();
        {
            const int row = tid >> 3, col = tid & 7;
            float s = 0.f;
#pragma unroll
            for (int w = 0; w < 8; ++w) s += part[(w * 64 + row) * 8 + col];
            const f32x4* spr = (const f32x4*)(sp + (size_t)(r0 + row) * 16);
            const f32x4 v0 = spr[0], v1 = spr[1], v2 = spr[2], v3 = spr[3];
            const float ss = ((v0[0] + v0[2]) + (v1[0] + v1[2])) + ((v2[0] + v2[2]) + (v3[0] + v3[2])), qq = ((v0[1] + v0[3]) + (v1[1] + v1[3])) + ((v2[1] + v2[3]) + (v3[1] + v3[3]));
            const float mean = ss * (1.f / D), var = qq * (1.f / D) - mean * mean, rstd = __builtin_amdgcn_rsqf(var + LN_EPS);
            GT[(size_t)(r0 + row) * 8 + col] = rstd * (s - mean * cg[col]) + cg[8 + col];
        }
        WG_BAR();
    }
}

DI void final_ln(const bf16* R, const float* sp, const float* g, const float* b, float* out, int ng, int gx, int gw, int NGW, int lane) {
    for (int bb = gx; bb < BATCH; bb += ng) for (int m = bb * SEQ + gw; m < (bb + 1) * SEQ; m += NGW) {
        float s, q;
        { const f32x4 v = *(const f32x4*)(sp + (size_t)m * 16 + (lane & 3) * 4); s = v[0] + v[2]; q = v[1] + v[3];
          s += SWZ_XOR(s, 1); q += SWZ_XOR(q, 1); s += SWZ_XOR(s, 2); q += SWZ_XOR(q, 2); }
        const float mean = s * (1.f / D), var = q * (1.f / D) - mean * mean, rstd = __builtin_amdgcn_rsqf(var + LN_EPS);
#pragma unroll
        for (int i = 0; i < 4; ++i) {
            const int k = 8 * lane + 512 * i;
            const v4u rv = __builtin_nontemporal_load((const v4u*)(R + (size_t)m * D + k));
            const f32x4 g0 = *(const f32x4*)(g + k), g1 = *(const f32x4*)(g + k + 4), b0 = *(const f32x4*)(b + k), b1 = *(const f32x4*)(b + k + 4);
            f32x4 o0, o1;
            o0[0] = (bflo(rv.x) - mean) * rstd * g0[0] + b0[0]; o0[1] = (bfhi(rv.x) - mean) * rstd * g0[1] + b0[1]; o0[2] = (bflo(rv.y) - mean) * rstd * g0[2] + b0[2]; o0[3] = (bfhi(rv.y) - mean) * rstd * g0[3] + b0[3];
            o1[0] = (bflo(rv.z) - mean) * rstd * g1[0] + b1[0]; o1[1] = (bfhi(rv.z) - mean) * rstd * g1[1] + b1[1]; o1[2] = (bflo(rv.w) - mean) * rstd * g1[2] + b1[2]; o1[3] = (bfhi(rv.w) - mean) * rstd * g1[3] + b1[3];
            __builtin_nontemporal_store(o0, (GAS f32x4*)(out + (size_t)m * D + k)); __builtin_nontemporal_store(o1, (GAS f32x4*)(out + (size_t)m * D + k + 4));
        }
    }
}

#ifndef PROBE_DUP
#define PROBE_DUP 0
#endif
#ifndef UP_STG
#define UP_STG false
#endif
#ifndef PROBE_DRY
#define PROBE_DRY 1
#endif
#ifndef PROBE_MLV
#define PROBE_MLV 0
#endif
#ifndef SKIP_ATT
#define SKIP_ATT 0
#endif
#ifndef SKIP_MLSTM
#define SKIP_MLSTM 0
#endif

#define GRID_BAR1() do { XcdBarrier b_; b_.bar = (unsigned*)(kargs()->ws + WS_CTL) + CW_BAR; b_.x = xb_xcc_id(); b_.st = (volatile LAS unsigned*)(lds + MISC_OFF) + 8; b_.total = gridDim.x; xcd_barrier(b_); } while (0)
#define GRID_BAR() do { GRID_BAR1(); if (PROBE_DUP & 1024) GRID_BAR1(); } while (0)
#define GROUP_BAR1() do { XcdBarrier b_; b_.bar = (unsigned*)(kargs()->ws + WS_CTL) + CW_BAR + (1 + (bid & 7)) * XCD_BAR_WORDS; b_.x = xb_xcc_id(); b_.st = (volatile LAS unsigned*)(lds + MISC_OFF) + 10; b_.total = gridDim.x / 8; xcd_barrier(b_); } while (0)
#define LAYER_BAR() do { if (grouped) { GROUP_BAR1(); if (PROBE_DUP & 1024) GROUP_BAR1(); } else GRID_BAR(); } while (0)

__global__ void __launch_bounds__(NWAVES * 64, 2) fwd_kernel(Args args_by_value) {
    extern __shared__ __attribute__((aligned(16))) unsigned char lds_raw[];
    LAS unsigned char* lds = (LAS unsigned char*)lds_raw;
    const int w0 = __builtin_amdgcn_readfirstlane((int)threadIdx.x >> 6);
    const int G0 = gridDim.x, bid0 = blockIdx.x; const int G = G0, bid = bid0;
    { const int tid0 = threadIdx.x; if (tid0 < 64) ((volatile LAS unsigned*)(lds + MISC_OFF))[tid0] = 0u; }
    __syncthreads();
    (void)xcd_barrier_post((unsigned*)(kargs()->ws + WS_CTL) + CW_BAR, (volatile LAS unsigned*)(lds + MISC_OFF) + 8);
#ifndef FORCE_UNGROUPED
#define FORCE_UNGROUPED 0
#endif
    const bool grouped = (G0 == 256) && !FORCE_UNGROUPED;
    if (grouped) (void)xcd_barrier_post((unsigned*)(kargs()->ws + WS_CTL) + CW_BAR + (1 + (bid0 & 7)) * XCD_BAR_WORDS, (volatile LAS unsigned*)(lds + MISC_OFF) + 10);
    {
        const int vcu = (G % 8 == 0) ? (bid % 8) * (G / 8) + bid / 8 : bid;
        prologue(kargs(), lds, vcu * NWAVES + w0, G * NWAVES, w0, pg8::pg8_lane());
        if (PROBE_DUP & 1) { WG_BAR(); prologue(kargs(), lds, vcu * NWAVES + w0, G * NWAVES, w0, pg8::pg8_lane()); }
#ifndef PROBE_PAT
#define PROBE_PAT 0
#endif
        if (PROBE_DUP & 8192) {
            kargs_t ka = kargs(); const int gwv = vcu * NWAVES + w0, lane = pg8::pg8_lane(); float s = 0.f;
            if (PROBE_PAT == 0) {
                for (int it = gwv; it < 8 * 2 * 176; it += G * NWAVES) { const int f = it / 352, rr = it % 352, which = rr / 176, n0 = 32 * (rr % 176); const float* W = (which ? ka->w3 : ka->w1) + (size_t)f * D * FF;
                    for (int kb = 0; kb < 32; ++kb) {
#pragma unroll 8
                        for (int i = 0; i < 32; ++i) s += __builtin_nontemporal_load(W + (size_t)(kb * 64 + 2 * i + (lane >> 5)) * FF + n0 + (lane & 31)); } }
            } else if (PROBE_PAT == 1) {
                for (int it = gwv; it < 8 * 2 * 176; it += G * NWAVES) { const int f = it / 352, rr = it % 352, which = rr / 176, st = rr % 176, n0 = 64 * (st >> 1), kh = st & 1; const float* W = (which ? ka->w3 : ka->w1) + (size_t)f * D * FF;
                    for (int kb = 0; kb < 16; ++kb) {
#pragma unroll 8
                        for (int i = 0; i < 64; ++i) s += __builtin_nontemporal_load(W + (size_t)(kh * 1024 + kb * 64 + i) * FF + n0 + lane); } }
            } else {
                for (int it = gwv; it < 8 * 2 * 176; it += G * NWAVES) { const int f = it / 352, rr = it % 352, which = rr / 176, st = rr % 176, n0 = 256 * (st >> 3), k8 = st & 7; const float* W = (which ? ka->w3 : ka->w1) + (size_t)f * D * FF;
                    for (int kb = 0; kb < 32; ++kb) {
#pragma unroll
                        for (int i = 0; i < 8; ++i) { const f32x4 v = __builtin_nontemporal_load((const f32x4*)(W + (size_t)(k8 * 256 + kb * 8 + i) * FF + n0 + 4 * lane)); s += v[0] + v[1] + v[2] + v[3]; } } }
            }
            if (s == 123.456f) ((float*)(ka->ws + WS_GATES))[0] = s;
        }
    }
    GRID_BAR();
#ifndef GROUP_STAGGER_TICKS
#define GROUP_STAGGER_TICKS 0
#endif
    if (grouped && (bid0 & 1) && GROUP_STAGGER_TICKS > 0) { const unsigned long long t0 = __builtin_amdgcn_s_memrealtime(); while (__builtin_amdgcn_s_memrealtime() - t0 < (unsigned long long)GROUP_STAGGER_TICKS) __builtin_amdgcn_s_sleep(8); }

    for (int t = 0; t < 3 * DEPTH; ++t) {
        int G = G0, bid = bid0; asm volatile("" : "+s"(G), "+s"(bid));
        const int ng = grouped ? 8 : 1, gx = bid % ng, gy = bid / ng, Gy = G / ng;
        const int layer = t / 3, sub = t % 3;
        const int kind = (sub != 1) ? 0 : ((layer & 1) ? 2 : 1);
        const int j = layer >> 1;
        {
            unsigned char* ws = kargs()->ws;
            float* vec = (float*)(ws + WS_VEC);
            const bf16* R = (const bf16*)(ws + WS_R);
            const float* sp_in = (const float*)(ws + WS_SP) + (size_t)(t & 1) * (SP_BYTES / 4);
            if (kind == 0) {
                const int f = 2 * layer + (sub >> 1);
                pg8::Gemm g{(const bf16*)(ws + WS_R8), (const bf16*)(ws + WS_W13 + (size_t)f * NUP * D), M, NUP, D / 2}; pg8::StaticOrder S; S.init(M, NUP, G, bid);
                pg8::EpiUp E{f, t & 1};
                if (PROBE_DUP & 2048) { S.r1 = 5; pg8::gemm_phase<pg8::EpiUp, pg8::StaticOrder, true, PG8_SP2, true>(lds + RING_OFF, g, S, E, w0); LAYER_BAR(); S.r0 = 5; S.r1 = 1 << 20; }
                if (grouped) { pg8::EpiUpT<true, 0, UP_STG> ET{f, t & 1}; pg8::gemm_phase<pg8::EpiUpT<true, 0, UP_STG>, pg8::StaticOrder, true, PG8_SP2, true>(lds + RING_OFF, g, S, ET, w0); }
                else pg8::gemm_phase<pg8::EpiUp, pg8::StaticOrder, true, PG8_SP2, true>(lds + RING_OFF, g, S, E, w0);
#ifndef PROBE_UPV
#define PROBE_UPV 4
#endif
                if (PROBE_DUP & 4096) { pg8::EpiUpT<true, PROBE_UPV> EP{f, t & 1}; pg8::gemm_phase<pg8::EpiUpT<true, PROBE_UPV>, pg8::StaticOrder, true, PG8_SP2, true>(lds + RING_OFF, g, S, EP, w0); }
                if (PROBE_DUP & 16) pg8::gemm_phase<pg8::EpiUp, pg8::StaticOrder, true, PG8_SP2, true>(lds + RING_OFF, g, S, E, w0);
                if (PROBE_DUP & 128) { pg8::EpiNull EN{(float*)(ws + WS_GATES)}; pg8::gemm_phase<pg8::EpiNull, pg8::StaticOrder, true, PG8_SP2, true>(lds + RING_OFF, g, S, EN, w0); }
            } else {
                if (kind == 2) {
                    pg8::Gemm g{R, (const bf16*)(ws + WS_WIN) + (size_t)j * NMI * D, M, OG_F8 ? 4096 : NMI, D}; pg8::StaticOrder S; S.init(M, OG_F8 ? 4096 : NMI, G, bid);
                    pg8::EpiLnOut E{1, j, t & 1};
                    pg8::gemm_phase<pg8::EpiLnOut, pg8::StaticOrder, true, PG8_SP2>(lds + RING_OFF, g, S, E, w0);
                    if (PROBE_DUP & 32) pg8::gemm_phase<pg8::EpiLnOut, pg8::StaticOrder, true, PG8_SP2>(lds + RING_OFF, g, S, E, w0);
                }
                if (kind == 1 || (kind == 2 && OG_F8)) {
                    const int N = kind == 1 ? NQKV : 2048;
                    pg8::Gemm g{(const bf16*)(ws + WS_R8), (const bf16*)(kind == 1 ? ws + WS_WQKV + (size_t)j * NQKV * D : ws + WS_WIN + ((size_t)j * NMI + 4096) * D * 2), M, N, D / 2}; pg8::StaticOrder S; S.init(M, N, G, bid);
                    pg8::EpiLnOut E{kind == 1 ? 0 : 2, j, t & 1};
                    pg8::gemm_phase<pg8::EpiLnOut, pg8::StaticOrder, true, PG8_SP2, true>(lds + RING_OFF, g, S, E, w0);
                    if (PROBE_DUP & 32) pg8::gemm_phase<pg8::EpiLnOut, pg8::StaticOrder, true, PG8_SP2, true>(lds + RING_OFF, g, S, E, w0);
                }
                if (kind == 2) {
                    gates_phase(lds, R, sp_in, (const bf16*)(vec + V_WG / 4) + (size_t)j * 8 * D, vec + V_CG / 4 + j * 16, (float*)(ws + WS_GATES), ng, gx, gy, Gy, w0);
                    if (PROBE_DUP & 8) { WG_BAR(); gates_phase(lds, R, sp_in, (const bf16*)(vec + V_WG / 4) + (size_t)j * 8 * D, vec + V_CG / 4 + j * 16, (float*)(ws + WS_GATES), ng, gx, gy, Gy, w0); }
                }
            }
        }
        LAYER_BAR();
        if (kind == 1) {
            if (!SKIP_ATT) { kargs_t ka = kargs(); unsigned char* ws = ka->ws; attn_phase(lds_raw, (const bf16*)(ws + WS_QKV), ws + WS_AO, ka->sinks + j * 32, ng, gx, gy, Gy, w0);
                if (PROBE_DUP & 2) attn_phase(lds_raw, (const bf16*)(ws + WS_QKV), ws + WS_AO, ka->sinks + j * 32, ng, gx, gy, Gy, w0); }
            LAYER_BAR();
        } else if (kind == 2) {
            if (!SKIP_MLSTM) { unsigned char* ws = kargs()->ws; mlstm_phase(lds_raw, (const bf16*)(ws + WS_MP), (const float*)(ws + WS_GATES), (bf16*)(ws + WS_HG), ng, gx, gy, Gy, w0);
                if (PROBE_DUP & 4) mlstm_phase<PROBE_MLV>(lds_raw, (const bf16*)(ws + WS_MP), (const float*)(ws + WS_GATES), (bf16*)(ws + WS_H), ng, gx, gy, Gy, w0); }
            LAYER_BAR();
        }
        {
            kargs_t ka = kargs(); unsigned char* ws = ka->ws;
            float coef = kind == 0 ? 0.5f / (pg8::F8_SH * pg8::F8_SW) : (kind == 1 ? 1.f / (pg8::F8_SO * pg8::F8_SW) : 1.f);
            if ((kind == 1 && SKIP_ATT) || (kind == 2 && SKIP_MLSTM)) coef = 0.f;
            pg8::StaticOrder S; S.init(M, D, G, bid);
            pg8::EpiRes E{t, coef, (LAS float*)(lds + TAB_OFF), w0, 0};
            if (kind != 2) {
                const int f = 2 * layer + (sub >> 1);
                pg8::Gemm g{(const bf16*)(ws + (kind == 0 ? WS_H : WS_AO)), (const bf16*)(kind == 0 ? ws + WS_W2 + (size_t)f * D * FF : ws + WS_WO + (size_t)j * D * D), M, D, kind == 0 ? FF / 2 : D / 2};
                if (PROBE_DUP & 64) { pg8::EpiNull EN{(float*)(ws + WS_GATES)}; pg8::gemm_phase<pg8::EpiNull, pg8::StaticOrder, true, PG8_SP2, true>(lds + RING_OFF, g, S, EN, w0); }
                if (PROBE_DUP & 512) { pg8::EpiRes ED{t, coef, (LAS float*)(lds + TAB_OFF), w0, PROBE_DRY}; pg8::gemm_phase<pg8::EpiRes, pg8::StaticOrder, true, PG8_SP2, true>(lds + RING_OFF, g, S, ED, w0); }
                pg8::gemm_phase<pg8::EpiRes, pg8::StaticOrder, true, PG8_SP2, true>(lds + RING_OFF, g, S, E, w0);
            } else {
                pg8::Gemm g{(const bf16*)(ws + WS_HG), (const bf16*)(ws + WS_WMO) + (size_t)j * D * D, M, D, D};
                if (PROBE_DUP & 256) { pg8::EpiNull EN{(float*)(ws + WS_GATES)}; pg8::gemm_phase<pg8::EpiNull, pg8::StaticOrder, true, PG8_SP2, false>(lds + RING_OFF, g, S, EN, w0); }
                pg8::gemm_phase<pg8::EpiRes, pg8::StaticOrder, true, PG8_SP2, false>(lds + RING_OFF, g, S, E, w0);
            }
        }
        LAYER_BAR();
    }
    {
        kargs_t ka = kargs(); unsigned char* ws = ka->ws;
        const int ng = grouped ? 8 : 1, gx = bid % ng, gy = bid / ng, Gy = G / ng;
        final_ln((const bf16*)(ws + WS_R), (const float*)(ws + WS_SP), ka->ln_g + (size_t)(3 * DEPTH - 1) * D, ka->ln_b + (size_t)(3 * DEPTH - 1) * D, ka->out, ng, gx, gy * NWAVES + w0, Gy * NWAVES, pg8::pg8_lane());
    }
}

extern "C" void kernel_launch(void* const* d_in, const int* in_sizes, int n_in, void* d_out, int out_size, void* d_ws, size_t ws_size, hipStream_t stream) {
    static int grid = 0;
    if (grid == 0) {
        if (n_in != 12 || in_sizes[0] != M * D || out_size != M * D || ws_size < WS_END) { fprintf(stderr, "kernel_launch: unexpected shapes / workspace (n_in %d, ws %zu < %zu); nothing launched\n", n_in, ws_size, (size_t)WS_END); grid = -1; return; }
        int dev = 0, cus = 0;
        if (hipGetDevice(&dev) != hipSuccess || hipDeviceGetAttribute(&cus, hipDeviceAttributeMultiprocessorCount, dev) != hipSuccess) { grid = -1; return; }
        if (hipFuncSetAttribute((const void*)fwd_kernel, hipFuncAttributeMaxDynamicSharedMemorySize, LDS_BYTES) != hipSuccess) { fprintf(stderr, "kernel_launch: hipFuncSetAttribute failed\n"); grid = -1; return; }
        int per_cu = 0;
        if (hipOccupancyMaxActiveBlocksPerMultiprocessor(&per_cu, (const void*)fwd_kernel, NWAVES * 64, LDS_BYTES) != hipSuccess || per_cu < 1) { fprintf(stderr, "kernel_launch: occupancy query says %d\n", per_cu); }
        (void)hipGetLastError();
        grid = cus;
#ifdef FORCE_GRID
        grid = FORCE_GRID;
#endif
    }
    if (grid < 0) return;
    (void)hipMemsetAsync((char*)d_ws + WS_CTL, 0, CTL_ZERO_BYTES, stream);
    Args a{};
    a.x = (const float*)d_in[0]; a.w1 = (const float*)d_in[1]; a.w3 = (const float*)d_in[2]; a.w2 = (const float*)d_in[3]; a.ln_g = (const float*)d_in[4]; a.ln_b = (const float*)d_in[5];
    a.wqkv = (const float*)d_in[6]; a.sinks = (const float*)d_in[7]; a.wo = (const float*)d_in[8]; a.win = (const float*)d_in[9]; a.bg = (const float*)d_in[10]; a.wmo = (const float*)d_in[11];
    a.out = (float*)d_out; a.ws = (unsigned char*)d_ws;
    hipLaunchKernelGGL(fwd_kernel, dim3(grid), dim3(NWAVES * 64), LDS_BYTES, stream, a);
}
```

```cpp
#include <hip/hip_runtime.h>
#include <hip/hip_bf16.h>
#include <cstdio>
#include <cstdint>
#include <cmath>

constexpr int BATCH = 8, SEQ = 2048, D = 2048, FF = 5632, DEPTH = 4;
constexpr int M = BATCH * SEQ;
constexpr int NUP = 2 * FF;
constexpr int NQKV = 2560;
constexpr int NMI = 6144, NMIW = 6152;
constexpr float LN_EPS = 1e-5f;
constexpr float ALPHA = 1.681792830507429f;
constexpr float LOG2E = 1.4426950408889634f;

constexpr size_t MiB = 1u << 20;
constexpr size_t WS_CTL = 0, CTL_ZERO_BYTES = 192 * 1024;
constexpr size_t WS_W13 = 2 * MiB;
constexpr size_t WS_W2 = 178 * MiB;
constexpr size_t WS_WQKV = 266 * MiB;
constexpr size_t WS_WO = 286 * MiB;
constexpr size_t WS_WIN = 302 * MiB;
constexpr size_t WS_WMO = 350 * MiB;
constexpr size_t WS_VEC = 366 * MiB;
constexpr size_t V_C1U = 0, V_C2U = 360448, V_C1Q = 720896, V_C2Q = 741376, V_C1I = 761856, V_C2I = 811008, V_CG = 860160, V_WG = 860416, V_ONES = 991488, V_ZEROS = 999680;
constexpr size_t WS_R = 368 * MiB;
constexpr size_t WS_R8 = 432 * MiB;
constexpr size_t WS_SP = 464 * MiB;
constexpr size_t SP_BYTES = (size_t)M * 16 * 4;
constexpr size_t WS_H = 466 * MiB;
constexpr size_t WS_QKV = 554 * MiB;
constexpr size_t WS_AO = 634 * MiB;
constexpr size_t WS_MP = 698 * MiB;
constexpr size_t WS_GATES = 890 * MiB;
constexpr size_t WS_HG = 891 * MiB;
constexpr size_t WS_END = 955 * MiB;
constexpr int CW_TMO = 0, CW_BAR = 4096;

struct Args { const float* x; const float* w1; const float* w3; const float* w2; const float* ln_g; const float* ln_b; const float* wqkv; const float* sinks; const float* wo;
              const float* win; const float* bg; const float* wmo; float* out; unsigned char* ws; };
typedef const __attribute__((address_space(4))) Args* kargs_t;
__device__ __forceinline__ kargs_t kargs() { kargs_t p = (kargs_t)__builtin_amdgcn_kernarg_segment_ptr(); asm volatile("" : "+s"(p)); return p; }

namespace pg8 {
#define PG8_LAS __attribute__((address_space(3)))
typedef unsigned short bf16_t;
typedef short bf16x8 __attribute__((ext_vector_type(8)));
typedef _Float16 f16x8 __attribute__((ext_vector_type(8)));
typedef float f32x4 __attribute__((ext_vector_type(4)));
typedef unsigned u32x4 __attribute__((ext_vector_type(4)));
constexpr int BM = 256, BK = 64, HALF = 128, HTB = HALF * BK * 2  , STAGE_BYTES = 8 * HTB, NXCD = 8, WGM = 8;

__host__ __device__ __forceinline__ int lds_byte(int r, int c) { const int st = (r >> 4) * 2 + (c >> 5), rr = r & 15, cc = c & 31, ob = rr * 64 + cc * 2; return st * 1024 + (ob ^ (((ob >> 9) & 1) << 5)); }
__host__ __device__ __forceinline__ void stage_rc(int b, int& R, int& C) { const int st = b / 1024, sb = b % 1024, swz = sb ^ (((sb >> 9) & 1) << 5); R = (st >> 1) * 16 + swz / 64; C = (st & 1) * 32 + (swz % 64) / 2; }
__host__ __device__ __forceinline__ int perm32(int rho) { const int n = rho >> 4, i = rho & 15; return 8 * (i >> 2) + 4 * n + (i & 3); }

typedef int i32x4 __attribute__((ext_vector_type(4)));
typedef int i32x8 __attribute__((ext_vector_type(8)));
constexpr float F8_SR = 8.f, F8_SW = 1024.f, F8_SH = 16.f, F8_SO = 64.f;
__device__ __forceinline__ i32x8 cat_i8(bf16x8 lo, bf16x8 hi) { const i32x4 a = __builtin_bit_cast(i32x4, lo), b = __builtin_bit_cast(i32x4, hi); return __builtin_shufflevector(a, b, 0, 1, 2, 3, 4, 5, 6, 7); }
__device__ __forceinline__ void mfma_f8_zero(f32x4& c, const i32x8 a, const i32x8 b) { asm volatile("v_mfma_f32_16x16x128_f8f6f4 %0, %1, %2, 0 cbsz:0 blgp:0" : "=&v"(c) : "v"(a), "v"(b)); }
__device__ __forceinline__ void mfma_f8_inplace(f32x4& c, const i32x8 a, const i32x8 b) { asm volatile("v_mfma_f32_16x16x128_f8f6f4 %0, %1, %2, %0 cbsz:0 blgp:0" : "+v"(c) : "v"(a), "v"(b)); }
typedef unsigned u32x2 __attribute__((ext_vector_type(2)));
__device__ __forceinline__ u32x2 cvt8_f8(const float (&v)[8], float s) {
    int a, b; asm volatile("" : "=v"(a), "=v"(b));
    a = __builtin_amdgcn_cvt_pk_fp8_f32(v[0] * s, v[1] * s, a, false); a = __builtin_amdgcn_cvt_pk_fp8_f32(v[2] * s, v[3] * s, a, true);
    b = __builtin_amdgcn_cvt_pk_fp8_f32(v[4] * s, v[5] * s, b, false); b = __builtin_amdgcn_cvt_pk_fp8_f32(v[6] * s, v[7] * s, b, true);
    return (u32x2){(unsigned)a, (unsigned)b};
}
__device__ __forceinline__ u32x2 cvt8_f8_raw(const float (&v)[8]) {
    int a, b; asm volatile("" : "=v"(a), "=v"(b));
    a = __builtin_amdgcn_cvt_pk_fp8_f32(v[0], v[1], a, false); a = __builtin_amdgcn_cvt_pk_fp8_f32(v[2], v[3], a, true);
    b = __builtin_amdgcn_cvt_pk_fp8_f32(v[4], v[5], b, false); b = __builtin_amdgcn_cvt_pk_fp8_f32(v[6], v[7], b, true);
    return (u32x2){(unsigned)a, (unsigned)b};
}
__device__ __forceinline__ int pg8_lane() { int l; asm volatile("v_mbcnt_lo_u32_b32 %0, -1, 0\n\tv_mbcnt_hi_u32_b32 %0, -1, %0" : "=v"(l)); return l; }
struct Unit { int pm, pn, ord; };
struct Gemm { const bf16_t* A; const bf16_t* Bt; int M, N, K; };

struct StaticOrder {
    int nM, nN, nwg, G, c, r0 = 0, r1 = 1 << 20;
    __host__ __device__ void init(int M_, int N_, int G_, int c_) { nM = M_ / BM; nN = N_ / BM; nwg = nM * nN; G = G_; c = c_; }
    __host__ __device__ bool next(int i, Unit& u) const {
        i += r0; if (i >= r1) return false;
        const long L = (long)i * G + c; if (L >= nwg) return false;
        int wgid = (int)L; { const int q = nwg / NXCD, r = nwg % NXCD, xcd = wgid % NXCD, off = wgid / NXCD; wgid = (xcd < r ? xcd * (q + 1) : r * (q + 1) + (xcd - r) * q) + off; }
        const int nig = WGM * nN, gid = wgid / nig, fm = gid * WGM, gsz = (nM - fm) < WGM ? (nM - fm) : WGM;
        u.pm = fm + ((wgid % nig) % gsz); u.pn = (wgid % nig) / gsz; u.ord = i - r0; return true;
    }
    __device__ __forceinline__ void a_ready(const Unit&) const {}
    __device__ __forceinline__ void done(const Unit&) const {}
};

__device__ __forceinline__ unsigned cvt_pk_bf16(float lo, float hi) { typedef float f2 __attribute__((ext_vector_type(2))); typedef _Float16 b2 __attribute__((ext_vector_type(2))); f2 v = {lo, hi}; b2 b = __builtin_convertvector(v, b2); return __builtin_bit_cast(unsigned, b); }
__device__ __forceinline__ float bf_lo(unsigned w) { typedef _Float16 b2 __attribute__((ext_vector_type(2))); return (float)__builtin_bit_cast(b2, w)[0]; }
__device__ __forceinline__ float bf_hi(unsigned w) { typedef _Float16 b2 __attribute__((ext_vector_type(2))); return (float)__builtin_bit_cast(b2, w)[1]; }
__device__ __forceinline__ float fsigmoid(float x) { return __builtin_amdgcn_rcpf(1.f + __builtin_amdgcn_exp2f(-LOG2E * x)); }

__device__ __forceinline__ float sum_fq(float v) {
    auto a = __builtin_amdgcn_permlane16_swap(__float_as_uint(v), __float_as_uint(v), false, false); v = __uint_as_float(a[0]) + __uint_as_float(a[1]);
    auto b = __builtin_amdgcn_permlane32_swap(__float_as_uint(v), __float_as_uint(v), false, false); return __uint_as_float(b[0]) + __uint_as_float(b[1]);
}
constexpr int STAB_OFF = 131072 + 16384;
__device__ __forceinline__ void stats_prep(const float* sp, int pm, int wave) {
    PG8_LAS float* stab = (PG8_LAS float*)(STAB_OFF);
    const int tid = wave * 64 + pg8_lane();
    if (tid < BM) {
        const f32x4* p = (const f32x4*)(sp + (size_t)(pm * BM + tid) * 16);
        const f32x4 v0 = p[0], v1 = p[1], v2 = p[2], v3 = p[3];
        const float s = ((v0[0] + v0[2]) + (v1[0] + v1[2])) + ((v2[0] + v2[2]) + (v3[0] + v3[2])), q = ((v0[1] + v0[3]) + (v1[1] + v1[3])) + ((v2[1] + v2[3]) + (v3[1] + v3[3]));
        const float mean = s * (1.f / D), var = q * (1.f / D) - mean * mean;
        typedef float f32x2v __attribute__((ext_vector_type(2)));
        *(PG8_LAS f32x2v*)(stab + 2 * tid) = (f32x2v){mean, __builtin_amdgcn_rsqf(var + LN_EPS)};
    }
    if (tid == 0) *(PG8_LAS int*)(stab + 2 * BM) = pm;
}
constexpr int CTAB_OFF = STAB_OFF + 2048 + 64, CTAB_UNITS = 11;
template <class Sched> __device__ __forceinline__ void ctab_prep(const Sched& S, const float* c1, const float* c2, int wave, float s_lo, float s_hi) {
    const int tid = wave * 64 + pg8_lane();
    const float sc = (tid & HALF) ? s_hi : s_lo;
    float v[CTAB_UNITS];
#pragma unroll
    for (int i = 0; i < CTAB_UNITS; ++i) { Unit u; const int pn = S.next(i, u) ? u.pn : 0; v[i] = tid < BM ? c1[pn * BM + tid] : c2[pn * BM + tid - BM]; }
    typedef _Float16 h1;
#pragma unroll
    for (int i = 0; i < CTAB_UNITS; ++i) *(PG8_LAS h1*)(CTAB_OFF + i * 1024 + tid * 2) = (h1)(v[i] * sc);
}
__device__ __forceinline__ void ctab_get8(int ord, int which, int lc, float (&o)[8]) {
    typedef _Float16 h8 __attribute__((ext_vector_type(8)));
    const h8 v = *(PG8_LAS const h8*)(CTAB_OFF + ord * 1024 + which * 512 + lc * 2);
#pragma unroll
    for (int i = 0; i < 8; ++i) o[i] = (float)v[i];
}
__device__ __forceinline__ void row_stats(const float* sp, int row0, int fq, float (&mu)[2][4], float (&rs)[2][4]) {
    { PG8_LAS const float* stab = (PG8_LAS const float*)(STAB_OFF); const int pm = row0 / BM;
      if (*(PG8_LAS const int*)(stab + 2 * BM) == pm) {
          typedef float f32x2v __attribute__((ext_vector_type(2)));
#pragma unroll
          for (int ai = 0; ai < 2; ++ai)
#pragma unroll
              for (int m = 0; m < 4; ++m) { const f32x2v v = *(PG8_LAS const f32x2v*)(stab + 2 * ((row0 % BM) + ai * HALF + m * 16)); mu[ai][m] = v[0]; rs[ai][m] = v[1]; }
          return; } }
#pragma unroll
    for (int ai = 0; ai < 2; ++ai)
#pragma unroll
        for (int m = 0; m < 4; ++m) {
            const f32x4 v = *(const f32x4*)(sp + (size_t)(row0 + ai * HALF + m * 16) * 16 + fq * 4);
            float s = v[0] + v[2], q = v[1] + v[3];
            s = sum_fq(s); q = sum_fq(q);
            const float mean = s * (1.f / D), var = q * (1.f / D) - mean * mean;
            mu[ai][m] = mean; rs[ai][m] = __builtin_amdgcn_rsqf(var + LN_EPS);
        }
}

struct EpiNull {
    static constexpr bool PERM = true, AFTER_DRAIN = false; static constexpr int MIN_VM_OPS = 0;
    template <class Sched> __device__ __forceinline__ void prep(const Sched&, const Unit&, int) const {}
    float* sink;
    __device__ __forceinline__ void operator()(const f32x4 (&acc)[2][2][4][2], const Unit& u, int wr, int wc, int, int) const {
        float s = 0.f;
#pragma unroll
        for (int ai = 0; ai < 2; ++ai)
#pragma unroll
            for (int bj = 0; bj < 2; ++bj)
#pragma unroll
                for (int m = 0; m < 4; ++m)
#pragma unroll
                    for (int n = 0; n < 2; ++n) s += acc[ai][bj][m][n][0] + acc[ai][bj][m][n][1] + acc[ai][bj][m][n][2] + acc[ai][bj][m][n][3];
        if (s == 123.456f) sink[u.pm + wr + wc] = s;
    }
};

template <bool TAB, int PRB = 0, bool STG = false> struct EpiUpT {
    static constexpr bool PERM = true, AFTER_DRAIN = false; static constexpr int MIN_VM_OPS = 4;
    static constexpr float CG = -LOG2E, CU = -F8_SH / LOG2E;
    template <class Sched> __device__ __forceinline__ void prep(const Sched& S, const Unit& u, int wave) const { unsigned char* ws = kargs()->ws;
        stats_prep((const float*)(ws + WS_SP) + (size_t)tpar * (SP_BYTES / 4), u.pm, wave);
        ctab_prep(S, (const float*)(ws + WS_VEC + V_C1U) + (size_t)f * NUP, (const float*)(ws + WS_VEC + V_C2U) + (size_t)f * NUP, wave, CG, CU); }
    int f, tpar;
    __device__ __forceinline__ void operator()(const f32x4 (&acc)[2][2][4][2], const Unit& u, int wr, int wc, int, int) const {
        const int lane_ = pg8_lane(), fr = lane_ & 15, fq = lane_ >> 4;
        const int row0 = u.pm * BM + wr * 64 + fr;
        int f = this->f, tpar = this->tpar; asm volatile("" : "+s"(f), "+s"(tpar));
        unsigned char* ws = kargs()->ws; unsigned char* H = ws + ((PRB & 4) ? WS_MP : WS_H);
        float mu[2][4], rs[2][4];
        float k1[2][8], k2[2][8];
        if constexpr (TAB) {
            typedef float f32x2v __attribute__((ext_vector_type(2))); PG8_LAS const float* stab = (PG8_LAS const float*)(STAB_OFF);
#pragma unroll
            for (int ai = 0; ai < 2; ++ai)
#pragma unroll
                for (int m = 0; m < 4; ++m) { const f32x2v v = *(PG8_LAS const f32x2v*)(stab + 2 * ((row0 % BM) + ai * HALF + m * 16)); mu[ai][m] = v[0]; rs[ai][m] = v[1]; }
#pragma unroll
            for (int bj = 0; bj < 2; ++bj) { ctab_get8(u.ord, 0, wc * 32 + 8 * fq + bj * HALF, k1[bj]); ctab_get8(u.ord, 1, wc * 32 + 8 * fq + bj * HALF, k2[bj]); }
        } else {
            const float* c1 = (const float*)(ws + WS_VEC + V_C1U) + (size_t)f * NUP; const float* c2 = (const float*)(ws + WS_VEC + V_C2U) + (size_t)f * NUP; const float* sp = (const float*)(ws + WS_SP) + (size_t)tpar * (SP_BYTES / 4);
            row_stats(sp, row0, fq, mu, rs);
            const int cb = u.pn * BM + wc * 32 + 8 * fq;
            if (u.ord < CTAB_UNITS) {
#pragma unroll
                for (int bj = 0; bj < 2; ++bj) { ctab_get8(u.ord, 0, wc * 32 + 8 * fq + bj * HALF, k1[bj]); ctab_get8(u.ord, 1, wc * 32 + 8 * fq + bj * HALF, k2[bj]); }
            } else {
#pragma unroll
                for (int bj = 0; bj < 2; ++bj)
#pragma unroll
                    for (int i = 0; i < 8; ++i) { k1[bj][i] = c1[cb + bj * HALF + i] * (bj ? CU : CG); k2[bj][i] = c2[cb + bj * HALF + i] * (bj ? CU : CG); }
            }
        }
        unsigned char* hp = H + (size_t)(row0 + (fq & 1) * 16) * FF + u.pn * HALF + wc * 32 + 8 * (fq & 2);
        u32x2 keep = {0u, 0u};
        const unsigned st_w = (unsigned)(131072 + (wr * 64 + fr) * 128 + (((wc * 2 + (fq >> 1)) ^ ((fr >> 1) & 7)) * 16) + 8 * (fq & 1));
        const int st_rr = (wr * 4 + wc) * 16 + (lane_ >> 3), st_ch = lane_ & 7;
        const unsigned st_r = (unsigned)(131072 + st_rr * 128 + ((st_ch ^ ((st_rr >> 1) & 7)) * 16));
        unsigned char* hp_s = H + (size_t)(u.pm * BM + st_rr) * FF + u.pn * HALF + st_ch * 16;
#pragma unroll
        for (int ai = 0; ai < 2; ++ai) {
            if constexpr (STG) { if (ai == 1) { asm volatile("s_waitcnt lgkmcnt(0)" ::: "memory"); __builtin_amdgcn_s_barrier(); asm volatile("" ::: "memory"); } }
#pragma unroll
            for (int m = 0; m < 4; ++m) {
                const float r_ = rs[ai][m], nm = -mu[ai][m] * r_, ra = r_ * (1.f / (F8_SR * F8_SW)), raG = ra * CG, raU = ra * CU;
                typedef float f2 __attribute__((ext_vector_type(2)));
                f2 ga[4], ub[4], sg[4];
#pragma unroll
                for (int n = 0; n < 2; ++n)
#pragma unroll
                    for (int jj = 0; jj < 2; ++jj) {
                        const int c = 4 * n + 2 * jj;
                        const f2 ag = {acc[ai][0][m][n][2 * jj], acc[ai][0][m][n][2 * jj + 1]}, au = {acc[ai][1][m][n][2 * jj], acc[ai][1][m][n][2 * jj + 1]};
                        const f2 k1g = {k1[0][c], k1[0][c + 1]}, k2g = {k2[0][c], k2[0][c + 1]}, k1u = {k1[1][c], k1[1][c + 1]}, k2u = {k2[1][c], k2[1][c + 1]};
                        ga[2 * n + jj] = ag * raG + (k1g * nm + k2g);
                        ub[2 * n + jj] = au * raU + (k1u * nm + k2u);
                    }
#pragma unroll
                for (int i = 0; i < 4; ++i) sg[i] = (PRB & 1) ? ga[i] : (f2){__builtin_amdgcn_exp2f(ga[i][0]), __builtin_amdgcn_exp2f(ga[i][1])};
#pragma unroll
                for (int i = 0; i < 4; ++i) { const f2 t = sg[i] + 1.f; sg[i] = (PRB & 1) ? t : (f2){__builtin_amdgcn_rcpf(t[0]), __builtin_amdgcn_rcpf(t[1])}; }
                float hv[8];
#pragma unroll
                for (int i = 0; i < 4; ++i) { const f2 h2 = ga[i] * sg[i] * ub[i]; hv[2 * i] = h2[0]; hv[2 * i + 1] = h2[1]; }
                const u32x2 xb = cvt8_f8_raw(hv);
                if constexpr (STG) { *(PG8_LAS u32x2*)(st_w + m * 2048) = xb; }
                else if ((m & 1) == 0) keep = xb;
                else {
                    const auto s0 = __builtin_amdgcn_permlane16_swap(keep.x, xb.x, false, false), s1 = __builtin_amdgcn_permlane16_swap(keep.y, xb.y, false, false);
                    if (!(PRB & 2) || ((hv[0] + hv[1]) + (hv[2] + hv[3])) + ((hv[4] + hv[5]) + (hv[6] + hv[7])) == 123.456f) *(u32x4*)(hp + (size_t)(ai * HALF + (m - 1) * 16) * FF) = (u32x4){s0[0], s1[0], s0[1], s1[1]};
                }
            }
            if constexpr (STG) {
                asm volatile("s_waitcnt lgkmcnt(0)" ::: "memory"); __builtin_amdgcn_s_barrier(); asm volatile("" ::: "memory");
                const u32x4 o0 = *(PG8_LAS const u32x4*)(st_r), o1 = *(PG8_LAS const u32x4*)((st_r + 1024) ^ 64u);
                *(u32x4*)(hp_s + (size_t)(ai * HALF) * FF) = o0; *(u32x4*)(hp_s + (size_t)(ai * HALF + 8) * FF) = o1;
            }
        }
    }
};
typedef EpiUpT<false> EpiUp;

struct EpiLnOut {
    static constexpr bool PERM = true, AFTER_DRAIN = false; static constexpr int MIN_VM_OPS = 0 * 16;
    template <class Sched> __device__ __forceinline__ void prep(const Sched&, const Unit& u, int wave) const { stats_prep((const float*)(kargs()->ws + WS_SP) + (size_t)tpar * (SP_BYTES / 4), u.pm, wave); }
    int mode, j, tpar;
    __device__ __forceinline__ void operator()(const f32x4 (&acc)[2][2][4][2], const Unit& u, int wr, int wc, int, int) const {
        const int lane_ = pg8_lane(), fr = lane_ & 15, fq = lane_ >> 4;
        const int row0 = u.pm * BM + wr * 64 + fr;
        int mode = this->mode, j = this->j, tpar = this->tpar; asm volatile("" : "+s"(mode), "+s"(j), "+s"(tpar));
        const bool att = mode == 0; const int coff = mode == 2 ? 4096 : 0;
        unsigned char* ws = kargs()->ws; bf16_t* O = (bf16_t*)(ws + (att ? WS_QKV : WS_MP)) + coff; const int ldo = att ? NQKV : NMI, sig_from = mode == 2 ? 0 : (mode == 1 ? 16 : 1000);
        const float ascale = mode == 1 ? 1.f : 1.f / (F8_SR * F8_SW);
        const float* c1 = (const float*)(ws + WS_VEC + (att ? V_C1Q : V_C1I)) + j * ldo + coff; const float* c2 = (const float*)(ws + WS_VEC + (att ? V_C2Q : V_C2I)) + j * ldo + coff; const float* sp = (const float*)(ws + WS_SP) + (size_t)tpar * (SP_BYTES / 4);
        float mu[2][4], rs[2][4]; row_stats(sp, row0, fq, mu, rs);
        const int cb = u.pn * BM + wc * 32 + 8 * fq;
        const bool sg = u.pn >= sig_from;
        f32x4 k1[2][2], k2[2][2];
#pragma unroll
        for (int bj = 0; bj < 2; ++bj)
#pragma unroll
            for (int n = 0; n < 2; ++n) { k1[bj][n] = *(const f32x4*)(c1 + cb + bj * HALF + 4 * n); k2[bj][n] = *(const f32x4*)(c2 + cb + bj * HALF + 4 * n); }
        bf16_t* op = O + (size_t)row0 * ldo + cb;
#define LNOUT_ROWS(SIG) _Pragma("unroll") for (int ai = 0; ai < 2; ++ai) _Pragma("unroll") for (int m = 0; m < 4; ++m) { \
            const float r_ = rs[ai][m], nm = -mu[ai][m] * r_, ra = r_ * ascale; \
            _Pragma("unroll") for (int bj = 0; bj < 2; ++bj) { \
                typedef float f2 __attribute__((ext_vector_type(2))); float v[8]; \
                _Pragma("unroll") for (int n = 0; n < 2; ++n) _Pragma("unroll") for (int jj = 0; jj < 2; ++jj) { \
                    const f2 a2 = {acc[ai][bj][m][n][2 * jj], acc[ai][bj][m][n][2 * jj + 1]}, c1v = {k1[bj][n][2 * jj], k1[bj][n][2 * jj + 1]}, c2v = {k2[bj][n][2 * jj], k2[bj][n][2 * jj + 1]}; \
                    f2 t = a2 * ra + (c1v * nm + c2v); \
                    if (SIG) { const f2 e = t * (-LOG2E); const f2 d = (f2){__builtin_amdgcn_exp2f(e[0]), __builtin_amdgcn_exp2f(e[1])} + 1.f; t = (f2){__builtin_amdgcn_rcpf(d[0]), __builtin_amdgcn_rcpf(d[1])}; } \
                    v[4 * n + 2 * jj] = t[0]; v[4 * n + 2 * jj + 1] = t[1]; } \
                u32x4 w; w.x = cvt_pk_bf16(v[0], v[1]); w.y = cvt_pk_bf16(v[2], v[3]); w.z = cvt_pk_bf16(v[4], v[5]); w.w = cvt_pk_bf16(v[6], v[7]); \
                *(u32x4*)(op + (size_t)(ai * HALF + m * 16) * ldo + bj * HALF) = w; } }
        const int sgi = __builtin_amdgcn_readfirstlane(sg ? 1 : 0);
        if (sgi) { LNOUT_ROWS(true) } else { LNOUT_ROWS(false) }
#undef LNOUT_ROWS
    }
};

#ifndef OG_F8
#define OG_F8 1
#endif
#define OG_F8_ OG_F8
struct EpiRes {
    static constexpr bool PERM = true, AFTER_DRAIN = false; static constexpr int MIN_VM_OPS = 0 * 32;
    template <class Sched> __device__ __forceinline__ void prep(const Sched&, const Unit& u, int wave) const { stats_prep((const float*)(kargs()->ws + WS_SP) + (size_t)(t & 1) * (SP_BYTES / 4), u.pm, wave); }
    int t; float coef; PG8_LAS float* tab; int wave; int dry;
    __device__ __forceinline__ void operator()(const f32x4 (&acc)[2][2][4][2], const Unit& u, int wr, int wc, int, int) const {
        const int lane_ = pg8_lane(), fr = lane_ & 15, fq = lane_ >> 4;
        typedef float f32x2v __attribute__((ext_vector_type(2)));
        const int row0 = u.pm * BM + wr * 64 + fr;
        int t = this->t; asm volatile("" : "+s"(t)); float coef = this->coef; asm volatile("" : "+v"(coef));
        const bool need8 = (t != 11 && (OG_F8_ || (t != 3 && t != 9))) || dry;
        kargs_t ka = kargs(); unsigned char* ws = ka->ws; bf16_t* R = (bf16_t*)(ws + WS_R); unsigned char* R8 = ws + (dry ? WS_MP + 64 * MiB : WS_R8); bf16_t* Ro = dry ? (bf16_t*)(ws + WS_MP) : R;
        const float* g = t ? ka->ln_g + (size_t)(t - 1) * D : (const float*)(ws + WS_VEC + V_ONES); const float* b = t ? ka->ln_b + (size_t)(t - 1) * D : (const float*)(ws + WS_VEC + V_ZEROS);
        const float* sp_in = (const float*)(ws + WS_SP) + (size_t)(t & 1) * (SP_BYTES / 4); float* sp_out = dry ? (float*)(ws + WS_MP + 96 * MiB) : (float*)(ws + WS_SP) + (size_t)((t + 1) & 1) * (SP_BYTES / 4);
        const int cb0 = u.pn * BM + wc * 32 + 8 * fq;
        u32x4 cur[4];
#pragma unroll
        for (int m = 0; m < 4; ++m) cur[m] = *(const u32x4*)(R + (size_t)(row0 + m * 16) * D + cb0);
        float mu[2][4], rs[2][4]; row_stats(sp_in, row0, fq, mu, rs);
        f32x4 gv[2], bv[2];
#pragma unroll
        for (int k = 0; k < 4; ++k) {
            const int bj = k >> 1, ai = k & 1, cb = cb0 + bj * HALF;
            if (ai == 0) {
#pragma unroll
                for (int n = 0; n < 2; ++n) { gv[n] = *(const f32x4*)(g + cb + 4 * n); bv[n] = *(const f32x4*)(b + cb + 4 * n) * ALPHA; }
            }
#pragma unroll
            for (int m = 0; m < 4; ++m) {
                const float A_ = ALPHA * rs[ai][m], B_ = -mu[ai][m] * A_;
                const size_t off = (size_t)(row0 + ai * HALF + m * 16) * D + cb;
                const u32x4 o = cur[m];
                if (k < 3 && dry != 3) cur[m] = *(const u32x4*)(R + (size_t)(row0 + ((k + 1) & 1) * HALF + m * 16) * D + cb0 + ((k + 1) >> 1) * HALF);
                typedef float fv2 __attribute__((ext_vector_type(2)));
                float nv[8];
#pragma unroll
                for (int n = 0; n < 2; ++n)
#pragma unroll
                    for (int jj = 0; jj < 2; ++jj) {
                        const unsigned w2 = n == 0 ? (jj == 0 ? o.x : o.y) : (jj == 0 ? o.z : o.w); const fv2 r2 = {bf_lo(w2), bf_hi(w2)}, a2 = {acc[ai][bj][m][n][2 * jj], acc[ai][bj][m][n][2 * jj + 1]};
                        const fv2 g2 = {gv[n][2 * jj], gv[n][2 * jj + 1]}, b2 = {bv[n][2 * jj], bv[n][2 * jj + 1]};
                        const fv2 t = (r2 * A_ + B_) * g2 + (a2 * coef + b2);
                        nv[4 * n + 2 * jj] = t[0]; nv[4 * n + 2 * jj + 1] = t[1];
                    }
                u32x4 w; w.x = cvt_pk_bf16(nv[0], nv[1]); w.y = cvt_pk_bf16(nv[2], nv[3]); w.z = cvt_pk_bf16(nv[4], nv[5]); w.w = cvt_pk_bf16(nv[6], nv[7]);
                if (dry != 2) { *(u32x4*)(Ro + off) = w;
                if (need8) *(u32x2*)(R8 + off) = cvt8_f8(nv, F8_SR); }
                const float f0 = bf_lo(w.x), f1 = bf_hi(w.x), f2 = bf_lo(w.y), f3 = bf_hi(w.y), f4 = bf_lo(w.z), f5 = bf_hi(w.z), f6 = bf_lo(w.w), f7 = bf_hi(w.w);
                float s = ((f0 + f1) + (f2 + f3)) + ((f4 + f5) + (f6 + f7));
                float q = ((f0 * f0 + f1 * f1) + (f2 * f2 + f3 * f3)) + ((f4 * f4 + f5 * f5) + (f6 * f6 + f7 * f7));
                s = sum_fq(s); q = sum_fq(q);
                if (fq == 0) *(PG8_LAS f32x2v*)(tab + (((ai * HALF + wr * 64 + m * 16 + fr) * 4 + wc) * 2 + bj) * 2) = (f32x2v){s, q};
                asm volatile("" ::: "memory");
            }
        }
        asm volatile("s_waitcnt lgkmcnt(0)" ::: "memory"); __builtin_amdgcn_s_barrier(); asm volatile("" ::: "memory");
        const int tid = wave * 64 + pg8_lane();
        if (tid < BM) {
            const PG8_LAS f32x4* t4 = (const PG8_LAS f32x4*)(tab + tid * 16);
            const f32x4 a = t4[0], c = t4[1], d = t4[2], e = t4[3];
            *(f32x2v*)(sp_out + (size_t)(u.pm * BM + tid) * 16 + u.pn * 2) = (f32x2v){((a[0] + a[2]) + (c[0] + c[2])) + ((d[0] + d[2]) + (e[0] + e[2])), ((a[1] + a[3]) + (c[1] + c[3])) + ((d[1] + d[3]) + (e[1] + e[3]))};
        }
    }
};

#ifndef PG8_ZF_F8
#define PG8_ZF_F8 1
#endif
#ifndef PG8_ZF_F16
#define PG8_ZF_F16 0
#endif
template <class Epi, class Sched, bool ALIGN_EPI = false, bool SP2 = false, bool F8 = false>
__device__ __forceinline__ void gemm_phase(PG8_LAS unsigned char* lds, const Gemm g, const Sched& S, const Epi& E, int wave_in) {
    int wid = wave_in; asm volatile("" : "+s"(wid));
    const int lane = pg8_lane(), tid = wid * 64 + lane, wr = wid >> 2, wc = wid & 3, fr = lane & 15, fq = lane >> 4;
    const int K = g.K, nt = K / BK;
    unsigned voffA[2], voffB[2];
#pragma unroll
    for (int i = 0; i < 2; ++i) { int R, C; stage_rc(tid * 16 + i * 8192, R, C); const int Rb = Epi::PERM ? ((R & ~31) + perm32(R & 31)) : R;
        voffA[i] = (unsigned)(R * K + C) * 2u; voffB[i] = (unsigned)(Rb * K + C) * 2u; }
    const size_t kstep = (size_t)(BK * 2);
    const size_t hstep = (size_t)HALF * K * 2;
    const size_t tstep = 2 * hstep;
    const unsigned ldsw = (unsigned)wid * 1024u;
    const int aoff = lds_byte(wr * 64 + fr, fq * 8), boff = lds_byte(wc * 32 + fr, fq * 8);
#define PG8_SA(b, h) (((b) * 2 + (h)) * HTB)
#define PG8_SB(b, h) ((4 + (b) * 2 + (h)) * HTB)
#ifndef PG8_DMA_IN_MMA
#define PG8_DMA_IN_MMA 0
#endif
#ifndef PG8_B_AUX
#define PG8_B_AUX 0
#endif
#define PG8_STAGE_AUX(bufoff, gbase, voff, aux) do { _Pragma("unroll") for (int _i = 0; _i < 2; ++_i) \
        __builtin_amdgcn_global_load_lds((const unsigned*)((const char*)(gbase) + (voff)[_i]), (PG8_LAS unsigned*)(lds + (bufoff) + ldsw + _i * 8192), 16, 0, aux); } while (0)
#define PG8_STAGE(bufoff, gbase, voff) PG8_STAGE_AUX(bufoff, gbase, voff, PG8_IS_B(bufoff) ? PG8_B_AUX : 0)
#define PG8_IS_B(bufoff) ((bufoff) >= 4 * HTB)
#define PG8_LDA(dst, b, h) do { _Pragma("unroll") for (int m = 0; m < 4; ++m) _Pragma("unroll") for (int k = 0; k < 2; ++k) dst[m][k] = *(const PG8_LAS bf16x8*)(lds + PG8_SA(b, h) + aoff + m * 2048 + k * 1024); } while (0)
#define PG8_LDB(dst, b, h) do { _Pragma("unroll") for (int n = 0; n < 2; ++n) _Pragma("unroll") for (int k = 0; k < 2; ++k) dst[n][k] = *(const PG8_LAS bf16x8*)(lds + PG8_SB(b, h) + boff + n * 2048 + k * 1024); } while (0)
#define PG8_MMA(ai, bj, At, Bt) do { __builtin_amdgcn_s_setprio(1); _Pragma("unroll") for (int m = 0; m < 4; ++m) _Pragma("unroll") for (int n = 0; n < 2; ++n) { \
        if constexpr (F8) mfma_f8_inplace(acc[ai][bj][m][n], cat_i8(Bt[n][0], Bt[n][1]), cat_i8(At[m][0], At[m][1])); \
        else { _Pragma("unroll") for (int k = 0; k < 2; ++k) acc[ai][bj][m][n] = __builtin_amdgcn_mfma_f32_16x16x32_f16(__builtin_bit_cast(f16x8, Bt[n][k]), __builtin_bit_cast(f16x8, At[m][k]), acc[ai][bj][m][n], 0, 0, 0); } } \
        __builtin_amdgcn_s_setprio(0); } while (0)
#define PG8_MMAZ(ai, bj, At, Bt) do { __builtin_amdgcn_s_setprio(1); _Pragma("unroll") for (int m = 0; m < 4; ++m) _Pragma("unroll") for (int n = 0; n < 2; ++n) { \
        if constexpr (F8) mfma_f8_zero(acc[ai][bj][m][n], cat_i8(Bt[n][0], Bt[n][1]), cat_i8(At[m][0], At[m][1])); \
        else { acc[ai][bj][m][n] = __builtin_amdgcn_mfma_f32_16x16x32_f16(__builtin_bit_cast(f16x8, Bt[n][0]), __builtin_bit_cast(f16x8, At[m][0]), (f32x4){0.f, 0.f, 0.f, 0.f}, 0, 0, 0); \
               acc[ai][bj][m][n] = __builtin_amdgcn_mfma_f32_16x16x32_f16(__builtin_bit_cast(f16x8, Bt[n][1]), __builtin_bit_cast(f16x8, At[m][1]), acc[ai][bj][m][n], 0, 0, 0); } } \
        __builtin_amdgcn_s_setprio(0); } while (0)
#define PG8_WAIT_V(n) asm volatile("s_waitcnt vmcnt(" #n ")" ::: "memory")
#define PG8_WAIT_L(n) asm volatile("s_waitcnt lgkmcnt(" #n ")" ::: "memory")
#define PG8_WAIT_VN(n) asm volatile("s_waitcnt vmcnt(%0)" :: "n"(n) : "memory")
#define PG8_BAR __builtin_amdgcn_s_barrier()
#define PG8_SCHED __builtin_amdgcn_sched_barrier(0)
    constexpr bool ZF = SP2 && (F8 ? PG8_ZF_F8 : PG8_ZF_F16);
    Unit cur, nxt; int ui = 0;
    constexpr int NS = Epi::MIN_VM_OPS;
    if (!S.next(0, cur)) return;
    f32x4 acc[2][2][4][2];
    if constexpr (!ZF)
#pragma unroll
    for (int a = 0; a < 2; ++a)
#pragma unroll
        for (int b = 0; b < 2; ++b)
#pragma unroll
            for (int m = 0; m < 4; ++m)
#pragma unroll
                for (int n = 0; n < 2; ++n) { float z0, z1, z2, z3; asm volatile("v_mov_b32 %0, 0\n\tv_mov_b32 %1, 0\n\tv_mov_b32 %2, 0\n\tv_mov_b32 %3, 0" : "=v"(z0), "=v"(z1), "=v"(z2), "=v"(z3)); acc[a][b][m][n] = (f32x4){z0, z1, z2, z3}; }
    bf16x8 At[4][2], B0[2][2], B1[2][2];
    const char* cA = (const char*)g.A + (size_t)cur.pm * tstep; const char* cB = (const char*)g.Bt + (size_t)cur.pn * tstep;
    S.a_ready(cur);
    if constexpr (SP2) {
        PG8_STAGE(PG8_SB(0, 0), cB, voffB); PG8_STAGE(PG8_SB(0, 1), cB + hstep, voffB); PG8_STAGE(PG8_SA(0, 0), cA, voffA); PG8_STAGE(PG8_SA(0, 1), cA + hstep, voffA);
        E.prep(S, cur, wave_in);
        if (wr == 1) PG8_BAR;
        PG8_WAIT_V(2); PG8_BAR;
        PG8_STAGE(PG8_SB(1, 0), cB + kstep, voffB); PG8_STAGE(PG8_SA(1, 0), cA + kstep, voffA); PG8_STAGE(PG8_SB(1, 1), cB + hstep + kstep, voffB);
        PG8_WAIT_V(6); PG8_BAR;
    } else {
        PG8_STAGE(PG8_SB(0, 0), cB, voffB); PG8_STAGE(PG8_SA(0, 0), cA, voffA); PG8_STAGE(PG8_SB(0, 1), cB + hstep, voffB); PG8_STAGE(PG8_SA(0, 1), cA + hstep, voffA);
        E.prep(S, cur, wave_in);
        if (wr == 1) PG8_BAR;
        PG8_WAIT_V(4); PG8_BAR;
        PG8_STAGE(PG8_SB(1, 0), cB + kstep, voffB); PG8_STAGE(PG8_SA(1, 0), cA + kstep, voffA); PG8_STAGE(PG8_SB(1, 1), cB + hstep + kstep, voffB);
        PG8_WAIT_V(6); PG8_BAR;
    }
    for (;;) {
        const bool has_next = S.next(ui + 1, nxt);
        const char* nA = has_next ? (const char*)g.A + (size_t)nxt.pm * tstep : cA; const char* nB = has_next ? (const char*)g.Bt + (size_t)nxt.pn * tstep : cB;
        for (int t = 0; t < nt; t += 2) {
            const bool last = (t == nt - 2);
            const char* a1 = cA + (size_t)(t + 1) * kstep;
            const char* a2 = last ? nA : cA + (size_t)(t + 2) * kstep; const char* b2 = last ? nB : cB + (size_t)(t + 2) * kstep;
            const char* a3 = a2 + kstep; const char* b3 = b2 + kstep;
            if (last && has_next) S.a_ready(nxt);
            if constexpr (SP2) {
            const bool after_epi = NS > 0 && t == 0 && ui > 0;
            PG8_LDB(B0, 0, 0); PG8_LDB(B1, 0, 1); PG8_SCHED; PG8_LDA(At, 0, 0); PG8_STAGE(PG8_SA(1, 1), a1 + hstep, voffA);
            if (after_epi) PG8_WAIT_VN(8 + NS); else PG8_WAIT_V(8);
            PG8_WAIT_L(0); PG8_BAR; if (ZF && t == 0) { PG8_MMAZ(0, 0, At, B0); PG8_MMAZ(0, 1, At, B1); } else { PG8_MMA(0, 0, At, B0); PG8_MMA(0, 1, At, B1); } PG8_BAR; PG8_SCHED;
#if PG8_DMA_IN_MMA
            PG8_LDA(At, 0, 1); PG8_STAGE(PG8_SB(0, 0), b2, voffB); PG8_STAGE(PG8_SB(0, 1), b2 + hstep, voffB);
            if (after_epi) PG8_WAIT_VN(6 + NS); else PG8_WAIT_V(6);
            PG8_WAIT_L(0); PG8_BAR; PG8_MMA(1, 0, At, B0); PG8_STAGE(PG8_SA(0, 0), a2, voffA); PG8_MMA(1, 1, At, B1); PG8_BAR; PG8_SCHED;
#else
            PG8_LDA(At, 0, 1); PG8_STAGE(PG8_SB(0, 0), b2, voffB); PG8_STAGE(PG8_SB(0, 1), b2 + hstep, voffB); PG8_STAGE(PG8_SA(0, 0), a2, voffA);
            if (after_epi) PG8_WAIT_VN(8 + NS); else PG8_WAIT_V(8);
            PG8_WAIT_L(0); PG8_BAR; if (ZF && t == 0) { PG8_MMAZ(1, 0, At, B0); PG8_MMAZ(1, 1, At, B1); } else { PG8_MMA(1, 0, At, B0); PG8_MMA(1, 1, At, B1); } PG8_BAR; PG8_SCHED;
#endif
            PG8_LDB(B0, 1, 0); PG8_LDB(B1, 1, 1); PG8_SCHED; PG8_LDA(At, 1, 0); PG8_STAGE(PG8_SA(0, 1), a2 + hstep, voffA);
            PG8_WAIT_V(8); PG8_WAIT_L(0); PG8_BAR; PG8_MMA(0, 0, At, B0); PG8_MMA(0, 1, At, B1); PG8_BAR; PG8_SCHED;
#if PG8_DMA_IN_MMA
            PG8_LDA(At, 1, 1); PG8_STAGE(PG8_SB(1, 0), b3, voffB); PG8_STAGE(PG8_SB(1, 1), b3 + hstep, voffB);
            PG8_WAIT_V(6); PG8_WAIT_L(0); PG8_BAR; PG8_MMA(1, 0, At, B0); PG8_STAGE(PG8_SA(1, 0), a3, voffA); PG8_MMA(1, 1, At, B1); PG8_BAR; PG8_SCHED;
#else
            PG8_LDA(At, 1, 1); PG8_STAGE(PG8_SB(1, 0), b3, voffB); PG8_STAGE(PG8_SB(1, 1), b3 + hstep, voffB); PG8_STAGE(PG8_SA(1, 0), a3, voffA);
            PG8_WAIT_V(8); PG8_WAIT_L(0); PG8_BAR; PG8_MMA(1, 0, At, B0); PG8_MMA(1, 1, At, B1); PG8_BAR; PG8_SCHED;
#endif
            } else {
            PG8_LDB(B0, 0, 0); PG8_SCHED; PG8_LDA(At, 0, 0); PG8_STAGE(PG8_SA(1, 1), a1 + hstep, voffA);
            PG8_WAIT_L(8); PG8_BAR; PG8_WAIT_L(0); PG8_MMA(0, 0, At, B0); PG8_BAR; PG8_SCHED;
            PG8_LDB(B1, 0, 1); PG8_STAGE(PG8_SB(0, 0), b2, voffB);
            PG8_BAR; PG8_WAIT_L(0); PG8_MMA(0, 1, At, B1); PG8_BAR;
            PG8_LDA(At, 0, 1); PG8_STAGE(PG8_SA(0, 0), a2, voffA);
            PG8_BAR; PG8_WAIT_L(0); PG8_MMA(1, 0, At, B0); PG8_BAR; PG8_SCHED;
            PG8_STAGE(PG8_SB(0, 1), b2 + hstep, voffB);
            PG8_WAIT_V(6); PG8_BAR; PG8_MMA(1, 1, At, B1); PG8_BAR;
            PG8_LDB(B0, 1, 0); PG8_SCHED; PG8_LDA(At, 1, 0); PG8_STAGE(PG8_SA(0, 1), a2 + hstep, voffA);
            PG8_WAIT_L(8); PG8_BAR; PG8_WAIT_L(0); PG8_MMA(0, 0, At, B0); PG8_BAR; PG8_SCHED;
            PG8_LDB(B1, 1, 1); PG8_STAGE(PG8_SB(1, 0), b3, voffB);
            PG8_BAR; PG8_WAIT_L(0); PG8_MMA(0, 1, At, B1); PG8_BAR;
            PG8_LDA(At, 1, 1); PG8_STAGE(PG8_SA(1, 0), a3, voffA);
            PG8_BAR; PG8_WAIT_L(0); PG8_MMA(1, 0, At, B0); PG8_BAR; PG8_SCHED;
            PG8_STAGE(PG8_SB(1, 1), b3 + hstep, voffB);
            PG8_WAIT_V(6); PG8_BAR; PG8_MMA(1, 1, At, B1); PG8_BAR;
            }
        }
        if constexpr (F8) asm volatile("s_nop 15\n\ts_nop 7" ::: "memory");
        if constexpr (ALIGN_EPI) { if (wr == 0) PG8_BAR; }
        if constexpr (!Epi::AFTER_DRAIN) { E(acc, cur, wr, wc, fr, fq); S.done(cur); }
        if (!has_next) break;
        if constexpr (!ZF)
#pragma unroll
        for (int a = 0; a < 2; ++a)
#pragma unroll
            for (int b = 0; b < 2; ++b)
#pragma unroll
                for (int m = 0; m < 4; ++m)
#pragma unroll
                    for (int n = 0; n < 2; ++n) { float z0, z1, z2, z3; asm volatile("v_mov_b32 %0, 0\n\tv_mov_b32 %1, 0\n\tv_mov_b32 %2, 0\n\tv_mov_b32 %3, 0" : "=v"(z0), "=v"(z1), "=v"(z2), "=v"(z3)); acc[a][b][m][n] = (f32x4){z0, z1, z2, z3}; }
        cur = nxt; cA = nA; cB = nB; ++ui;
        if constexpr (ALIGN_EPI) { if (wr == 1) PG8_BAR; }
    }
    PG8_WAIT_V(0);
    if constexpr (!ALIGN_EPI) { if (wr == 0) PG8_BAR; }
    PG8_BAR;
    if constexpr (Epi::AFTER_DRAIN) { E.fused(acc, cur, wr, wc, fr, fq, lds, wid, lane); S.done(cur); }
#undef PG8_SA
#undef PG8_SB
#undef PG8_STAGE
#undef PG8_STAGE_AUX
#undef PG8_IS_B
#undef PG8_LDA
#undef PG8_LDB
#undef PG8_MMA
#undef PG8_MMAZ
#undef PG8_WAIT_V
#undef PG8_WAIT_L
#undef PG8_WAIT_VN
#undef PG8_BAR
#undef PG8_SCHED
}
}

#ifndef PG8_SP2
#define PG8_SP2 true
#endif

#define GAS __attribute__((address_space(1)))
#define LAS __attribute__((address_space(3)))
typedef unsigned short bf16;
typedef unsigned v4u __attribute__((ext_vector_type(4)));
typedef unsigned v2u __attribute__((ext_vector_type(2)));
typedef float f32x4 __attribute__((ext_vector_type(4)));
typedef float f32x2 __attribute__((ext_vector_type(2)));
typedef float f32x16 __attribute__((ext_vector_type(16)));
typedef short bf16x8 __attribute__((ext_vector_type(8)));
typedef short s16x4 __attribute__((ext_vector_type(4)));
typedef GAS unsigned gu32;
typedef GAS unsigned long long gu64;
typedef LAS const char* lcp;
typedef LAS char* lwp;
#define RLX_AGENT __ATOMIC_RELAXED, __HIP_MEMORY_SCOPE_AGENT
#define LDS_WAIT() asm volatile("s_waitcnt lgkmcnt(0)" ::: "memory")
#define VM_WAIT() asm volatile("s_waitcnt vmcnt(0)" ::: "memory")
#define WG_BAR() do { asm volatile("s_waitcnt vmcnt(0) lgkmcnt(0)" ::: "memory"); __builtin_amdgcn_s_barrier(); asm volatile("" ::: "memory"); } while (0)
#define DI __device__ __forceinline__
#define MFMA32(a, b, c) __builtin_amdgcn_mfma_f32_32x32x16_f16(__builtin_bit_cast(pg8::f16x8, (a)), __builtin_bit_cast(pg8::f16x8, (b)), (c), 0, 0, 0)
DI unsigned pk2(float lo, float hi) { return pg8::cvt_pk_bf16(lo, hi); }
DI float bflo(unsigned w) { return pg8::bf_lo(w); }
DI float bfhi(unsigned w) { return pg8::bf_hi(w); }
DI float ex2(float x) { return __builtin_amdgcn_exp2f(x); }
DI f32x16 zero16() { float z = 0.f; asm volatile("" : "+v"(z)); return (f32x16){z, z, z, z, z, z, z, z, z, z, z, z, z, z, z, z}; }
DI int crow(int r, int hi) { return (r & 3) + 8 * (r >> 2) + 4 * hi; }
#define SWZ_XOR(v, m) __uint_as_float((unsigned)__builtin_amdgcn_ds_swizzle((int)__float_as_uint(v), ((m) << 10) | 0x1f))
DI float half_swap_add(float v);
DI float wave_sum(float v) { v += SWZ_XOR(v, 1); v += SWZ_XOR(v, 2); v += SWZ_XOR(v, 4); v += SWZ_XOR(v, 8); v += SWZ_XOR(v, 16); return half_swap_add(v); }
DI float shfl_lane(float v, int src_lane) { return __uint_as_float((unsigned)__builtin_amdgcn_ds_bpermute(src_lane << 2, (int)__float_as_uint(v))); }
DI float half_swap_add(float v) { auto rr = __builtin_amdgcn_permlane32_swap(__float_as_uint(v), __float_as_uint(v), false, false); return __uint_as_float(rr[0]) + __uint_as_float(rr[1]); }
DI float half_swap_max(float v) { auto rr = __builtin_amdgcn_permlane32_swap(__float_as_uint(v), __float_as_uint(v), false, false); return fmaxf(__uint_as_float(rr[0]), __uint_as_float(rr[1])); }
typedef short v4i16_t __attribute__((ext_vector_type(4)));
DI s16x4 vtr(lcp p) { return __builtin_bit_cast(s16x4, __builtin_amdgcn_ds_read_tr16_b64_v4i16((LAS v4i16_t*)p)); }
DI bf16x8 cat8(s16x4 lo, s16x4 hi) { return __builtin_shufflevector(lo, hi, 0, 1, 2, 3, 4, 5, 6, 7); }
DI bf16x8 trfrag(lcp p) { return cat8(vtr(p), vtr(p + 512)); }
DI bf16x8 ldfrag(lcp p) { return *(const LAS bf16x8*)p; }
DI bf16x8 mask_frag(v4u v, unsigned m) { v4u o; asm("v_and_b32 %0, %4, %8\n\tv_and_b32 %1, %5, %8\n\tv_and_b32 %2, %6, %8\n\tv_and_b32 %3, %7, %8\n\ts_nop 1" : "=&v"(o.x), "=&v"(o.y), "=&v"(o.z), "=&v"(o.w) : "v"(v.x), "v"(v.y), "v"(v.z), "v"(v.w), "v"(m)); return __builtin_bit_cast(bf16x8, o); }
DI void glds16(const void* gsrc, LAS void* ldst) { __builtin_amdgcn_global_load_lds((const unsigned*)gsrc, (LAS unsigned*)ldst, 16, 0, 0); }
#define PACK8(x, s) ((bf16x8)__builtin_bit_cast(bf16x8, (v4u){pk2((x)[8 * (s) + 0], (x)[8 * (s) + 1]), pk2((x)[8 * (s) + 2], (x)[8 * (s) + 3]), pk2((x)[8 * (s) + 4], (x)[8 * (s) + 5]), pk2((x)[8 * (s) + 6], (x)[8 * (s) + 7])}))

constexpr int RING_OFF = 0, RING_BYTES = 131072;
constexpr int TAB_OFF = 131072;
constexpr int MISC_OFF = 163840 - 256;
constexpr int LDS_BYTES = 163840;
constexpr int AT_K = 0, AT_V = 32768, AT_WS = 65536, AT_STG = 67584;
constexpr int ML_K = 0, ML_V = 65536, ML_VW = 81920, ML_C = 98304, ML_N = 131072, ML_G2 = 131584, ML_M2 = 132096, ML_FI = 132608, ML_EI = 133120, ML_WK = 133632, ML_WKB = 134144, ML_SC = 134400, ML_WS = 134464, ML_STG = 136512;
static_assert(ML_STG + 4 * 4096 <= MISC_OFF && AT_STG + 8 * 4096 <= MISC_OFF && pg8::CTAB_OFF + pg8::CTAB_UNITS * 1024 <= MISC_OFF && pg8::STAB_OFF == TAB_OFF + 16384, "LDS map");

#define XB_TMO      128
#define XB_XCNT(j)  (256  + 64 * (j))
#define XB_XSUB(j)  (1280 + 64 * (j))
#define XB_XGEN(j)  (2304 + 64 * (j))
#define XB_TOP      3328
#define XB_TOPGEN   3392
#define XCD_BAR_WORDS 3456
#define XB_SPIN_CAP (1u << 18)

__device__ __forceinline__ unsigned xb_ld(unsigned* p)              { return __hip_atomic_load(p, __ATOMIC_RELAXED, __HIP_MEMORY_SCOPE_AGENT); }
__device__ __forceinline__ unsigned xb_add(unsigned* p, unsigned v) { return __hip_atomic_fetch_add(p, v, __ATOMIC_RELAXED, __HIP_MEMORY_SCOPE_AGENT); }
__device__ __forceinline__ unsigned xb_xcc_id() { return (unsigned)__builtin_amdgcn_s_getreg((3 << 11) | 20) & 0xFu; }
#define XB_SPIN(cond, bar) do { unsigned _sp = 0; while (cond) { __builtin_amdgcn_s_sleep(1); \
    if ((++_sp & 255u) == 0u) { if (xb_ld(&(bar)[XB_TMO])) break; if (_sp > XB_SPIN_CAP) { atomicAdd(&(bar)[XB_TMO], 1u); break; } } } } while (0)

struct XcdBarrier {
    unsigned* bar; unsigned x;
    volatile LAS unsigned* st;
    unsigned total;
};

__device__ __forceinline__ XcdBarrier xcd_barrier_post(unsigned* bar, volatile LAS unsigned* st) {
    XcdBarrier b; b.bar = bar; b.x = xb_xcc_id(); b.st = st; b.total = gridDim.x * gridDim.y * gridDim.z;
    if (threadIdx.x == 0) (void)xb_add(&bar[XB_XCNT(b.x)], 1u);
    return b;
}
__device__ __forceinline__ void xcd_barrier_complete(unsigned* bar, unsigned x, unsigned G, unsigned& nloc, unsigned& nx) {
    unsigned sum, cnt, mine, sp = 0u;
    for (;;) {
        sum = 0u; cnt = 0u; mine = 0u;
#pragma unroll
        for (unsigned j = 0; j < 16; ++j) { const unsigned c = xb_ld(&bar[XB_XCNT(j)]); sum += c; cnt += (c > 0u) ? 1u : 0u; mine = (j == x) ? c : mine; }
        if (sum == G) break;
        __builtin_amdgcn_s_sleep(1);
        if ((++sp & 255u) == 0u) { if (xb_ld(&bar[XB_TMO])) break; if (sp > XB_SPIN_CAP) { atomicAdd(&bar[XB_TMO], 1u); break; } }
    }
    nloc = mine > 0u ? mine : 1u; nx = cnt > 0u ? cnt : 1u;
}

__device__ __forceinline__ void xcd_barrier(const XcdBarrier& b) {
    asm volatile("s_waitcnt vmcnt(0)" ::: "memory");
    __syncthreads();
    if (threadIdx.x == 0) {
        unsigned* bar = b.bar;
        __builtin_amdgcn_s_waitcnt(0);
        unsigned nloc = b.st[0], nx = b.st[1];
        if (nloc == 0u) { xcd_barrier_complete(bar, b.x, b.total, nloc, nx); b.st[0] = nloc; b.st[1] = nx; }
        const unsigned old = xb_add(&bar[XB_XSUB(b.x)], 1u);
        const unsigned gen = old / nloc;
        if (old + 1u == (gen + 1u) * nloc) {
            if (nx > 1u) {
            __builtin_amdgcn_fence(__ATOMIC_RELEASE, "agent");
            asm volatile("s_waitcnt vmcnt(0)" ::: "memory");
            const unsigned og = xb_add(&bar[XB_TOP], 1u);
            const unsigned tg = og / nx;
            if (og + 1u == (tg + 1u) * nx) xb_add(&bar[XB_TOPGEN], 1u);
            else XB_SPIN(xb_ld(&bar[XB_TOPGEN]) == tg, bar);
            }
            xb_add(&bar[XB_XGEN(b.x)], 1u);
            __builtin_amdgcn_fence(__ATOMIC_ACQUIRE, "agent");
            asm volatile("s_waitcnt vmcnt(0)" ::: "memory");
        } else {
            XB_SPIN(xb_ld(&bar[XB_XGEN(b.x)]) == gen, bar);
            __builtin_amdgcn_fence(__ATOMIC_ACQUIRE, "agent");
            asm volatile("s_waitcnt vmcnt(0)" ::: "memory");
        }
    }
    __syncthreads();
}
DI void glds16_nt(const void* gsrc, LAS void* ldst) { __builtin_amdgcn_global_load_lds((const unsigned*)gsrc, (LAS unsigned*)ldst, 16, 0, 2); }
DI void attn_phase(unsigned char* ldsg, const bf16* QKV, unsigned char* AO8, const float* sinks, int ng, int gx, int gy, int Gy, int wave_in) {
    int wid = wave_in; asm volatile("" : "+s"(wid));
    const int lane = pg8::pg8_lane(), tid = wid * 64 + lane, r32 = lane & 31, hi = lane >> 5;
    LAS unsigned char* lds = (LAS unsigned char*)ldsg; const lcp L = (lcp)lds;
    LAS float* wsf = (LAS float*)(lds + AT_WS) + wid * 64;
    LAS unsigned char* stg = lds + AT_STG + wid * 4096;
    const lcp vlane = L + AT_V + ((lane >> 4) & 1) * 32 + (lane & 3) * 8 + (4 * hi + ((lane & 15) >> 2)) * 64;
    const lcp klane = L + AT_K + hi * 1024 + r32 * 16;
    for (int uu = gy; uu < 64 * (BATCH / ng); uu += Gy) { const int b = gx + ng * (uu >> 6), ul = uu & 63;
        const int kvh = ul & 3, nb = ul >> 2;
        const long rowq = (long)b * SEQ + nb * 128, rowk = rowq - 128;
        const int slot_lo = (nb == 0) ? 2 : 0;
        for (int sl = slot_lo; sl < 4; ++sl) {
            glds16(QKV + (rowk + 64 * sl + lane) * NQKV + 2048 + 64 * kvh + 8 * wid, lds + AT_K + sl * 8192 + wid * 1024);
            glds16(QKV + (rowk + 64 * sl + 16 * (wid & 3) + (lane >> 2)) * NQKV + 2304 + 64 * kvh + (wid >> 2) * 32 + (lane & 3) * 8, lds + AT_V + sl * 8192 + wid * 1024);
        }
        const int hq = 8 * kvh + wid;
        const bf16* qsrc = QKV + (rowq + r32) * NQKV + 64 * hq + 8 * hi;
        bf16x8 qn[4];
#pragma unroll
        for (int d0 = 0; d0 < 4; ++d0) qn[d0] = *(const bf16x8*)(qsrc + 16 * d0);
        const float slope2 = ex2(-0.25f * (float)(hq + 1)) * LOG2E, sink2 = sinks[hq] * LOG2E;
        const float base_l = -slope2 * (float)(r32 - 4 * hi);
        WG_BAR();
#pragma unroll 1
        for (int j = 0; j < 4; ++j) {
            const int ilo = (nb == 0) ? 4 - j : 0;
            bf16x8 qr[4];
#pragma unroll
            for (int d0 = 0; d0 < 4; ++d0) qr[d0] = qn[d0];
            if (j < 3) {
#pragma unroll
                for (int d0 = 0; d0 < 4; ++d0) qn[d0] = *(const bf16x8*)(qsrc + (size_t)(32 * (j + 1)) * NQKV + 16 * d0);
            }
            float sl2 = slope2, bl = base_l; asm volatile("" : "+v"(sl2), "+v"(bl));
            f32x16 p[5];
#pragma unroll
            for (int i = 0; i < 5; ++i) {
                if (i >= ilo) {
                    const int kt = j + i; const lcp kb = klane + (kt >> 1) * 8192 + (kt & 1) * 512;
                    f32x16 a = zero16();
#pragma unroll
                    for (int d0 = 0; d0 < 4; ++d0) a = MFMA32(ldfrag(kb + d0 * 2048), qr[d0], a);
#pragma unroll
                    for (int r = 0; r < 16; ++r) {
                        const int cr = (r & 3) + 8 * (r >> 2);
                        float s = fmaf(sl2, (float)(cr - 128 + 32 * i), fmaf(a[r], LOG2E, bl));
                        if (i == 0) { if (!(cr + 4 * hi > r32)) s = -INFINITY; }
                        if (i == 4) { if (!(cr + 4 * hi <= r32)) s = -INFINITY; }
                        a[r] = s;
                    }
                    p[i] = a;
                } else {
#pragma unroll
                    for (int r = 0; r < 16; ++r) p[i][r] = -INFINITY;
                }
            }
            float mx = sink2;
#pragma unroll
            for (int i = 0; i < 5; ++i)
#pragma unroll
                for (int r = 0; r < 16; ++r) mx = fmaxf(mx, p[i][r]);
            mx = half_swap_max(mx);
            float ls = 0.f;
#pragma unroll
            for (int i = 0; i < 5; ++i)
#pragma unroll
                for (int r = 0; r < 16; ++r) { const float e = ex2(p[i][r] - mx); p[i][r] = e; ls += e; }
            ls = half_swap_add(ls) + ex2(sink2 - mx);
            f32x16 o0 = zero16(), o1 = zero16();
#pragma unroll
            for (int i = 0; i < 5; ++i) {
                if (i >= ilo) {
                    const int kt = j + i; const lcp vb = vlane + (kt >> 1) * 8192 + (kt & 1) * 2048;
                    const bf16x8 pa = PACK8(p[i], 0), pb = PACK8(p[i], 1);
                    o0 = MFMA32(pa, trfrag(vb), o0);        o0 = MFMA32(pb, trfrag(vb + 1024), o0);
                    o1 = MFMA32(pa, trfrag(vb + 4096), o1); o1 = MFMA32(pb, trfrag(vb + 4096 + 1024), o1);
                }
            }
            if (hi == 0) wsf[r32] = __builtin_amdgcn_rcpf(ls);
#pragma unroll
            for (int r = 0; r < 16; ++r) {
                const int orow = crow(r, hi); const float rl = wsf[orow] * pg8::F8_SO;
                int pk; asm volatile("" : "=v"(pk)); pk = __builtin_amdgcn_cvt_pk_fp8_f32(o0[r] * rl, o1[r] * rl, pk, false);
                stg[orow * 64 + r32] = (unsigned char)(pk & 0xff);
                stg[orow * 64 + 32 + r32] = (unsigned char)((pk >> 8) & 0xff);
            }
#pragma unroll
            for (int i4 = 0; i4 < 2; ++i4) {
                const int row = i4 * 16 + (lane >> 2), ch = lane & 3;
                const v4u v = *(const LAS v4u*)(stg + row * 64 + ch * 16);
                *(v4u*)(AO8 + (rowq + 32 * j + row) * D + 64 * hq + ch * 16) = v;
            }
        }
        WG_BAR();
    }
}

constexpr int ML_GSET = ML_STG + 4 * 4096 - ML_G2;
static_assert(ML_G2 + ML_GSET + (ML_WS - ML_G2) <= MISC_OFF, "LDS map: second gate-array set");
#define DPPF(old, src, ctrl, rmask, bc) __uint_as_float((unsigned)__builtin_amdgcn_update_dpp((int)__float_as_uint(old), (int)__float_as_uint(src), (ctrl), (rmask), 0xf, (bc)))
DI float scan_add64(float v) {
    v += DPPF(0.f, v, 0x111, 0xf, true); v += DPPF(0.f, v, 0x112, 0xf, true); v += DPPF(0.f, v, 0x114, 0xf, true); v += DPPF(0.f, v, 0x118, 0xf, true);
    v += DPPF(0.f, v, 0x142, 0xa, false); v += DPPF(0.f, v, 0x143, 0xc, false); return v;
}
DI float scan_max64(float v) {
    const float ninf = -INFINITY;
    v = fmaxf(v, DPPF(ninf, v, 0x111, 0xf, false)); v = fmaxf(v, DPPF(ninf, v, 0x112, 0xf, false)); v = fmaxf(v, DPPF(ninf, v, 0x114, 0xf, false)); v = fmaxf(v, DPPF(ninf, v, 0x118, 0xf, false));
    v = fmaxf(v, DPPF(ninf, v, 0x142, 0xa, false)); v = fmaxf(v, DPPF(ninf, v, 0x143, 0xc, false)); return v;
}
DI float ml_gate_scan(LAS unsigned char* lds, int gofs, const float* GT, long row0, int h, int lane, float m_prev) {
    LAS float* G2 = (LAS float*)(lds + ML_G2 + gofs); LAS float* M2 = (LAS float*)(lds + ML_M2 + gofs); LAS float* FI = (LAS float*)(lds + ML_FI + gofs); LAS float* EI = (LAS float*)(lds + ML_EI + gofs);
    LAS float* WK = (LAS float*)(lds + ML_WK + gofs); LAS bf16* WKB = (LAS bf16*)(lds + ML_WKB + gofs); LAS float* SC = (LAS float*)(lds + ML_SC + gofs);
    const float* gp = GT + (size_t)(row0 + 2 * lane) * 8;
    const float i0 = gp[h], f0 = gp[4 + h], i1 = gp[8 + h], f1 = gp[12 + h];
    const float lf0 = -0.6931471805599453f * __builtin_amdgcn_logf(1.f + ex2(-LOG2E * f0)), lf1 = -0.6931471805599453f * __builtin_amdgcn_logf(1.f + ex2(-LOG2E * f1));
    const float incl = scan_add64(lf0 + lf1);
    const float b1 = incl, b0 = incl - lf1;
    const float g0 = i0 - b0, g1 = i1 - b1;
    const float cm = scan_max64(fmaxf(g0, g1));
    const float cprev = DPPF(-INFINITY, cm, 0x138, 0xf, false);
    const float M0 = fmaxf(m_prev, fmaxf(cprev, g0)), M1 = fmaxf(m_prev, cm);
    const float Mend = __uint_as_float((unsigned)__builtin_amdgcn_readlane((int)__float_as_uint(M1), 63)), blast = __uint_as_float((unsigned)__builtin_amdgcn_readlane((int)__float_as_uint(b1), 63));
    *(LAS f32x2*)(G2 + 2 * lane) = (f32x2){g0 * LOG2E, g1 * LOG2E};
    *(LAS f32x2*)(M2 + 2 * lane) = (f32x2){M0 * LOG2E, M1 * LOG2E};
    *(LAS f32x2*)(FI + 2 * lane) = (f32x2){ex2((m_prev - M0) * LOG2E), ex2((m_prev - M1) * LOG2E)};
    *(LAS f32x2*)(EI + 2 * lane) = (f32x2){ex2(-(b0 + M0) * LOG2E), ex2(-(b1 + M1) * LOG2E)};
    const float w0 = ex2((g0 - Mend) * LOG2E), w1 = ex2((g1 - Mend) * LOG2E);
    *(LAS f32x2*)(WK + 2 * lane) = (f32x2){w0, w1};
    *(LAS unsigned*)(WKB + 2 * lane) = pk2(w0, w1);
    if (lane == 0) SC[0] = ex2((m_prev - Mend) * LOG2E);
    return blast + Mend;
}
template <int VAR = 0>
DI void mlstm_phase(unsigned char* ldsg, const bf16* MP, const float* GT, bf16* HG, int ng, int gx, int gy, int Gy, int wave_in) {
    int wid = wave_in; asm volatile("" : "+s"(wid));
    const int lane0 = pg8::pg8_lane(), tid = wid * 64 + lane0;
    LAS unsigned char* lds = (LAS unsigned char*)ldsg; const lcp L = (lcp)lds;
    LAS float* wsf = (LAS float*)(lds + ML_WS) + wid * 64;
    for (int uu = gy; uu < 32 * (BATCH / ng); uu += Gy) { const int b = gx + ng * (uu >> 5), ul = uu & 31;
        const int h = ul >> 3, sl = ul & 7;
        const bf16* Qp = MP + 256 * h; const bf16* Kp = MP + 1024 + 256 * h; const bf16* Vp = MP + 2048 + 512 * h + 64 * sl; const bf16* OGp = MP + 4096 + 512 * h + 64 * sl;
        { unsigned z = 0u; asm volatile("" : "+v"(z)); for (int i = tid; i < (32768 + 512) / 16; i += 512) *(LAS v4u*)(lds + ML_C + i * 16) = (v4u){z, z, z, z}; }
        f32x16 T[6];
#pragma unroll
        for (int x = 0; x < 6; ++x) T[x] = zero16();
        float m_prev = 0.f;
        v4u X[16], vreg[2];
        { const long row0 = (long)b * SEQ; const int lane = lane0, r32 = lane & 31, hi = lane >> 5;
          if (wid >= 4) {
#pragma unroll
              for (int i = 0; i < 16; ++i) X[i] = *(const v4u*)(Kp + (row0 + 8 * i + (lane & 7)) * NMI + (8 * (wid - 4) + (lane >> 3)) * 8);
          } else {
#pragma unroll
              for (int ks = 0; ks < 16; ++ks) X[ks] = *(const v4u*)(Qp + (row0 + 32 * wid + r32) * NMI + 16 * ks + 8 * hi);
          }
#pragma unroll
          for (int i = 0; i < 2; ++i) vreg[i] = *(const v4u*)(Vp + (row0 + 64 * i + 16 * (wid & 3) + (lane >> 2)) * NMI + (wid >> 2) * 32 + (lane & 3) * 8);
          if (wid == 4 && !(VAR & 16)) m_prev = ml_gate_scan(lds, 0, GT, row0, h, lane, m_prev);
        }
        WG_BAR();
        for (int c = 0; c < 16; ++c) {
            const long row0 = (long)b * SEQ + 128 * c;
            const int gofs = (c & 1) * ML_GSET;
            const int lane = pg8::pg8_lane(), r32 = lane & 31, hi = lane >> 5;
            const int blk = (lane >> 4) & 1, q4 = (lane & 15) >> 2, p4 = lane & 3;
            const int vlo_ = blk * 32 + p4 * 8 + (4 * hi + q4) * 64;
            const int ktl_ = (2 * blk + (p4 >> 1)) * 2048 + (q4 + 4 * hi) * 16 + (p4 & 1) * 8;
            const int cbl_ = hi * 1024 + r32 * 16, kbl_ = hi * 2048 + r32 * 16;
            const unsigned m0 = (r32 == 0) ? 0xffffffffu : 0u;
            LAS float* G2 = (LAS float*)(lds + ML_G2 + gofs); LAS float* M2 = (LAS float*)(lds + ML_M2 + gofs); LAS float* FI = (LAS float*)(lds + ML_FI + gofs); LAS float* EI = (LAS float*)(lds + ML_EI + gofs);
            LAS float* WK = (LAS float*)(lds + ML_WK + gofs); LAS bf16* WKB = (LAS bf16*)(lds + ML_WKB + gofs); LAS float* SC = (LAS float*)(lds + ML_SC + gofs);
            if (wid >= 4) {
#pragma unroll
                for (int i = 0; i < 16; ++i) *(LAS v4u*)(lds + ML_K + (8 * (wid - 4) + (lane >> 3)) * 2048 + (8 * i + (lane & 7)) * 16) = X[i];
            }
#pragma unroll
            for (int i = 0; i < 2; ++i) { const float w = WK[64 * i + 16 * (wid & 3) + (lane >> 2)]; const v4u v = vreg[i]; v4u o;
                o.x = pk2(bflo(v.x) * w, bfhi(v.x) * w); o.y = pk2(bflo(v.y) * w, bfhi(v.y) * w); o.z = pk2(bflo(v.z) * w, bfhi(v.z) * w); o.w = pk2(bflo(v.w) * w, bfhi(v.w) * w);
                *(LAS v4u*)(lds + ML_V + i * 8192 + wid * 1024 + lane * 16) = v;
                *(LAS v4u*)(lds + ML_VW + i * 8192 + wid * 1024 + lane * 16) = o; }
            asm volatile("s_waitcnt lgkmcnt(0)" ::: "memory"); __builtin_amdgcn_s_barrier(); asm volatile("" ::: "memory");
            const bool more = c + 1 < 16;
            if (more && !(VAR & 32)) {
                const long row1 = row0 + 128;
                if (wid >= 4) {
#pragma unroll
                    for (int i = 0; i < 16; ++i) X[i] = *(const v4u*)(Kp + (row1 + 8 * i + (lane & 7)) * NMI + (8 * (wid - 4) + (lane >> 3)) * 8);
                }
#pragma unroll
                for (int i = 0; i < 2; ++i) vreg[i] = *(const v4u*)(Vp + (row1 + 64 * i + 16 * (wid & 3) + (lane >> 2)) * NMI + (wid >> 2) * 32 + (lane & 3) * 8);
            }
            if (wid < 4) {
                const int tt = wid;
                v4u ogv[4];
#pragma unroll
                for (int i4 = 0; i4 < 4; ++i4) ogv[i4] = *(const v4u*)(OGp + (row0 + 32 * tt + i4 * 8 + (lane >> 3)) * NMI + (lane & 7) * 8);
                T[0] = zero16(); T[1] = zero16(); T[2] = zero16();
                if (!(VAR & 4)) { const lcp cb = L + ML_C + cbl_; const lcp nbp = L + ML_N + 16 * hi;
                  bf16x8 fc0[3], fc1[3]; v4u fn[3];
#pragma unroll
                  for (int p = 0; p < 2; ++p) { fc0[p] = ldfrag(cb + p * 2048); fc1[p] = ldfrag(cb + p * 2048 + 512); fn[p] = *(const LAS v4u*)(nbp + p * 32); }
#pragma unroll
                  for (int ks = 0; ks < 16; ++ks) {
                      if (ks + 2 < 16) { fc0[(ks + 2) % 3] = ldfrag(cb + (ks + 2) * 2048); fc1[(ks + 2) % 3] = ldfrag(cb + (ks + 2) * 2048 + 512); fn[(ks + 2) % 3] = *(const LAS v4u*)(nbp + (ks + 2) * 32); }
                      __builtin_amdgcn_sched_barrier(0);
                      const bf16x8 nf = mask_frag(fn[ks % 3], m0);
                      T[0] = MFMA32(__builtin_bit_cast(bf16x8, X[ks]), fc0[ks % 3], T[0]); T[1] = MFMA32(__builtin_bit_cast(bf16x8, X[ks]), fc1[ks % 3], T[1]); T[2] = MFMA32(__builtin_bit_cast(bf16x8, X[ks]), nf, T[2]);
                      __builtin_amdgcn_sched_barrier(0);
                  } }
                { float fi[16];
#pragma unroll
                  for (int r = 0; r < 16; ++r) fi[r] = FI[32 * tt + crow(r, hi)];
#pragma unroll
                  for (int r = 0; r < 16; ++r) { T[0][r] *= fi[r]; T[1][r] *= fi[r]; }
                  if (r32 == 0) {
#pragma unroll
                      for (int r = 0; r < 16; ++r) wsf[crow(r, hi)] = T[2][r] * fi[r];
                  } }
                const float Mt = M2[32 * tt + r32];
                float dsum = 0.f;
                for (int st = 0; st <= ((VAR & 2) ? -1 : tt); ++st) {
                    f32x16 S = zero16();
                    const lcp kb = L + ML_K + kbl_ + st * 512;
                    float g2[16];
#pragma unroll
                    for (int r = 0; r < 16; ++r) g2[r] = G2[32 * st + crow(r, hi)];
                    const lcp vb = L + ML_V + (st >> 1) * 8192 + (st & 1) * 2048 + vlo_;
                    const bf16x8 vf0 = trfrag(vb), vf1 = trfrag(vb + 1024), vf2 = trfrag(vb + 4096), vf3 = trfrag(vb + 4096 + 1024);
                    __builtin_amdgcn_sched_barrier(0);
                    { bf16x8 kf[4];
#pragma unroll
                      for (int p = 0; p < 3; ++p) kf[p] = ldfrag(kb + p * 4096);
#pragma unroll
                      for (int ks = 0; ks < 16; ++ks) {
                          if (ks + 3 < 16) kf[(ks + 3) & 3] = ldfrag(kb + (ks + 3) * 4096);
                          __builtin_amdgcn_sched_barrier(0);
                          S = MFMA32(kf[ks & 3], __builtin_bit_cast(bf16x8, X[ks]), S);
                          __builtin_amdgcn_sched_barrier(0);
                      } }
#pragma unroll
                    for (int r = 0; r < 16; ++r) {
                        const float w = ex2(g2[r] - Mt);
                        float v = S[r] * w;
                        if (st == tt && crow(r, hi) > r32) v = 0.f;
                        S[r] = v; dsum += v;
                    }
                    const bf16x8 pa = PACK8(S, 0), pb = PACK8(S, 1);
                    T[0] = MFMA32(pa, vf0, T[0]); T[0] = MFMA32(pb, vf1, T[0]);
                    T[1] = MFMA32(pa, vf2, T[1]); T[1] = MFMA32(pb, vf3, T[1]);
                }
                if (more && !(VAR & 64)) {
#pragma unroll
                    for (int ks = 0; ks < 16; ++ks) X[ks] = *(const v4u*)(Qp + (row0 + 128 + 32 * wid + r32) * NMI + 16 * ks + 8 * hi);
                }
                dsum = half_swap_add(dsum);
                { const float den = wsf[r32] + dsum; const float dn = fmaxf(fabsf(den), EI[32 * tt + r32]);
                  if (hi == 0) wsf[32 + r32] = __builtin_amdgcn_rcpf(dn); }
                LAS bf16* stg = (LAS bf16*)(lds + ML_STG + tt * 4096);
                if (!(VAR & 8)) {
#pragma unroll
                for (int r = 0; r < 16; ++r) {
                    const int orow = crow(r, hi); const float rd = wsf[32 + orow];
                    stg[orow * 64 + r32] = (bf16)(pk2(T[0][r] * rd, 0.f) & 0xffffu);
                    stg[orow * 64 + 32 + r32] = (bf16)(pk2(T[1][r] * rd, 0.f) & 0xffffu);
                }
#pragma unroll
                for (int i4 = 0; i4 < 4; ++i4) {
                    const int row = i4 * 8 + (lane >> 3), ch = lane & 7;
                    const v4u hv = *(const LAS v4u*)(stg + row * 64 + ch * 8);
                    const v4u og = ogv[i4];
                    v4u o;
                    o.x = pk2(bflo(hv.x) * bflo(og.x), bfhi(hv.x) * bfhi(og.x)); o.y = pk2(bflo(hv.y) * bflo(og.y), bfhi(hv.y) * bfhi(og.y));
                    o.z = pk2(bflo(hv.z) * bflo(og.z), bfhi(hv.z) * bfhi(og.z)); o.w = pk2(bflo(hv.w) * bflo(og.w), bfhi(hv.w) * bfhi(og.w));
                    *(v4u*)(HG + (row0 + 32 * tt + row) * D + 512 * h + 64 * sl + ch * 8) = o;
                }
                }
#pragma unroll
                for (int x = 3; x < 6; ++x) T[x] = zero16();
            } else {
                const float decay = SC[0];
#pragma unroll
                for (int x = 0; x < 6; ++x)
#pragma unroll
                    for (int r = 0; r < 16; ++r) T[x][r] *= decay;
#pragma unroll
                for (int dti = 0; dti < ((VAR & 1) ? 0 : 2); ++dti) {
                    const int dt = 2 * (wid - 4) + dti;
                    const lcp ka0 = L + ML_K + dt * 8192 + ktl_;
#pragma unroll
                    for (int s8 = 0; s8 < 8; ++s8) {
                        const lcp ka = ka0 + s8 * 256;
                        const bf16x8 af = cat8(vtr(ka), vtr(ka + 128));
                        const lcp vwb = L + ML_VW + (s8 >> 2) * 8192 + (s8 & 3) * 1024 + vlo_;
                        const bf16x8 b0 = trfrag(vwb), b1 = trfrag(vwb + 4096);
                        const v2u wlo = *(const LAS v2u*)(WKB + 16 * s8 + 4 * hi), whi = *(const LAS v2u*)(WKB + 16 * s8 + 4 * hi + 8); const bf16x8 nb = mask_frag((v4u){wlo.x, wlo.y, whi.x, whi.y}, m0);
                        T[2 * dti] = MFMA32(af, b0, T[2 * dti]); T[2 * dti + 1] = MFMA32(af, b1, T[2 * dti + 1]); T[4 + dti] = MFMA32(af, nb, T[4 + dti]);
                        if (s8 & 1) __builtin_amdgcn_sched_barrier(0);
                    }
                }
                if (more && wid == 4 && !(VAR & 16)) m_prev = ml_gate_scan(lds, ML_GSET - gofs, GT, row0 + 128, h, lane, m_prev);
            }
            asm volatile("s_waitcnt lgkmcnt(0)" ::: "memory"); __builtin_amdgcn_s_barrier(); asm volatile("" ::: "memory");
            if (wid >= 4) {
#pragma unroll
                for (int dti = 0; dti < 2; ++dti) {
                    const int dt = 2 * (wid - 4) + dti;
#pragma unroll
                    for (int et = 0; et < 2; ++et)
#pragma unroll
                        for (int g = 0; g < 4; ++g)
                            *(LAS v2u*)(lds + ML_C + (4 * dt + g) * 1024 + (32 * et + r32) * 16 + hi * 8) = (v2u){pk2(T[2 * dti + et][4 * g], T[2 * dti + et][4 * g + 1]), pk2(T[2 * dti + et][4 * g + 2], T[2 * dti + et][4 * g + 3])};
                    if (r32 == 0) {
#pragma unroll
                        for (int g = 0; g < 4; ++g)
                            *(LAS v2u*)(lds + ML_N + (32 * dt + 8 * g + 4 * hi) * 2) = (v2u){pk2(T[4 + dti][4 * g], T[4 + dti][4 * g + 1]), pk2(T[4 + dti][4 * g + 2], T[4 + dti][4 * g + 3])};
                    }
                }
            }
        }
        WG_BAR();
    }
}


constexpr int NWAVES = 8;

template <bool F8> DI void tr_strip(const float* W, int ldw, int n0, void* WTv, size_t wt_row0, int Kdim, int kb0, int nkb, const float* g, const float* bb, float cs, float* c1o, float* c2o, LAS float* scr, int lane) {
    bf16* WT = (bf16*)WTv; unsigned char* WT8 = (unsigned char*)WTv;
    const int c = lane & 7;
    float a1[4] = {0.f, 0.f, 0.f, 0.f}, a2[4] = {0.f, 0.f, 0.f, 0.f};
    for (int kb = kb0; kb < kb0 + nkb; ++kb) {
        const int k0 = kb * 64;
#pragma unroll 8
        for (int i = 0; i < 32; ++i) { const int kk = 2 * i + (lane >> 5); scr[kk * 33 + (lane & 31)] = __builtin_nontemporal_load(W + (size_t)(k0 + kk) * ldw + n0 + (lane & 31)); }
        float gk[8], bk[8];
        if (g) { const f32x4 g0 = *(const f32x4*)(g + k0 + 8 * c), g1 = *(const f32x4*)(g + k0 + 8 * c + 4), b0 = *(const f32x4*)(bb + k0 + 8 * c), b1 = *(const f32x4*)(bb + k0 + 8 * c + 4);
#pragma unroll
            for (int i = 0; i < 4; ++i) { gk[i] = g0[i] * cs; gk[4 + i] = g1[i] * cs; bk[i] = b0[i] * cs; bk[4 + i] = b1[i] * cs; } }
        else {
#pragma unroll
            for (int i = 0; i < 8; ++i) { gk[i] = cs; bk[i] = 0.f; } }
        LDS_WAIT(); asm volatile("" ::: "memory");
#pragma unroll
        for (int j = 0; j < 4; ++j) { const int n = (lane >> 3) + 8 * j; const LAS float* s = scr + (8 * c) * 33 + n;
            float v[8];
#pragma unroll
            for (int i = 0; i < 8; ++i) v[i] = s[i * 33];
            a2[j] += ((v[0] * bk[0] + v[1] * bk[1]) + (v[2] * bk[2] + v[3] * bk[3])) + ((v[4] * bk[4] + v[5] * bk[5]) + (v[6] * bk[6] + v[7] * bk[7]));
            if constexpr (F8) {
                float wv[8];
#pragma unroll
                for (int i = 0; i < 8; ++i) wv[i] = v[i] * gk[i];
                const v2u o = pg8::cvt8_f8(wv, pg8::F8_SW);
                a1[j] += ((__builtin_amdgcn_cvt_f32_fp8((int)o.x, 0) + __builtin_amdgcn_cvt_f32_fp8((int)o.x, 1)) + (__builtin_amdgcn_cvt_f32_fp8((int)o.x, 2) + __builtin_amdgcn_cvt_f32_fp8((int)o.x, 3)))
                       + ((__builtin_amdgcn_cvt_f32_fp8((int)o.y, 0) + __builtin_amdgcn_cvt_f32_fp8((int)o.y, 1)) + (__builtin_amdgcn_cvt_f32_fp8((int)o.y, 2) + __builtin_amdgcn_cvt_f32_fp8((int)o.y, 3)));
                *(GAS v2u*)(WT8 + (wt_row0 + n) * Kdim + k0 + 8 * c) = o;
            } else {
                v4u o; o.x = pk2(v[0] * gk[0], v[1] * gk[1]); o.y = pk2(v[2] * gk[2], v[3] * gk[3]); o.z = pk2(v[4] * gk[4], v[5] * gk[5]); o.w = pk2(v[6] * gk[6], v[7] * gk[7]);
                a1[j] += ((bflo(o.x) + bfhi(o.x)) + (bflo(o.y) + bfhi(o.y))) + ((bflo(o.z) + bfhi(o.z)) + (bflo(o.w) + bfhi(o.w)));
                *(GAS v4u*)(WT + (wt_row0 + n) * Kdim + k0 + 8 * c) = o;
            } }
        LDS_WAIT(); asm volatile("" ::: "memory");
    }
    if (g) {
#pragma unroll
        for (int j = 0; j < 4; ++j) { float s1 = a1[j], s2 = a2[j];
            s1 += SWZ_XOR(s1, 1); s2 += SWZ_XOR(s2, 1); s1 += SWZ_XOR(s1, 2); s2 += SWZ_XOR(s2, 2); s1 += SWZ_XOR(s1, 4); s2 += SWZ_XOR(s2, 4);
            if (c == 0) { c1o[(lane >> 3) + 8 * j] = F8 ? s1 * (1.f / pg8::F8_SW) : s1; c2o[(lane >> 3) + 8 * j] = s2; } }
    }
}

DI void prologue(kargs_t a, LAS unsigned char* lds, int gw, int NGW, int wave, int lane) {
    unsigned char* ws = a->ws;
    float* vec = (float*)(ws + WS_VEC);
    const float* ones = (const float*)(ws + WS_VEC + V_ONES); const float* zeros = (const float*)(ws + WS_VEC + V_ZEROS);
    LAS float* scr = (LAS float*)(lds + wave * 16384);
    constexpr int T_UP = 8 * 2 * 176, T_QKV = 2 * 80, T_MI = 2 * 192, T_W2 = 8 * 64 * 4, T_WO = 2 * 64, T_WMO = 2 * 64, T_G = 16;
    constexpr int NT = T_UP + T_QKV + T_MI + T_W2 + T_WO + T_WMO + T_G;
#ifndef PROBE_PERM
#define PROBE_PERM 0
#endif
    for (int it = (PROBE_PERM && NGW == 2048) ? (gw & 7) * 256 + (gw >> 3) : gw; it < NT; it += NGW) {
        int r = it;
        if (r < T_UP) {
            const int f = r / 352, rr = r % 352, which = rr / 176, strip = rr % 176, n0 = 32 * strip;
            const int t = 3 * (f >> 1) + 2 * (f & 1);
            const float* gp = t ? a->ln_g + (size_t)(t - 1) * D : nullptr; const float* bp = t ? a->ln_b + (size_t)(t - 1) * D : nullptr;
            const size_t wrow = (size_t)256 * (n0 / 128) + 128 * which + (n0 % 128);
            const float* W = (which ? a->w3 : a->w1) + (size_t)f * D * FF;
            if (gp) tr_strip<true>(W, FF, n0, ws + WS_W13 + (size_t)f * NUP * D, wrow, D, 0, 32, gp, bp, 1.f, vec + V_C1U / 4 + (size_t)f * NUP + wrow, vec + V_C2U / 4 + (size_t)f * NUP + wrow, scr, lane);
            else { tr_strip<true>(W, FF, n0, ws + WS_W13 + (size_t)f * NUP * D, wrow, D, 0, 32, nullptr, nullptr, 1.f, nullptr, nullptr, scr, lane);
                   if (lane < 32) { vec[V_C1U / 4 + (size_t)f * NUP + wrow + lane] = 0.f; vec[V_C2U / 4 + (size_t)f * NUP + wrow + lane] = 0.f; } }
            continue; }
        r -= T_UP;
        if (r < T_QKV) { const int j = r / 80, n0 = 32 * (r % 80); const int t = 6 * j + 1;
            tr_strip<true>(a->wqkv + (size_t)j * D * NQKV, NQKV, n0, ws + WS_WQKV + (size_t)j * NQKV * D, n0, D, 0, 32, a->ln_g + (size_t)(t - 1) * D, a->ln_b + (size_t)(t - 1) * D, n0 < 2048 ? 0.125f : 1.f,
                     vec + V_C1Q / 4 + j * NQKV + n0, vec + V_C2Q / 4 + j * NQKV + n0, scr, lane);
            continue; }
        r -= T_QKV;
        if (r < T_MI) { const int j = r / 192, n0 = 32 * (r % 192); const int t = 6 * j + 4;
            if (!OG_F8 || n0 < 4096) tr_strip<false>(a->win + (size_t)j * D * NMIW, NMIW, n0, (bf16*)(ws + WS_WIN) + (size_t)j * NMI * D, n0, D, 0, 32, a->ln_g + (size_t)(t - 1) * D, a->ln_b + (size_t)(t - 1) * D, (n0 >= 1024 && n0 < 2048) ? 0.0625f : 1.f,
                     vec + V_C1I / 4 + j * NMI + n0, vec + V_C2I / 4 + j * NMI + n0, scr, lane);
            else tr_strip<true>(a->win + (size_t)j * D * NMIW, NMIW, n0, ws + WS_WIN + ((size_t)j * NMI + 4096) * D * 2, n0 - 4096, D, 0, 32, a->ln_g + (size_t)(t - 1) * D, a->ln_b + (size_t)(t - 1) * D, 1.f,
                     vec + V_C1I / 4 + j * NMI + n0, vec + V_C2I / 4 + j * NMI + n0, scr, lane);
            continue; }
        r -= T_MI;
        if (r < T_W2) { const int f = r / 256, rr = r % 256, strip = rr / 4, kq = rr % 4;
            tr_strip<true>(a->w2 + (size_t)f * FF * D, D, 32 * strip, ws + WS_W2 + (size_t)f * D * FF, 32 * strip, FF, 22 * kq, 22, nullptr, nullptr, 1.f, nullptr, nullptr, scr, lane);
            continue; }
        r -= T_W2;
        if (r < T_WO) { const int j = r / 64, strip = r % 64;
            tr_strip<true>(a->wo + (size_t)j * D * D, D, 32 * strip, ws + WS_WO + (size_t)j * D * D, 32 * strip, D, 0, 32, nullptr, nullptr, 1.f, nullptr, nullptr, scr, lane);
            continue; }
        r -= T_WO;
        if (r < T_WMO) { const int j = r / 64, strip = r % 64;
            tr_strip<false>(a->wmo + (size_t)j * D * D, D, 32 * strip, (bf16*)(ws + WS_WMO) + (size_t)j * D * D, 32 * strip, D, 0, 32, nullptr, nullptr, 1.f, nullptr, nullptr, scr, lane);
            continue; }
        r -= T_WMO;
        {
            const int j = r / 8, jj = r % 8; const int t = 6 * j + 4;
            const float* gp = a->ln_g + (size_t)(t - 1) * D; const float* bp = a->ln_b + (size_t)(t - 1) * D;
            const float* W = a->win + (size_t)j * D * NMIW + NMI + jj;
            bf16* wg16 = (bf16*)(vec + V_WG / 4) + (size_t)(j * 8 + jj) * D;
            float s1 = 0.f, s2 = 0.f;
            for (int k = lane; k < D; k += 64) { const float w = W[(size_t)k * NMIW]; const unsigned hv = pk2(w * gp[k], 0.f) & 0xffffu; wg16[k] = (bf16)hv; s1 += bflo(hv); s2 += w * bp[k]; }
            s1 = wave_sum(s1); s2 = wave_sum(s2);
            if (lane == 0) { vec[V_CG / 4 + j * 16 + jj] = s1; vec[V_CG / 4 + j * 16 + 8 + jj] = s2 + a->bg[j * 8 + jj]; }
        }
    }
    bf16* R = (bf16*)(ws + WS_R); float* sp0 = (float*)(ws + WS_SP);
    for (int m = gw; m < M; m += NGW) {
        const GAS f32x4* xr = (const GAS f32x4*)(a->x + (size_t)m * D);
#pragma unroll
        for (int i = 0; i < 4; ++i) { const f32x4 v0 = __builtin_nontemporal_load(xr + (i * 64 + lane) * 2), v1 = __builtin_nontemporal_load(xr + (i * 64 + lane) * 2 + 1);
            *(GAS v4u*)(R + (size_t)m * D + (i * 64 + lane) * 8) = (v4u){pk2(v0[0], v0[1]), pk2(v0[2], v0[3]), pk2(v1[0], v1[1]), pk2(v1[2], v1[3])};
            { const float xv[8] = {v0[0], v0[1], v0[2], v0[3], v1[0], v1[1], v1[2], v1[3]}; *(GAS v2u*)(ws + WS_R8 + (size_t)m * D + (i * 64 + lane) * 8) = pg8::cvt8_f8(xv, pg8::F8_SR); } }
        if (lane < 8) *(f32x2*)(sp0 + (size_t)m * 16 + lane * 2) = (f32x2){0.f, 256.f * (1.f - LN_EPS)};
    }
    for (int i = gw * 64 + lane; i < D; i += NGW * 64) { vec[V_ONES / 4 + i] = 1.f; vec[V_ZEROS / 4 + i] = 0.f; }
    (void)ones; (void)zeros;
}

DI void gates_phase(LAS unsigned char* lds, const bf16* R, const float* sp, const bf16* wg16, const float* cg, float* GT, int ng, int gx, int gy, int Gy, int wave_in) {
    int wave = wave_in; asm volatile("" : "+s"(wave));
    const int lane = pg8::pg8_lane(), tid = wave * 64 + lane, r32 = lane & 31, hi = lane >> 5;
    LAS float* part = (LAS float*)lds;
    const unsigned mk = (r32 < 8) ? 0xffffffffu : 0u; const v4u mkv = {mk, mk, mk, mk};
    for (int uu = gy; uu < (SEQ / 64) * (BATCH / ng); uu += Gy) { const int b = gx + ng * (uu >> 5), pl = uu & 31;
        const long r0 = (long)b * SEQ + (long)pl * 64;
        const bf16* bsrc = wg16 + (size_t)(r32 & 7) * D + 256 * wave + 8 * hi;
        bf16x8 bfr[16];
#pragma unroll
        for (int ks = 0; ks < 16; ++ks) bfr[ks] = __builtin_bit_cast(bf16x8, *(const v4u*)(bsrc + 16 * ks) & mkv);
#pragma unroll
        for (int rt = 0; rt < 2; ++rt) {
            const bf16* asrc = R + (r0 + 32 * rt + r32) * D + 256 * wave + 8 * hi;
            bf16x8 afr[16];
#pragma unroll
            for (int ks = 0; ks < 16; ++ks) afr[ks] = *(const bf16x8*)(asrc + 16 * ks);
            f32x16 acc = zero16();
#pragma unroll
            for (int ks = 0; ks < 16; ++ks) acc = MFMA32(afr[ks], bfr[ks], acc);
            if (r32 < 8) {
#pragma unroll
                for (int r = 0; r < 16; ++r) part[(wave * 64 + 32 * rt + crow(r, hi)) * 8 + r32] = acc[r];
            }
        }
        WG_BAR();
        {
            const int row = tid >> 3, col = tid & 7;
            float s = 0.f;
#pragma unroll
            for (int w = 0; w < 8; ++w) s += part[(w * 64 + row) * 8 + col];
            const f32x4* spr = (const f32x4*)(sp + (size_t)(r0 + row) * 16);
            const f32x4 v0 = spr[0], v1 = spr[1], v2 = spr[2], v3 = spr[3];
            const float ss = ((v0[0] + v0[2]) + (v1[0] + v1[2])) + ((v2[0] + v2[2]) + (v3[0] + v3[2])), qq = ((v0[1] + v0[3]) + (v1[1] + v1[3])) + ((v2[1] + v2[3]) + (v3[1] + v3[3]));
            const float mean = ss * (1.f / D), var = qq * (1.f / D) - mean * mean, rstd = __builtin_amdgcn_rsqf(var + LN_EPS);
            GT[(size_t)(r0 + row) * 8 + col] = rstd * (s - mean * cg[col]) + cg[8 + col];
        }
        WG_BAR();
    }
}

DI void final_ln(const bf16* R, const float* sp, const float* g, const float* b, float* out, int ng, int gx, int gw, int NGW, int lane) {
    for (int bb = gx; bb < BATCH; bb += ng) for (int m = bb * SEQ + gw; m < (bb + 1) * SEQ; m += NGW) {
        float s, q;
        { const f32x4 v = *(const f32x4*)(sp + (size_t)m * 16 + (lane & 3) * 4); s = v[0] + v[2]; q = v[1] + v[3];
          s += SWZ_XOR(s, 1); q += SWZ_XOR(q, 1); s += SWZ_XOR(s, 2); q += SWZ_XOR(q, 2); }
        const float mean = s * (1.f / D), var = q * (1.f / D) - mean * mean, rstd = __builtin_amdgcn_rsqf(var + LN_EPS);
#pragma unroll
        for (int i = 0; i < 4; ++i) {
            const int k = 8 * lane + 512 * i;
            const v4u rv = __builtin_nontemporal_load((const v4u*)(R + (size_t)m * D + k));
            const f32x4 g0 = *(const f32x4*)(g + k), g1 = *(const f32x4*)(g + k + 4), b0 = *(const f32x4*)(b + k), b1 = *(const f32x4*)(b + k + 4);
            f32x4 o0, o1;
            o0[0] = (bflo(rv.x) - mean) * rstd * g0[0] + b0[0]; o0[1] = (bfhi(rv.x) - mean) * rstd * g0[1] + b0[1]; o0[2] = (bflo(rv.y) - mean) * rstd * g0[2] + b0[2]; o0[3] = (bfhi(rv.y) - mean) * rstd * g0[3] + b0[3];
            o1[0] = (bflo(rv.z) - mean) * rstd * g1[0] + b1[0]; o1[1] = (bfhi(rv.z) - mean) * rstd * g1[1] + b1[1]; o1[2] = (bflo(rv.w) - mean) * rstd * g1[2] + b1[2]; o1[3] = (bfhi(rv.w) - mean) * rstd * g1[3] + b1[3];
            __builtin_nontemporal_store(o0, (GAS f32x4*)(out + (size_t)m * D + k)); __builtin_nontemporal_store(o1, (GAS f32x4*)(out + (size_t)m * D + k + 4));
        }
    }
}

#ifndef PROBE_DUP
#define PROBE_DUP 0
#endif
#ifndef UP_ALIGN
#define UP_ALIGN true
#endif
#ifndef UP_STG
#define UP_STG false
#endif
#ifndef PROBE_DRY
#define PROBE_DRY 1
#endif
#ifndef PROBE_MLV
#define PROBE_MLV 0
#endif
#ifndef SKIP_ATT
#define SKIP_ATT 0
#endif
#ifndef SKIP_MLSTM
#define SKIP_MLSTM 0
#endif

#define GRID_BAR1() do { XcdBarrier b_; b_.bar = (unsigned*)(kargs()->ws + WS_CTL) + CW_BAR; b_.x = xb_xcc_id(); b_.st = (volatile LAS unsigned*)(lds + MISC_OFF) + 8; b_.total = gridDim.x; xcd_barrier(b_); } while (0)
#define GRID_BAR() do { GRID_BAR1(); if (PROBE_DUP & 1024) GRID_BAR1(); } while (0)
#define GROUP_BAR1() do { XcdBarrier b_; b_.bar = (unsigned*)(kargs()->ws + WS_CTL) + CW_BAR + (1 + (bid & 7)) * XCD_BAR_WORDS; b_.x = xb_xcc_id(); b_.st = (volatile LAS unsigned*)(lds + MISC_OFF) + 10; b_.total = gridDim.x / 8; xcd_barrier(b_); } while (0)
#define LAYER_BAR() do { if (grouped) { GROUP_BAR1(); if (PROBE_DUP & 1024) GROUP_BAR1(); } else GRID_BAR(); } while (0)

__global__ void __launch_bounds__(NWAVES * 64, 2) fwd_kernel(Args args_by_value) {
    extern __shared__ __attribute__((aligned(16))) unsigned char lds_raw[];
    LAS unsigned char* lds = (LAS unsigned char*)lds_raw;
    const int w0 = __builtin_amdgcn_readfirstlane((int)threadIdx.x >> 6);
    const int G0 = gridDim.x, bid0 = blockIdx.x; const int G = G0, bid = bid0;
    { const int tid0 = threadIdx.x; if (tid0 < 64) ((volatile LAS unsigned*)(lds + MISC_OFF))[tid0] = 0u; }
    __syncthreads();
    (void)xcd_barrier_post((unsigned*)(kargs()->ws + WS_CTL) + CW_BAR, (volatile LAS unsigned*)(lds + MISC_OFF) + 8);
#ifndef FORCE_UNGROUPED
#define FORCE_UNGROUPED 0
#endif
    const bool grouped = (G0 == 256) && !FORCE_UNGROUPED;
    if (grouped) (void)xcd_barrier_post((unsigned*)(kargs()->ws + WS_CTL) + CW_BAR + (1 + (bid0 & 7)) * XCD_BAR_WORDS, (volatile LAS unsigned*)(lds + MISC_OFF) + 10);
    {
        const int vcu = (G % 8 == 0) ? (bid % 8) * (G / 8) + bid / 8 : bid;
        prologue(kargs(), lds, vcu * NWAVES + w0, G * NWAVES, w0, pg8::pg8_lane());
        if (PROBE_DUP & 1) { WG_BAR(); prologue(kargs(), lds, vcu * NWAVES + w0, G * NWAVES, w0, pg8::pg8_lane()); }
#ifndef PROBE_PAT
#define PROBE_PAT 0
#endif
        if (PROBE_DUP & 8192) {
            kargs_t ka = kargs(); const int gwv = vcu * NWAVES + w0, lane = pg8::pg8_lane(); float s = 0.f;
            if (PROBE_PAT == 0) {
                for (int it = gwv; it < 8 * 2 * 176; it += G * NWAVES) { const int f = it / 352, rr = it % 352, which = rr / 176, n0 = 32 * (rr % 176); const float* W = (which ? ka->w3 : ka->w1) + (size_t)f * D * FF;
                    for (int kb = 0; kb < 32; ++kb) {
#pragma unroll 8
                        for (int i = 0; i < 32; ++i) s += __builtin_nontemporal_load(W + (size_t)(kb * 64 + 2 * i + (lane >> 5)) * FF + n0 + (lane & 31)); } }
            } else if (PROBE_PAT == 1) {
                for (int it = gwv; it < 8 * 2 * 176; it += G * NWAVES) { const int f = it / 352, rr = it % 352, which = rr / 176, st = rr % 176, n0 = 64 * (st >> 1), kh = st & 1; const float* W = (which ? ka->w3 : ka->w1) + (size_t)f * D * FF;
                    for (int kb = 0; kb < 16; ++kb) {
#pragma unroll 8
                        for (int i = 0; i < 64; ++i) s += __builtin_nontemporal_load(W + (size_t)(kh * 1024 + kb * 64 + i) * FF + n0 + lane); } }
            } else {
                for (int it = gwv; it < 8 * 2 * 176; it += G * NWAVES) { const int f = it / 352, rr = it % 352, which = rr / 176, st = rr % 176, n0 = 256 * (st >> 3), k8 = st & 7; const float* W = (which ? ka->w3 : ka->w1) + (size_t)f * D * FF;
                    for (int kb = 0; kb < 32; ++kb) {
#pragma unroll
                        for (int i = 0; i < 8; ++i) { const f32x4 v = __builtin_nontemporal_load((const f32x4*)(W + (size_t)(k8 * 256 + kb * 8 + i) * FF + n0 + 4 * lane)); s += v[0] + v[1] + v[2] + v[3]; } } }
            }
            if (s == 123.456f) ((float*)(ka->ws + WS_GATES))[0] = s;
        }
    }
    GRID_BAR();
#ifndef GROUP_STAGGER_TICKS
#define GROUP_STAGGER_TICKS 0
#endif
    if (grouped && (bid0 & 1) && GROUP_STAGGER_TICKS > 0) { const unsigned long long t0 = __builtin_amdgcn_s_memrealtime(); while (__builtin_amdgcn_s_memrealtime() - t0 < (unsigned long long)GROUP_STAGGER_TICKS) __builtin_amdgcn_s_sleep(8); }

    for (int t = 0; t < 3 * DEPTH; ++t) {
        int G = G0, bid = bid0; asm volatile("" : "+s"(G), "+s"(bid));
        const int ng = grouped ? 8 : 1, gx = bid % ng, gy = bid / ng, Gy = G / ng;
        const int layer = t / 3, sub = t % 3;
        const int kind = (sub != 1) ? 0 : ((layer & 1) ? 2 : 1);
        const int j = layer >> 1;
        {
            unsigned char* ws = kargs()->ws;
            float* vec = (float*)(ws + WS_VEC);
            const bf16* R = (const bf16*)(ws + WS_R);
            const float* sp_in = (const float*)(ws + WS_SP) + (size_t)(t & 1) * (SP_BYTES / 4);
            if (kind == 0) {
                const int f = 2 * layer + (sub >> 1);
                pg8::Gemm g{(const bf16*)(ws + WS_R8), (const bf16*)(ws + WS_W13 + (size_t)f * NUP * D), M, NUP, D / 2}; pg8::StaticOrder S; S.init(M, NUP, G, bid);
                pg8::EpiUp E{f, t & 1};
                if (PROBE_DUP & 2048) { S.r1 = 5; pg8::gemm_phase<pg8::EpiUp, pg8::StaticOrder, true, PG8_SP2, true>(lds + RING_OFF, g, S, E, w0); LAYER_BAR(); S.r0 = 5; S.r1 = 1 << 20; }
                if (grouped) { pg8::EpiUpT<true, 0, UP_STG> ET{f, t & 1}; pg8::gemm_phase<pg8::EpiUpT<true, 0, UP_STG>, pg8::StaticOrder, UP_ALIGN, PG8_SP2, true>(lds + RING_OFF, g, S, ET, w0); }
                else pg8::gemm_phase<pg8::EpiUp, pg8::StaticOrder, true, PG8_SP2, true>(lds + RING_OFF, g, S, E, w0);
#ifndef PROBE_UPV
#define PROBE_UPV 4
#endif
                if (PROBE_DUP & 4096) { pg8::EpiUpT<true, PROBE_UPV> EP{f, t & 1}; pg8::gemm_phase<pg8::EpiUpT<true, PROBE_UPV>, pg8::StaticOrder, true, PG8_SP2, true>(lds + RING_OFF, g, S, EP, w0); }
                if (PROBE_DUP & 16) pg8::gemm_phase<pg8::EpiUp, pg8::StaticOrder, true, PG8_SP2, true>(lds + RING_OFF, g, S, E, w0);
                if (PROBE_DUP & 128) { pg8::EpiNull EN{(float*)(ws + WS_GATES)}; pg8::gemm_phase<pg8::EpiNull, pg8::StaticOrder, true, PG8_SP2, true>(lds + RING_OFF, g, S, EN, w0); }
            } else {
                if (kind == 2) {
                    pg8::Gemm g{R, (const bf16*)(ws + WS_WIN) + (size_t)j * NMI * D, M, OG_F8 ? 4096 : NMI, D}; pg8::StaticOrder S; S.init(M, OG_F8 ? 4096 : NMI, G, bid);
                    pg8::EpiLnOut E{1, j, t & 1};
                    pg8::gemm_phase<pg8::EpiLnOut, pg8::StaticOrder, true, PG8_SP2>(lds + RING_OFF, g, S, E, w0);
                    if (PROBE_DUP & 32) pg8::gemm_phase<pg8::EpiLnOut, pg8::StaticOrder, true, PG8_SP2>(lds + RING_OFF, g, S, E, w0);
                }
                if (kind == 1 || (kind == 2 && OG_F8)) {
                    const int N = kind == 1 ? NQKV : 2048;
                    pg8::Gemm g{(const bf16*)(ws + WS_R8), (const bf16*)(kind == 1 ? ws + WS_WQKV + (size_t)j * NQKV * D : ws + WS_WIN + ((size_t)j * NMI + 4096) * D * 2), M, N, D / 2}; pg8::StaticOrder S; S.init(M, N, G, bid);
                    pg8::EpiLnOut E{kind == 1 ? 0 : 2, j, t & 1};
                    pg8::gemm_phase<pg8::EpiLnOut, pg8::StaticOrder, true, PG8_SP2, true>(lds + RING_OFF, g, S, E, w0);
                    if (PROBE_DUP & 32) pg8::gemm_phase<pg8::EpiLnOut, pg8::StaticOrder, true, PG8_SP2, true>(lds + RING_OFF, g, S, E, w0);
                }
                if (kind == 2) {
                    gates_phase(lds, R, sp_in, (const bf16*)(vec + V_WG / 4) + (size_t)j * 8 * D, vec + V_CG / 4 + j * 16, (float*)(ws + WS_GATES), ng, gx, gy, Gy, w0);
                    if (PROBE_DUP & 8) { WG_BAR(); gates_phase(lds, R, sp_in, (const bf16*)(vec + V_WG / 4) + (size_t)j * 8 * D, vec + V_CG / 4 + j * 16, (float*)(ws + WS_GATES), ng, gx, gy, Gy, w0); }
                }
            }
        }
        LAYER_BAR();
        if (kind == 1) {
            if (!SKIP_ATT) { kargs_t ka = kargs(); unsigned char* ws = ka->ws; attn_phase(lds_raw, (const bf16*)(ws + WS_QKV), ws + WS_AO, ka->sinks + j * 32, ng, gx, gy, Gy, w0);
                if (PROBE_DUP & 2) attn_phase(lds_raw, (const bf16*)(ws + WS_QKV), ws + WS_AO, ka->sinks + j * 32, ng, gx, gy, Gy, w0); }
            LAYER_BAR();
        } else if (kind == 2) {
            if (!SKIP_MLSTM) { unsigned char* ws = kargs()->ws; mlstm_phase(lds_raw, (const bf16*)(ws + WS_MP), (const float*)(ws + WS_GATES), (bf16*)(ws + WS_HG), ng, gx, gy, Gy, w0);
                if (PROBE_DUP & 4) mlstm_phase<PROBE_MLV>(lds_raw, (const bf16*)(ws + WS_MP), (const float*)(ws + WS_GATES), (bf16*)(ws + WS_H), ng, gx, gy, Gy, w0); }
            LAYER_BAR();
        }
        {
            kargs_t ka = kargs(); unsigned char* ws = ka->ws;
            float coef = kind == 0 ? 0.5f / (pg8::F8_SH * pg8::F8_SW) : (kind == 1 ? 1.f / (pg8::F8_SO * pg8::F8_SW) : 1.f);
            if ((kind == 1 && SKIP_ATT) || (kind == 2 && SKIP_MLSTM)) coef = 0.f;
            pg8::StaticOrder S; S.init(M, D, G, bid);
            pg8::EpiRes E{t, coef, (LAS float*)(lds + TAB_OFF), w0, 0};
            if (kind != 2) {
                const int f = 2 * layer + (sub >> 1);
                pg8::Gemm g{(const bf16*)(ws + (kind == 0 ? WS_H : WS_AO)), (const bf16*)(kind == 0 ? ws + WS_W2 + (size_t)f * D * FF : ws + WS_WO + (size_t)j * D * D), M, D, kind == 0 ? FF / 2 : D / 2};
                if (PROBE_DUP & 64) { pg8::EpiNull EN{(float*)(ws + WS_GATES)}; pg8::gemm_phase<pg8::EpiNull, pg8::StaticOrder, true, PG8_SP2, true>(lds + RING_OFF, g, S, EN, w0); }
                if (PROBE_DUP & 512) { pg8::EpiRes ED{t, coef, (LAS float*)(lds + TAB_OFF), w0, PROBE_DRY}; pg8::gemm_phase<pg8::EpiRes, pg8::StaticOrder, true, PG8_SP2, true>(lds + RING_OFF, g, S, ED, w0); }
                pg8::gemm_phase<pg8::EpiRes, pg8::StaticOrder, true, PG8_SP2, true>(lds + RING_OFF, g, S, E, w0);
            } else {
                pg8::Gemm g{(const bf16*)(ws + WS_HG), (const bf16*)(ws + WS_WMO) + (size_t)j * D * D, M, D, D};
                if (PROBE_DUP & 256) { pg8::EpiNull EN{(float*)(ws + WS_GATES)}; pg8::gemm_phase<pg8::EpiNull, pg8::StaticOrder, true, PG8_SP2, false>(lds + RING_OFF, g, S, EN, w0); }
                pg8::gemm_phase<pg8::EpiRes, pg8::StaticOrder, true, PG8_SP2, false>(lds + RING_OFF, g, S, E, w0);
            }
        }
        LAYER_BAR();
    }
    {
        kargs_t ka = kargs(); unsigned char* ws = ka->ws;
        const int ng = grouped ? 8 : 1, gx = bid % ng, gy = bid / ng, Gy = G / ng;
        final_ln((const bf16*)(ws + WS_R), (const float*)(ws + WS_SP), ka->ln_g + (size_t)(3 * DEPTH - 1) * D, ka->ln_b + (size_t)(3 * DEPTH - 1) * D, ka->out, ng, gx, gy * NWAVES + w0, Gy * NWAVES, pg8::pg8_lane());
    }
}

extern "C" void kernel_launch(void* const* d_in, const int* in_sizes, int n_in, void* d_out, int out_size, void* d_ws, size_t ws_size, hipStream_t stream) {
    static int grid = 0;
    if (grid == 0) {
        if (n_in != 12 || in_sizes[0] != M * D || out_size != M * D || ws_size < WS_END) { fprintf(stderr, "kernel_launch: unexpected shapes / workspace (n_in %d, ws %zu < %zu); nothing launched\n", n_in, ws_size, (size_t)WS_END); grid = -1; return; }
        int dev = 0, cus = 0;
        if (hipGetDevice(&dev) != hipSuccess || hipDeviceGetAttribute(&cus, hipDeviceAttributeMultiprocessorCount, dev) != hipSuccess) { grid = -1; return; }
        if (hipFuncSetAttribute((const void*)fwd_kernel, hipFuncAttributeMaxDynamicSharedMemorySize, LDS_BYTES) != hipSuccess) { fprintf(stderr, "kernel_launch: hipFuncSetAttribute failed\n"); grid = -1; return; }
        int per_cu = 0;
        if (hipOccupancyMaxActiveBlocksPerMultiprocessor(&per_cu, (const void*)fwd_kernel, NWAVES * 64, LDS_BYTES) != hipSuccess || per_cu < 1) { fprintf(stderr, "kernel_launch: occupancy query says %d\n", per_cu); }
        (void)hipGetLastError();
        grid = cus;
#ifdef FORCE_GRID
        grid = FORCE_GRID;
#endif
    }
    if (grid < 0) return;
    (void)hipMemsetAsync((char*)d_ws + WS_CTL, 0, CTL_ZERO_BYTES, stream);
    Args a{};
    a.x = (const float*)d_in[0]; a.w1 = (const float*)d_in[1]; a.w3 = (const float*)d_in[2]; a.w2 = (const float*)d_in[3]; a.ln_g = (const float*)d_in[4]; a.ln_b = (const float*)d_in[5];
    a.wqkv = (const float*)d_in[6]; a.sinks = (const float*)d_in[7]; a.wo = (const float*)d_in[8]; a.win = (const float*)d_in[9]; a.bg = (const float*)d_in[10]; a.wmo = (const float*)d_in[11];
    a.out = (float*)d_out; a.ws = (unsigned char*)d_ws;
    hipLaunchKernelGGL(fwd_kernel, dim3(grid), dim3(NWAVES * 64), LDS_BYTES, stream, a);
}
```
